# Optimizing an MI355X kernel written in HIP

```python
import jax, jax.numpy as jnp
from jax import lax
import numpy as np

D_MODEL = 1024
BATCH = 8
SEQ = 4096
DEPTH = 4

N_MIXERS = 2
N_LAYERS_A = (DEPTH + 1) // 2
N_LAYERS_B = DEPTH // 2

DEEPNORM_ALPHA = (2.0 * DEPTH) ** 0.25
DEEPNORM_BETA = (8.0 * DEPTH) ** -0.25
LN_EPS = 1e-5

GLA_HEADS = 4
GLA_DK = D_MODEL // 2 // GLA_HEADS
GLA_DV = D_MODEL // GLA_HEADS
GLA_QK = GLA_HEADS * GLA_DK
GLA_VO = GLA_HEADS * GLA_DV
GLA_GATE_RANK = 16
GLA_GATE_TAU = 16.0
GLA_CHUNK = 64
GLA_IN = 2 * GLA_QK + 2 * GLA_VO + 2 * GLA_GATE_RANK
GLA_SPLITS = [GLA_QK, 2 * GLA_QK, 2 * GLA_QK + GLA_VO, 2 * GLA_QK + 2 * GLA_VO,
              2 * GLA_QK + 2 * GLA_VO + GLA_GATE_RANK]

SGU_CHUNK = 128
SGU_GROUPS = 8
SGU_WIDTH = D_MODEL
SGU_GROUP_DIM = SGU_WIDTH // SGU_GROUPS

N_EXPERTS = 32
TOP_K = 4
D_EXPERT = D_MODEL
SWIGLU_LIMIT = 7.0
SWIGLU_ALPHA = 1.702
MOE_BLOCK = 256

kernel_name = 'hybrid_gla_sgu_moe_deepnorm'


def layer_norm(x, g, b):
    xf = x.astype(jnp.float32)
    mu = jnp.mean(xf, axis=-1, keepdims=True)
    var = jnp.mean(jnp.square(xf - mu), axis=-1, keepdims=True)
    y = (xf - mu) * lax.rsqrt(var + LN_EPS)
    return (y * g.astype(jnp.float32) + b.astype(jnp.float32)).astype(x.dtype)


def gla_scan(q, k, v, logg):
    bsz, nh, s, dk = q.shape
    dv = v.shape[-1]
    nc = s // GLA_CHUNK

    def to_chunks(t):
        t = t.reshape(bsz, nh, nc, GLA_CHUNK, t.shape[-1])
        return jnp.moveaxis(t, 2, 0)

    mask = jnp.tril(jnp.ones((GLA_CHUNK, GLA_CHUNK), dtype=bool))[:, :, None]

    def step(state, inp):
        qc, kc, vc, gc = inp
        b = jnp.cumsum(gc, axis=-2)
        o_inter = jnp.einsum('bhid,bhde->bhie', qc * jnp.exp(b), state)
        diff = b[:, :, :, None, :] - b[:, :, None, :, :]
        decay = jnp.exp(jnp.where(mask, diff, -jnp.inf))
        scores = jnp.einsum('bhid,bhjd,bhijd->bhij', qc, kc, decay)
        o_intra = jnp.einsum('bhij,bhje->bhie', scores, vc)
        b_last = b[:, :, -1:, :]
        new_state = (jnp.exp(b_last[:, :, 0, :])[..., None] * state
                     + jnp.einsum('bhjd,bhje->bhde', kc * jnp.exp(b_last - b), vc))
        return new_state, o_inter + o_intra

    s0 = jnp.zeros((bsz, nh, dk, dv), jnp.float32)
    _, o = lax.scan(step, s0, (to_chunks(q), to_chunks(k), to_chunks(v), to_chunks(logg)))
    return jnp.moveaxis(o, 0, 2).reshape(bsz, nh, s, dv)


def gla_mixer(h, w_in, wg2_f, bg_f, wg2_b, bg_b, norm_g, w_out):
    bsz, s, _ = h.shape
    proj = h @ w_in
    q, k, v, r, lr_f, lr_b = jnp.split(proj, GLA_SPLITS, axis=-1)

    def heads(t, d):
        return t.reshape(bsz, s, GLA_HEADS, d).transpose(0, 2, 1, 3).astype(jnp.float32)

    qh = heads(q, GLA_DK) * (GLA_DK ** -0.5)
    kh = heads(k, GLA_DK)
    vh = heads(v, GLA_DV)
    logg_f = heads(jax.nn.log_sigmoid((lr_f @ wg2_f + bg_f).astype(jnp.float32)) / GLA_GATE_TAU, GLA_DK)
    logg_b = heads(jax.nn.log_sigmoid((lr_b @ wg2_b + bg_b).astype(jnp.float32)) / GLA_GATE_TAU, GLA_DK)

    o_f = gla_scan(qh, kh, vh, logg_f)
    flip = lambda t: jnp.flip(t, axis=2)
    o_b = flip(gla_scan(flip(qh), flip(kh), flip(vh), flip(logg_b)))
    o = o_f + o_b
    o = o * lax.rsqrt(jnp.mean(o * o, axis=-1, keepdims=True) + LN_EPS)
    o = o.astype(h.dtype) * norm_g
    o = o.transpose(0, 2, 1, 3).reshape(bsz, s, GLA_VO)
    return (o * jax.nn.silu(r)) @ w_out


def sgu_mixer(h, w_in, b_in, ln_g, ln_b, w_s, b_s, w_out, b_out):
    bsz, s, _ = h.shape
    z = jax.nn.gelu(h @ w_in + b_in, approximate=False)
    u, v = z[..., :SGU_WIDTH], z[..., SGU_WIDTH:]
    v = layer_norm(v, ln_g, ln_b)
    nch = s // SGU_CHUNK
    v = v.reshape(bsz, nch, SGU_CHUNK, SGU_GROUPS, SGU_GROUP_DIM)
    sv = jnp.einsum('gpq,bnqgc->bnpgc', w_s, v) + b_s.T[None, None, :, :, None]
    sv = sv.reshape(bsz, s, SGU_WIDTH)
    return (u * sv) @ w_out + b_out


def clamped_swiglu(hu):
    gate, lin = hu[..., ::2], hu[..., 1::2]
    gate = jnp.minimum(gate, SWIGLU_LIMIT)
    lin = jnp.clip(lin, -SWIGLU_LIMIT, SWIGLU_LIMIT)
    return gate * jax.nn.sigmoid(SWIGLU_ALPHA * gate) * (lin + 1.0)


def moe_ffn(h, w_router, b_router, w_up, b_up, w_down, b_down):
    bsz, s, d = h.shape
    n_tok = bsz * s
    xt = h.reshape(n_tok, d)
    logits = (xt @ w_router + b_router).astype(jnp.float32)
    top_vals, top_idx = lax.top_k(logits, TOP_K)
    top_w = jax.nn.softmax(top_vals, axis=-1).astype(h.dtype)

    n_assign = n_tok * TOP_K
    flat_e = top_idx.reshape(-1).astype(jnp.int32)
    flat_w = top_w.reshape(-1)
    flat_tok = jnp.arange(n_assign, dtype=jnp.int32) // TOP_K
    order = jnp.argsort(flat_e)
    se, stok, sw = flat_e[order], flat_tok[order], flat_w[order]

    counts = jnp.zeros((N_EXPERTS,), jnp.int32).at[flat_e].add(1)
    padded = (counts + MOE_BLOCK - 1) // MOE_BLOCK * MOE_BLOCK
    grp_start = jnp.cumsum(counts) - counts
    pad_end = jnp.cumsum(padded)
    pad_start = pad_end - padded
    dest = pad_start[se] + (jnp.arange(n_assign, dtype=jnp.int32) - grp_start[se])
    n_blocks = -(-(n_assign + N_EXPERTS * MOE_BLOCK) // MOE_BLOCK)
    cap = n_blocks * MOE_BLOCK
    buf_tok = jnp.zeros((cap,), jnp.int32).at[dest].set(stok)
    buf_w = jnp.zeros((cap,), h.dtype).at[dest].set(sw)
    blk_start = jnp.arange(n_blocks, dtype=jnp.int32) * MOE_BLOCK
    blk_e = jnp.minimum(jnp.searchsorted(pad_end, blk_start, side='right'), N_EXPERTS - 1).astype(jnp.int32)

    xb = xt[buf_tok].reshape(n_blocks, MOE_BLOCK, d)

    def expert_block(args):
        xblk, e = args
        hu = xblk @ w_up[e] + b_up[e]
        return clamped_swiglu(hu) @ w_down[e] + b_down[e]

    yb = lax.map(expert_block, (xb, blk_e)).reshape(cap, d) * buf_w[:, None]
    return jnp.zeros((n_tok, d), h.dtype).at[buf_tok].add(yb).reshape(bsz, s, d)


def setup_inputs(seed: int = 0) -> dict:
    key = jax.random.key(seed)
    ks = jax.random.split(key, 32)
    nrm = lambda k, shape, sc: jax.random.normal(k, shape, jnp.float32) * sc
    d = D_MODEL
    return {
        'x': nrm(ks[0], (BATCH, SEQ, d), 1.0),
        'c': nrm(ks[1], (BATCH, d), 1.0),
        'ada_w': nrm(ks[2], (DEPTH, d, 6 * d), 0.1 * d ** -0.5),
        'ada_b': nrm(ks[3], (DEPTH, 6 * d), 0.01),
        'ln_g': 1.0 + nrm(ks[4], (DEPTH, 2, d), 0.02),
        'ln_b': nrm(ks[5], (DEPTH, 2, d), 0.02),
        'gla_w_in': nrm(ks[6], (N_LAYERS_A, d, GLA_IN), d ** -0.5),
        'gla_wg2_f': nrm(ks[7], (N_LAYERS_A, GLA_GATE_RANK, GLA_QK), GLA_GATE_RANK ** -0.5),
        'gla_bg_f': nrm(ks[8], (N_LAYERS_A, GLA_QK), 0.1),
        'gla_wg2_b': nrm(ks[9], (N_LAYERS_A, GLA_GATE_RANK, GLA_QK), GLA_GATE_RANK ** -0.5),
        'gla_bg_b': nrm(ks[10], (N_LAYERS_A, GLA_QK), 0.1),
        'gla_norm_g': 1.0 + nrm(ks[11], (N_LAYERS_A, GLA_DV), 0.02),
        'gla_w_out': nrm(ks[12], (N_LAYERS_A, GLA_VO, d), DEEPNORM_BETA * GLA_VO ** -0.5),
        'sgu_w_in': nrm(ks[13], (N_LAYERS_B, d, 2 * SGU_WIDTH), d ** -0.5),
        'sgu_b_in': nrm(ks[14], (N_LAYERS_B, 2 * SGU_WIDTH), 0.02),
        'sgu_ln_g': 1.0 + nrm(ks[15], (N_LAYERS_B, SGU_WIDTH), 0.02),
        'sgu_ln_b': nrm(ks[16], (N_LAYERS_B, SGU_WIDTH), 0.02),
        'sgu_w_s': nrm(ks[17], (N_LAYERS_B, SGU_GROUPS, SGU_CHUNK, SGU_CHUNK), 0.5 * SGU_CHUNK ** -0.5),
        'sgu_b_s': 1.0 + nrm(ks[18], (N_LAYERS_B, SGU_GROUPS, SGU_CHUNK), 0.02),
        'sgu_w_out': nrm(ks[19], (N_LAYERS_B, SGU_WIDTH, d), DEEPNORM_BETA * SGU_WIDTH ** -0.5),
        'sgu_b_out': nrm(ks[20], (N_LAYERS_B, d), 0.02),
        'moe_w_router': nrm(ks[21], (DEPTH, d, N_EXPERTS), d ** -0.5),
        'moe_b_router': nrm(ks[22], (DEPTH, N_EXPERTS), 0.01),
        'moe_w_up': nrm(ks[23], (DEPTH, N_EXPERTS, d, 2 * D_EXPERT), d ** -0.5),
        'moe_b_up': nrm(ks[24], (DEPTH, N_EXPERTS, 2 * D_EXPERT), 0.02),
        'moe_w_down': nrm(ks[25], (DEPTH, N_EXPERTS, D_EXPERT, d), DEEPNORM_BETA * D_EXPERT ** -0.5),
        'moe_b_down': nrm(ks[26], (DEPTH, N_EXPERTS, d), 0.02),
    }


def reference(x, c, ada_w, ada_b, ln_g, ln_b,
              gla_w_in, gla_wg2_f, gla_bg_f, gla_wg2_b, gla_bg_b, gla_norm_g, gla_w_out,
              sgu_w_in, sgu_b_in, sgu_ln_g, sgu_ln_b, sgu_w_s, sgu_b_s, sgu_w_out, sgu_b_out,
              moe_w_router, moe_b_router, moe_w_up, moe_b_up, moe_w_down, moe_b_down):
    mod_all = jnp.einsum('bd,lde->lbe', jax.nn.silu(c), ada_w) + ada_b[:, None, :]
    for layer in range(DEPTH):
        shift1, scale1, gate1, shift2, scale2, gate2 = jnp.split(mod_all[layer], 6, axis=-1)
        h = x * (1.0 + scale1[:, None, :]) + shift1[:, None, :]
        i = layer // N_MIXERS
        if layer % N_MIXERS == 0:
            y = gla_mixer(h, gla_w_in[i], gla_wg2_f[i], gla_bg_f[i], gla_wg2_b[i], gla_bg_b[i],
                          gla_norm_g[i], gla_w_out[i])
        else:
            y = sgu_mixer(h, sgu_w_in[i], sgu_b_in[i], sgu_ln_g[i], sgu_ln_b[i], sgu_w_s[i],
                          sgu_b_s[i], sgu_w_out[i], sgu_b_out[i])
        x = layer_norm(DEEPNORM_ALPHA * x + (1.0 + gate1[:, None, :]) * y, ln_g[layer, 0], ln_b[layer, 0])
        h = x * (1.0 + scale2[:, None, :]) + shift2[:, None, :]
        y = moe_ffn(h, moe_w_router[layer], moe_b_router[layer], moe_w_up[layer], moe_b_up[layer],
                    moe_w_down[layer], moe_b_down[layer])
        x = layer_norm(DEEPNORM_ALPHA * x + (1.0 + gate2[:, None, :]) * y, ln_g[layer, 1], ln_b[layer, 1])
    return x
```

```cpp
#include <hip/hip_runtime.h>
#include <cstdio>
#include <cstdint>

#define LAS __attribute__((address_space(3)))
#define GAS __attribute__((address_space(1)))
typedef unsigned short bf16;
typedef short bf16x8 __attribute__((ext_vector_type(8)));
typedef float f32x4 __attribute__((ext_vector_type(4)));
typedef float f32x2 __attribute__((ext_vector_type(2)));
typedef unsigned u32x4 __attribute__((ext_vector_type(4)));
typedef unsigned u32x2 __attribute__((ext_vector_type(2)));

constexpr int D = 1024, NB = 8, SEQ = 4096, T = NB * SEQ, DEPTH = 4;
constexpr int NE = 32, TOPK = 4, CAP = T * TOPK + NE * 256;
constexpr int MAXTILES = CAP / 256;
constexpr float ALPHA = 1.681792830507429f;
constexpr float LN_EPS = 1e-5f;
constexpr int GLA_IN = 3104, GLA_MAIN = 3072;
constexpr int NWAVES = 8, NTHREADS = 512;
constexpr int LDS_BYTES = 147456, MISC_OFF = 139264;

constexpr size_t MiB = 1u << 20;
constexpr size_t WS_CTL = 0, CTL_ZERO_BYTES = 2 * MiB;
constexpr size_t WS_MOD = 2 * MiB;
constexpr size_t WS_ROUTE = 4 * MiB;
constexpr size_t WS_LR = 8 * MiB;
constexpr size_t WS_GLAIN_T = 16 * MiB;
constexpr size_t WS_GLALR_T = 28 * MiB;
constexpr size_t WS_ROUTER_T = 29 * MiB;
constexpr size_t WS_SGUWS = 30 * MiB;
constexpr size_t WS_GLAOUT_T = 32 * MiB;
constexpr size_t WS_SGUIN_T = 36 * MiB;
constexpr size_t WS_SGUOUT_T = 44 * MiB;
constexpr size_t WS_WUP_T = 64 * MiB;
constexpr size_t WS_WDN_T = 576 * MiB;
constexpr size_t WS_X1 = 832 * MiB;
constexpr size_t WS_X2 = 960 * MiB;
constexpr size_t WS_H = 1088 * MiB;
constexpr size_t WS_BIG = 1152 * MiB;
constexpr size_t WS_OF = 1344 * MiB;
constexpr size_t WS_OB = 1408 * MiB;
constexpr size_t WS_A2 = 1472 * MiB;
constexpr size_t WS_Y = 1536 * MiB;
constexpr size_t WS_ACT = 1664 * MiB;
constexpr size_t WS_YS = 1936 * MiB;
constexpr size_t WS_END = 2208 * MiB;
constexpr int R_TOPI = 0;
constexpr int R_TOPW = T * 4;
constexpr int R_DEST = 2 * T * 4;
constexpr int R_BUFTOK = 3 * T * 4;
constexpr int R_HIST = R_BUFTOK + CAP;
constexpr int R_TILEE = R_HIST + 1024 * 32;
constexpr int R_NTILES = R_TILEE + 1024;
static_assert((size_t)(R_NTILES + 64) * 4 <= 4 * MiB, "route tables");
constexpr int CW_BAR = 4096;
constexpr int MAX_LAUNCH = 64;

#define RLX_AGENT __ATOMIC_RELAXED, __HIP_MEMORY_SCOPE_AGENT
#define LDS_WAIT() asm volatile("s_waitcnt lgkmcnt(0)" ::: "memory")
#define VM_WAIT() asm volatile("s_waitcnt vmcnt(0)" ::: "memory")
__device__ __forceinline__ unsigned cvt_pk_bf16(float lo, float hi) { unsigned r; asm volatile("v_cvt_pk_bf16_f32 %0, %1, %2" : "=v"(r) : "v"(lo), "v"(hi)); return r; }
__device__ __forceinline__ float bf_lo(unsigned w) { return __uint_as_float(w << 16); }
__device__ __forceinline__ float bf_hi(unsigned w) { return __uint_as_float(w & 0xffff0000u); }
__device__ __forceinline__ float bf2f(bf16 b) { return __uint_as_float(((unsigned)b) << 16); }
__device__ __forceinline__ float wave_sum(float v) {
#pragma unroll
    for (int o = 1; o < 64; o <<= 1) v += __shfl_xor(v, o);
    return v;
}
__device__ __forceinline__ float silu_f(float x) { return x / (1.0f + __expf(-x)); }
__device__ __forceinline__ float sigmoid_f(float x) { return 1.0f / (1.0f + __expf(-x)); }
__device__ __forceinline__ float gelu_f(float v) {
    const float av = fabsf(v), t = __builtin_amdgcn_rcpf(av * 0.2316418882f + 1.0f);
    float q = t * 0.5307027145f + (-0.7265760135f); q = q * t + 0.7107068705f; q = q * t + (-0.142248368f); q = q * t + 0.127414796f; q = q * t;
    const float e = __builtin_amdgcn_exp2f((v * v) * (-0.72134752044f));
    const float m = v * (q * e);
    return v < 0.f ? m : v - m;
}

#define XB_TMO      128
#define XB_XCNT(j)  (256  + 64 * (j))
#define XB_XSUB(j)  (1280 + 64 * (j))
#define XB_XGEN(j)  (2304 + 64 * (j))
#define XB_TOP      3328
#define XB_TOPGEN   3392
#define XCD_BAR_WORDS 3456
#define XB_SPIN_CAP (1u << 18)
__device__ __forceinline__ unsigned xb_ld(unsigned* p)              { return __hip_atomic_load(p, __ATOMIC_RELAXED, __HIP_MEMORY_SCOPE_AGENT); }
__device__ __forceinline__ unsigned xb_add(unsigned* p, unsigned v) { return __hip_atomic_fetch_add(p, v, __ATOMIC_RELAXED, __HIP_MEMORY_SCOPE_AGENT); }
__device__ __forceinline__ unsigned xb_xcc_id() { return (unsigned)__builtin_amdgcn_s_getreg((3 << 11) | 20) & 0xFu; }
#define XB_SPIN(cond, bar) do { unsigned _sp = 0; while (cond) { __builtin_amdgcn_s_sleep(1); \
    if ((++_sp & 255u) == 0u) { if (xb_ld(&(bar)[XB_TMO])) break; if (_sp > XB_SPIN_CAP) { atomicAdd(&(bar)[XB_TMO], 1u); break; } } } } while (0)
struct XcdBarrier { unsigned* bar; unsigned x; volatile LAS unsigned* st; };
__device__ __forceinline__ XcdBarrier xcd_barrier_post(unsigned* bar, volatile LAS unsigned* st) {
    XcdBarrier b; b.bar = bar; b.x = xb_xcc_id(); b.st = st;
    if (threadIdx.x == 0) (void)xb_add(&bar[XB_XCNT(b.x)], 1u);
    return b;
}
__device__ __forceinline__ void xcd_barrier_complete(unsigned* bar, unsigned x, unsigned& nloc, unsigned& nx) {
    const unsigned G = gridDim.x * gridDim.y * gridDim.z;
    unsigned sum, cnt, mine, sp = 0u;
    for (;;) {
        sum = 0u; cnt = 0u; mine = 0u;
#pragma unroll
        for (unsigned j = 0; j < 16; ++j) { const unsigned c = xb_ld(&bar[XB_XCNT(j)]); sum += c; cnt += (c > 0u) ? 1u : 0u; mine = (j == x) ? c : mine; }
        if (sum == G) break;
        __builtin_amdgcn_s_sleep(1);
        if ((++sp & 255u) == 0u) { if (xb_ld(&bar[XB_TMO])) break; if (sp > XB_SPIN_CAP) { atomicAdd(&bar[XB_TMO], 1u); break; } }
    }
    nloc = mine > 0u ? mine : 1u; nx = cnt > 0u ? cnt : 1u;
}
__device__ __forceinline__ void xcd_barrier(const XcdBarrier& b) {
    asm volatile("s_waitcnt vmcnt(0)" ::: "memory");
    __syncthreads();
    if (threadIdx.x == 0) {
        unsigned* bar = b.bar;
        __builtin_amdgcn_s_waitcnt(0);
        unsigned nloc = b.st[0], nx = b.st[1];
        if (nloc == 0u) { xcd_barrier_complete(bar, b.x, nloc, nx); b.st[0] = nloc; b.st[1] = nx; }
        const unsigned old = xb_add(&bar[XB_XSUB(b.x)], 1u);
        const unsigned gen = old / nloc;
        if (old + 1u == (gen + 1u) * nloc) {
            __builtin_amdgcn_fence(__ATOMIC_RELEASE, "agent");
            asm volatile("s_waitcnt vmcnt(0)" ::: "memory");
            const unsigned og = xb_add(&bar[XB_TOP], 1u);
            const unsigned tg = og / nx;
            if (og + 1u == (tg + 1u) * nx) xb_add(&bar[XB_TOPGEN], 1u);
            else XB_SPIN(xb_ld(&bar[XB_TOPGEN]) == tg, bar);
            __builtin_amdgcn_fence(__ATOMIC_ACQUIRE, "agent");
            xb_add(&bar[XB_XGEN(b.x)], 1u);
            asm volatile("s_waitcnt vmcnt(0)" ::: "memory");
        } else {
            XB_SPIN(xb_ld(&bar[XB_XGEN(b.x)]) == gen, bar);
            __builtin_amdgcn_fence(__ATOMIC_ACQUIRE, "agent");
            asm volatile("s_waitcnt vmcnt(0)" ::: "memory");
        }
    }
    __syncthreads();
}

struct Args { const float* in[27]; float* out; unsigned char* ws; int ph_lo, ph_hi, li, pad; };
enum { I_X = 0, I_C, I_ADAW, I_ADAB, I_LNG, I_LNB, I_GWIN, I_GWG2F, I_GBGF, I_GWG2B, I_GBGB, I_GNORM, I_GWOUT, I_SWIN, I_SBIN, I_SLNG, I_SLNB, I_SWS, I_SBS, I_SWOUT, I_SBOUT, I_RW, I_RB, I_WUP, I_BUP, I_WDN, I_BDN };

#define PHASE_ENTER() int tid = threadIdx.x; asm volatile("" : "+v"(tid)); int bx = blockIdx.x, G = gridDim.x; asm volatile("" : "+s"(bx), "+s"(G)); \
    const Args* ap_ = (const Args*)__builtin_amdgcn_kernarg_segment_ptr(); asm volatile("" : "+s"(ap_)); const Args& a = *ap_; unsigned char* ws = a.ws; \
    extern __shared__ __attribute__((aligned(16))) unsigned char lds_raw[]; LAS unsigned char* lds = (LAS unsigned char*)lds_raw; (void)lds; (void)ws; (void)bx; (void)G; (void)tid
__device__ __forceinline__ int swiglu_perm(int o) {
    const int a = o >> 1, h = o & 1, pn = a >> 7, r = a & 127, bj = r >> 6, r2 = r & 63, wc = r2 >> 4, r3 = r2 & 15;
    return 256 * pn + 128 * bj + 32 * wc + 16 * h + r3;
}
__device__ __forceinline__ void conv_tile(const float* W, int K, int N, int k0, int n0, int nw, bf16* dst, int mode, LAS float* scr, int lane) {
    const int c4 = lane & 15, kr = lane >> 4;
    if (4 * c4 < nw) {
#pragma unroll 4
        for (int i = 0; i < 16; ++i) { const int kk = 4 * i + kr; const f32x4 v = *(const f32x4*)(W + (size_t)(k0 + kk) * N + n0 + 4 * c4);
            LAS float* s = scr + kk * 65 + 4 * c4; s[0] = v[0]; s[1] = v[1]; s[2] = v[2]; s[3] = v[3]; }
    }
    LDS_WAIT(); asm volatile("" ::: "memory");
    const int kc = lane & 7, ns = lane >> 3;
    for (int j = 0; j < nw / 8; ++j) {
        const int n = ns + 8 * j; const LAS float* s = scr + (8 * kc) * 65 + n;
        float v[8];
#pragma unroll
        for (int q = 0; q < 8; ++q) v[q] = s[q * 65];
        u32x4 o; o.x = cvt_pk_bf16(v[0], v[1]); o.y = cvt_pk_bf16(v[2], v[3]); o.z = cvt_pk_bf16(v[4], v[5]); o.w = cvt_pk_bf16(v[6], v[7]);
        const int ng = n0 + n;
        if (mode == 2) {
            *(u32x4*)(dst + (size_t)n * K + k0 + 8 * kc) = o;
            u32x4 l; l.x = cvt_pk_bf16(v[0] - bf_lo(o.x), v[1] - bf_hi(o.x)); l.y = cvt_pk_bf16(v[2] - bf_lo(o.y), v[3] - bf_hi(o.y));
            l.z = cvt_pk_bf16(v[4] - bf_lo(o.z), v[5] - bf_hi(o.z)); l.w = cvt_pk_bf16(v[6] - bf_lo(o.w), v[7] - bf_hi(o.w));
            *(u32x4*)(dst + (size_t)(32 + n) * K + k0 + 8 * kc) = l;
        } else {
            const int row = (mode == 1) ? swiglu_perm(ng) : ng;
            *(u32x4*)(dst + (size_t)row * K + k0 + 8 * kc) = o;
        }
    }
    LDS_WAIT(); asm volatile("" ::: "memory");
}

__device__ __forceinline__ void phase_prologue(const Args& a, LAS unsigned char* lds, int tid, int bx, int G) {
    const int lane = tid & 63, wave = __builtin_amdgcn_readfirstlane(tid >> 6);
    unsigned char* ws = a.ws;
    for (int slab = bx; slab < 192; slab += G) {
        LAS float* sc = (LAS float*)lds;
        LAS float* red = (LAS float*)(lds + 32768);
        for (int i = tid; i < 8 * 1024; i += NTHREADS) sc[i] = silu_f(a.in[I_C][i]);
        __syncthreads();
        const int g0 = slab * 128, l = g0 / 6144, e0 = g0 % 6144;
        const int c4 = tid & 31, seg = tid >> 5;
        f32x4 acc[8];
#pragma unroll
        for (int b = 0; b < 8; ++b) acc[b] = (f32x4){0.f, 0.f, 0.f, 0.f};
        const float* wp = a.in[I_ADAW] + ((size_t)l * 1024 + seg * 64) * 6144 + e0 + 4 * c4;
#pragma unroll 8
        for (int d = 0; d < 64; ++d) { const f32x4 w = *(const f32x4*)(wp + (size_t)d * 6144);
#pragma unroll
            for (int b = 0; b < 8; ++b) acc[b] += w * sc[b * 1024 + seg * 64 + d]; }
#pragma unroll
        for (int b = 0; b < 8; ++b) *(LAS f32x4*)(red + (seg * 8 + b) * 128 + 4 * c4) = acc[b];
        __syncthreads();
        for (int o = tid; o < 1024; o += NTHREADS) { const int b = o >> 7, c = o & 127; float s = a.in[I_ADAB][l * 6144 + e0 + c];
#pragma unroll
            for (int sg = 0; sg < 16; ++sg) s += red[(sg * 8 + b) * 128 + c];
            ((float*)(ws + WS_MOD))[((size_t)l * 8 + b) * 6144 + e0 + c] = s; }
        __syncthreads();
    }
    LAS float* scr = (LAS float*)(lds + wave * 16640);
    const int gw = bx * NWAVES + wave, NGW = G * NWAVES;
    constexpr int N_UP = 128 * 16 * 32, N_DN = 128 * 16 * 16, N_GIN = 2 * 16 * 48, N_GLR = 2 * 16, N_GOUT = 2 * 256, N_SIN = 2 * 16 * 32, N_SOUT = 2 * 256, N_RT = 4 * 16;
    constexpr int NITEMS = N_UP + N_DN + N_GIN + N_GLR + N_GOUT + N_SIN + N_SOUT + N_RT;
    for (int it = gw; it < NITEMS; it += NGW) {
        int r = it;
        if (r < N_UP) { const int m = r >> 9, q = r & 511, kt = q >> 5, nt = q & 31;
            conv_tile(a.in[I_WUP] + (size_t)m * 1024 * 2048, 1024, 2048, kt * 64, nt * 64, 64, (bf16*)(ws + WS_WUP_T) + (size_t)m * 2048 * 1024, 1, scr, lane); continue; } r -= N_UP;
        if (r < N_DN) { const int m = r >> 8, q = r & 255, kt = q >> 4, nt = q & 15;
            conv_tile(a.in[I_WDN] + (size_t)m * 1024 * 1024, 1024, 1024, kt * 64, nt * 64, 64, (bf16*)(ws + WS_WDN_T) + (size_t)m * 1024 * 1024, 0, scr, lane); continue; } r -= N_DN;
        if (r < N_GIN) { const int m = r / 768, q = r % 768, kt = q / 48, nt = q % 48;
            conv_tile(a.in[I_GWIN] + (size_t)m * 1024 * GLA_IN, 1024, GLA_IN, kt * 64, nt * 64, 64, (bf16*)(ws + WS_GLAIN_T) + (size_t)m * GLA_MAIN * 1024, 0, scr, lane); continue; } r -= N_GIN;
        if (r < N_GLR) { const int m = r >> 4, kt = r & 15;
            conv_tile(a.in[I_GWIN] + (size_t)m * 1024 * GLA_IN, 1024, GLA_IN, kt * 64, GLA_MAIN, 32, (bf16*)(ws + WS_GLALR_T) + (size_t)m * 64 * 1024, 2, scr, lane); continue; } r -= N_GLR;
        if (r < N_GOUT) { const int m = r >> 8, q = r & 255, kt = q >> 4, nt = q & 15;
            conv_tile(a.in[I_GWOUT] + (size_t)m * 1024 * 1024, 1024, 1024, kt * 64, nt * 64, 64, (bf16*)(ws + WS_GLAOUT_T) + (size_t)m * 1024 * 1024, 0, scr, lane); continue; } r -= N_GOUT;
        if (r < N_SIN) { const int m = r >> 9, q = r & 511, kt = q >> 5, nt = q & 31;
            conv_tile(a.in[I_SWIN] + (size_t)m * 1024 * 2048, 1024, 2048, kt * 64, nt * 64, 64, (bf16*)(ws + WS_SGUIN_T) + (size_t)m * 2048 * 1024, 0, scr, lane); continue; } r -= N_SIN;
        if (r < N_SOUT) { const int m = r >> 8, q = r & 255, kt = q >> 4, nt = q & 15;
            conv_tile(a.in[I_SWOUT] + (size_t)m * 1024 * 1024, 1024, 1024, kt * 64, nt * 64, 64, (bf16*)(ws + WS_SGUOUT_T) + (size_t)m * 1024 * 1024, 0, scr, lane); continue; } r -= N_SOUT;
        { const int m = r >> 4, kt = r & 15;
            conv_tile(a.in[I_RW] + (size_t)m * 1024 * 32, 1024, 32, kt * 64, 0, 32, (bf16*)(ws + WS_ROUTER_T) + (size_t)m * 64 * 1024, 2, scr, lane); }
    }
    { bf16* d = (bf16*)(ws + WS_SGUWS); const float* s = a.in[I_SWS];
      for (int i = (bx * NTHREADS + tid) * 4; i < 2 * 8 * 128 * 128; i += G * NTHREADS * 4) { const f32x4 v = *(const f32x4*)(s + i); u32x2 o; o.x = cvt_pk_bf16(v[0], v[1]); o.y = cvt_pk_bf16(v[2], v[3]); *(u32x2*)(d + i) = o; } }
}

struct RowPass {
    const float* xin; const float* y; float* xout; bf16* hout;
    const float* gate; const float* lng; const float* lnb; const float* sc; const float* sh;
    const bf16* wside;
    float* lr_out;
    const float* rbias;
    int* topi; float* topw; int* hist;
    const bf16* ys; const int* dest; const float* tw;
    int has_h, has_side;
};
template <int MODE>
__device__ __forceinline__ void row_pass(const RowPass& p, LAS unsigned char* lds, int tid, int bx, int G) {
    const int lane = tid & 63, wave = __builtin_amdgcn_readfirstlane(tid >> 6);
    constexpr int HS = 1032;
    LAS bf16* Hhi = (LAS bf16*)lds;
    LAS bf16* Hlo = (LAS bf16*)(lds + 16 * HS * 2);
    LAS float* part = (LAS float*)(lds + 2 * 16 * HS * 2);
    LAS float* logit = part + 8 * 32 * 16;
    LAS int* lhist = (LAS int*)(logit + 16 * 32);
    if (MODE == 1) { if (tid < 32) lhist[tid] = 0; }
    const bool side = (p.has_side != 0) && (p.wside != nullptr);
    bf16x8 whi[2][4], wlo[2][4];
    if (side) {
#pragma unroll
        for (int hf = 0; hf < 2; ++hf)
#pragma unroll
            for (int s = 0; s < 4; ++s) { const size_t off = (size_t)(hf * 16 + (lane & 15)) * 1024 + 128 * wave + 32 * s + 8 * (lane >> 4);
                whi[hf][s] = *(const bf16x8*)(p.wside + off); wlo[hf][s] = *(const bf16x8*)(p.wside + 32 * 1024 + off); }
    }
    for (int tile = bx; tile < T / 16; tile += G) {
        const int b = (tile * 16) / SEQ;
#pragma unroll 1
        for (int tt = 0; tt < 2; ++tt) {
            const int tl = 2 * wave + tt, token = tile * 16 + tl;
            f32x4 v[4];
            const float* xr = p.xin + (size_t)token * D + 4 * lane;
#pragma unroll
            for (int j = 0; j < 4; ++j) v[j] = *(const f32x4*)(xr + 256 * j);
            if (MODE == 1) {
                const float* yr = p.y + (size_t)token * D + 4 * lane; const float* gp = p.gate + (size_t)b * 6144 + 4 * lane;
#pragma unroll
                for (int j = 0; j < 4; ++j) { const f32x4 yy = *(const f32x4*)(yr + 256 * j); const f32x4 g = *(const f32x4*)(gp + 256 * j); v[j] = v[j] * ALPHA + (g + 1.0f) * yy; }
            }
            if (MODE == 2) {
                f32x4 ya[4];
#pragma unroll
                for (int j = 0; j < 4; ++j) ya[j] = (f32x4){0.f, 0.f, 0.f, 0.f};
#pragma unroll
                for (int k = 0; k < 4; ++k) { const int ds = p.dest[token * 4 + k]; const float w = p.tw[token * 4 + k]; const bf16* yr = p.ys + (size_t)ds * D + 4 * lane;
#pragma unroll
                    for (int j = 0; j < 4; ++j) { const u32x2 q = *(const u32x2*)(yr + 256 * j); ya[j] += (f32x4){bf_lo(q.x), bf_hi(q.x), bf_lo(q.y), bf_hi(q.y)} * w; } }
                const float* gp = p.gate + (size_t)b * 6144 + 4 * lane;
#pragma unroll
                for (int j = 0; j < 4; ++j) { const f32x4 g = *(const f32x4*)(gp + 256 * j); v[j] = v[j] * ALPHA + (g + 1.0f) * ya[j]; }
            }
            if (MODE != 0) {
                float s = 0.f;
#pragma unroll
                for (int j = 0; j < 4; ++j) s += (v[j][0] + v[j][1]) + (v[j][2] + v[j][3]);
                const float mean = wave_sum(s) * (1.0f / D); float s2 = 0.f;
#pragma unroll
                for (int j = 0; j < 4; ++j) { v[j] = v[j] - mean; s2 += (v[j][0] * v[j][0] + v[j][1] * v[j][1]) + (v[j][2] * v[j][2] + v[j][3] * v[j][3]); }
                const float rstd = 1.0f / sqrtf(wave_sum(s2) * (1.0f / D) + LN_EPS);
                float* xo = p.xout + (size_t)token * D + 4 * lane;
#pragma unroll
                for (int j = 0; j < 4; ++j) { const f32x4 g = *(const f32x4*)(p.lng + 4 * lane + 256 * j), bb = *(const f32x4*)(p.lnb + 4 * lane + 256 * j); v[j] = v[j] * rstd * g + bb; *(f32x4*)(xo + 256 * j) = v[j]; }
            }
            if (p.has_h) {
                const float* scp = p.sc + (size_t)b * 6144 + 4 * lane; const float* shp = p.sh + (size_t)b * 6144 + 4 * lane;
                bf16* ho = p.hout + (size_t)token * D + 4 * lane;
#pragma unroll
                for (int j = 0; j < 4; ++j) { const f32x4 s1 = *(const f32x4*)(scp + 256 * j), s0 = *(const f32x4*)(shp + 256 * j); const f32x4 h = v[j] * (s1 + 1.0f) + s0;
                    u32x2 o; o.x = cvt_pk_bf16(h[0], h[1]); o.y = cvt_pk_bf16(h[2], h[3]); *(u32x2*)(ho + 256 * j) = o;
                    if (side) { u32x2 l; l.x = cvt_pk_bf16(h[0] - bf_lo(o.x), h[1] - bf_hi(o.x)); l.y = cvt_pk_bf16(h[2] - bf_lo(o.y), h[3] - bf_hi(o.y));
                        *(LAS u32x2*)(Hhi + tl * HS + 4 * lane + 256 * j) = o; *(LAS u32x2*)(Hlo + tl * HS + 4 * lane + 256 * j) = l; } }
            }
        }
        if (side) {
            __syncthreads();
            f32x4 acc[2]; acc[0] = (f32x4){0.f, 0.f, 0.f, 0.f}; acc[1] = acc[0];
#pragma unroll
            for (int s = 0; s < 4; ++s) { const int ko = (lane & 15) * HS + 128 * wave + 32 * s + 8 * (lane >> 4);
                const bf16x8 bh = *(const LAS bf16x8*)(Hhi + ko), bl = *(const LAS bf16x8*)(Hlo + ko);
#pragma unroll
                for (int hf = 0; hf < 2; ++hf) { acc[hf] = __builtin_amdgcn_mfma_f32_16x16x32_bf16(whi[hf][s], bh, acc[hf], 0, 0, 0);
                    acc[hf] = __builtin_amdgcn_mfma_f32_16x16x32_bf16(wlo[hf][s], bh, acc[hf], 0, 0, 0); acc[hf] = __builtin_amdgcn_mfma_f32_16x16x32_bf16(whi[hf][s], bl, acc[hf], 0, 0, 0); } }
#pragma unroll
            for (int hf = 0; hf < 2; ++hf)
#pragma unroll
                for (int j = 0; j < 4; ++j) part[(wave * 32 + hf * 16 + 4 * (lane >> 4) + j) * 16 + (lane & 15)] = acc[hf][j];
            __syncthreads();
            { const int e = tid >> 4, tk = tid & 15; float s = 0.f;
#pragma unroll
              for (int w = 0; w < 8; ++w) s += part[(w * 32 + e) * 16 + tk];
              if (MODE == 1) logit[tk * 32 + e] = s + p.rbias[e];
              else p.lr_out[(size_t)(tile * 16 + tk) * 32 + e] = s; }
            if (MODE == 1) {
                __syncthreads();
                if (tid < 16) {
                    const int token = tile * 16 + tid; float lv[32];
#pragma unroll
                    for (int e = 0; e < 32; ++e) lv[e] = logit[tid * 32 + e];
                    int bi[4]; float bv[4];
#pragma unroll
                    for (int k = 0; k < 4; ++k) { float m = -3.0e38f; int mi = 0;
#pragma unroll
                        for (int e = 0; e < 32; ++e) { const bool take = lv[e] > m; m = take ? lv[e] : m; mi = take ? e : mi; }
                        bi[k] = mi; bv[k] = m;
#pragma unroll
                        for (int e = 0; e < 32; ++e) lv[e] = (e == mi) ? -3.0e38f : lv[e]; }
                    const float e1 = __expf(bv[1] - bv[0]), e2 = __expf(bv[2] - bv[0]), e3 = __expf(bv[3] - bv[0]); const float inv = 1.0f / (1.0f + e1 + e2 + e3);
                    *(int4*)(p.topi + token * 4) = make_int4(bi[0], bi[1], bi[2], bi[3]);
                    *(f32x4*)(p.topw + token * 4) = (f32x4){inv, e1 * inv, e2 * inv, e3 * inv};
#pragma unroll
                    for (int k = 0; k < 4; ++k) atomicAdd((int*)&lhist[bi[k]], 1);
                }
            }
            __syncthreads();
        }
    }
    if (MODE == 1) { __syncthreads(); if (tid < 32) p.hist[tid] = lhist[tid]; }
}

__device__ __forceinline__ void phase_place(int* route, LAS unsigned char* lds, int tid, int bx, int G) {
    const int lane = tid & 63, wave = tid >> 6;
    LAS int* ptot = (LAS int*)lds;
    LAS int* ppre = ptot + 512;
    LAS int* tot = ppre + 512;
    LAS int* pre = tot + 32;
    LAS int* pstart = pre + 32;
    const int* hist = route + R_HIST;
    { const int e = tid & 31, part = tid >> 5; int st = 0, sp = 0;
      for (int bb = part; bb < G; bb += 16) { const int h = hist[bb * 32 + e]; st += h; if (bb < bx) sp += h; }
      ptot[part * 32 + e] = st; ppre[part * 32 + e] = sp; }
    __syncthreads();
    if (tid < 32) { int st = 0, sp = 0;
#pragma unroll
        for (int q = 0; q < 16; ++q) { st += ptot[q * 32 + tid]; sp += ppre[q * 32 + tid]; }
        tot[tid] = st; pre[tid] = sp; }
    __syncthreads();
    if (tid == 0) { int acc = 0; for (int e = 0; e < 32; ++e) { pstart[e] = acc; acc += (tot[e] + 255) / 256 * 256; } pstart[32] = acc; }
    __syncthreads();
    if (bx == 0) {
        const int ntiles = pstart[32] / 256;
        if (tid == 0) route[R_NTILES] = ntiles;
        for (int t = tid; t < ntiles; t += NTHREADS) { int e = 0; for (int q = 1; q < 32; ++q) if (pstart[q] <= t * 256) e = q; route[R_TILEE + t] = e; }
    }
    for (int e = bx; e < 32; e += G) { const int s0 = pstart[e] + tot[e], s1 = pstart[e + 1]; for (int s = s0 + tid; s < s1; s += NTHREADS) route[R_BUFTOK + s] = 0; }
    if (wave == 0) {
        int run = 0;
        for (int tile = bx; tile < T / 16; tile += G) {
            const int token = tile * 16 + (lane >> 2);
            const int e = route[R_TOPI + tile * 64 + lane];
            const int base = __shfl(run, e);
            int rank = 0, add = 0;
#pragma unroll 1
            for (int x = 0; x < 32; ++x) { const unsigned long long m = __ballot(e == x); if (e == x) rank = __popcll(m & ((1ull << lane) - 1ull)); if (lane == x) add = __popcll(m); }
            run += add;
            const int ds = pstart[e] + pre[e] + base + rank;
            route[R_DEST + tile * 64 + lane] = ds;
            route[R_BUFTOK + ds] = token;
        }
    }
}

struct Unit { int pm, pn, e; const bf16* bt; };
constexpr int NXCD = 8, WGM = 8;
struct Sched {
    int nM, nN, nwg, G, c; const bf16* Bt; size_t estride; const int* tile_e; int K;
    __device__ __forceinline__ void init(int nM_, int nN_, int G_, int c_, const bf16* Bt_, size_t es, const int* te, int K_) { nM = nM_; nN = nN_; nwg = nM * nN; G = G_; c = c_; Bt = Bt_; estride = es; tile_e = te; K = K_; }
    __device__ __forceinline__ bool next(int i, Unit& u) const {
        const long L = (long)i * G + c; if (L >= nwg) return false;
        int wgid = (int)L; { const int q = nwg / NXCD, r = nwg % NXCD, xcd = wgid % NXCD, off = wgid / NXCD; wgid = (xcd < r ? xcd * (q + 1) : r * (q + 1) + (xcd - r) * q) + off; }
        const int nig = WGM * nN, gid = wgid / nig, fm = gid * WGM, gsz = (nM - fm) < WGM ? (nM - fm) : WGM;
        u.pm = fm + ((wgid % nig) % gsz); u.pn = (wgid % nig) / gsz;
        u.e = tile_e ? tile_e[u.pm] : 0;
        u.bt = Bt + (size_t)u.e * estride + (size_t)u.pn * 256 * K;
        return true;
    }
};
struct EpiGlaIn { bf16* O;
    __device__ __forceinline__ void operator()(const f32x4 (&acc)[2][2][4][2], const Unit& u, int wr, int wc, int fr, int fq) const {
        const int row0 = u.pm * 256 + wr * 64 + fr, col0 = u.pn * 256 + wc * 32 + 4 * fq; const float sc = (u.pn < 2) ? 0.08838834764831845f : 1.0f;
#pragma unroll
        for (int ai = 0; ai < 2; ++ai)
#pragma unroll
            for (int m = 0; m < 4; ++m) { bf16* rp = O + (size_t)(row0 + ai * 128 + m * 16) * GLA_MAIN + col0;
#pragma unroll
                for (int bj = 0; bj < 2; ++bj)
#pragma unroll
                    for (int n = 0; n < 2; ++n) { const f32x4 v = acc[ai][bj][m][n] * sc; u32x2 o; o.x = cvt_pk_bf16(v[0], v[1]); o.y = cvt_pk_bf16(v[2], v[3]); *(u32x2*)(rp + bj * 128 + n * 16) = o; } }
    }
};
struct EpiSguIn { bf16* O; const float* bias;
    __device__ __forceinline__ void operator()(const f32x4 (&acc)[2][2][4][2], const Unit& u, int wr, int wc, int fr, int fq) const {
        const int row0 = u.pm * 256 + wr * 64 + fr, col0 = u.pn * 256 + wc * 32 + 4 * fq;
        f32x4 bv[2][2];
#pragma unroll
        for (int bj = 0; bj < 2; ++bj)
#pragma unroll
            for (int n = 0; n < 2; ++n) bv[bj][n] = *(const f32x4*)(bias + col0 + bj * 128 + n * 16);
#pragma unroll
        for (int ai = 0; ai < 2; ++ai)
#pragma unroll
            for (int m = 0; m < 4; ++m) { bf16* rp = O + (size_t)(row0 + ai * 128 + m * 16) * 2048 + col0;
#pragma unroll
                for (int bj = 0; bj < 2; ++bj)
#pragma unroll
                    for (int n = 0; n < 2; ++n) { const f32x4 v = acc[ai][bj][m][n] + bv[bj][n]; u32x2 o; o.x = cvt_pk_bf16(gelu_f(v[0]), gelu_f(v[1])); o.y = cvt_pk_bf16(gelu_f(v[2]), gelu_f(v[3])); *(u32x2*)(rp + bj * 128 + n * 16) = o; } }
    }
};
struct EpiOut { float* O; const float* bias;
    __device__ __forceinline__ void operator()(const f32x4 (&acc)[2][2][4][2], const Unit& u, int wr, int wc, int fr, int fq) const {
        const int row0 = u.pm * 256 + wr * 64 + fr, col0 = u.pn * 256 + wc * 32 + 4 * fq;
        f32x4 bv[2][2];
#pragma unroll
        for (int bj = 0; bj < 2; ++bj)
#pragma unroll
            for (int n = 0; n < 2; ++n) bv[bj][n] = bias ? *(const f32x4*)(bias + col0 + bj * 128 + n * 16) : (f32x4){0.f, 0.f, 0.f, 0.f};
#pragma unroll
        for (int ai = 0; ai < 2; ++ai)
#pragma unroll
            for (int m = 0; m < 4; ++m) { float* rp = O + (size_t)(row0 + ai * 128 + m * 16) * D + col0;
#pragma unroll
                for (int bj = 0; bj < 2; ++bj)
#pragma unroll
                    for (int n = 0; n < 2; ++n) *(f32x4*)(rp + bj * 128 + n * 16) = acc[ai][bj][m][n] + bv[bj][n]; }
    }
};
struct EpiUp { bf16* O; const float* bias;
    __device__ __forceinline__ void operator()(const f32x4 (&acc)[2][2][4][2], const Unit& u, int wr, int wc, int fr, int fq) const {
        const int row0 = u.pm * 256 + wr * 64 + fr, a0 = u.pn * 128 + wc * 16 + 4 * fq;
        f32x4 bg[2], bl[2];
#pragma unroll
        for (int bj = 0; bj < 2; ++bj) { const float* bp = bias + (size_t)u.e * 2048 + 2 * (a0 + 64 * bj); const f32x4 p0 = *(const f32x4*)bp, p1 = *(const f32x4*)(bp + 4);
            bg[bj] = (f32x4){p0[0], p0[2], p1[0], p1[2]}; bl[bj] = (f32x4){p0[1], p0[3], p1[1], p1[3]}; }
#pragma unroll
        for (int ai = 0; ai < 2; ++ai)
#pragma unroll
            for (int m = 0; m < 4; ++m) { bf16* rp = O + (size_t)(row0 + ai * 128 + m * 16) * D + a0;
#pragma unroll
                for (int bj = 0; bj < 2; ++bj) { const f32x4 g = acc[ai][bj][m][0] + bg[bj], l = acc[ai][bj][m][1] + bl[bj]; float r[4];
#pragma unroll
                    for (int j = 0; j < 4; ++j) { const float gg = fminf(g[j], 7.0f), ll = fminf(fmaxf(l[j], -7.0f), 7.0f); r[j] = gg * sigmoid_f(1.702f * gg) * (ll + 1.0f); }
                    u32x2 o; o.x = cvt_pk_bf16(r[0], r[1]); o.y = cvt_pk_bf16(r[2], r[3]); *(u32x2*)(rp + bj * 64) = o; } }
    }
};
struct EpiDown { bf16* O; const float* bias;
    __device__ __forceinline__ void operator()(const f32x4 (&acc)[2][2][4][2], const Unit& u, int wr, int wc, int fr, int fq) const {
        const int row0 = u.pm * 256 + wr * 64 + fr, col0 = u.pn * 256 + wc * 32 + 4 * fq;
        f32x4 bv[2][2];
#pragma unroll
        for (int bj = 0; bj < 2; ++bj)
#pragma unroll
            for (int n = 0; n < 2; ++n) bv[bj][n] = *(const f32x4*)(bias + (size_t)u.e * 1024 + col0 + bj * 128 + n * 16);
#pragma unroll
        for (int ai = 0; ai < 2; ++ai)
#pragma unroll
            for (int m = 0; m < 4; ++m) { bf16* rp = O + (size_t)(row0 + ai * 128 + m * 16) * D + col0;
#pragma unroll
                for (int bj = 0; bj < 2; ++bj)
#pragma unroll
                    for (int n = 0; n < 2; ++n) { const f32x4 v = acc[ai][bj][m][n] + bv[bj][n]; u32x2 o; o.x = cvt_pk_bf16(v[0], v[1]); o.y = cvt_pk_bf16(v[2], v[3]); *(u32x2*)(rp + bj * 128 + n * 16) = o; } }
    }
};

template <class Epi>
__device__ __forceinline__ void gemm_naive(const bf16* A, const int* gather, int K, const Sched& S, const Epi& E, int tid) {
    const int wid = __builtin_amdgcn_readfirstlane(tid >> 6), lane = tid & 63, wr = wid >> 2, wc = wid & 3, fr = lane & 15, fq = lane >> 4;
    Unit u;
    for (int ui = 0; S.next(ui, u); ++ui) {
        f32x4 acc[2][2][4][2];
#pragma unroll
        for (int a = 0; a < 2; ++a)
#pragma unroll
            for (int b = 0; b < 2; ++b)
#pragma unroll
                for (int m = 0; m < 4; ++m)
#pragma unroll
                    for (int n = 0; n < 2; ++n) acc[a][b][m][n] = (f32x4){0.f, 0.f, 0.f, 0.f};
        unsigned ap[2][4], bp[2][2];
#pragma unroll
        for (int ai = 0; ai < 2; ++ai)
#pragma unroll
            for (int m = 0; m < 4; ++m) { const int r = u.pm * 256 + ai * 128 + wr * 64 + m * 16 + fr; const int ar = gather ? gather[r] : r; ap[ai][m] = (unsigned)ar * (unsigned)K + 8u * fq; }
#pragma unroll
        for (int bj = 0; bj < 2; ++bj)
#pragma unroll
            for (int n = 0; n < 2; ++n) bp[bj][n] = (unsigned)(bj * 128 + wc * 32 + n * 16 + fr) * (unsigned)K + 8u * fq;
#pragma unroll 1
        for (int k0 = 0; k0 < K; k0 += 32) {
            bf16x8 af[2][4], bfr[2][2];
#pragma unroll
            for (int ai = 0; ai < 2; ++ai)
#pragma unroll
                for (int m = 0; m < 4; ++m) af[ai][m] = *(const bf16x8*)(A + ap[ai][m] + k0);
#pragma unroll
            for (int bj = 0; bj < 2; ++bj)
#pragma unroll
                for (int n = 0; n < 2; ++n) bfr[bj][n] = *(const bf16x8*)(u.bt + bp[bj][n] + k0);
#pragma unroll
            for (int ai = 0; ai < 2; ++ai)
#pragma unroll
                for (int bj = 0; bj < 2; ++bj)
#pragma unroll
                    for (int m = 0; m < 4; ++m)
#pragma unroll
                        for (int n = 0; n < 2; ++n) acc[ai][bj][m][n] = __builtin_amdgcn_mfma_f32_16x16x32_bf16(bfr[bj][n], af[ai][m], acc[ai][bj][m][n], 0, 0, 0);
        }
        E(acc, u, wr, wc, fr, fq);
    }
}

__device__ __forceinline__ float logsigmoid_f(float x) { return fminf(x, 0.f) - log1pf(__expf(-fabsf(x))); }
__device__ __forceinline__ void phase_gla_scan_naive(const Args& a, int li, LAS unsigned char* lds, int tid, int bx, int G) {
    const bf16* qkvr = (const bf16*)(a.ws + WS_BIG); const float* lr = (const float*)(a.ws + WS_LR);
    LAS float* qs = (LAS float*)lds;
    LAS float* ks = qs + 2048;
    LAS float* as = ks + 2048;
    LAS float* vs = as + 2048;
    LAS float* lrs = vs + 1024;
    LAS float* part = lrs + 256;
    for (int it = bx; it < 256; it += G) {
        const int b = it >> 5, h = (it >> 3) & 3, dir = (it >> 2) & 1, es = it & 3;
        const float* wg2 = a.in[dir ? I_GWG2B : I_GWG2F] + (size_t)li * 16 * 512; const float* bg = a.in[dir ? I_GBGB : I_GBGF] + (size_t)li * 512;
        bf16* oo = (bf16*)(a.ws + (dir ? WS_OB : WS_OF));
        const int dd = tid & 127;
        float wcol[16];
#pragma unroll
        for (int r = 0; r < 16; ++r) wcol[r] = wg2[r * 512 + h * 128 + dd];
        const float bgd = bg[h * 128 + dd];
        const int e = tid & 63, dp = tid >> 6;
        float S[16];
#pragma unroll
        for (int i = 0; i < 16; ++i) S[i] = 0.f;
        for (int t0 = 0; t0 < SEQ; t0 += 16) {
            __syncthreads();
            if (tid < 256) { const int st = tid >> 4, r = tid & 15; const int s = dir ? (SEQ - 1 - (t0 + st)) : (t0 + st); lrs[tid] = lr[(size_t)(b * SEQ + s) * 32 + dir * 16 + r]; }
            __syncthreads();
#pragma unroll
            for (int i = 0; i < 4; ++i) { const int st = (tid >> 7) + 4 * i; const int s = dir ? (SEQ - 1 - (t0 + st)) : (t0 + st); const size_t row = (size_t)(b * SEQ + s) * GLA_MAIN;
                qs[st * 128 + dd] = bf2f(qkvr[row + h * 128 + dd]); ks[st * 128 + dd] = bf2f(qkvr[row + 512 + h * 128 + dd]);
                float x = bgd;
#pragma unroll
                for (int r = 0; r < 16; ++r) x += lrs[st * 16 + r] * wcol[r];
                as[st * 128 + dd] = __expf(logsigmoid_f(x) * (1.0f / 16.0f)); }
#pragma unroll
            for (int i = 0; i < 2; ++i) { const int idx = tid + 512 * i, st = idx >> 6, ee = idx & 63; const int s = dir ? (SEQ - 1 - (t0 + st)) : (t0 + st);
                vs[idx] = bf2f(qkvr[(size_t)(b * SEQ + s) * GLA_MAIN + 1024 + h * 256 + es * 64 + ee]); }
            __syncthreads();
            for (int st = 0; st < 16; ++st) {
                const float vv = vs[st * 64 + e]; float po = 0.f;
#pragma unroll
                for (int i4 = 0; i4 < 4; ++i4) { const f32x4 q4 = *(const LAS f32x4*)(qs + st * 128 + dp * 16 + 4 * i4), k4 = *(const LAS f32x4*)(ks + st * 128 + dp * 16 + 4 * i4), a4 = *(const LAS f32x4*)(as + st * 128 + dp * 16 + 4 * i4);
#pragma unroll
                    for (int j = 0; j < 4; ++j) { S[4 * i4 + j] = a4[j] * S[4 * i4 + j] + k4[j] * vv; po += q4[j] * S[4 * i4 + j]; } }
                part[(dp * 16 + st) * 64 + e] = po;
            }
            __syncthreads();
#pragma unroll
            for (int i = 0; i < 2; ++i) { const int idx = tid + 512 * i, st = idx >> 6, ee = idx & 63; float s = 0.f;
#pragma unroll
                for (int w = 0; w < 8; ++w) s += part[(w * 16 + st) * 64 + ee];
                const int sq = dir ? (SEQ - 1 - (t0 + st)) : (t0 + st);
                oo[(size_t)(b * SEQ + sq) * D + h * 256 + es * 64 + ee] = (bf16)(cvt_pk_bf16(s, 0.f) & 0xffffu); }
        }
        __syncthreads();
    }
}
__device__ __forceinline__ void phase_gla_post(const Args& a, int li, int tid, int bx, int G) {
    const int lane = tid & 63, wave = tid >> 6;
    const bf16* of = (const bf16*)(a.ws + WS_OF); const bf16* ob = (const bf16*)(a.ws + WS_OB); const bf16* qkvr = (const bf16*)(a.ws + WS_BIG); bf16* A2 = (bf16*)(a.ws + WS_A2);
    const float* ng = a.in[I_GNORM] + (size_t)li * 256 + (lane & 15) * 16;
    float g[16];
#pragma unroll
    for (int j = 0; j < 16; ++j) g[j] = ng[j];
    for (int token = bx * NWAVES + wave; token < T; token += G * NWAVES) {
        const u32x4 f0 = *(const u32x4*)(of + (size_t)token * D + 16 * lane), f1 = *(const u32x4*)(of + (size_t)token * D + 16 * lane + 8);
        const u32x4 b0 = *(const u32x4*)(ob + (size_t)token * D + 16 * lane), b1 = *(const u32x4*)(ob + (size_t)token * D + 16 * lane + 8);
        const u32x4 r0 = *(const u32x4*)(qkvr + (size_t)token * GLA_MAIN + 2048 + 16 * lane), r1 = *(const u32x4*)(qkvr + (size_t)token * GLA_MAIN + 2048 + 16 * lane + 8);
        float o[16], r[16];
#pragma unroll
        for (int q = 0; q < 4; ++q) { o[2 * q] = bf_lo(f0[q]) + bf_lo(b0[q]); o[2 * q + 1] = bf_hi(f0[q]) + bf_hi(b0[q]); o[8 + 2 * q] = bf_lo(f1[q]) + bf_lo(b1[q]); o[8 + 2 * q + 1] = bf_hi(f1[q]) + bf_hi(b1[q]);
            r[2 * q] = bf_lo(r0[q]); r[2 * q + 1] = bf_hi(r0[q]); r[8 + 2 * q] = bf_lo(r1[q]); r[8 + 2 * q + 1] = bf_hi(r1[q]); }
        float ss = 0.f;
#pragma unroll
        for (int j = 0; j < 16; ++j) ss += o[j] * o[j];
        ss += __shfl_xor(ss, 1); ss += __shfl_xor(ss, 2); ss += __shfl_xor(ss, 4); ss += __shfl_xor(ss, 8);
        const float rstd = 1.0f / sqrtf(ss * (1.0f / 256.0f) + LN_EPS);
        unsigned w[8];
#pragma unroll
        for (int q = 0; q < 8; ++q) w[q] = cvt_pk_bf16(o[2 * q] * rstd * g[2 * q] * silu_f(r[2 * q]), o[2 * q + 1] * rstd * g[2 * q + 1] * silu_f(r[2 * q + 1]));
        *(u32x4*)(A2 + (size_t)token * D + 16 * lane) = (u32x4){w[0], w[1], w[2], w[3]}; *(u32x4*)(A2 + (size_t)token * D + 16 * lane + 8) = (u32x4){w[4], w[5], w[6], w[7]};
    }
}

__device__ __forceinline__ void phase_sgu_naive(const Args& a, int li, LAS unsigned char* lds, int tid, int bx, int G) {
    const int lane = tid & 63, wave = tid >> 6, fr = lane & 15, fq = lane >> 4;
    const bf16* z = (const bf16*)(a.ws + WS_BIG); bf16* A2 = (bf16*)(a.ws + WS_A2);
    const float* lng = a.in[I_SLNG] + (size_t)li * 1024; const float* lnb = a.in[I_SLNB] + (size_t)li * 1024;
    const float* wsp = a.in[I_SWS] + (size_t)li * 8 * 128 * 128; const float* bs = a.in[I_SBS] + (size_t)li * 8 * 128;
    LAS float* st_mean = (LAS float*)lds; LAS float* st_rstd = st_mean + 128;
    for (int it = bx; it < T / 128; it += G) {
        const int row0 = it * 128;
        __syncthreads();
#pragma unroll 1
        for (int rr = 0; rr < 16; ++rr) { const int q = wave * 16 + rr; const bf16* vp = z + (size_t)(row0 + q) * 2048 + 1024 + 16 * lane;
            const u32x4 v0 = *(const u32x4*)vp, v1 = *(const u32x4*)(vp + 8); float x[16];
#pragma unroll
            for (int k = 0; k < 4; ++k) { x[2 * k] = bf_lo(v0[k]); x[2 * k + 1] = bf_hi(v0[k]); x[8 + 2 * k] = bf_lo(v1[k]); x[8 + 2 * k + 1] = bf_hi(v1[k]); }
            float s = 0.f;
#pragma unroll
            for (int k = 0; k < 16; ++k) s += x[k];
            const float mean = wave_sum(s) * (1.0f / 1024.0f); float s2 = 0.f;
#pragma unroll
            for (int k = 0; k < 16; ++k) { const float d = x[k] - mean; s2 += d * d; }
            const float rstd = 1.0f / sqrtf(wave_sum(s2) * (1.0f / 1024.0f) + LN_EPS);
            if (lane == 0) { st_mean[q] = mean; st_rstd[q] = rstd; } }
        __syncthreads();
        const int p = wave * 16 + fr;
#pragma unroll 1
        for (int g = 0; g < 8; ++g) {
#pragma unroll 1
            for (int ct = 0; ct < 8; ++ct) {
                const int ch = g * 128 + ct * 16 + fr;
                const float lg = lng[ch], lb = lnb[ch];
                f32x4 acc = (f32x4){0.f, 0.f, 0.f, 0.f};
#pragma unroll
                for (int ks = 0; ks < 4; ++ks) {
                    const int q0 = ks * 32 + 8 * fq;
                    const float* wp = wsp + ((size_t)g * 128 + p) * 128 + q0; const f32x4 w0 = *(const f32x4*)wp, w1 = *(const f32x4*)(wp + 4);
                    bf16x8 wf; { u32x4 t; t.x = cvt_pk_bf16(w0[0], w0[1]); t.y = cvt_pk_bf16(w0[2], w0[3]); t.z = cvt_pk_bf16(w1[0], w1[1]); t.w = cvt_pk_bf16(w1[2], w1[3]); wf = __builtin_bit_cast(bf16x8, t); }
                    float vn[8];
#pragma unroll
                    for (int j = 0; j < 8; ++j) { const int q = q0 + j; const float vv = bf2f(z[(size_t)(row0 + q) * 2048 + 1024 + ch]); vn[j] = (vv - st_mean[q]) * st_rstd[q] * lg + lb; }
                    bf16x8 vf; { u32x4 t; t.x = cvt_pk_bf16(vn[0], vn[1]); t.y = cvt_pk_bf16(vn[2], vn[3]); t.z = cvt_pk_bf16(vn[4], vn[5]); t.w = cvt_pk_bf16(vn[6], vn[7]); vf = __builtin_bit_cast(bf16x8, t); }
                    acc = __builtin_amdgcn_mfma_f32_16x16x32_bf16(vf, wf, acc, 0, 0, 0);
                }
                const float bias = bs[g * 128 + p]; const int c0 = g * 128 + ct * 16 + 4 * fq;
                const u32x2 uu = *(const u32x2*)(z + (size_t)(row0 + p) * 2048 + c0);
                u32x2 o; o.x = cvt_pk_bf16(bf_lo(uu.x) * (acc[0] + bias), bf_hi(uu.x) * (acc[1] + bias)); o.y = cvt_pk_bf16(bf_lo(uu.y) * (acc[2] + bias), bf_hi(uu.y) * (acc[3] + bias));
                *(u32x2*)(A2 + (size_t)(row0 + p) * D + c0) = o;
            }
        }
    }
}

constexpr int NPHASES = 2 + 9 * DEPTH;
__device__ __forceinline__ void ph_prologue() { PHASE_ENTER(); phase_prologue(a, lds, tid, bx, G); }
__device__ __forceinline__ void ph_rp_init() { PHASE_ENTER(); float* mod = (float*)(ws + WS_MOD);
    RowPass p{}; p.xin = a.in[I_X]; p.hout = (bf16*)(ws + WS_H); p.sc = mod + 1 * 1024; p.sh = mod + 0 * 1024; p.wside = (const bf16*)(ws + WS_GLALR_T); p.lr_out = (float*)(ws + WS_LR); p.has_h = 1; p.has_side = 1;
    row_pass<0>(p, lds, tid, bx, G); }
__device__ __forceinline__ void ph_gla_in(int li) { PHASE_ENTER(); Sched S; S.init(T / 256, GLA_MAIN / 256, G, bx, (const bf16*)(ws + WS_GLAIN_T) + (size_t)li * GLA_MAIN * 1024, 0, nullptr, 1024); EpiGlaIn E{(bf16*)(ws + WS_BIG)}; gemm_naive((const bf16*)(ws + WS_H), nullptr, 1024, S, E, tid); }
__device__ __forceinline__ void ph_sgu_in(int li) { PHASE_ENTER(); Sched S; S.init(T / 256, 2048 / 256, G, bx, (const bf16*)(ws + WS_SGUIN_T) + (size_t)li * 2048 * 1024, 0, nullptr, 1024); EpiSguIn E{(bf16*)(ws + WS_BIG), a.in[I_SBIN] + (size_t)li * 2048}; gemm_naive((const bf16*)(ws + WS_H), nullptr, 1024, S, E, tid); }
__device__ __forceinline__ void ph_gla_scan(int li) { PHASE_ENTER(); phase_gla_scan_naive(a, li, lds, tid, bx, G); }
__device__ __forceinline__ void ph_sgu_core(int li) { PHASE_ENTER(); phase_sgu_naive(a, li, lds, tid, bx, G); }
__device__ __forceinline__ void ph_gla_post(int li) { PHASE_ENTER(); phase_gla_post(a, li, tid, bx, G); }
__device__ __forceinline__ void ph_out(int l) { PHASE_ENTER(); const int li = l >> 1; const bool sgu = (l & 1) != 0;
    Sched S; S.init(T / 256, 4, G, bx, (const bf16*)(ws + (sgu ? WS_SGUOUT_T : WS_GLAOUT_T)) + (size_t)li * 1024 * 1024, 0, nullptr, 1024);
    EpiOut E{(float*)(ws + WS_Y), sgu ? a.in[I_SBOUT] + (size_t)li * 1024 : nullptr}; gemm_naive((const bf16*)(ws + WS_A2), nullptr, 1024, S, E, tid); }
__device__ __forceinline__ void ph_rp_mid(int l) { PHASE_ENTER(); float* modl = (float*)(ws + WS_MOD) + (size_t)l * 8 * 6144; int* route = (int*)(ws + WS_ROUTE);
    RowPass p{}; p.xin = (l == 0) ? a.in[I_X] : (const float*)(ws + WS_X2); p.y = (const float*)(ws + WS_Y); p.xout = (float*)(ws + WS_X1); p.hout = (bf16*)(ws + WS_H);
    p.gate = modl + 2 * 1024; p.lng = a.in[I_LNG] + (size_t)(l * 2 + 0) * 1024; p.lnb = a.in[I_LNB] + (size_t)(l * 2 + 0) * 1024; p.sc = modl + 4 * 1024; p.sh = modl + 3 * 1024;
    p.wside = (const bf16*)(ws + WS_ROUTER_T) + (size_t)l * 64 * 1024; p.rbias = a.in[I_RB] + (size_t)l * 32;
    p.topi = route + R_TOPI; p.topw = (float*)(route + R_TOPW); p.hist = route + R_HIST + bx * 32; p.has_h = 1; p.has_side = 1;
    row_pass<1>(p, lds, tid, bx, G); }
__device__ __forceinline__ void ph_place() { PHASE_ENTER(); phase_place((int*)(ws + WS_ROUTE), lds, tid, bx, G); }
__device__ __forceinline__ void ph_moe_up(int l) { PHASE_ENTER(); int* route = (int*)(ws + WS_ROUTE); const int ntiles = route[R_NTILES];
    Sched S; S.init(ntiles, 8, G, bx, (const bf16*)(ws + WS_WUP_T) + (size_t)l * 32 * 2048 * 1024, (size_t)2048 * 1024, route + R_TILEE, 1024);
    EpiUp E{(bf16*)(ws + WS_ACT), a.in[I_BUP] + (size_t)l * 32 * 2048}; gemm_naive((const bf16*)(ws + WS_H), route + R_BUFTOK, 1024, S, E, tid); }
__device__ __forceinline__ void ph_moe_down(int l) { PHASE_ENTER(); int* route = (int*)(ws + WS_ROUTE); const int ntiles = route[R_NTILES];
    Sched S; S.init(ntiles, 4, G, bx, (const bf16*)(ws + WS_WDN_T) + (size_t)l * 32 * 1024 * 1024, (size_t)1024 * 1024, route + R_TILEE, 1024);
    EpiDown E{(bf16*)(ws + WS_YS), a.in[I_BDN] + (size_t)l * 32 * 1024}; gemm_naive((const bf16*)(ws + WS_ACT), nullptr, 1024, S, E, tid); }
__device__ __forceinline__ void ph_rp_end(int l) { PHASE_ENTER(); float* mod = (float*)(ws + WS_MOD); float* modl = mod + (size_t)l * 8 * 6144; int* route = (int*)(ws + WS_ROUTE);
    RowPass p{}; p.xin = (const float*)(ws + WS_X1); p.xout = (l == DEPTH - 1) ? a.out : (float*)(ws + WS_X2); p.hout = (bf16*)(ws + WS_H);
    p.gate = modl + 5 * 1024; p.lng = a.in[I_LNG] + (size_t)(l * 2 + 1) * 1024; p.lnb = a.in[I_LNB] + (size_t)(l * 2 + 1) * 1024;
    p.ys = (const bf16*)(ws + WS_YS); p.dest = route + R_DEST; p.tw = (const float*)(route + R_TOPW);
    if (l < DEPTH - 1) { float* modn = mod + (size_t)(l + 1) * 8 * 6144; p.sc = modn + 1 * 1024; p.sh = modn + 0 * 1024; p.has_h = 1;
        if (((l + 1) & 1) == 0) { p.has_side = 1; p.wside = (const bf16*)(ws + WS_GLALR_T) + (size_t)((l + 1) >> 1) * 64 * 1024; p.lr_out = (float*)(ws + WS_LR); } }
    row_pass<2>(p, lds, tid, bx, G); }

__global__ void __launch_bounds__(NTHREADS, 2) fwd_kernel(Args a) {
    extern __shared__ __attribute__((aligned(16))) unsigned char lds_raw[];
    LAS unsigned char* lds = (LAS unsigned char*)lds_raw;
    volatile LAS unsigned* MISC = (volatile LAS unsigned*)(lds + MISC_OFF);
    const int tid = threadIdx.x;
    if (tid < 32) ((LAS unsigned*)(lds + MISC_OFF))[tid] = 0u;
    __syncthreads();
    unsigned* ctl = (unsigned*)(a.ws + WS_CTL);
    XcdBarrier bar = xcd_barrier_post(ctl + CW_BAR + a.li * XCD_BAR_WORDS, MISC + 8);
    const int lo = a.ph_lo, hi = a.ph_hi;
#define IN(k) (lo <= (k) && (k) < hi)
#define SEAM(k) do { if (IN(k) && IN((k) + 1)) xcd_barrier(bar); } while (0)
    if (IN(0)) { ph_prologue(); SEAM(0); }
    if (IN(1)) { ph_rp_init(); SEAM(1); }
    for (int l = 0; l < DEPTH; ++l) {
        const int pb = 2 + 9 * l, li = l >> 1; const bool sgu = (l & 1) != 0;
        if (IN(pb + 0)) { if (!sgu) ph_gla_in(li); else ph_sgu_in(li); SEAM(pb + 0); }
        if (IN(pb + 1)) { if (!sgu) ph_gla_scan(li); else ph_sgu_core(li); SEAM(pb + 1); }
        if (IN(pb + 2)) { if (!sgu) { ph_gla_post(li); SEAM(pb + 2); } }
        if (IN(pb + 3)) { ph_out(l); SEAM(pb + 3); }
        if (IN(pb + 4)) { ph_rp_mid(l); SEAM(pb + 4); }
        if (IN(pb + 5)) { ph_place(); SEAM(pb + 5); }
        if (IN(pb + 6)) { ph_moe_up(l); SEAM(pb + 6); }
        if (IN(pb + 7)) { ph_moe_down(l); SEAM(pb + 7); }
        if (IN(pb + 8)) { ph_rp_end(l); SEAM(pb + 8); }
    }
#undef IN
#undef SEAM
}

#ifndef N_LAUNCH_MODE
#define N_LAUNCH_MODE 0
#endif
extern "C" void kernel_launch(void* const* d_in, const int* in_sizes, int n_in, void* d_out, int out_size, void* d_ws, size_t ws_size, hipStream_t stream) {
    static int grid = 0;
    if (grid == 0) {
        if (n_in != 27 || out_size != T * D || ws_size < WS_END) { fprintf(stderr, "kernel_launch: unexpected shapes (n_in %d out %d ws %zu)\n", n_in, out_size, ws_size); grid = -1; return; }
        int dev = 0, cus = 0, per_cu = 0;
        if (hipGetDevice(&dev) != hipSuccess || hipDeviceGetAttribute(&cus, hipDeviceAttributeMultiprocessorCount, dev) != hipSuccess) { grid = -1; return; }
        if (hipFuncSetAttribute((const void*)fwd_kernel, hipFuncAttributeMaxDynamicSharedMemorySize, LDS_BYTES) != hipSuccess) { fprintf(stderr, "kernel_launch: hipFuncSetAttribute failed\n"); grid = -1; return; }
        if (hipOccupancyMaxActiveBlocksPerMultiprocessor(&per_cu, (const void*)fwd_kernel, NTHREADS, LDS_BYTES) != hipSuccess || per_cu < 1) fprintf(stderr, "kernel_launch: occupancy query reports %d\n", per_cu);
        (void)hipGetLastError();
        grid = cus;
        if (grid > 1024) grid = 1024;
    }
    if (grid < 0) return;
    (void)hipMemsetAsync((char*)d_ws + WS_CTL, 0, CTL_ZERO_BYTES, stream);
    Args a{};
    for (int i = 0; i < 27; ++i) a.in[i] = (const float*)d_in[i];
    a.out = (float*)d_out; a.ws = (unsigned char*)d_ws; a.pad = 0;
#if N_LAUNCH_MODE == 1
    a.ph_lo = 0; a.ph_hi = NPHASES; a.li = 0;
    hipLaunchKernelGGL(fwd_kernel, dim3(grid), dim3(NTHREADS), LDS_BYTES, stream, a);
#else
    for (int ph = 0, li = 0; ph < NPHASES; ++ph) {
        if (ph >= 2 && ((ph - 2) % 9) == 2 && (((ph - 2) / 9) & 1)) continue;
        a.ph_lo = ph; a.ph_hi = ph + 1; a.li = li++;
        hipLaunchKernelGGL(fwd_kernel, dim3(grid), dim3(NTHREADS), LDS_BYTES, stream, a);
    }
#endif
}
```

```cpp
#include <hip/hip_runtime.h>
#include <cstdio>
#include <cstdint>

#define LAS __attribute__((address_space(3)))
#define GAS __attribute__((address_space(1)))
typedef unsigned short bf16;
typedef short bf16x8 __attribute__((ext_vector_type(8)));
typedef float f32x4 __attribute__((ext_vector_type(4)));
typedef float f32x2 __attribute__((ext_vector_type(2)));
typedef unsigned u32x4 __attribute__((ext_vector_type(4)));
typedef unsigned u32x2 __attribute__((ext_vector_type(2)));

constexpr int D = 1024, NB = 8, SEQ = 4096, T = NB * SEQ, DEPTH = 4;
constexpr int NE = 32, TOPK = 4, CAP = T * TOPK + NE * 256;
constexpr int MAXTILES = CAP / 256;
constexpr float ALPHA = 1.681792830507429f;
constexpr float LN_EPS = 1e-5f;
constexpr int GLA_IN = 3104, GLA_MAIN = 3072;
constexpr int NWAVES = 8, NTHREADS = 512;
constexpr int LDS_BYTES = 147456, MISC_OFF = 139264;

constexpr size_t MiB = 1u << 20;
constexpr size_t WS_CTL = 0, CTL_ZERO_BYTES = 2 * MiB;
constexpr size_t WS_MOD = 2 * MiB;
constexpr size_t WS_ROUTE = 4 * MiB;
constexpr size_t WS_LR = 8 * MiB;
constexpr size_t WS_GLAIN_T = 16 * MiB;
constexpr size_t WS_GLALR_T = 28 * MiB;
constexpr size_t WS_ROUTER_T = 29 * MiB;
constexpr size_t WS_SGUWS = 30 * MiB;
constexpr size_t WS_GLAOUT_T = 32 * MiB;
constexpr size_t WS_SGUIN_T = 36 * MiB;
constexpr size_t WS_SGUOUT_T = 44 * MiB;
constexpr size_t WS_WUP_T = 64 * MiB;
constexpr size_t WS_WDN_T = 576 * MiB;
constexpr size_t WS_X1 = 832 * MiB;
constexpr size_t WS_X2 = 960 * MiB;
constexpr size_t WS_H = 1088 * MiB;
constexpr size_t WS_BIG = 1152 * MiB;
constexpr size_t WS_OF = 1344 * MiB;
constexpr size_t WS_OB = 1408 * MiB;
constexpr size_t WS_A2 = 1472 * MiB;
constexpr size_t WS_Y = 1536 * MiB;
constexpr size_t WS_ACT = 1664 * MiB;
constexpr size_t WS_YS = 1936 * MiB;
constexpr size_t WS_END = 2208 * MiB;
constexpr int R_TOPI = 0;
constexpr int R_TOPW = T * 4;
constexpr int R_DEST = 2 * T * 4;
constexpr int R_BUFTOK = 3 * T * 4;
constexpr int R_HIST = R_BUFTOK + CAP;
constexpr int R_TILEE = R_HIST + 1024 * 32;
constexpr int R_NTILES = R_TILEE + 1024;
static_assert((size_t)(R_NTILES + 64) * 4 <= 4 * MiB, "route tables");
constexpr int CW_BAR = 4096;
constexpr int MAX_LAUNCH = 64;

#define RLX_AGENT __ATOMIC_RELAXED, __HIP_MEMORY_SCOPE_AGENT
#define LDS_WAIT() asm volatile("s_waitcnt lgkmcnt(0)" ::: "memory")
#define VM_WAIT() asm volatile("s_waitcnt vmcnt(0)" ::: "memory")
__device__ __forceinline__ unsigned cvt_pk_bf16(float lo, float hi) { unsigned r; asm volatile("v_cvt_pk_bf16_f32 %0, %1, %2" : "=v"(r) : "v"(lo), "v"(hi)); return r; }
__device__ __forceinline__ float bf_lo(unsigned w) { return __uint_as_float(w << 16); }
__device__ __forceinline__ float bf_hi(unsigned w) { return __uint_as_float(w & 0xffff0000u); }
__device__ __forceinline__ float bf2f(bf16 b) { return __uint_as_float(((unsigned)b) << 16); }
__device__ __forceinline__ float wave_sum(float v) {
#pragma unroll
    for (int o = 1; o < 64; o <<= 1) v += __shfl_xor(v, o);
    return v;
}
__device__ __forceinline__ float silu_f(float x) { return x / (1.0f + __expf(-x)); }
__device__ __forceinline__ float sigmoid_f(float x) { return 1.0f / (1.0f + __expf(-x)); }
__device__ __forceinline__ float gelu_f(float v) {
    const float av = fabsf(v), t = __builtin_amdgcn_rcpf(av * 0.2316418882f + 1.0f);
    float q = t * 0.5307027145f + (-0.7265760135f); q = q * t + 0.7107068705f; q = q * t + (-0.142248368f); q = q * t + 0.127414796f; q = q * t;
    const float e = __builtin_amdgcn_exp2f((v * v) * (-0.72134752044f));
    const float m = v * (q * e);
    return v < 0.f ? m : v - m;
}

#define XB_TMO      128
#define XB_XCNT(j)  (256  + 64 * (j))
#define XB_XSUB(j)  (1280 + 64 * (j))
#define XB_XGEN(j)  (2304 + 64 * (j))
#define XB_TOP      3328
#define XB_TOPGEN   3392
#define XCD_BAR_WORDS 3456
#define XB_SPIN_CAP (1u << 18)
__device__ __forceinline__ unsigned xb_ld(unsigned* p)              { return __hip_atomic_load(p, __ATOMIC_RELAXED, __HIP_MEMORY_SCOPE_AGENT); }
__device__ __forceinline__ unsigned xb_add(unsigned* p, unsigned v) { return __hip_atomic_fetch_add(p, v, __ATOMIC_RELAXED, __HIP_MEMORY_SCOPE_AGENT); }
__device__ __forceinline__ unsigned xb_xcc_id() { return (unsigned)__builtin_amdgcn_s_getreg((3 << 11) | 20) & 0xFu; }
#define XB_SPIN(cond, bar) do { unsigned _sp = 0; while (cond) { __builtin_amdgcn_s_sleep(1); \
    if ((++_sp & 255u) == 0u) { if (xb_ld(&(bar)[XB_TMO])) break; if (_sp > XB_SPIN_CAP) { atomicAdd(&(bar)[XB_TMO], 1u); break; } } } } while (0)
struct XcdBarrier { unsigned* bar; unsigned x; volatile LAS unsigned* st; };
__device__ __forceinline__ XcdBarrier xcd_barrier_post(unsigned* bar, volatile LAS unsigned* st) {
    XcdBarrier b; b.bar = bar; b.x = xb_xcc_id(); b.st = st;
    if (threadIdx.x == 0) (void)xb_add(&bar[XB_XCNT(b.x)], 1u);
    return b;
}
__device__ __forceinline__ void xcd_barrier_complete(unsigned* bar, unsigned x, unsigned& nloc, unsigned& nx) {
    const unsigned G = gridDim.x * gridDim.y * gridDim.z;
    unsigned sum, cnt, mine, sp = 0u;
    for (;;) {
        sum = 0u; cnt = 0u; mine = 0u;
#pragma unroll
        for (unsigned j = 0; j < 16; ++j) { const unsigned c = xb_ld(&bar[XB_XCNT(j)]); sum += c; cnt += (c > 0u) ? 1u : 0u; mine = (j == x) ? c : mine; }
        if (sum == G) break;
        __builtin_amdgcn_s_sleep(1);
        if ((++sp & 255u) == 0u) { if (xb_ld(&bar[XB_TMO])) break; if (sp > XB_SPIN_CAP) { atomicAdd(&bar[XB_TMO], 1u); break; } }
    }
    nloc = mine > 0u ? mine : 1u; nx = cnt > 0u ? cnt : 1u;
}
__device__ __forceinline__ void xcd_barrier(const XcdBarrier& b) {
    asm volatile("s_waitcnt vmcnt(0)" ::: "memory");
    __syncthreads();
    if (threadIdx.x == 0) {
        unsigned* bar = b.bar;
        __builtin_amdgcn_s_waitcnt(0);
        unsigned nloc = b.st[0], nx = b.st[1];
        if (nloc == 0u) { xcd_barrier_complete(bar, b.x, nloc, nx); b.st[0] = nloc; b.st[1] = nx; }
        const unsigned old = xb_add(&bar[XB_XSUB(b.x)], 1u);
        const unsigned gen = old / nloc;
        if (old + 1u == (gen + 1u) * nloc) {
            __builtin_amdgcn_fence(__ATOMIC_RELEASE, "agent");
            asm volatile("s_waitcnt vmcnt(0)" ::: "memory");
            const unsigned og = xb_add(&bar[XB_TOP], 1u);
            const unsigned tg = og / nx;
            if (og + 1u == (tg + 1u) * nx) xb_add(&bar[XB_TOPGEN], 1u);
            else XB_SPIN(xb_ld(&bar[XB_TOPGEN]) == tg, bar);
            __builtin_amdgcn_fence(__ATOMIC_ACQUIRE, "agent");
            xb_add(&bar[XB_XGEN(b.x)], 1u);
            asm volatile("s_waitcnt vmcnt(0)" ::: "memory");
        } else {
            XB_SPIN(xb_ld(&bar[XB_XGEN(b.x)]) == gen, bar);
            __builtin_amdgcn_fence(__ATOMIC_ACQUIRE, "agent");
            asm volatile("s_waitcnt vmcnt(0)" ::: "memory");
        }
    }
    __syncthreads();
}

struct Args { const float* in[27]; float* out; unsigned char* ws; int ph_lo, ph_hi, li, pad; };
enum { I_X = 0, I_C, I_ADAW, I_ADAB, I_LNG, I_LNB, I_GWIN, I_GWG2F, I_GBGF, I_GWG2B, I_GBGB, I_GNORM, I_GWOUT, I_SWIN, I_SBIN, I_SLNG, I_SLNB, I_SWS, I_SBS, I_SWOUT, I_SBOUT, I_RW, I_RB, I_WUP, I_BUP, I_WDN, I_BDN };

#define PHASE_ENTER() int tid = threadIdx.x; asm volatile("" : "+v"(tid)); int bx = blockIdx.x, G = gridDim.x; asm volatile("" : "+s"(bx), "+s"(G)); \
    const Args* ap_ = (const Args*)__builtin_amdgcn_kernarg_segment_ptr(); asm volatile("" : "+s"(ap_)); const Args& a = *ap_; unsigned char* ws = a.ws; \
    extern __shared__ __attribute__((aligned(16))) unsigned char lds_raw[]; LAS unsigned char* lds = (LAS unsigned char*)lds_raw; (void)lds; (void)ws; (void)bx; (void)G; (void)tid
__device__ __forceinline__ int swiglu_perm(int o) {
    const int a = o >> 1, h = o & 1, pn = a >> 7, r = a & 127, bj = r >> 6, r2 = r & 63, wc = r2 >> 4, r3 = r2 & 15;
    return 256 * pn + 128 * bj + 32 * wc + 16 * h + r3;
}
__device__ __forceinline__ void conv_tile(const float* W, int K, int N, int k0, int n0, int nw, bf16* dst, int mode, LAS float* scr, int lane) {
    const int c4 = lane & 15, kr = lane >> 4;
    if (4 * c4 < nw) {
#pragma unroll 4
        for (int i = 0; i < 16; ++i) { const int kk = 4 * i + kr; const f32x4 v = *(const f32x4*)(W + (size_t)(k0 + kk) * N + n0 + 4 * c4);
            LAS float* s = scr + kk * 65 + 4 * c4; s[0] = v[0]; s[1] = v[1]; s[2] = v[2]; s[3] = v[3]; }
    }
    LDS_WAIT(); asm volatile("" ::: "memory");
    const int kc = lane & 7, ns = lane >> 3;
    for (int j = 0; j < nw / 8; ++j) {
        const int n = ns + 8 * j; const LAS float* s = scr + (8 * kc) * 65 + n;
        float v[8];
#pragma unroll
        for (int q = 0; q < 8; ++q) v[q] = s[q * 65];
        u32x4 o; o.x = cvt_pk_bf16(v[0], v[1]); o.y = cvt_pk_bf16(v[2], v[3]); o.z = cvt_pk_bf16(v[4], v[5]); o.w = cvt_pk_bf16(v[6], v[7]);
        const int ng = n0 + n;
        if (mode == 2) {
            *(u32x4*)(dst + (size_t)n * K + k0 + 8 * kc) = o;
            u32x4 l; l.x = cvt_pk_bf16(v[0] - bf_lo(o.x), v[1] - bf_hi(o.x)); l.y = cvt_pk_bf16(v[2] - bf_lo(o.y), v[3] - bf_hi(o.y));
            l.z = cvt_pk_bf16(v[4] - bf_lo(o.z), v[5] - bf_hi(o.z)); l.w = cvt_pk_bf16(v[6] - bf_lo(o.w), v[7] - bf_hi(o.w));
            *(u32x4*)(dst + (size_t)(32 + n) * K + k0 + 8 * kc) = l;
        } else {
            const int row = (mode == 1) ? swiglu_perm(ng) : ng;
            *(u32x4*)(dst + (size_t)row * K + k0 + 8 * kc) = o;
        }
    }
    LDS_WAIT(); asm volatile("" ::: "memory");
}

__device__ __forceinline__ void phase_prologue(const Args& a, LAS unsigned char* lds, int tid, int bx, int G) {
    const int lane = tid & 63, wave = __builtin_amdgcn_readfirstlane(tid >> 6);
    unsigned char* ws = a.ws;
    for (int slab = bx; slab < 192; slab += G) {
        LAS float* sc = (LAS float*)lds;
        LAS float* red = (LAS float*)(lds + 32768);
        for (int i = tid; i < 8 * 1024; i += NTHREADS) sc[i] = silu_f(a.in[I_C][i]);
        __syncthreads();
        const int g0 = slab * 128, l = g0 / 6144, e0 = g0 % 6144;
        const int c4 = tid & 31, seg = tid >> 5;
        f32x4 acc[8];
#pragma unroll
        for (int b = 0; b < 8; ++b) acc[b] = (f32x4){0.f, 0.f, 0.f, 0.f};
        const float* wp = a.in[I_ADAW] + ((size_t)l * 1024 + seg * 64) * 6144 + e0 + 4 * c4;
#pragma unroll 8
        for (int d = 0; d < 64; ++d) { const f32x4 w = *(const f32x4*)(wp + (size_t)d * 6144);
#pragma unroll
            for (int b = 0; b < 8; ++b) acc[b] += w * sc[b * 1024 + seg * 64 + d]; }
#pragma unroll
        for (int b = 0; b < 8; ++b) *(LAS f32x4*)(red + (seg * 8 + b) * 128 + 4 * c4) = acc[b];
        __syncthreads();
        for (int o = tid; o < 1024; o += NTHREADS) { const int b = o >> 7, c = o & 127; float s = a.in[I_ADAB][l * 6144 + e0 + c];
#pragma unroll
            for (int sg = 0; sg < 16; ++sg) s += red[(sg * 8 + b) * 128 + c];
            ((float*)(ws + WS_MOD))[((size_t)l * 8 + b) * 6144 + e0 + c] = s; }
        __syncthreads();
    }
    LAS float* scr = (LAS float*)(lds + wave * 16640);
    const int gw = bx * NWAVES + wave, NGW = G * NWAVES;
    constexpr int N_UP = 128 * 16 * 32, N_DN = 128 * 16 * 16, N_GIN = 2 * 16 * 48, N_GLR = 2 * 16, N_GOUT = 2 * 256, N_SIN = 2 * 16 * 32, N_SOUT = 2 * 256, N_RT = 4 * 16;
    constexpr int NITEMS = N_UP + N_DN + N_GIN + N_GLR + N_GOUT + N_SIN + N_SOUT + N_RT;
    for (int it = gw; it < NITEMS; it += NGW) {
        int r = it;
        if (r < N_UP) { const int m = r >> 9, q = r & 511, kt = q >> 5, nt = q & 31;
            conv_tile(a.in[I_WUP] + (size_t)m * 1024 * 2048, 1024, 2048, kt * 64, nt * 64, 64, (bf16*)(ws + WS_WUP_T) + (size_t)m * 2048 * 1024, 1, scr, lane); continue; } r -= N_UP;
        if (r < N_DN) { const int m = r >> 8, q = r & 255, kt = q >> 4, nt = q & 15;
            conv_tile(a.in[I_WDN] + (size_t)m * 1024 * 1024, 1024, 1024, kt * 64, nt * 64, 64, (bf16*)(ws + WS_WDN_T) + (size_t)m * 1024 * 1024, 0, scr, lane); continue; } r -= N_DN;
        if (r < N_GIN) { const int m = r / 768, q = r % 768, kt = q / 48, nt = q % 48;
            conv_tile(a.in[I_GWIN] + (size_t)m * 1024 * GLA_IN, 1024, GLA_IN, kt * 64, nt * 64, 64, (bf16*)(ws + WS_GLAIN_T) + (size_t)m * GLA_MAIN * 1024, 0, scr, lane); continue; } r -= N_GIN;
        if (r < N_GLR) { const int m = r >> 4, kt = r & 15;
            conv_tile(a.in[I_GWIN] + (size_t)m * 1024 * GLA_IN, 1024, GLA_IN, kt * 64, GLA_MAIN, 32, (bf16*)(ws + WS_GLALR_T) + (size_t)m * 64 * 1024, 2, scr, lane); continue; } r -= N_GLR;
        if (r < N_GOUT) { const int m = r >> 8, q = r & 255, kt = q >> 4, nt = q & 15;
            conv_tile(a.in[I_GWOUT] + (size_t)m * 1024 * 1024, 1024, 1024, kt * 64, nt * 64, 64, (bf16*)(ws + WS_GLAOUT_T) + (size_t)m * 1024 * 1024, 0, scr, lane); continue; } r -= N_GOUT;
        if (r < N_SIN) { const int m = r >> 9, q = r & 511, kt = q >> 5, nt = q & 31;
            conv_tile(a.in[I_SWIN] + (size_t)m * 1024 * 2048, 1024, 2048, kt * 64, nt * 64, 64, (bf16*)(ws + WS_SGUIN_T) + (size_t)m * 2048 * 1024, 0, scr, lane); continue; } r -= N_SIN;
        if (r < N_SOUT) { const int m = r >> 8, q = r & 255, kt = q >> 4, nt = q & 15;
            conv_tile(a.in[I_SWOUT] + (size_t)m * 1024 * 1024, 1024, 1024, kt * 64, nt * 64, 64, (bf16*)(ws + WS_SGUOUT_T) + (size_t)m * 1024 * 1024, 0, scr, lane); continue; } r -= N_SOUT;
        { const int m = r >> 4, kt = r & 15;
            conv_tile(a.in[I_RW] + (size_t)m * 1024 * 32, 1024, 32, kt * 64, 0, 32, (bf16*)(ws + WS_ROUTER_T) + (size_t)m * 64 * 1024, 2, scr, lane); }
    }
    { bf16* d = (bf16*)(ws + WS_SGUWS); const float* s = a.in[I_SWS];
      for (int i = (bx * NTHREADS + tid) * 4; i < 2 * 8 * 128 * 128; i += G * NTHREADS * 4) { const f32x4 v = *(const f32x4*)(s + i); u32x2 o; o.x = cvt_pk_bf16(v[0], v[1]); o.y = cvt_pk_bf16(v[2], v[3]); *(u32x2*)(d + i) = o; } }
}

struct RowPass {
    const float* xin; const float* y; float* xout; bf16* hout;
    const float* gate; const float* lng; const float* lnb; const float* sc; const float* sh;
    const bf16* wside;
    float* lr_out;
    const float* rbias;
    int* topi; float* topw; int* hist;
    const bf16* ys; const int* dest; const float* tw;
    int has_h, has_side;
};
template <int MODE>
__device__ __forceinline__ void row_pass(const RowPass& p, LAS unsigned char* lds, int tid, int bx, int G) {
    const int lane = tid & 63, wave = __builtin_amdgcn_readfirstlane(tid >> 6);
    constexpr int HS = 1032;
    LAS bf16* Hhi = (LAS bf16*)lds;
    LAS bf16* Hlo = (LAS bf16*)(lds + 16 * HS * 2);
    LAS float* part = (LAS float*)(lds + 2 * 16 * HS * 2);
    LAS float* logit = part + 8 * 32 * 16;
    LAS int* lhist = (LAS int*)(logit + 16 * 32);
    if (MODE == 1) { if (tid < 32) lhist[tid] = 0; }
    const bool side = (p.has_side != 0) && (p.wside != nullptr);
    bf16x8 whi[2][4], wlo[2][4];
    if (side) {
#pragma unroll
        for (int hf = 0; hf < 2; ++hf)
#pragma unroll
            for (int s = 0; s < 4; ++s) { const size_t off = (size_t)(hf * 16 + (lane & 15)) * 1024 + 128 * wave + 32 * s + 8 * (lane >> 4);
                whi[hf][s] = *(const bf16x8*)(p.wside + off); wlo[hf][s] = *(const bf16x8*)(p.wside + 32 * 1024 + off); }
    }
    for (int tile = bx; tile < T / 16; tile += G) {
        const int b = (tile * 16) / SEQ;
#pragma unroll 1
        for (int tt = 0; tt < 2; ++tt) {
            const int tl = 2 * wave + tt, token = tile * 16 + tl;
            f32x4 v[4];
            const float* xr = p.xin + (size_t)token * D + 4 * lane;
#pragma unroll
            for (int j = 0; j < 4; ++j) v[j] = *(const f32x4*)(xr + 256 * j);
            if (MODE == 1) {
                const float* yr = p.y + (size_t)token * D + 4 * lane; const float* gp = p.gate + (size_t)b * 6144 + 4 * lane;
#pragma unroll
                for (int j = 0; j < 4; ++j) { const f32x4 yy = *(const f32x4*)(yr + 256 * j); const f32x4 g = *(const f32x4*)(gp + 256 * j); v[j] = v[j] * ALPHA + (g + 1.0f) * yy; }
            }
            if (MODE == 2) {
                f32x4 ya[4];
#pragma unroll
                for (int j = 0; j < 4; ++j) ya[j] = (f32x4){0.f, 0.f, 0.f, 0.f};
#pragma unroll
                for (int k = 0; k < 4; ++k) { const int ds = p.dest[token * 4 + k]; const float w = p.tw[token * 4 + k]; const bf16* yr = p.ys + (size_t)ds * D + 4 * lane;
#pragma unroll
                    for (int j = 0; j < 4; ++j) { const u32x2 q = *(const u32x2*)(yr + 256 * j); ya[j] += (f32x4){bf_lo(q.x), bf_hi(q.x), bf_lo(q.y), bf_hi(q.y)} * w; } }
                const float* gp = p.gate + (size_t)b * 6144 + 4 * lane;
#pragma unroll
                for (int j = 0; j < 4; ++j) { const f32x4 g = *(const f32x4*)(gp + 256 * j); v[j] = v[j] * ALPHA + (g + 1.0f) * ya[j]; }
            }
            if (MODE != 0) {
                float s = 0.f;
#pragma unroll
                for (int j = 0; j < 4; ++j) s += (v[j][0] + v[j][1]) + (v[j][2] + v[j][3]);
                const float mean = wave_sum(s) * (1.0f / D); float s2 = 0.f;
#pragma unroll
                for (int j = 0; j < 4; ++j) { v[j] = v[j] - mean; s2 += (v[j][0] * v[j][0] + v[j][1] * v[j][1]) + (v[j][2] * v[j][2] + v[j][3] * v[j][3]); }
                const float rstd = 1.0f / sqrtf(wave_sum(s2) * (1.0f / D) + LN_EPS);
                float* xo = p.xout + (size_t)token * D + 4 * lane;
#pragma unroll
                for (int j = 0; j < 4; ++j) { const f32x4 g = *(const f32x4*)(p.lng + 4 * lane + 256 * j), bb = *(const f32x4*)(p.lnb + 4 * lane + 256 * j); v[j] = v[j] * rstd * g + bb; *(f32x4*)(xo + 256 * j) = v[j]; }
            }
            if (p.has_h) {
                const float* scp = p.sc + (size_t)b * 6144 + 4 * lane; const float* shp = p.sh + (size_t)b * 6144 + 4 * lane;
                bf16* ho = p.hout + (size_t)token * D + 4 * lane;
#pragma unroll
                for (int j = 0; j < 4; ++j) { const f32x4 s1 = *(const f32x4*)(scp + 256 * j), s0 = *(const f32x4*)(shp + 256 * j); const f32x4 h = v[j] * (s1 + 1.0f) + s0;
                    u32x2 o; o.x = cvt_pk_bf16(h[0], h[1]); o.y = cvt_pk_bf16(h[2], h[3]); *(u32x2*)(ho + 256 * j) = o;
                    if (side) { u32x2 l; l.x = cvt_pk_bf16(h[0] - bf_lo(o.x), h[1] - bf_hi(o.x)); l.y = cvt_pk_bf16(h[2] - bf_lo(o.y), h[3] - bf_hi(o.y));
                        *(LAS u32x2*)(Hhi + tl * HS + 4 * lane + 256 * j) = o; *(LAS u32x2*)(Hlo + tl * HS + 4 * lane + 256 * j) = l; } }
            }
        }
        if (side) {
            __syncthreads();
            f32x4 acc[2]; acc[0] = (f32x4){0.f, 0.f, 0.f, 0.f}; acc[1] = acc[0];
#pragma unroll
            for (int s = 0; s < 4; ++s) { const int ko = (lane & 15) * HS + 128 * wave + 32 * s + 8 * (lane >> 4);
                const bf16x8 bh = *(const LAS bf16x8*)(Hhi + ko), bl = *(const LAS bf16x8*)(Hlo + ko);
#pragma unroll
                for (int hf = 0; hf < 2; ++hf) { acc[hf] = __builtin_amdgcn_mfma_f32_16x16x32_bf16(whi[hf][s], bh, acc[hf], 0, 0, 0);
                    acc[hf] = __builtin_amdgcn_mfma_f32_16x16x32_bf16(wlo[hf][s], bh, acc[hf], 0, 0, 0); acc[hf] = __builtin_amdgcn_mfma_f32_16x16x32_bf16(whi[hf][s], bl, acc[hf], 0, 0, 0); } }
#pragma unroll
            for (int hf = 0; hf < 2; ++hf)
#pragma unroll
                for (int j = 0; j < 4; ++j) part[(wave * 32 + hf * 16 + 4 * (lane >> 4) + j) * 16 + (lane & 15)] = acc[hf][j];
            __syncthreads();
            { const int e = tid >> 4, tk = tid & 15; float s = 0.f;
#pragma unroll
              for (int w = 0; w < 8; ++w) s += part[(w * 32 + e) * 16 + tk];
              if (MODE == 1) logit[tk * 32 + e] = s + p.rbias[e];
              else p.lr_out[(size_t)(tile * 16 + tk) * 32 + e] = s; }
            if (MODE == 1) {
                __syncthreads();
                if (tid < 16) {
                    const int token = tile * 16 + tid; float lv[32];
#pragma unroll
                    for (int e = 0; e < 32; ++e) lv[e] = logit[tid * 32 + e];
                    int bi[4]; float bv[4];
#pragma unroll
                    for (int k = 0; k < 4; ++k) { float m = -3.0e38f; int mi = 0;
#pragma unroll
                        for (int e = 0; e < 32; ++e) { const bool take = lv[e] > m; m = take ? lv[e] : m; mi = take ? e : mi; }
                        bi[k] = mi; bv[k] = m;
#pragma unroll
                        for (int e = 0; e < 32; ++e) lv[e] = (e == mi) ? -3.0e38f : lv[e]; }
                    const float e1 = __expf(bv[1] - bv[0]), e2 = __expf(bv[2] - bv[0]), e3 = __expf(bv[3] - bv[0]); const float inv = 1.0f / (1.0f + e1 + e2 + e3);
                    *(int4*)(p.topi + token * 4) = make_int4(bi[0], bi[1], bi[2], bi[3]);
                    *(f32x4*)(p.topw + token * 4) = (f32x4){inv, e1 * inv, e2 * inv, e3 * inv};
#pragma unroll
                    for (int k = 0; k < 4; ++k) atomicAdd((int*)&lhist[bi[k]], 1);
                }
            }
            __syncthreads();
        }
    }
    if (MODE == 1) { __syncthreads(); if (tid < 32) p.hist[tid] = lhist[tid]; }
}

__device__ __forceinline__ void phase_place(int* route, LAS unsigned char* lds, int tid, int bx, int G) {
    const int lane = tid & 63, wave = tid >> 6;
    LAS int* ptot = (LAS int*)lds;
    LAS int* ppre = ptot + 512;
    LAS int* tot = ppre + 512;
    LAS int* pre = tot + 32;
    LAS int* pstart = pre + 32;
    const int* hist = route + R_HIST;
    { const int e = tid & 31, part = tid >> 5; int st = 0, sp = 0;
      for (int bb = part; bb < G; bb += 16) { const int h = hist[bb * 32 + e]; st += h; if (bb < bx) sp += h; }
      ptot[part * 32 + e] = st; ppre[part * 32 + e] = sp; }
    __syncthreads();
    if (tid < 32) { int st = 0, sp = 0;
#pragma unroll
        for (int q = 0; q < 16; ++q) { st += ptot[q * 32 + tid]; sp += ppre[q * 32 + tid]; }
        tot[tid] = st; pre[tid] = sp; }
    __syncthreads();
    if (tid == 0) { int acc = 0; for (int e = 0; e < 32; ++e) { pstart[e] = acc; acc += (tot[e] + 255) / 256 * 256; } pstart[32] = acc; }
    __syncthreads();
    if (bx == 0) {
        const int ntiles = pstart[32] / 256;
        if (tid == 0) route[R_NTILES] = ntiles;
        for (int t = tid; t < ntiles; t += NTHREADS) { int e = 0; for (int q = 1; q < 32; ++q) if (pstart[q] <= t * 256) e = q; route[R_TILEE + t] = e; }
    }
    for (int e = bx; e < 32; e += G) { const int s0 = pstart[e] + tot[e], s1 = pstart[e + 1]; for (int s = s0 + tid; s < s1; s += NTHREADS) route[R_BUFTOK + s] = 0; }
    if (wave == 0) {
        int run = 0;
        for (int tile = bx; tile < T / 16; tile += G) {
            const int token = tile * 16 + (lane >> 2);
            const int e = route[R_TOPI + tile * 64 + lane];
            const int base = __shfl(run, e);
            int rank = 0, add = 0;
#pragma unroll 1
            for (int x = 0; x < 32; ++x) { const unsigned long long m = __ballot(e == x); if (e == x) rank = __popcll(m & ((1ull << lane) - 1ull)); if (lane == x) add = __popcll(m); }
            run += add;
            const int ds = pstart[e] + pre[e] + base + rank;
            route[R_DEST + tile * 64 + lane] = ds;
            route[R_BUFTOK + ds] = token;
        }
    }
}

struct Unit { int pm, pn, e; const bf16* bt; };
constexpr int NXCD = 8, WGM = 8;
struct Sched {
    int nM, nN, nwg, G, c; const bf16* Bt; size_t estride; const int* tile_e; int K;
    __device__ __forceinline__ void init(int nM_, int nN_, int G_, int c_, const bf16* Bt_, size_t es, const int* te, int K_) { nM = nM_; nN = nN_; nwg = nM * nN; G = G_; c = c_; Bt = Bt_; estride = es; tile_e = te; K = K_; }
    __device__ __forceinline__ bool next(int i, Unit& u) const {
        const long L = (long)i * G + c; if (L >= nwg) return false;
        int wgid = (int)L; { const int q = nwg / NXCD, r = nwg % NXCD, xcd = wgid % NXCD, off = wgid / NXCD; wgid = (xcd < r ? xcd * (q + 1) : r * (q + 1) + (xcd - r) * q) + off; }
        const int nig = WGM * nN, gid = wgid / nig, fm = gid * WGM, gsz = (nM - fm) < WGM ? (nM - fm) : WGM;
        u.pm = fm + ((wgid % nig) % gsz); u.pn = (wgid % nig) / gsz;
        u.e = tile_e ? tile_e[u.pm] : 0;
        u.bt = Bt + (size_t)u.e * estride + (size_t)u.pn * 256 * K;
        return true;
    }
};
struct EpiGlaIn { bf16* O;
    __device__ __forceinline__ void operator()(const f32x4 (&acc)[2][2][4][2], const Unit& u, int wr, int wc, int fr, int fq) const {
        const int row0 = u.pm * 256 + wr * 64 + fr, col0 = u.pn * 256 + wc * 32 + 4 * fq; const float sc = (u.pn < 2) ? 0.08838834764831845f : 1.0f;
#pragma unroll
        for (int ai = 0; ai < 2; ++ai)
#pragma unroll
            for (int m = 0; m < 4; ++m) { bf16* rp = O + (size_t)(row0 + ai * 128 + m * 16) * GLA_MAIN + col0;
#pragma unroll
                for (int bj = 0; bj < 2; ++bj)
#pragma unroll
                    for (int n = 0; n < 2; ++n) { const f32x4 v = acc[ai][bj][m][n] * sc; u32x2 o; o.x = cvt_pk_bf16(v[0], v[1]); o.y = cvt_pk_bf16(v[2], v[3]); *(u32x2*)(rp + bj * 128 + n * 16) = o; } }
    }
};
struct EpiSguIn { bf16* O; const float* bias;
    __device__ __forceinline__ void operator()(const f32x4 (&acc)[2][2][4][2], const Unit& u, int wr, int wc, int fr, int fq) const {
        const int row0 = u.pm * 256 + wr * 64 + fr, col0 = u.pn * 256 + wc * 32 + 4 * fq;
        f32x4 bv[2][2];
#pragma unroll
        for (int bj = 0; bj < 2; ++bj)
#pragma unroll
            for (int n = 0; n < 2; ++n) bv[bj][n] = *(const f32x4*)(bias + col0 + bj * 128 + n * 16);
#pragma unroll
        for (int ai = 0; ai < 2; ++ai)
#pragma unroll
            for (int m = 0; m < 4; ++m) { bf16* rp = O + (size_t)(row0 + ai * 128 + m * 16) * 2048 + col0;
#pragma unroll
                for (int bj = 0; bj < 2; ++bj)
#pragma unroll
                    for (int n = 0; n < 2; ++n) { const f32x4 v = acc[ai][bj][m][n] + bv[bj][n]; u32x2 o; o.x = cvt_pk_bf16(gelu_f(v[0]), gelu_f(v[1])); o.y = cvt_pk_bf16(gelu_f(v[2]), gelu_f(v[3])); *(u32x2*)(rp + bj * 128 + n * 16) = o; } }
    }
};
struct EpiOut { float* O; const float* bias;
    __device__ __forceinline__ void operator()(const f32x4 (&acc)[2][2][4][2], const Unit& u, int wr, int wc, int fr, int fq) const {
        const int row0 = u.pm * 256 + wr * 64 + fr, col0 = u.pn * 256 + wc * 32 + 4 * fq;
        f32x4 bv[2][2];
#pragma unroll
        for (int bj = 0; bj < 2; ++bj)
#pragma unroll
            for (int n = 0; n < 2; ++n) bv[bj][n] = bias ? *(const f32x4*)(bias + col0 + bj * 128 + n * 16) : (f32x4){0.f, 0.f, 0.f, 0.f};
#pragma unroll
        for (int ai = 0; ai < 2; ++ai)
#pragma unroll
            for (int m = 0; m < 4; ++m) { float* rp = O + (size_t)(row0 + ai * 128 + m * 16) * D + col0;
#pragma unroll
                for (int bj = 0; bj < 2; ++bj)
#pragma unroll
                    for (int n = 0; n < 2; ++n) *(f32x4*)(rp + bj * 128 + n * 16) = acc[ai][bj][m][n] + bv[bj][n]; }
    }
};
struct EpiUp { bf16* O; const float* bias;
    __device__ __forceinline__ void operator()(const f32x4 (&acc)[2][2][4][2], const Unit& u, int wr, int wc, int fr, int fq) const {
        const int row0 = u.pm * 256 + wr * 64 + fr, a0 = u.pn * 128 + wc * 16 + 4 * fq;
        f32x4 bg[2], bl[2];
#pragma unroll
        for (int bj = 0; bj < 2; ++bj) { const float* bp = bias + (size_t)u.e * 2048 + 2 * (a0 + 64 * bj); const f32x4 p0 = *(const f32x4*)bp, p1 = *(const f32x4*)(bp + 4);
            bg[bj] = (f32x4){p0[0], p0[2], p1[0], p1[2]}; bl[bj] = (f32x4){p0[1], p0[3], p1[1], p1[3]}; }
#pragma unroll
        for (int ai = 0; ai < 2; ++ai)
#pragma unroll
            for (int m = 0; m < 4; ++m) { bf16* rp = O + (size_t)(row0 + ai * 128 + m * 16) * D + a0;
#pragma unroll
                for (int bj = 0; bj < 2; ++bj) { const f32x4 g = acc[ai][bj][m][0] + bg[bj], l = acc[ai][bj][m][1] + bl[bj]; float r[4];
#pragma unroll
                    for (int j = 0; j < 4; ++j) { const float gg = fminf(g[j], 7.0f), ll = fminf(fmaxf(l[j], -7.0f), 7.0f); r[j] = gg * sigmoid_f(1.702f * gg) * (ll + 1.0f); }
                    u32x2 o; o.x = cvt_pk_bf16(r[0], r[1]); o.y = cvt_pk_bf16(r[2], r[3]); *(u32x2*)(rp + bj * 64) = o; } }
    }
};
struct EpiDown { bf16* O; const float* bias;
    __device__ __forceinline__ void operator()(const f32x4 (&acc)[2][2][4][2], const Unit& u, int wr, int wc, int fr, int fq) const {
        const int row0 = u.pm * 256 + wr * 64 + fr, col0 = u.pn * 256 + wc * 32 + 4 * fq;
        f32x4 bv[2][2];
#pragma unroll
        for (int bj = 0; bj < 2; ++bj)
#pragma unroll
            for (int n = 0; n < 2; ++n) bv[bj][n] = *(const f32x4*)(bias + (size_t)u.e * 1024 + col0 + bj * 128 + n * 16);
#pragma unroll
        for (int ai = 0; ai < 2; ++ai)
#pragma unroll
            for (int m = 0; m < 4; ++m) { bf16* rp = O + (size_t)(row0 + ai * 128 + m * 16) * D + col0;
#pragma unroll
                for (int bj = 0; bj < 2; ++bj)
#pragma unroll
                    for (int n = 0; n < 2; ++n) { const f32x4 v = acc[ai][bj][m][n] + bv[bj][n]; u32x2 o; o.x = cvt_pk_bf16(v[0], v[1]); o.y = cvt_pk_bf16(v[2], v[3]); *(u32x2*)(rp + bj * 128 + n * 16) = o; } }
    }
};

template <class Epi>
__device__ __forceinline__ void gemm_naive(const bf16* A, const int* gather, int K, const Sched& S, const Epi& E, int tid) {
    const int wid = __builtin_amdgcn_readfirstlane(tid >> 6), lane = tid & 63, wr = wid >> 2, wc = wid & 3, fr = lane & 15, fq = lane >> 4;
    Unit u;
    for (int ui = 0; S.next(ui, u); ++ui) {
        f32x4 acc[2][2][4][2];
#pragma unroll
        for (int a = 0; a < 2; ++a)
#pragma unroll
            for (int b = 0; b < 2; ++b)
#pragma unroll
                for (int m = 0; m < 4; ++m)
#pragma unroll
                    for (int n = 0; n < 2; ++n) acc[a][b][m][n] = (f32x4){0.f, 0.f, 0.f, 0.f};
        unsigned ap[2][4], bp[2][2];
#pragma unroll
        for (int ai = 0; ai < 2; ++ai)
#pragma unroll
            for (int m = 0; m < 4; ++m) { const int r = u.pm * 256 + ai * 128 + wr * 64 + m * 16 + fr; const int ar = gather ? gather[r] : r; ap[ai][m] = (unsigned)ar * (unsigned)K + 8u * fq; }
#pragma unroll
        for (int bj = 0; bj < 2; ++bj)
#pragma unroll
            for (int n = 0; n < 2; ++n) bp[bj][n] = (unsigned)(bj * 128 + wc * 32 + n * 16 + fr) * (unsigned)K + 8u * fq;
#pragma unroll 1
        for (int k0 = 0; k0 < K; k0 += 32) {
            bf16x8 af[2][4], bfr[2][2];
#pragma unroll
            for (int ai = 0; ai < 2; ++ai)
#pragma unroll
                for (int m = 0; m < 4; ++m) af[ai][m] = *(const bf16x8*)(A + ap[ai][m] + k0);
#pragma unroll
            for (int bj = 0; bj < 2; ++bj)
#pragma unroll
                for (int n = 0; n < 2; ++n) bfr[bj][n] = *(const bf16x8*)(u.bt + bp[bj][n] + k0);
#pragma unroll
            for (int ai = 0; ai < 2; ++ai)
#pragma unroll
                for (int bj = 0; bj < 2; ++bj)
#pragma unroll
                    for (int m = 0; m < 4; ++m)
#pragma unroll
                        for (int n = 0; n < 2; ++n) acc[ai][bj][m][n] = __builtin_amdgcn_mfma_f32_16x16x32_bf16(bfr[bj][n], af[ai][m], acc[ai][bj][m][n], 0, 0, 0);
        }
        E(acc, u, wr, wc, fr, fq);
    }
}

__device__ __forceinline__ float logsigmoid_f(float x) { return fminf(x, 0.f) - log1pf(__expf(-fabsf(x))); }
__device__ __forceinline__ void phase_gla_scan_naive(const Args& a, int li, LAS unsigned char* lds, int tid, int bx, int G) {
    const bf16* qkvr = (const bf16*)(a.ws + WS_BIG); const float* lr = (const float*)(a.ws + WS_LR);
    LAS float* qs = (LAS float*)lds;
    LAS float* ks = qs + 2048;
    LAS float* as = ks + 2048;
    LAS float* vs = as + 2048;
    LAS float* lrs = vs + 1024;
    LAS float* part = lrs + 256;
    for (int it = bx; it < 256; it += G) {
        const int b = it >> 5, h = (it >> 3) & 3, dir = (it >> 2) & 1, es = it & 3;
        const float* wg2 = a.in[dir ? I_GWG2B : I_GWG2F] + (size_t)li * 16 * 512; const float* bg = a.in[dir ? I_GBGB : I_GBGF] + (size_t)li * 512;
        bf16* oo = (bf16*)(a.ws + (dir ? WS_OB : WS_OF));
        const int dd = tid & 127;
        float wcol[16];
#pragma unroll
        for (int r = 0; r < 16; ++r) wcol[r] = wg2[r * 512 + h * 128 + dd];
        const float bgd = bg[h * 128 + dd];
        const int e = tid & 63, dp = tid >> 6;
        float S[16];
#pragma unroll
        for (int i = 0; i < 16; ++i) S[i] = 0.f;
        for (int t0 = 0; t0 < SEQ; t0 += 16) {
            __syncthreads();
            if (tid < 256) { const int st = tid >> 4, r = tid & 15; const int s = dir ? (SEQ - 1 - (t0 + st)) : (t0 + st); lrs[tid] = lr[(size_t)(b * SEQ + s) * 32 + dir * 16 + r]; }
            __syncthreads();
#pragma unroll
            for (int i = 0; i < 4; ++i) { const int st = (tid >> 7) + 4 * i; const int s = dir ? (SEQ - 1 - (t0 + st)) : (t0 + st); const size_t row = (size_t)(b * SEQ + s) * GLA_MAIN;
                qs[st * 128 + dd] = bf2f(qkvr[row + h * 128 + dd]); ks[st * 128 + dd] = bf2f(qkvr[row + 512 + h * 128 + dd]);
                float x = bgd;
#pragma unroll
                for (int r = 0; r < 16; ++r) x += lrs[st * 16 + r] * wcol[r];
                as[st * 128 + dd] = __expf(logsigmoid_f(x) * (1.0f / 16.0f)); }
#pragma unroll
            for (int i = 0; i < 2; ++i) { const int idx = tid + 512 * i, st = idx >> 6, ee = idx & 63; const int s = dir ? (SEQ - 1 - (t0 + st)) : (t0 + st);
                vs[idx] = bf2f(qkvr[(size_t)(b * SEQ + s) * GLA_MAIN + 1024 + h * 256 + es * 64 + ee]); }
            __syncthreads();
            for (int st = 0; st < 16; ++st) {
                const float vv = vs[st * 64 + e]; float po = 0.f;
#pragma unroll
                for (int i4 = 0; i4 < 4; ++i4) { const f32x4 q4 = *(const LAS f32x4*)(qs + st * 128 + dp * 16 + 4 * i4), k4 = *(const LAS f32x4*)(ks + st * 128 + dp * 16 + 4 * i4), a4 = *(const LAS f32x4*)(as + st * 128 + dp * 16 + 4 * i4);
#pragma unroll
                    for (int j = 0; j < 4; ++j) { S[4 * i4 + j] = a4[j] * S[4 * i4 + j] + k4[j] * vv; po += q4[j] * S[4 * i4 + j]; } }
                part[(dp * 16 + st) * 64 + e] = po;
            }
            __syncthreads();
#pragma unroll
            for (int i = 0; i < 2; ++i) { const int idx = tid + 512 * i, st = idx >> 6, ee = idx & 63; float s = 0.f;
#pragma unroll
                for (int w = 0; w < 8; ++w) s += part[(w * 16 + st) * 64 + ee];
                const int sq = dir ? (SEQ - 1 - (t0 + st)) : (t0 + st);
                oo[(size_t)(b * SEQ + sq) * D + h * 256 + es * 64 + ee] = (bf16)(cvt_pk_bf16(s, 0.f) & 0xffffu); }
        }
        __syncthreads();
    }
}
__device__ __forceinline__ void phase_gla_post(const Args& a, int li, int tid, int bx, int G) {
    const int lane = tid & 63, wave = tid >> 6;
    const bf16* of = (const bf16*)(a.ws + WS_OF); const bf16* ob = (const bf16*)(a.ws + WS_OB); const bf16* qkvr = (const bf16*)(a.ws + WS_BIG); bf16* A2 = (bf16*)(a.ws + WS_A2);
    const float* ng = a.in[I_GNORM] + (size_t)li * 256 + (lane & 15) * 16;
    float g[16];
#pragma unroll
    for (int j = 0; j < 16; ++j) g[j] = ng[j];
    for (int token = bx * NWAVES + wave; token < T; token += G * NWAVES) {
        const u32x4 f0 = *(const u32x4*)(of + (size_t)token * D + 16 * lane), f1 = *(const u32x4*)(of + (size_t)token * D + 16 * lane + 8);
        const u32x4 b0 = *(const u32x4*)(ob + (size_t)token * D + 16 * lane), b1 = *(const u32x4*)(ob + (size_t)token * D + 16 * lane + 8);
        const u32x4 r0 = *(const u32x4*)(qkvr + (size_t)token * GLA_MAIN + 2048 + 16 * lane), r1 = *(const u32x4*)(qkvr + (size_t)token * GLA_MAIN + 2048 + 16 * lane + 8);
        float o[16], r[16];
#pragma unroll
        for (int q = 0; q < 4; ++q) { o[2 * q] = bf_lo(f0[q]) + bf_lo(b0[q]); o[2 * q + 1] = bf_hi(f0[q]) + bf_hi(b0[q]); o[8 + 2 * q] = bf_lo(f1[q]) + bf_lo(b1[q]); o[8 + 2 * q + 1] = bf_hi(f1[q]) + bf_hi(b1[q]);
            r[2 * q] = bf_lo(r0[q]); r[2 * q + 1] = bf_hi(r0[q]); r[8 + 2 * q] = bf_lo(r1[q]); r[8 + 2 * q + 1] = bf_hi(r1[q]); }
        float ss = 0.f;
#pragma unroll
        for (int j = 0; j < 16; ++j) ss += o[j] * o[j];
        ss += __shfl_xor(ss, 1); ss += __shfl_xor(ss, 2); ss += __shfl_xor(ss, 4); ss += __shfl_xor(ss, 8);
        const float rstd = 1.0f / sqrtf(ss * (1.0f / 256.0f) + LN_EPS);
        unsigned w[8];
#pragma unroll
        for (int q = 0; q < 8; ++q) w[q] = cvt_pk_bf16(o[2 * q] * rstd * g[2 * q] * silu_f(r[2 * q]), o[2 * q + 1] * rstd * g[2 * q + 1] * silu_f(r[2 * q + 1]));
        *(u32x4*)(A2 + (size_t)token * D + 16 * lane) = (u32x4){w[0], w[1], w[2], w[3]}; *(u32x4*)(A2 + (size_t)token * D + 16 * lane + 8) = (u32x4){w[4], w[5], w[6], w[7]};
    }
}

__device__ __forceinline__ void phase_sgu_naive(const Args& a, int li, LAS unsigned char* lds, int tid, int bx, int G) {
    const int lane = tid & 63, wave = tid >> 6, fr = lane & 15, fq = lane >> 4;
    const bf16* z = (const bf16*)(a.ws + WS_BIG); bf16* A2 = (bf16*)(a.ws + WS_A2);
    const float* lng = a.in[I_SLNG] + (size_t)li * 1024; const float* lnb = a.in[I_SLNB] + (size_t)li * 1024;
    const float* wsp = a.in[I_SWS] + (size_t)li * 8 * 128 * 128; const float* bs = a.in[I_SBS] + (size_t)li * 8 * 128;
    LAS float* st_mean = (LAS float*)lds; LAS float* st_rstd = st_mean + 128;
    for (int it = bx; it < T / 128; it += G) {
        const int row0 = it * 128;
        __syncthreads();
#pragma unroll 1
        for (int rr = 0; rr < 16; ++rr) { const int q = wave * 16 + rr; const bf16* vp = z + (size_t)(row0 + q) * 2048 + 1024 + 16 * lane;
            const u32x4 v0 = *(const u32x4*)vp, v1 = *(const u32x4*)(vp + 8); float x[16];
#pragma unroll
            for (int k = 0; k < 4; ++k) { x[2 * k] = bf_lo(v0[k]); x[2 * k + 1] = bf_hi(v0[k]); x[8 + 2 * k] = bf_lo(v1[k]); x[8 + 2 * k + 1] = bf_hi(v1[k]); }
            float s = 0.f;
#pragma unroll
            for (int k = 0; k < 16; ++k) s += x[k];
            const float mean = wave_sum(s) * (1.0f / 1024.0f); float s2 = 0.f;
#pragma unroll
            for (int k = 0; k < 16; ++k) { const float d = x[k] - mean; s2 += d * d; }
            const float rstd = 1.0f / sqrtf(wave_sum(s2) * (1.0f / 1024.0f) + LN_EPS);
            if (lane == 0) { st_mean[q] = mean; st_rstd[q] = rstd; } }
        __syncthreads();
        const int p = wave * 16 + fr;
#pragma unroll 1
        for (int g = 0; g < 8; ++g) {
#pragma unroll 1
            for (int ct = 0; ct < 8; ++ct) {
                const int ch = g * 128 + ct * 16 + fr;
                const float lg = lng[ch], lb = lnb[ch];
                f32x4 acc = (f32x4){0.f, 0.f, 0.f, 0.f};
#pragma unroll
                for (int ks = 0; ks < 4; ++ks) {
                    const int q0 = ks * 32 + 8 * fq;
                    const float* wp = wsp + ((size_t)g * 128 + p) * 128 + q0; const f32x4 w0 = *(const f32x4*)wp, w1 = *(const f32x4*)(wp + 4);
                    bf16x8 wf; { u32x4 t; t.x = cvt_pk_bf16(w0[0], w0[1]); t.y = cvt_pk_bf16(w0[2], w0[3]); t.z = cvt_pk_bf16(w1[0], w1[1]); t.w = cvt_pk_bf16(w1[2], w1[3]); wf = __builtin_bit_cast(bf16x8, t); }
                    float vn[8];
#pragma unroll
                    for (int j = 0; j < 8; ++j) { const int q = q0 + j; const float vv = bf2f(z[(size_t)(row0 + q) * 2048 + 1024 + ch]); vn[j] = (vv - st_mean[q]) * st_rstd[q] * lg + lb; }
                    bf16x8 vf; { u32x4 t; t.x = cvt_pk_bf16(vn[0], vn[1]); t.y = cvt_pk_bf16(vn[2], vn[3]); t.z = cvt_pk_bf16(vn[4], vn[5]); t.w = cvt_pk_bf16(vn[6], vn[7]); vf = __builtin_bit_cast(bf16x8, t); }
                    acc = __builtin_amdgcn_mfma_f32_16x16x32_bf16(vf, wf, acc, 0, 0, 0);
                }
                const float bias = bs[g * 128 + p]; const int c0 = g * 128 + ct * 16 + 4 * fq;
                const u32x2 uu = *(const u32x2*)(z + (size_t)(row0 + p) * 2048 + c0);
                u32x2 o; o.x = cvt_pk_bf16(bf_lo(uu.x) * (acc[0] + bias), bf_hi(uu.x) * (acc[1] + bias)); o.y = cvt_pk_bf16(bf_lo(uu.y) * (acc[2] + bias), bf_hi(uu.y) * (acc[3] + bias));
                *(u32x2*)(A2 + (size_t)(row0 + p) * D + c0) = o;
            }
        }
    }
}

constexpr int NPHASES = 2 + 9 * DEPTH;
__device__ __forceinline__ void ph_prologue() { PHASE_ENTER(); phase_prologue(a, lds, tid, bx, G); }
__device__ __forceinline__ void ph_rp_init() { PHASE_ENTER(); float* mod = (float*)(ws + WS_MOD);
    RowPass p{}; p.xin = a.in[I_X]; p.hout = (bf16*)(ws + WS_H); p.sc = mod + 1 * 1024; p.sh = mod + 0 * 1024; p.wside = (const bf16*)(ws + WS_GLALR_T); p.lr_out = (float*)(ws + WS_LR); p.has_h = 1; p.has_side = 1;
    row_pass<0>(p, lds, tid, bx, G); }
__device__ __forceinline__ void ph_gla_in(int li) { PHASE_ENTER(); Sched S; S.init(T / 256, GLA_MAIN / 256, G, bx, (const bf16*)(ws + WS_GLAIN_T) + (size_t)li * GLA_MAIN * 1024, 0, nullptr, 1024); EpiGlaIn E{(bf16*)(ws + WS_BIG)}; gemm_naive((const bf16*)(ws + WS_H), nullptr, 1024, S, E, tid); }
__device__ __forceinline__ void ph_sgu_in(int li) { PHASE_ENTER(); Sched S; S.init(T / 256, 2048 / 256, G, bx, (const bf16*)(ws + WS_SGUIN_T) + (size_t)li * 2048 * 1024, 0, nullptr, 1024); EpiSguIn E{(bf16*)(ws + WS_BIG), a.in[I_SBIN] + (size_t)li * 2048}; gemm_naive((const bf16*)(ws + WS_H), nullptr, 1024, S, E, tid); }
__device__ __forceinline__ void ph_gla_scan(int li) { PHASE_ENTER(); phase_gla_scan_naive(a, li, lds, tid, bx, G); }
__device__ __forceinline__ void ph_sgu_core(int li) { PHASE_ENTER(); phase_sgu_naive(a, li, lds, tid, bx, G); }
__device__ __forceinline__ void ph_gla_post(int li) { PHASE_ENTER(); phase_gla_post(a, li, tid, bx, G); }
__device__ __forceinline__ void ph_out(int l) { PHASE_ENTER(); const int li = l >> 1; const bool sgu = (l & 1) != 0;
    Sched S; S.init(T / 256, 4, G, bx, (const bf16*)(ws + (sgu ? WS_SGUOUT_T : WS_GLAOUT_T)) + (size_t)li * 1024 * 1024, 0, nullptr, 1024);
    EpiOut E{(float*)(ws + WS_Y), sgu ? a.in[I_SBOUT] + (size_t)li * 1024 : nullptr}; gemm_naive((const bf16*)(ws + WS_A2), nullptr, 1024, S, E, tid); }
__device__ __forceinline__ void ph_rp_mid(int l) { PHASE_ENTER(); float* modl = (float*)(ws + WS_MOD) + (size_t)l * 8 * 6144; int* route = (int*)(ws + WS_ROUTE);
    RowPass p{}; p.xin = (l == 0) ? a.in[I_X] : (const float*)(ws + WS_X2); p.y = (const float*)(ws + WS_Y); p.xout = (float*)(ws + WS_X1); p.hout = (bf16*)(ws + WS_H);
    p.gate = modl + 2 * 1024; p.lng = a.in[I_LNG] + (size_t)(l * 2 + 0) * 1024; p.lnb = a.in[I_LNB] + (size_t)(l * 2 + 0) * 1024; p.sc = modl + 4 * 1024; p.sh = modl + 3 * 1024;
    p.wside = (const bf16*)(ws + WS_ROUTER_T) + (size_t)l * 64 * 1024; p.rbias = a.in[I_RB] + (size_t)l * 32;
    p.topi = route + R_TOPI; p.topw = (float*)(route + R_TOPW); p.hist = route + R_HIST + bx * 32; p.has_h = 1; p.has_side = 1;
    row_pass<1>(p, lds, tid, bx, G); }
__device__ __forceinline__ void ph_place() { PHASE_ENTER(); phase_place((int*)(ws + WS_ROUTE), lds, tid, bx, G); }
__device__ __forceinline__ void ph_moe_up(int l) { PHASE_ENTER(); int* route = (int*)(ws + WS_ROUTE); const int ntiles = route[R_NTILES];
    Sched S; S.init(ntiles, 8, G, bx, (const bf16*)(ws + WS_WUP_T) + (size_t)l * 32 * 2048 * 1024, (size_t)2048 * 1024, route + R_TILEE, 1024);
    EpiUp E{(bf16*)(ws + WS_ACT), a.in[I_BUP] + (size_t)l * 32 * 2048}; gemm_naive((const bf16*)(ws + WS_H), route + R_BUFTOK, 1024, S, E, tid); }
__device__ __forceinline__ void ph_moe_down(int l) { PHASE_ENTER(); int* route = (int*)(ws + WS_ROUTE); const int ntiles = route[R_NTILES];
    Sched S; S.init(ntiles, 4, G, bx, (const bf16*)(ws + WS_WDN_T) + (size_t)l * 32 * 1024 * 1024, (size_t)1024 * 1024, route + R_TILEE, 1024);
    EpiDown E{(bf16*)(ws + WS_YS), a.in[I_BDN] + (size_t)l * 32 * 1024}; gemm_naive((const bf16*)(ws + WS_ACT), nullptr, 1024, S, E, tid); }
__device__ __forceinline__ void ph_rp_end(int l) { PHASE_ENTER(); float* mod = (float*)(ws + WS_MOD); float* modl = mod + (size_t)l * 8 * 6144; int* route = (int*)(ws + WS_ROUTE);
    RowPass p{}; p.xin = (const float*)(ws + WS_X1); p.xout = (l == DEPTH - 1) ? a.out : (float*)(ws + WS_X2); p.hout = (bf16*)(ws + WS_H);
    p.gate = modl + 5 * 1024; p.lng = a.in[I_LNG] + (size_t)(l * 2 + 1) * 1024; p.lnb = a.in[I_LNB] + (size_t)(l * 2 + 1) * 1024;
    p.ys = (const bf16*)(ws + WS_YS); p.dest = route + R_DEST; p.tw = (const float*)(route + R_TOPW);
    if (l < DEPTH - 1) { float* modn = mod + (size_t)(l + 1) * 8 * 6144; p.sc = modn + 1 * 1024; p.sh = modn + 0 * 1024; p.has_h = 1;
        if (((l + 1) & 1) == 0) { p.has_side = 1; p.wside = (const bf16*)(ws + WS_GLALR_T) + (size_t)((l + 1) >> 1) * 64 * 1024; p.lr_out = (float*)(ws + WS_LR); } }
    row_pass<2>(p, lds, tid, bx, G); }

__global__ void __launch_bounds__(NTHREADS, 2) fwd_kernel(Args a) {
    extern __shared__ __attribute__((aligned(16))) unsigned char lds_raw[];
    LAS unsigned char* lds = (LAS unsigned char*)lds_raw;
    volatile LAS unsigned* MISC = (volatile LAS unsigned*)(lds + MISC_OFF);
    const int tid = threadIdx.x;
    if (tid < 32) ((LAS unsigned*)(lds + MISC_OFF))[tid] = 0u;
    __syncthreads();
    unsigned* ctl = (unsigned*)(a.ws + WS_CTL);
    XcdBarrier bar = xcd_barrier_post(ctl + CW_BAR + a.li * XCD_BAR_WORDS, MISC + 8);
    const int lo = a.ph_lo, hi = a.ph_hi;
#define IN(k) (lo <= (k) && (k) < hi)
#define SEAM(k) do { if (IN(k) && IN((k) + 1)) xcd_barrier(bar); } while (0)
    if (IN(0)) { ph_prologue(); SEAM(0); }
    if (IN(1)) { ph_rp_init(); SEAM(1); }
    for (int l = 0; l < DEPTH; ++l) {
        const int pb = 2 + 9 * l, li = l >> 1; const bool sgu = (l & 1) != 0;
        if (IN(pb + 0)) { if (!sgu) ph_gla_in(li); else ph_sgu_in(li); SEAM(pb + 0); }
        if (IN(pb + 1)) { if (!sgu) ph_gla_scan(li); else ph_sgu_core(li); SEAM(pb + 1); }
        if (IN(pb + 2)) { if (!sgu) { ph_gla_post(li); SEAM(pb + 2); } }
        if (IN(pb + 3)) { ph_out(l); SEAM(pb + 3); }
        if (IN(pb + 4)) { ph_rp_mid(l); SEAM(pb + 4); }
        if (IN(pb + 5)) { ph_place(); SEAM(pb + 5); }
        if (IN(pb + 6)) { ph_moe_up(l); SEAM(pb + 6); }
        if (IN(pb + 7)) { ph_moe_down(l); SEAM(pb + 7); }
        if (IN(pb + 8)) { ph_rp_end(l); SEAM(pb + 8); }
    }
#undef IN
#undef SEAM
}

#ifndef N_LAUNCH_MODE
#define N_LAUNCH_MODE 1
#endif
extern "C" void kernel_launch(void* const* d_in, const int* in_sizes, int n_in, void* d_out, int out_size, void* d_ws, size_t ws_size, hipStream_t stream) {
    static int grid = 0;
    if (grid == 0) {
        if (n_in != 27 || out_size != T * D || ws_size < WS_END) { fprintf(stderr, "kernel_launch: unexpected shapes (n_in %d out %d ws %zu)\n", n_in, out_size, ws_size); grid = -1; return; }
        int dev = 0, cus = 0, per_cu = 0;
        if (hipGetDevice(&dev) != hipSuccess || hipDeviceGetAttribute(&cus, hipDeviceAttributeMultiprocessorCount, dev) != hipSuccess) { grid = -1; return; }
        if (hipFuncSetAttribute((const void*)fwd_kernel, hipFuncAttributeMaxDynamicSharedMemorySize, LDS_BYTES) != hipSuccess) { fprintf(stderr, "kernel_launch: hipFuncSetAttribute failed\n"); grid = -1; return; }
        if (hipOccupancyMaxActiveBlocksPerMultiprocessor(&per_cu, (const void*)fwd_kernel, NTHREADS, LDS_BYTES) != hipSuccess || per_cu < 1) fprintf(stderr, "kernel_launch: occupancy query reports %d\n", per_cu);
        (void)hipGetLastError();
        grid = cus;
        if (grid > 1024) grid = 1024;
    }
    if (grid < 0) return;
    (void)hipMemsetAsync((char*)d_ws + WS_CTL, 0, CTL_ZERO_BYTES, stream);
    Args a{};
    for (int i = 0; i < 27; ++i) a.in[i] = (const float*)d_in[i];
    a.out = (float*)d_out; a.ws = (unsigned char*)d_ws; a.pad = 0;
#if N_LAUNCH_MODE == 1
    a.ph_lo = 0; a.ph_hi = NPHASES; a.li = 0;
    hipLaunchKernelGGL(fwd_kernel, dim3(grid), dim3(NTHREADS), LDS_BYTES, stream, a);
#else
    for (int ph = 0, li = 0; ph < NPHASES; ++ph) {
        if (ph >= 2 && ((ph - 2) % 9) == 2 && (((ph - 2) / 9) & 1)) continue;
        a.ph_lo = ph; a.ph_hi = ph + 1; a.li = li++;
        hipLaunchKernelGGL(fwd_kernel, dim3(grid), dim3(NTHREADS), LDS_BYTES, stream, a);
    }
#endif
}
```

```cpp
#include <hip/hip_runtime.h>
#include <cstdio>
#include <cstdint>

#define LAS __attribute__((address_space(3)))
#define GAS __attribute__((address_space(1)))
typedef unsigned short bf16;
typedef short bf16x8 __attribute__((ext_vector_type(8)));
typedef float f32x4 __attribute__((ext_vector_type(4)));
typedef float f32x2 __attribute__((ext_vector_type(2)));
typedef unsigned u32x4 __attribute__((ext_vector_type(4)));
typedef unsigned u32x2 __attribute__((ext_vector_type(2)));

constexpr int D = 1024, NB = 8, SEQ = 4096, T = NB * SEQ, DEPTH = 4;
constexpr int NE = 32, TOPK = 4, CAP = T * TOPK + NE * 256;
constexpr int MAXTILES = CAP / 256;
constexpr float ALPHA = 1.681792830507429f;
constexpr float LN_EPS = 1e-5f;
constexpr int GLA_IN = 3104, GLA_MAIN = 3072;
constexpr int NWAVES = 8, NTHREADS = 512;
constexpr int LDS_BYTES = 147456, MISC_OFF = 139264;

constexpr size_t MiB = 1u << 20;
constexpr size_t WS_CTL = 0, CTL_ZERO_BYTES = 2 * MiB;
constexpr size_t WS_MOD = 2 * MiB;
constexpr size_t WS_ROUTE = 4 * MiB;
constexpr size_t WS_LR = 8 * MiB;
constexpr size_t WS_GLAIN_T = 16 * MiB;
constexpr size_t WS_GLALR_T = 28 * MiB;
constexpr size_t WS_ROUTER_T = 29 * MiB;
constexpr size_t WS_SGUWS = 30 * MiB;
constexpr size_t WS_GLAOUT_T = 32 * MiB;
constexpr size_t WS_SGUIN_T = 36 * MiB;
constexpr size_t WS_SGUOUT_T = 44 * MiB;
constexpr size_t WS_WUP_T = 64 * MiB;
constexpr size_t WS_WDN_T = 576 * MiB;
constexpr size_t WS_X1 = 832 * MiB;
constexpr size_t WS_X2 = 960 * MiB;
constexpr size_t WS_H = 1088 * MiB;
constexpr size_t WS_BIG = 1152 * MiB;
constexpr size_t WS_OF = 1344 * MiB;
constexpr size_t WS_OB = 1408 * MiB;
constexpr size_t WS_A2 = 1472 * MiB;
constexpr size_t WS_Y = 1536 * MiB;
constexpr size_t WS_ACT = 1664 * MiB;
constexpr size_t WS_YS = 1936 * MiB;
constexpr size_t WS_END = 2208 * MiB;
constexpr int R_TOPI = 0;
constexpr int R_TOPW = T * 4;
constexpr int R_DEST = 2 * T * 4;
constexpr int R_BUFTOK = 3 * T * 4;
constexpr int R_HIST = R_BUFTOK + CAP;
constexpr int R_TILEE = R_HIST + 1024 * 32;
constexpr int R_NTILES = R_TILEE + 1024;
static_assert((size_t)(R_NTILES + 64) * 4 <= 4 * MiB, "route tables");
constexpr int CW_BAR = 4096;
constexpr int MAX_LAUNCH = 64;

#define RLX_AGENT __ATOMIC_RELAXED, __HIP_MEMORY_SCOPE_AGENT
#define LDS_WAIT() asm volatile("s_waitcnt lgkmcnt(0)" ::: "memory")
#define VM_WAIT() asm volatile("s_waitcnt vmcnt(0)" ::: "memory")
__device__ __forceinline__ unsigned cvt_pk_bf16(float lo, float hi) { unsigned r; asm volatile("v_cvt_pk_bf16_f32 %0, %1, %2" : "=v"(r) : "v"(lo), "v"(hi)); return r; }
__device__ __forceinline__ float bf_lo(unsigned w) { return __uint_as_float(w << 16); }
__device__ __forceinline__ float bf_hi(unsigned w) { return __uint_as_float(w & 0xffff0000u); }
__device__ __forceinline__ float bf2f(bf16 b) { return __uint_as_float(((unsigned)b) << 16); }
__device__ __forceinline__ float wave_sum(float v) {
#pragma unroll
    for (int o = 1; o < 64; o <<= 1) v += __shfl_xor(v, o);
    return v;
}
__device__ __forceinline__ float silu_f(float x) { return x / (1.0f + __expf(-x)); }
__device__ __forceinline__ float sigmoid_f(float x) { return 1.0f / (1.0f + __expf(-x)); }
__device__ __forceinline__ float gelu_f(float v) {
    const float av = fabsf(v), t = __builtin_amdgcn_rcpf(av * 0.2316418882f + 1.0f);
    float q = t * 0.5307027145f + (-0.7265760135f); q = q * t + 0.7107068705f; q = q * t + (-0.142248368f); q = q * t + 0.127414796f; q = q * t;
    const float e = __builtin_amdgcn_exp2f((v * v) * (-0.72134752044f));
    const float m = v * (q * e);
    return v < 0.f ? m : v - m;
}

#define XB_TMO      128
#define XB_XCNT(j)  (256  + 64 * (j))
#define XB_XSUB(j)  (1280 + 64 * (j))
#define XB_XGEN(j)  (2304 + 64 * (j))
#define XB_TOP      3328
#define XB_TOPGEN   3392
#define XCD_BAR_WORDS 3456
#define XB_SPIN_CAP (1u << 18)
__device__ __forceinline__ unsigned xb_ld(unsigned* p)              { return __hip_atomic_load(p, __ATOMIC_RELAXED, __HIP_MEMORY_SCOPE_AGENT); }
__device__ __forceinline__ unsigned xb_add(unsigned* p, unsigned v) { return __hip_atomic_fetch_add(p, v, __ATOMIC_RELAXED, __HIP_MEMORY_SCOPE_AGENT); }
__device__ __forceinline__ unsigned xb_xcc_id() { return (unsigned)__builtin_amdgcn_s_getreg((3 << 11) | 20) & 0xFu; }
#define XB_SPIN(cond, bar) do { unsigned _sp = 0; while (cond) { __builtin_amdgcn_s_sleep(1); \
    if ((++_sp & 255u) == 0u) { if (xb_ld(&(bar)[XB_TMO])) break; if (_sp > XB_SPIN_CAP) { atomicAdd(&(bar)[XB_TMO], 1u); break; } } } } while (0)
struct XcdBarrier { unsigned* bar; unsigned x; volatile LAS unsigned* st; };
__device__ __forceinline__ XcdBarrier xcd_barrier_post(unsigned* bar, volatile LAS unsigned* st) {
    XcdBarrier b; b.bar = bar; b.x = xb_xcc_id(); b.st = st;
    if (threadIdx.x == 0) (void)xb_add(&bar[XB_XCNT(b.x)], 1u);
    return b;
}
__device__ __forceinline__ void xcd_barrier_complete(unsigned* bar, unsigned x, unsigned& nloc, unsigned& nx) {
    const unsigned G = gridDim.x * gridDim.y * gridDim.z;
    unsigned sum, cnt, mine, sp = 0u;
    for (;;) {
        sum = 0u; cnt = 0u; mine = 0u;
#pragma unroll
        for (unsigned j = 0; j < 16; ++j) { const unsigned c = xb_ld(&bar[XB_XCNT(j)]); sum += c; cnt += (c > 0u) ? 1u : 0u; mine = (j == x) ? c : mine; }
        if (sum == G) break;
        __builtin_amdgcn_s_sleep(1);
        if ((++sp & 255u) == 0u) { if (xb_ld(&bar[XB_TMO])) break; if (sp > XB_SPIN_CAP) { atomicAdd(&bar[XB_TMO], 1u); break; } }
    }
    nloc = mine > 0u ? mine : 1u; nx = cnt > 0u ? cnt : 1u;
}
__device__ __forceinline__ void xcd_barrier(const XcdBarrier& b) {
    asm volatile("s_waitcnt vmcnt(0)" ::: "memory");
    __syncthreads();
    if (threadIdx.x == 0) {
        unsigned* bar = b.bar;
        __builtin_amdgcn_s_waitcnt(0);
        unsigned nloc = b.st[0], nx = b.st[1];
        if (nloc == 0u) { xcd_barrier_complete(bar, b.x, nloc, nx); b.st[0] = nloc; b.st[1] = nx; }
        const unsigned old = xb_add(&bar[XB_XSUB(b.x)], 1u);
        const unsigned gen = old / nloc;
        if (old + 1u == (gen + 1u) * nloc) {
            __builtin_amdgcn_fence(__ATOMIC_RELEASE, "agent");
            asm volatile("s_waitcnt vmcnt(0)" ::: "memory");
            const unsigned og = xb_add(&bar[XB_TOP], 1u);
            const unsigned tg = og / nx;
            if (og + 1u == (tg + 1u) * nx) xb_add(&bar[XB_TOPGEN], 1u);
            else XB_SPIN(xb_ld(&bar[XB_TOPGEN]) == tg, bar);
            __builtin_amdgcn_fence(__ATOMIC_ACQUIRE, "agent");
            xb_add(&bar[XB_XGEN(b.x)], 1u);
            asm volatile("s_waitcnt vmcnt(0)" ::: "memory");
        } else {
            XB_SPIN(xb_ld(&bar[XB_XGEN(b.x)]) == gen, bar);
            __builtin_amdgcn_fence(__ATOMIC_ACQUIRE, "agent");
            asm volatile("s_waitcnt vmcnt(0)" ::: "memory");
        }
    }
    __syncthreads();
}

struct Args { const float* in[27]; float* out; unsigned char* ws; int ph_lo, ph_hi, li, pad; };
enum { I_X = 0, I_C, I_ADAW, I_ADAB, I_LNG, I_LNB, I_GWIN, I_GWG2F, I_GBGF, I_GWG2B, I_GBGB, I_GNORM, I_GWOUT, I_SWIN, I_SBIN, I_SLNG, I_SLNB, I_SWS, I_SBS, I_SWOUT, I_SBOUT, I_RW, I_RB, I_WUP, I_BUP, I_WDN, I_BDN };

typedef const __attribute__((address_space(4))) Args* KA;
#define PHASE_ENTER() int tid = (wave_s << 6) | (int)__builtin_amdgcn_mbcnt_hi(~0u, __builtin_amdgcn_mbcnt_lo(~0u, 0u)); asm volatile("" : "+v"(tid)); int bx = blockIdx.x, G = gridDim.x; asm volatile("" : "+s"(bx), "+s"(G)); \
    KA a = (KA)__builtin_amdgcn_kernarg_segment_ptr(); asm volatile("" : "+s"(a)); unsigned char* ws = a->ws; \
    extern __shared__ __attribute__((aligned(16))) unsigned char lds_raw[]; LAS unsigned char* lds = (LAS unsigned char*)lds_raw; (void)lds; (void)ws; (void)bx; (void)G; (void)tid
__device__ __forceinline__ int swiglu_perm(int o) {
    const int a = o >> 1, h = o & 1, pn = a >> 7, r = a & 127, bj = r >> 6, r2 = r & 63, wc = r2 >> 4, r3 = r2 & 15;
    return 256 * pn + 128 * bj + 32 * wc + 16 * h + r3;
}
__device__ __forceinline__ void conv_tile(const float* W, int K, int N, int k0, int n0, int nw, bf16* dst, int mode, LAS float* scr, int lane) {
    const int c4 = lane & 15, kr = lane >> 4;
    if (4 * c4 < nw) {
#pragma unroll 4
        for (int i = 0; i < 16; ++i) { const int kk = 4 * i + kr; const f32x4 v = *(const f32x4*)(W + (size_t)(k0 + kk) * N + n0 + 4 * c4);
            LAS float* s = scr + kk * 65 + 4 * c4; s[0] = v[0]; s[1] = v[1]; s[2] = v[2]; s[3] = v[3]; }
    }
    LDS_WAIT(); asm volatile("" ::: "memory");
    const int kc = lane & 7, ns = lane >> 3;
    for (int j = 0; j < nw / 8; ++j) {
        const int n = ns + 8 * j; const LAS float* s = scr + (8 * kc) * 65 + n;
        float v[8];
#pragma unroll
        for (int q = 0; q < 8; ++q) v[q] = s[q * 65];
        u32x4 o; o.x = cvt_pk_bf16(v[0], v[1]); o.y = cvt_pk_bf16(v[2], v[3]); o.z = cvt_pk_bf16(v[4], v[5]); o.w = cvt_pk_bf16(v[6], v[7]);
        const int ng = n0 + n;
        if (mode == 2) {
            *(u32x4*)(dst + (size_t)n * K + k0 + 8 * kc) = o;
            u32x4 l; l.x = cvt_pk_bf16(v[0] - bf_lo(o.x), v[1] - bf_hi(o.x)); l.y = cvt_pk_bf16(v[2] - bf_lo(o.y), v[3] - bf_hi(o.y));
            l.z = cvt_pk_bf16(v[4] - bf_lo(o.z), v[5] - bf_hi(o.z)); l.w = cvt_pk_bf16(v[6] - bf_lo(o.w), v[7] - bf_hi(o.w));
            *(u32x4*)(dst + (size_t)(32 + n) * K + k0 + 8 * kc) = l;
        } else {
            const int row = (mode == 1) ? swiglu_perm(ng) : ng;
            *(u32x4*)(dst + (size_t)row * K + k0 + 8 * kc) = o;
        }
    }
    LDS_WAIT(); asm volatile("" ::: "memory");
}

__device__ __forceinline__ void phase_prologue(KA a, LAS unsigned char* lds, int tid, int bx, int G) {
    const int lane = tid & 63, wave = __builtin_amdgcn_readfirstlane(tid >> 6);
    unsigned char* ws = a->ws;
    for (int slab = bx; slab < 192; slab += G) {
        LAS float* sc = (LAS float*)lds;
        LAS float* red = (LAS float*)(lds + 32768);
        for (int i = tid; i < 8 * 1024; i += NTHREADS) sc[i] = silu_f(a->in[I_C][i]);
        __syncthreads();
        const int g0 = slab * 128, l = g0 / 6144, e0 = g0 % 6144;
        const int c4 = tid & 31, seg = tid >> 5;
        f32x4 acc[8];
#pragma unroll
        for (int b = 0; b < 8; ++b) acc[b] = (f32x4){0.f, 0.f, 0.f, 0.f};
        const float* wp = a->in[I_ADAW] + ((size_t)l * 1024 + seg * 64) * 6144 + e0 + 4 * c4;
#pragma unroll 8
        for (int d = 0; d < 64; ++d) { const f32x4 w = *(const f32x4*)(wp + (size_t)d * 6144);
#pragma unroll
            for (int b = 0; b < 8; ++b) acc[b] += w * sc[b * 1024 + seg * 64 + d]; }
#pragma unroll
        for (int b = 0; b < 8; ++b) *(LAS f32x4*)(red + (seg * 8 + b) * 128 + 4 * c4) = acc[b];
        __syncthreads();
        for (int o = tid; o < 1024; o += NTHREADS) { const int b = o >> 7, c = o & 127; float s = a->in[I_ADAB][l * 6144 + e0 + c];
#pragma unroll
            for (int sg = 0; sg < 16; ++sg) s += red[(sg * 8 + b) * 128 + c];
            ((float*)(ws + WS_MOD))[((size_t)l * 8 + b) * 6144 + e0 + c] = s; }
        __syncthreads();
    }
    LAS float* scr = (LAS float*)(lds + wave * 16640);
    const int gw = bx * NWAVES + wave, NGW = G * NWAVES;
    constexpr int N_UP = 128 * 16 * 32, N_DN = 128 * 16 * 16, N_GIN = 2 * 16 * 48, N_GLR = 2 * 16, N_GOUT = 2 * 256, N_SIN = 2 * 16 * 32, N_SOUT = 2 * 256, N_RT = 4 * 16;
    constexpr int NITEMS = N_UP + N_DN + N_GIN + N_GLR + N_GOUT + N_SIN + N_SOUT + N_RT;
    for (int it = gw; it < NITEMS; it += NGW) {
        int r = it;
        if (r < N_UP) { const int m = r >> 9, q = r & 511, kt = q >> 5, nt = q & 31;
            conv_tile(a->in[I_WUP] + (size_t)m * 1024 * 2048, 1024, 2048, kt * 64, nt * 64, 64, (bf16*)(ws + WS_WUP_T) + (size_t)m * 2048 * 1024, 1, scr, lane); continue; } r -= N_UP;
        if (r < N_DN) { const int m = r >> 8, q = r & 255, kt = q >> 4, nt = q & 15;
            conv_tile(a->in[I_WDN] + (size_t)m * 1024 * 1024, 1024, 1024, kt * 64, nt * 64, 64, (bf16*)(ws + WS_WDN_T) + (size_t)m * 1024 * 1024, 0, scr, lane); continue; } r -= N_DN;
        if (r < N_GIN) { const int m = r / 768, q = r % 768, kt = q / 48, nt = q % 48;
            conv_tile(a->in[I_GWIN] + (size_t)m * 1024 * GLA_IN, 1024, GLA_IN, kt * 64, nt * 64, 64, (bf16*)(ws + WS_GLAIN_T) + (size_t)m * GLA_MAIN * 1024, 0, scr, lane); continue; } r -= N_GIN;
        if (r < N_GLR) { const int m = r >> 4, kt = r & 15;
            conv_tile(a->in[I_GWIN] + (size_t)m * 1024 * GLA_IN, 1024, GLA_IN, kt * 64, GLA_MAIN, 32, (bf16*)(ws + WS_GLALR_T) + (size_t)m * 64 * 1024, 2, scr, lane); continue; } r -= N_GLR;
        if (r < N_GOUT) { const int m = r >> 8, q = r & 255, kt = q >> 4, nt = q & 15;
            conv_tile(a->in[I_GWOUT] + (size_t)m * 1024 * 1024, 1024, 1024, kt * 64, nt * 64, 64, (bf16*)(ws + WS_GLAOUT_T) + (size_t)m * 1024 * 1024, 0, scr, lane); continue; } r -= N_GOUT;
        if (r < N_SIN) { const int m = r >> 9, q = r & 511, kt = q >> 5, nt = q & 31;
            conv_tile(a->in[I_SWIN] + (size_t)m * 1024 * 2048, 1024, 2048, kt * 64, nt * 64, 64, (bf16*)(ws + WS_SGUIN_T) + (size_t)m * 2048 * 1024, 0, scr, lane); continue; } r -= N_SIN;
        if (r < N_SOUT) { const int m = r >> 8, q = r & 255, kt = q >> 4, nt = q & 15;
            conv_tile(a->in[I_SWOUT] + (size_t)m * 1024 * 1024, 1024, 1024, kt * 64, nt * 64, 64, (bf16*)(ws + WS_SGUOUT_T) + (size_t)m * 1024 * 1024, 0, scr, lane); continue; } r -= N_SOUT;
        { const int m = r >> 4, kt = r & 15;
            conv_tile(a->in[I_RW] + (size_t)m * 1024 * 32, 1024, 32, kt * 64, 0, 32, (bf16*)(ws + WS_ROUTER_T) + (size_t)m * 64 * 1024, 2, scr, lane); }
    }
    { bf16* d = (bf16*)(ws + WS_SGUWS); const float* s = a->in[I_SWS];
      for (int i = (bx * NTHREADS + tid) * 4; i < 2 * 8 * 128 * 128; i += G * NTHREADS * 4) { const f32x4 v = *(const f32x4*)(s + i); u32x2 o; o.x = cvt_pk_bf16(v[0], v[1]); o.y = cvt_pk_bf16(v[2], v[3]); *(u32x2*)(d + i) = o; } }
}

struct RowPass {
    const float* xin; const float* y; float* xout; bf16* hout;
    const float* gate; const float* lng; const float* lnb; const float* sc; const float* sh;
    const bf16* wside;
    float* lr_out;
    const float* rbias;
    int* topi; float* topw; int* hist;
    const bf16* ys; const int* dest; const float* tw;
    int has_h, has_side;
};
template <int MODE>
__device__ __forceinline__ void row_pass(const RowPass& p, LAS unsigned char* lds, int tid, int bx, int G) {
    const int lane = tid & 63, wave = __builtin_amdgcn_readfirstlane(tid >> 6);
    constexpr int HS = 1032;
    LAS bf16* Hhi = (LAS bf16*)lds;
    LAS bf16* Hlo = (LAS bf16*)(lds + 16 * HS * 2);
    LAS float* part = (LAS float*)(lds + 2 * 16 * HS * 2);
    LAS float* logit = part + 8 * 32 * 16;
    LAS int* lhist = (LAS int*)(logit + 16 * 32);
    if (MODE == 1) { if (tid < 32) lhist[tid] = 0; }
    const bool side = (p.has_side != 0) && (p.wside != nullptr);
    bf16x8 whi[2][4], wlo[2][4];
    if (side) {
#pragma unroll
        for (int hf = 0; hf < 2; ++hf)
#pragma unroll
            for (int s = 0; s < 4; ++s) { const size_t off = (size_t)(hf * 16 + (lane & 15)) * 1024 + 128 * wave + 32 * s + 8 * (lane >> 4);
                whi[hf][s] = *(const bf16x8*)(p.wside + off); wlo[hf][s] = *(const bf16x8*)(p.wside + 32 * 1024 + off); }
    }
    for (int tile = bx; tile < T / 16; tile += G) {
        const int b = (tile * 16) / SEQ;
#pragma unroll 1
        for (int tt = 0; tt < 2; ++tt) {
            const int tl = 2 * wave + tt, token = tile * 16 + tl;
            f32x4 v[4];
            const float* xr = p.xin + (size_t)token * D + 4 * lane;
#pragma unroll
            for (int j = 0; j < 4; ++j) v[j] = *(const f32x4*)(xr + 256 * j);
            if (MODE == 1) {
                const float* yr = p.y + (size_t)token * D + 4 * lane; const float* gp = p.gate + (size_t)b * 6144 + 4 * lane;
#pragma unroll
                for (int j = 0; j < 4; ++j) { const f32x4 yy = *(const f32x4*)(yr + 256 * j); const f32x4 g = *(const f32x4*)(gp + 256 * j); v[j] = v[j] * ALPHA + (g + 1.0f) * yy; }
            }
            if (MODE == 2) {
                f32x4 ya[4];
#pragma unroll
                for (int j = 0; j < 4; ++j) ya[j] = (f32x4){0.f, 0.f, 0.f, 0.f};
#pragma unroll
                for (int k = 0; k < 4; ++k) { const int ds = p.dest[token * 4 + k]; const float w = p.tw[token * 4 + k]; const bf16* yr = p.ys + (size_t)ds * D + 4 * lane;
#pragma unroll
                    for (int j = 0; j < 4; ++j) { const u32x2 q = *(const u32x2*)(yr + 256 * j); ya[j] += (f32x4){bf_lo(q.x), bf_hi(q.x), bf_lo(q.y), bf_hi(q.y)} * w; } }
                const float* gp = p.gate + (size_t)b * 6144 + 4 * lane;
#pragma unroll
                for (int j = 0; j < 4; ++j) { const f32x4 g = *(const f32x4*)(gp + 256 * j); v[j] = v[j] * ALPHA + (g + 1.0f) * ya[j]; }
            }
            if (MODE != 0) {
                float s = 0.f;
#pragma unroll
                for (int j = 0; j < 4; ++j) s += (v[j][0] + v[j][1]) + (v[j][2] + v[j][3]);
                const float mean = wave_sum(s) * (1.0f / D); float s2 = 0.f;
#pragma unroll
                for (int j = 0; j < 4; ++j) { v[j] = v[j] - mean; s2 += (v[j][0] * v[j][0] + v[j][1] * v[j][1]) + (v[j][2] * v[j][2] + v[j][3] * v[j][3]); }
                const float rstd = 1.0f / sqrtf(wave_sum(s2) * (1.0f / D) + LN_EPS);
                float* xo = p.xout + (size_t)token * D + 4 * lane;
#pragma unroll
                for (int j = 0; j < 4; ++j) { const f32x4 g = *(const f32x4*)(p.lng + 4 * lane + 256 * j), bb = *(const f32x4*)(p.lnb + 4 * lane + 256 * j); v[j] = v[j] * rstd * g + bb; *(f32x4*)(xo + 256 * j) = v[j]; }
            }
            if (p.has_h) {
                const float* scp = p.sc + (size_t)b * 6144 + 4 * lane; const float* shp = p.sh + (size_t)b * 6144 + 4 * lane;
                bf16* ho = p.hout + (size_t)token * D + 4 * lane;
#pragma unroll
                for (int j = 0; j < 4; ++j) { const f32x4 s1 = *(const f32x4*)(scp + 256 * j), s0 = *(const f32x4*)(shp + 256 * j); const f32x4 h = v[j] * (s1 + 1.0f) + s0;
                    u32x2 o; o.x = cvt_pk_bf16(h[0], h[1]); o.y = cvt_pk_bf16(h[2], h[3]); *(u32x2*)(ho + 256 * j) = o;
                    if (side) { u32x2 l; l.x = cvt_pk_bf16(h[0] - bf_lo(o.x), h[1] - bf_hi(o.x)); l.y = cvt_pk_bf16(h[2] - bf_lo(o.y), h[3] - bf_hi(o.y));
                        *(LAS u32x2*)(Hhi + tl * HS + 4 * lane + 256 * j) = o; *(LAS u32x2*)(Hlo + tl * HS + 4 * lane + 256 * j) = l; } }
            }
        }
        if (side) {
            __syncthreads();
            f32x4 acc[2]; acc[0] = (f32x4){0.f, 0.f, 0.f, 0.f}; acc[1] = acc[0];
#pragma unroll
            for (int s = 0; s < 4; ++s) { const int ko = (lane & 15) * HS + 128 * wave + 32 * s + 8 * (lane >> 4);
                const bf16x8 bh = *(const LAS bf16x8*)(Hhi + ko), bl = *(const LAS bf16x8*)(Hlo + ko);
#pragma unroll
                for (int hf = 0; hf < 2; ++hf) { acc[hf] = __builtin_amdgcn_mfma_f32_16x16x32_bf16(whi[hf][s], bh, acc[hf], 0, 0, 0);
                    acc[hf] = __builtin_amdgcn_mfma_f32_16x16x32_bf16(wlo[hf][s], bh, acc[hf], 0, 0, 0); acc[hf] = __builtin_amdgcn_mfma_f32_16x16x32_bf16(whi[hf][s], bl, acc[hf], 0, 0, 0); } }
#pragma unroll
            for (int hf = 0; hf < 2; ++hf)
#pragma unroll
                for (int j = 0; j < 4; ++j) part[(wave * 32 + hf * 16 + 4 * (lane >> 4) + j) * 16 + (lane & 15)] = acc[hf][j];
            __syncthreads();
            { const int e = tid >> 4, tk = tid & 15; float s = 0.f;
#pragma unroll
              for (int w = 0; w < 8; ++w) s += part[(w * 32 + e) * 16 + tk];
              if (MODE == 1) logit[tk * 32 + e] = s + p.rbias[e];
              else p.lr_out[(size_t)(tile * 16 + tk) * 32 + e] = s; }
            if (MODE == 1) {
                __syncthreads();
                if (tid < 16) {
                    const int token = tile * 16 + tid; float lv[32];
#pragma unroll
                    for (int e = 0; e < 32; ++e) lv[e] = logit[tid * 32 + e];
                    int bi[4]; float bv[4];
#pragma unroll
                    for (int k = 0; k < 4; ++k) { float m = -3.0e38f; int mi = 0;
#pragma unroll
                        for (int e = 0; e < 32; ++e) { const bool take = lv[e] > m; m = take ? lv[e] : m; mi = take ? e : mi; }
                        bi[k] = mi; bv[k] = m;
#pragma unroll
                        for (int e = 0; e < 32; ++e) lv[e] = (e == mi) ? -3.0e38f : lv[e]; }
                    const float e1 = __expf(bv[1] - bv[0]), e2 = __expf(bv[2] - bv[0]), e3 = __expf(bv[3] - bv[0]); const float inv = 1.0f / (1.0f + e1 + e2 + e3);
                    *(int4*)(p.topi + token * 4) = make_int4(bi[0], bi[1], bi[2], bi[3]);
                    *(f32x4*)(p.topw + token * 4) = (f32x4){inv, e1 * inv, e2 * inv, e3 * inv};
#pragma unroll
                    for (int k = 0; k < 4; ++k) atomicAdd((int*)&lhist[bi[k]], 1);
                }
            }
            __syncthreads();
        }
    }
    if (MODE == 1) { __syncthreads(); if (tid < 32) p.hist[tid] = lhist[tid]; }
}

__device__ __forceinline__ void phase_place(int* route, LAS unsigned char* lds, int tid, int bx, int G) {
    const int lane = tid & 63, wave = tid >> 6;
    LAS int* ptot = (LAS int*)lds;
    LAS int* ppre = ptot + 512;
    LAS int* tot = ppre + 512;
    LAS int* pre = tot + 32;
    LAS int* pstart = pre + 32;
    const int* hist = route + R_HIST;
    { const int e = tid & 31, part = tid >> 5; int st = 0, sp = 0;
      for (int bb = part; bb < G; bb += 16) { const int h = hist[bb * 32 + e]; st += h; if (bb < bx) sp += h; }
      ptot[part * 32 + e] = st; ppre[part * 32 + e] = sp; }
    __syncthreads();
    if (tid < 32) { int st = 0, sp = 0;
#pragma unroll
        for (int q = 0; q < 16; ++q) { st += ptot[q * 32 + tid]; sp += ppre[q * 32 + tid]; }
        tot[tid] = st; pre[tid] = sp; }
    __syncthreads();
    if (tid == 0) { int acc = 0; for (int e = 0; e < 32; ++e) { pstart[e] = acc; acc += (tot[e] + 255) / 256 * 256; } pstart[32] = acc; }
    __syncthreads();
    if (bx == 0) {
        const int ntiles = pstart[32] / 256;
        if (tid == 0) route[R_NTILES] = ntiles;
        for (int t = tid; t < ntiles; t += NTHREADS) { int e = 0; for (int q = 1; q < 32; ++q) if (pstart[q] <= t * 256) e = q; route[R_TILEE + t] = e; }
    }
    for (int e = bx; e < 32; e += G) { const int s0 = pstart[e] + tot[e], s1 = pstart[e + 1]; for (int s = s0 + tid; s < s1; s += NTHREADS) route[R_BUFTOK + s] = 0; }
    if (wave == 0) {
        int run = 0;
        for (int tile = bx; tile < T / 16; tile += G) {
            const int token = tile * 16 + (lane >> 2);
            const int e = route[R_TOPI + tile * 64 + lane];
            const int base = __shfl(run, e);
            int rank = 0, add = 0;
#pragma unroll 1
            for (int x = 0; x < 32; ++x) { const unsigned long long m = __ballot(e == x); if (e == x) rank = __popcll(m & ((1ull << lane) - 1ull)); if (lane == x) add = __popcll(m); }
            run += add;
            const int ds = pstart[e] + pre[e] + base + rank;
            route[R_DEST + tile * 64 + lane] = ds;
            route[R_BUFTOK + ds] = token;
        }
    }
}

struct Unit { int pm, pn, e; const bf16* bt; };
constexpr int NXCD = 8, WGM = 8;
struct Sched {
    int nM, nN, nwg, G, c; const bf16* Bt; size_t estride; const int* tile_e; int K;
    __device__ __forceinline__ void init(int nM_, int nN_, int G_, int c_, const bf16* Bt_, size_t es, const int* te, int K_) { nM = nM_; nN = nN_; nwg = nM * nN; G = G_; c = c_; Bt = Bt_; estride = es; tile_e = te; K = K_; }
    __device__ __forceinline__ bool next(int i, Unit& u) const {
        const long L = (long)i * G + c; if (L >= nwg) return false;
        int wgid = (int)L; { const int q = nwg / NXCD, r = nwg % NXCD, xcd = wgid % NXCD, off = wgid / NXCD; wgid = (xcd < r ? xcd * (q + 1) : r * (q + 1) + (xcd - r) * q) + off; }
        const int nig = WGM * nN, gid = wgid / nig, fm = gid * WGM, gsz = (nM - fm) < WGM ? (nM - fm) : WGM;
        u.pm = fm + ((wgid % nig) % gsz); u.pn = (wgid % nig) / gsz;
        u.e = tile_e ? __builtin_amdgcn_readfirstlane(tile_e[u.pm]) : 0;
        u.bt = Bt + (size_t)u.e * estride + (size_t)u.pn * 256 * K;
        return true;
    }
};
struct EpiGlaIn { bf16* O;
    __device__ __forceinline__ void operator()(const f32x4 (&acc)[2][2][4][2], const Unit& u, int wr, int wc, int fr, int fq) const {
        const int row0 = u.pm * 256 + wr * 64 + fr, col0 = u.pn * 256 + wc * 32 + 4 * fq; const float sc = (u.pn < 2) ? 0.08838834764831845f : 1.0f;
#pragma unroll
        for (int ai = 0; ai < 2; ++ai)
#pragma unroll
            for (int m = 0; m < 4; ++m) { bf16* rp = O + (size_t)(row0 + ai * 128 + m * 16) * GLA_MAIN + col0;
#pragma unroll
                for (int bj = 0; bj < 2; ++bj)
#pragma unroll
                    for (int n = 0; n < 2; ++n) { const f32x4 v = acc[ai][bj][m][n] * sc; u32x2 o; o.x = cvt_pk_bf16(v[0], v[1]); o.y = cvt_pk_bf16(v[2], v[3]); *(u32x2*)(rp + bj * 128 + n * 16) = o; } }
    }
};
struct EpiSguIn { bf16* O; const float* bias;
    __device__ __forceinline__ void operator()(const f32x4 (&acc)[2][2][4][2], const Unit& u, int wr, int wc, int fr, int fq) const {
        const int row0 = u.pm * 256 + wr * 64 + fr, col0 = u.pn * 256 + wc * 32 + 4 * fq;
        f32x4 bv[2][2];
#pragma unroll
        for (int bj = 0; bj < 2; ++bj)
#pragma unroll
            for (int n = 0; n < 2; ++n) bv[bj][n] = *(const f32x4*)(bias + col0 + bj * 128 + n * 16);
#pragma unroll
        for (int ai = 0; ai < 2; ++ai)
#pragma unroll
            for (int m = 0; m < 4; ++m) { bf16* rp = O + (size_t)(row0 + ai * 128 + m * 16) * 2048 + col0;
#pragma unroll
                for (int bj = 0; bj < 2; ++bj)
#pragma unroll
                    for (int n = 0; n < 2; ++n) { const f32x4 v = acc[ai][bj][m][n] + bv[bj][n]; u32x2 o; o.x = cvt_pk_bf16(gelu_f(v[0]), gelu_f(v[1])); o.y = cvt_pk_bf16(gelu_f(v[2]), gelu_f(v[3])); *(u32x2*)(rp + bj * 128 + n * 16) = o; } }
    }
};
struct EpiOut { float* O; const float* bias;
    __device__ __forceinline__ void operator()(const f32x4 (&acc)[2][2][4][2], const Unit& u, int wr, int wc, int fr, int fq) const {
        const int row0 = u.pm * 256 + wr * 64 + fr, col0 = u.pn * 256 + wc * 32 + 4 * fq;
        f32x4 bv[2][2];
#pragma unroll
        for (int bj = 0; bj < 2; ++bj)
#pragma unroll
            for (int n = 0; n < 2; ++n) bv[bj][n] = bias ? *(const f32x4*)(bias + col0 + bj * 128 + n * 16) : (f32x4){0.f, 0.f, 0.f, 0.f};
#pragma unroll
        for (int ai = 0; ai < 2; ++ai)
#pragma unroll
            for (int m = 0; m < 4; ++m) { float* rp = O + (size_t)(row0 + ai * 128 + m * 16) * D + col0;
#pragma unroll
                for (int bj = 0; bj < 2; ++bj)
#pragma unroll
                    for (int n = 0; n < 2; ++n) *(f32x4*)(rp + bj * 128 + n * 16) = acc[ai][bj][m][n] + bv[bj][n]; }
    }
};
struct EpiUp { bf16* O; const float* bias;
    __device__ __forceinline__ void operator()(const f32x4 (&acc)[2][2][4][2], const Unit& u, int wr, int wc, int fr, int fq) const {
        const int row0 = u.pm * 256 + wr * 64 + fr, a0 = u.pn * 128 + wc * 16 + 4 * fq;
        f32x4 bg[2], bl[2];
#pragma unroll
        for (int bj = 0; bj < 2; ++bj) { const float* bp = bias + (size_t)u.e * 2048 + 2 * (a0 + 64 * bj); const f32x4 p0 = *(const f32x4*)bp, p1 = *(const f32x4*)(bp + 4);
            bg[bj] = (f32x4){p0[0], p0[2], p1[0], p1[2]}; bl[bj] = (f32x4){p0[1], p0[3], p1[1], p1[3]}; }
#pragma unroll
        for (int ai = 0; ai < 2; ++ai)
#pragma unroll
            for (int m = 0; m < 4; ++m) { bf16* rp = O + (size_t)(row0 + ai * 128 + m * 16) * D + a0;
#pragma unroll
                for (int bj = 0; bj < 2; ++bj) { const f32x4 g = acc[ai][bj][m][0] + bg[bj], l = acc[ai][bj][m][1] + bl[bj]; float r[4];
#pragma unroll
                    for (int j = 0; j < 4; ++j) { const float gg = fminf(g[j], 7.0f), ll = fminf(fmaxf(l[j], -7.0f), 7.0f); r[j] = gg * sigmoid_f(1.702f * gg) * (ll + 1.0f); }
                    u32x2 o; o.x = cvt_pk_bf16(r[0], r[1]); o.y = cvt_pk_bf16(r[2], r[3]); *(u32x2*)(rp + bj * 64) = o; } }
    }
};
struct EpiDown { bf16* O; const float* bias;
    __device__ __forceinline__ void operator()(const f32x4 (&acc)[2][2][4][2], const Unit& u, int wr, int wc, int fr, int fq) const {
        const int row0 = u.pm * 256 + wr * 64 + fr, col0 = u.pn * 256 + wc * 32 + 4 * fq;
        f32x4 bv[2][2];
#pragma unroll
        for (int bj = 0; bj < 2; ++bj)
#pragma unroll
            for (int n = 0; n < 2; ++n) bv[bj][n] = *(const f32x4*)(bias + (size_t)u.e * 1024 + col0 + bj * 128 + n * 16);
#pragma unroll
        for (int ai = 0; ai < 2; ++ai)
#pragma unroll
            for (int m = 0; m < 4; ++m) { bf16* rp = O + (size_t)(row0 + ai * 128 + m * 16) * D + col0;
#pragma unroll
                for (int bj = 0; bj < 2; ++bj)
#pragma unroll
                    for (int n = 0; n < 2; ++n) { const f32x4 v = acc[ai][bj][m][n] + bv[bj][n]; u32x2 o; o.x = cvt_pk_bf16(v[0], v[1]); o.y = cvt_pk_bf16(v[2], v[3]); *(u32x2*)(rp + bj * 128 + n * 16) = o; } }
    }
};

template <class Epi>
__device__ __forceinline__ void gemm_naive(const bf16* A, const int* gather, int K, const Sched& S, const Epi& E, int tid) {
    const int wid = __builtin_amdgcn_readfirstlane(tid >> 6), lane = tid & 63, wr = wid >> 2, wc = wid & 3, fr = lane & 15, fq = lane >> 4;
    Unit u;
    for (int ui = 0; S.next(ui, u); ++ui) {
        f32x4 acc[2][2][4][2];
#pragma unroll
        for (int a = 0; a < 2; ++a)
#pragma unroll
            for (int b = 0; b < 2; ++b)
#pragma unroll
                for (int m = 0; m < 4; ++m)
#pragma unroll
                    for (int n = 0; n < 2; ++n) acc[a][b][m][n] = (f32x4){0.f, 0.f, 0.f, 0.f};
        unsigned ap[2][4], bp[2][2];
#pragma unroll
        for (int ai = 0; ai < 2; ++ai)
#pragma unroll
            for (int m = 0; m < 4; ++m) { const int r = u.pm * 256 + ai * 128 + wr * 64 + m * 16 + fr; const int ar = gather ? gather[r] : r; ap[ai][m] = (unsigned)ar * (unsigned)K + 8u * fq; }
#pragma unroll
        for (int bj = 0; bj < 2; ++bj)
#pragma unroll
            for (int n = 0; n < 2; ++n) bp[bj][n] = (unsigned)(bj * 128 + wc * 32 + n * 16 + fr) * (unsigned)K + 8u * fq;
#pragma unroll 1
        for (int k0 = 0; k0 < K; k0 += 32) {
            bf16x8 af[2][4], bfr[2][2];
#pragma unroll
            for (int ai = 0; ai < 2; ++ai)
#pragma unroll
                for (int m = 0; m < 4; ++m) af[ai][m] = *(const bf16x8*)(A + ap[ai][m] + k0);
#pragma unroll
            for (int bj = 0; bj < 2; ++bj)
#pragma unroll
                for (int n = 0; n < 2; ++n) bfr[bj][n] = *(const bf16x8*)(u.bt + bp[bj][n] + k0);
#pragma unroll
            for (int ai = 0; ai < 2; ++ai)
#pragma unroll
                for (int bj = 0; bj < 2; ++bj)
#pragma unroll
                    for (int m = 0; m < 4; ++m)
#pragma unroll
                        for (int n = 0; n < 2; ++n) acc[ai][bj][m][n] = __builtin_amdgcn_mfma_f32_16x16x32_bf16(bfr[bj][n], af[ai][m], acc[ai][bj][m][n], 0, 0, 0);
        }
        E(acc, u, wr, wc, fr, fq);
    }
}

constexpr int G8_BK = 64, G8_HALF = 128, G8_HTB = G8_HALF * G8_BK * 2, G8_STAGE_BYTES = 8 * G8_HTB;
__device__ __forceinline__ int g8_lds_byte(int r, int c) { const int st = (r >> 4) * 2 + (c >> 5), rr = r & 15, cc = c & 31, ob = rr * 64 + cc * 2; return st * 1024 + (ob ^ (((ob >> 9) & 1) << 5)); }
__device__ __forceinline__ void g8_stage_rc(int b, int& R, int& C) { const int st = b / 1024, sb = b % 1024, swz = sb ^ (((sb >> 9) & 1) << 5); R = (st >> 1) * 16 + swz / 64; C = (st & 1) * 32 + (swz % 64) / 2; }
__device__ __forceinline__ u32x4 g8_avoff(int pm, const int* gather, int tid, int K) {
    int t2 = tid; asm volatile("" : "+v"(t2));
    int R, C; g8_stage_rc(t2 * 16, R, C);
    const int* gp = gather + pm * 256 + R;
    const unsigned r00 = gp[0], r01 = gp[64], r10 = gp[128], r11 = gp[192], c2 = (unsigned)(C * 2), k2 = (unsigned)(K * 2);
    return (u32x4){r00 * k2 + c2, r01 * k2 + c2, r10 * k2 + c2, r11 * k2 + c2};
}
template <bool GATHER, class Epi>
__device__ __forceinline__ void gemm_fast(const bf16* A, const int* gather, const int K, const Sched& S, const Epi& E, LAS unsigned char* lds, int tid) {
    const int wid = __builtin_amdgcn_readfirstlane(tid >> 6), lane = tid & 63, wr = wid >> 2, wc = wid & 3, fr = lane & 15, fq = lane >> 4;
    const int nt = K / G8_BK;
    unsigned voff; { int R, C; g8_stage_rc(tid * 16, R, C); voff = (unsigned)(R * K + C) * 2u; }
    const size_t kstep = (size_t)(G8_BK * 2), hstep = (size_t)G8_HALF * K * 2, qstep = (size_t)64 * K * 2, tstep = 2 * hstep;
    const unsigned ldsw = (unsigned)wid * 1024u;
    const int aoff = g8_lds_byte(wr * 64 + fr, fq * 8), boff = g8_lds_byte(wc * 32 + fr, fq * 8);
#define G8_SA(b, h) (((b) * 2 + (h)) * G8_HTB)
#define G8_SB(b, h) ((4 + (b) * 2 + (h)) * G8_HTB)
#define G8_GLDS(gp, ldsoff) __builtin_amdgcn_global_load_lds((const unsigned*)(gp), (LAS unsigned*)(lds + (ldsoff)), 16, 0, 0)
#define G8_STAGE_D(bufoff, gbase) do { G8_GLDS((const char*)(gbase) + voff, (bufoff) + ldsw); G8_GLDS((const char*)(gbase) + qstep + voff, (bufoff) + ldsw + 8192); } while (0)
#define G8_STAGE_A(bufoff, kb, h) do { if constexpr (GATHER) { G8_GLDS((kb) + va[(h) * 2], (bufoff) + ldsw); G8_GLDS((kb) + va[(h) * 2 + 1], (bufoff) + ldsw + 8192); } \
        else { G8_STAGE_D(bufoff, (kb) + (h) * hstep); } } while (0)
#define G8_LDA(dst, b, h) do { _Pragma("unroll") for (int m = 0; m < 4; ++m) _Pragma("unroll") for (int k = 0; k < 2; ++k) dst[m][k] = *(const LAS bf16x8*)(lds + G8_SA(b, h) + aoff + m * 2048 + k * 1024); } while (0)
#define G8_LDB(dst, b, h) do { _Pragma("unroll") for (int n = 0; n < 2; ++n) _Pragma("unroll") for (int k = 0; k < 2; ++k) dst[n][k] = *(const LAS bf16x8*)(lds + G8_SB(b, h) + boff + n * 2048 + k * 1024); } while (0)
#define G8_MMA(ai, bj, At, Bt) do { __builtin_amdgcn_s_setprio(1); _Pragma("unroll") for (int m = 0; m < 4; ++m) _Pragma("unroll") for (int n = 0; n < 2; ++n) _Pragma("unroll") for (int k = 0; k < 2; ++k) \
        acc[ai][bj][m][n] = __builtin_amdgcn_mfma_f32_16x16x32_bf16(Bt[n][k], At[m][k], acc[ai][bj][m][n], 0, 0, 0); __builtin_amdgcn_s_setprio(0); } while (0)
#define G8_WAIT_V(n) asm volatile("s_waitcnt vmcnt(" #n ")" ::: "memory")
#define G8_WAIT_L(n) asm volatile("s_waitcnt lgkmcnt(" #n ")" ::: "memory")
#define G8_BAR __builtin_amdgcn_s_barrier()
#define G8_SCHED __builtin_amdgcn_sched_barrier(0)
    Unit cur, nxt; int ui = 0;
    if (!S.next(0, cur)) return;
    f32x4 acc[2][2][4][2];
#pragma unroll
    for (int a = 0; a < 2; ++a)
#pragma unroll
        for (int b = 0; b < 2; ++b)
#pragma unroll
            for (int m = 0; m < 4; ++m)
#pragma unroll
                for (int n = 0; n < 2; ++n) acc[a][b][m][n] = (f32x4){0.f, 0.f, 0.f, 0.f};
    bf16x8 At[4][2], B0[2][2], B1[2][2];
    u32x4 va = (u32x4){0u, 0u, 0u, 0u};
    if constexpr (GATHER) va = g8_avoff(cur.pm, gather, tid, K);
    LAS u32x4* vslot = (LAS u32x4*)(lds + G8_STAGE_BYTES) + tid;
    const char* cB = (const char*)cur.bt; const char* cA = (const char*)A + (GATHER ? (size_t)0 : (size_t)cur.pm * tstep);
    G8_STAGE_D(G8_SB(0, 0), cB); G8_STAGE_D(G8_SB(0, 1), cB + hstep); G8_STAGE_A(G8_SA(0, 0), cA, 0); G8_STAGE_A(G8_SA(0, 1), cA, 1);
    if (wr == 1) G8_BAR;
    G8_WAIT_V(2); G8_BAR;
    G8_STAGE_D(G8_SB(1, 0), cB + kstep); G8_STAGE_A(G8_SA(1, 0), cA + kstep, 0); G8_STAGE_D(G8_SB(1, 1), cB + hstep + kstep);
    G8_WAIT_V(6); G8_BAR;
    for (;;) {
        const bool has_next = S.next(ui + 1, nxt);
        if constexpr (GATHER) { if (has_next) *vslot = g8_avoff(nxt.pm, gather, tid, K); }
        const char* nB = has_next ? (const char*)nxt.bt : cB;
        const char* nA = (GATHER || !has_next) ? cA : (const char*)A + (size_t)nxt.pm * tstep;
        for (int t = 0; t < nt; t += 2) {
            const bool last = (t == nt - 2);
            const char* a1 = cA + (size_t)(t + 1) * kstep;
            const char* a2 = last ? nA : cA + (size_t)(t + 2) * kstep; const char* b2 = last ? nB : cB + (size_t)(t + 2) * kstep;
            const char* a3 = a2 + kstep; const char* b3 = b2 + kstep;
            G8_LDB(B0, 0, 0); G8_LDB(B1, 0, 1); G8_SCHED; G8_LDA(At, 0, 0); G8_STAGE_A(G8_SA(1, 1), a1, 1);
            if constexpr (GATHER) { if (last && has_next) va = *vslot; }
            G8_WAIT_V(8); G8_WAIT_L(0); G8_BAR; G8_MMA(0, 0, At, B0); G8_MMA(0, 1, At, B1); G8_BAR; G8_SCHED;
            G8_LDA(At, 0, 1); G8_STAGE_D(G8_SB(0, 0), b2); G8_STAGE_D(G8_SB(0, 1), b2 + hstep); G8_STAGE_A(G8_SA(0, 0), a2, 0);
            G8_WAIT_V(8); G8_WAIT_L(0); G8_BAR; G8_MMA(1, 0, At, B0); G8_MMA(1, 1, At, B1); G8_BAR; G8_SCHED;
            G8_LDB(B0, 1, 0); G8_LDB(B1, 1, 1); G8_SCHED; G8_LDA(At, 1, 0); G8_STAGE_A(G8_SA(0, 1), a2, 1);
            G8_WAIT_V(8); G8_WAIT_L(0); G8_BAR; G8_MMA(0, 0, At, B0); G8_MMA(0, 1, At, B1); G8_BAR; G8_SCHED;
            G8_LDA(At, 1, 1); G8_STAGE_D(G8_SB(1, 0), b3); G8_STAGE_D(G8_SB(1, 1), b3 + hstep); G8_STAGE_A(G8_SA(1, 0), a3, 0);
            G8_WAIT_V(8); G8_WAIT_L(0); G8_BAR; G8_MMA(1, 0, At, B0); G8_MMA(1, 1, At, B1); G8_BAR; G8_SCHED;
        }
        if (wr == 0) G8_BAR;
        E(acc, cur, wr, wc, fr, fq);
        if (!has_next) break;
#pragma unroll
        for (int a = 0; a < 2; ++a)
#pragma unroll
            for (int b = 0; b < 2; ++b)
#pragma unroll
                for (int m = 0; m < 4; ++m)
#pragma unroll
                    for (int n = 0; n < 2; ++n) acc[a][b][m][n] = (f32x4){0.f, 0.f, 0.f, 0.f};
        cur = nxt; cB = nB; cA = nA; ++ui;
        if (wr == 1) G8_BAR;
    }
    G8_WAIT_V(0);
    G8_BAR;
#undef G8_SA
#undef G8_SB
#undef G8_GLDS
#undef G8_STAGE_D
#undef G8_STAGE_A
#undef G8_LDA
#undef G8_LDB
#undef G8_MMA
#undef G8_WAIT_V
#undef G8_WAIT_L
#undef G8_BAR
#undef G8_SCHED
}

__device__ __forceinline__ float logsigmoid_f(float x) { return fminf(x, 0.f) - log1pf(__expf(-fabsf(x))); }
__device__ __forceinline__ void phase_gla_scan_naive(KA a, int li, LAS unsigned char* lds, int tid, int bx, int G) {
    const bf16* qkvr = (const bf16*)(a->ws + WS_BIG); const float* lr = (const float*)(a->ws + WS_LR);
    LAS float* qs = (LAS float*)lds;
    LAS float* ks = qs + 2048;
    LAS float* as = ks + 2048;
    LAS float* vs = as + 2048;
    LAS float* lrs = vs + 1024;
    LAS float* part = lrs + 256;
    for (int it = bx; it < 256; it += G) {
        const int b = it >> 5, h = (it >> 3) & 3, dir = (it >> 2) & 1, es = it & 3;
        const float* wg2 = a->in[dir ? I_GWG2B : I_GWG2F] + (size_t)li * 16 * 512; const float* bg = a->in[dir ? I_GBGB : I_GBGF] + (size_t)li * 512;
        bf16* oo = (bf16*)(a->ws + (dir ? WS_OB : WS_OF));
        const int dd = tid & 127;
        float wcol[16];
#pragma unroll
        for (int r = 0; r < 16; ++r) wcol[r] = wg2[r * 512 + h * 128 + dd];
        const float bgd = bg[h * 128 + dd];
        const int e = tid & 63, dp = tid >> 6;
        float S[16];
#pragma unroll
        for (int i = 0; i < 16; ++i) S[i] = 0.f;
        for (int t0 = 0; t0 < SEQ; t0 += 16) {
            __syncthreads();
            if (tid < 256) { const int st = tid >> 4, r = tid & 15; const int s = dir ? (SEQ - 1 - (t0 + st)) : (t0 + st); lrs[tid] = lr[(size_t)(b * SEQ + s) * 32 + dir * 16 + r]; }
            __syncthreads();
#pragma unroll
            for (int i = 0; i < 4; ++i) { const int st = (tid >> 7) + 4 * i; const int s = dir ? (SEQ - 1 - (t0 + st)) : (t0 + st); const size_t row = (size_t)(b * SEQ + s) * GLA_MAIN;
                qs[st * 128 + dd] = bf2f(qkvr[row + h * 128 + dd]); ks[st * 128 + dd] = bf2f(qkvr[row + 512 + h * 128 + dd]);
                float x = bgd;
#pragma unroll
                for (int r = 0; r < 16; ++r) x += lrs[st * 16 + r] * wcol[r];
                as[st * 128 + dd] = __expf(logsigmoid_f(x) * (1.0f / 16.0f)); }
#pragma unroll
            for (int i = 0; i < 2; ++i) { const int idx = tid + 512 * i, st = idx >> 6, ee = idx & 63; const int s = dir ? (SEQ - 1 - (t0 + st)) : (t0 + st);
                vs[idx] = bf2f(qkvr[(size_t)(b * SEQ + s) * GLA_MAIN + 1024 + h * 256 + es * 64 + ee]); }
            __syncthreads();
            for (int st = 0; st < 16; ++st) {
                const float vv = vs[st * 64 + e]; float po = 0.f;
#pragma unroll
                for (int i4 = 0; i4 < 4; ++i4) { const f32x4 q4 = *(const LAS f32x4*)(qs + st * 128 + dp * 16 + 4 * i4), k4 = *(const LAS f32x4*)(ks + st * 128 + dp * 16 + 4 * i4), a4 = *(const LAS f32x4*)(as + st * 128 + dp * 16 + 4 * i4);
#pragma unroll
                    for (int j = 0; j < 4; ++j) { S[4 * i4 + j] = a4[j] * S[4 * i4 + j] + k4[j] * vv; po += q4[j] * S[4 * i4 + j]; } }
                part[(dp * 16 + st) * 64 + e] = po;
            }
            __syncthreads();
#pragma unroll
            for (int i = 0; i < 2; ++i) { const int idx = tid + 512 * i, st = idx >> 6, ee = idx & 63; float s = 0.f;
#pragma unroll
                for (int w = 0; w < 8; ++w) s += part[(w * 16 + st) * 64 + ee];
                const int sq = dir ? (SEQ - 1 - (t0 + st)) : (t0 + st);
                oo[(size_t)(b * SEQ + sq) * D + h * 256 + es * 64 + ee] = (bf16)(cvt_pk_bf16(s, 0.f) & 0xffffu); }
        }
        __syncthreads();
    }
}
__device__ __forceinline__ void phase_gla_post(KA a, int li, int tid, int bx, int G) {
    const int lane = tid & 63, wave = tid >> 6;
    const bf16* of = (const bf16*)(a->ws + WS_OF); const bf16* ob = (const bf16*)(a->ws + WS_OB); const bf16* qkvr = (const bf16*)(a->ws + WS_BIG); bf16* A2 = (bf16*)(a->ws + WS_A2);
    const float* ng = a->in[I_GNORM] + (size_t)li * 256 + (lane & 15) * 16;
    float g[16];
#pragma unroll
    for (int j = 0; j < 16; ++j) g[j] = ng[j];
    for (int token = bx * NWAVES + wave; token < T; token += G * NWAVES) {
        const u32x4 f0 = *(const u32x4*)(of + (size_t)token * D + 16 * lane), f1 = *(const u32x4*)(of + (size_t)token * D + 16 * lane + 8);
        const u32x4 b0 = *(const u32x4*)(ob + (size_t)token * D + 16 * lane), b1 = *(const u32x4*)(ob + (size_t)token * D + 16 * lane + 8);
        const u32x4 r0 = *(const u32x4*)(qkvr + (size_t)token * GLA_MAIN + 2048 + 16 * lane), r1 = *(const u32x4*)(qkvr + (size_t)token * GLA_MAIN + 2048 + 16 * lane + 8);
        float o[16], r[16];
#pragma unroll
        for (int q = 0; q < 4; ++q) { o[2 * q] = bf_lo(f0[q]) + bf_lo(b0[q]); o[2 * q + 1] = bf_hi(f0[q]) + bf_hi(b0[q]); o[8 + 2 * q] = bf_lo(f1[q]) + bf_lo(b1[q]); o[8 + 2 * q + 1] = bf_hi(f1[q]) + bf_hi(b1[q]);
            r[2 * q] = bf_lo(r0[q]); r[2 * q + 1] = bf_hi(r0[q]); r[8 + 2 * q] = bf_lo(r1[q]); r[8 + 2 * q + 1] = bf_hi(r1[q]); }
        float ss = 0.f;
#pragma unroll
        for (int j = 0; j < 16; ++j) ss += o[j] * o[j];
        ss += __shfl_xor(ss, 1); ss += __shfl_xor(ss, 2); ss += __shfl_xor(ss, 4); ss += __shfl_xor(ss, 8);
        const float rstd = 1.0f / sqrtf(ss * (1.0f / 256.0f) + LN_EPS);
        unsigned w[8];
#pragma unroll
        for (int q = 0; q < 8; ++q) w[q] = cvt_pk_bf16(o[2 * q] * rstd * g[2 * q] * silu_f(r[2 * q]), o[2 * q + 1] * rstd * g[2 * q + 1] * silu_f(r[2 * q + 1]));
        *(u32x4*)(A2 + (size_t)token * D + 16 * lane) = (u32x4){w[0], w[1], w[2], w[3]}; *(u32x4*)(A2 + (size_t)token * D + 16 * lane + 8) = (u32x4){w[4], w[5], w[6], w[7]};
    }
}

__device__ __forceinline__ void phase_sgu_naive(KA a, int li, LAS unsigned char* lds, int tid, int bx, int G) {
    const int lane = tid & 63, wave = tid >> 6, fr = lane & 15, fq = lane >> 4;
    const bf16* z = (const bf16*)(a->ws + WS_BIG); bf16* A2 = (bf16*)(a->ws + WS_A2);
    const float* lng = a->in[I_SLNG] + (size_t)li * 1024; const float* lnb = a->in[I_SLNB] + (size_t)li * 1024;
    const float* wsp = a->in[I_SWS] + (size_t)li * 8 * 128 * 128; const float* bs = a->in[I_SBS] + (size_t)li * 8 * 128;
    LAS float* st_mean = (LAS float*)lds; LAS float* st_rstd = st_mean + 128;
    for (int it = bx; it < T / 128; it += G) {
        const int row0 = it * 128;
        __syncthreads();
#pragma unroll 1
        for (int rr = 0; rr < 16; ++rr) { const int q = wave * 16 + rr; const bf16* vp = z + (size_t)(row0 + q) * 2048 + 1024 + 16 * lane;
            const u32x4 v0 = *(const u32x4*)vp, v1 = *(const u32x4*)(vp + 8); float x[16];
#pragma unroll
            for (int k = 0; k < 4; ++k) { x[2 * k] = bf_lo(v0[k]); x[2 * k + 1] = bf_hi(v0[k]); x[8 + 2 * k] = bf_lo(v1[k]); x[8 + 2 * k + 1] = bf_hi(v1[k]); }
            float s = 0.f;
#pragma unroll
            for (int k = 0; k < 16; ++k) s += x[k];
            const float mean = wave_sum(s) * (1.0f / 1024.0f); float s2 = 0.f;
#pragma unroll
            for (int k = 0; k < 16; ++k) { const float d = x[k] - mean; s2 += d * d; }
            const float rstd = 1.0f / sqrtf(wave_sum(s2) * (1.0f / 1024.0f) + LN_EPS);
            if (lane == 0) { st_mean[q] = mean; st_rstd[q] = rstd; } }
        __syncthreads();
        const int p = wave * 16 + fr;
#pragma unroll 1
        for (int g = 0; g < 8; ++g) {
#pragma unroll 1
            for (int ct = 0; ct < 8; ++ct) {
                const int ch = g * 128 + ct * 16 + fr;
                const float lg = lng[ch], lb = lnb[ch];
                f32x4 acc = (f32x4){0.f, 0.f, 0.f, 0.f};
#pragma unroll
                for (int ks = 0; ks < 4; ++ks) {
                    const int q0 = ks * 32 + 8 * fq;
                    const float* wp = wsp + ((size_t)g * 128 + p) * 128 + q0; const f32x4 w0 = *(const f32x4*)wp, w1 = *(const f32x4*)(wp + 4);
                    bf16x8 wf; { u32x4 t; t.x = cvt_pk_bf16(w0[0], w0[1]); t.y = cvt_pk_bf16(w0[2], w0[3]); t.z = cvt_pk_bf16(w1[0], w1[1]); t.w = cvt_pk_bf16(w1[2], w1[3]); wf = __builtin_bit_cast(bf16x8, t); }
                    float vn[8];
#pragma unroll
                    for (int j = 0; j < 8; ++j) { const int q = q0 + j; const float vv = bf2f(z[(size_t)(row0 + q) * 2048 + 1024 + ch]); vn[j] = (vv - st_mean[q]) * st_rstd[q] * lg + lb; }
                    bf16x8 vf; { u32x4 t; t.x = cvt_pk_bf16(vn[0], vn[1]); t.y = cvt_pk_bf16(vn[2], vn[3]); t.z = cvt_pk_bf16(vn[4], vn[5]); t.w = cvt_pk_bf16(vn[6], vn[7]); vf = __builtin_bit_cast(bf16x8, t); }
                    acc = __builtin_amdgcn_mfma_f32_16x16x32_bf16(vf, wf, acc, 0, 0, 0);
                }
                const float bias = bs[g * 128 + p]; const int c0 = g * 128 + ct * 16 + 4 * fq;
                const u32x2 uu = *(const u32x2*)(z + (size_t)(row0 + p) * 2048 + c0);
                u32x2 o; o.x = cvt_pk_bf16(bf_lo(uu.x) * (acc[0] + bias), bf_hi(uu.x) * (acc[1] + bias)); o.y = cvt_pk_bf16(bf_lo(uu.y) * (acc[2] + bias), bf_hi(uu.y) * (acc[3] + bias));
                *(u32x2*)(A2 + (size_t)(row0 + p) * D + c0) = o;
            }
        }
    }
}

constexpr int NPHASES = 2 + 9 * DEPTH;
#ifdef USE_NAIVE_GEMM
#define GEMM_BODY(A, g, K, S, E) gemm_naive(A, g, K, S, E, tid)
#define GEMM_BODY_G(A, g, K, S, E) gemm_naive(A, g, K, S, E, tid)
#else
#define GEMM_BODY(A, g, K, S, E) gemm_fast<false>(A, g, K, S, E, lds, tid)
#define GEMM_BODY_G(A, g, K, S, E) gemm_fast<true>(A, g, K, S, E, lds, tid)
#endif
__device__ __forceinline__ void ph_prologue(int wave_s) { PHASE_ENTER(); phase_prologue(a, lds, tid, bx, G); }
__device__ __forceinline__ void ph_rp_init(int wave_s) { PHASE_ENTER(); float* mod = (float*)(ws + WS_MOD);
    RowPass p{}; p.xin = a->in[I_X]; p.hout = (bf16*)(ws + WS_H); p.sc = mod + 1 * 1024; p.sh = mod + 0 * 1024; p.wside = (const bf16*)(ws + WS_GLALR_T); p.lr_out = (float*)(ws + WS_LR); p.has_h = 1; p.has_side = 1;
    row_pass<0>(p, lds, tid, bx, G); }
__device__ __forceinline__ void ph_gla_in(int wave_s, int li) { PHASE_ENTER(); Sched S; S.init(T / 256, GLA_MAIN / 256, G, bx, (const bf16*)(ws + WS_GLAIN_T) + (size_t)li * GLA_MAIN * 1024, 0, nullptr, 1024); EpiGlaIn E{(bf16*)(ws + WS_BIG)}; GEMM_BODY((const bf16*)(ws + WS_H), nullptr, 1024, S, E); }
__device__ __forceinline__ void ph_sgu_in(int wave_s, int li) { PHASE_ENTER(); Sched S; S.init(T / 256, 2048 / 256, G, bx, (const bf16*)(ws + WS_SGUIN_T) + (size_t)li * 2048 * 1024, 0, nullptr, 1024); EpiSguIn E{(bf16*)(ws + WS_BIG), a->in[I_SBIN] + (size_t)li * 2048}; GEMM_BODY((const bf16*)(ws + WS_H), nullptr, 1024, S, E); }
__device__ __forceinline__ void ph_gla_scan(int wave_s, int li) { PHASE_ENTER(); phase_gla_scan_naive(a, li, lds, tid, bx, G); }
__device__ __forceinline__ void ph_sgu_core(int wave_s, int li) { PHASE_ENTER(); phase_sgu_naive(a, li, lds, tid, bx, G); }
__device__ __forceinline__ void ph_gla_post(int wave_s, int li) { PHASE_ENTER(); phase_gla_post(a, li, tid, bx, G); }
__device__ __forceinline__ void ph_out(int wave_s, int l) { PHASE_ENTER(); const int li = l >> 1; const bool sgu = (l & 1) != 0;
    Sched S; S.init(T / 256, 4, G, bx, (const bf16*)(ws + (sgu ? WS_SGUOUT_T : WS_GLAOUT_T)) + (size_t)li * 1024 * 1024, 0, nullptr, 1024);
    EpiOut E{(float*)(ws + WS_Y), sgu ? a->in[I_SBOUT] + (size_t)li * 1024 : nullptr}; GEMM_BODY((const bf16*)(ws + WS_A2), nullptr, 1024, S, E); }
__device__ __forceinline__ void ph_rp_mid(int wave_s, int l) { PHASE_ENTER(); float* modl = (float*)(ws + WS_MOD) + (size_t)l * 8 * 6144; int* route = (int*)(ws + WS_ROUTE);
    RowPass p{}; p.xin = (l == 0) ? a->in[I_X] : (const float*)(ws + WS_X2); p.y = (const float*)(ws + WS_Y); p.xout = (float*)(ws + WS_X1); p.hout = (bf16*)(ws + WS_H);
    p.gate = modl + 2 * 1024; p.lng = a->in[I_LNG] + (size_t)(l * 2 + 0) * 1024; p.lnb = a->in[I_LNB] + (size_t)(l * 2 + 0) * 1024; p.sc = modl + 4 * 1024; p.sh = modl + 3 * 1024;
    p.wside = (const bf16*)(ws + WS_ROUTER_T) + (size_t)l * 64 * 1024; p.rbias = a->in[I_RB] + (size_t)l * 32;
    p.topi = route + R_TOPI; p.topw = (float*)(route + R_TOPW); p.hist = route + R_HIST + bx * 32; p.has_h = 1; p.has_side = 1;
    row_pass<1>(p, lds, tid, bx, G); }
__device__ __forceinline__ void ph_place(int wave_s) { PHASE_ENTER(); phase_place((int*)(ws + WS_ROUTE), lds, tid, bx, G); }
__device__ __forceinline__ void ph_moe_up(int wave_s, int l) { PHASE_ENTER(); int* route = (int*)(ws + WS_ROUTE); const int ntiles = __builtin_amdgcn_readfirstlane(route[R_NTILES]);
    Sched S; S.init(ntiles, 8, G, bx, (const bf16*)(ws + WS_WUP_T) + (size_t)l * 32 * 2048 * 1024, (size_t)2048 * 1024, route + R_TILEE, 1024);
    EpiUp E{(bf16*)(ws + WS_ACT), a->in[I_BUP] + (size_t)l * 32 * 2048}; GEMM_BODY_G((const bf16*)(ws + WS_H), route + R_BUFTOK, 1024, S, E); }
__device__ __forceinline__ void ph_moe_down(int wave_s, int l) { PHASE_ENTER(); int* route = (int*)(ws + WS_ROUTE); const int ntiles = __builtin_amdgcn_readfirstlane(route[R_NTILES]);
    Sched S; S.init(ntiles, 4, G, bx, (const bf16*)(ws + WS_WDN_T) + (size_t)l * 32 * 1024 * 1024, (size_t)1024 * 1024, route + R_TILEE, 1024);
    EpiDown E{(bf16*)(ws + WS_YS), a->in[I_BDN] + (size_t)l * 32 * 1024}; GEMM_BODY((const bf16*)(ws + WS_ACT), nullptr, 1024, S, E); }
__device__ __forceinline__ void ph_rp_end(int wave_s, int l) { PHASE_ENTER(); float* mod = (float*)(ws + WS_MOD); float* modl = mod + (size_t)l * 8 * 6144; int* route = (int*)(ws + WS_ROUTE);
    RowPass p{}; p.xin = (const float*)(ws + WS_X1); p.xout = (l == DEPTH - 1) ? a->out : (float*)(ws + WS_X2); p.hout = (bf16*)(ws + WS_H);
    p.gate = modl + 5 * 1024; p.lng = a->in[I_LNG] + (size_t)(l * 2 + 1) * 1024; p.lnb = a->in[I_LNB] + (size_t)(l * 2 + 1) * 1024;
    p.ys = (const bf16*)(ws + WS_YS); p.dest = route + R_DEST; p.tw = (const float*)(route + R_TOPW);
    if (l < DEPTH - 1) { float* modn = mod + (size_t)(l + 1) * 8 * 6144; p.sc = modn + 1 * 1024; p.sh = modn + 0 * 1024; p.has_h = 1;
        if (((l + 1) & 1) == 0) { p.has_side = 1; p.wside = (const bf16*)(ws + WS_GLALR_T) + (size_t)((l + 1) >> 1) * 64 * 1024; p.lr_out = (float*)(ws + WS_LR); } }
    row_pass<2>(p, lds, tid, bx, G); }

__global__ void __launch_bounds__(NTHREADS, 2) fwd_kernel(Args a) {
    extern __shared__ __attribute__((aligned(16))) unsigned char lds_raw[];
    LAS unsigned char* lds = (LAS unsigned char*)lds_raw;
    volatile LAS unsigned* MISC = (volatile LAS unsigned*)(lds + MISC_OFF);
    const int tid = threadIdx.x; const int wave_s = __builtin_amdgcn_readfirstlane(tid >> 6);
    if (tid < 32) ((LAS unsigned*)(lds + MISC_OFF))[tid] = 0u;
    __syncthreads();
    unsigned* ctl = (unsigned*)(a.ws + WS_CTL);
    XcdBarrier bar = xcd_barrier_post(ctl + CW_BAR + a.li * XCD_BAR_WORDS, MISC + 8);
    const int lo = a.ph_lo, hi = a.ph_hi;
#define IN(k) (lo <= (k) && (k) < hi)
#define SEAM(k) do { if (IN(k) && IN((k) + 1)) xcd_barrier(bar); } while (0)
    if (IN(0)) { ph_prologue(wave_s); SEAM(0); }
    if (IN(1)) { ph_rp_init(wave_s); SEAM(1); }
    for (int l = 0; l < DEPTH; ++l) {
        const int pb = 2 + 9 * l, li = l >> 1; const bool sgu = (l & 1) != 0;
        if (IN(pb + 0)) { if (!sgu) ph_gla_in(wave_s, li); else ph_sgu_in(wave_s, li); SEAM(pb + 0); }
        if (IN(pb + 1)) { if (!sgu) ph_gla_scan(wave_s, li); else ph_sgu_core(wave_s, li); SEAM(pb + 1); }
        if (IN(pb + 2)) { if (!sgu) { ph_gla_post(wave_s, li); SEAM(pb + 2); } }
        if (IN(pb + 3)) { ph_out(wave_s, l); SEAM(pb + 3); }
        if (IN(pb + 4)) { ph_rp_mid(wave_s, l); SEAM(pb + 4); }
        if (IN(pb + 5)) { ph_place(wave_s); SEAM(pb + 5); }
        if (IN(pb + 6)) { ph_moe_up(wave_s, l); SEAM(pb + 6); }
        if (IN(pb + 7)) { ph_moe_down(wave_s, l); SEAM(pb + 7); }
        if (IN(pb + 8)) { ph_rp_end(wave_s, l); SEAM(pb + 8); }
    }
#undef IN
#undef SEAM
}

#ifndef N_LAUNCH_MODE
#define N_LAUNCH_MODE 1
#endif
extern "C" void kernel_launch(void* const* d_in, const int* in_sizes, int n_in, void* d_out, int out_size, void* d_ws, size_t ws_size, hipStream_t stream) {
    static int grid = 0;
    if (grid == 0) {
        if (n_in != 27 || out_size != T * D || ws_size < WS_END) { fprintf(stderr, "kernel_launch: unexpected shapes (n_in %d out %d ws %zu)\n", n_in, out_size, ws_size); grid = -1; return; }
        int dev = 0, cus = 0, per_cu = 0;
        if (hipGetDevice(&dev) != hipSuccess || hipDeviceGetAttribute(&cus, hipDeviceAttributeMultiprocessorCount, dev) != hipSuccess) { grid = -1; return; }
        if (hipFuncSetAttribute((const void*)fwd_kernel, hipFuncAttributeMaxDynamicSharedMemorySize, LDS_BYTES) != hipSuccess) { fprintf(stderr, "kernel_launch: hipFuncSetAttribute failed\n"); grid = -1; return; }
        if (hipOccupancyMaxActiveBlocksPerMultiprocessor(&per_cu, (const void*)fwd_kernel, NTHREADS, LDS_BYTES) != hipSuccess || per_cu < 1) fprintf(stderr, "kernel_launch: occupancy query reports %d\n", per_cu);
        (void)hipGetLastError();
        grid = cus;
        if (grid > 1024) grid = 1024;
    }
    if (grid < 0) return;
    (void)hipMemsetAsync((char*)d_ws + WS_CTL, 0, CTL_ZERO_BYTES, stream);
    Args a{};
    for (int i = 0; i < 27; ++i) a.in[i] = (const float*)d_in[i];
    a.out = (float*)d_out; a.ws = (unsigned char*)d_ws; a.pad = 0;
#if N_LAUNCH_MODE == 1
    a.ph_lo = 0; a.ph_hi = NPHASES; a.li = 0;
    hipLaunchKernelGGL(fwd_kernel, dim3(grid), dim3(NTHREADS), LDS_BYTES, stream, a);
#else
    for (int ph = 0, li = 0; ph < NPHASES; ++ph) {
        if (ph >= 2 && ((ph - 2) % 9) == 2 && (((ph - 2) / 9) & 1)) continue;
        a.ph_lo = ph; a.ph_hi = ph + 1; a.li = li++;
        hipLaunchKernelGGL(fwd_kernel, dim3(grid), dim3(NTHREADS), LDS_BYTES, stream, a);
    }
#endif
}
```

```cpp
#include <hip/hip_runtime.h>
#include <cstdio>
#include <cstdint>

#define LAS __attribute__((address_space(3)))
#define GAS __attribute__((address_space(1)))
typedef unsigned short bf16;
typedef short bf16x8 __attribute__((ext_vector_type(8)));
typedef float f32x4 __attribute__((ext_vector_type(4)));
typedef float f32x2 __attribute__((ext_vector_type(2)));
typedef unsigned u32x4 __attribute__((ext_vector_type(4)));
typedef unsigned u32x2 __attribute__((ext_vector_type(2)));

constexpr int D = 1024, NB = 8, SEQ = 4096, T = NB * SEQ, DEPTH = 4;
constexpr int NE = 32, TOPK = 4, CAP = T * TOPK + NE * 256;
constexpr int MAXTILES = CAP / 256;
constexpr float ALPHA = 1.681792830507429f;
constexpr float LN_EPS = 1e-5f;
constexpr int GLA_IN = 3104, GLA_MAIN = 3072;
constexpr int NWAVES = 8, NTHREADS = 512;
constexpr int LDS_BYTES = 147456, MISC_OFF = 139264;

constexpr size_t MiB = 1u << 20;
constexpr size_t WS_CTL = 0, CTL_ZERO_BYTES = 2 * MiB;
constexpr size_t WS_MOD = 2 * MiB;
constexpr size_t WS_ROUTE = 4 * MiB;
constexpr size_t WS_LR = 8 * MiB;
constexpr size_t WS_GLAIN_T = 16 * MiB;
constexpr size_t WS_GLALR_T = 28 * MiB;
constexpr size_t WS_ROUTER_T = 29 * MiB;
constexpr size_t WS_SGUWS = 30 * MiB;
constexpr size_t WS_GLAOUT_T = 32 * MiB;
constexpr size_t WS_SGUIN_T = 36 * MiB;
constexpr size_t WS_SGUOUT_T = 44 * MiB;
constexpr size_t WS_WUP_T = 64 * MiB;
constexpr size_t WS_WDN_T = 576 * MiB;
constexpr size_t WS_X1 = 832 * MiB;
constexpr size_t WS_X2 = 960 * MiB;
constexpr size_t WS_H = 1088 * MiB;
constexpr size_t WS_BIG = 1152 * MiB;
constexpr size_t WS_OF = 1344 * MiB;
constexpr size_t WS_OB = 1408 * MiB;
constexpr size_t WS_A2 = 1472 * MiB;
constexpr size_t WS_Y = 1536 * MiB;
constexpr size_t WS_ACT = 1664 * MiB;
constexpr size_t WS_YS = 1936 * MiB;
constexpr size_t WS_QE = 2208 * MiB;
constexpr size_t WS_KET = 2272 * MiB;
constexpr size_t WS_P = 2336 * MiB;
constexpr size_t WS_VT = 2368 * MiB;
constexpr size_t WS_EL = 2432 * MiB;
constexpr size_t WS_END = 2440 * MiB;
constexpr int R_TOPI = 0;
constexpr int R_TOPW = T * 4;
constexpr int R_DEST = 2 * T * 4;
constexpr int R_BUFTOK = 3 * T * 4;
constexpr int R_HIST = R_BUFTOK + CAP;
constexpr int R_TILEE = R_HIST + 1024 * 32;
constexpr int R_NTILES = R_TILEE + 1024;
static_assert((size_t)(R_NTILES + 64) * 4 <= 4 * MiB, "route tables");
constexpr int CW_BAR = 4096;
constexpr int MAX_LAUNCH = 64;

#define RLX_AGENT __ATOMIC_RELAXED, __HIP_MEMORY_SCOPE_AGENT
#define LDS_WAIT() asm volatile("s_waitcnt lgkmcnt(0)" ::: "memory")
#define VM_WAIT() asm volatile("s_waitcnt vmcnt(0)" ::: "memory")
typedef __bf16 bf16x2_t __attribute__((ext_vector_type(2)));
__device__ __forceinline__ unsigned cvt_pk_bf16(float lo, float hi) { const f32x2 v = {lo, hi}; const bf16x2_t r = __builtin_convertvector(v, bf16x2_t); return __builtin_bit_cast(unsigned, r); }
__device__ __forceinline__ float bf_lo(unsigned w) { return __uint_as_float(w << 16); }
__device__ __forceinline__ float bf_hi(unsigned w) { return __uint_as_float(w & 0xffff0000u); }
__device__ __forceinline__ float bf2f(bf16 b) { return __uint_as_float(((unsigned)b) << 16); }
__device__ __forceinline__ float shfl_xor_f(float v, int o, int lane) { return __builtin_bit_cast(float, __builtin_amdgcn_ds_bpermute((lane ^ o) << 2, __builtin_bit_cast(int, v))); }
__device__ __forceinline__ int shfl_i(int v, int src, int lane) { (void)lane; return __builtin_amdgcn_ds_bpermute(src << 2, v); }
__device__ __forceinline__ float wave_sum(float v, int lane) {
#pragma unroll
    for (int o = 1; o < 64; o <<= 1) v += shfl_xor_f(v, o, lane);
    return v;
}
__device__ __forceinline__ float silu_f(float x) { return x / (1.0f + __expf(-x)); }
__device__ __forceinline__ float sigmoid_f(float x) { return 1.0f / (1.0f + __expf(-x)); }
__device__ __forceinline__ float gelu_f(float v) {
    const float av = fabsf(v), t = __builtin_amdgcn_rcpf(av * 0.2316418882f + 1.0f);
    float q = t * 0.5307027145f + (-0.7265760135f); q = q * t + 0.7107068705f; q = q * t + (-0.142248368f); q = q * t + 0.127414796f; q = q * t;
    const float e = __builtin_amdgcn_exp2f((v * v) * (-0.72134752044f));
    const float m = v * (q * e);
    return v < 0.f ? m : v - m;
}

#define XB_TMO      128
#define XB_XCNT(j)  (256  + 64 * (j))
#define XB_XSUB(j)  (1280 + 64 * (j))
#define XB_XGEN(j)  (2304 + 64 * (j))
#define XB_TOP      3328
#define XB_TOPGEN   3392
#define XCD_BAR_WORDS 3456
#define XB_SPIN_CAP (1u << 18)
__device__ __forceinline__ unsigned xb_ld(unsigned* p)              { return __hip_atomic_load(p, __ATOMIC_RELAXED, __HIP_MEMORY_SCOPE_AGENT); }
__device__ __forceinline__ unsigned xb_add(unsigned* p, unsigned v) { return __hip_atomic_fetch_add(p, v, __ATOMIC_RELAXED, __HIP_MEMORY_SCOPE_AGENT); }
__device__ __forceinline__ unsigned xb_xcc_id() { return (unsigned)__builtin_amdgcn_s_getreg((3 << 11) | 20) & 0xFu; }
#define XB_SPIN(cond, bar) do { unsigned _sp = 0; while (cond) { __builtin_amdgcn_s_sleep(1); \
    if ((++_sp & 255u) == 0u) { if (xb_ld(&(bar)[XB_TMO])) break; if (_sp > XB_SPIN_CAP) { atomicAdd(&(bar)[XB_TMO], 1u); break; } } } } while (0)
struct XcdBarrier { unsigned* bar; unsigned x; volatile LAS unsigned* st; };
__device__ __forceinline__ XcdBarrier xcd_barrier_post(unsigned* bar, volatile LAS unsigned* st) {
    XcdBarrier b; b.bar = bar; b.x = xb_xcc_id(); b.st = st;
    if (threadIdx.x == 0) (void)xb_add(&bar[XB_XCNT(b.x)], 1u);
    return b;
}
__device__ __forceinline__ void xcd_barrier_complete(unsigned* bar, unsigned x, unsigned& nloc, unsigned& nx) {
    const unsigned G = gridDim.x * gridDim.y * gridDim.z;
    unsigned sum, cnt, mine, sp = 0u;
    for (;;) {
        sum = 0u; cnt = 0u; mine = 0u;
#pragma unroll
        for (unsigned j = 0; j < 16; ++j) { const unsigned c = xb_ld(&bar[XB_XCNT(j)]); sum += c; cnt += (c > 0u) ? 1u : 0u; mine = (j == x) ? c : mine; }
        if (sum == G) break;
        __builtin_amdgcn_s_sleep(1);
        if ((++sp & 255u) == 0u) { if (xb_ld(&bar[XB_TMO])) break; if (sp > XB_SPIN_CAP) { atomicAdd(&bar[XB_TMO], 1u); break; } }
    }
    nloc = mine > 0u ? mine : 1u; nx = cnt > 0u ? cnt : 1u;
}
__device__ __forceinline__ void xcd_barrier(const XcdBarrier& b) {
    asm volatile("s_waitcnt vmcnt(0)" ::: "memory");
    __syncthreads();
    if (threadIdx.x == 0) {
        unsigned* bar = b.bar;
        __builtin_amdgcn_s_waitcnt(0);
        unsigned nloc = b.st[0], nx = b.st[1];
        if (nloc == 0u) { xcd_barrier_complete(bar, b.x, nloc, nx); b.st[0] = nloc; b.st[1] = nx; }
        const unsigned old = xb_add(&bar[XB_XSUB(b.x)], 1u);
        const unsigned gen = old / nloc;
        if (old + 1u == (gen + 1u) * nloc) {
            __builtin_amdgcn_fence(__ATOMIC_RELEASE, "agent");
            asm volatile("s_waitcnt vmcnt(0)" ::: "memory");
            const unsigned og = xb_add(&bar[XB_TOP], 1u);
            const unsigned tg = og / nx;
            if (og + 1u == (tg + 1u) * nx) xb_add(&bar[XB_TOPGEN], 1u);
            else XB_SPIN(xb_ld(&bar[XB_TOPGEN]) == tg, bar);
            __builtin_amdgcn_fence(__ATOMIC_ACQUIRE, "agent");
            xb_add(&bar[XB_XGEN(b.x)], 1u);
            asm volatile("s_waitcnt vmcnt(0)" ::: "memory");
        } else {
            XB_SPIN(xb_ld(&bar[XB_XGEN(b.x)]) == gen, bar);
            __builtin_amdgcn_fence(__ATOMIC_ACQUIRE, "agent");
            asm volatile("s_waitcnt vmcnt(0)" ::: "memory");
        }
    }
    __syncthreads();
}

struct Args { const float* in[27]; float* out; unsigned char* ws; int ph_lo, ph_hi, li, pad; };
enum { I_X = 0, I_C, I_ADAW, I_ADAB, I_LNG, I_LNB, I_GWIN, I_GWG2F, I_GBGF, I_GWG2B, I_GBGB, I_GNORM, I_GWOUT, I_SWIN, I_SBIN, I_SLNG, I_SLNB, I_SWS, I_SBS, I_SWOUT, I_SBOUT, I_RW, I_RB, I_WUP, I_BUP, I_WDN, I_BDN };

typedef const __attribute__((address_space(4))) Args* KA;
#define PHASE_ENTER() unsigned m1_ = ~0u; asm volatile("" : "+s"(m1_)); int tid = (wave_s << 6) | (int)__builtin_amdgcn_mbcnt_hi(m1_, __builtin_amdgcn_mbcnt_lo(m1_, 0u)); asm volatile("" : "+v"(tid)); int bx = blockIdx.x, G = gridDim.x; asm volatile("" : "+s"(bx), "+s"(G)); \
    KA a = (KA)__builtin_amdgcn_kernarg_segment_ptr(); asm volatile("" : "+s"(a)); unsigned char* ws = a->ws; \
    extern __shared__ __attribute__((aligned(16))) unsigned char lds_raw[]; LAS unsigned char* lds = (LAS unsigned char*)lds_raw; (void)lds; (void)ws; (void)bx; (void)G; (void)tid
__device__ __forceinline__ int swiglu_perm(int o) {
    const int a = o >> 1, h = o & 1, pn = a >> 7, r = a & 127, bj = r >> 6, r2 = r & 63, wc = r2 >> 4, r3 = r2 & 15;
    return 256 * pn + 128 * bj + 32 * wc + 16 * h + r3;
}
__device__ __forceinline__ void conv_tile(const float* W, int K, int N, int k0, int n0, int nw, bf16* dst, int mode, LAS float* scr, int lane) {
    const int c4 = lane & 15, kr = lane >> 4;
    if (4 * c4 < nw) {
#pragma unroll 4
        for (int i = 0; i < 16; ++i) { const int kk = 4 * i + kr; const f32x4 v = *(const f32x4*)(W + (size_t)(k0 + kk) * N + n0 + 4 * c4);
            LAS float* s = scr + kk * 65 + 4 * c4; s[0] = v[0]; s[1] = v[1]; s[2] = v[2]; s[3] = v[3]; }
    }
    LDS_WAIT(); asm volatile("" ::: "memory");
    const int kc = lane & 7, ns = lane >> 3;
    for (int j = 0; j < nw / 8; ++j) {
        const int n = ns + 8 * j; const LAS float* s = scr + (8 * kc) * 65 + n;
        float v[8];
#pragma unroll
        for (int q = 0; q < 8; ++q) v[q] = s[q * 65];
        u32x4 o; o.x = cvt_pk_bf16(v[0], v[1]); o.y = cvt_pk_bf16(v[2], v[3]); o.z = cvt_pk_bf16(v[4], v[5]); o.w = cvt_pk_bf16(v[6], v[7]);
        const int ng = n0 + n;
        if (mode == 2) {
            *(u32x4*)(dst + (size_t)n * K + k0 + 8 * kc) = o;
            u32x4 l; l.x = cvt_pk_bf16(v[0] - bf_lo(o.x), v[1] - bf_hi(o.x)); l.y = cvt_pk_bf16(v[2] - bf_lo(o.y), v[3] - bf_hi(o.y));
            l.z = cvt_pk_bf16(v[4] - bf_lo(o.z), v[5] - bf_hi(o.z)); l.w = cvt_pk_bf16(v[6] - bf_lo(o.w), v[7] - bf_hi(o.w));
            *(u32x4*)(dst + (size_t)(32 + n) * K + k0 + 8 * kc) = l;
        } else {
            const int row = (mode == 1) ? swiglu_perm(ng) : ng;
            *(u32x4*)(dst + (size_t)row * K + k0 + 8 * kc) = o;
        }
    }
    LDS_WAIT(); asm volatile("" ::: "memory");
}

__device__ __forceinline__ void phase_prologue(KA a, LAS unsigned char* lds, int tid, int bx, int G) {
    const int lane = tid & 63, wave = __builtin_amdgcn_readfirstlane(tid >> 6);
    unsigned char* ws = a->ws;
    for (int slab = bx; slab < 192; slab += G) {
        LAS float* sc = (LAS float*)lds;
        LAS float* red = (LAS float*)(lds + 32768);
        for (int i = tid; i < 8 * 1024; i += NTHREADS) sc[i] = silu_f(a->in[I_C][i]);
        __syncthreads();
        const int g0 = slab * 128, l = g0 / 6144, e0 = g0 % 6144;
        const int c4 = tid & 31, seg = tid >> 5;
        f32x4 acc[8];
#pragma unroll
        for (int b = 0; b < 8; ++b) acc[b] = (f32x4){0.f, 0.f, 0.f, 0.f};
        const float* wp = a->in[I_ADAW] + ((size_t)l * 1024 + seg * 64) * 6144 + e0 + 4 * c4;
#pragma unroll 8
        for (int d = 0; d < 64; ++d) { const f32x4 w = *(const f32x4*)(wp + (size_t)d * 6144);
#pragma unroll
            for (int b = 0; b < 8; ++b) acc[b] += w * sc[b * 1024 + seg * 64 + d]; }
#pragma unroll
        for (int b = 0; b < 8; ++b) *(LAS f32x4*)(red + (seg * 8 + b) * 128 + 4 * c4) = acc[b];
        __syncthreads();
        for (int o = tid; o < 1024; o += NTHREADS) { const int b = o >> 7, c = o & 127; float s = a->in[I_ADAB][l * 6144 + e0 + c];
#pragma unroll
            for (int sg = 0; sg < 16; ++sg) s += red[(sg * 8 + b) * 128 + c];
            ((float*)(ws + WS_MOD))[((size_t)l * 8 + b) * 6144 + e0 + c] = s; }
        __syncthreads();
    }
    LAS float* scr = (LAS float*)(lds + wave * 16640);
    const int gw = bx * NWAVES + wave, NGW = G * NWAVES;
    constexpr int N_UP = 128 * 16 * 32, N_DN = 128 * 16 * 16, N_GIN = 2 * 16 * 48, N_GLR = 2 * 16, N_GOUT = 2 * 256, N_SIN = 2 * 16 * 32, N_SOUT = 2 * 256, N_RT = 4 * 16;
    constexpr int NITEMS = N_UP + N_DN + N_GIN + N_GLR + N_GOUT + N_SIN + N_SOUT + N_RT;
    for (int it = gw; it < NITEMS; it += NGW) {
        int r = it;
        if (r < N_UP) { const int m = r >> 9, q = r & 511, kt = q >> 5, nt = q & 31;
            conv_tile(a->in[I_WUP] + (size_t)m * 1024 * 2048, 1024, 2048, kt * 64, nt * 64, 64, (bf16*)(ws + WS_WUP_T) + (size_t)m * 2048 * 1024, 1, scr, lane); continue; } r -= N_UP;
        if (r < N_DN) { const int m = r >> 8, q = r & 255, kt = q >> 4, nt = q & 15;
            conv_tile(a->in[I_WDN] + (size_t)m * 1024 * 1024, 1024, 1024, kt * 64, nt * 64, 64, (bf16*)(ws + WS_WDN_T) + (size_t)m * 1024 * 1024, 0, scr, lane); continue; } r -= N_DN;
        if (r < N_GIN) { const int m = r / 768, q = r % 768, kt = q / 48, nt = q % 48;
            conv_tile(a->in[I_GWIN] + (size_t)m * 1024 * GLA_IN, 1024, GLA_IN, kt * 64, nt * 64, 64, (bf16*)(ws + WS_GLAIN_T) + (size_t)m * GLA_MAIN * 1024, 0, scr, lane); continue; } r -= N_GIN;
        if (r < N_GLR) { const int m = r >> 4, kt = r & 15;
            conv_tile(a->in[I_GWIN] + (size_t)m * 1024 * GLA_IN, 1024, GLA_IN, kt * 64, GLA_MAIN, 32, (bf16*)(ws + WS_GLALR_T) + (size_t)m * 64 * 1024, 2, scr, lane); continue; } r -= N_GLR;
        if (r < N_GOUT) { const int m = r >> 8, q = r & 255, kt = q >> 4, nt = q & 15;
            conv_tile(a->in[I_GWOUT] + (size_t)m * 1024 * 1024, 1024, 1024, kt * 64, nt * 64, 64, (bf16*)(ws + WS_GLAOUT_T) + (size_t)m * 1024 * 1024, 0, scr, lane); continue; } r -= N_GOUT;
        if (r < N_SIN) { const int m = r >> 9, q = r & 511, kt = q >> 5, nt = q & 31;
            conv_tile(a->in[I_SWIN] + (size_t)m * 1024 * 2048, 1024, 2048, kt * 64, nt * 64, 64, (bf16*)(ws + WS_SGUIN_T) + (size_t)m * 2048 * 1024, 0, scr, lane); continue; } r -= N_SIN;
        if (r < N_SOUT) { const int m = r >> 8, q = r & 255, kt = q >> 4, nt = q & 15;
            conv_tile(a->in[I_SWOUT] + (size_t)m * 1024 * 1024, 1024, 1024, kt * 64, nt * 64, 64, (bf16*)(ws + WS_SGUOUT_T) + (size_t)m * 1024 * 1024, 0, scr, lane); continue; } r -= N_SOUT;
        { const int m = r >> 4, kt = r & 15;
            conv_tile(a->in[I_RW] + (size_t)m * 1024 * 32, 1024, 32, kt * 64, 0, 32, (bf16*)(ws + WS_ROUTER_T) + (size_t)m * 64 * 1024, 2, scr, lane); }
    }
    { bf16* d = (bf16*)(ws + WS_SGUWS); const float* s = a->in[I_SWS];
      for (int i = (bx * NTHREADS + tid) * 4; i < 2 * 8 * 128 * 128; i += G * NTHREADS * 4) { const f32x4 v = *(const f32x4*)(s + i); u32x2 o; o.x = cvt_pk_bf16(v[0], v[1]); o.y = cvt_pk_bf16(v[2], v[3]); *(u32x2*)(d + i) = o; } }
}

struct RowPass {
    const float* xin; const float* y; float* xout; bf16* hout;
    const float* gate; const float* lng; const float* lnb; const float* sc; const float* sh;
    const bf16* wside;
    float* lr_out;
    const float* rbias;
    int* topi; float* topw; int* hist;
    const bf16* ys; const int* dest; const float* tw;
    int has_h, has_side;
};
template <int MODE>
__device__ __forceinline__ void row_pass(const RowPass& p, LAS unsigned char* lds, int tid, int bx, int G) {
    const int lane = tid & 63, wave = __builtin_amdgcn_readfirstlane(tid >> 6);
    constexpr int HS = 1032;
    LAS bf16* Hhi = (LAS bf16*)lds;
    LAS bf16* Hlo = (LAS bf16*)(lds + 16 * HS * 2);
    LAS float* part = (LAS float*)(lds + 2 * 16 * HS * 2);
    LAS float* logit = part + 8 * 32 * 16;
    LAS int* lhist = (LAS int*)(logit + 16 * 32);
    if (MODE == 1) { if (tid < 32) lhist[tid] = 0; }
    const bool side = (p.has_side != 0) && (p.wside != nullptr);
    bf16x8 whi[2][4], wlo[2][4];
    if (side) {
#pragma unroll
        for (int hf = 0; hf < 2; ++hf)
#pragma unroll
            for (int s = 0; s < 4; ++s) { const size_t off = (size_t)(hf * 16 + (lane & 15)) * 1024 + 128 * wave + 32 * s + 8 * (lane >> 4);
                whi[hf][s] = *(const bf16x8*)(p.wside + off); wlo[hf][s] = *(const bf16x8*)(p.wside + 32 * 1024 + off); }
    }
    for (int tile = bx; tile < T / 16; tile += G) {
        const int b = (tile * 16) / SEQ;
#pragma unroll 1
        for (int tt = 0; tt < 2; ++tt) {
            const int tl = 2 * wave + tt, token = tile * 16 + tl;
            f32x4 v[4];
            const float* xr = p.xin + (size_t)token * D + 4 * lane;
#pragma unroll
            for (int j = 0; j < 4; ++j) v[j] = *(const f32x4*)(xr + 256 * j);
            if (MODE == 1) {
                const float* yr = p.y + (size_t)token * D + 4 * lane; const float* gp = p.gate + (size_t)b * 6144 + 4 * lane;
#pragma unroll
                for (int j = 0; j < 4; ++j) { const f32x4 yy = *(const f32x4*)(yr + 256 * j); const f32x4 g = *(const f32x4*)(gp + 256 * j); v[j] = v[j] * ALPHA + (g + 1.0f) * yy; }
            }
            if (MODE == 2) {
                f32x4 ya[4];
#pragma unroll
                for (int j = 0; j < 4; ++j) ya[j] = (f32x4){0.f, 0.f, 0.f, 0.f};
#pragma unroll
                for (int k = 0; k < 4; ++k) { const int ds = p.dest[token * 4 + k]; const float w = p.tw[token * 4 + k]; const bf16* yr = p.ys + (size_t)ds * D + 4 * lane;
#pragma unroll
                    for (int j = 0; j < 4; ++j) { const u32x2 q = *(const u32x2*)(yr + 256 * j); ya[j] += (f32x4){bf_lo(q.x), bf_hi(q.x), bf_lo(q.y), bf_hi(q.y)} * w; } }
                const float* gp = p.gate + (size_t)b * 6144 + 4 * lane;
#pragma unroll
                for (int j = 0; j < 4; ++j) { const f32x4 g = *(const f32x4*)(gp + 256 * j); v[j] = v[j] * ALPHA + (g + 1.0f) * ya[j]; }
            }
            if (MODE != 0) {
                float s = 0.f;
#pragma unroll
                for (int j = 0; j < 4; ++j) s += (v[j][0] + v[j][1]) + (v[j][2] + v[j][3]);
                const float mean = wave_sum(s, lane) * (1.0f / D); float s2 = 0.f;
#pragma unroll
                for (int j = 0; j < 4; ++j) { v[j] = v[j] - mean; s2 += (v[j][0] * v[j][0] + v[j][1] * v[j][1]) + (v[j][2] * v[j][2] + v[j][3] * v[j][3]); }
                const float rstd = 1.0f / sqrtf(wave_sum(s2, lane) * (1.0f / D) + LN_EPS);
                float* xo = p.xout + (size_t)token * D + 4 * lane;
#pragma unroll
                for (int j = 0; j < 4; ++j) { const f32x4 g = *(const f32x4*)(p.lng + 4 * lane + 256 * j), bb = *(const f32x4*)(p.lnb + 4 * lane + 256 * j); v[j] = v[j] * rstd * g + bb; *(f32x4*)(xo + 256 * j) = v[j]; }
            }
            if (p.has_h) {
                const float* scp = p.sc + (size_t)b * 6144 + 4 * lane; const float* shp = p.sh + (size_t)b * 6144 + 4 * lane;
                bf16* ho = p.hout + (size_t)token * D + 4 * lane;
#pragma unroll
                for (int j = 0; j < 4; ++j) { const f32x4 s1 = *(const f32x4*)(scp + 256 * j), s0 = *(const f32x4*)(shp + 256 * j); const f32x4 h = v[j] * (s1 + 1.0f) + s0;
                    u32x2 o; o.x = cvt_pk_bf16(h[0], h[1]); o.y = cvt_pk_bf16(h[2], h[3]); *(u32x2*)(ho + 256 * j) = o;
                    if (side) { u32x2 l; l.x = cvt_pk_bf16(h[0] - bf_lo(o.x), h[1] - bf_hi(o.x)); l.y = cvt_pk_bf16(h[2] - bf_lo(o.y), h[3] - bf_hi(o.y));
                        *(LAS u32x2*)(Hhi + tl * HS + 4 * lane + 256 * j) = o; *(LAS u32x2*)(Hlo + tl * HS + 4 * lane + 256 * j) = l; } }
            }
        }
        if (side) {
            __syncthreads();
            f32x4 acc[2]; acc[0] = (f32x4){0.f, 0.f, 0.f, 0.f}; acc[1] = acc[0];
#pragma unroll
            for (int s = 0; s < 4; ++s) { const int ko = (lane & 15) * HS + 128 * wave + 32 * s + 8 * (lane >> 4);
                const bf16x8 bh = *(const LAS bf16x8*)(Hhi + ko), bl = *(const LAS bf16x8*)(Hlo + ko);
#pragma unroll
                for (int hf = 0; hf < 2; ++hf) { acc[hf] = __builtin_amdgcn_mfma_f32_16x16x32_bf16(whi[hf][s], bh, acc[hf], 0, 0, 0);
                    acc[hf] = __builtin_amdgcn_mfma_f32_16x16x32_bf16(wlo[hf][s], bh, acc[hf], 0, 0, 0); acc[hf] = __builtin_amdgcn_mfma_f32_16x16x32_bf16(whi[hf][s], bl, acc[hf], 0, 0, 0); } }
#pragma unroll
            for (int hf = 0; hf < 2; ++hf)
#pragma unroll
                for (int j = 0; j < 4; ++j) part[(wave * 32 + hf * 16 + 4 * (lane >> 4) + j) * 16 + (lane & 15)] = acc[hf][j];
            __syncthreads();
            { const int e = tid >> 4, tk = tid & 15; float s = 0.f;
#pragma unroll
              for (int w = 0; w < 8; ++w) s += part[(w * 32 + e) * 16 + tk];
              if (MODE == 1) logit[tk * 32 + e] = s + p.rbias[e];
              else p.lr_out[(size_t)(tile * 16 + tk) * 32 + e] = s; }
            if (MODE == 1) {
                __syncthreads();
                if (tid < 16) {
                    const int token = tile * 16 + tid; float lv[32];
#pragma unroll
                    for (int e = 0; e < 32; ++e) lv[e] = logit[tid * 32 + e];
                    int bi[4]; float bv[4];
#pragma unroll
                    for (int k = 0; k < 4; ++k) { float m = -3.0e38f; int mi = 0;
#pragma unroll
                        for (int e = 0; e < 32; ++e) { const bool take = lv[e] > m; m = take ? lv[e] : m; mi = take ? e : mi; }
                        bi[k] = mi; bv[k] = m;
#pragma unroll
                        for (int e = 0; e < 32; ++e) lv[e] = (e == mi) ? -3.0e38f : lv[e]; }
                    const float e1 = __expf(bv[1] - bv[0]), e2 = __expf(bv[2] - bv[0]), e3 = __expf(bv[3] - bv[0]); const float inv = 1.0f / (1.0f + e1 + e2 + e3);
                    *(int4*)(p.topi + token * 4) = make_int4(bi[0], bi[1], bi[2], bi[3]);
                    *(f32x4*)(p.topw + token * 4) = (f32x4){inv, e1 * inv, e2 * inv, e3 * inv};
#pragma unroll
                    for (int k = 0; k < 4; ++k) atomicAdd((int*)&lhist[bi[k]], 1);
                }
            }
            __syncthreads();
        }
    }
    if (MODE == 1) { __syncthreads(); if (tid < 32) p.hist[tid] = lhist[tid]; }
}

__device__ __forceinline__ void phase_place(int* route, LAS unsigned char* lds, int tid, int bx, int G) {
    const int lane = tid & 63, wave = tid >> 6;
    LAS int* ptot = (LAS int*)lds;
    LAS int* ppre = ptot + 512;
    LAS int* tot = ppre + 512;
    LAS int* pre = tot + 32;
    LAS int* pstart = pre + 32;
    const int* hist = route + R_HIST;
    { const int e = tid & 31, part = tid >> 5; int st = 0, sp = 0;
      for (int bb = part; bb < G; bb += 16) { const int h = hist[bb * 32 + e]; st += h; if (bb < bx) sp += h; }
      ptot[part * 32 + e] = st; ppre[part * 32 + e] = sp; }
    __syncthreads();
    if (tid < 32) { int st = 0, sp = 0;
#pragma unroll
        for (int q = 0; q < 16; ++q) { st += ptot[q * 32 + tid]; sp += ppre[q * 32 + tid]; }
        tot[tid] = st; pre[tid] = sp; }
    __syncthreads();
    if (tid == 0) { int acc = 0; for (int e = 0; e < 32; ++e) { pstart[e] = acc; acc += (tot[e] + 255) / 256 * 256; } pstart[32] = acc; }
    __syncthreads();
    if (bx == 0) {
        const int ntiles = pstart[32] / 256;
        if (tid == 0) route[R_NTILES] = ntiles;
        for (int t = tid; t < ntiles; t += NTHREADS) { int e = 0; for (int q = 1; q < 32; ++q) if (pstart[q] <= t * 256) e = q; route[R_TILEE + t] = e; }
    }
    for (int e = bx; e < 32; e += G) { const int s0 = pstart[e] + tot[e], s1 = pstart[e + 1]; for (int s = s0 + tid; s < s1; s += NTHREADS) route[R_BUFTOK + s] = 0; }
    if (wave == 0) {
        int run = 0;
        for (int tile = bx; tile < T / 16; tile += G) {
            const int token = tile * 16 + (lane >> 2);
            const int e = route[R_TOPI + tile * 64 + lane];
            const int base = shfl_i(run, e, lane);
            int rank = 0, add = 0;
#pragma unroll 1
            for (int x = 0; x < 32; ++x) { const unsigned long long m = __ballot(e == x); if (e == x) rank = __popcll(m & ((1ull << lane) - 1ull)); if (lane == x) add = __popcll(m); }
            run += add;
            const int ds = pstart[e] + pre[e] + base + rank;
            route[R_DEST + tile * 64 + lane] = ds;
            route[R_BUFTOK + ds] = token;
        }
    }
}

struct Unit { int pm, pn, e; const bf16* bt; };
constexpr int NXCD = 8, WGM = 8;
struct Sched {
    int nM, nN, nwg, G, c; const bf16* Bt; size_t estride; const int* tile_e; int K;
    __device__ __forceinline__ void init(int nM_, int nN_, int G_, int c_, const bf16* Bt_, size_t es, const int* te, int K_) { nM = nM_; nN = nN_; nwg = nM * nN; G = G_; c = c_; Bt = Bt_; estride = es; tile_e = te; K = K_; }
    __device__ __forceinline__ bool next(int i, Unit& u) const {
        const long L = (long)i * G + c; if (L >= nwg) return false;
        int wgid = (int)L; { const int q = nwg / NXCD, r = nwg % NXCD, xcd = wgid % NXCD, off = wgid / NXCD; wgid = (xcd < r ? xcd * (q + 1) : r * (q + 1) + (xcd - r) * q) + off; }
        const int nig = WGM * nN, gid = wgid / nig, fm = gid * WGM, gsz = (nM - fm) < WGM ? (nM - fm) : WGM;
        u.pm = fm + ((wgid % nig) % gsz); u.pn = (wgid % nig) / gsz;
        u.e = tile_e ? __builtin_amdgcn_readfirstlane(tile_e[u.pm]) : 0;
        u.bt = Bt + (size_t)u.e * estride + (size_t)u.pn * 256 * K;
        return true;
    }
};
struct EpiGlaIn { bf16* O;
    __device__ __forceinline__ void operator()(const f32x4 (&acc)[2][2][4][2], const Unit& u, int wr, int wc, int fr, int fq) const {
        const int row0 = u.pm * 256 + wr * 64 + fr, col0 = u.pn * 256 + wc * 32 + 4 * fq; const float sc = (u.pn < 2) ? 0.08838834764831845f : 1.0f;
#pragma unroll
        for (int ai = 0; ai < 2; ++ai)
#pragma unroll
            for (int m = 0; m < 4; ++m) { bf16* rp = O + (size_t)(row0 + ai * 128 + m * 16) * GLA_MAIN + col0;
#pragma unroll
                for (int bj = 0; bj < 2; ++bj)
#pragma unroll
                    for (int n = 0; n < 2; ++n) { const f32x4 v = acc[ai][bj][m][n] * sc; u32x2 o; o.x = cvt_pk_bf16(v[0], v[1]); o.y = cvt_pk_bf16(v[2], v[3]); *(u32x2*)(rp + bj * 128 + n * 16) = o; } }
    }
};
struct EpiSguIn { bf16* O; const float* bias;
    __device__ __forceinline__ void operator()(const f32x4 (&acc)[2][2][4][2], const Unit& u, int wr, int wc, int fr, int fq) const {
        const int row0 = u.pm * 256 + wr * 64 + fr, col0 = u.pn * 256 + wc * 32 + 4 * fq;
        f32x4 bv[2][2];
#pragma unroll
        for (int bj = 0; bj < 2; ++bj)
#pragma unroll
            for (int n = 0; n < 2; ++n) bv[bj][n] = *(const f32x4*)(bias + col0 + bj * 128 + n * 16);
#pragma unroll
        for (int ai = 0; ai < 2; ++ai)
#pragma unroll
            for (int m = 0; m < 4; ++m) { bf16* rp = O + (size_t)(row0 + ai * 128 + m * 16) * 2048 + col0;
#pragma unroll
                for (int bj = 0; bj < 2; ++bj)
#pragma unroll
                    for (int n = 0; n < 2; ++n) { const f32x4 v = acc[ai][bj][m][n] + bv[bj][n]; u32x2 o; o.x = cvt_pk_bf16(gelu_f(v[0]), gelu_f(v[1])); o.y = cvt_pk_bf16(gelu_f(v[2]), gelu_f(v[3])); *(u32x2*)(rp + bj * 128 + n * 16) = o; } }
    }
};
struct EpiOut { float* O; const float* bias;
    __device__ __forceinline__ void operator()(const f32x4 (&acc)[2][2][4][2], const Unit& u, int wr, int wc, int fr, int fq) const {
        const int row0 = u.pm * 256 + wr * 64 + fr, col0 = u.pn * 256 + wc * 32 + 4 * fq;
        f32x4 bv[2][2];
#pragma unroll
        for (int bj = 0; bj < 2; ++bj)
#pragma unroll
            for (int n = 0; n < 2; ++n) bv[bj][n] = bias ? *(const f32x4*)(bias + col0 + bj * 128 + n * 16) : (f32x4){0.f, 0.f, 0.f, 0.f};
#pragma unroll
        for (int ai = 0; ai < 2; ++ai)
#pragma unroll
            for (int m = 0; m < 4; ++m) { float* rp = O + (size_t)(row0 + ai * 128 + m * 16) * D + col0;
#pragma unroll
                for (int bj = 0; bj < 2; ++bj)
#pragma unroll
                    for (int n = 0; n < 2; ++n) *(f32x4*)(rp + bj * 128 + n * 16) = acc[ai][bj][m][n] + bv[bj][n]; }
    }
};
struct EpiUp { bf16* O; const float* bias;
    __device__ __forceinline__ void operator()(const f32x4 (&acc)[2][2][4][2], const Unit& u, int wr, int wc, int fr, int fq) const {
        const int row0 = u.pm * 256 + wr * 64 + fr, a0 = u.pn * 128 + wc * 16 + 4 * fq;
        f32x4 bg[2], bl[2];
#pragma unroll
        for (int bj = 0; bj < 2; ++bj) { const float* bp = bias + (size_t)u.e * 2048 + 2 * (a0 + 64 * bj); const f32x4 p0 = *(const f32x4*)bp, p1 = *(const f32x4*)(bp + 4);
            bg[bj] = (f32x4){p0[0], p0[2], p1[0], p1[2]}; bl[bj] = (f32x4){p0[1], p0[3], p1[1], p1[3]}; }
#pragma unroll
        for (int ai = 0; ai < 2; ++ai)
#pragma unroll
            for (int m = 0; m < 4; ++m) { bf16* rp = O + (size_t)(row0 + ai * 128 + m * 16) * D + a0;
#pragma unroll
                for (int bj = 0; bj < 2; ++bj) { const f32x4 g = acc[ai][bj][m][0] + bg[bj], l = acc[ai][bj][m][1] + bl[bj]; float r[4];
#pragma unroll
                    for (int j = 0; j < 4; ++j) { const float gg = fminf(g[j], 7.0f), ll = fminf(fmaxf(l[j], -7.0f), 7.0f); r[j] = gg * sigmoid_f(1.702f * gg) * (ll + 1.0f); }
                    u32x2 o; o.x = cvt_pk_bf16(r[0], r[1]); o.y = cvt_pk_bf16(r[2], r[3]); *(u32x2*)(rp + bj * 64) = o; } }
    }
};
struct EpiDown { bf16* O; const float* bias;
    __device__ __forceinline__ void operator()(const f32x4 (&acc)[2][2][4][2], const Unit& u, int wr, int wc, int fr, int fq) const {
        const int row0 = u.pm * 256 + wr * 64 + fr, col0 = u.pn * 256 + wc * 32 + 4 * fq;
        f32x4 bv[2][2];
#pragma unroll
        for (int bj = 0; bj < 2; ++bj)
#pragma unroll
            for (int n = 0; n < 2; ++n) bv[bj][n] = *(const f32x4*)(bias + (size_t)u.e * 1024 + col0 + bj * 128 + n * 16);
#pragma unroll
        for (int ai = 0; ai < 2; ++ai)
#pragma unroll
            for (int m = 0; m < 4; ++m) { bf16* rp = O + (size_t)(row0 + ai * 128 + m * 16) * D + col0;
#pragma unroll
                for (int bj = 0; bj < 2; ++bj)
#pragma unroll
                    for (int n = 0; n < 2; ++n) { const f32x4 v = acc[ai][bj][m][n] + bv[bj][n]; u32x2 o; o.x = cvt_pk_bf16(v[0], v[1]); o.y = cvt_pk_bf16(v[2], v[3]); *(u32x2*)(rp + bj * 128 + n * 16) = o; } }
    }
};

template <class Epi>
__device__ __forceinline__ void gemm_naive(const bf16* A, const int* gather, int K, const Sched& S, const Epi& E, int tid) {
    const int wid = __builtin_amdgcn_readfirstlane(tid >> 6), lane = tid & 63, wr = wid >> 2, wc = wid & 3, fr = lane & 15, fq = lane >> 4;
    Unit u;
    for (int ui = 0; S.next(ui, u); ++ui) {
        f32x4 acc[2][2][4][2];
#pragma unroll
        for (int a = 0; a < 2; ++a)
#pragma unroll
            for (int b = 0; b < 2; ++b)
#pragma unroll
                for (int m = 0; m < 4; ++m)
#pragma unroll
                    for (int n = 0; n < 2; ++n) acc[a][b][m][n] = (f32x4){0.f, 0.f, 0.f, 0.f};
        unsigned ap[2][4], bp[2][2];
#pragma unroll
        for (int ai = 0; ai < 2; ++ai)
#pragma unroll
            for (int m = 0; m < 4; ++m) { const int r = u.pm * 256 + ai * 128 + wr * 64 + m * 16 + fr; const int ar = gather ? gather[r] : r; ap[ai][m] = (unsigned)ar * (unsigned)K + 8u * fq; }
#pragma unroll
        for (int bj = 0; bj < 2; ++bj)
#pragma unroll
            for (int n = 0; n < 2; ++n) bp[bj][n] = (unsigned)(bj * 128 + wc * 32 + n * 16 + fr) * (unsigned)K + 8u * fq;
#pragma unroll 1
        for (int k0 = 0; k0 < K; k0 += 32) {
            bf16x8 af[2][4], bfr[2][2];
#pragma unroll
            for (int ai = 0; ai < 2; ++ai)
#pragma unroll
                for (int m = 0; m < 4; ++m) af[ai][m] = *(const bf16x8*)(A + ap[ai][m] + k0);
#pragma unroll
            for (int bj = 0; bj < 2; ++bj)
#pragma unroll
                for (int n = 0; n < 2; ++n) bfr[bj][n] = *(const bf16x8*)(u.bt + bp[bj][n] + k0);
#pragma unroll
            for (int ai = 0; ai < 2; ++ai)
#pragma unroll
                for (int bj = 0; bj < 2; ++bj)
#pragma unroll
                    for (int m = 0; m < 4; ++m)
#pragma unroll
                        for (int n = 0; n < 2; ++n) acc[ai][bj][m][n] = __builtin_amdgcn_mfma_f32_16x16x32_bf16(bfr[bj][n], af[ai][m], acc[ai][bj][m][n], 0, 0, 0);
        }
        E(acc, u, wr, wc, fr, fq);
    }
}

constexpr int G8_BK = 64, G8_HALF = 128, G8_HTB = G8_HALF * G8_BK * 2, G8_STAGE_BYTES = 8 * G8_HTB;
__device__ __forceinline__ int g8_lds_byte(int r, int c) { const int st = (r >> 4) * 2 + (c >> 5), rr = r & 15, cc = c & 31, ob = rr * 64 + cc * 2; return st * 1024 + (ob ^ (((ob >> 9) & 1) << 5)); }
__device__ __forceinline__ void g8_stage_rc(int b, int& R, int& C) { const int st = b / 1024, sb = b % 1024, swz = sb ^ (((sb >> 9) & 1) << 5); R = (st >> 1) * 16 + swz / 64; C = (st & 1) * 32 + (swz % 64) / 2; }
__device__ __forceinline__ u32x4 g8_avoff(int pm, const int* gather, int tid, int K) {
    int t2 = tid; asm volatile("" : "+v"(t2));
    int R, C; g8_stage_rc(t2 * 16, R, C);
    const int* gp = gather + pm * 256 + R;
    const unsigned r00 = gp[0], r01 = gp[64], r10 = gp[128], r11 = gp[192], c2 = (unsigned)(C * 2), k2 = (unsigned)(K * 2);
    return (u32x4){r00 * k2 + c2, r01 * k2 + c2, r10 * k2 + c2, r11 * k2 + c2};
}
template <bool GATHER, class Epi>
__device__ __forceinline__ void gemm_fast(const bf16* A, const int* gather, const int K, const Sched& S, const Epi& E, LAS unsigned char* lds, int tid) {
    const int wid = __builtin_amdgcn_readfirstlane(tid >> 6), lane = tid & 63, wr = wid >> 2, wc = wid & 3, fr = lane & 15, fq = lane >> 4;
    const int nt = K / G8_BK;
    unsigned voff; { int R, C; g8_stage_rc(tid * 16, R, C); voff = (unsigned)(R * K + C) * 2u; }
    const size_t kstep = (size_t)(G8_BK * 2), hstep = (size_t)G8_HALF * K * 2, qstep = (size_t)64 * K * 2, tstep = 2 * hstep;
    const unsigned ldsw = (unsigned)wid * 1024u;
    const int aoff = g8_lds_byte(wr * 64 + fr, fq * 8), boff = g8_lds_byte(wc * 32 + fr, fq * 8);
#define G8_SA(b, h) (((b) * 2 + (h)) * G8_HTB)
#define G8_SB(b, h) ((4 + (b) * 2 + (h)) * G8_HTB)
#define G8_GLDS(gp, ldsoff) __builtin_amdgcn_global_load_lds((const unsigned*)(gp), (LAS unsigned*)(lds + (ldsoff)), 16, 0, 0)
#define G8_STAGE_D(bufoff, gbase) do { G8_GLDS((const char*)(gbase) + voff, (bufoff) + ldsw); G8_GLDS((const char*)(gbase) + qstep + voff, (bufoff) + ldsw + 8192); } while (0)
#define G8_STAGE_A(bufoff, kb, h) do { if constexpr (GATHER) { G8_GLDS((kb) + va[(h) * 2], (bufoff) + ldsw); G8_GLDS((kb) + va[(h) * 2 + 1], (bufoff) + ldsw + 8192); } \
        else { G8_STAGE_D(bufoff, (kb) + (h) * hstep); } } while (0)
#define G8_LDA(dst, b, h) do { _Pragma("unroll") for (int m = 0; m < 4; ++m) _Pragma("unroll") for (int k = 0; k < 2; ++k) dst[m][k] = *(const LAS bf16x8*)(lds + G8_SA(b, h) + aoff + m * 2048 + k * 1024); } while (0)
#define G8_LDB(dst, b, h) do { _Pragma("unroll") for (int n = 0; n < 2; ++n) _Pragma("unroll") for (int k = 0; k < 2; ++k) dst[n][k] = *(const LAS bf16x8*)(lds + G8_SB(b, h) + boff + n * 2048 + k * 1024); } while (0)
#define G8_MMA(ai, bj, At, Bt) do { __builtin_amdgcn_s_setprio(1); _Pragma("unroll") for (int m = 0; m < 4; ++m) _Pragma("unroll") for (int n = 0; n < 2; ++n) _Pragma("unroll") for (int k = 0; k < 2; ++k) \
        acc[ai][bj][m][n] = __builtin_amdgcn_mfma_f32_16x16x32_bf16(Bt[n][k], At[m][k], acc[ai][bj][m][n], 0, 0, 0); __builtin_amdgcn_s_setprio(0); } while (0)
#define G8_WAIT_V(n) asm volatile("s_waitcnt vmcnt(" #n ")" ::: "memory")
#define G8_WAIT_L(n) asm volatile("s_waitcnt lgkmcnt(" #n ")" ::: "memory")
#define G8_BAR __builtin_amdgcn_s_barrier()
#define G8_SCHED __builtin_amdgcn_sched_barrier(0)
    Unit cur, nxt; int ui = 0;
    if (!S.next(0, cur)) return;
    f32x4 acc[2][2][4][2];
#pragma unroll
    for (int a = 0; a < 2; ++a)
#pragma unroll
        for (int b = 0; b < 2; ++b)
#pragma unroll
            for (int m = 0; m < 4; ++m)
#pragma unroll
                for (int n = 0; n < 2; ++n) acc[a][b][m][n] = (f32x4){0.f, 0.f, 0.f, 0.f};
    bf16x8 At[4][2], B0[2][2], B1[2][2];
    u32x4 va = (u32x4){0u, 0u, 0u, 0u};
    if constexpr (GATHER) va = g8_avoff(cur.pm, gather, tid, K);
    LAS u32x4* vslot = (LAS u32x4*)(lds + G8_STAGE_BYTES) + tid;
    const char* cB = (const char*)cur.bt; const char* cA = (const char*)A + (GATHER ? (size_t)0 : (size_t)cur.pm * tstep);
    G8_STAGE_D(G8_SB(0, 0), cB); G8_STAGE_D(G8_SB(0, 1), cB + hstep); G8_STAGE_A(G8_SA(0, 0), cA, 0); G8_STAGE_A(G8_SA(0, 1), cA, 1);
    if (wr == 1) G8_BAR;
    G8_WAIT_V(2); G8_BAR;
    G8_STAGE_D(G8_SB(1, 0), cB + kstep); G8_STAGE_A(G8_SA(1, 0), cA + kstep, 0); G8_STAGE_D(G8_SB(1, 1), cB + hstep + kstep);
    G8_WAIT_V(6); G8_BAR;
    for (;;) {
        const bool has_next = S.next(ui + 1, nxt);
        if constexpr (GATHER) { if (has_next) *vslot = g8_avoff(nxt.pm, gather, tid, K); }
        const char* nB = has_next ? (const char*)nxt.bt : cB;
        const char* nA = (GATHER || !has_next) ? cA : (const char*)A + (size_t)nxt.pm * tstep;
        for (int t = 0; t < nt; t += 2) {
            const bool last = (t == nt - 2);
            const char* a1 = cA + (size_t)(t + 1) * kstep;
            const char* a2 = last ? nA : cA + (size_t)(t + 2) * kstep; const char* b2 = last ? nB : cB + (size_t)(t + 2) * kstep;
            const char* a3 = a2 + kstep; const char* b3 = b2 + kstep;
            G8_LDB(B0, 0, 0); G8_LDB(B1, 0, 1); G8_SCHED; G8_LDA(At, 0, 0); G8_STAGE_A(G8_SA(1, 1), a1, 1);
            if constexpr (GATHER) { if (last && has_next) va = *vslot; }
            G8_WAIT_V(8); G8_WAIT_L(0); G8_BAR; G8_MMA(0, 0, At, B0); G8_MMA(0, 1, At, B1); G8_BAR; G8_SCHED;
            G8_LDA(At, 0, 1); G8_STAGE_D(G8_SB(0, 0), b2); G8_STAGE_D(G8_SB(0, 1), b2 + hstep); G8_STAGE_A(G8_SA(0, 0), a2, 0);
            G8_WAIT_V(8); G8_WAIT_L(0); G8_BAR; G8_MMA(1, 0, At, B0); G8_MMA(1, 1, At, B1); G8_BAR; G8_SCHED;
            G8_LDB(B0, 1, 0); G8_LDB(B1, 1, 1); G8_SCHED; G8_LDA(At, 1, 0); G8_STAGE_A(G8_SA(0, 1), a2, 1);
            G8_WAIT_V(8); G8_WAIT_L(0); G8_BAR; G8_MMA(0, 0, At, B0); G8_MMA(0, 1, At, B1); G8_BAR; G8_SCHED;
            G8_LDA(At, 1, 1); G8_STAGE_D(G8_SB(1, 0), b3); G8_STAGE_D(G8_SB(1, 1), b3 + hstep); G8_STAGE_A(G8_SA(1, 0), a3, 0);
            G8_WAIT_V(8); G8_WAIT_L(0); G8_BAR; G8_MMA(1, 0, At, B0); G8_MMA(1, 1, At, B1); G8_BAR; G8_SCHED;
        }
        if (wr == 0) G8_BAR;
        E(acc, cur, wr, wc, fr, fq);
        if (!has_next) break;
#pragma unroll
        for (int a = 0; a < 2; ++a)
#pragma unroll
            for (int b = 0; b < 2; ++b)
#pragma unroll
                for (int m = 0; m < 4; ++m)
#pragma unroll
                    for (int n = 0; n < 2; ++n) acc[a][b][m][n] = (f32x4){0.f, 0.f, 0.f, 0.f};
        cur = nxt; cB = nB; cA = nA; ++ui;
        if (wr == 1) G8_BAR;
    }
    G8_WAIT_V(0);
    G8_BAR;
#undef G8_SA
#undef G8_SB
#undef G8_GLDS
#undef G8_STAGE_D
#undef G8_STAGE_A
#undef G8_LDA
#undef G8_LDB
#undef G8_MMA
#undef G8_WAIT_V
#undef G8_WAIT_L
#undef G8_BAR
#undef G8_SCHED
}

__device__ __forceinline__ float logsigmoid_f(float x) { return fminf(x, 0.f) - log1pf(__expf(-fabsf(x))); }
__device__ __forceinline__ void phase_gla_scan_naive(KA a, int li, LAS unsigned char* lds, int tid, int bx, int G) {
    const bf16* qkvr = (const bf16*)(a->ws + WS_BIG); const float* lr = (const float*)(a->ws + WS_LR);
    LAS float* qs = (LAS float*)lds;
    LAS float* ks = qs + 2048;
    LAS float* as = ks + 2048;
    LAS float* vs = as + 2048;
    LAS float* lrs = vs + 1024;
    LAS float* part = lrs + 256;
    for (int it = bx; it < 256; it += G) {
        const int b = it >> 5, h = (it >> 3) & 3, dir = (it >> 2) & 1, es = it & 3;
        const float* wg2 = a->in[dir ? I_GWG2B : I_GWG2F] + (size_t)li * 16 * 512; const float* bg = a->in[dir ? I_GBGB : I_GBGF] + (size_t)li * 512;
        bf16* oo = (bf16*)(a->ws + (dir ? WS_OB : WS_OF));
        const int dd = tid & 127;
        float wcol[16];
#pragma unroll
        for (int r = 0; r < 16; ++r) wcol[r] = wg2[r * 512 + h * 128 + dd];
        const float bgd = bg[h * 128 + dd];
        const int e = tid & 63, dp = tid >> 6;
        float S[16];
#pragma unroll
        for (int i = 0; i < 16; ++i) S[i] = 0.f;
        for (int t0 = 0; t0 < SEQ; t0 += 16) {
            __syncthreads();
            if (tid < 256) { const int st = tid >> 4, r = tid & 15; const int s = dir ? (SEQ - 1 - (t0 + st)) : (t0 + st); lrs[tid] = lr[(size_t)(b * SEQ + s) * 32 + dir * 16 + r]; }
            __syncthreads();
#pragma unroll
            for (int i = 0; i < 4; ++i) { const int st = (tid >> 7) + 4 * i; const int s = dir ? (SEQ - 1 - (t0 + st)) : (t0 + st); const size_t row = (size_t)(b * SEQ + s) * GLA_MAIN;
                qs[st * 128 + dd] = bf2f(qkvr[row + h * 128 + dd]); ks[st * 128 + dd] = bf2f(qkvr[row + 512 + h * 128 + dd]);
                float x = bgd;
#pragma unroll
                for (int r = 0; r < 16; ++r) x += lrs[st * 16 + r] * wcol[r];
                as[st * 128 + dd] = __expf(logsigmoid_f(x) * (1.0f / 16.0f)); }
#pragma unroll
            for (int i = 0; i < 2; ++i) { const int idx = tid + 512 * i, st = idx >> 6, ee = idx & 63; const int s = dir ? (SEQ - 1 - (t0 + st)) : (t0 + st);
                vs[idx] = bf2f(qkvr[(size_t)(b * SEQ + s) * GLA_MAIN + 1024 + h * 256 + es * 64 + ee]); }
            __syncthreads();
            for (int st = 0; st < 16; ++st) {
                const float vv = vs[st * 64 + e]; float po = 0.f;
#pragma unroll
                for (int i4 = 0; i4 < 4; ++i4) { const f32x4 q4 = *(const LAS f32x4*)(qs + st * 128 + dp * 16 + 4 * i4), k4 = *(const LAS f32x4*)(ks + st * 128 + dp * 16 + 4 * i4), a4 = *(const LAS f32x4*)(as + st * 128 + dp * 16 + 4 * i4);
#pragma unroll
                    for (int j = 0; j < 4; ++j) { S[4 * i4 + j] = a4[j] * S[4 * i4 + j] + k4[j] * vv; po += q4[j] * S[4 * i4 + j]; } }
                part[(dp * 16 + st) * 64 + e] = po;
            }
            __syncthreads();
#pragma unroll
            for (int i = 0; i < 2; ++i) { const int idx = tid + 512 * i, st = idx >> 6, ee = idx & 63; float s = 0.f;
#pragma unroll
                for (int w = 0; w < 8; ++w) s += part[(w * 16 + st) * 64 + ee];
                const int sq = dir ? (SEQ - 1 - (t0 + st)) : (t0 + st);
                oo[(size_t)(b * SEQ + sq) * D + h * 256 + es * 64 + ee] = (bf16)(cvt_pk_bf16(s, 0.f) & 0xffffu); }
        }
        __syncthreads();
    }
}
__device__ __forceinline__ void phase_gla_prep(KA a, int li, LAS unsigned char* lds, int tid, int bx, int G) {
    const int lane = tid & 63, wave = __builtin_amdgcn_readfirstlane(tid >> 6), fr = lane & 15, fq = lane >> 4;
    unsigned char* ws = a->ws;
    const bf16* qkvr = (const bf16*)(ws + WS_BIG); const float* lr = (const float*)(ws + WS_LR);
    bf16* QE = (bf16*)(ws + WS_QE); bf16* KET = (bf16*)(ws + WS_KET); bf16* PP = (bf16*)(ws + WS_P); bf16* VT = (bf16*)(ws + WS_VT); float* EL = (float*)(ws + WS_EL);
    constexpr int LS = 136;
    LAS bf16* qes = (LAS bf16*)lds;
    LAS bf16* kes = qes + 64 * LS;
    LAS float* lrs = (LAS float*)(kes + 64 * LS);
    LAS float* segtot = lrs + 1024;
    const int d = tid & 127, seg = tid >> 7;
    for (int it = bx; it < 4096; it += G) {
        const int chunk = it & 63, dir = (it >> 6) & 1, h = (it >> 7) & 3, b = it >> 9;
        const int row0 = b * SEQ + chunk * 64;
        const size_t cidx = (size_t)(((dir * 8 + b) * 4 + h) * 64 + chunk);
        const float* wg2 = a->in[dir ? I_GWG2B : I_GWG2F] + (size_t)li * 16 * 512 + h * 128 + d; const float bgd = a->in[dir ? I_GBGB : I_GBGF][(size_t)li * 512 + h * 128 + d];
        for (int i = tid; i < 1024; i += NTHREADS) lrs[i] = lr[(size_t)(row0 + (i >> 4)) * 32 + dir * 16 + (i & 15)];
        float wcol[16];
#pragma unroll
        for (int r = 0; r < 16; ++r) wcol[r] = wg2[r * 512];
        __syncthreads();
        float g[16];
#pragma unroll
        for (int s2 = 0; s2 < 16; ++s2) { const LAS float* lp = lrs + (seg * 16 + s2) * 16; float x = bgd;
#pragma unroll
            for (int r4 = 0; r4 < 4; ++r4) { const f32x4 l4 = *(const LAS f32x4*)(lp + 4 * r4); x += l4[0] * wcol[4 * r4] + l4[1] * wcol[4 * r4 + 1] + l4[2] * wcol[4 * r4 + 2] + l4[3] * wcol[4 * r4 + 3]; }
            g[s2] = logsigmoid_f(x) * (1.0f / 16.0f); }
        if (dir == 0) {
#pragma unroll
            for (int s2 = 1; s2 < 16; ++s2) g[s2] += g[s2 - 1];
        } else {
#pragma unroll
            for (int s2 = 14; s2 >= 0; --s2) g[s2] += g[s2 + 1];
        }
        segtot[seg * 128 + d] = dir ? g[0] : g[15];
        __syncthreads();
        float pre = 0.f, total = 0.f;
#pragma unroll
        for (int sg = 0; sg < 4; ++sg) { const float t = segtot[sg * 128 + d]; total += t; if (dir ? (sg > seg) : (sg < seg)) pre += t; }
        if (seg == 0) EL[cidx * 128 + d] = __expf(total);
        unsigned kt[8];
#pragma unroll
        for (int s2 = 0; s2 < 16; s2 += 2) {
            unsigned qw[2], kw[2];
#pragma unroll
            for (int u = 0; u < 2; ++u) { const int p = seg * 16 + s2 + u; const size_t ro = (size_t)(row0 + p) * GLA_MAIN + h * 128 + d;
                const float q = bf2f(qkvr[ro]), k = bf2f(qkvr[ro + 512]); const float bb = g[s2 + u] + pre;
                qw[u] = cvt_pk_bf16(q * __expf(bb), 0.f) & 0xffffu; kw[u] = cvt_pk_bf16(k * __expf(-bb), 0.f) & 0xffffu;
                QE[((size_t)dir * T + row0 + p) * 512 + h * 128 + d] = (bf16)qw[u]; qes[p * LS + d] = (bf16)qw[u]; kes[p * LS + d] = (bf16)kw[u]; }
            kt[s2 >> 1] = kw[0] | (kw[1] << 16);
        }
        { bf16* kp = KET + cidx * 8192 + (size_t)d * 64 + seg * 16; *(u32x4*)kp = (u32x4){kt[0], kt[1], kt[2], kt[3]}; *(u32x4*)(kp + 8) = (u32x4){kt[4], kt[5], kt[6], kt[7]}; }
        __syncthreads();
        { const int jt = wave & 3;
#pragma unroll
          for (int ii = 0; ii < 2; ++ii) { const int itile = 2 * (wave >> 2) + ii;
            f32x4 acc = (f32x4){0.f, 0.f, 0.f, 0.f};
            const bool dead = dir ? (jt < itile) : (jt > itile);
            if (!dead) {
#pragma unroll
                for (int ks = 0; ks < 4; ++ks) { const bf16x8 kf = *(const LAS bf16x8*)(kes + (jt * 16 + fr) * LS + ks * 32 + 8 * fq), qf = *(const LAS bf16x8*)(qes + (itile * 16 + fr) * LS + ks * 32 + 8 * fq);
                    acc = __builtin_amdgcn_mfma_f32_16x16x32_bf16(kf, qf, acc, 0, 0, 0); }
            }
            const int i = itile * 16 + fr, j0 = jt * 16 + 4 * fq; float pv[4];
#pragma unroll
            for (int jj = 0; jj < 4; ++jj) { const int j = j0 + jj; const bool keep = dir ? (j >= i) : (j <= i); pv[jj] = keep ? acc[jj] : 0.f; }
            u32x2 o; o.x = cvt_pk_bf16(pv[0], pv[1]); o.y = cvt_pk_bf16(pv[2], pv[3]);
            *(u32x2*)(PP + cidx * 4096 + (size_t)i * 64 + j0) = o; } }
        if (dir == 0) {
            const int e = tid & 255, jh = tid >> 8; unsigned w[16];
#pragma unroll
            for (int jj = 0; jj < 32; jj += 2) { const bf16 v0 = qkvr[(size_t)(row0 + jh * 32 + jj) * GLA_MAIN + 1024 + h * 256 + e], v1 = qkvr[(size_t)(row0 + jh * 32 + jj + 1) * GLA_MAIN + 1024 + h * 256 + e]; w[jj >> 1] = (unsigned)v0 | ((unsigned)v1 << 16); }
            bf16* vp = VT + ((size_t)((b * 4 + h) * 64 + chunk) * 256 + e) * 64 + jh * 32;
#pragma unroll
            for (int q4 = 0; q4 < 4; ++q4) *(u32x4*)(vp + 8 * q4) = (u32x4){w[4 * q4], w[4 * q4 + 1], w[4 * q4 + 2], w[4 * q4 + 3]};
        }
        __syncthreads();
    }
}
struct GlaFrags { bf16x8 qf[4], pf[2], vf[2][2], kf[2][2]; };
__device__ __forceinline__ void phase_gla_scan(KA a, LAS unsigned char* lds, int tid, int bx, int G) {
    const int lane = tid & 63, wave = __builtin_amdgcn_readfirstlane(tid >> 6), fr = lane & 15, fq = lane >> 4;
    unsigned char* ws = a->ws;
    const bf16* QE = (const bf16*)(ws + WS_QE); const bf16* KET = (const bf16*)(ws + WS_KET); const bf16* PP = (const bf16*)(ws + WS_P); const bf16* VT = (const bf16*)(ws + WS_VT); const float* EL = (const float*)(ws + WS_EL);
    constexpr int SS = 136;
    LAS bf16* ST = (LAS bf16*)lds;
    const int et0 = 2 * (wave & 1), dt0 = 2 * (wave >> 1), itile = wave >> 1;
    for (int it = bx; it < 256; it += G) {
        const int b = it >> 5, h = (it >> 3) & 3, dir = (it >> 2) & 1, es = it & 3;
        bf16* OO = (bf16*)(ws + (dir ? WS_OB : WS_OF));
        __syncthreads();
        for (int i = tid; i < 64 * SS / 2; i += NTHREADS) ((LAS unsigned*)ST)[i] = 0u;
        __syncthreads();
        f32x4 accS[2][2];
#pragma unroll
        for (int x = 0; x < 2; ++x)
#pragma unroll
            for (int y = 0; y < 2; ++y) accS[x][y] = (f32x4){0.f, 0.f, 0.f, 0.f};
        const size_t cbase = (size_t)((dir * 8 + b) * 4 + h) * 64;
        const char* qb = (const char*)(QE + ((size_t)dir * T + (size_t)b * SEQ + itile * 16) * 512 + h * 128);
        const char* pb = (const char*)(PP + cbase * 4096 + (size_t)(itile * 16) * 64);
        const char* vb = (const char*)(VT + ((size_t)(b * 4 + h) * 64 * 256 + es * 64 + et0 * 16) * 64);
        const char* kb = (const char*)(KET + cbase * 8192 + (size_t)(dt0 * 16) * 64);
        const char* eb = (const char*)(EL + cbase * 128 + dt0 * 16);
        char* ob = (char*)(OO + ((size_t)b * SEQ + itile * 16) * D + h * 256 + es * 64 + et0 * 16);
        const unsigned lq = (unsigned)(fr * 512 + 8 * fq) * 2u, l64 = (unsigned)(fr * 64 + 8 * fq) * 2u, le = (unsigned)fq * 16u, lo = (unsigned)(fr * D + 4 * fq) * 2u;
#define GLA_LOAD(F, c_) do { const int c__ = (c_); \
            _Pragma("unroll") for (int ks = 0; ks < 4; ++ks) F.qf[ks] = *(const bf16x8*)(qb + (size_t)c__ * (64 * 512 * 2) + ks * 64 + lq); \
            _Pragma("unroll") for (int ks = 0; ks < 2; ++ks) F.pf[ks] = *(const bf16x8*)(pb + (size_t)c__ * 8192 + ks * 64 + l64); \
            _Pragma("unroll") for (int et = 0; et < 2; ++et) _Pragma("unroll") for (int ks = 0; ks < 2; ++ks) F.vf[et][ks] = *(const bf16x8*)(vb + (size_t)c__ * 32768 + et * 2048 + ks * 64 + l64); \
            _Pragma("unroll") for (int dt = 0; dt < 2; ++dt) _Pragma("unroll") for (int ks = 0; ks < 2; ++ks) F.kf[dt][ks] = *(const bf16x8*)(kb + (size_t)c__ * 16384 + dt * 2048 + ks * 64 + l64); } while (0)
#define GLA_STEP(cc_, CUR, NXT) do { const int cc = (cc_); const int c = dir ? 63 - cc : cc; const int ccn = cc + 1 < 64 ? cc + 1 : 63; \
            GLA_LOAD(NXT, dir ? 63 - ccn : ccn); \
            const f32x4 el0 = *(const f32x4*)(eb + (size_t)c * 512 + le), el1 = *(const f32x4*)(eb + (size_t)c * 512 + 64 + le); \
            const LAS bf16* Sr = ST + (cc & 1) * 64 * SS; LAS bf16* Sw = ST + ((cc + 1) & 1) * 64 * SS; \
            _Pragma("unroll") for (int et = 0; et < 2; ++et) { f32x4 ao = (f32x4){0.f, 0.f, 0.f, 0.f}; \
                _Pragma("unroll") for (int ks = 0; ks < 4; ++ks) { const bf16x8 sf = *(const LAS bf16x8*)(Sr + ((et0 + et) * 16 + fr) * SS + ks * 32 + 8 * fq); ao = __builtin_amdgcn_mfma_f32_16x16x32_bf16(sf, CUR.qf[ks], ao, 0, 0, 0); } \
                _Pragma("unroll") for (int ks = 0; ks < 2; ++ks) ao = __builtin_amdgcn_mfma_f32_16x16x32_bf16(CUR.vf[et][ks], CUR.pf[ks], ao, 0, 0, 0); \
                u32x2 o; o.x = cvt_pk_bf16(ao[0], ao[1]); o.y = cvt_pk_bf16(ao[2], ao[3]); \
                *(u32x2*)(ob + (size_t)c * (64 * D * 2) + et * 32 + lo) = o; } \
            _Pragma("unroll") for (int dt = 0; dt < 2; ++dt) _Pragma("unroll") for (int et = 0; et < 2; ++et) { \
                _Pragma("unroll") for (int ks = 0; ks < 2; ++ks) accS[dt][et] = __builtin_amdgcn_mfma_f32_16x16x32_bf16(CUR.kf[dt][ks], CUR.vf[et][ks], accS[dt][et], 0, 0, 0); \
                accS[dt][et] = accS[dt][et] * (dt ? el1 : el0); \
                u32x2 o; o.x = cvt_pk_bf16(accS[dt][et][0], accS[dt][et][1]); o.y = cvt_pk_bf16(accS[dt][et][2], accS[dt][et][3]); \
                *(LAS u32x2*)(Sw + ((et0 + et) * 16 + fr) * SS + (dt0 + dt) * 16 + 4 * fq) = o; } \
            __syncthreads(); } while (0)
        GlaFrags FA, FB;
        GLA_LOAD(FA, dir ? 63 : 0);
#pragma unroll 1
        for (int c2 = 0; c2 < 64; c2 += 2) { GLA_STEP(c2, FA, FB); GLA_STEP(c2 + 1, FB, FA); }
#undef GLA_LOAD
#undef GLA_STEP
    }
}

__device__ __forceinline__ void phase_gla_post(KA a, int li, int tid, int bx, int G) {
    const int lane = tid & 63, wave = tid >> 6;
    const bf16* of = (const bf16*)(a->ws + WS_OF); const bf16* ob = (const bf16*)(a->ws + WS_OB); const bf16* qkvr = (const bf16*)(a->ws + WS_BIG); bf16* A2 = (bf16*)(a->ws + WS_A2);
    const float* ng = a->in[I_GNORM] + (size_t)li * 256 + (lane & 15) * 16;
    float g[16];
#pragma unroll
    for (int j = 0; j < 16; ++j) g[j] = ng[j];
    for (int token = bx * NWAVES + wave; token < T; token += G * NWAVES) {
        const u32x4 f0 = *(const u32x4*)(of + (size_t)token * D + 16 * lane), f1 = *(const u32x4*)(of + (size_t)token * D + 16 * lane + 8);
        const u32x4 b0 = *(const u32x4*)(ob + (size_t)token * D + 16 * lane), b1 = *(const u32x4*)(ob + (size_t)token * D + 16 * lane + 8);
        const u32x4 r0 = *(const u32x4*)(qkvr + (size_t)token * GLA_MAIN + 2048 + 16 * lane), r1 = *(const u32x4*)(qkvr + (size_t)token * GLA_MAIN + 2048 + 16 * lane + 8);
        float o[16], r[16];
#pragma unroll
        for (int q = 0; q < 4; ++q) { o[2 * q] = bf_lo(f0[q]) + bf_lo(b0[q]); o[2 * q + 1] = bf_hi(f0[q]) + bf_hi(b0[q]); o[8 + 2 * q] = bf_lo(f1[q]) + bf_lo(b1[q]); o[8 + 2 * q + 1] = bf_hi(f1[q]) + bf_hi(b1[q]);
            r[2 * q] = bf_lo(r0[q]); r[2 * q + 1] = bf_hi(r0[q]); r[8 + 2 * q] = bf_lo(r1[q]); r[8 + 2 * q + 1] = bf_hi(r1[q]); }
        float ss = 0.f;
#pragma unroll
        for (int j = 0; j < 16; ++j) ss += o[j] * o[j];
        ss += shfl_xor_f(ss, 1, lane); ss += shfl_xor_f(ss, 2, lane); ss += shfl_xor_f(ss, 4, lane); ss += shfl_xor_f(ss, 8, lane);
        const float rstd = 1.0f / sqrtf(ss * (1.0f / 256.0f) + LN_EPS);
        unsigned w[8];
#pragma unroll
        for (int q = 0; q < 8; ++q) w[q] = cvt_pk_bf16(o[2 * q] * rstd * g[2 * q] * silu_f(r[2 * q]), o[2 * q + 1] * rstd * g[2 * q + 1] * silu_f(r[2 * q + 1]));
        *(u32x4*)(A2 + (size_t)token * D + 16 * lane) = (u32x4){w[0], w[1], w[2], w[3]}; *(u32x4*)(A2 + (size_t)token * D + 16 * lane + 8) = (u32x4){w[4], w[5], w[6], w[7]};
    }
}

__device__ __forceinline__ void phase_sgu_core(KA a, int li, LAS unsigned char* lds, int tid, int bx, int G) {
    const int lane = tid & 63, wave = __builtin_amdgcn_readfirstlane(tid >> 6), fr = lane & 15, fq = lane >> 4;
    unsigned char* ws = a->ws;
    const bf16* z = (const bf16*)(ws + WS_BIG); bf16* A2 = (bf16*)(ws + WS_A2);
    const float* lng = a->in[I_SLNG] + (size_t)li * 1024; const float* lnb = a->in[I_SLNB] + (size_t)li * 1024;
    const bf16* wsp = (const bf16*)(ws + WS_SGUWS) + (size_t)li * 8 * 128 * 128; const float* bs = a->in[I_SBS] + (size_t)li * 8 * 128;
    constexpr int VS = 132;
    LAS bf16* vn = (LAS bf16*)lds;
    LAS float* st_mean = (LAS float*)(lds + 2 * 128 * VS * 2); LAS float* st_rstd = st_mean + 128;
    const int co = tid & 15, qr = tid >> 4;
    for (int it = bx; it < T / 128; it += G) {
        const int row0 = it * 128;
        __syncthreads();
#pragma unroll 1
        for (int rr = 0; rr < 16; ++rr) { const int q = wave * 16 + rr; const bf16* vp = z + (size_t)(row0 + q) * 2048 + 1024 + 16 * lane;
            const u32x4 v0 = *(const u32x4*)vp, v1 = *(const u32x4*)(vp + 8); float x[16];
#pragma unroll
            for (int k = 0; k < 4; ++k) { x[2 * k] = bf_lo(v0[k]); x[2 * k + 1] = bf_hi(v0[k]); x[8 + 2 * k] = bf_lo(v1[k]); x[8 + 2 * k + 1] = bf_hi(v1[k]); }
            float s1 = 0.f;
#pragma unroll
            for (int k = 0; k < 16; ++k) s1 += x[k];
            const float mean = wave_sum(s1, lane) * (1.0f / 1024.0f); float s2 = 0.f;
#pragma unroll
            for (int k = 0; k < 16; ++k) { const float dd = x[k] - mean; s2 += dd * dd; }
            const float rstd = 1.0f / sqrtf(wave_sum(s2, lane) * (1.0f / 1024.0f) + LN_EPS);
            if (lane == 0) { st_mean[q] = mean; st_rstd[q] = rstd; } }
        __syncthreads();
        const int p = wave * 16 + fr;
#pragma unroll 1
        for (int g = 0; g < 8; ++g) {
            LAS bf16* vb = vn + (g & 1) * 128 * VS;
            {
                const f32x4 g0 = *(const f32x4*)(lng + g * 128 + 8 * co), g1 = *(const f32x4*)(lng + g * 128 + 8 * co + 4), b0 = *(const f32x4*)(lnb + g * 128 + 8 * co), b1 = *(const f32x4*)(lnb + g * 128 + 8 * co + 4);
#pragma unroll
                for (int k = 0; k < 4; ++k) { const int q = qr + 32 * k; const u32x4 w = *(const u32x4*)(z + (size_t)(row0 + q) * 2048 + 1024 + g * 128 + 8 * co);
                    const float m = st_mean[q], r = st_rstd[q];
                    u32x2 o0, o1;
                    o0.x = cvt_pk_bf16((bf_lo(w.x) - m) * r * g0[0] + b0[0], (bf_hi(w.x) - m) * r * g0[1] + b0[1]); o0.y = cvt_pk_bf16((bf_lo(w.y) - m) * r * g0[2] + b0[2], (bf_hi(w.y) - m) * r * g0[3] + b0[3]);
                    o1.x = cvt_pk_bf16((bf_lo(w.z) - m) * r * g1[0] + b1[0], (bf_hi(w.z) - m) * r * g1[1] + b1[1]); o1.y = cvt_pk_bf16((bf_lo(w.w) - m) * r * g1[2] + b1[2], (bf_hi(w.w) - m) * r * g1[3] + b1[3]);
                    *(LAS u32x2*)(vb + q * VS + 8 * co) = o0; *(LAS u32x2*)(vb + q * VS + 8 * co + 4) = o1; }
            }
            bf16x8 wf[4];
#pragma unroll
            for (int ks = 0; ks < 4; ++ks) wf[ks] = *(const bf16x8*)(wsp + ((size_t)g * 128 + p) * 128 + ks * 32 + 8 * fq);
            const float bias = bs[g * 128 + p];
            __syncthreads();
#pragma unroll 2
            for (int ct = 0; ct < 8; ++ct) {
                f32x4 acc = (f32x4){0.f, 0.f, 0.f, 0.f};
#pragma unroll
                for (int ks = 0; ks < 4; ++ks) { const LAS bf16* sp = vb + (ks * 32 + 8 * fq) * VS + ct * 16 + fr; unsigned w4[4];
#pragma unroll
                    for (int j2 = 0; j2 < 4; ++j2) w4[j2] = (unsigned)sp[(2 * j2) * VS] | ((unsigned)sp[(2 * j2 + 1) * VS] << 16);
                    const bf16x8 vf = __builtin_bit_cast(bf16x8, (u32x4){w4[0], w4[1], w4[2], w4[3]});
                    acc = __builtin_amdgcn_mfma_f32_16x16x32_bf16(vf, wf[ks], acc, 0, 0, 0); }
                const int c0 = g * 128 + ct * 16 + 4 * fq;
                const u32x2 uu = *(const u32x2*)(z + (size_t)(row0 + p) * 2048 + c0);
                u32x2 o; o.x = cvt_pk_bf16(bf_lo(uu.x) * (acc[0] + bias), bf_hi(uu.x) * (acc[1] + bias)); o.y = cvt_pk_bf16(bf_lo(uu.y) * (acc[2] + bias), bf_hi(uu.y) * (acc[3] + bias));
                *(u32x2*)(A2 + (size_t)(row0 + p) * D + c0) = o;
            }
        }
    }
}

constexpr int PH_PER_LAYER = 10;
constexpr int NPHASES = 2 + PH_PER_LAYER * DEPTH;
#ifdef USE_NAIVE_GEMM
#define GEMM_BODY(A, g, K, S, E) gemm_naive(A, g, K, S, E, tid)
#define GEMM_BODY_G(A, g, K, S, E) gemm_naive(A, g, K, S, E, tid)
#else
#define GEMM_BODY(A, g, K, S, E) gemm_fast<false>(A, g, K, S, E, lds, tid)
#define GEMM_BODY_G(A, g, K, S, E) gemm_fast<true>(A, g, K, S, E, lds, tid)
#endif
__device__ __forceinline__ void ph_prologue(int wave_s) { PHASE_ENTER(); phase_prologue(a, lds, tid, bx, G); }
__device__ __forceinline__ void ph_rp_init(int wave_s) { PHASE_ENTER(); float* mod = (float*)(ws + WS_MOD);
    RowPass p{}; p.xin = a->in[I_X]; p.hout = (bf16*)(ws + WS_H); p.sc = mod + 1 * 1024; p.sh = mod + 0 * 1024; p.wside = (const bf16*)(ws + WS_GLALR_T); p.lr_out = (float*)(ws + WS_LR); p.has_h = 1; p.has_side = 1;
    row_pass<0>(p, lds, tid, bx, G); }
__device__ __forceinline__ void ph_gla_in(int wave_s, int li) { PHASE_ENTER(); Sched S; S.init(T / 256, GLA_MAIN / 256, G, bx, (const bf16*)(ws + WS_GLAIN_T) + (size_t)li * GLA_MAIN * 1024, 0, nullptr, 1024); EpiGlaIn E{(bf16*)(ws + WS_BIG)}; GEMM_BODY((const bf16*)(ws + WS_H), nullptr, 1024, S, E); }
__device__ __forceinline__ void ph_sgu_in(int wave_s, int li) { PHASE_ENTER(); Sched S; S.init(T / 256, 2048 / 256, G, bx, (const bf16*)(ws + WS_SGUIN_T) + (size_t)li * 2048 * 1024, 0, nullptr, 1024); EpiSguIn E{(bf16*)(ws + WS_BIG), a->in[I_SBIN] + (size_t)li * 2048}; GEMM_BODY((const bf16*)(ws + WS_H), nullptr, 1024, S, E); }
__device__ __forceinline__ void ph_gla_scan_naive(int wave_s, int li) { PHASE_ENTER(); phase_gla_scan_naive(a, li, lds, tid, bx, G); }
__device__ __forceinline__ void ph_gla_prep(int wave_s, int li) { PHASE_ENTER(); phase_gla_prep(a, li, lds, tid, bx, G); }
__device__ __forceinline__ void ph_gla_scan(int wave_s) { PHASE_ENTER(); phase_gla_scan(a, lds, tid, bx, G); }
__device__ __forceinline__ void ph_sgu_core(int wave_s, int li) { PHASE_ENTER(); phase_sgu_core(a, li, lds, tid, bx, G); }
__device__ __forceinline__ void ph_gla_post(int wave_s, int li) { PHASE_ENTER(); phase_gla_post(a, li, tid, bx, G); }
__device__ __forceinline__ void ph_out(int wave_s, int l) { PHASE_ENTER(); const int li = l >> 1; const bool sgu = (l & 1) != 0;
    Sched S; S.init(T / 256, 4, G, bx, (const bf16*)(ws + (sgu ? WS_SGUOUT_T : WS_GLAOUT_T)) + (size_t)li * 1024 * 1024, 0, nullptr, 1024);
    EpiOut E{(float*)(ws + WS_Y), sgu ? a->in[I_SBOUT] + (size_t)li * 1024 : nullptr}; GEMM_BODY((const bf16*)(ws + WS_A2), nullptr, 1024, S, E); }
__device__ __forceinline__ void ph_rp_mid(int wave_s, int l) { PHASE_ENTER(); float* modl = (float*)(ws + WS_MOD) + (size_t)l * 8 * 6144; int* route = (int*)(ws + WS_ROUTE);
    RowPass p{}; p.xin = (l == 0) ? a->in[I_X] : (const float*)(ws + WS_X2); p.y = (const float*)(ws + WS_Y); p.xout = (float*)(ws + WS_X1); p.hout = (bf16*)(ws + WS_H);
    p.gate = modl + 2 * 1024; p.lng = a->in[I_LNG] + (size_t)(l * 2 + 0) * 1024; p.lnb = a->in[I_LNB] + (size_t)(l * 2 + 0) * 1024; p.sc = modl + 4 * 1024; p.sh = modl + 3 * 1024;
    p.wside = (const bf16*)(ws + WS_ROUTER_T) + (size_t)l * 64 * 1024; p.rbias = a->in[I_RB] + (size_t)l * 32;
    p.topi = route + R_TOPI; p.topw = (float*)(route + R_TOPW); p.hist = route + R_HIST + bx * 32; p.has_h = 1; p.has_side = 1;
    row_pass<1>(p, lds, tid, bx, G); }
__device__ __forceinline__ void ph_place(int wave_s) { PHASE_ENTER(); phase_place((int*)(ws + WS_ROUTE), lds, tid, bx, G); }
__device__ __forceinline__ void ph_moe_up(int wave_s, int l) { PHASE_ENTER(); int* route = (int*)(ws + WS_ROUTE); const int ntiles = __builtin_amdgcn_readfirstlane(route[R_NTILES]);
    Sched S; S.init(ntiles, 8, G, bx, (const bf16*)(ws + WS_WUP_T) + (size_t)l * 32 * 2048 * 1024, (size_t)2048 * 1024, route + R_TILEE, 1024);
    EpiUp E{(bf16*)(ws + WS_ACT), a->in[I_BUP] + (size_t)l * 32 * 2048}; GEMM_BODY_G((const bf16*)(ws + WS_H), route + R_BUFTOK, 1024, S, E); }
__device__ __forceinline__ void ph_moe_down(int wave_s, int l) { PHASE_ENTER(); int* route = (int*)(ws + WS_ROUTE); const int ntiles = __builtin_amdgcn_readfirstlane(route[R_NTILES]);
    Sched S; S.init(ntiles, 4, G, bx, (const bf16*)(ws + WS_WDN_T) + (size_t)l * 32 * 1024 * 1024, (size_t)1024 * 1024, route + R_TILEE, 1024);
    EpiDown E{(bf16*)(ws + WS_YS), a->in[I_BDN] + (size_t)l * 32 * 1024}; GEMM_BODY((const bf16*)(ws + WS_ACT), nullptr, 1024, S, E); }
__device__ __forceinline__ void ph_rp_end(int wave_s, int l) { PHASE_ENTER(); float* mod = (float*)(ws + WS_MOD); float* modl = mod + (size_t)l * 8 * 6144; int* route = (int*)(ws + WS_ROUTE);
    RowPass p{}; p.xin = (const float*)(ws + WS_X1); p.xout = (l == DEPTH - 1) ? a->out : (float*)(ws + WS_X2); p.hout = (bf16*)(ws + WS_H);
    p.gate = modl + 5 * 1024; p.lng = a->in[I_LNG] + (size_t)(l * 2 + 1) * 1024; p.lnb = a->in[I_LNB] + (size_t)(l * 2 + 1) * 1024;
    p.ys = (const bf16*)(ws + WS_YS); p.dest = route + R_DEST; p.tw = (const float*)(route + R_TOPW);
    if (l < DEPTH - 1) { float* modn = mod + (size_t)(l + 1) * 8 * 6144; p.sc = modn + 1 * 1024; p.sh = modn + 0 * 1024; p.has_h = 1;
        if (((l + 1) & 1) == 0) { p.has_side = 1; p.wside = (const bf16*)(ws + WS_GLALR_T) + (size_t)((l + 1) >> 1) * 64 * 1024; p.lr_out = (float*)(ws + WS_LR); } }
    row_pass<2>(p, lds, tid, bx, G); }

__global__ void __launch_bounds__(NTHREADS, 2) fwd_kernel(Args a) {
    extern __shared__ __attribute__((aligned(16))) unsigned char lds_raw[];
    LAS unsigned char* lds = (LAS unsigned char*)lds_raw;
    volatile LAS unsigned* MISC = (volatile LAS unsigned*)(lds + MISC_OFF);
    const int tid = threadIdx.x; const int wave_s = __builtin_amdgcn_readfirstlane(tid >> 6);
    if (tid < 32) ((LAS unsigned*)(lds + MISC_OFF))[tid] = 0u;
    __syncthreads();
    unsigned* ctl = (unsigned*)(a.ws + WS_CTL);
    XcdBarrier bar = xcd_barrier_post(ctl + CW_BAR + a.li * XCD_BAR_WORDS, MISC + 8);
    const int lo = a.ph_lo, hi = a.ph_hi;
#ifndef REPK
#define REPK 0
#define REPN 1
#endif
#define REP(kind) for (int rep_ = 0; rep_ < ((REPK == (kind)) ? REPN : 1); ++rep_)
#define IN(k) (lo <= (k) && (k) < hi)
#define SEAM(k) do { if (IN(k) && IN((k) + 1)) xcd_barrier(bar); } while (0)
    if (IN(0)) { REP(3) ph_prologue(wave_s); SEAM(0); }
    if (IN(1)) { ph_rp_init(wave_s); SEAM(1); }
    for (int l = 0; l < DEPTH; ++l) {
        const int pb = 2 + PH_PER_LAYER * l, li = l >> 1; const bool sgu = (l & 1) != 0;
        if (IN(pb + 0)) { REP(10) { if (!sgu) ph_gla_in(wave_s, li); else ph_sgu_in(wave_s, li); } SEAM(pb + 0); }
        if (IN(pb + 1)) { if (!sgu) { REP(12) ph_gla_prep(wave_s, li); SEAM(pb + 1); } }
        if (IN(pb + 2)) { if (!sgu) { REP(1) ph_gla_scan(wave_s); } else { REP(2) ph_sgu_core(wave_s, li); } SEAM(pb + 2); }
        if (IN(pb + 3)) { if (!sgu) { REP(6) ph_gla_post(wave_s, li); SEAM(pb + 3); } }
        if (IN(pb + 4)) { REP(11) ph_out(wave_s, l); SEAM(pb + 4); }
        if (IN(pb + 5)) { REP(4) ph_rp_mid(wave_s, l); SEAM(pb + 5); }
        if (IN(pb + 6)) { REP(7) ph_place(wave_s); SEAM(pb + 6); }
        if (IN(pb + 7)) { REP(8) ph_moe_up(wave_s, l); SEAM(pb + 7); }
        if (IN(pb + 8)) { REP(9) ph_moe_down(wave_s, l); SEAM(pb + 8); }
        if (IN(pb + 9)) { REP(5) ph_rp_end(wave_s, l); SEAM(pb + 9); }
    }
#undef IN
#undef SEAM
}

#ifndef N_LAUNCH_MODE
#define N_LAUNCH_MODE 1
#endif
extern "C" void kernel_launch(void* const* d_in, const int* in_sizes, int n_in, void* d_out, int out_size, void* d_ws, size_t ws_size, hipStream_t stream) {
    static int grid = 0;
    if (grid == 0) {
        if (n_in != 27 || out_size != T * D || ws_size < WS_END) { fprintf(stderr, "kernel_launch: unexpected shapes (n_in %d out %d ws %zu)\n", n_in, out_size, ws_size); grid = -1; return; }
        int dev = 0, cus = 0, per_cu = 0;
        if (hipGetDevice(&dev) != hipSuccess || hipDeviceGetAttribute(&cus, hipDeviceAttributeMultiprocessorCount, dev) != hipSuccess) { grid = -1; return; }
        if (hipFuncSetAttribute((const void*)fwd_kernel, hipFuncAttributeMaxDynamicSharedMemorySize, LDS_BYTES) != hipSuccess) { fprintf(stderr, "kernel_launch: hipFuncSetAttribute failed\n"); grid = -1; return; }
        if (hipOccupancyMaxActiveBlocksPerMultiprocessor(&per_cu, (const void*)fwd_kernel, NTHREADS, LDS_BYTES) != hipSuccess || per_cu < 1) fprintf(stderr, "kernel_launch: occupancy query reports %d\n", per_cu);
        (void)hipGetLastError();
        grid = cus;
        if (grid > 1024) grid = 1024;
    }
    if (grid < 0) return;
    (void)hipMemsetAsync((char*)d_ws + WS_CTL, 0, CTL_ZERO_BYTES, stream);
    Args a{};
    for (int i = 0; i < 27; ++i) a.in[i] = (const float*)d_in[i];
    a.out = (float*)d_out; a.ws = (unsigned char*)d_ws; a.pad = 0;
#if N_LAUNCH_MODE == 1
    a.ph_lo = 0; a.ph_hi = NPHASES; a.li = 0;
    hipLaunchKernelGGL(fwd_kernel, dim3(grid), dim3(NTHREADS), LDS_BYTES, stream, a);
#else
    for (int ph = 0, li = 0; ph < NPHASES; ++ph) {
        if (ph >= 2 && (((ph - 2) % PH_PER_LAYER) == 1 || ((ph - 2) % PH_PER_LAYER) == 3) && (((ph - 2) / PH_PER_LAYER) & 1)) continue;
        a.ph_lo = ph; a.ph_hi = ph + 1; a.li = li++;
        hipLaunchKernelGGL(fwd_kernel, dim3(grid), dim3(NTHREADS), LDS_BYTES, stream, a);
    }
#endif
}
```

```cpp
#include <hip/hip_runtime.h>
#include <cstdio>
#include <cstdint>

#define LAS __attribute__((address_space(3)))
#define GAS __attribute__((address_space(1)))
typedef unsigned short bf16;
typedef short bf16x8 __attribute__((ext_vector_type(8)));
typedef float f32x4 __attribute__((ext_vector_type(4)));
typedef float f32x2 __attribute__((ext_vector_type(2)));
typedef unsigned u32x4 __attribute__((ext_vector_type(4)));
typedef unsigned u32x2 __attribute__((ext_vector_type(2)));

constexpr int D = 1024, NB = 8, SEQ = 4096, T = NB * SEQ, DEPTH = 4;
constexpr int NE = 32, TOPK = 4, CAP = T * TOPK + NE * 256;
constexpr int MAXTILES = CAP / 256;
constexpr float ALPHA = 1.681792830507429f;
constexpr float LN_EPS = 1e-5f;
constexpr int GLA_IN = 3104, GLA_MAIN = 3072;
constexpr int NWAVES = 8, NTHREADS = 512;
constexpr int LDS_BYTES = 147456, MISC_OFF = 139264;

constexpr size_t MiB = 1u << 20;
constexpr size_t WS_CTL = 0, CTL_ZERO_BYTES = 2 * MiB;
constexpr size_t WS_MOD = 2 * MiB;
constexpr size_t WS_ROUTE = 4 * MiB;
constexpr size_t WS_LR = 8 * MiB;
constexpr size_t WS_GLAIN_T = 16 * MiB;
constexpr size_t WS_GLALR_T = 28 * MiB;
constexpr size_t WS_ROUTER_T = 29 * MiB;
constexpr size_t WS_SGUWS = 30 * MiB;
constexpr size_t WS_GLAOUT_T = 32 * MiB;
constexpr size_t WS_SGUIN_T = 36 * MiB;
constexpr size_t WS_SGUOUT_T = 44 * MiB;
constexpr size_t WS_WUP_T = 64 * MiB;
constexpr size_t WS_WDN_T = 576 * MiB;
constexpr size_t WS_X1 = 832 * MiB;
constexpr size_t WS_X2 = 960 * MiB;
constexpr size_t WS_H = 1088 * MiB;
constexpr size_t WS_BIG = 1152 * MiB;
constexpr size_t WS_OF = 1344 * MiB;
constexpr size_t WS_OB = 1408 * MiB;
constexpr size_t WS_A2 = 1472 * MiB;
constexpr size_t WS_Y = 1536 * MiB;
constexpr size_t WS_ACT = 1664 * MiB;
constexpr size_t WS_YS = 1936 * MiB;
constexpr size_t WS_QE = 2208 * MiB;
constexpr size_t WS_KET = 2272 * MiB;
constexpr size_t WS_P = 2336 * MiB;
constexpr size_t WS_VT = 2368 * MiB;
constexpr size_t WS_EL = 2432 * MiB;
constexpr size_t WS_END = 2440 * MiB;
constexpr int R_TOPI = 0;
constexpr int R_TOPW = T * 4;
constexpr int R_DEST = 2 * T * 4;
constexpr int R_BUFTOK = 3 * T * 4;
constexpr int R_HIST = R_BUFTOK + CAP;
constexpr int R_TILEE = R_HIST + 1024 * 32;
constexpr int R_NTILES = R_TILEE + 1024;
static_assert((size_t)(R_NTILES + 64) * 4 <= 4 * MiB, "route tables");
constexpr int CW_BAR = 4096;
constexpr int MAX_LAUNCH = 64;

#define RLX_AGENT __ATOMIC_RELAXED, __HIP_MEMORY_SCOPE_AGENT
#define LDS_WAIT() asm volatile("s_waitcnt lgkmcnt(0)" ::: "memory")
#define VM_WAIT() asm volatile("s_waitcnt vmcnt(0)" ::: "memory")
typedef __bf16 bf16x2_t __attribute__((ext_vector_type(2)));
__device__ __forceinline__ unsigned cvt_pk_bf16(float lo, float hi) { const f32x2 v = {lo, hi}; const bf16x2_t r = __builtin_convertvector(v, bf16x2_t); return __builtin_bit_cast(unsigned, r); }
__device__ __forceinline__ float bf_lo(unsigned w) { return __uint_as_float(w << 16); }
__device__ __forceinline__ float bf_hi(unsigned w) { return __uint_as_float(w & 0xffff0000u); }
__device__ __forceinline__ float bf2f(bf16 b) { return __uint_as_float(((unsigned)b) << 16); }
__device__ __forceinline__ float shfl_xor_f(float v, int o, int lane) { return __builtin_bit_cast(float, __builtin_amdgcn_ds_bpermute((lane ^ o) << 2, __builtin_bit_cast(int, v))); }
__device__ __forceinline__ int shfl_i(int v, int src, int lane) { (void)lane; return __builtin_amdgcn_ds_bpermute(src << 2, v); }
__device__ __forceinline__ float wave_sum(float v, int lane) {
#pragma unroll
    for (int o = 1; o < 64; o <<= 1) v += shfl_xor_f(v, o, lane);
    return v;
}
__device__ __forceinline__ float silu_f(float x) { return x / (1.0f + __expf(-x)); }
__device__ __forceinline__ float sigmoid_f(float x) { return 1.0f / (1.0f + __expf(-x)); }
__device__ __forceinline__ float gelu_f(float v) {
    const float av = fabsf(v), t = __builtin_amdgcn_rcpf(av * 0.2316418882f + 1.0f);
    float q = t * 0.5307027145f + (-0.7265760135f); q = q * t + 0.7107068705f; q = q * t + (-0.142248368f); q = q * t + 0.127414796f; q = q * t;
    const float e = __builtin_amdgcn_exp2f((v * v) * (-0.72134752044f));
    const float m = v * (q * e);
    return v < 0.f ? m : v - m;
}

#define XB_TMO      128
#define XB_XCNT(j)  (256  + 64 * (j))
#define XB_XSUB(j)  (1280 + 64 * (j))
#define XB_XGEN(j)  (2304 + 64 * (j))
#define XB_TOP      3328
#define XB_TOPGEN   3392
#define XCD_BAR_WORDS 3456
#define XB_SPIN_CAP (1u << 18)
__device__ __forceinline__ unsigned xb_ld(unsigned* p)              { return __hip_atomic_load(p, __ATOMIC_RELAXED, __HIP_MEMORY_SCOPE_AGENT); }
__device__ __forceinline__ unsigned xb_add(unsigned* p, unsigned v) { return __hip_atomic_fetch_add(p, v, __ATOMIC_RELAXED, __HIP_MEMORY_SCOPE_AGENT); }
__device__ __forceinline__ unsigned xb_xcc_id() { return (unsigned)__builtin_amdgcn_s_getreg((3 << 11) | 20) & 0xFu; }
#define XB_SPIN(cond, bar) do { unsigned _sp = 0; while (cond) { __builtin_amdgcn_s_sleep(1); \
    if ((++_sp & 255u) == 0u) { if (xb_ld(&(bar)[XB_TMO])) break; if (_sp > XB_SPIN_CAP) { atomicAdd(&(bar)[XB_TMO], 1u); break; } } } } while (0)
struct XcdBarrier { unsigned* bar; unsigned x; volatile LAS unsigned* st; };
__device__ __forceinline__ XcdBarrier xcd_barrier_post(unsigned* bar, volatile LAS unsigned* st) {
    XcdBarrier b; b.bar = bar; b.x = xb_xcc_id(); b.st = st;
    if (threadIdx.x == 0) (void)xb_add(&bar[XB_XCNT(b.x)], 1u);
    return b;
}
__device__ __forceinline__ void xcd_barrier_complete(unsigned* bar, unsigned x, unsigned& nloc, unsigned& nx) {
    const unsigned G = gridDim.x * gridDim.y * gridDim.z;
    unsigned sum, cnt, mine, sp = 0u;
    for (;;) {
        sum = 0u; cnt = 0u; mine = 0u;
#pragma unroll
        for (unsigned j = 0; j < 16; ++j) { const unsigned c = xb_ld(&bar[XB_XCNT(j)]); sum += c; cnt += (c > 0u) ? 1u : 0u; mine = (j == x) ? c : mine; }
        if (sum == G) break;
        __builtin_amdgcn_s_sleep(1);
        if ((++sp & 255u) == 0u) { if (xb_ld(&bar[XB_TMO])) break; if (sp > XB_SPIN_CAP) { atomicAdd(&bar[XB_TMO], 1u); break; } }
    }
    nloc = mine > 0u ? mine : 1u; nx = cnt > 0u ? cnt : 1u;
}
__device__ __forceinline__ void xcd_barrier(const XcdBarrier& b) {
    asm volatile("s_waitcnt vmcnt(0)" ::: "memory");
    __syncthreads();
    if (threadIdx.x == 0) {
        unsigned* bar = b.bar;
        __builtin_amdgcn_s_waitcnt(0);
        unsigned nloc = b.st[0], nx = b.st[1];
        if (nloc == 0u) { xcd_barrier_complete(bar, b.x, nloc, nx); b.st[0] = nloc; b.st[1] = nx; }
        const unsigned old = xb_add(&bar[XB_XSUB(b.x)], 1u);
        const unsigned gen = old / nloc;
        if (old + 1u == (gen + 1u) * nloc) {
            __builtin_amdgcn_fence(__ATOMIC_RELEASE, "agent");
            asm volatile("s_waitcnt vmcnt(0)" ::: "memory");
            const unsigned og = xb_add(&bar[XB_TOP], 1u);
            const unsigned tg = og / nx;
            if (og + 1u == (tg + 1u) * nx) xb_add(&bar[XB_TOPGEN], 1u);
            else XB_SPIN(xb_ld(&bar[XB_TOPGEN]) == tg, bar);
            __builtin_amdgcn_fence(__ATOMIC_ACQUIRE, "agent");
            xb_add(&bar[XB_XGEN(b.x)], 1u);
            asm volatile("s_waitcnt vmcnt(0)" ::: "memory");
        } else {
            XB_SPIN(xb_ld(&bar[XB_XGEN(b.x)]) == gen, bar);
            __builtin_amdgcn_fence(__ATOMIC_ACQUIRE, "agent");
            asm volatile("s_waitcnt vmcnt(0)" ::: "memory");
        }
    }
    __syncthreads();
}

struct Args { const float* in[27]; float* out; unsigned char* ws; int ph_lo, ph_hi, li, pad; };
enum { I_X = 0, I_C, I_ADAW, I_ADAB, I_LNG, I_LNB, I_GWIN, I_GWG2F, I_GBGF, I_GWG2B, I_GBGB, I_GNORM, I_GWOUT, I_SWIN, I_SBIN, I_SLNG, I_SLNB, I_SWS, I_SBS, I_SWOUT, I_SBOUT, I_RW, I_RB, I_WUP, I_BUP, I_WDN, I_BDN };

typedef const __attribute__((address_space(4))) Args* KA;
#define PHASE_ENTER() unsigned m1_ = ~0u; asm volatile("" : "+s"(m1_)); int tid = (wave_s << 6) | (int)__builtin_amdgcn_mbcnt_hi(m1_, __builtin_amdgcn_mbcnt_lo(m1_, 0u)); asm volatile("" : "+v"(tid)); int bx = blockIdx.x, G = gridDim.x; asm volatile("" : "+s"(bx), "+s"(G)); \
    KA a = (KA)__builtin_amdgcn_kernarg_segment_ptr(); asm volatile("" : "+s"(a)); unsigned char* ws = a->ws; \
    extern __shared__ __attribute__((aligned(16))) unsigned char lds_raw[]; LAS unsigned char* lds = (LAS unsigned char*)lds_raw; (void)lds; (void)ws; (void)bx; (void)G; (void)tid
__device__ __forceinline__ int swiglu_perm(int o) {
    const int a = o >> 1, h = o & 1, pn = a >> 7, r = a & 127, bj = r >> 6, r2 = r & 63, wc = r2 >> 4, r3 = r2 & 15;
    return 256 * pn + 128 * bj + 32 * wc + 16 * h + r3;
}
__device__ __forceinline__ void conv_tile(const float* W, int K, int N, int k0, int n0, int nw, bf16* dst, int mode, LAS float* scr, int lane) {
    const int c4 = lane & 15, kr = lane >> 4;
    if (4 * c4 < nw) {
#pragma unroll 4
        for (int i = 0; i < 16; ++i) { const int kk = 4 * i + kr; const f32x4 v = *(const f32x4*)(W + (size_t)(k0 + kk) * N + n0 + 4 * c4);
            LAS float* s = scr + kk * 65 + 4 * c4; s[0] = v[0]; s[1] = v[1]; s[2] = v[2]; s[3] = v[3]; }
    }
    LDS_WAIT(); asm volatile("" ::: "memory");
    const int kc = lane & 7, ns = lane >> 3;
    for (int j = 0; j < nw / 8; ++j) {
        const int n = ns + 8 * j; const LAS float* s = scr + (8 * kc) * 65 + n;
        float v[8];
#pragma unroll
        for (int q = 0; q < 8; ++q) v[q] = s[q * 65];
        u32x4 o; o.x = cvt_pk_bf16(v[0], v[1]); o.y = cvt_pk_bf16(v[2], v[3]); o.z = cvt_pk_bf16(v[4], v[5]); o.w = cvt_pk_bf16(v[6], v[7]);
        const int ng = n0 + n;
        if (mode == 2) {
            *(u32x4*)(dst + (size_t)n * K + k0 + 8 * kc) = o;
            u32x4 l; l.x = cvt_pk_bf16(v[0] - bf_lo(o.x), v[1] - bf_hi(o.x)); l.y = cvt_pk_bf16(v[2] - bf_lo(o.y), v[3] - bf_hi(o.y));
            l.z = cvt_pk_bf16(v[4] - bf_lo(o.z), v[5] - bf_hi(o.z)); l.w = cvt_pk_bf16(v[6] - bf_lo(o.w), v[7] - bf_hi(o.w));
            *(u32x4*)(dst + (size_t)(32 + n) * K + k0 + 8 * kc) = l;
        } else {
            const int row = (mode == 1) ? swiglu_perm(ng) : ng;
            *(u32x4*)(dst + (size_t)row * K + k0 + 8 * kc) = o;
        }
    }
    LDS_WAIT(); asm volatile("" ::: "memory");
}

__device__ __forceinline__ void phase_prologue(KA a, LAS unsigned char* lds, int tid, int bx, int G) {
    const int lane = tid & 63, wave = __builtin_amdgcn_readfirstlane(tid >> 6);
    unsigned char* ws = a->ws;
    for (int slab = bx; slab < 192; slab += G) {
        LAS float* sc = (LAS float*)lds;
        LAS float* red = (LAS float*)(lds + 32768);
        for (int i = tid; i < 8 * 1024; i += NTHREADS) sc[i] = silu_f(a->in[I_C][i]);
        __syncthreads();
        const int g0 = slab * 128, l = g0 / 6144, e0 = g0 % 6144;
        const int c4 = tid & 31, seg = tid >> 5;
        f32x4 acc[8];
#pragma unroll
        for (int b = 0; b < 8; ++b) acc[b] = (f32x4){0.f, 0.f, 0.f, 0.f};
        const float* wp = a->in[I_ADAW] + ((size_t)l * 1024 + seg * 64) * 6144 + e0 + 4 * c4;
#pragma unroll 8
        for (int d = 0; d < 64; ++d) { const f32x4 w = *(const f32x4*)(wp + (size_t)d * 6144);
#pragma unroll
            for (int b = 0; b < 8; ++b) acc[b] += w * sc[b * 1024 + seg * 64 + d]; }
#pragma unroll
        for (int b = 0; b < 8; ++b) *(LAS f32x4*)(red + (seg * 8 + b) * 128 + 4 * c4) = acc[b];
        __syncthreads();
        for (int o = tid; o < 1024; o += NTHREADS) { const int b = o >> 7, c = o & 127; float s = a->in[I_ADAB][l * 6144 + e0 + c];
#pragma unroll
            for (int sg = 0; sg < 16; ++sg) s += red[(sg * 8 + b) * 128 + c];
            ((float*)(ws + WS_MOD))[((size_t)l * 8 + b) * 6144 + e0 + c] = s; }
        __syncthreads();
    }
    LAS float* scr = (LAS float*)(lds + wave * 16640);
    const int gw = bx * NWAVES + wave, NGW = G * NWAVES;
    constexpr int N_UP = 128 * 16 * 32, N_DN = 128 * 16 * 16, N_GIN = 2 * 16 * 48, N_GLR = 2 * 16, N_GOUT = 2 * 256, N_SIN = 2 * 16 * 32, N_SOUT = 2 * 256, N_RT = 4 * 16;
    constexpr int NITEMS = N_UP + N_DN + N_GIN + N_GLR + N_GOUT + N_SIN + N_SOUT + N_RT;
    for (int it = gw; it < NITEMS; it += NGW) {
        int r = it;
        if (r < N_UP) { const int m = r >> 9, q = r & 511, kt = q >> 5, nt = q & 31;
            conv_tile(a->in[I_WUP] + (size_t)m * 1024 * 2048, 1024, 2048, kt * 64, nt * 64, 64, (bf16*)(ws + WS_WUP_T) + (size_t)m * 2048 * 1024, 1, scr, lane); continue; } r -= N_UP;
        if (r < N_DN) { const int m = r >> 8, q = r & 255, kt = q >> 4, nt = q & 15;
            conv_tile(a->in[I_WDN] + (size_t)m * 1024 * 1024, 1024, 1024, kt * 64, nt * 64, 64, (bf16*)(ws + WS_WDN_T) + (size_t)m * 1024 * 1024, 0, scr, lane); continue; } r -= N_DN;
        if (r < N_GIN) { const int m = r / 768, q = r % 768, kt = q / 48, nt = q % 48;
            conv_tile(a->in[I_GWIN] + (size_t)m * 1024 * GLA_IN, 1024, GLA_IN, kt * 64, nt * 64, 64, (bf16*)(ws + WS_GLAIN_T) + (size_t)m * GLA_MAIN * 1024, 0, scr, lane); continue; } r -= N_GIN;
        if (r < N_GLR) { const int m = r >> 4, kt = r & 15;
            conv_tile(a->in[I_GWIN] + (size_t)m * 1024 * GLA_IN, 1024, GLA_IN, kt * 64, GLA_MAIN, 32, (bf16*)(ws + WS_GLALR_T) + (size_t)m * 64 * 1024, 2, scr, lane); continue; } r -= N_GLR;
        if (r < N_GOUT) { const int m = r >> 8, q = r & 255, kt = q >> 4, nt = q & 15;
            conv_tile(a->in[I_GWOUT] + (size_t)m * 1024 * 1024, 1024, 1024, kt * 64, nt * 64, 64, (bf16*)(ws + WS_GLAOUT_T) + (size_t)m * 1024 * 1024, 0, scr, lane); continue; } r -= N_GOUT;
        if (r < N_SIN) { const int m = r >> 9, q = r & 511, kt = q >> 5, nt = q & 31;
            conv_tile(a->in[I_SWIN] + (size_t)m * 1024 * 2048, 1024, 2048, kt * 64, nt * 64, 64, (bf16*)(ws + WS_SGUIN_T) + (size_t)m * 2048 * 1024, 0, scr, lane); continue; } r -= N_SIN;
        if (r < N_SOUT) { const int m = r >> 8, q = r & 255, kt = q >> 4, nt = q & 15;
            conv_tile(a->in[I_SWOUT] + (size_t)m * 1024 * 1024, 1024, 1024, kt * 64, nt * 64, 64, (bf16*)(ws + WS_SGUOUT_T) + (size_t)m * 1024 * 1024, 0, scr, lane); continue; } r -= N_SOUT;
        { const int m = r >> 4, kt = r & 15;
            conv_tile(a->in[I_RW] + (size_t)m * 1024 * 32, 1024, 32, kt * 64, 0, 32, (bf16*)(ws + WS_ROUTER_T) + (size_t)m * 64 * 1024, 2, scr, lane); }
    }
    { bf16* d = (bf16*)(ws + WS_SGUWS); const float* s = a->in[I_SWS];
      for (int i = (bx * NTHREADS + tid) * 4; i < 2 * 8 * 128 * 128; i += G * NTHREADS * 4) { const f32x4 v = *(const f32x4*)(s + i); u32x2 o; o.x = cvt_pk_bf16(v[0], v[1]); o.y = cvt_pk_bf16(v[2], v[3]); *(u32x2*)(d + i) = o; } }
}

struct RowPass {
    const float* xin; const bf16* y; float* xout; bf16* hout;
    const float* gate; const float* lng; const float* lnb; const float* sc; const float* sh;
    const bf16* wside;
    float* lr_out;
    const float* rbias;
    int* topi; float* topw; int* hist;
    const bf16* ys; const int* dest; const float* tw;
    int has_h, has_side;
};
template <int MODE>
__device__ __forceinline__ void row_pass(const RowPass& p, LAS unsigned char* lds, int tid, int bx, int G) {
    const int lane = tid & 63, wave = __builtin_amdgcn_readfirstlane(tid >> 6);
    constexpr int HS = 1032;
    LAS bf16* Hhi = (LAS bf16*)lds;
    LAS bf16* Hlo = (LAS bf16*)(lds + 16 * HS * 2);
    LAS float* part = (LAS float*)(lds + 2 * 16 * HS * 2);
    LAS float* logit = part + 8 * 32 * 16;
    LAS int* lhist = (LAS int*)(logit + 16 * 32);
    if (MODE == 1) { if (tid < 32) lhist[tid] = 0; }
    const bool side = (p.has_side != 0) && (p.wside != nullptr);
    bf16x8 whi[2][4], wlo[2][4];
    if (side) {
#pragma unroll
        for (int hf = 0; hf < 2; ++hf)
#pragma unroll
            for (int s = 0; s < 4; ++s) { const size_t off = (size_t)(hf * 16 + (lane & 15)) * 1024 + 128 * wave + 32 * s + 8 * (lane >> 4);
                whi[hf][s] = *(const bf16x8*)(p.wside + off); wlo[hf][s] = *(const bf16x8*)(p.wside + 32 * 1024 + off); }
    }
    for (int tile = bx; tile < T / 16; tile += G) {
        const int b = (tile * 16) / SEQ;
#pragma unroll 1
        for (int tt = 0; tt < 2; ++tt) {
            const int tl = 2 * wave + tt, token = tile * 16 + tl;
            f32x4 v[4];
            const float* xr = p.xin + (size_t)token * D + 4 * lane;
#pragma unroll
            for (int j = 0; j < 4; ++j) v[j] = *(const f32x4*)(xr + 256 * j);
            if (MODE == 1) {
                const bf16* yr = p.y + (size_t)token * D + 4 * lane; const float* gp = p.gate + (size_t)b * 6144 + 4 * lane;
#pragma unroll
                for (int j = 0; j < 4; ++j) { const u32x2 yq = *(const u32x2*)(yr + 256 * j); const f32x4 yy = (f32x4){bf_lo(yq.x), bf_hi(yq.x), bf_lo(yq.y), bf_hi(yq.y)}; const f32x4 g = *(const f32x4*)(gp + 256 * j); v[j] = v[j] * ALPHA + (g + 1.0f) * yy; }
            }
            if (MODE == 2) {
                f32x4 ya[4];
#pragma unroll
                for (int j = 0; j < 4; ++j) ya[j] = (f32x4){0.f, 0.f, 0.f, 0.f};
#pragma unroll
                for (int k = 0; k < 4; ++k) { const int ds = p.dest[token * 4 + k]; const float w = p.tw[token * 4 + k]; const bf16* yr = p.ys + (size_t)ds * D + 4 * lane;
#pragma unroll
                    for (int j = 0; j < 4; ++j) { const u32x2 q = *(const u32x2*)(yr + 256 * j); ya[j] += (f32x4){bf_lo(q.x), bf_hi(q.x), bf_lo(q.y), bf_hi(q.y)} * w; } }
                const float* gp = p.gate + (size_t)b * 6144 + 4 * lane;
#pragma unroll
                for (int j = 0; j < 4; ++j) { const f32x4 g = *(const f32x4*)(gp + 256 * j); v[j] = v[j] * ALPHA + (g + 1.0f) * ya[j]; }
            }
            if (MODE != 0) {
                float s = 0.f;
#pragma unroll
                for (int j = 0; j < 4; ++j) s += (v[j][0] + v[j][1]) + (v[j][2] + v[j][3]);
                const float mean = wave_sum(s, lane) * (1.0f / D); float s2 = 0.f;
#pragma unroll
                for (int j = 0; j < 4; ++j) { v[j] = v[j] - mean; s2 += (v[j][0] * v[j][0] + v[j][1] * v[j][1]) + (v[j][2] * v[j][2] + v[j][3] * v[j][3]); }
                const float rstd = 1.0f / sqrtf(wave_sum(s2, lane) * (1.0f / D) + LN_EPS);
                float* xo = p.xout + (size_t)token * D + 4 * lane;
#pragma unroll
                for (int j = 0; j < 4; ++j) { const f32x4 g = *(const f32x4*)(p.lng + 4 * lane + 256 * j), bb = *(const f32x4*)(p.lnb + 4 * lane + 256 * j); v[j] = v[j] * rstd * g + bb; *(f32x4*)(xo + 256 * j) = v[j]; }
            }
            if (p.has_h) {
                const float* scp = p.sc + (size_t)b * 6144 + 4 * lane; const float* shp = p.sh + (size_t)b * 6144 + 4 * lane;
                bf16* ho = p.hout + (size_t)token * D + 4 * lane;
#pragma unroll
                for (int j = 0; j < 4; ++j) { const f32x4 s1 = *(const f32x4*)(scp + 256 * j), s0 = *(const f32x4*)(shp + 256 * j); const f32x4 h = v[j] * (s1 + 1.0f) + s0;
                    u32x2 o; o.x = cvt_pk_bf16(h[0], h[1]); o.y = cvt_pk_bf16(h[2], h[3]); *(u32x2*)(ho + 256 * j) = o;
                    if (side) { u32x2 l; l.x = cvt_pk_bf16(h[0] - bf_lo(o.x), h[1] - bf_hi(o.x)); l.y = cvt_pk_bf16(h[2] - bf_lo(o.y), h[3] - bf_hi(o.y));
                        *(LAS u32x2*)(Hhi + tl * HS + 4 * lane + 256 * j) = o; *(LAS u32x2*)(Hlo + tl * HS + 4 * lane + 256 * j) = l; } }
            }
        }
        if (side) {
            __syncthreads();
            f32x4 acc[2]; acc[0] = (f32x4){0.f, 0.f, 0.f, 0.f}; acc[1] = acc[0];
#pragma unroll
            for (int s = 0; s < 4; ++s) { const int ko = (lane & 15) * HS + 128 * wave + 32 * s + 8 * (lane >> 4);
                const bf16x8 bh = *(const LAS bf16x8*)(Hhi + ko), bl = *(const LAS bf16x8*)(Hlo + ko);
#pragma unroll
                for (int hf = 0; hf < 2; ++hf) { acc[hf] = __builtin_amdgcn_mfma_f32_16x16x32_bf16(whi[hf][s], bh, acc[hf], 0, 0, 0);
                    acc[hf] = __builtin_amdgcn_mfma_f32_16x16x32_bf16(wlo[hf][s], bh, acc[hf], 0, 0, 0); acc[hf] = __builtin_amdgcn_mfma_f32_16x16x32_bf16(whi[hf][s], bl, acc[hf], 0, 0, 0); } }
#pragma unroll
            for (int hf = 0; hf < 2; ++hf)
#pragma unroll
                for (int j = 0; j < 4; ++j) part[(wave * 32 + hf * 16 + 4 * (lane >> 4) + j) * 16 + (lane & 15)] = acc[hf][j];
            __syncthreads();
            { const int e = tid >> 4, tk = tid & 15; float s = 0.f;
#pragma unroll
              for (int w = 0; w < 8; ++w) s += part[(w * 32 + e) * 16 + tk];
              if (MODE == 1) logit[tk * 32 + e] = s + p.rbias[e];
              else p.lr_out[(size_t)(tile * 16 + tk) * 32 + e] = s; }
            if (MODE == 1) {
                __syncthreads();
                if (tid < 16) {
                    const int token = tile * 16 + tid; float lv[32];
#pragma unroll
                    for (int e = 0; e < 32; ++e) lv[e] = logit[tid * 32 + e];
                    int bi[4]; float bv[4];
#pragma unroll
                    for (int k = 0; k < 4; ++k) { float m = -3.0e38f; int mi = 0;
#pragma unroll
                        for (int e = 0; e < 32; ++e) { const bool take = lv[e] > m; m = take ? lv[e] : m; mi = take ? e : mi; }
                        bi[k] = mi; bv[k] = m;
#pragma unroll
                        for (int e = 0; e < 32; ++e) lv[e] = (e == mi) ? -3.0e38f : lv[e]; }
                    const float e1 = __expf(bv[1] - bv[0]), e2 = __expf(bv[2] - bv[0]), e3 = __expf(bv[3] - bv[0]); const float inv = 1.0f / (1.0f + e1 + e2 + e3);
                    *(int4*)(p.topi + token * 4) = make_int4(bi[0], bi[1], bi[2], bi[3]);
                    *(f32x4*)(p.topw + token * 4) = (f32x4){inv, e1 * inv, e2 * inv, e3 * inv};
#pragma unroll
                    for (int k = 0; k < 4; ++k) atomicAdd((int*)&lhist[bi[k]], 1);
                }
            }
            __syncthreads();
        }
    }
    if (MODE == 1) { __syncthreads(); if (tid < 32) p.hist[tid] = lhist[tid]; }
}

__device__ __forceinline__ void phase_place(int* route, LAS unsigned char* lds, int tid, int bx, int G) {
    const int lane = tid & 63, wave = tid >> 6;
    LAS int* ptot = (LAS int*)lds;
    LAS int* ppre = ptot + 512;
    LAS int* tot = ppre + 512;
    LAS int* pre = tot + 32;
    LAS int* pstart = pre + 32;
    const int* hist = route + R_HIST;
    { const int e = tid & 31, part = tid >> 5; int st = 0, sp = 0;
      for (int bb = part; bb < G; bb += 16) { const int h = hist[bb * 32 + e]; st += h; if (bb < bx) sp += h; }
      ptot[part * 32 + e] = st; ppre[part * 32 + e] = sp; }
    __syncthreads();
    if (tid < 32) { int st = 0, sp = 0;
#pragma unroll
        for (int q = 0; q < 16; ++q) { st += ptot[q * 32 + tid]; sp += ppre[q * 32 + tid]; }
        tot[tid] = st; pre[tid] = sp; }
    __syncthreads();
    if (tid == 0) { int acc = 0; for (int e = 0; e < 32; ++e) { pstart[e] = acc; acc += (tot[e] + 255) / 256 * 256; } pstart[32] = acc; }
    __syncthreads();
    if (bx == 0) {
        const int ntiles = pstart[32] / 256;
        if (tid == 0) route[R_NTILES] = ntiles;
        for (int t = tid; t < ntiles; t += NTHREADS) { int e = 0; for (int q = 1; q < 32; ++q) if (pstart[q] <= t * 256) e = q; route[R_TILEE + t] = e; }
    }
    for (int e = bx; e < 32; e += G) { const int s0 = pstart[e] + tot[e], s1 = pstart[e + 1]; for (int s = s0 + tid; s < s1; s += NTHREADS) route[R_BUFTOK + s] = 0; }
    if (wave == 0) {
        int run = 0;
        for (int tile = bx; tile < T / 16; tile += G) {
            const int token = tile * 16 + (lane >> 2);
            const int e = route[R_TOPI + tile * 64 + lane];
            const int base = shfl_i(run, e, lane);
            int rank = 0, add = 0;
#pragma unroll 1
            for (int x = 0; x < 32; ++x) { const unsigned long long m = __ballot(e == x); if (e == x) rank = __popcll(m & ((1ull << lane) - 1ull)); if (lane == x) add = __popcll(m); }
            run += add;
            const int ds = pstart[e] + pre[e] + base + rank;
            route[R_DEST + tile * 64 + lane] = ds;
            route[R_BUFTOK + ds] = token;
        }
    }
}

struct Unit { int pm, pn, e; const bf16* bt; };
constexpr int NXCD = 8, WGM = 8;
struct Sched {
    int nM, nN, nwg, G, c; const bf16* Bt; size_t estride; const int* tile_e; int K;
    __device__ __forceinline__ void init(int nM_, int nN_, int G_, int c_, const bf16* Bt_, size_t es, const int* te, int K_) { nM = nM_; nN = nN_; nwg = nM * nN; G = G_; c = c_; Bt = Bt_; estride = es; tile_e = te; K = K_; }
    __device__ __forceinline__ bool next(int i, Unit& u) const {
        const long L = (long)i * G + c; if (L >= nwg) return false;
        int wgid = (int)L; { const int q = nwg / NXCD, r = nwg % NXCD, xcd = wgid % NXCD, off = wgid / NXCD; wgid = (xcd < r ? xcd * (q + 1) : r * (q + 1) + (xcd - r) * q) + off; }
        const int nig = WGM * nN, gid = wgid / nig, fm = gid * WGM, gsz = (nM - fm) < WGM ? (nM - fm) : WGM;
        u.pm = fm + ((wgid % nig) % gsz); u.pn = (wgid % nig) / gsz;
        u.e = tile_e ? __builtin_amdgcn_readfirstlane(tile_e[u.pm]) : 0;
        u.bt = Bt + (size_t)u.e * estride + (size_t)u.pn * 256 * K;
        return true;
    }
};
struct EpiGlaIn { bf16* O;
    __device__ __forceinline__ void operator()(const f32x4 (&acc)[2][2][4][2], const Unit& u, int wr, int wc, int fr, int fq) const {
        const int row0 = u.pm * 256 + wr * 64 + fr, col0 = u.pn * 256 + wc * 32 + 4 * fq; const float sc = (u.pn < 2) ? 0.08838834764831845f : 1.0f;
#pragma unroll
        for (int ai = 0; ai < 2; ++ai)
#pragma unroll
            for (int m = 0; m < 4; ++m) { bf16* rp = O + (size_t)(row0 + ai * 128 + m * 16) * GLA_MAIN + col0;
#pragma unroll
                for (int bj = 0; bj < 2; ++bj)
#pragma unroll
                    for (int n = 0; n < 2; ++n) { const f32x4 v = acc[ai][bj][m][n] * sc; u32x2 o; o.x = cvt_pk_bf16(v[0], v[1]); o.y = cvt_pk_bf16(v[2], v[3]); *(u32x2*)(rp + bj * 128 + n * 16) = o; } }
    }
};
struct EpiSguIn { bf16* O; const float* bias;
    __device__ __forceinline__ void operator()(const f32x4 (&acc)[2][2][4][2], const Unit& u, int wr, int wc, int fr, int fq) const {
        const int row0 = u.pm * 256 + wr * 64 + fr, col0 = u.pn * 256 + wc * 32 + 4 * fq;
        f32x4 bv[2][2];
#pragma unroll
        for (int bj = 0; bj < 2; ++bj)
#pragma unroll
            for (int n = 0; n < 2; ++n) bv[bj][n] = *(const f32x4*)(bias + col0 + bj * 128 + n * 16);
#pragma unroll
        for (int ai = 0; ai < 2; ++ai)
#pragma unroll
            for (int m = 0; m < 4; ++m) { bf16* rp = O + (size_t)(row0 + ai * 128 + m * 16) * 2048 + col0;
#pragma unroll
                for (int bj = 0; bj < 2; ++bj)
#pragma unroll
                    for (int n = 0; n < 2; ++n) { const f32x4 v = acc[ai][bj][m][n] + bv[bj][n]; u32x2 o; o.x = cvt_pk_bf16(gelu_f(v[0]), gelu_f(v[1])); o.y = cvt_pk_bf16(gelu_f(v[2]), gelu_f(v[3])); *(u32x2*)(rp + bj * 128 + n * 16) = o; } }
    }
};
struct EpiOut { bf16* O; const float* bias;
    __device__ __forceinline__ void operator()(const f32x4 (&acc)[2][2][4][2], const Unit& u, int wr, int wc, int fr, int fq) const {
        const int row0 = u.pm * 256 + wr * 64 + fr, col0 = u.pn * 256 + wc * 32 + 4 * fq;
        f32x4 bv[2][2];
#pragma unroll
        for (int bj = 0; bj < 2; ++bj)
#pragma unroll
            for (int n = 0; n < 2; ++n) bv[bj][n] = bias ? *(const f32x4*)(bias + col0 + bj * 128 + n * 16) : (f32x4){0.f, 0.f, 0.f, 0.f};
#pragma unroll
        for (int ai = 0; ai < 2; ++ai)
#pragma unroll
            for (int m = 0; m < 4; ++m) { bf16* rp = O + (size_t)(row0 + ai * 128 + m * 16) * D + col0;
#pragma unroll
                for (int bj = 0; bj < 2; ++bj)
#pragma unroll
                    for (int n = 0; n < 2; ++n) { const f32x4 v = acc[ai][bj][m][n] + bv[bj][n]; u32x2 o; o.x = cvt_pk_bf16(v[0], v[1]); o.y = cvt_pk_bf16(v[2], v[3]); *(u32x2*)(rp + bj * 128 + n * 16) = o; } }
    }
};
struct EpiUp { bf16* O; const float* bias;
    __device__ __forceinline__ void operator()(const f32x4 (&acc)[2][2][4][2], const Unit& u, int wr, int wc, int fr, int fq) const {
        const int row0 = u.pm * 256 + wr * 64 + fr, a0 = u.pn * 128 + wc * 16 + 4 * fq;
        f32x4 bg[2], bl[2];
#pragma unroll
        for (int bj = 0; bj < 2; ++bj) { const float* bp = bias + (size_t)u.e * 2048 + 2 * (a0 + 64 * bj); const f32x4 p0 = *(const f32x4*)bp, p1 = *(const f32x4*)(bp + 4);
            bg[bj] = (f32x4){p0[0], p0[2], p1[0], p1[2]}; bl[bj] = (f32x4){p0[1], p0[3], p1[1], p1[3]}; }
#pragma unroll
        for (int ai = 0; ai < 2; ++ai)
#pragma unroll
            for (int m = 0; m < 4; ++m) { bf16* rp = O + (size_t)(row0 + ai * 128 + m * 16) * D + a0;
#pragma unroll
                for (int bj = 0; bj < 2; ++bj) { const f32x4 g = acc[ai][bj][m][0] + bg[bj], l = acc[ai][bj][m][1] + bl[bj]; float r[4];
#pragma unroll
                    for (int j = 0; j < 4; ++j) { const float gg = fminf(g[j], 7.0f), ll = fminf(fmaxf(l[j], -7.0f), 7.0f); r[j] = gg * sigmoid_f(1.702f * gg) * (ll + 1.0f); }
                    u32x2 o; o.x = cvt_pk_bf16(r[0], r[1]); o.y = cvt_pk_bf16(r[2], r[3]); *(u32x2*)(rp + bj * 64) = o; } }
    }
};
struct EpiDown { bf16* O; const float* bias;
    __device__ __forceinline__ void operator()(const f32x4 (&acc)[2][2][4][2], const Unit& u, int wr, int wc, int fr, int fq) const {
        const int row0 = u.pm * 256 + wr * 64 + fr, col0 = u.pn * 256 + wc * 32 + 4 * fq;
        f32x4 bv[2][2];
#pragma unroll
        for (int bj = 0; bj < 2; ++bj)
#pragma unroll
            for (int n = 0; n < 2; ++n) bv[bj][n] = *(const f32x4*)(bias + (size_t)u.e * 1024 + col0 + bj * 128 + n * 16);
#pragma unroll
        for (int ai = 0; ai < 2; ++ai)
#pragma unroll
            for (int m = 0; m < 4; ++m) { bf16* rp = O + (size_t)(row0 + ai * 128 + m * 16) * D + col0;
#pragma unroll
                for (int bj = 0; bj < 2; ++bj)
#pragma unroll
                    for (int n = 0; n < 2; ++n) { const f32x4 v = acc[ai][bj][m][n] + bv[bj][n]; u32x2 o; o.x = cvt_pk_bf16(v[0], v[1]); o.y = cvt_pk_bf16(v[2], v[3]); *(u32x2*)(rp + bj * 128 + n * 16) = o; } }
    }
};

template <class Epi>
__device__ __forceinline__ void gemm_naive(const bf16* A, const int* gather, int K, const Sched& S, const Epi& E, int tid) {
    const int wid = __builtin_amdgcn_readfirstlane(tid >> 6), lane = tid & 63, wr = wid >> 2, wc = wid & 3, fr = lane & 15, fq = lane >> 4;
    Unit u;
    for (int ui = 0; S.next(ui, u); ++ui) {
        f32x4 acc[2][2][4][2];
#pragma unroll
        for (int a = 0; a < 2; ++a)
#pragma unroll
            for (int b = 0; b < 2; ++b)
#pragma unroll
                for (int m = 0; m < 4; ++m)
#pragma unroll
                    for (int n = 0; n < 2; ++n) acc[a][b][m][n] = (f32x4){0.f, 0.f, 0.f, 0.f};
        unsigned ap[2][4], bp[2][2];
#pragma unroll
        for (int ai = 0; ai < 2; ++ai)
#pragma unroll
            for (int m = 0; m < 4; ++m) { const int r = u.pm * 256 + ai * 128 + wr * 64 + m * 16 + fr; const int ar = gather ? gather[r] : r; ap[ai][m] = (unsigned)ar * (unsigned)K + 8u * fq; }
#pragma unroll
        for (int bj = 0; bj < 2; ++bj)
#pragma unroll
            for (int n = 0; n < 2; ++n) bp[bj][n] = (unsigned)(bj * 128 + wc * 32 + n * 16 + fr) * (unsigned)K + 8u * fq;
#pragma unroll 1
        for (int k0 = 0; k0 < K; k0 += 32) {
            bf16x8 af[2][4], bfr[2][2];
#pragma unroll
            for (int ai = 0; ai < 2; ++ai)
#pragma unroll
                for (int m = 0; m < 4; ++m) af[ai][m] = *(const bf16x8*)(A + ap[ai][m] + k0);
#pragma unroll
            for (int bj = 0; bj < 2; ++bj)
#pragma unroll
                for (int n = 0; n < 2; ++n) bfr[bj][n] = *(const bf16x8*)(u.bt + bp[bj][n] + k0);
#pragma unroll
            for (int ai = 0; ai < 2; ++ai)
#pragma unroll
                for (int bj = 0; bj < 2; ++bj)
#pragma unroll
                    for (int m = 0; m < 4; ++m)
#pragma unroll
                        for (int n = 0; n < 2; ++n) acc[ai][bj][m][n] = __builtin_amdgcn_mfma_f32_16x16x32_bf16(bfr[bj][n], af[ai][m], acc[ai][bj][m][n], 0, 0, 0);
        }
        E(acc, u, wr, wc, fr, fq);
    }
}

constexpr int G8_BK = 64, G8_HALF = 128, G8_HTB = G8_HALF * G8_BK * 2, G8_STAGE_BYTES = 8 * G8_HTB;
__device__ __forceinline__ int g8_lds_byte(int r, int c) { const int st = (r >> 4) * 2 + (c >> 5), rr = r & 15, cc = c & 31, ob = rr * 64 + cc * 2; return st * 1024 + (ob ^ (((ob >> 9) & 1) << 5)); }
__device__ __forceinline__ void g8_stage_rc(int b, int& R, int& C) { const int st = b / 1024, sb = b % 1024, swz = sb ^ (((sb >> 9) & 1) << 5); R = (st >> 1) * 16 + swz / 64; C = (st & 1) * 32 + (swz % 64) / 2; }
__device__ __forceinline__ u32x4 g8_avoff(int pm, const int* gather, int tid, int K) {
    int t2 = tid; asm volatile("" : "+v"(t2));
    int R, C; g8_stage_rc(t2 * 16, R, C);
    const int* gp = gather + pm * 256 + R;
    const unsigned r00 = gp[0], r01 = gp[64], r10 = gp[128], r11 = gp[192], c2 = (unsigned)(C * 2), k2 = (unsigned)(K * 2);
    return (u32x4){r00 * k2 + c2, r01 * k2 + c2, r10 * k2 + c2, r11 * k2 + c2};
}
template <bool GATHER, class Epi>
__device__ __forceinline__ void gemm_fast(const bf16* A, const int* gather, const int K, const Sched& S, const Epi& E, LAS unsigned char* lds, int tid) {
    const int wid = __builtin_amdgcn_readfirstlane(tid >> 6), lane = tid & 63, wr = wid >> 2, wc = wid & 3, fr = lane & 15, fq = lane >> 4;
    const int nt = K / G8_BK;
    unsigned voff; { int R, C; g8_stage_rc(tid * 16, R, C); voff = (unsigned)(R * K + C) * 2u; }
    const size_t kstep = (size_t)(G8_BK * 2), hstep = (size_t)G8_HALF * K * 2, qstep = (size_t)64 * K * 2, tstep = 2 * hstep;
    const unsigned ldsw = (unsigned)wid * 1024u;
    const int aoff = g8_lds_byte(wr * 64 + fr, fq * 8), boff = g8_lds_byte(wc * 32 + fr, fq * 8);
#define G8_SA(b, h) (((b) * 2 + (h)) * G8_HTB)
#define G8_SB(b, h) ((4 + (b) * 2 + (h)) * G8_HTB)
#define G8_GLDS(gp, ldsoff) __builtin_amdgcn_global_load_lds((const unsigned*)(gp), (LAS unsigned*)(lds + (ldsoff)), 16, 0, 0)
#define G8_STAGE_D(bufoff, gbase) do { G8_GLDS((const char*)(gbase) + voff, (bufoff) + ldsw); G8_GLDS((const char*)(gbase) + qstep + voff, (bufoff) + ldsw + 8192); } while (0)
#define G8_STAGE_A(bufoff, kb, h) do { if constexpr (GATHER) { G8_GLDS((kb) + va[(h) * 2], (bufoff) + ldsw); G8_GLDS((kb) + va[(h) * 2 + 1], (bufoff) + ldsw + 8192); } \
        else { G8_STAGE_D(bufoff, (kb) + (h) * hstep); } } while (0)
#define G8_LDA(dst, b, h) do { _Pragma("unroll") for (int m = 0; m < 4; ++m) _Pragma("unroll") for (int k = 0; k < 2; ++k) dst[m][k] = *(const LAS bf16x8*)(lds + G8_SA(b, h) + aoff + m * 2048 + k * 1024); } while (0)
#define G8_LDB(dst, b, h) do { _Pragma("unroll") for (int n = 0; n < 2; ++n) _Pragma("unroll") for (int k = 0; k < 2; ++k) dst[n][k] = *(const LAS bf16x8*)(lds + G8_SB(b, h) + boff + n * 2048 + k * 1024); } while (0)
#define G8_MMA(ai, bj, At, Bt) do { __builtin_amdgcn_s_setprio(1); _Pragma("unroll") for (int m = 0; m < 4; ++m) _Pragma("unroll") for (int n = 0; n < 2; ++n) _Pragma("unroll") for (int k = 0; k < 2; ++k) \
        acc[ai][bj][m][n] = __builtin_amdgcn_mfma_f32_16x16x32_bf16(Bt[n][k], At[m][k], acc[ai][bj][m][n], 0, 0, 0); __builtin_amdgcn_s_setprio(0); } while (0)
#define G8_WAIT_V(n) asm volatile("s_waitcnt vmcnt(" #n ")" ::: "memory")
#define G8_WAIT_L(n) asm volatile("s_waitcnt lgkmcnt(" #n ")" ::: "memory")
#define G8_BAR __builtin_amdgcn_s_barrier()
#define G8_SCHED __builtin_amdgcn_sched_barrier(0)
    Unit cur, nxt; int ui = 0;
    if (!S.next(0, cur)) return;
    f32x4 acc[2][2][4][2];
#pragma unroll
    for (int a = 0; a < 2; ++a)
#pragma unroll
        for (int b = 0; b < 2; ++b)
#pragma unroll
            for (int m = 0; m < 4; ++m)
#pragma unroll
                for (int n = 0; n < 2; ++n) acc[a][b][m][n] = (f32x4){0.f, 0.f, 0.f, 0.f};
    bf16x8 At[4][2], B0[2][2], B1[2][2];
    u32x4 va = (u32x4){0u, 0u, 0u, 0u};
    if constexpr (GATHER) va = g8_avoff(cur.pm, gather, tid, K);
    LAS u32x4* vslot = (LAS u32x4*)(lds + G8_STAGE_BYTES) + tid;
    const char* cB = (const char*)cur.bt; const char* cA = (const char*)A + (GATHER ? (size_t)0 : (size_t)cur.pm * tstep);
    G8_STAGE_D(G8_SB(0, 0), cB); G8_STAGE_D(G8_SB(0, 1), cB + hstep); G8_STAGE_A(G8_SA(0, 0), cA, 0); G8_STAGE_A(G8_SA(0, 1), cA, 1);
    if (wr == 1) G8_BAR;
    G8_WAIT_V(2); G8_BAR;
    G8_STAGE_D(G8_SB(1, 0), cB + kstep); G8_STAGE_A(G8_SA(1, 0), cA + kstep, 0); G8_STAGE_D(G8_SB(1, 1), cB + hstep + kstep);
    G8_WAIT_V(6); G8_BAR;
    for (;;) {
        const bool has_next = S.next(ui + 1, nxt);
        if constexpr (GATHER) { if (has_next) *vslot = g8_avoff(nxt.pm, gather, tid, K); }
        const char* nB = has_next ? (const char*)nxt.bt : cB;
        const char* nA = (GATHER || !has_next) ? cA : (const char*)A + (size_t)nxt.pm * tstep;
        for (int t = 0; t < nt; t += 2) {
            const bool last = (t == nt - 2);
            const char* a1 = cA + (size_t)(t + 1) * kstep;
            const char* a2 = last ? nA : cA + (size_t)(t + 2) * kstep; const char* b2 = last ? nB : cB + (size_t)(t + 2) * kstep;
            const char* a3 = a2 + kstep; const char* b3 = b2 + kstep;
            G8_LDB(B0, 0, 0); G8_LDB(B1, 0, 1); G8_SCHED; G8_LDA(At, 0, 0); G8_STAGE_A(G8_SA(1, 1), a1, 1);
            if constexpr (GATHER) { if (last && has_next) va = *vslot; }
            G8_WAIT_V(8); G8_WAIT_L(0); G8_BAR; G8_MMA(0, 0, At, B0); G8_MMA(0, 1, At, B1); G8_BAR; G8_SCHED;
            G8_LDA(At, 0, 1); G8_STAGE_D(G8_SB(0, 0), b2); G8_STAGE_D(G8_SB(0, 1), b2 + hstep); G8_STAGE_A(G8_SA(0, 0), a2, 0);
            G8_WAIT_V(8); G8_WAIT_L(0); G8_BAR; G8_MMA(1, 0, At, B0); G8_MMA(1, 1, At, B1); G8_BAR; G8_SCHED;
            G8_LDB(B0, 1, 0); G8_LDB(B1, 1, 1); G8_SCHED; G8_LDA(At, 1, 0); G8_STAGE_A(G8_SA(0, 1), a2, 1);
            G8_WAIT_V(8); G8_WAIT_L(0); G8_BAR; G8_MMA(0, 0, At, B0); G8_MMA(0, 1, At, B1); G8_BAR; G8_SCHED;
            G8_LDA(At, 1, 1); G8_STAGE_D(G8_SB(1, 0), b3); G8_STAGE_D(G8_SB(1, 1), b3 + hstep); G8_STAGE_A(G8_SA(1, 0), a3, 0);
            G8_WAIT_V(8); G8_WAIT_L(0); G8_BAR; G8_MMA(1, 0, At, B0); G8_MMA(1, 1, At, B1); G8_BAR; G8_SCHED;
        }
        if (wr == 0) G8_BAR;
        E(acc, cur, wr, wc, fr, fq);
        if (!has_next) break;
#pragma unroll
        for (int a = 0; a < 2; ++a)
#pragma unroll
            for (int b = 0; b < 2; ++b)
#pragma unroll
                for (int m = 0; m < 4; ++m)
#pragma unroll
                    for (int n = 0; n < 2; ++n) acc[a][b][m][n] = (f32x4){0.f, 0.f, 0.f, 0.f};
        cur = nxt; cB = nB; cA = nA; ++ui;
        if (wr == 1) G8_BAR;
    }
    G8_WAIT_V(0);
    G8_BAR;
#undef G8_SA
#undef G8_SB
#undef G8_GLDS
#undef G8_STAGE_D
#undef G8_STAGE_A
#undef G8_LDA
#undef G8_LDB
#undef G8_MMA
#undef G8_WAIT_V
#undef G8_WAIT_L
#undef G8_BAR
#undef G8_SCHED
}

__device__ __forceinline__ float logsigmoid_f(float x) { return fminf(x, 0.f) - log1pf(__expf(-fabsf(x))); }
__device__ __forceinline__ void phase_gla_scan_naive(KA a, int li, LAS unsigned char* lds, int tid, int bx, int G) {
    const bf16* qkvr = (const bf16*)(a->ws + WS_BIG); const float* lr = (const float*)(a->ws + WS_LR);
    LAS float* qs = (LAS float*)lds;
    LAS float* ks = qs + 2048;
    LAS float* as = ks + 2048;
    LAS float* vs = as + 2048;
    LAS float* lrs = vs + 1024;
    LAS float* part = lrs + 256;
    for (int it = bx; it < 256; it += G) {
        const int b = it >> 5, h = (it >> 3) & 3, dir = (it >> 2) & 1, es = it & 3;
        const float* wg2 = a->in[dir ? I_GWG2B : I_GWG2F] + (size_t)li * 16 * 512; const float* bg = a->in[dir ? I_GBGB : I_GBGF] + (size_t)li * 512;
        bf16* oo = (bf16*)(a->ws + (dir ? WS_OB : WS_OF));
        const int dd = tid & 127;
        float wcol[16];
#pragma unroll
        for (int r = 0; r < 16; ++r) wcol[r] = wg2[r * 512 + h * 128 + dd];
        const float bgd = bg[h * 128 + dd];
        const int e = tid & 63, dp = tid >> 6;
        float S[16];
#pragma unroll
        for (int i = 0; i < 16; ++i) S[i] = 0.f;
        for (int t0 = 0; t0 < SEQ; t0 += 16) {
            __syncthreads();
            if (tid < 256) { const int st = tid >> 4, r = tid & 15; const int s = dir ? (SEQ - 1 - (t0 + st)) : (t0 + st); lrs[tid] = lr[(size_t)(b * SEQ + s) * 32 + dir * 16 + r]; }
            __syncthreads();
#pragma unroll
            for (int i = 0; i < 4; ++i) { const int st = (tid >> 7) + 4 * i; const int s = dir ? (SEQ - 1 - (t0 + st)) : (t0 + st); const size_t row = (size_t)(b * SEQ + s) * GLA_MAIN;
                qs[st * 128 + dd] = bf2f(qkvr[row + h * 128 + dd]); ks[st * 128 + dd] = bf2f(qkvr[row + 512 + h * 128 + dd]);
                float x = bgd;
#pragma unroll
                for (int r = 0; r < 16; ++r) x += lrs[st * 16 + r] * wcol[r];
                as[st * 128 + dd] = __expf(logsigmoid_f(x) * (1.0f / 16.0f)); }
#pragma unroll
            for (int i = 0; i < 2; ++i) { const int idx = tid + 512 * i, st = idx >> 6, ee = idx & 63; const int s = dir ? (SEQ - 1 - (t0 + st)) : (t0 + st);
                vs[idx] = bf2f(qkvr[(size_t)(b * SEQ + s) * GLA_MAIN + 1024 + h * 256 + es * 64 + ee]); }
            __syncthreads();
            for (int st = 0; st < 16; ++st) {
                const float vv = vs[st * 64 + e]; float po = 0.f;
#pragma unroll
                for (int i4 = 0; i4 < 4; ++i4) { const f32x4 q4 = *(const LAS f32x4*)(qs + st * 128 + dp * 16 + 4 * i4), k4 = *(const LAS f32x4*)(ks + st * 128 + dp * 16 + 4 * i4), a4 = *(const LAS f32x4*)(as + st * 128 + dp * 16 + 4 * i4);
#pragma unroll
                    for (int j = 0; j < 4; ++j) { S[4 * i4 + j] = a4[j] * S[4 * i4 + j] + k4[j] * vv; po += q4[j] * S[4 * i4 + j]; } }
                part[(dp * 16 + st) * 64 + e] = po;
            }
            __syncthreads();
#pragma unroll
            for (int i = 0; i < 2; ++i) { const int idx = tid + 512 * i, st = idx >> 6, ee = idx & 63; float s = 0.f;
#pragma unroll
                for (int w = 0; w < 8; ++w) s += part[(w * 16 + st) * 64 + ee];
                const int sq = dir ? (SEQ - 1 - (t0 + st)) : (t0 + st);
                oo[(size_t)(b * SEQ + sq) * D + h * 256 + es * 64 + ee] = (bf16)(cvt_pk_bf16(s, 0.f) & 0xffffu); }
        }
        __syncthreads();
    }
}
__device__ __forceinline__ void phase_gla_prep(KA a, int li, LAS unsigned char* lds, int tid, int bx, int G) {
    const int lane = tid & 63, wave = __builtin_amdgcn_readfirstlane(tid >> 6), fr = lane & 15, fq = lane >> 4;
    unsigned char* ws = a->ws;
    const bf16* qkvr = (const bf16*)(ws + WS_BIG); const float* lr = (const float*)(ws + WS_LR);
    bf16* QE = (bf16*)(ws + WS_QE); bf16* KET = (bf16*)(ws + WS_KET); bf16* PP = (bf16*)(ws + WS_P); bf16* VT = (bf16*)(ws + WS_VT); float* EL = (float*)(ws + WS_EL);
    constexpr int LS = 136, VLS = 264;
    LAS bf16* qes = (LAS bf16*)lds;
    LAS bf16* kes = qes + 64 * LS;
    LAS float* lrs = (LAS float*)(kes + 64 * LS);
    LAS float* segtot = lrs + 1024;
    LAS bf16* vraw = (LAS bf16*)(segtot + 512);
    const int d = tid & 127, seg = tid >> 7;
    const int so = tid & 15, sr = tid >> 4;
    for (int it = bx; it < 4096; it += G) {
        const int chunk = it & 63, dir = (it >> 6) & 1, h = (it >> 7) & 3, b = it >> 9;
        const int row0 = b * SEQ + chunk * 64;
        const size_t cidx = (size_t)(((dir * 8 + b) * 4 + h) * 64 + chunk);
        const float* wg2 = a->in[dir ? I_GWG2B : I_GWG2F] + (size_t)li * 16 * 512 + h * 128 + d; const float bgd = a->in[dir ? I_GBGB : I_GBGF][(size_t)li * 512 + h * 128 + d];
#pragma unroll
        for (int k2 = 0; k2 < 2; ++k2) { const int p = sr + 32 * k2; const bf16* src = qkvr + (size_t)(row0 + p) * GLA_MAIN + h * 128 + 8 * so;
            const u32x4 qv = *(const u32x4*)src, kv = *(const u32x4*)(src + 512);
            *(LAS u32x4*)(qes + p * LS + 8 * so) = qv; *(LAS u32x4*)(kes + p * LS + 8 * so) = kv; }
        if (dir == 0) {
#pragma unroll
            for (int k4 = 0; k4 < 4; ++k4) { const int idx = tid + 512 * k4, p = idx >> 5, oc = idx & 31;
                *(LAS u32x4*)(vraw + p * VLS + 8 * oc) = *(const u32x4*)(qkvr + (size_t)(row0 + p) * GLA_MAIN + 1024 + h * 256 + 8 * oc); }
        }
        for (int i = tid; i < 1024; i += NTHREADS) lrs[i] = lr[(size_t)(row0 + (i >> 4)) * 32 + dir * 16 + (i & 15)];
        float wcol[16];
#pragma unroll
        for (int r = 0; r < 16; ++r) wcol[r] = wg2[r * 512];
        __syncthreads();
        float g[16];
#pragma unroll
        for (int s2 = 0; s2 < 16; ++s2) { const LAS float* lp = lrs + (seg * 16 + s2) * 16; float x = bgd;
#pragma unroll
            for (int r4 = 0; r4 < 4; ++r4) { const f32x4 l4 = *(const LAS f32x4*)(lp + 4 * r4); x += l4[0] * wcol[4 * r4] + l4[1] * wcol[4 * r4 + 1] + l4[2] * wcol[4 * r4 + 2] + l4[3] * wcol[4 * r4 + 3]; }
            g[s2] = (fminf(x, 0.f) - __logf(1.0f + __expf(-fabsf(x)))) * (1.0f / 16.0f); }
        if (dir == 0) {
#pragma unroll
            for (int s2 = 1; s2 < 16; ++s2) g[s2] += g[s2 - 1];
        } else {
#pragma unroll
            for (int s2 = 14; s2 >= 0; --s2) g[s2] += g[s2 + 1];
        }
        segtot[seg * 128 + d] = dir ? g[0] : g[15];
        __syncthreads();
        float pre = 0.f, total = 0.f;
#pragma unroll
        for (int sg = 0; sg < 4; ++sg) { const float t = segtot[sg * 128 + d]; total += t; if (dir ? (sg > seg) : (sg < seg)) pre += t; }
        if (seg == 0) EL[cidx * 128 + d] = __expf(total);
        unsigned kt[8];
#pragma unroll
        for (int s2 = 0; s2 < 16; s2 += 2) {
            unsigned kw[2];
#pragma unroll
            for (int u = 0; u < 2; ++u) { const int p = seg * 16 + s2 + u;
                const float q = bf2f(qes[p * LS + d]), k = bf2f(kes[p * LS + d]); const float bb = g[s2 + u] + pre;
                const float eb_ = __expf(bb); const unsigned qw = cvt_pk_bf16(q * eb_, 0.f) & 0xffffu; kw[u] = cvt_pk_bf16(k * __builtin_amdgcn_rcpf(eb_), 0.f) & 0xffffu;
                qes[p * LS + d] = (bf16)qw; kes[p * LS + d] = (bf16)kw[u]; }
            kt[s2 >> 1] = kw[0] | (kw[1] << 16);
        }
        { bf16* kp = KET + cidx * 8192 + (size_t)d * 64 + seg * 16; *(u32x4*)kp = (u32x4){kt[0], kt[1], kt[2], kt[3]}; *(u32x4*)(kp + 8) = (u32x4){kt[4], kt[5], kt[6], kt[7]}; }
        __syncthreads();
#pragma unroll
        for (int k2 = 0; k2 < 2; ++k2) { const int p = sr + 32 * k2; *(u32x4*)(QE + ((size_t)dir * T + row0 + p) * 512 + h * 128 + 8 * so) = *(const LAS u32x4*)(qes + p * LS + 8 * so); }
        { const int jt = wave & 3;
#pragma unroll
          for (int ii = 0; ii < 2; ++ii) { const int itile = 2 * (wave >> 2) + ii;
            f32x4 acc = (f32x4){0.f, 0.f, 0.f, 0.f};
            const bool dead = dir ? (jt < itile) : (jt > itile);
            if (!dead) {
#pragma unroll
                for (int ks = 0; ks < 4; ++ks) { const bf16x8 kf = *(const LAS bf16x8*)(kes + (jt * 16 + fr) * LS + ks * 32 + 8 * fq), qf = *(const LAS bf16x8*)(qes + (itile * 16 + fr) * LS + ks * 32 + 8 * fq);
                    acc = __builtin_amdgcn_mfma_f32_16x16x32_bf16(kf, qf, acc, 0, 0, 0); }
            }
            const int i = itile * 16 + fr, j0 = jt * 16 + 4 * fq; float pv[4];
#pragma unroll
            for (int jj = 0; jj < 4; ++jj) { const int j = j0 + jj; const bool keep = dir ? (j >= i) : (j <= i); pv[jj] = keep ? acc[jj] : 0.f; }
            u32x2 o; o.x = cvt_pk_bf16(pv[0], pv[1]); o.y = cvt_pk_bf16(pv[2], pv[3]);
            *(u32x2*)(PP + cidx * 4096 + (size_t)i * 64 + j0) = o; } }
        if (dir == 0) {
            const int e = tid & 255, jh = tid >> 8; unsigned w[16];
#pragma unroll
            for (int jj = 0; jj < 32; jj += 2) w[jj >> 1] = (unsigned)vraw[(jh * 32 + jj) * VLS + e] | ((unsigned)vraw[(jh * 32 + jj + 1) * VLS + e] << 16);
            bf16* vp = VT + ((size_t)((b * 4 + h) * 64 + chunk) * 256 + e) * 64 + jh * 32;
#pragma unroll
            for (int q4 = 0; q4 < 4; ++q4) *(u32x4*)(vp + 8 * q4) = (u32x4){w[4 * q4], w[4 * q4 + 1], w[4 * q4 + 2], w[4 * q4 + 3]};
        }
        __syncthreads();
    }
}
struct GlaFrags { bf16x8 qf[4], pf[2], vf[2][2], kf[2][2]; };
__device__ __forceinline__ void phase_gla_scan(KA a, LAS unsigned char* lds, int tid, int bx, int G) {
    const int lane = tid & 63, wave = __builtin_amdgcn_readfirstlane(tid >> 6), fr = lane & 15, fq = lane >> 4;
    unsigned char* ws = a->ws;
    const bf16* QE = (const bf16*)(ws + WS_QE); const bf16* KET = (const bf16*)(ws + WS_KET); const bf16* PP = (const bf16*)(ws + WS_P); const bf16* VT = (const bf16*)(ws + WS_VT); const float* EL = (const float*)(ws + WS_EL);
    constexpr int SS = 136;
    LAS bf16* ST = (LAS bf16*)lds;
    const int et0 = 2 * (wave & 1), dt0 = 2 * (wave >> 1), itile = wave >> 1;
    for (int it0 = bx; it0 < 256; it0 += G) {
        const int it = (G == 256) ? ((it0 & 7) * 32 + (it0 >> 3)) : it0;
        const int b = it >> 5, h = (it >> 3) & 3, dir = (it >> 2) & 1, es = it & 3;
        bf16* OO = (bf16*)(ws + (dir ? WS_OB : WS_OF));
        __syncthreads();
        for (int i = tid; i < 64 * SS / 2; i += NTHREADS) ((LAS unsigned*)ST)[i] = 0u;
        __syncthreads();
        f32x4 accS[2][2];
#pragma unroll
        for (int x = 0; x < 2; ++x)
#pragma unroll
            for (int y = 0; y < 2; ++y) accS[x][y] = (f32x4){0.f, 0.f, 0.f, 0.f};
        const size_t cbase = (size_t)((dir * 8 + b) * 4 + h) * 64;
        const char* qb = (const char*)(QE + ((size_t)dir * T + (size_t)b * SEQ + itile * 16) * 512 + h * 128);
        const char* pb = (const char*)(PP + cbase * 4096 + (size_t)(itile * 16) * 64);
        const char* vb = (const char*)(VT + ((size_t)(b * 4 + h) * 64 * 256 + es * 64 + et0 * 16) * 64);
        const char* kb = (const char*)(KET + cbase * 8192 + (size_t)(dt0 * 16) * 64);
        const char* eb = (const char*)(EL + cbase * 128 + dt0 * 16);
        char* ob = (char*)(OO + ((size_t)b * SEQ + itile * 16) * D + h * 256 + es * 64 + et0 * 16);
        const unsigned lq = (unsigned)(fr * 512 + 8 * fq) * 2u, l64 = (unsigned)(fr * 64 + 8 * fq) * 2u, le = (unsigned)fq * 16u, lo = (unsigned)(fr * D + 4 * fq) * 2u;
#define GLA_LOAD(F, c_) do { const int c__ = (c_); \
            _Pragma("unroll") for (int ks = 0; ks < 4; ++ks) F.qf[ks] = *(const bf16x8*)(qb + (size_t)c__ * (64 * 512 * 2) + ks * 64 + lq); \
            _Pragma("unroll") for (int ks = 0; ks < 2; ++ks) F.pf[ks] = *(const bf16x8*)(pb + (size_t)c__ * 8192 + ks * 64 + l64); \
            _Pragma("unroll") for (int et = 0; et < 2; ++et) _Pragma("unroll") for (int ks = 0; ks < 2; ++ks) F.vf[et][ks] = *(const bf16x8*)(vb + (size_t)c__ * 32768 + et * 2048 + ks * 64 + l64); \
            _Pragma("unroll") for (int dt = 0; dt < 2; ++dt) _Pragma("unroll") for (int ks = 0; ks < 2; ++ks) F.kf[dt][ks] = *(const bf16x8*)(kb + (size_t)c__ * 16384 + dt * 2048 + ks * 64 + l64); } while (0)
#define GLA_STEP(cc_, CUR, NXT) do { const int cc = (cc_); const int c = dir ? 63 - cc : cc; const int ccn = cc + 1 < 64 ? cc + 1 : 63; \
            GLA_LOAD(NXT, dir ? 63 - ccn : ccn); \
            const f32x4 el0 = *(const f32x4*)(eb + (size_t)c * 512 + le), el1 = *(const f32x4*)(eb + (size_t)c * 512 + 64 + le); \
            const LAS bf16* Sr = ST + (cc & 1) * 64 * SS; LAS bf16* Sw = ST + ((cc + 1) & 1) * 64 * SS; \
            _Pragma("unroll") for (int et = 0; et < 2; ++et) { f32x4 ao = (f32x4){0.f, 0.f, 0.f, 0.f}; \
                _Pragma("unroll") for (int ks = 0; ks < 4; ++ks) { const bf16x8 sf = *(const LAS bf16x8*)(Sr + ((et0 + et) * 16 + fr) * SS + ks * 32 + 8 * fq); ao = __builtin_amdgcn_mfma_f32_16x16x32_bf16(sf, CUR.qf[ks], ao, 0, 0, 0); } \
                _Pragma("unroll") for (int ks = 0; ks < 2; ++ks) ao = __builtin_amdgcn_mfma_f32_16x16x32_bf16(CUR.vf[et][ks], CUR.pf[ks], ao, 0, 0, 0); \
                u32x2 o; o.x = cvt_pk_bf16(ao[0], ao[1]); o.y = cvt_pk_bf16(ao[2], ao[3]); \
                *(u32x2*)(ob + (size_t)c * (64 * D * 2) + et * 32 + lo) = o; } \
            _Pragma("unroll") for (int dt = 0; dt < 2; ++dt) _Pragma("unroll") for (int et = 0; et < 2; ++et) { \
                _Pragma("unroll") for (int ks = 0; ks < 2; ++ks) accS[dt][et] = __builtin_amdgcn_mfma_f32_16x16x32_bf16(CUR.kf[dt][ks], CUR.vf[et][ks], accS[dt][et], 0, 0, 0); \
                accS[dt][et] = accS[dt][et] * (dt ? el1 : el0); \
                u32x2 o; o.x = cvt_pk_bf16(accS[dt][et][0], accS[dt][et][1]); o.y = cvt_pk_bf16(accS[dt][et][2], accS[dt][et][3]); \
                *(LAS u32x2*)(Sw + ((et0 + et) * 16 + fr) * SS + (dt0 + dt) * 16 + 4 * fq) = o; } \
            __syncthreads(); } while (0)
        GlaFrags FA, FB;
        GLA_LOAD(FA, dir ? 63 : 0);
#pragma unroll 1
        for (int c2 = 0; c2 < 64; c2 += 2) { GLA_STEP(c2, FA, FB); GLA_STEP(c2 + 1, FB, FA); }
#undef GLA_LOAD
#undef GLA_STEP
    }
}

__device__ __forceinline__ void phase_gla_post(KA a, int li, int tid, int bx, int G) {
    const int lane = tid & 63, wave = tid >> 6;
    const bf16* of = (const bf16*)(a->ws + WS_OF); const bf16* ob = (const bf16*)(a->ws + WS_OB); const bf16* qkvr = (const bf16*)(a->ws + WS_BIG); bf16* A2 = (bf16*)(a->ws + WS_A2);
    const float* ng = a->in[I_GNORM] + (size_t)li * 256 + (lane & 15) * 16;
    float g[16];
#pragma unroll
    for (int j = 0; j < 16; ++j) g[j] = ng[j];
    for (int token = bx * NWAVES + wave; token < T; token += G * NWAVES) {
        const u32x4 f0 = *(const u32x4*)(of + (size_t)token * D + 16 * lane), f1 = *(const u32x4*)(of + (size_t)token * D + 16 * lane + 8);
        const u32x4 b0 = *(const u32x4*)(ob + (size_t)token * D + 16 * lane), b1 = *(const u32x4*)(ob + (size_t)token * D + 16 * lane + 8);
        const u32x4 r0 = *(const u32x4*)(qkvr + (size_t)token * GLA_MAIN + 2048 + 16 * lane), r1 = *(const u32x4*)(qkvr + (size_t)token * GLA_MAIN + 2048 + 16 * lane + 8);
        float o[16], r[16];
#pragma unroll
        for (int q = 0; q < 4; ++q) { o[2 * q] = bf_lo(f0[q]) + bf_lo(b0[q]); o[2 * q + 1] = bf_hi(f0[q]) + bf_hi(b0[q]); o[8 + 2 * q] = bf_lo(f1[q]) + bf_lo(b1[q]); o[8 + 2 * q + 1] = bf_hi(f1[q]) + bf_hi(b1[q]);
            r[2 * q] = bf_lo(r0[q]); r[2 * q + 1] = bf_hi(r0[q]); r[8 + 2 * q] = bf_lo(r1[q]); r[8 + 2 * q + 1] = bf_hi(r1[q]); }
        float ss = 0.f;
#pragma unroll
        for (int j = 0; j < 16; ++j) ss += o[j] * o[j];
        ss += shfl_xor_f(ss, 1, lane); ss += shfl_xor_f(ss, 2, lane); ss += shfl_xor_f(ss, 4, lane); ss += shfl_xor_f(ss, 8, lane);
        const float rstd = 1.0f / sqrtf(ss * (1.0f / 256.0f) + LN_EPS);
        unsigned w[8];
#pragma unroll
        for (int q = 0; q < 8; ++q) w[q] = cvt_pk_bf16(o[2 * q] * rstd * g[2 * q] * silu_f(r[2 * q]), o[2 * q + 1] * rstd * g[2 * q + 1] * silu_f(r[2 * q + 1]));
        *(u32x4*)(A2 + (size_t)token * D + 16 * lane) = (u32x4){w[0], w[1], w[2], w[3]}; *(u32x4*)(A2 + (size_t)token * D + 16 * lane + 8) = (u32x4){w[4], w[5], w[6], w[7]};
    }
}

__device__ __forceinline__ void phase_sgu_core(KA a, int li, LAS unsigned char* lds, int tid, int bx, int G) {
    const int lane = tid & 63, wave = __builtin_amdgcn_readfirstlane(tid >> 6), fr = lane & 15, fq = lane >> 4;
    unsigned char* ws = a->ws;
    const bf16* z = (const bf16*)(ws + WS_BIG); bf16* A2 = (bf16*)(ws + WS_A2);
    const float* lng = a->in[I_SLNG] + (size_t)li * 1024; const float* lnb = a->in[I_SLNB] + (size_t)li * 1024;
    const bf16* wsp = (const bf16*)(ws + WS_SGUWS) + (size_t)li * 8 * 128 * 128; const float* bs = a->in[I_SBS] + (size_t)li * 8 * 128;
    constexpr int VS = 132;
    LAS bf16* vn = (LAS bf16*)lds;
    LAS float* st_mean = (LAS float*)(lds + 2 * 128 * VS * 2); LAS float* st_rstd = st_mean + 128;
    const int co = tid & 15, qr = tid >> 4;
    for (int it = bx; it < T / 128; it += G) {
        const int row0 = it * 128;
        __syncthreads();
#pragma unroll 1
        for (int rr = 0; rr < 16; ++rr) { const int q = wave * 16 + rr; const bf16* vp = z + (size_t)(row0 + q) * 2048 + 1024 + 16 * lane;
            const u32x4 v0 = *(const u32x4*)vp, v1 = *(const u32x4*)(vp + 8); float x[16];
#pragma unroll
            for (int k = 0; k < 4; ++k) { x[2 * k] = bf_lo(v0[k]); x[2 * k + 1] = bf_hi(v0[k]); x[8 + 2 * k] = bf_lo(v1[k]); x[8 + 2 * k + 1] = bf_hi(v1[k]); }
            float s1 = 0.f;
#pragma unroll
            for (int k = 0; k < 16; ++k) s1 += x[k];
            const float mean = wave_sum(s1, lane) * (1.0f / 1024.0f); float s2 = 0.f;
#pragma unroll
            for (int k = 0; k < 16; ++k) { const float dd = x[k] - mean; s2 += dd * dd; }
            const float rstd = 1.0f / sqrtf(wave_sum(s2, lane) * (1.0f / 1024.0f) + LN_EPS);
            if (lane == 0) { st_mean[q] = mean; st_rstd[q] = rstd; } }
        __syncthreads();
        const int p = wave * 16 + fr;
#pragma unroll 1
        for (int g = 0; g < 8; ++g) {
            LAS bf16* vb = vn + (g & 1) * 128 * VS;
            {
                const f32x4 g0 = *(const f32x4*)(lng + g * 128 + 8 * co), g1 = *(const f32x4*)(lng + g * 128 + 8 * co + 4), b0 = *(const f32x4*)(lnb + g * 128 + 8 * co), b1 = *(const f32x4*)(lnb + g * 128 + 8 * co + 4);
#pragma unroll
                for (int k = 0; k < 4; ++k) { const int q = qr + 32 * k; const u32x4 w = *(const u32x4*)(z + (size_t)(row0 + q) * 2048 + 1024 + g * 128 + 8 * co);
                    const float m = st_mean[q], r = st_rstd[q];
                    u32x2 o0, o1;
                    o0.x = cvt_pk_bf16((bf_lo(w.x) - m) * r * g0[0] + b0[0], (bf_hi(w.x) - m) * r * g0[1] + b0[1]); o0.y = cvt_pk_bf16((bf_lo(w.y) - m) * r * g0[2] + b0[2], (bf_hi(w.y) - m) * r * g0[3] + b0[3]);
                    o1.x = cvt_pk_bf16((bf_lo(w.z) - m) * r * g1[0] + b1[0], (bf_hi(w.z) - m) * r * g1[1] + b1[1]); o1.y = cvt_pk_bf16((bf_lo(w.w) - m) * r * g1[2] + b1[2], (bf_hi(w.w) - m) * r * g1[3] + b1[3]);
                    *(LAS u32x2*)(vb + q * VS + 8 * co) = o0; *(LAS u32x2*)(vb + q * VS + 8 * co + 4) = o1; }
            }
            bf16x8 wf[4];
#pragma unroll
            for (int ks = 0; ks < 4; ++ks) wf[ks] = *(const bf16x8*)(wsp + ((size_t)g * 128 + p) * 128 + ks * 32 + 8 * fq);
            const float bias = bs[g * 128 + p];
            __syncthreads();
#pragma unroll 2
            for (int ct = 0; ct < 8; ++ct) {
                f32x4 acc = (f32x4){0.f, 0.f, 0.f, 0.f};
#pragma unroll
                for (int ks = 0; ks < 4; ++ks) { const LAS bf16* sp = vb + (ks * 32 + 8 * fq) * VS + ct * 16 + fr; unsigned w4[4];
#pragma unroll
                    for (int j2 = 0; j2 < 4; ++j2) w4[j2] = (unsigned)sp[(2 * j2) * VS] | ((unsigned)sp[(2 * j2 + 1) * VS] << 16);
                    const bf16x8 vf = __builtin_bit_cast(bf16x8, (u32x4){w4[0], w4[1], w4[2], w4[3]});
                    acc = __builtin_amdgcn_mfma_f32_16x16x32_bf16(vf, wf[ks], acc, 0, 0, 0); }
                const int c0 = g * 128 + ct * 16 + 4 * fq;
                const u32x2 uu = *(const u32x2*)(z + (size_t)(row0 + p) * 2048 + c0);
                u32x2 o; o.x = cvt_pk_bf16(bf_lo(uu.x) * (acc[0] + bias), bf_hi(uu.x) * (acc[1] + bias)); o.y = cvt_pk_bf16(bf_lo(uu.y) * (acc[2] + bias), bf_hi(uu.y) * (acc[3] + bias));
                *(u32x2*)(A2 + (size_t)(row0 + p) * D + c0) = o;
            }
        }
    }
}

constexpr int PH_PER_LAYER = 10;
constexpr int NPHASES = 2 + PH_PER_LAYER * DEPTH;
#ifdef USE_NAIVE_GEMM
#define GEMM_BODY(A, g, K, S, E) gemm_naive(A, g, K, S, E, tid)
#define GEMM_BODY_G(A, g, K, S, E) gemm_naive(A, g, K, S, E, tid)
#else
#define GEMM_BODY(A, g, K, S, E) gemm_fast<false>(A, g, K, S, E, lds, tid)
#define GEMM_BODY_G(A, g, K, S, E) gemm_fast<true>(A, g, K, S, E, lds, tid)
#endif
__device__ __forceinline__ void ph_prologue(int wave_s) { PHASE_ENTER(); phase_prologue(a, lds, tid, bx, G); }
__device__ __forceinline__ void ph_rp_init(int wave_s) { PHASE_ENTER(); float* mod = (float*)(ws + WS_MOD);
    RowPass p{}; p.xin = a->in[I_X]; p.hout = (bf16*)(ws + WS_H); p.sc = mod + 1 * 1024; p.sh = mod + 0 * 1024; p.wside = (const bf16*)(ws + WS_GLALR_T); p.lr_out = (float*)(ws + WS_LR); p.has_h = 1; p.has_side = 1;
    row_pass<0>(p, lds, tid, bx, G); }
__device__ __forceinline__ void ph_gla_in(int wave_s, int li) { PHASE_ENTER(); Sched S; S.init(T / 256, GLA_MAIN / 256, G, bx, (const bf16*)(ws + WS_GLAIN_T) + (size_t)li * GLA_MAIN * 1024, 0, nullptr, 1024); EpiGlaIn E{(bf16*)(ws + WS_BIG)}; GEMM_BODY((const bf16*)(ws + WS_H), nullptr, 1024, S, E); }
__device__ __forceinline__ void ph_sgu_in(int wave_s, int li) { PHASE_ENTER(); Sched S; S.init(T / 256, 2048 / 256, G, bx, (const bf16*)(ws + WS_SGUIN_T) + (size_t)li * 2048 * 1024, 0, nullptr, 1024); EpiSguIn E{(bf16*)(ws + WS_BIG), a->in[I_SBIN] + (size_t)li * 2048}; GEMM_BODY((const bf16*)(ws + WS_H), nullptr, 1024, S, E); }
__device__ __forceinline__ void ph_gla_scan_naive(int wave_s, int li) { PHASE_ENTER(); phase_gla_scan_naive(a, li, lds, tid, bx, G); }
__device__ __forceinline__ void ph_gla_prep(int wave_s, int li) { PHASE_ENTER(); phase_gla_prep(a, li, lds, tid, bx, G); }
__device__ __forceinline__ void ph_gla_scan(int wave_s) { PHASE_ENTER(); phase_gla_scan(a, lds, tid, bx, G); }
__device__ __forceinline__ void ph_sgu_core(int wave_s, int li) { PHASE_ENTER(); phase_sgu_core(a, li, lds, tid, bx, G); }
__device__ __forceinline__ void ph_gla_post(int wave_s, int li) { PHASE_ENTER(); phase_gla_post(a, li, tid, bx, G); }
__device__ __forceinline__ void ph_out(int wave_s, int l) { PHASE_ENTER(); const int li = l >> 1; const bool sgu = (l & 1) != 0;
    Sched S; S.init(T / 256, 4, G, bx, (const bf16*)(ws + (sgu ? WS_SGUOUT_T : WS_GLAOUT_T)) + (size_t)li * 1024 * 1024, 0, nullptr, 1024);
    EpiOut E{(bf16*)(ws + WS_Y), sgu ? a->in[I_SBOUT] + (size_t)li * 1024 : nullptr}; GEMM_BODY((const bf16*)(ws + WS_A2), nullptr, 1024, S, E); }
__device__ __forceinline__ void ph_rp_mid(int wave_s, int l) { PHASE_ENTER(); float* modl = (float*)(ws + WS_MOD) + (size_t)l * 8 * 6144; int* route = (int*)(ws + WS_ROUTE);
    RowPass p{}; p.xin = (l == 0) ? a->in[I_X] : (const float*)(ws + WS_X2); p.y = (const bf16*)(ws + WS_Y); p.xout = (float*)(ws + WS_X1); p.hout = (bf16*)(ws + WS_H);
    p.gate = modl + 2 * 1024; p.lng = a->in[I_LNG] + (size_t)(l * 2 + 0) * 1024; p.lnb = a->in[I_LNB] + (size_t)(l * 2 + 0) * 1024; p.sc = modl + 4 * 1024; p.sh = modl + 3 * 1024;
    p.wside = (const bf16*)(ws + WS_ROUTER_T) + (size_t)l * 64 * 1024; p.rbias = a->in[I_RB] + (size_t)l * 32;
    p.topi = route + R_TOPI; p.topw = (float*)(route + R_TOPW); p.hist = route + R_HIST + bx * 32; p.has_h = 1; p.has_side = 1;
    row_pass<1>(p, lds, tid, bx, G); }
__device__ __forceinline__ void ph_place(int wave_s) { PHASE_ENTER(); phase_place((int*)(ws + WS_ROUTE), lds, tid, bx, G); }
__device__ __forceinline__ void ph_moe_up(int wave_s, int l) { PHASE_ENTER(); int* route = (int*)(ws + WS_ROUTE); const int ntiles = __builtin_amdgcn_readfirstlane(route[R_NTILES]);
    Sched S; S.init(ntiles, 8, G, bx, (const bf16*)(ws + WS_WUP_T) + (size_t)l * 32 * 2048 * 1024, (size_t)2048 * 1024, route + R_TILEE, 1024);
    EpiUp E{(bf16*)(ws + WS_ACT), a->in[I_BUP] + (size_t)l * 32 * 2048}; GEMM_BODY_G((const bf16*)(ws + WS_H), route + R_BUFTOK, 1024, S, E); }
__device__ __forceinline__ void ph_moe_down(int wave_s, int l) { PHASE_ENTER(); int* route = (int*)(ws + WS_ROUTE); const int ntiles = __builtin_amdgcn_readfirstlane(route[R_NTILES]);
    Sched S; S.init(ntiles, 4, G, bx, (const bf16*)(ws + WS_WDN_T) + (size_t)l * 32 * 1024 * 1024, (size_t)1024 * 1024, route + R_TILEE, 1024);
    EpiDown E{(bf16*)(ws + WS_YS), a->in[I_BDN] + (size_t)l * 32 * 1024}; GEMM_BODY((const bf16*)(ws + WS_ACT), nullptr, 1024, S, E); }
__device__ __forceinline__ void ph_rp_end(int wave_s, int l) { PHASE_ENTER(); float* mod = (float*)(ws + WS_MOD); float* modl = mod + (size_t)l * 8 * 6144; int* route = (int*)(ws + WS_ROUTE);
    RowPass p{}; p.xin = (const float*)(ws + WS_X1); p.xout = (l == DEPTH - 1) ? a->out : (float*)(ws + WS_X2); p.hout = (bf16*)(ws + WS_H);
    p.gate = modl + 5 * 1024; p.lng = a->in[I_LNG] + (size_t)(l * 2 + 1) * 1024; p.lnb = a->in[I_LNB] + (size_t)(l * 2 + 1) * 1024;
    p.ys = (const bf16*)(ws + WS_YS); p.dest = route + R_DEST; p.tw = (const float*)(route + R_TOPW);
    if (l < DEPTH - 1) { float* modn = mod + (size_t)(l + 1) * 8 * 6144; p.sc = modn + 1 * 1024; p.sh = modn + 0 * 1024; p.has_h = 1;
        if (((l + 1) & 1) == 0) { p.has_side = 1; p.wside = (const bf16*)(ws + WS_GLALR_T) + (size_t)((l + 1) >> 1) * 64 * 1024; p.lr_out = (float*)(ws + WS_LR); } }
    row_pass<2>(p, lds, tid, bx, G); }

__global__ void __launch_bounds__(NTHREADS, 2) fwd_kernel(Args a) {
    extern __shared__ __attribute__((aligned(16))) unsigned char lds_raw[];
    LAS unsigned char* lds = (LAS unsigned char*)lds_raw;
    volatile LAS unsigned* MISC = (volatile LAS unsigned*)(lds + MISC_OFF);
    const int tid = threadIdx.x; const int wave_s = __builtin_amdgcn_readfirstlane(tid >> 6);
    if (tid < 32) ((LAS unsigned*)(lds + MISC_OFF))[tid] = 0u;
    __syncthreads();
    unsigned* ctl = (unsigned*)(a.ws + WS_CTL);
    XcdBarrier bar = xcd_barrier_post(ctl + CW_BAR + a.li * XCD_BAR_WORDS, MISC + 8);
    const int lo = a.ph_lo, hi = a.ph_hi;
#ifndef REPK
#define REPK 0
#define REPN 1
#endif
#define REP(kind) for (int rep_ = 0; rep_ < ((REPK == (kind)) ? REPN : 1); ++rep_)
#define IN(k) (lo <= (k) && (k) < hi)
#define SEAM(k) do { if (IN(k) && IN((k) + 1)) xcd_barrier(bar); } while (0)
    if (IN(0)) { REP(3) ph_prologue(wave_s); SEAM(0); }
    if (IN(1)) { ph_rp_init(wave_s); SEAM(1); }
    for (int l = 0; l < DEPTH; ++l) {
        const int pb = 2 + PH_PER_LAYER * l, li = l >> 1; const bool sgu = (l & 1) != 0;
        if (IN(pb + 0)) { REP(10) { if (!sgu) ph_gla_in(wave_s, li); else ph_sgu_in(wave_s, li); } SEAM(pb + 0); }
        if (IN(pb + 1)) { if (!sgu) { REP(12) ph_gla_prep(wave_s, li); SEAM(pb + 1); } }
        if (IN(pb + 2)) { if (!sgu) { REP(1) ph_gla_scan(wave_s); } else { REP(2) ph_sgu_core(wave_s, li); } SEAM(pb + 2); }
        if (IN(pb + 3)) { if (!sgu) { REP(6) ph_gla_post(wave_s, li); SEAM(pb + 3); } }
        if (IN(pb + 4)) { REP(11) ph_out(wave_s, l); SEAM(pb + 4); }
        if (IN(pb + 5)) { REP(4) ph_rp_mid(wave_s, l); SEAM(pb + 5); }
        if (IN(pb + 6)) { REP(7) ph_place(wave_s); SEAM(pb + 6); }
        if (IN(pb + 7)) { REP(8) ph_moe_up(wave_s, l); SEAM(pb + 7); }
        if (IN(pb + 8)) { REP(9) ph_moe_down(wave_s, l); SEAM(pb + 8); }
        if (IN(pb + 9)) { REP(5) ph_rp_end(wave_s, l); SEAM(pb + 9); }
    }
#undef IN
#undef SEAM
}

#ifndef N_LAUNCH_MODE
#define N_LAUNCH_MODE 1
#endif
extern "C" void kernel_launch(void* const* d_in, const int* in_sizes, int n_in, void* d_out, int out_size, void* d_ws, size_t ws_size, hipStream_t stream) {
    static int grid = 0;
    if (grid == 0) {
        if (n_in != 27 || out_size != T * D || ws_size < WS_END) { fprintf(stderr, "kernel_launch: unexpected shapes (n_in %d out %d ws %zu)\n", n_in, out_size, ws_size); grid = -1; return; }
        int dev = 0, cus = 0, per_cu = 0;
        if (hipGetDevice(&dev) != hipSuccess || hipDeviceGetAttribute(&cus, hipDeviceAttributeMultiprocessorCount, dev) != hipSuccess) { grid = -1; return; }
        if (hipFuncSetAttribute((const void*)fwd_kernel, hipFuncAttributeMaxDynamicSharedMemorySize, LDS_BYTES) != hipSuccess) { fprintf(stderr, "kernel_launch: hipFuncSetAttribute failed\n"); grid = -1; return; }
        if (hipOccupancyMaxActiveBlocksPerMultiprocessor(&per_cu, (const void*)fwd_kernel, NTHREADS, LDS_BYTES) != hipSuccess || per_cu < 1) fprintf(stderr, "kernel_launch: occupancy query reports %d\n", per_cu);
        (void)hipGetLastError();
        grid = cus;
        if (grid > 1024) grid = 1024;
    }
    if (grid < 0) return;
    (void)hipMemsetAsync((char*)d_ws + WS_CTL, 0, CTL_ZERO_BYTES, stream);
    Args a{};
    for (int i = 0; i < 27; ++i) a.in[i] = (const float*)d_in[i];
    a.out = (float*)d_out; a.ws = (unsigned char*)d_ws; a.pad = 0;
#if N_LAUNCH_MODE == 1
    a.ph_lo = 0; a.ph_hi = NPHASES; a.li = 0;
    hipLaunchKernelGGL(fwd_kernel, dim3(grid), dim3(NTHREADS), LDS_BYTES, stream, a);
#else
    for (int ph = 0, li = 0; ph < NPHASES; ++ph) {
        if (ph >= 2 && (((ph - 2) % PH_PER_LAYER) == 1 || ((ph - 2) % PH_PER_LAYER) == 3) && (((ph - 2) / PH_PER_LAYER) & 1)) continue;
        a.ph_lo = ph; a.ph_hi = ph + 1; a.li = li++;
        hipLaunchKernelGGL(fwd_kernel, dim3(grid), dim3(NTHREADS), LDS_BYTES, stream, a);
    }
#endif
}
```

```cpp
#include <hip/hip_runtime.h>
#include <cstdio>
#include <cstdint>

#define LAS __attribute__((address_space(3)))
#define GAS __attribute__((address_space(1)))
typedef unsigned short bf16;
typedef short bf16x8 __attribute__((ext_vector_type(8)));
typedef float f32x4 __attribute__((ext_vector_type(4)));
typedef float f32x2 __attribute__((ext_vector_type(2)));
typedef unsigned u32x4 __attribute__((ext_vector_type(4)));
typedef unsigned u32x2 __attribute__((ext_vector_type(2)));
typedef int i32x4 __attribute__((ext_vector_type(4)));
typedef int i32x8 __attribute__((ext_vector_type(8)));

#ifndef MOE_FP8
#define MOE_FP8 1
#endif
constexpr int D = 1024, NB = 8, SEQ = 4096, T = NB * SEQ, DEPTH = 4;
constexpr int NE = 32, TOPK = 4, CAP = T * TOPK + NE * 256;
constexpr int MAXTILES = CAP / 256;
constexpr float ALPHA = 1.681792830507429f;
constexpr float LN_EPS = 1e-5f;
constexpr float F8_WSCALE = 64.0f, F8_HSCALE = 8.0f, F8_ASCALE = 4.0f;
constexpr int GLA_IN = 3104, GLA_MAIN = 3072;
constexpr int NWAVES = 8, NTHREADS = 512;
constexpr int LDS_BYTES = 147456, MISC_OFF = 139264;

constexpr size_t MiB = 1u << 20;
constexpr size_t WS_CTL = 0, CTL_ZERO_BYTES = 2 * MiB;
constexpr size_t WS_MOD = 2 * MiB;
constexpr size_t WS_ROUTE = 4 * MiB;
constexpr size_t WS_LR = 8 * MiB;
constexpr size_t WS_GLAIN_T = 16 * MiB;
constexpr size_t WS_GLALR_T = 28 * MiB;
constexpr size_t WS_ROUTER_T = 29 * MiB;
constexpr size_t WS_SGUWS = 30 * MiB;
constexpr size_t WS_GLAOUT_T = 32 * MiB;
constexpr size_t WS_SGUIN_T = 36 * MiB;
constexpr size_t WS_SGUOUT_T = 44 * MiB;
constexpr size_t WS_WUP_T = 64 * MiB;
constexpr size_t WS_WDN_T = 576 * MiB;
constexpr size_t WS_X1 = 832 * MiB;
constexpr size_t WS_X2 = 960 * MiB;
constexpr size_t WS_H = 1088 * MiB;
constexpr size_t WS_BIG = 1152 * MiB;
constexpr size_t WS_OF = 1344 * MiB;
constexpr size_t WS_OB = 1408 * MiB;
constexpr size_t WS_A2 = 1472 * MiB;
constexpr size_t WS_Y = 1536 * MiB;
constexpr size_t WS_ACT = 1664 * MiB;
constexpr size_t WS_YS = 1936 * MiB;
constexpr size_t WS_QE = 2208 * MiB;
constexpr size_t WS_KET = 2272 * MiB;
constexpr size_t WS_P = 2336 * MiB;
constexpr size_t WS_VT = 2368 * MiB;
constexpr size_t WS_EL = 2432 * MiB;
constexpr size_t WS_H8 = 2440 * MiB;
constexpr size_t WS_END = 2472 * MiB;
constexpr int R_TOPI = 0;
constexpr int R_TOPW = T * 4;
constexpr int R_DEST = 2 * T * 4;
constexpr int R_BUFTOK = 3 * T * 4;
constexpr int R_HIST = R_BUFTOK + CAP;
constexpr int R_TILEE = R_HIST + 1024 * 32;
constexpr int R_NTILES = R_TILEE + 1024;
static_assert((size_t)(R_NTILES + 64) * 4 <= 4 * MiB, "route tables");
constexpr int CW_BAR = 4096;
constexpr int MAX_LAUNCH = 64;

#define RLX_AGENT __ATOMIC_RELAXED, __HIP_MEMORY_SCOPE_AGENT
#define LDS_WAIT() asm volatile("s_waitcnt lgkmcnt(0)" ::: "memory")
#define VM_WAIT() asm volatile("s_waitcnt vmcnt(0)" ::: "memory")
typedef __bf16 bf16x2_t __attribute__((ext_vector_type(2)));
__device__ __forceinline__ unsigned cvt_pk_bf16(float lo, float hi) { const f32x2 v = {lo, hi}; const bf16x2_t r = __builtin_convertvector(v, bf16x2_t); return __builtin_bit_cast(unsigned, r); }
__device__ __forceinline__ float bf_lo(unsigned w) { return __uint_as_float(w << 16); }
__device__ __forceinline__ float bf_hi(unsigned w) { return __uint_as_float(w & 0xffff0000u); }
__device__ __forceinline__ float bf2f(bf16 b) { return __uint_as_float(((unsigned)b) << 16); }
__device__ __forceinline__ float shfl_xor_f(float v, int o, int lane) { return __builtin_bit_cast(float, __builtin_amdgcn_ds_bpermute((lane ^ o) << 2, __builtin_bit_cast(int, v))); }
__device__ __forceinline__ int shfl_i(int v, int src, int lane) { (void)lane; return __builtin_amdgcn_ds_bpermute(src << 2, v); }
__device__ __forceinline__ float wave_sum(float v, int lane) {
#pragma unroll
    for (int o = 1; o < 64; o <<= 1) v += shfl_xor_f(v, o, lane);
    return v;
}
__device__ __forceinline__ float silu_f(float x) { return x / (1.0f + __expf(-x)); }
__device__ __forceinline__ float sigmoid_f(float x) { return 1.0f / (1.0f + __expf(-x)); }
__device__ __forceinline__ float gelu_f(float v) {
    const float av = fabsf(v), t = __builtin_amdgcn_rcpf(av * 0.2316418882f + 1.0f);
    float q = t * 0.5307027145f + (-0.7265760135f); q = q * t + 0.7107068705f; q = q * t + (-0.142248368f); q = q * t + 0.127414796f; q = q * t;
    const float e = __builtin_amdgcn_exp2f((v * v) * (-0.72134752044f));
    const float m = v * (q * e);
    return v < 0.f ? m : v - m;
}

#define XB_TMO      128
#define XB_XCNT(j)  (256  + 64 * (j))
#define XB_XSUB(j)  (1280 + 64 * (j))
#define XB_XGEN(j)  (2304 + 64 * (j))
#define XB_TOP      3328
#define XB_TOPGEN   3392
#define XCD_BAR_WORDS 3456
#define XB_SPIN_CAP (1u << 18)
__device__ __forceinline__ unsigned xb_ld(unsigned* p)              { return __hip_atomic_load(p, __ATOMIC_RELAXED, __HIP_MEMORY_SCOPE_AGENT); }
__device__ __forceinline__ unsigned xb_add(unsigned* p, unsigned v) { return __hip_atomic_fetch_add(p, v, __ATOMIC_RELAXED, __HIP_MEMORY_SCOPE_AGENT); }
__device__ __forceinline__ unsigned xb_xcc_id() { return (unsigned)__builtin_amdgcn_s_getreg((3 << 11) | 20) & 0xFu; }
#define XB_SPIN(cond, bar) do { unsigned _sp = 0; while (cond) { __builtin_amdgcn_s_sleep(1); \
    if ((++_sp & 255u) == 0u) { if (xb_ld(&(bar)[XB_TMO])) break; if (_sp > XB_SPIN_CAP) { atomicAdd(&(bar)[XB_TMO], 1u); break; } } } } while (0)
struct XcdBarrier { unsigned* bar; unsigned x; volatile LAS unsigned* st; };
__device__ __forceinline__ XcdBarrier xcd_barrier_post(unsigned* bar, volatile LAS unsigned* st) {
    XcdBarrier b; b.bar = bar; b.x = xb_xcc_id(); b.st = st;
    if (threadIdx.x == 0) (void)xb_add(&bar[XB_XCNT(b.x)], 1u);
    return b;
}
__device__ __forceinline__ void xcd_barrier_complete(unsigned* bar, unsigned x, unsigned& nloc, unsigned& nx) {
    const unsigned G = gridDim.x * gridDim.y * gridDim.z;
    unsigned sum, cnt, mine, sp = 0u;
    for (;;) {
        sum = 0u; cnt = 0u; mine = 0u;
#pragma unroll
        for (unsigned j = 0; j < 16; ++j) { const unsigned c = xb_ld(&bar[XB_XCNT(j)]); sum += c; cnt += (c > 0u) ? 1u : 0u; mine = (j == x) ? c : mine; }
        if (sum == G) break;
        __builtin_amdgcn_s_sleep(1);
        if ((++sp & 255u) == 0u) { if (xb_ld(&bar[XB_TMO])) break; if (sp > XB_SPIN_CAP) { atomicAdd(&bar[XB_TMO], 1u); break; } }
    }
    nloc = mine > 0u ? mine : 1u; nx = cnt > 0u ? cnt : 1u;
}
__device__ __forceinline__ void xcd_barrier(const XcdBarrier& b) {
    asm volatile("s_waitcnt vmcnt(0)" ::: "memory");
    __syncthreads();
    if (threadIdx.x == 0) {
        unsigned* bar = b.bar;
        __builtin_amdgcn_s_waitcnt(0);
        unsigned nloc = b.st[0], nx = b.st[1];
        if (nloc == 0u) { xcd_barrier_complete(bar, b.x, nloc, nx); b.st[0] = nloc; b.st[1] = nx; }
        const unsigned old = xb_add(&bar[XB_XSUB(b.x)], 1u);
        const unsigned gen = old / nloc;
        if (old + 1u == (gen + 1u) * nloc) {
            __builtin_amdgcn_fence(__ATOMIC_RELEASE, "agent");
            asm volatile("s_waitcnt vmcnt(0)" ::: "memory");
            const unsigned og = xb_add(&bar[XB_TOP], 1u);
            const unsigned tg = og / nx;
            if (og + 1u == (tg + 1u) * nx) xb_add(&bar[XB_TOPGEN], 1u);
            else XB_SPIN(xb_ld(&bar[XB_TOPGEN]) == tg, bar);
            __builtin_amdgcn_fence(__ATOMIC_ACQUIRE, "agent");
            xb_add(&bar[XB_XGEN(b.x)], 1u);
            asm volatile("s_waitcnt vmcnt(0)" ::: "memory");
        } else {
            XB_SPIN(xb_ld(&bar[XB_XGEN(b.x)]) == gen, bar);
            __builtin_amdgcn_fence(__ATOMIC_ACQUIRE, "agent");
            asm volatile("s_waitcnt vmcnt(0)" ::: "memory");
        }
    }
    __syncthreads();
}

struct Args { const float* in[27]; float* out; unsigned char* ws; int ph_lo, ph_hi, li, pad; };
enum { I_X = 0, I_C, I_ADAW, I_ADAB, I_LNG, I_LNB, I_GWIN, I_GWG2F, I_GBGF, I_GWG2B, I_GBGB, I_GNORM, I_GWOUT, I_SWIN, I_SBIN, I_SLNG, I_SLNB, I_SWS, I_SBS, I_SWOUT, I_SBOUT, I_RW, I_RB, I_WUP, I_BUP, I_WDN, I_BDN };

typedef const __attribute__((address_space(4))) Args* KA;
#define PHASE_ENTER() unsigned m1_ = ~0u; asm volatile("" : "+s"(m1_)); int tid = (wave_s << 6) | (int)__builtin_amdgcn_mbcnt_hi(m1_, __builtin_amdgcn_mbcnt_lo(m1_, 0u)); asm volatile("" : "+v"(tid)); int bx = blockIdx.x, G = gridDim.x; asm volatile("" : "+s"(bx), "+s"(G)); \
    KA a = (KA)__builtin_amdgcn_kernarg_segment_ptr(); asm volatile("" : "+s"(a)); unsigned char* ws = a->ws; \
    extern __shared__ __attribute__((aligned(16))) unsigned char lds_raw[]; LAS unsigned char* lds = (LAS unsigned char*)lds_raw; (void)lds; (void)ws; (void)bx; (void)G; (void)tid
__device__ __forceinline__ int swiglu_perm(int o) {
    const int a = o >> 1, h = o & 1, pn = a >> 7, r = a & 127, bj = r >> 6, r2 = r & 63, wc = r2 >> 4, r3 = r2 & 15;
    return 256 * pn + 128 * bj + 32 * wc + 16 * h + r3;
}
__device__ __forceinline__ void conv_tile(const float* W, int K, int N, int k0, int n0, int nw, bf16* dst, int mode, LAS float* scr, int lane) {
    const int c4 = lane & 15, kr = lane >> 4;
    if (4 * c4 < nw) {
#pragma unroll 4
        for (int i = 0; i < 16; ++i) { const int kk = 4 * i + kr; const f32x4 v = *(const f32x4*)(W + (size_t)(k0 + kk) * N + n0 + 4 * c4);
            LAS float* s = scr + kk * 65 + 4 * c4; s[0] = v[0]; s[1] = v[1]; s[2] = v[2]; s[3] = v[3]; }
    }
    LDS_WAIT(); asm volatile("" ::: "memory");
    const int kc = lane & 7, ns = lane >> 3;
    for (int j = 0; j < nw / 8; ++j) {
        const int n = ns + 8 * j; const LAS float* s = scr + (8 * kc) * 65 + n;
        float v[8];
#pragma unroll
        for (int q = 0; q < 8; ++q) v[q] = s[q * 65];
        u32x4 o; o.x = cvt_pk_bf16(v[0], v[1]); o.y = cvt_pk_bf16(v[2], v[3]); o.z = cvt_pk_bf16(v[4], v[5]); o.w = cvt_pk_bf16(v[6], v[7]);
        const int ng = n0 + n;
        if (mode >= 3) {
            const int row = (mode == 4) ? swiglu_perm(ng) : ng;
            int w0 = __builtin_amdgcn_cvt_pk_fp8_f32(v[0] * F8_WSCALE, v[1] * F8_WSCALE, 0, false); w0 = __builtin_amdgcn_cvt_pk_fp8_f32(v[2] * F8_WSCALE, v[3] * F8_WSCALE, w0, true);
            int w1 = __builtin_amdgcn_cvt_pk_fp8_f32(v[4] * F8_WSCALE, v[5] * F8_WSCALE, 0, false); w1 = __builtin_amdgcn_cvt_pk_fp8_f32(v[6] * F8_WSCALE, v[7] * F8_WSCALE, w1, true);
            *(u32x2*)((unsigned char*)dst + (size_t)row * K + k0 + 8 * kc) = (u32x2){(unsigned)w0, (unsigned)w1};
        } else if (mode == 2) {
            *(u32x4*)(dst + (size_t)n * K + k0 + 8 * kc) = o;
            u32x4 l; l.x = cvt_pk_bf16(v[0] - bf_lo(o.x), v[1] - bf_hi(o.x)); l.y = cvt_pk_bf16(v[2] - bf_lo(o.y), v[3] - bf_hi(o.y));
            l.z = cvt_pk_bf16(v[4] - bf_lo(o.z), v[5] - bf_hi(o.z)); l.w = cvt_pk_bf16(v[6] - bf_lo(o.w), v[7] - bf_hi(o.w));
            *(u32x4*)(dst + (size_t)(32 + n) * K + k0 + 8 * kc) = l;
        } else {
            const int row = (mode == 1) ? swiglu_perm(ng) : ng;
            *(u32x4*)(dst + (size_t)row * K + k0 + 8 * kc) = o;
        }
    }
    LDS_WAIT(); asm volatile("" ::: "memory");
}

__device__ __forceinline__ void phase_prologue(KA a, LAS unsigned char* lds, int tid, int bx, int G) {
    const int lane = tid & 63, wave = __builtin_amdgcn_readfirstlane(tid >> 6);
    unsigned char* ws = a->ws;
    for (int slab = bx; slab < 192; slab += G) {
        LAS float* sc = (LAS float*)lds;
        LAS float* red = (LAS float*)(lds + 32768);
        for (int i = tid; i < 8 * 1024; i += NTHREADS) sc[i] = silu_f(a->in[I_C][i]);
        __syncthreads();
        const int g0 = slab * 128, l = g0 / 6144, e0 = g0 % 6144;
        const int c4 = tid & 31, seg = tid >> 5;
        f32x4 acc[8];
#pragma unroll
        for (int b = 0; b < 8; ++b) acc[b] = (f32x4){0.f, 0.f, 0.f, 0.f};
        const float* wp = a->in[I_ADAW] + ((size_t)l * 1024 + seg * 64) * 6144 + e0 + 4 * c4;
#pragma unroll 8
        for (int d = 0; d < 64; ++d) { const f32x4 w = *(const f32x4*)(wp + (size_t)d * 6144);
#pragma unroll
            for (int b = 0; b < 8; ++b) acc[b] += w * sc[b * 1024 + seg * 64 + d]; }
#pragma unroll
        for (int b = 0; b < 8; ++b) *(LAS f32x4*)(red + (seg * 8 + b) * 128 + 4 * c4) = acc[b];
        __syncthreads();
        for (int o = tid; o < 1024; o += NTHREADS) { const int b = o >> 7, c = o & 127; float s = a->in[I_ADAB][l * 6144 + e0 + c];
#pragma unroll
            for (int sg = 0; sg < 16; ++sg) s += red[(sg * 8 + b) * 128 + c];
            ((float*)(ws + WS_MOD))[((size_t)l * 8 + b) * 6144 + e0 + c] = s; }
        __syncthreads();
    }
    LAS float* scr = (LAS float*)(lds + wave * 16640);
    const int gw = bx * NWAVES + wave, NGW = G * NWAVES;
    constexpr int N_UP = 128 * 16 * 32, N_DN = 128 * 16 * 16, N_GIN = 2 * 16 * 48, N_GLR = 2 * 16, N_GOUT = 2 * 256, N_SIN = 2 * 16 * 32, N_SOUT = 2 * 256, N_RT = 4 * 16;
    constexpr int NITEMS = N_UP + N_DN + N_GIN + N_GLR + N_GOUT + N_SIN + N_SOUT + N_RT;
    for (int it = gw; it < NITEMS; it += NGW) {
        int r = it;
        if (r < N_UP) { const int m = r >> 9, q = r & 511, kt = q >> 5, nt = q & 31;
            conv_tile(a->in[I_WUP] + (size_t)m * 1024 * 2048, 1024, 2048, kt * 64, nt * 64, 64, (bf16*)(ws + WS_WUP_T + (size_t)m * 2048 * 1024 * (MOE_FP8 ? 1 : 2)), MOE_FP8 ? 4 : 1, scr, lane); continue; } r -= N_UP;
        if (r < N_DN) { const int m = r >> 8, q = r & 255, kt = q >> 4, nt = q & 15;
            conv_tile(a->in[I_WDN] + (size_t)m * 1024 * 1024, 1024, 1024, kt * 64, nt * 64, 64, (bf16*)(ws + WS_WDN_T + (size_t)m * 1024 * 1024 * (MOE_FP8 ? 1 : 2)), MOE_FP8 ? 3 : 0, scr, lane); continue; } r -= N_DN;
        if (r < N_GIN) { const int m = r / 768, q = r % 768, kt = q / 48, nt = q % 48;
            conv_tile(a->in[I_GWIN] + (size_t)m * 1024 * GLA_IN, 1024, GLA_IN, kt * 64, nt * 64, 64, (bf16*)(ws + WS_GLAIN_T) + (size_t)m * GLA_MAIN * 1024, 0, scr, lane); continue; } r -= N_GIN;
        if (r < N_GLR) { const int m = r >> 4, kt = r & 15;
            conv_tile(a->in[I_GWIN] + (size_t)m * 1024 * GLA_IN, 1024, GLA_IN, kt * 64, GLA_MAIN, 32, (bf16*)(ws + WS_GLALR_T) + (size_t)m * 64 * 1024, 2, scr, lane); continue; } r -= N_GLR;
        if (r < N_GOUT) { const int m = r >> 8, q = r & 255, kt = q >> 4, nt = q & 15;
            conv_tile(a->in[I_GWOUT] + (size_t)m * 1024 * 1024, 1024, 1024, kt * 64, nt * 64, 64, (bf16*)(ws + WS_GLAOUT_T) + (size_t)m * 1024 * 1024, 0, scr, lane); continue; } r -= N_GOUT;
        if (r < N_SIN) { const int m = r >> 9, q = r & 511, kt = q >> 5, nt = q & 31;
            conv_tile(a->in[I_SWIN] + (size_t)m * 1024 * 2048, 1024, 2048, kt * 64, nt * 64, 64, (bf16*)(ws + WS_SGUIN_T) + (size_t)m * 2048 * 1024, 0, scr, lane); continue; } r -= N_SIN;
        if (r < N_SOUT) { const int m = r >> 8, q = r & 255, kt = q >> 4, nt = q & 15;
            conv_tile(a->in[I_SWOUT] + (size_t)m * 1024 * 1024, 1024, 1024, kt * 64, nt * 64, 64, (bf16*)(ws + WS_SGUOUT_T) + (size_t)m * 1024 * 1024, 0, scr, lane); continue; } r -= N_SOUT;
        { const int m = r >> 4, kt = r & 15;
            conv_tile(a->in[I_RW] + (size_t)m * 1024 * 32, 1024, 32, kt * 64, 0, 32, (bf16*)(ws + WS_ROUTER_T) + (size_t)m * 64 * 1024, 2, scr, lane); }
    }
    { bf16* d = (bf16*)(ws + WS_SGUWS); const float* s = a->in[I_SWS];
      for (int i = (bx * NTHREADS + tid) * 4; i < 2 * 8 * 128 * 128; i += G * NTHREADS * 4) { const f32x4 v = *(const f32x4*)(s + i); u32x2 o; o.x = cvt_pk_bf16(v[0], v[1]); o.y = cvt_pk_bf16(v[2], v[3]); *(u32x2*)(d + i) = o; } }
}

struct RowPass {
    const float* xin; const bf16* y; float* xout; bf16* hout; unsigned char* h8out;
    const float* gate; const float* lng; const float* lnb; const float* sc; const float* sh;
    const bf16* wside;
    float* lr_out;
    const float* rbias;
    int* topi; float* topw; int* hist;
    const bf16* ys; const int* dest; const float* tw;
    int has_h, has_side;
};
template <int MODE>
__device__ __forceinline__ void row_pass(const RowPass& p, LAS unsigned char* lds, int tid, int bx, int G) {
    const int lane = tid & 63, wave = __builtin_amdgcn_readfirstlane(tid >> 6);
    constexpr int HS = 1032;
    LAS bf16* Hhi = (LAS bf16*)lds;
    LAS bf16* Hlo = (LAS bf16*)(lds + 16 * HS * 2);
    LAS float* part = (LAS float*)(lds + 2 * 16 * HS * 2);
    LAS float* logit = part + 8 * 32 * 16;
    LAS int* lhist = (LAS int*)(logit + 16 * 32);
    if (MODE == 1) { if (tid < 32) lhist[tid] = 0; }
    const bool side = (p.has_side != 0) && (p.wside != nullptr);
    bf16x8 whi[2][4], wlo[2][4];
    if (side) {
#pragma unroll
        for (int hf = 0; hf < 2; ++hf)
#pragma unroll
            for (int s = 0; s < 4; ++s) { const size_t off = (size_t)(hf * 16 + (lane & 15)) * 1024 + 128 * wave + 32 * s + 8 * (lane >> 4);
                whi[hf][s] = *(const bf16x8*)(p.wside + off); wlo[hf][s] = *(const bf16x8*)(p.wside + 32 * 1024 + off); }
    }
    for (int tile = bx; tile < T / 16; tile += G) {
        const int b = (tile * 16) / SEQ;
#pragma unroll 1
        for (int tt = 0; tt < 2; ++tt) {
            const int tl = 2 * wave + tt, token = tile * 16 + tl;
            f32x4 v[4];
            const float* xr = p.xin + (size_t)token * D + 4 * lane;
#pragma unroll
            for (int j = 0; j < 4; ++j) v[j] = *(const f32x4*)(xr + 256 * j);
            if (MODE == 1) {
                const bf16* yr = p.y + (size_t)token * D + 4 * lane; const float* gp = p.gate + (size_t)b * 6144 + 4 * lane;
#pragma unroll
                for (int j = 0; j < 4; ++j) { const u32x2 yq = *(const u32x2*)(yr + 256 * j); const f32x4 yy = (f32x4){bf_lo(yq.x), bf_hi(yq.x), bf_lo(yq.y), bf_hi(yq.y)}; const f32x4 g = *(const f32x4*)(gp + 256 * j); v[j] = v[j] * ALPHA + (g + 1.0f) * yy; }
            }
            if (MODE == 2) {
                f32x4 ya[4];
#pragma unroll
                for (int j = 0; j < 4; ++j) ya[j] = (f32x4){0.f, 0.f, 0.f, 0.f};
#pragma unroll
                for (int k = 0; k < 4; ++k) { const int ds = p.dest[token * 4 + k]; const float w = p.tw[token * 4 + k]; const bf16* yr = p.ys + (size_t)ds * D + 4 * lane;
#pragma unroll
                    for (int j = 0; j < 4; ++j) { const u32x2 q = *(const u32x2*)(yr + 256 * j); ya[j] += (f32x4){bf_lo(q.x), bf_hi(q.x), bf_lo(q.y), bf_hi(q.y)} * w; } }
                const float* gp = p.gate + (size_t)b * 6144 + 4 * lane;
#pragma unroll
                for (int j = 0; j < 4; ++j) { const f32x4 g = *(const f32x4*)(gp + 256 * j); v[j] = v[j] * ALPHA + (g + 1.0f) * ya[j]; }
            }
            if (MODE != 0) {
                float s = 0.f;
#pragma unroll
                for (int j = 0; j < 4; ++j) s += (v[j][0] + v[j][1]) + (v[j][2] + v[j][3]);
                const float mean = wave_sum(s, lane) * (1.0f / D); float s2 = 0.f;
#pragma unroll
                for (int j = 0; j < 4; ++j) { v[j] = v[j] - mean; s2 += (v[j][0] * v[j][0] + v[j][1] * v[j][1]) + (v[j][2] * v[j][2] + v[j][3] * v[j][3]); }
                const float rstd = 1.0f / sqrtf(wave_sum(s2, lane) * (1.0f / D) + LN_EPS);
                float* xo = p.xout + (size_t)token * D + 4 * lane;
#pragma unroll
                for (int j = 0; j < 4; ++j) { const f32x4 g = *(const f32x4*)(p.lng + 4 * lane + 256 * j), bb = *(const f32x4*)(p.lnb + 4 * lane + 256 * j); v[j] = v[j] * rstd * g + bb; *(f32x4*)(xo + 256 * j) = v[j]; }
            }
            if (p.has_h) {
                const float* scp = p.sc + (size_t)b * 6144 + 4 * lane; const float* shp = p.sh + (size_t)b * 6144 + 4 * lane;
                bf16* ho = p.hout + (size_t)token * D + 4 * lane;
#pragma unroll
                for (int j = 0; j < 4; ++j) { const f32x4 s1 = *(const f32x4*)(scp + 256 * j), s0 = *(const f32x4*)(shp + 256 * j); const f32x4 h = v[j] * (s1 + 1.0f) + s0;
                    u32x2 o; o.x = cvt_pk_bf16(h[0], h[1]); o.y = cvt_pk_bf16(h[2], h[3]); *(u32x2*)(ho + 256 * j) = o;
                    if (MODE == 1 && p.h8out) { int w8 = __builtin_amdgcn_cvt_pk_fp8_f32(h[0] * F8_HSCALE, h[1] * F8_HSCALE, 0, false); w8 = __builtin_amdgcn_cvt_pk_fp8_f32(h[2] * F8_HSCALE, h[3] * F8_HSCALE, w8, true); *(int*)(p.h8out + (size_t)token * D + 4 * lane + 256 * j) = w8; }
                    if (side) { u32x2 l; l.x = cvt_pk_bf16(h[0] - bf_lo(o.x), h[1] - bf_hi(o.x)); l.y = cvt_pk_bf16(h[2] - bf_lo(o.y), h[3] - bf_hi(o.y));
                        *(LAS u32x2*)(Hhi + tl * HS + 4 * lane + 256 * j) = o; *(LAS u32x2*)(Hlo + tl * HS + 4 * lane + 256 * j) = l; } }
            }
        }
        if (side) {
            __syncthreads();
            f32x4 acc[2]; acc[0] = (f32x4){0.f, 0.f, 0.f, 0.f}; acc[1] = acc[0];
#pragma unroll
            for (int s = 0; s < 4; ++s) { const int ko = (lane & 15) * HS + 128 * wave + 32 * s + 8 * (lane >> 4);
                const bf16x8 bh = *(const LAS bf16x8*)(Hhi + ko), bl = *(const LAS bf16x8*)(Hlo + ko);
#pragma unroll
                for (int hf = 0; hf < 2; ++hf) { acc[hf] = __builtin_amdgcn_mfma_f32_16x16x32_bf16(whi[hf][s], bh, acc[hf], 0, 0, 0);
                    acc[hf] = __builtin_amdgcn_mfma_f32_16x16x32_bf16(wlo[hf][s], bh, acc[hf], 0, 0, 0); acc[hf] = __builtin_amdgcn_mfma_f32_16x16x32_bf16(whi[hf][s], bl, acc[hf], 0, 0, 0); } }
#pragma unroll
            for (int hf = 0; hf < 2; ++hf)
#pragma unroll
                for (int j = 0; j < 4; ++j) part[(wave * 32 + hf * 16 + 4 * (lane >> 4) + j) * 16 + (lane & 15)] = acc[hf][j];
            __syncthreads();
            { const int e = tid >> 4, tk = tid & 15; float s = 0.f;
#pragma unroll
              for (int w = 0; w < 8; ++w) s += part[(w * 32 + e) * 16 + tk];
              if (MODE == 1) logit[tk * 32 + e] = s + p.rbias[e];
              else p.lr_out[(size_t)(tile * 16 + tk) * 32 + e] = s; }
            if (MODE == 1) {
                __syncthreads();
                if (tid < 16) {
                    const int token = tile * 16 + tid; float lv[32];
#pragma unroll
                    for (int e = 0; e < 32; ++e) lv[e] = logit[tid * 32 + e];
                    int bi[4]; float bv[4];
#pragma unroll
                    for (int k = 0; k < 4; ++k) { float m = -3.0e38f; int mi = 0;
#pragma unroll
                        for (int e = 0; e < 32; ++e) { const bool take = lv[e] > m; m = take ? lv[e] : m; mi = take ? e : mi; }
                        bi[k] = mi; bv[k] = m;
#pragma unroll
                        for (int e = 0; e < 32; ++e) lv[e] = (e == mi) ? -3.0e38f : lv[e]; }
                    const float e1 = __expf(bv[1] - bv[0]), e2 = __expf(bv[2] - bv[0]), e3 = __expf(bv[3] - bv[0]); const float inv = 1.0f / (1.0f + e1 + e2 + e3);
                    *(int4*)(p.topi + token * 4) = make_int4(bi[0], bi[1], bi[2], bi[3]);
                    *(f32x4*)(p.topw + token * 4) = (f32x4){inv, e1 * inv, e2 * inv, e3 * inv};
#pragma unroll
                    for (int k = 0; k < 4; ++k) atomicAdd((int*)&lhist[bi[k]], 1);
                }
            }
            __syncthreads();
        }
    }
    if (MODE == 1) { __syncthreads(); if (tid < 32) p.hist[tid] = lhist[tid]; }
}

__device__ __forceinline__ void phase_place(int* route, LAS unsigned char* lds, int tid, int bx, int G) {
    const int lane = tid & 63, wave = tid >> 6;
    LAS int* ptot = (LAS int*)lds;
    LAS int* ppre = ptot + 512;
    LAS int* tot = ppre + 512;
    LAS int* pre = tot + 32;
    LAS int* pstart = pre + 32;
    const int* hist = route + R_HIST;
    { const int e = tid & 31, part = tid >> 5; int st = 0, sp = 0;
      for (int bb = part; bb < G; bb += 16) { const int h = hist[bb * 32 + e]; st += h; if (bb < bx) sp += h; }
      ptot[part * 32 + e] = st; ppre[part * 32 + e] = sp; }
    __syncthreads();
    if (tid < 32) { int st = 0, sp = 0;
#pragma unroll
        for (int q = 0; q < 16; ++q) { st += ptot[q * 32 + tid]; sp += ppre[q * 32 + tid]; }
        tot[tid] = st; pre[tid] = sp; }
    __syncthreads();
    if (tid == 0) { int acc = 0; for (int e = 0; e < 32; ++e) { pstart[e] = acc; acc += (tot[e] + 255) / 256 * 256; } pstart[32] = acc; }
    __syncthreads();
    if (bx == 0) {
        const int ntiles = pstart[32] / 256;
        if (tid == 0) route[R_NTILES] = ntiles;
        for (int t = tid; t < ntiles; t += NTHREADS) { int e = 0; for (int q = 1; q < 32; ++q) if (pstart[q] <= t * 256) e = q; route[R_TILEE + t] = e; }
    }
    for (int e = bx; e < 32; e += G) { const int s0 = pstart[e] + tot[e], s1 = pstart[e + 1]; for (int s = s0 + tid; s < s1; s += NTHREADS) route[R_BUFTOK + s] = 0; }
    if (wave == 0) {
        int run = 0;
        for (int tile = bx; tile < T / 16; tile += G) {
            const int token = tile * 16 + (lane >> 2);
            const int e = route[R_TOPI + tile * 64 + lane];
            const int base = shfl_i(run, e, lane);
            int rank = 0, add = 0;
#pragma unroll 1
            for (int x = 0; x < 32; ++x) { const unsigned long long m = __ballot(e == x); if (e == x) rank = __popcll(m & ((1ull << lane) - 1ull)); if (lane == x) add = __popcll(m); }
            run += add;
            const int ds = pstart[e] + pre[e] + base + rank;
            route[R_DEST + tile * 64 + lane] = ds;
            route[R_BUFTOK + ds] = token;
        }
    }
}

struct Unit { int pm, pn, e; const char* bt; };
constexpr int NXCD = 8, WGM = 8;
struct Sched {
    int nM, nN, nwg, G, c; const char* Bt; size_t estride; const int* tile_e; int KB;
    __device__ __forceinline__ void init(int nM_, int nN_, int G_, int c_, const void* Bt_, size_t es, const int* te, int KB_) { nM = nM_; nN = nN_; nwg = nM * nN; G = G_; c = c_; Bt = (const char*)Bt_; estride = es; tile_e = te; KB = KB_; }
    __device__ __forceinline__ bool next(int i, Unit& u) const {
        const long L = (long)i * G + c; if (L >= nwg) return false;
        int wgid = (int)L; { const int q = nwg / NXCD, r = nwg % NXCD, xcd = wgid % NXCD, off = wgid / NXCD; wgid = (xcd < r ? xcd * (q + 1) : r * (q + 1) + (xcd - r) * q) + off; }
        const int nig = WGM * nN, gid = wgid / nig, fm = gid * WGM, gsz = (nM - fm) < WGM ? (nM - fm) : WGM;
        u.pm = fm + ((wgid % nig) % gsz); u.pn = (wgid % nig) / gsz;
        u.e = tile_e ? __builtin_amdgcn_readfirstlane(tile_e[u.pm]) : 0;
        u.bt = Bt + (size_t)u.e * estride + (size_t)u.pn * 256 * KB;
        return true;
    }
};
struct EpiGlaIn { bf16* O;
    __device__ __forceinline__ void operator()(const f32x4 (&acc)[2][2][4][2], const Unit& u, int wr, int wc, int fr, int fq) const {
        const int row0 = u.pm * 256 + wr * 64 + fr, col0 = u.pn * 256 + wc * 32 + 4 * fq; const float sc = (u.pn < 2) ? 0.08838834764831845f : 1.0f;
#pragma unroll
        for (int ai = 0; ai < 2; ++ai)
#pragma unroll
            for (int m = 0; m < 4; ++m) { bf16* rp = O + (size_t)(row0 + ai * 128 + m * 16) * GLA_MAIN + col0;
#pragma unroll
                for (int bj = 0; bj < 2; ++bj)
#pragma unroll
                    for (int n = 0; n < 2; ++n) { const f32x4 v = acc[ai][bj][m][n] * sc; u32x2 o; o.x = cvt_pk_bf16(v[0], v[1]); o.y = cvt_pk_bf16(v[2], v[3]); *(u32x2*)(rp + bj * 128 + n * 16) = o; } }
    }
};
struct EpiSguIn { bf16* O; const float* bias;
    __device__ __forceinline__ void operator()(const f32x4 (&acc)[2][2][4][2], const Unit& u, int wr, int wc, int fr, int fq) const {
        const int row0 = u.pm * 256 + wr * 64 + fr, col0 = u.pn * 256 + wc * 32 + 4 * fq;
        f32x4 bv[2][2];
#pragma unroll
        for (int bj = 0; bj < 2; ++bj)
#pragma unroll
            for (int n = 0; n < 2; ++n) bv[bj][n] = *(const f32x4*)(bias + col0 + bj * 128 + n * 16);
#pragma unroll
        for (int ai = 0; ai < 2; ++ai)
#pragma unroll
            for (int m = 0; m < 4; ++m) { bf16* rp = O + (size_t)(row0 + ai * 128 + m * 16) * 2048 + col0;
#pragma unroll
                for (int bj = 0; bj < 2; ++bj)
#pragma unroll
                    for (int n = 0; n < 2; ++n) { const f32x4 v = acc[ai][bj][m][n] + bv[bj][n]; u32x2 o; o.x = cvt_pk_bf16(gelu_f(v[0]), gelu_f(v[1])); o.y = cvt_pk_bf16(gelu_f(v[2]), gelu_f(v[3])); *(u32x2*)(rp + bj * 128 + n * 16) = o; } }
    }
};
struct EpiOut { bf16* O; const float* bias;
    __device__ __forceinline__ void operator()(const f32x4 (&acc)[2][2][4][2], const Unit& u, int wr, int wc, int fr, int fq) const {
        const int row0 = u.pm * 256 + wr * 64 + fr, col0 = u.pn * 256 + wc * 32 + 4 * fq;
        f32x4 bv[2][2];
#pragma unroll
        for (int bj = 0; bj < 2; ++bj)
#pragma unroll
            for (int n = 0; n < 2; ++n) bv[bj][n] = bias ? *(const f32x4*)(bias + col0 + bj * 128 + n * 16) : (f32x4){0.f, 0.f, 0.f, 0.f};
#pragma unroll
        for (int ai = 0; ai < 2; ++ai)
#pragma unroll
            for (int m = 0; m < 4; ++m) { bf16* rp = O + (size_t)(row0 + ai * 128 + m * 16) * D + col0;
#pragma unroll
                for (int bj = 0; bj < 2; ++bj)
#pragma unroll
                    for (int n = 0; n < 2; ++n) { const f32x4 v = acc[ai][bj][m][n] + bv[bj][n]; u32x2 o; o.x = cvt_pk_bf16(v[0], v[1]); o.y = cvt_pk_bf16(v[2], v[3]); *(u32x2*)(rp + bj * 128 + n * 16) = o; } }
    }
};
template <bool F8> struct EpiUp { unsigned char* O; const float* bias;
    __device__ __forceinline__ void operator()(const f32x4 (&acc)[2][2][4][2], const Unit& u, int wr, int wc, int fr, int fq) const {
        const int row0 = u.pm * 256 + wr * 64 + fr, a0 = u.pn * 128 + wc * 16 + 4 * fq;
        const float asc = F8 ? 1.0f / (F8_WSCALE * F8_HSCALE) : 1.0f;
        f32x4 bg[2], bl[2];
#pragma unroll
        for (int bj = 0; bj < 2; ++bj) { const float* bp = bias + (size_t)u.e * 2048 + 2 * (a0 + 64 * bj); const f32x4 p0 = *(const f32x4*)bp, p1 = *(const f32x4*)(bp + 4);
            bg[bj] = (f32x4){p0[0], p0[2], p1[0], p1[2]}; bl[bj] = (f32x4){p0[1], p0[3], p1[1], p1[3]}; }
#pragma unroll
        for (int ai = 0; ai < 2; ++ai)
#pragma unroll
            for (int m = 0; m < 4; ++m) { const size_t ro = (size_t)(row0 + ai * 128 + m * 16) * D + a0;
#pragma unroll
                for (int bj = 0; bj < 2; ++bj) { const f32x4 g = acc[ai][bj][m][0] * asc + bg[bj], l = acc[ai][bj][m][1] * asc + bl[bj]; float r[4];
#pragma unroll
                    for (int j = 0; j < 4; ++j) { const float gg = fminf(g[j], 7.0f), ll = fminf(fmaxf(l[j], -7.0f), 7.0f); r[j] = gg * sigmoid_f(1.702f * gg) * (ll + 1.0f); }
                    if constexpr (F8) { int w = __builtin_amdgcn_cvt_pk_fp8_f32(r[0] * F8_ASCALE, r[1] * F8_ASCALE, 0, false); w = __builtin_amdgcn_cvt_pk_fp8_f32(r[2] * F8_ASCALE, r[3] * F8_ASCALE, w, true);
                        *(int*)(O + ro + bj * 64) = w; }
                    else { u32x2 o; o.x = cvt_pk_bf16(r[0], r[1]); o.y = cvt_pk_bf16(r[2], r[3]); *(u32x2*)((bf16*)O + ro + bj * 64) = o; } } }
    }
};
struct EpiDown { bf16* O; const float* bias; float asc;
    __device__ __forceinline__ void operator()(const f32x4 (&acc)[2][2][4][2], const Unit& u, int wr, int wc, int fr, int fq) const {
        const int row0 = u.pm * 256 + wr * 64 + fr, col0 = u.pn * 256 + wc * 32 + 4 * fq;
        f32x4 bv[2][2];
#pragma unroll
        for (int bj = 0; bj < 2; ++bj)
#pragma unroll
            for (int n = 0; n < 2; ++n) bv[bj][n] = *(const f32x4*)(bias + (size_t)u.e * 1024 + col0 + bj * 128 + n * 16);
#pragma unroll
        for (int ai = 0; ai < 2; ++ai)
#pragma unroll
            for (int m = 0; m < 4; ++m) { bf16* rp = O + (size_t)(row0 + ai * 128 + m * 16) * D + col0;
#pragma unroll
                for (int bj = 0; bj < 2; ++bj)
#pragma unroll
                    for (int n = 0; n < 2; ++n) { const f32x4 v = acc[ai][bj][m][n] * asc + bv[bj][n]; u32x2 o; o.x = cvt_pk_bf16(v[0], v[1]); o.y = cvt_pk_bf16(v[2], v[3]); *(u32x2*)(rp + bj * 128 + n * 16) = o; } }
    }
};

constexpr int G8_BK = 64, G8_HALF = 128, G8_HTB = G8_HALF * G8_BK * 2, G8_STAGE_BYTES = 8 * G8_HTB;
__device__ __forceinline__ int g8_lds_byte(int r, int c) { const int st = (r >> 4) * 2 + (c >> 5), rr = r & 15, cc = c & 31, ob = rr * 64 + cc * 2; return st * 1024 + (ob ^ (((ob >> 9) & 1) << 5)); }
__device__ __forceinline__ void g8_stage_rc(int b, int& R, int& C) { const int st = b / 1024, sb = b % 1024, swz = sb ^ (((sb >> 9) & 1) << 5); R = (st >> 1) * 16 + swz / 64; C = (st & 1) * 32 + (swz % 64) / 2; }
__device__ __forceinline__ u32x4 g8_avoff(int pm, const int* gather, int tid, int KB) {
    int t2 = tid; asm volatile("" : "+v"(t2));
    int R, C; g8_stage_rc(t2 * 16, R, C);
    const int* gp = gather + pm * 256 + R;
    const unsigned r00 = gp[0], r01 = gp[64], r10 = gp[128], r11 = gp[192], c2 = (unsigned)(C * 2), k2 = (unsigned)KB;
    return (u32x4){r00 * k2 + c2, r01 * k2 + c2, r10 * k2 + c2, r11 * k2 + c2};
}
template <bool GATHER, bool FP8, class Epi>
__device__ __forceinline__ void gemm_fast(const void* A, const int* gather, const int K, const Sched& S, const Epi& E, LAS unsigned char* lds, int tid) {
    const int wid = __builtin_amdgcn_readfirstlane(tid >> 6), lane = tid & 63, wr = wid >> 2, wc = wid & 3, fr = lane & 15, fq = lane >> 4;
    const int KB = FP8 ? K : 2 * K, nt = KB / 128;
    unsigned voff; { int R, C; g8_stage_rc(tid * 16, R, C); voff = (unsigned)(R * KB + C * 2); }
    const size_t kstep = (size_t)128, hstep = (size_t)G8_HALF * KB, qstep = (size_t)64 * KB, tstep = 2 * hstep;
    const unsigned ldsw = (unsigned)wid * 1024u;
    const int aoff = g8_lds_byte(wr * 64 + fr, fq * (FP8 ? 16 : 8)), boff = g8_lds_byte(wc * 32 + fr, fq * (FP8 ? 16 : 8));
    constexpr int KSTR = FP8 ? 16 : 1024;
#define G8_SA(b, h) (((b) * 2 + (h)) * G8_HTB)
#define G8_SB(b, h) ((4 + (b) * 2 + (h)) * G8_HTB)
#define G8_GLDS(gp, ldsoff) __builtin_amdgcn_global_load_lds((const unsigned*)(gp), (LAS unsigned*)(lds + (ldsoff)), 16, 0, 0)
#define G8_STAGE_D(bufoff, gbase) do { G8_GLDS((const char*)(gbase) + voff, (bufoff) + ldsw); G8_GLDS((const char*)(gbase) + qstep + voff, (bufoff) + ldsw + 8192); } while (0)
#define G8_STAGE_A(bufoff, kb, h) do { if constexpr (GATHER) { G8_GLDS((kb) + va[(h) * 2], (bufoff) + ldsw); G8_GLDS((kb) + va[(h) * 2 + 1], (bufoff) + ldsw + 8192); } \
        else { G8_STAGE_D(bufoff, (kb) + (h) * hstep); } } while (0)
#define G8_LDA(dst, b, h) do { _Pragma("unroll") for (int m = 0; m < 4; ++m) _Pragma("unroll") for (int k = 0; k < 2; ++k) dst[m][k] = *(const LAS bf16x8*)(lds + G8_SA(b, h) + aoff + m * 2048 + k * KSTR); } while (0)
#define G8_LDB(dst, b, h) do { _Pragma("unroll") for (int n = 0; n < 2; ++n) _Pragma("unroll") for (int k = 0; k < 2; ++k) dst[n][k] = *(const LAS bf16x8*)(lds + G8_SB(b, h) + boff + n * 2048 + k * KSTR); } while (0)
#define G8_CAT(x) __builtin_shufflevector(__builtin_bit_cast(i32x4, (x)[0]), __builtin_bit_cast(i32x4, (x)[1]), 0, 1, 2, 3, 4, 5, 6, 7)
#define G8_MMA(ai, bj, At, Bt) do { __builtin_amdgcn_s_setprio(1); _Pragma("unroll") for (int m = 0; m < 4; ++m) _Pragma("unroll") for (int n = 0; n < 2; ++n) { \
        if constexpr (FP8) acc[ai][bj][m][n] = __builtin_amdgcn_mfma_scale_f32_16x16x128_f8f6f4(G8_CAT(Bt[n]), G8_CAT(At[m]), acc[ai][bj][m][n], 0, 0, 0, 0x7f7f7f7f, 0, 0x7f7f7f7f); \
        else { _Pragma("unroll") for (int k = 0; k < 2; ++k) acc[ai][bj][m][n] = __builtin_amdgcn_mfma_f32_16x16x32_bf16(Bt[n][k], At[m][k], acc[ai][bj][m][n], 0, 0, 0); } } \
        __builtin_amdgcn_s_setprio(0); } while (0)
#define G8_WAIT_V(n) asm volatile("s_waitcnt vmcnt(" #n ")" ::: "memory")
#define G8_WAIT_L(n) asm volatile("s_waitcnt lgkmcnt(" #n ")" ::: "memory")
#define G8_BAR __builtin_amdgcn_s_barrier()
#define G8_SCHED __builtin_amdgcn_sched_barrier(0)
    Unit cur, nxt; int ui = 0;
    if (!S.next(0, cur)) return;
    f32x4 acc[2][2][4][2];
#pragma unroll
    for (int a = 0; a < 2; ++a)
#pragma unroll
        for (int b = 0; b < 2; ++b)
#pragma unroll
            for (int m = 0; m < 4; ++m)
#pragma unroll
                for (int n = 0; n < 2; ++n) acc[a][b][m][n] = (f32x4){0.f, 0.f, 0.f, 0.f};
    bf16x8 At[4][2], B0[2][2], B1[2][2];
    u32x4 va = (u32x4){0u, 0u, 0u, 0u};
    if constexpr (GATHER) va = g8_avoff(cur.pm, gather, tid, KB);
    LAS u32x4* vslot = (LAS u32x4*)(lds + G8_STAGE_BYTES) + tid;
    const char* cB = (const char*)cur.bt; const char* cA = (const char*)A + (GATHER ? (size_t)0 : (size_t)cur.pm * tstep);
    G8_STAGE_D(G8_SB(0, 0), cB); G8_STAGE_D(G8_SB(0, 1), cB + hstep); G8_STAGE_A(G8_SA(0, 0), cA, 0); G8_STAGE_A(G8_SA(0, 1), cA, 1);
    if (wr == 1) G8_BAR;
    G8_WAIT_V(2); G8_BAR;
    G8_STAGE_D(G8_SB(1, 0), cB + kstep); G8_STAGE_A(G8_SA(1, 0), cA + kstep, 0); G8_STAGE_D(G8_SB(1, 1), cB + hstep + kstep);
    G8_WAIT_V(6); G8_BAR;
    for (;;) {
        const bool has_next = S.next(ui + 1, nxt);
        if constexpr (GATHER) { if (has_next) *vslot = g8_avoff(nxt.pm, gather, tid, KB); }
        const char* nB = has_next ? (const char*)nxt.bt : cB;
        const char* nA = (GATHER || !has_next) ? cA : (const char*)A + (size_t)nxt.pm * tstep;
#pragma unroll 1
        for (int t = 0; t < nt; t += 2) {
            const bool last = (t == nt - 2);
            const char* a1 = cA + (size_t)(t + 1) * kstep;
            const char* a2 = last ? nA : cA + (size_t)(t + 2) * kstep; const char* b2 = last ? nB : cB + (size_t)(t + 2) * kstep;
            const char* a3 = a2 + kstep; const char* b3 = b2 + kstep;
            G8_LDB(B0, 0, 0); G8_LDB(B1, 0, 1); G8_SCHED; G8_LDA(At, 0, 0); G8_STAGE_A(G8_SA(1, 1), a1, 1);
            if constexpr (GATHER) { if (last && has_next) va = *vslot; }
            G8_WAIT_V(8); G8_WAIT_L(0); G8_BAR; G8_MMA(0, 0, At, B0); G8_MMA(0, 1, At, B1); G8_BAR; G8_SCHED;
            G8_LDA(At, 0, 1); G8_STAGE_D(G8_SB(0, 0), b2); G8_STAGE_D(G8_SB(0, 1), b2 + hstep); G8_STAGE_A(G8_SA(0, 0), a2, 0);
            G8_WAIT_V(8); G8_WAIT_L(0); G8_BAR; G8_MMA(1, 0, At, B0); G8_MMA(1, 1, At, B1); G8_BAR; G8_SCHED;
            G8_LDB(B0, 1, 0); G8_LDB(B1, 1, 1); G8_SCHED; G8_LDA(At, 1, 0); G8_STAGE_A(G8_SA(0, 1), a2, 1);
            G8_WAIT_V(8); G8_WAIT_L(0); G8_BAR; G8_MMA(0, 0, At, B0); G8_MMA(0, 1, At, B1); G8_BAR; G8_SCHED;
            G8_LDA(At, 1, 1); G8_STAGE_D(G8_SB(1, 0), b3); G8_STAGE_D(G8_SB(1, 1), b3 + hstep); G8_STAGE_A(G8_SA(1, 0), a3, 0);
            G8_WAIT_V(8); G8_WAIT_L(0); G8_BAR; G8_MMA(1, 0, At, B0); G8_MMA(1, 1, At, B1); G8_BAR; G8_SCHED;
        }
        if (wr == 0) G8_BAR;
        { int t3 = tid; asm volatile("" : "+v"(t3)); const int l3 = t3 & 63; E(acc, cur, wr, wc, l3 & 15, l3 >> 4); }
        if (!has_next) break;
#pragma unroll
        for (int a = 0; a < 2; ++a)
#pragma unroll
            for (int b = 0; b < 2; ++b)
#pragma unroll
                for (int m = 0; m < 4; ++m)
#pragma unroll
                    for (int n = 0; n < 2; ++n) acc[a][b][m][n] = (f32x4){0.f, 0.f, 0.f, 0.f};
        cur = nxt; cB = nB; cA = nA; ++ui;
        if (wr == 1) G8_BAR;
    }
    G8_WAIT_V(0);
    G8_BAR;
#undef G8_SA
#undef G8_SB
#undef G8_GLDS
#undef G8_STAGE_D
#undef G8_STAGE_A
#undef G8_LDA
#undef G8_LDB
#undef G8_MMA
#undef G8_CAT
#undef G8_WAIT_V
#undef G8_WAIT_L
#undef G8_BAR
#undef G8_SCHED
}

__device__ __forceinline__ float logsigmoid_f(float x) { return fminf(x, 0.f) - log1pf(__expf(-fabsf(x))); }
__device__ __forceinline__ void phase_gla_prep(KA a, int li, LAS unsigned char* lds, int tid, int bx, int G) {
    const int lane = tid & 63, wave = __builtin_amdgcn_readfirstlane(tid >> 6), fr = lane & 15, fq = lane >> 4;
    unsigned char* ws = a->ws;
    const bf16* qkvr = (const bf16*)(ws + WS_BIG); const float* lr = (const float*)(ws + WS_LR);
    bf16* QE = (bf16*)(ws + WS_QE); bf16* KET = (bf16*)(ws + WS_KET); bf16* PP = (bf16*)(ws + WS_P); bf16* VT = (bf16*)(ws + WS_VT); float* EL = (float*)(ws + WS_EL);
    constexpr int LS = 136, VLS = 264;
    LAS bf16* qes = (LAS bf16*)lds;
    LAS bf16* kes = qes + 64 * LS;
    LAS float* lrs = (LAS float*)(kes + 64 * LS);
    LAS float* segtot = lrs + 1024;
    LAS bf16* vraw = (LAS bf16*)(segtot + 512);
    const int d = tid & 127, seg = tid >> 7;
    const int so = tid & 15, sr = tid >> 4;
    for (int it = bx; it < 4096; it += G) {
        const int chunk = it & 63, dir = (it >> 6) & 1, h = (it >> 7) & 3, b = it >> 9;
        const int row0 = b * SEQ + chunk * 64;
        const size_t cidx = (size_t)(((dir * 8 + b) * 4 + h) * 64 + chunk);
        const float* wg2 = a->in[dir ? I_GWG2B : I_GWG2F] + (size_t)li * 16 * 512 + h * 128 + d; const float bgd = a->in[dir ? I_GBGB : I_GBGF][(size_t)li * 512 + h * 128 + d];
#pragma unroll
        for (int k2 = 0; k2 < 2; ++k2) { const int p = sr + 32 * k2; const bf16* src = qkvr + (size_t)(row0 + p) * GLA_MAIN + h * 128 + 8 * so;
            const u32x4 qv = *(const u32x4*)src, kv = *(const u32x4*)(src + 512);
            *(LAS u32x4*)(qes + p * LS + 8 * so) = qv; *(LAS u32x4*)(kes + p * LS + 8 * so) = kv; }
        if (dir == 0) {
#pragma unroll
            for (int k4 = 0; k4 < 4; ++k4) { const int idx = tid + 512 * k4, p = idx >> 5, oc = idx & 31;
                *(LAS u32x4*)(vraw + p * VLS + 8 * oc) = *(const u32x4*)(qkvr + (size_t)(row0 + p) * GLA_MAIN + 1024 + h * 256 + 8 * oc); }
        }
        for (int i = tid; i < 1024; i += NTHREADS) lrs[i] = lr[(size_t)(row0 + (i >> 4)) * 32 + dir * 16 + (i & 15)];
        float wcol[16];
#pragma unroll
        for (int r = 0; r < 16; ++r) wcol[r] = wg2[r * 512];
        __syncthreads();
        float g[16];
#pragma unroll
        for (int s2 = 0; s2 < 16; ++s2) { const LAS float* lp = lrs + (seg * 16 + s2) * 16; float x = bgd;
#pragma unroll
            for (int r4 = 0; r4 < 4; ++r4) { const f32x4 l4 = *(const LAS f32x4*)(lp + 4 * r4); x += l4[0] * wcol[4 * r4] + l4[1] * wcol[4 * r4 + 1] + l4[2] * wcol[4 * r4 + 2] + l4[3] * wcol[4 * r4 + 3]; }
            g[s2] = (fminf(x, 0.f) - __logf(1.0f + __expf(-fabsf(x)))) * (1.0f / 16.0f); }
        if (dir == 0) {
#pragma unroll
            for (int s2 = 1; s2 < 16; ++s2) g[s2] += g[s2 - 1];
        } else {
#pragma unroll
            for (int s2 = 14; s2 >= 0; --s2) g[s2] += g[s2 + 1];
        }
        segtot[seg * 128 + d] = dir ? g[0] : g[15];
        __syncthreads();
        float pre = 0.f, total = 0.f;
#pragma unroll
        for (int sg = 0; sg < 4; ++sg) { const float t = segtot[sg * 128 + d]; total += t; if (dir ? (sg > seg) : (sg < seg)) pre += t; }
        if (seg == 0) EL[cidx * 128 + d] = __expf(total);
        unsigned kt[8];
#pragma unroll
        for (int s2 = 0; s2 < 16; s2 += 2) {
            unsigned kw[2];
#pragma unroll
            for (int u = 0; u < 2; ++u) { const int p = seg * 16 + s2 + u;
                const float q = bf2f(qes[p * LS + d]), k = bf2f(kes[p * LS + d]); const float bb = g[s2 + u] + pre;
                const float eb_ = __expf(bb); const unsigned qw = cvt_pk_bf16(q * eb_, 0.f) & 0xffffu; kw[u] = cvt_pk_bf16(k * __builtin_amdgcn_rcpf(eb_), 0.f) & 0xffffu;
                qes[p * LS + d] = (bf16)qw; kes[p * LS + d] = (bf16)kw[u]; }
            kt[s2 >> 1] = kw[0] | (kw[1] << 16);
        }
        { bf16* kp = KET + cidx * 8192 + (size_t)d * 64 + seg * 16; *(u32x4*)kp = (u32x4){kt[0], kt[1], kt[2], kt[3]}; *(u32x4*)(kp + 8) = (u32x4){kt[4], kt[5], kt[6], kt[7]}; }
        __syncthreads();
#pragma unroll
        for (int k2 = 0; k2 < 2; ++k2) { const int p = sr + 32 * k2; *(u32x4*)(QE + ((size_t)dir * T + row0 + p) * 512 + h * 128 + 8 * so) = *(const LAS u32x4*)(qes + p * LS + 8 * so); }
        { const int jt = wave & 3;
#pragma unroll
          for (int ii = 0; ii < 2; ++ii) { const int itile = 2 * (wave >> 2) + ii;
            f32x4 acc = (f32x4){0.f, 0.f, 0.f, 0.f};
            const bool dead = dir ? (jt < itile) : (jt > itile);
            if (!dead) {
#pragma unroll
                for (int ks = 0; ks < 4; ++ks) { const bf16x8 kf = *(const LAS bf16x8*)(kes + (jt * 16 + fr) * LS + ks * 32 + 8 * fq), qf = *(const LAS bf16x8*)(qes + (itile * 16 + fr) * LS + ks * 32 + 8 * fq);
                    acc = __builtin_amdgcn_mfma_f32_16x16x32_bf16(kf, qf, acc, 0, 0, 0); }
            }
            const int i = itile * 16 + fr, j0 = jt * 16 + 4 * fq; float pv[4];
#pragma unroll
            for (int jj = 0; jj < 4; ++jj) { const int j = j0 + jj; const bool keep = dir ? (j >= i) : (j <= i); pv[jj] = keep ? acc[jj] : 0.f; }
            u32x2 o; o.x = cvt_pk_bf16(pv[0], pv[1]); o.y = cvt_pk_bf16(pv[2], pv[3]);
            *(u32x2*)(PP + cidx * 4096 + (size_t)i * 64 + j0) = o; } }
        if (dir == 0) {
            const int e = tid & 255, jh = tid >> 8; unsigned w[16];
#pragma unroll
            for (int jj = 0; jj < 32; jj += 2) w[jj >> 1] = (unsigned)vraw[(jh * 32 + jj) * VLS + e] | ((unsigned)vraw[(jh * 32 + jj + 1) * VLS + e] << 16);
            bf16* vp = VT + ((size_t)((b * 4 + h) * 64 + chunk) * 256 + e) * 64 + jh * 32;
#pragma unroll
            for (int q4 = 0; q4 < 4; ++q4) *(u32x4*)(vp + 8 * q4) = (u32x4){w[4 * q4], w[4 * q4 + 1], w[4 * q4 + 2], w[4 * q4 + 3]};
        }
        __syncthreads();
    }
}
struct GlaFrags { bf16x8 qf[4], pf[2], vf[2][2], kf[2][2]; };
__device__ __forceinline__ void phase_gla_scan(KA a, LAS unsigned char* lds, int tid, int bx, int G) {
    const int lane = tid & 63, wave = __builtin_amdgcn_readfirstlane(tid >> 6), fr = lane & 15, fq = lane >> 4;
    unsigned char* ws = a->ws;
    const bf16* QE = (const bf16*)(ws + WS_QE); const bf16* KET = (const bf16*)(ws + WS_KET); const bf16* PP = (const bf16*)(ws + WS_P); const bf16* VT = (const bf16*)(ws + WS_VT); const float* EL = (const float*)(ws + WS_EL);
    constexpr int SS = 136;
    LAS bf16* ST = (LAS bf16*)lds;
    const int et0 = 2 * (wave & 1), dt0 = 2 * (wave >> 1), itile = wave >> 1;
    for (int it0 = bx; it0 < 256; it0 += G) {
        const int it = (G == 256) ? ((it0 & 7) * 32 + (it0 >> 3)) : it0;
        const int b = it >> 5, h = (it >> 3) & 3, dir = (it >> 2) & 1, es = it & 3;
        bf16* OO = (bf16*)(ws + (dir ? WS_OB : WS_OF));
        __syncthreads();
        for (int i = tid; i < 64 * SS / 2; i += NTHREADS) ((LAS unsigned*)ST)[i] = 0u;
        __syncthreads();
        f32x4 accS[2][2];
#pragma unroll
        for (int x = 0; x < 2; ++x)
#pragma unroll
            for (int y = 0; y < 2; ++y) accS[x][y] = (f32x4){0.f, 0.f, 0.f, 0.f};
        const size_t cbase = (size_t)((dir * 8 + b) * 4 + h) * 64;
        const char* qb = (const char*)(QE + ((size_t)dir * T + (size_t)b * SEQ + itile * 16) * 512 + h * 128);
        const char* pb = (const char*)(PP + cbase * 4096 + (size_t)(itile * 16) * 64);
        const char* vb = (const char*)(VT + ((size_t)(b * 4 + h) * 64 * 256 + es * 64 + et0 * 16) * 64);
        const char* kb = (const char*)(KET + cbase * 8192 + (size_t)(dt0 * 16) * 64);
        const char* eb = (const char*)(EL + cbase * 128 + dt0 * 16);
        char* ob = (char*)(OO + ((size_t)b * SEQ + itile * 16) * D + h * 256 + es * 64 + et0 * 16);
        const unsigned lq = (unsigned)(fr * 512 + 8 * fq) * 2u, l64 = (unsigned)(fr * 64 + 8 * fq) * 2u, le = (unsigned)fq * 16u, lo = (unsigned)(fr * D + 4 * fq) * 2u;
#define GLA_LOAD(F, c_) do { const int c__ = (c_); \
            _Pragma("unroll") for (int ks = 0; ks < 4; ++ks) F.qf[ks] = *(const bf16x8*)(qb + (size_t)c__ * (64 * 512 * 2) + ks * 64 + lq); \
            _Pragma("unroll") for (int ks = 0; ks < 2; ++ks) F.pf[ks] = *(const bf16x8*)(pb + (size_t)c__ * 8192 + ks * 64 + l64); \
            _Pragma("unroll") for (int et = 0; et < 2; ++et) _Pragma("unroll") for (int ks = 0; ks < 2; ++ks) F.vf[et][ks] = *(const bf16x8*)(vb + (size_t)c__ * 32768 + et * 2048 + ks * 64 + l64); \
            _Pragma("unroll") for (int dt = 0; dt < 2; ++dt) _Pragma("unroll") for (int ks = 0; ks < 2; ++ks) F.kf[dt][ks] = *(const bf16x8*)(kb + (size_t)c__ * 16384 + dt * 2048 + ks * 64 + l64); } while (0)
#define GLA_STEP(cc_, CUR, NXT) do { const int cc = (cc_); const int c = dir ? 63 - cc : cc; const int ccn = cc + 1 < 64 ? cc + 1 : 63; \
            GLA_LOAD(NXT, dir ? 63 - ccn : ccn); \
            const f32x4 el0 = *(const f32x4*)(eb + (size_t)c * 512 + le), el1 = *(const f32x4*)(eb + (size_t)c * 512 + 64 + le); \
            const LAS bf16* Sr = ST + (cc & 1) * 64 * SS; LAS bf16* Sw = ST + ((cc + 1) & 1) * 64 * SS; \
            _Pragma("unroll") for (int et = 0; et < 2; ++et) { f32x4 ao = (f32x4){0.f, 0.f, 0.f, 0.f}; \
                _Pragma("unroll") for (int ks = 0; ks < 4; ++ks) { const bf16x8 sf = *(const LAS bf16x8*)(Sr + ((et0 + et) * 16 + fr) * SS + ks * 32 + 8 * fq); ao = __builtin_amdgcn_mfma_f32_16x16x32_bf16(sf, CUR.qf[ks], ao, 0, 0, 0); } \
                _Pragma("unroll") for (int ks = 0; ks < 2; ++ks) ao = __builtin_amdgcn_mfma_f32_16x16x32_bf16(CUR.vf[et][ks], CUR.pf[ks], ao, 0, 0, 0); \
                u32x2 o; o.x = cvt_pk_bf16(ao[0], ao[1]); o.y = cvt_pk_bf16(ao[2], ao[3]); \
                *(u32x2*)(ob + (size_t)c * (64 * D * 2) + et * 32 + lo) = o; } \
            _Pragma("unroll") for (int dt = 0; dt < 2; ++dt) _Pragma("unroll") for (int et = 0; et < 2; ++et) { \
                _Pragma("unroll") for (int ks = 0; ks < 2; ++ks) accS[dt][et] = __builtin_amdgcn_mfma_f32_16x16x32_bf16(CUR.kf[dt][ks], CUR.vf[et][ks], accS[dt][et], 0, 0, 0); \
                accS[dt][et] = accS[dt][et] * (dt ? el1 : el0); \
                u32x2 o; o.x = cvt_pk_bf16(accS[dt][et][0], accS[dt][et][1]); o.y = cvt_pk_bf16(accS[dt][et][2], accS[dt][et][3]); \
                *(LAS u32x2*)(Sw + ((et0 + et) * 16 + fr) * SS + (dt0 + dt) * 16 + 4 * fq) = o; } \
            __syncthreads(); } while (0)
        GlaFrags FA, FB;
        GLA_LOAD(FA, dir ? 63 : 0);
#pragma unroll 1
        for (int c2 = 0; c2 < 64; c2 += 2) { GLA_STEP(c2, FA, FB); GLA_STEP(c2 + 1, FB, FA); }
#undef GLA_LOAD
#undef GLA_STEP
    }
}

__device__ __forceinline__ void phase_gla_post(KA a, int li, int tid, int bx, int G) {
    const int lane = tid & 63, wave = tid >> 6;
    const bf16* of = (const bf16*)(a->ws + WS_OF); const bf16* ob = (const bf16*)(a->ws + WS_OB); const bf16* qkvr = (const bf16*)(a->ws + WS_BIG); bf16* A2 = (bf16*)(a->ws + WS_A2);
    const float* ng = a->in[I_GNORM] + (size_t)li * 256 + (lane & 15) * 16;
    float g[16];
#pragma unroll
    for (int j = 0; j < 16; ++j) g[j] = ng[j];
    for (int token = bx * NWAVES + wave; token < T; token += G * NWAVES) {
        const u32x4 f0 = *(const u32x4*)(of + (size_t)token * D + 16 * lane), f1 = *(const u32x4*)(of + (size_t)token * D + 16 * lane + 8);
        const u32x4 b0 = *(const u32x4*)(ob + (size_t)token * D + 16 * lane), b1 = *(const u32x4*)(ob + (size_t)token * D + 16 * lane + 8);
        const u32x4 r0 = *(const u32x4*)(qkvr + (size_t)token * GLA_MAIN + 2048 + 16 * lane), r1 = *(const u32x4*)(qkvr + (size_t)token * GLA_MAIN + 2048 + 16 * lane + 8);
        float o[16], r[16];
#pragma unroll
        for (int q = 0; q < 4; ++q) { o[2 * q] = bf_lo(f0[q]) + bf_lo(b0[q]); o[2 * q + 1] = bf_hi(f0[q]) + bf_hi(b0[q]); o[8 + 2 * q] = bf_lo(f1[q]) + bf_lo(b1[q]); o[8 + 2 * q + 1] = bf_hi(f1[q]) + bf_hi(b1[q]);
            r[2 * q] = bf_lo(r0[q]); r[2 * q + 1] = bf_hi(r0[q]); r[8 + 2 * q] = bf_lo(r1[q]); r[8 + 2 * q + 1] = bf_hi(r1[q]); }
        float ss = 0.f;
#pragma unroll
        for (int j = 0; j < 16; ++j) ss += o[j] * o[j];
        ss += shfl_xor_f(ss, 1, lane); ss += shfl_xor_f(ss, 2, lane); ss += shfl_xor_f(ss, 4, lane); ss += shfl_xor_f(ss, 8, lane);
        const float rstd = 1.0f / sqrtf(ss * (1.0f / 256.0f) + LN_EPS);
        unsigned w[8];
#pragma unroll
        for (int q = 0; q < 8; ++q) w[q] = cvt_pk_bf16(o[2 * q] * rstd * g[2 * q] * silu_f(r[2 * q]), o[2 * q + 1] * rstd * g[2 * q + 1] * silu_f(r[2 * q + 1]));
        *(u32x4*)(A2 + (size_t)token * D + 16 * lane) = (u32x4){w[0], w[1], w[2], w[3]}; *(u32x4*)(A2 + (size_t)token * D + 16 * lane + 8) = (u32x4){w[4], w[5], w[6], w[7]};
    }
}

__device__ __forceinline__ void phase_sgu_core(KA a, int li, LAS unsigned char* lds, int tid, int bx, int G) {
    const int lane = tid & 63, wave = __builtin_amdgcn_readfirstlane(tid >> 6), fr = lane & 15, fq = lane >> 4;
    unsigned char* ws = a->ws;
    const bf16* z = (const bf16*)(ws + WS_BIG); bf16* A2 = (bf16*)(ws + WS_A2);
    const float* lng = a->in[I_SLNG] + (size_t)li * 1024; const float* lnb = a->in[I_SLNB] + (size_t)li * 1024;
    const bf16* wsp = (const bf16*)(ws + WS_SGUWS) + (size_t)li * 8 * 128 * 128; const float* bs = a->in[I_SBS] + (size_t)li * 8 * 128;
    constexpr int VS = 132;
    LAS bf16* vn = (LAS bf16*)lds;
    LAS float* st_mean = (LAS float*)(lds + 2 * 128 * VS * 2); LAS float* st_rstd = st_mean + 128;
    const int co = tid & 15, qr = tid >> 4;
    for (int it = bx; it < T / 128; it += G) {
        const int row0 = it * 128;
        __syncthreads();
#pragma unroll 1
        for (int rr = 0; rr < 16; ++rr) { const int q = wave * 16 + rr; const bf16* vp = z + (size_t)(row0 + q) * 2048 + 1024 + 16 * lane;
            const u32x4 v0 = *(const u32x4*)vp, v1 = *(const u32x4*)(vp + 8); float x[16];
#pragma unroll
            for (int k = 0; k < 4; ++k) { x[2 * k] = bf_lo(v0[k]); x[2 * k + 1] = bf_hi(v0[k]); x[8 + 2 * k] = bf_lo(v1[k]); x[8 + 2 * k + 1] = bf_hi(v1[k]); }
            float s1 = 0.f;
#pragma unroll
            for (int k = 0; k < 16; ++k) s1 += x[k];
            const float mean = wave_sum(s1, lane) * (1.0f / 1024.0f); float s2 = 0.f;
#pragma unroll
            for (int k = 0; k < 16; ++k) { const float dd = x[k] - mean; s2 += dd * dd; }
            const float rstd = 1.0f / sqrtf(wave_sum(s2, lane) * (1.0f / 1024.0f) + LN_EPS);
            if (lane == 0) { st_mean[q] = mean; st_rstd[q] = rstd; } }
        __syncthreads();
        const int p = wave * 16 + fr;
#pragma unroll 1
        for (int g = 0; g < 8; ++g) {
            LAS bf16* vb = vn + (g & 1) * 128 * VS;
            {
                const f32x4 g0 = *(const f32x4*)(lng + g * 128 + 8 * co), g1 = *(const f32x4*)(lng + g * 128 + 8 * co + 4), b0 = *(const f32x4*)(lnb + g * 128 + 8 * co), b1 = *(const f32x4*)(lnb + g * 128 + 8 * co + 4);
#pragma unroll
                for (int k = 0; k < 4; ++k) { const int q = qr + 32 * k; const u32x4 w = *(const u32x4*)(z + (size_t)(row0 + q) * 2048 + 1024 + g * 128 + 8 * co);
                    const float m = st_mean[q], r = st_rstd[q];
                    u32x2 o0, o1;
                    o0.x = cvt_pk_bf16((bf_lo(w.x) - m) * r * g0[0] + b0[0], (bf_hi(w.x) - m) * r * g0[1] + b0[1]); o0.y = cvt_pk_bf16((bf_lo(w.y) - m) * r * g0[2] + b0[2], (bf_hi(w.y) - m) * r * g0[3] + b0[3]);
                    o1.x = cvt_pk_bf16((bf_lo(w.z) - m) * r * g1[0] + b1[0], (bf_hi(w.z) - m) * r * g1[1] + b1[1]); o1.y = cvt_pk_bf16((bf_lo(w.w) - m) * r * g1[2] + b1[2], (bf_hi(w.w) - m) * r * g1[3] + b1[3]);
                    *(LAS u32x2*)(vb + q * VS + 8 * co) = o0; *(LAS u32x2*)(vb + q * VS + 8 * co + 4) = o1; }
            }
            bf16x8 wf[4];
#pragma unroll
            for (int ks = 0; ks < 4; ++ks) wf[ks] = *(const bf16x8*)(wsp + ((size_t)g * 128 + p) * 128 + ks * 32 + 8 * fq);
            const float bias = bs[g * 128 + p];
            __syncthreads();
#pragma unroll 2
            for (int ct = 0; ct < 8; ++ct) {
                f32x4 acc = (f32x4){0.f, 0.f, 0.f, 0.f};
#pragma unroll
                for (int ks = 0; ks < 4; ++ks) { const LAS bf16* sp = vb + (ks * 32 + 8 * fq) * VS + ct * 16 + fr; unsigned w4[4];
#pragma unroll
                    for (int j2 = 0; j2 < 4; ++j2) w4[j2] = (unsigned)sp[(2 * j2) * VS] | ((unsigned)sp[(2 * j2 + 1) * VS] << 16);
                    const bf16x8 vf = __builtin_bit_cast(bf16x8, (u32x4){w4[0], w4[1], w4[2], w4[3]});
                    acc = __builtin_amdgcn_mfma_f32_16x16x32_bf16(vf, wf[ks], acc, 0, 0, 0); }
                const int c0 = g * 128 + ct * 16 + 4 * fq;
                const u32x2 uu = *(const u32x2*)(z + (size_t)(row0 + p) * 2048 + c0);
                u32x2 o; o.x = cvt_pk_bf16(bf_lo(uu.x) * (acc[0] + bias), bf_hi(uu.x) * (acc[1] + bias)); o.y = cvt_pk_bf16(bf_lo(uu.y) * (acc[2] + bias), bf_hi(uu.y) * (acc[3] + bias));
                *(u32x2*)(A2 + (size_t)(row0 + p) * D + c0) = o;
            }
        }
    }
}

constexpr int PH_PER_LAYER = 10;
constexpr int NPHASES = 2 + PH_PER_LAYER * DEPTH;
#define GEMM_BODY(A, g, K, S, E) gemm_fast<false, false>(A, g, K, S, E, lds, tid)
#define GEMM_BODY_G(A, g, K, S, E) gemm_fast<true, false>(A, g, K, S, E, lds, tid)
#define GEMM_BODY8(A, g, K, S, E) gemm_fast<false, true>(A, g, K, S, E, lds, tid)
#define GEMM_BODY8_G(A, g, K, S, E) gemm_fast<true, true>(A, g, K, S, E, lds, tid)
__device__ __forceinline__ void ph_prologue(int wave_s) { PHASE_ENTER(); phase_prologue(a, lds, tid, bx, G); }
__device__ __forceinline__ void ph_rp_init(int wave_s) { PHASE_ENTER(); float* mod = (float*)(ws + WS_MOD);
    RowPass p{}; p.xin = a->in[I_X]; p.hout = (bf16*)(ws + WS_H); p.sc = mod + 1 * 1024; p.sh = mod + 0 * 1024; p.wside = (const bf16*)(ws + WS_GLALR_T); p.lr_out = (float*)(ws + WS_LR); p.has_h = 1; p.has_side = 1;
    row_pass<0>(p, lds, tid, bx, G); }
__device__ __forceinline__ void ph_gla_in(int wave_s, int li) { PHASE_ENTER(); Sched S; S.init(T / 256, GLA_MAIN / 256, G, bx, (const bf16*)(ws + WS_GLAIN_T) + (size_t)li * GLA_MAIN * 1024, 0, nullptr, 2048); EpiGlaIn E{(bf16*)(ws + WS_BIG)}; GEMM_BODY((const bf16*)(ws + WS_H), nullptr, 1024, S, E); }
__device__ __forceinline__ void ph_sgu_in(int wave_s, int li) { PHASE_ENTER(); Sched S; S.init(T / 256, 2048 / 256, G, bx, (const bf16*)(ws + WS_SGUIN_T) + (size_t)li * 2048 * 1024, 0, nullptr, 2048); EpiSguIn E{(bf16*)(ws + WS_BIG), a->in[I_SBIN] + (size_t)li * 2048}; GEMM_BODY((const bf16*)(ws + WS_H), nullptr, 1024, S, E); }
__device__ __forceinline__ void ph_gla_prep(int wave_s, int li) { PHASE_ENTER(); phase_gla_prep(a, li, lds, tid, bx, G); }
__device__ __forceinline__ void ph_gla_scan(int wave_s) { PHASE_ENTER(); phase_gla_scan(a, lds, tid, bx, G); }
__device__ __forceinline__ void ph_sgu_core(int wave_s, int li) { PHASE_ENTER(); phase_sgu_core(a, li, lds, tid, bx, G); }
__device__ __forceinline__ void ph_gla_post(int wave_s, int li) { PHASE_ENTER(); phase_gla_post(a, li, tid, bx, G); }
__device__ __forceinline__ void ph_out(int wave_s, int l) { PHASE_ENTER(); const int li = l >> 1; const bool sgu = (l & 1) != 0;
    Sched S; S.init(T / 256, 4, G, bx, (const bf16*)(ws + (sgu ? WS_SGUOUT_T : WS_GLAOUT_T)) + (size_t)li * 1024 * 1024, 0, nullptr, 2048);
    EpiOut E{(bf16*)(ws + WS_Y), sgu ? a->in[I_SBOUT] + (size_t)li * 1024 : nullptr}; GEMM_BODY((const bf16*)(ws + WS_A2), nullptr, 1024, S, E); }
__device__ __forceinline__ void ph_rp_mid(int wave_s, int l) { PHASE_ENTER(); float* modl = (float*)(ws + WS_MOD) + (size_t)l * 8 * 6144; int* route = (int*)(ws + WS_ROUTE);
    RowPass p{}; p.xin = (l == 0) ? a->in[I_X] : (const float*)(ws + WS_X2); p.y = (const bf16*)(ws + WS_Y); p.xout = (float*)(ws + WS_X1); p.hout = (bf16*)(ws + WS_H);
    p.gate = modl + 2 * 1024; p.lng = a->in[I_LNG] + (size_t)(l * 2 + 0) * 1024; p.lnb = a->in[I_LNB] + (size_t)(l * 2 + 0) * 1024; p.sc = modl + 4 * 1024; p.sh = modl + 3 * 1024;
    p.wside = (const bf16*)(ws + WS_ROUTER_T) + (size_t)l * 64 * 1024; p.rbias = a->in[I_RB] + (size_t)l * 32;
    p.topi = route + R_TOPI; p.topw = (float*)(route + R_TOPW); p.hist = route + R_HIST + bx * 32; p.has_h = 1; p.has_side = 1; p.h8out = MOE_FP8 ? (ws + WS_H8) : nullptr;
    row_pass<1>(p, lds, tid, bx, G); }
__device__ __forceinline__ void ph_place(int wave_s) { PHASE_ENTER(); phase_place((int*)(ws + WS_ROUTE), lds, tid, bx, G); }
__device__ __forceinline__ void ph_moe_up(int wave_s, int l) { PHASE_ENTER(); int* route = (int*)(ws + WS_ROUTE); const int ntiles = __builtin_amdgcn_readfirstlane(route[R_NTILES]);
#if MOE_FP8
    Sched S; S.init(ntiles, 8, G, bx, ws + WS_WUP_T + (size_t)l * 32 * 2048 * 1024, (size_t)2048 * 1024, route + R_TILEE, 1024);
    EpiUp<true> E{ws + WS_ACT, a->in[I_BUP] + (size_t)l * 32 * 2048}; GEMM_BODY8_G(ws + WS_H8, route + R_BUFTOK, 1024, S, E); }
#else
    Sched S; S.init(ntiles, 8, G, bx, ws + WS_WUP_T + (size_t)l * 32 * 2048 * 2048, (size_t)2048 * 2048, route + R_TILEE, 2048);
    EpiUp<false> E{ws + WS_ACT, a->in[I_BUP] + (size_t)l * 32 * 2048}; GEMM_BODY_G(ws + WS_H, route + R_BUFTOK, 1024, S, E); }
#endif
__device__ __forceinline__ void ph_moe_down(int wave_s, int l) { PHASE_ENTER(); int* route = (int*)(ws + WS_ROUTE); const int ntiles = __builtin_amdgcn_readfirstlane(route[R_NTILES]);
#if MOE_FP8
    Sched S; S.init(ntiles, 4, G, bx, ws + WS_WDN_T + (size_t)l * 32 * 1024 * 1024, (size_t)1024 * 1024, route + R_TILEE, 1024);
    EpiDown E{(bf16*)(ws + WS_YS), a->in[I_BDN] + (size_t)l * 32 * 1024, 1.0f / (F8_WSCALE * F8_ASCALE)}; GEMM_BODY8(ws + WS_ACT, nullptr, 1024, S, E); }
#else
    Sched S; S.init(ntiles, 4, G, bx, ws + WS_WDN_T + (size_t)l * 32 * 1024 * 2048, (size_t)1024 * 2048, route + R_TILEE, 2048);
    EpiDown E{(bf16*)(ws + WS_YS), a->in[I_BDN] + (size_t)l * 32 * 1024, 1.0f}; GEMM_BODY(ws + WS_ACT, nullptr, 1024, S, E); }
#endif
__device__ __forceinline__ void ph_rp_end(int wave_s, int l) { PHASE_ENTER(); float* mod = (float*)(ws + WS_MOD); float* modl = mod + (size_t)l * 8 * 6144; int* route = (int*)(ws + WS_ROUTE);
    RowPass p{}; p.xin = (const float*)(ws + WS_X1); p.xout = (l == DEPTH - 1) ? a->out : (float*)(ws + WS_X2); p.hout = (bf16*)(ws + WS_H);
    p.gate = modl + 5 * 1024; p.lng = a->in[I_LNG] + (size_t)(l * 2 + 1) * 1024; p.lnb = a->in[I_LNB] + (size_t)(l * 2 + 1) * 1024;
    p.ys = (const bf16*)(ws + WS_YS); p.dest = route + R_DEST; p.tw = (const float*)(route + R_TOPW);
    if (l < DEPTH - 1) { float* modn = mod + (size_t)(l + 1) * 8 * 6144; p.sc = modn + 1 * 1024; p.sh = modn + 0 * 1024; p.has_h = 1;
        if (((l + 1) & 1) == 0) { p.has_side = 1; p.wside = (const bf16*)(ws + WS_GLALR_T) + (size_t)((l + 1) >> 1) * 64 * 1024; p.lr_out = (float*)(ws + WS_LR); } }
    row_pass<2>(p, lds, tid, bx, G); }

__global__ void __launch_bounds__(NTHREADS, 2) fwd_kernel(Args a) {
    extern __shared__ __attribute__((aligned(16))) unsigned char lds_raw[];
    LAS unsigned char* lds = (LAS unsigned char*)lds_raw;
    volatile LAS unsigned* MISC = (volatile LAS unsigned*)(lds + MISC_OFF);
    const int tid = threadIdx.x; const int wave_s = __builtin_amdgcn_readfirstlane(tid >> 6);
    if (tid < 32) ((LAS unsigned*)(lds + MISC_OFF))[tid] = 0u;
    __syncthreads();
    unsigned* ctl = (unsigned*)(a.ws + WS_CTL);
    XcdBarrier bar = xcd_barrier_post(ctl + CW_BAR + a.li * XCD_BAR_WORDS, MISC + 8);
    const int lo = a.ph_lo, hi = a.ph_hi;
#ifndef REPK
#define REPK 0
#define REPN 1
#endif
#define REP(kind) for (int rep_ = 0; rep_ < ((REPK == (kind)) ? REPN : 1); ++rep_)
#define IN(k) (lo <= (k) && (k) < hi)
#define SEAM(k) do { if (IN(k) && IN((k) + 1)) xcd_barrier(bar); } while (0)
    if (IN(0)) { REP(3) ph_prologue(wave_s); SEAM(0); }
    if (IN(1)) { ph_rp_init(wave_s); SEAM(1); }
    for (int l = 0; l < DEPTH; ++l) {
        const int pb = 2 + PH_PER_LAYER * l, li = l >> 1; const bool sgu = (l & 1) != 0;
        if (IN(pb + 0)) { REP(10) { if (!sgu) ph_gla_in(wave_s, li); else ph_sgu_in(wave_s, li); } SEAM(pb + 0); }
        if (IN(pb + 1)) { if (!sgu) { REP(12) ph_gla_prep(wave_s, li); SEAM(pb + 1); } }
        if (IN(pb + 2)) { if (!sgu) { REP(1) ph_gla_scan(wave_s); } else { REP(2) ph_sgu_core(wave_s, li); } SEAM(pb + 2); }
        if (IN(pb + 3)) { if (!sgu) { REP(6) ph_gla_post(wave_s, li); SEAM(pb + 3); } }
        if (IN(pb + 4)) { REP(11) ph_out(wave_s, l); SEAM(pb + 4); }
        if (IN(pb + 5)) { REP(4) ph_rp_mid(wave_s, l); SEAM(pb + 5); }
        if (IN(pb + 6)) { REP(7) ph_place(wave_s); SEAM(pb + 6); }
        if (IN(pb + 7)) { REP(8) ph_moe_up(wave_s, l); SEAM(pb + 7); }
        if (IN(pb + 8)) { REP(9) ph_moe_down(wave_s, l); SEAM(pb + 8); }
        if (IN(pb + 9)) { REP(5) ph_rp_end(wave_s, l); SEAM(pb + 9); }
    }
#undef IN
#undef SEAM
}

#ifndef N_LAUNCH_MODE
#define N_LAUNCH_MODE 1
#endif
extern "C" void kernel_launch(void* const* d_in, const int* in_sizes, int n_in, void* d_out, int out_size, void* d_ws, size_t ws_size, hipStream_t stream) {
    static int grid = 0;
    if (grid == 0) {
        if (n_in != 27 || out_size != T * D || ws_size < WS_END) { fprintf(stderr, "kernel_launch: unexpected shapes (n_in %d out %d ws %zu)\n", n_in, out_size, ws_size); grid = -1; return; }
        int dev = 0, cus = 0, per_cu = 0;
        if (hipGetDevice(&dev) != hipSuccess || hipDeviceGetAttribute(&cus, hipDeviceAttributeMultiprocessorCount, dev) != hipSuccess) { grid = -1; return; }
        if (hipFuncSetAttribute((const void*)fwd_kernel, hipFuncAttributeMaxDynamicSharedMemorySize, LDS_BYTES) != hipSuccess) { fprintf(stderr, "kernel_launch: hipFuncSetAttribute failed\n"); grid = -1; return; }
        if (hipOccupancyMaxActiveBlocksPerMultiprocessor(&per_cu, (const void*)fwd_kernel, NTHREADS, LDS_BYTES) != hipSuccess || per_cu < 1) fprintf(stderr, "kernel_launch: occupancy query reports %d\n", per_cu);
        (void)hipGetLastError();
        grid = cus;
        if (grid > 1024) grid = 1024;
    }
    if (grid < 0) return;
    (void)hipMemsetAsync((char*)d_ws + WS_CTL, 0, CTL_ZERO_BYTES, stream);
    Args a{};
    for (int i = 0; i < 27; ++i) a.in[i] = (const float*)d_in[i];
    a.out = (float*)d_out; a.ws = (unsigned char*)d_ws; a.pad = 0;
#if N_LAUNCH_MODE == 1
    a.ph_lo = 0; a.ph_hi = NPHASES; a.li = 0;
    hipLaunchKernelGGL(fwd_kernel, dim3(grid), dim3(NTHREADS), LDS_BYTES, stream, a);
#else
    for (int ph = 0, li = 0; ph < NPHASES; ++ph) {
        if (ph >= 2 && (((ph - 2) % PH_PER_LAYER) == 1 || ((ph - 2) % PH_PER_LAYER) == 3) && (((ph - 2) / PH_PER_LAYER) & 1)) continue;
        a.ph_lo = ph; a.ph_hi = ph + 1; a.li = li++;
        hipLaunchKernelGGL(fwd_kernel, dim3(grid), dim3(NTHREADS), LDS_BYTES, stream, a);
    }
#endif
}
```

```cpp
#include <hip/hip_runtime.h>
#include <cstdio>
#include <cstdint>

#define LAS __attribute__((address_space(3)))
#define GAS __attribute__((address_space(1)))
typedef unsigned short bf16;
typedef short bf16x8 __attribute__((ext_vector_type(8)));
typedef float f32x4 __attribute__((ext_vector_type(4)));
typedef float f32x2 __attribute__((ext_vector_type(2)));
typedef unsigned u32x4 __attribute__((ext_vector_type(4)));
typedef unsigned u32x2 __attribute__((ext_vector_type(2)));
typedef int i32x4 __attribute__((ext_vector_type(4)));
typedef int i32x8 __attribute__((ext_vector_type(8)));

#ifndef MOE_FP8
#define MOE_FP8 1
#endif
constexpr int D = 1024, NB = 8, SEQ = 4096, T = NB * SEQ, DEPTH = 4;
constexpr int NE = 32, TOPK = 4, CAP = T * TOPK + NE * 256;
constexpr int MAXTILES = CAP / 256;
constexpr float ALPHA = 1.681792830507429f;
constexpr float LN_EPS = 1e-5f;
constexpr float F8_WSCALE = 64.0f, F8_HSCALE = 8.0f, F8_ASCALE = 4.0f;
constexpr int GLA_IN = 3104, GLA_MAIN = 3072;
constexpr int NWAVES = 8, NTHREADS = 512;
constexpr int LDS_BYTES = 147456, MISC_OFF = 139264;

constexpr size_t MiB = 1u << 20;
constexpr size_t WS_CTL = 0, CTL_ZERO_BYTES = 2 * MiB;
constexpr size_t WS_MOD = 2 * MiB;
constexpr size_t WS_ROUTE = 4 * MiB;
constexpr size_t WS_LR = 8 * MiB;
constexpr size_t WS_GLAIN_T = 16 * MiB;
constexpr size_t WS_GLALR_T = 28 * MiB;
constexpr size_t WS_ROUTER_T = 29 * MiB;
constexpr size_t WS_SGUWS = 30 * MiB;
constexpr size_t WS_GLAOUT_T = 32 * MiB;
constexpr size_t WS_SGUIN_T = 36 * MiB;
constexpr size_t WS_SGUOUT_T = 44 * MiB;
constexpr size_t WS_WUP_T = 64 * MiB;
constexpr size_t WS_WDN_T = 576 * MiB;
constexpr size_t WS_X1 = 832 * MiB;
constexpr size_t WS_X2 = 960 * MiB;
constexpr size_t WS_H = 1088 * MiB;
constexpr size_t WS_BIG = 1152 * MiB;
constexpr size_t WS_OF = 1344 * MiB;
constexpr size_t WS_OB = 1408 * MiB;
constexpr size_t WS_A2 = 1472 * MiB;
constexpr size_t WS_Y = 1536 * MiB;
constexpr size_t WS_ACT = 1664 * MiB;
constexpr size_t WS_YS = 1936 * MiB;
constexpr size_t WS_QE = 2208 * MiB;
constexpr size_t WS_KET = 2272 * MiB;
constexpr size_t WS_P = 2336 * MiB;
constexpr size_t WS_VT = 2368 * MiB;
constexpr size_t WS_EL = 2432 * MiB;
constexpr size_t WS_H8 = 2440 * MiB;
constexpr size_t WS_END = 2472 * MiB;
constexpr int R_TOPI = 0;
constexpr int R_TOPW = T * 4;
constexpr int R_DEST = 2 * T * 4;
constexpr int R_BUFTOK = 3 * T * 4;
constexpr int R_HIST = R_BUFTOK + CAP;
constexpr int R_TILEE = R_HIST + 1024 * 32;
constexpr int R_NTILES = R_TILEE + 1024;
static_assert((size_t)(R_NTILES + 64) * 4 <= 4 * MiB, "route tables");
constexpr int CW_BAR = 4096;
constexpr int MAX_LAUNCH = 64;

#define RLX_AGENT __ATOMIC_RELAXED, __HIP_MEMORY_SCOPE_AGENT
#define LDS_WAIT() asm volatile("s_waitcnt lgkmcnt(0)" ::: "memory")
#define VM_WAIT() asm volatile("s_waitcnt vmcnt(0)" ::: "memory")
typedef __bf16 bf16x2_t __attribute__((ext_vector_type(2)));
__device__ __forceinline__ unsigned cvt_pk_bf16(float lo, float hi) { const f32x2 v = {lo, hi}; const bf16x2_t r = __builtin_convertvector(v, bf16x2_t); return __builtin_bit_cast(unsigned, r); }
__device__ __forceinline__ float bf_lo(unsigned w) { return __uint_as_float(w << 16); }
__device__ __forceinline__ float bf_hi(unsigned w) { return __uint_as_float(w & 0xffff0000u); }
__device__ __forceinline__ float bf2f(bf16 b) { return __uint_as_float(((unsigned)b) << 16); }
__device__ __forceinline__ float shfl_xor_f(float v, int o, int lane) { return __builtin_bit_cast(float, __builtin_amdgcn_ds_bpermute((lane ^ o) << 2, __builtin_bit_cast(int, v))); }
__device__ __forceinline__ int shfl_i(int v, int src, int lane) { (void)lane; return __builtin_amdgcn_ds_bpermute(src << 2, v); }
__device__ __forceinline__ float wave_sum(float v, int lane) {
#pragma unroll
    for (int o = 1; o < 64; o <<= 1) v += shfl_xor_f(v, o, lane);
    return v;
}
__device__ __forceinline__ float silu_f(float x) { return x * __builtin_amdgcn_rcpf(1.0f + __expf(-x)); }
__device__ __forceinline__ float sigmoid_f(float x) { return __builtin_amdgcn_rcpf(1.0f + __expf(-x)); }
__device__ __forceinline__ float gelu_f(float v) {
    const float av = fabsf(v), t = __builtin_amdgcn_rcpf(av * 0.2316418882f + 1.0f);
    float q = t * 0.5307027145f + (-0.7265760135f); q = q * t + 0.7107068705f; q = q * t + (-0.142248368f); q = q * t + 0.127414796f; q = q * t;
    const float e = __builtin_amdgcn_exp2f((v * v) * (-0.72134752044f));
    const float m = v * (q * e);
    return v < 0.f ? m : v - m;
}

#define XB_TMO      128
#define XB_XCNT(j)  (256  + 64 * (j))
#define XB_XSUB(j)  (1280 + 64 * (j))
#define XB_XGEN(j)  (2304 + 64 * (j))
#define XB_TOP      3328
#define XB_TOPGEN   3392
#define XCD_BAR_WORDS 3456
#define XB_SPIN_CAP (1u << 18)
__device__ __forceinline__ unsigned xb_ld(unsigned* p)              { return __hip_atomic_load(p, __ATOMIC_RELAXED, __HIP_MEMORY_SCOPE_AGENT); }
__device__ __forceinline__ unsigned xb_add(unsigned* p, unsigned v) { return __hip_atomic_fetch_add(p, v, __ATOMIC_RELAXED, __HIP_MEMORY_SCOPE_AGENT); }
__device__ __forceinline__ unsigned xb_xcc_id() { return (unsigned)__builtin_amdgcn_s_getreg((3 << 11) | 20) & 0xFu; }
#define XB_SPIN(cond, bar) do { unsigned _sp = 0; while (cond) { __builtin_amdgcn_s_sleep(1); \
    if ((++_sp & 255u) == 0u) { if (xb_ld(&(bar)[XB_TMO])) break; if (_sp > XB_SPIN_CAP) { atomicAdd(&(bar)[XB_TMO], 1u); break; } } } } while (0)
struct XcdBarrier { unsigned* bar; unsigned x; volatile LAS unsigned* st; };
__device__ __forceinline__ XcdBarrier xcd_barrier_post(unsigned* bar, volatile LAS unsigned* st) {
    XcdBarrier b; b.bar = bar; b.x = xb_xcc_id(); b.st = st;
    if (threadIdx.x == 0) (void)xb_add(&bar[XB_XCNT(b.x)], 1u);
    return b;
}
__device__ __forceinline__ void xcd_barrier_complete(unsigned* bar, unsigned x, unsigned& nloc, unsigned& nx) {
    const unsigned G = gridDim.x * gridDim.y * gridDim.z;
    unsigned sum, cnt, mine, sp = 0u;
    for (;;) {
        sum = 0u; cnt = 0u; mine = 0u;
#pragma unroll
        for (unsigned j = 0; j < 16; ++j) { const unsigned c = xb_ld(&bar[XB_XCNT(j)]); sum += c; cnt += (c > 0u) ? 1u : 0u; mine = (j == x) ? c : mine; }
        if (sum == G) break;
        __builtin_amdgcn_s_sleep(1);
        if ((++sp & 255u) == 0u) { if (xb_ld(&bar[XB_TMO])) break; if (sp > XB_SPIN_CAP) { atomicAdd(&bar[XB_TMO], 1u); break; } }
    }
    nloc = mine > 0u ? mine : 1u; nx = cnt > 0u ? cnt : 1u;
}
__device__ __forceinline__ void xcd_barrier(const XcdBarrier& b) {
    asm volatile("s_waitcnt vmcnt(0)" ::: "memory");
    __syncthreads();
    if (threadIdx.x == 0) {
        unsigned* bar = b.bar;
        __builtin_amdgcn_s_waitcnt(0);
        unsigned nloc = b.st[0], nx = b.st[1];
        if (nloc == 0u) { xcd_barrier_complete(bar, b.x, nloc, nx); b.st[0] = nloc; b.st[1] = nx; }
        const unsigned old = xb_add(&bar[XB_XSUB(b.x)], 1u);
        const unsigned gen = old / nloc;
        if (old + 1u == (gen + 1u) * nloc) {
            __builtin_amdgcn_fence(__ATOMIC_RELEASE, "agent");
            asm volatile("s_waitcnt vmcnt(0)" ::: "memory");
            const unsigned og = xb_add(&bar[XB_TOP], 1u);
            const unsigned tg = og / nx;
            if (og + 1u == (tg + 1u) * nx) xb_add(&bar[XB_TOPGEN], 1u);
            else XB_SPIN(xb_ld(&bar[XB_TOPGEN]) == tg, bar);
            __builtin_amdgcn_fence(__ATOMIC_ACQUIRE, "agent");
            xb_add(&bar[XB_XGEN(b.x)], 1u);
            asm volatile("s_waitcnt vmcnt(0)" ::: "memory");
        } else {
            XB_SPIN(xb_ld(&bar[XB_XGEN(b.x)]) == gen, bar);
            __builtin_amdgcn_fence(__ATOMIC_ACQUIRE, "agent");
            asm volatile("s_waitcnt vmcnt(0)" ::: "memory");
        }
    }
    __syncthreads();
}

struct Args { const float* in[27]; float* out; unsigned char* ws; int ph_lo, ph_hi, li, pad; };
enum { I_X = 0, I_C, I_ADAW, I_ADAB, I_LNG, I_LNB, I_GWIN, I_GWG2F, I_GBGF, I_GWG2B, I_GBGB, I_GNORM, I_GWOUT, I_SWIN, I_SBIN, I_SLNG, I_SLNB, I_SWS, I_SBS, I_SWOUT, I_SBOUT, I_RW, I_RB, I_WUP, I_BUP, I_WDN, I_BDN };

typedef const __attribute__((address_space(4))) Args* KA;
#define PHASE_ENTER() unsigned m1_ = ~0u; asm volatile("" : "+s"(m1_)); int tid = (wave_s << 6) | (int)__builtin_amdgcn_mbcnt_hi(m1_, __builtin_amdgcn_mbcnt_lo(m1_, 0u)); asm volatile("" : "+v"(tid)); int bx = blockIdx.x, G = gridDim.x; asm volatile("" : "+s"(bx), "+s"(G)); \
    KA a = (KA)__builtin_amdgcn_kernarg_segment_ptr(); asm volatile("" : "+s"(a)); unsigned char* ws = a->ws; \
    extern __shared__ __attribute__((aligned(16))) unsigned char lds_raw[]; LAS unsigned char* lds = (LAS unsigned char*)lds_raw; (void)lds; (void)ws; (void)bx; (void)G; (void)tid
__device__ __forceinline__ int swiglu_perm(int o) {
    const int a = o >> 1, h = o & 1, pn = a >> 7, r = a & 127, bj = r >> 6, r2 = r & 63, wc = r2 >> 4, r3 = r2 & 15;
    return 256 * pn + 128 * bj + 32 * wc + 16 * h + r3;
}
__device__ __forceinline__ void conv_tile(const float* W, int K, int N, int k0, int n0, int nw, bf16* dst, int mode, LAS float* scr, int lane) {
    const int c4 = lane & 15, kr = lane >> 4;
    if (4 * c4 < nw) {
#pragma unroll 4
        for (int i = 0; i < 16; ++i) { const int kk = 4 * i + kr; const f32x4 v = *(const f32x4*)(W + (size_t)(k0 + kk) * N + n0 + 4 * c4);
            LAS float* s = scr + kk * 65 + 4 * c4; s[0] = v[0]; s[1] = v[1]; s[2] = v[2]; s[3] = v[3]; }
    }
    LDS_WAIT(); asm volatile("" ::: "memory");
    const int kc = lane & 7, ns = lane >> 3;
    for (int j = 0; j < nw / 8; ++j) {
        const int n = ns + 8 * j; const LAS float* s = scr + (8 * kc) * 65 + n;
        float v[8];
#pragma unroll
        for (int q = 0; q < 8; ++q) v[q] = s[q * 65];
        u32x4 o; o.x = cvt_pk_bf16(v[0], v[1]); o.y = cvt_pk_bf16(v[2], v[3]); o.z = cvt_pk_bf16(v[4], v[5]); o.w = cvt_pk_bf16(v[6], v[7]);
        const int ng = n0 + n;
        if (mode >= 3) {
            const int row = (mode == 4) ? swiglu_perm(ng) : ng;
            int w0 = __builtin_amdgcn_cvt_pk_fp8_f32(v[0] * F8_WSCALE, v[1] * F8_WSCALE, 0, false); w0 = __builtin_amdgcn_cvt_pk_fp8_f32(v[2] * F8_WSCALE, v[3] * F8_WSCALE, w0, true);
            int w1 = __builtin_amdgcn_cvt_pk_fp8_f32(v[4] * F8_WSCALE, v[5] * F8_WSCALE, 0, false); w1 = __builtin_amdgcn_cvt_pk_fp8_f32(v[6] * F8_WSCALE, v[7] * F8_WSCALE, w1, true);
            *(u32x2*)((unsigned char*)dst + (size_t)row * K + k0 + 8 * kc) = (u32x2){(unsigned)w0, (unsigned)w1};
        } else if (mode == 2) {
            *(u32x4*)(dst + (size_t)n * K + k0 + 8 * kc) = o;
            u32x4 l; l.x = cvt_pk_bf16(v[0] - bf_lo(o.x), v[1] - bf_hi(o.x)); l.y = cvt_pk_bf16(v[2] - bf_lo(o.y), v[3] - bf_hi(o.y));
            l.z = cvt_pk_bf16(v[4] - bf_lo(o.z), v[5] - bf_hi(o.z)); l.w = cvt_pk_bf16(v[6] - bf_lo(o.w), v[7] - bf_hi(o.w));
            *(u32x4*)(dst + (size_t)(32 + n) * K + k0 + 8 * kc) = l;
        } else {
            const int row = (mode == 1) ? swiglu_perm(ng) : ng;
            *(u32x4*)(dst + (size_t)row * K + k0 + 8 * kc) = o;
        }
    }
    LDS_WAIT(); asm volatile("" ::: "memory");
}

__device__ __forceinline__ void phase_prologue(KA a, LAS unsigned char* lds, int tid, int bx, int G) {
    const int lane = tid & 63, wave = __builtin_amdgcn_readfirstlane(tid >> 6);
    unsigned char* ws = a->ws;
    for (int slab = bx; slab < 192; slab += G) {
        LAS float* sc = (LAS float*)lds;
        LAS float* red = (LAS float*)(lds + 32768);
        for (int i = tid; i < 8 * 1024; i += NTHREADS) sc[i] = silu_f(a->in[I_C][i]);
        __syncthreads();
        const int g0 = slab * 128, l = g0 / 6144, e0 = g0 % 6144;
        const int c4 = tid & 31, seg = tid >> 5;
        f32x4 acc[8];
#pragma unroll
        for (int b = 0; b < 8; ++b) acc[b] = (f32x4){0.f, 0.f, 0.f, 0.f};
        const float* wp = a->in[I_ADAW] + ((size_t)l * 1024 + seg * 64) * 6144 + e0 + 4 * c4;
#pragma unroll 8
        for (int d = 0; d < 64; ++d) { const f32x4 w = *(const f32x4*)(wp + (size_t)d * 6144);
#pragma unroll
            for (int b = 0; b < 8; ++b) acc[b] += w * sc[b * 1024 + seg * 64 + d]; }
#pragma unroll
        for (int b = 0; b < 8; ++b) *(LAS f32x4*)(red + (seg * 8 + b) * 128 + 4 * c4) = acc[b];
        __syncthreads();
        for (int o = tid; o < 1024; o += NTHREADS) { const int b = o >> 7, c = o & 127; float s = a->in[I_ADAB][l * 6144 + e0 + c];
#pragma unroll
            for (int sg = 0; sg < 16; ++sg) s += red[(sg * 8 + b) * 128 + c];
            ((float*)(ws + WS_MOD))[((size_t)l * 8 + b) * 6144 + e0 + c] = s; }
        __syncthreads();
    }
    LAS float* scr = (LAS float*)(lds + wave * 16640);
    const int gw = bx * NWAVES + wave, NGW = G * NWAVES;
    constexpr int N_UP = 128 * 16 * 32, N_DN = 128 * 16 * 16, N_GIN = 2 * 16 * 48, N_GLR = 2 * 16, N_GOUT = 2 * 256, N_SIN = 2 * 16 * 32, N_SOUT = 2 * 256, N_RT = 4 * 16;
    constexpr int NITEMS = N_UP + N_DN + N_GIN + N_GLR + N_GOUT + N_SIN + N_SOUT + N_RT;
    for (int it = gw; it < NITEMS; it += NGW) {
        int r = it;
        if (r < N_UP) { const int m = r >> 9, q = r & 511, kt = q >> 5, nt = q & 31;
            conv_tile(a->in[I_WUP] + (size_t)m * 1024 * 2048, 1024, 2048, kt * 64, nt * 64, 64, (bf16*)(ws + WS_WUP_T + (size_t)m * 2048 * 1024 * (MOE_FP8 ? 1 : 2)), MOE_FP8 ? 4 : 1, scr, lane); continue; } r -= N_UP;
        if (r < N_DN) { const int m = r >> 8, q = r & 255, kt = q >> 4, nt = q & 15;
            conv_tile(a->in[I_WDN] + (size_t)m * 1024 * 1024, 1024, 1024, kt * 64, nt * 64, 64, (bf16*)(ws + WS_WDN_T + (size_t)m * 1024 * 1024 * (MOE_FP8 ? 1 : 2)), MOE_FP8 ? 3 : 0, scr, lane); continue; } r -= N_DN;
        if (r < N_GIN) { const int m = r / 768, q = r % 768, kt = q / 48, nt = q % 48;
            conv_tile(a->in[I_GWIN] + (size_t)m * 1024 * GLA_IN, 1024, GLA_IN, kt * 64, nt * 64, 64, (bf16*)(ws + WS_GLAIN_T) + (size_t)m * GLA_MAIN * 1024, 0, scr, lane); continue; } r -= N_GIN;
        if (r < N_GLR) { const int m = r >> 4, kt = r & 15;
            conv_tile(a->in[I_GWIN] + (size_t)m * 1024 * GLA_IN, 1024, GLA_IN, kt * 64, GLA_MAIN, 32, (bf16*)(ws + WS_GLALR_T) + (size_t)m * 64 * 1024, 2, scr, lane); continue; } r -= N_GLR;
        if (r < N_GOUT) { const int m = r >> 8, q = r & 255, kt = q >> 4, nt = q & 15;
            conv_tile(a->in[I_GWOUT] + (size_t)m * 1024 * 1024, 1024, 1024, kt * 64, nt * 64, 64, (bf16*)(ws + WS_GLAOUT_T) + (size_t)m * 1024 * 1024, 0, scr, lane); continue; } r -= N_GOUT;
        if (r < N_SIN) { const int m = r >> 9, q = r & 511, kt = q >> 5, nt = q & 31;
            conv_tile(a->in[I_SWIN] + (size_t)m * 1024 * 2048, 1024, 2048, kt * 64, nt * 64, 64, (bf16*)(ws + WS_SGUIN_T) + (size_t)m * 2048 * 1024, 0, scr, lane); continue; } r -= N_SIN;
        if (r < N_SOUT) { const int m = r >> 8, q = r & 255, kt = q >> 4, nt = q & 15;
            conv_tile(a->in[I_SWOUT] + (size_t)m * 1024 * 1024, 1024, 1024, kt * 64, nt * 64, 64, (bf16*)(ws + WS_SGUOUT_T) + (size_t)m * 1024 * 1024, 0, scr, lane); continue; } r -= N_SOUT;
        { const int m = r >> 4, kt = r & 15;
            conv_tile(a->in[I_RW] + (size_t)m * 1024 * 32, 1024, 32, kt * 64, 0, 32, (bf16*)(ws + WS_ROUTER_T) + (size_t)m * 64 * 1024, 2, scr, lane); }
    }
    { bf16* d = (bf16*)(ws + WS_SGUWS); const float* s = a->in[I_SWS];
      for (int i = (bx * NTHREADS + tid) * 4; i < 2 * 8 * 128 * 128; i += G * NTHREADS * 4) { const f32x4 v = *(const f32x4*)(s + i); u32x2 o; o.x = cvt_pk_bf16(v[0], v[1]); o.y = cvt_pk_bf16(v[2], v[3]); *(u32x2*)(d + i) = o; } }
}

struct RowPass {
    const float* xin; const bf16* y; float* xout; bf16* hout; unsigned char* h8out;
    const float* gate; const float* lng; const float* lnb; const float* sc; const float* sh;
    const bf16* wside;
    float* lr_out;
    const float* rbias;
    int* topi; float* topw; int* hist;
    const bf16* ys; const int* dest; const float* tw;
    int has_h, has_side;
};
template <int MODE>
__device__ __forceinline__ void row_pass(const RowPass& p, LAS unsigned char* lds, int tid, int bx, int G) {
    const int lane = tid & 63, wave = __builtin_amdgcn_readfirstlane(tid >> 6);
    constexpr int HS = 1032;
    LAS bf16* Hhi = (LAS bf16*)lds;
    LAS bf16* Hlo = (LAS bf16*)(lds + 16 * HS * 2);
    LAS float* part = (LAS float*)(lds + 2 * 16 * HS * 2);
    LAS float* logit = part + 8 * 32 * 16;
    LAS int* lhist = (LAS int*)(logit + 16 * 32);
    if (MODE == 1) { if (tid < 32) lhist[tid] = 0; }
    const bool side = (p.has_side != 0) && (p.wside != nullptr);
    bf16x8 whi[2][4], wlo[2][4];
    if (side) {
#pragma unroll
        for (int hf = 0; hf < 2; ++hf)
#pragma unroll
            for (int s = 0; s < 4; ++s) { const size_t off = (size_t)(hf * 16 + (lane & 15)) * 1024 + 128 * wave + 32 * s + 8 * (lane >> 4);
                whi[hf][s] = *(const bf16x8*)(p.wside + off); wlo[hf][s] = *(const bf16x8*)(p.wside + 32 * 1024 + off); }
    }
    for (int tile = bx; tile < T / 16; tile += G) {
        const int b = (tile * 16) / SEQ;
#pragma unroll 1
        for (int tt = 0; tt < 2; ++tt) {
            const int tl = 2 * wave + tt, token = tile * 16 + tl;
            f32x4 v[4];
            const float* xr = p.xin + (size_t)token * D + 4 * lane;
#pragma unroll
            for (int j = 0; j < 4; ++j) v[j] = *(const f32x4*)(xr + 256 * j);
            if (MODE == 1) {
                const bf16* yr = p.y + (size_t)token * D + 4 * lane; const float* gp = p.gate + (size_t)b * 6144 + 4 * lane;
#pragma unroll
                for (int j = 0; j < 4; ++j) { const u32x2 yq = *(const u32x2*)(yr + 256 * j); const f32x4 yy = (f32x4){bf_lo(yq.x), bf_hi(yq.x), bf_lo(yq.y), bf_hi(yq.y)}; const f32x4 g = *(const f32x4*)(gp + 256 * j); v[j] = v[j] * ALPHA + (g + 1.0f) * yy; }
            }
            if (MODE == 2) {
                f32x4 ya[4];
#pragma unroll
                for (int j = 0; j < 4; ++j) ya[j] = (f32x4){0.f, 0.f, 0.f, 0.f};
#pragma unroll
                for (int k = 0; k < 4; ++k) { const int ds = p.dest[token * 4 + k]; const float w = p.tw[token * 4 + k]; const bf16* yr = p.ys + (size_t)ds * D + 4 * lane;
#pragma unroll
                    for (int j = 0; j < 4; ++j) { const u32x2 q = *(const u32x2*)(yr + 256 * j); ya[j] += (f32x4){bf_lo(q.x), bf_hi(q.x), bf_lo(q.y), bf_hi(q.y)} * w; } }
                const float* gp = p.gate + (size_t)b * 6144 + 4 * lane;
#pragma unroll
                for (int j = 0; j < 4; ++j) { const f32x4 g = *(const f32x4*)(gp + 256 * j); v[j] = v[j] * ALPHA + (g + 1.0f) * ya[j]; }
            }
            if (MODE != 0) {
                float s = 0.f;
#pragma unroll
                for (int j = 0; j < 4; ++j) s += (v[j][0] + v[j][1]) + (v[j][2] + v[j][3]);
                const float mean = wave_sum(s, lane) * (1.0f / D); float s2 = 0.f;
#pragma unroll
                for (int j = 0; j < 4; ++j) { v[j] = v[j] - mean; s2 += (v[j][0] * v[j][0] + v[j][1] * v[j][1]) + (v[j][2] * v[j][2] + v[j][3] * v[j][3]); }
                const float rstd = 1.0f / sqrtf(wave_sum(s2, lane) * (1.0f / D) + LN_EPS);
                float* xo = p.xout + (size_t)token * D + 4 * lane;
#pragma unroll
                for (int j = 0; j < 4; ++j) { const f32x4 g = *(const f32x4*)(p.lng + 4 * lane + 256 * j), bb = *(const f32x4*)(p.lnb + 4 * lane + 256 * j); v[j] = v[j] * rstd * g + bb; *(f32x4*)(xo + 256 * j) = v[j]; }
            }
            if (p.has_h) {
                const float* scp = p.sc + (size_t)b * 6144 + 4 * lane; const float* shp = p.sh + (size_t)b * 6144 + 4 * lane;
                bf16* ho = p.hout + (size_t)token * D + 4 * lane;
#pragma unroll
                for (int j = 0; j < 4; ++j) { const f32x4 s1 = *(const f32x4*)(scp + 256 * j), s0 = *(const f32x4*)(shp + 256 * j); const f32x4 h = v[j] * (s1 + 1.0f) + s0;
                    u32x2 o; o.x = cvt_pk_bf16(h[0], h[1]); o.y = cvt_pk_bf16(h[2], h[3]); *(u32x2*)(ho + 256 * j) = o;
                    if (MODE == 1 && p.h8out) { int w8 = __builtin_amdgcn_cvt_pk_fp8_f32(h[0] * F8_HSCALE, h[1] * F8_HSCALE, 0, false); w8 = __builtin_amdgcn_cvt_pk_fp8_f32(h[2] * F8_HSCALE, h[3] * F8_HSCALE, w8, true); *(int*)(p.h8out + (size_t)token * D + 4 * lane + 256 * j) = w8; }
                    if (side) { u32x2 l; l.x = cvt_pk_bf16(h[0] - bf_lo(o.x), h[1] - bf_hi(o.x)); l.y = cvt_pk_bf16(h[2] - bf_lo(o.y), h[3] - bf_hi(o.y));
                        *(LAS u32x2*)(Hhi + tl * HS + 4 * lane + 256 * j) = o; *(LAS u32x2*)(Hlo + tl * HS + 4 * lane + 256 * j) = l; } }
            }
        }
        if (side) {
            __syncthreads();
            f32x4 acc[2]; acc[0] = (f32x4){0.f, 0.f, 0.f, 0.f}; acc[1] = acc[0];
#pragma unroll
            for (int s = 0; s < 4; ++s) { const int ko = (lane & 15) * HS + 128 * wave + 32 * s + 8 * (lane >> 4);
                const bf16x8 bh = *(const LAS bf16x8*)(Hhi + ko), bl = *(const LAS bf16x8*)(Hlo + ko);
#pragma unroll
                for (int hf = 0; hf < 2; ++hf) { acc[hf] = __builtin_amdgcn_mfma_f32_16x16x32_bf16(whi[hf][s], bh, acc[hf], 0, 0, 0);
                    acc[hf] = __builtin_amdgcn_mfma_f32_16x16x32_bf16(wlo[hf][s], bh, acc[hf], 0, 0, 0); acc[hf] = __builtin_amdgcn_mfma_f32_16x16x32_bf16(whi[hf][s], bl, acc[hf], 0, 0, 0); } }
#pragma unroll
            for (int hf = 0; hf < 2; ++hf)
#pragma unroll
                for (int j = 0; j < 4; ++j) part[(wave * 32 + hf * 16 + 4 * (lane >> 4) + j) * 16 + (lane & 15)] = acc[hf][j];
            __syncthreads();
            { const int e = tid >> 4, tk = tid & 15; float s = 0.f;
#pragma unroll
              for (int w = 0; w < 8; ++w) s += part[(w * 32 + e) * 16 + tk];
              if (MODE == 1) logit[tk * 32 + e] = s + p.rbias[e];
              else p.lr_out[(size_t)(tile * 16 + tk) * 32 + e] = s; }
            if (MODE == 1) {
                __syncthreads();
                if (tid < 16) {
                    const int token = tile * 16 + tid; float lv[32];
#pragma unroll
                    for (int e = 0; e < 32; ++e) lv[e] = logit[tid * 32 + e];
                    int bi[4]; float bv[4];
#pragma unroll
                    for (int k = 0; k < 4; ++k) { float m = -3.0e38f; int mi = 0;
#pragma unroll
                        for (int e = 0; e < 32; ++e) { const bool take = lv[e] > m; m = take ? lv[e] : m; mi = take ? e : mi; }
                        bi[k] = mi; bv[k] = m;
#pragma unroll
                        for (int e = 0; e < 32; ++e) lv[e] = (e == mi) ? -3.0e38f : lv[e]; }
                    const float e1 = __expf(bv[1] - bv[0]), e2 = __expf(bv[2] - bv[0]), e3 = __expf(bv[3] - bv[0]); const float inv = 1.0f / (1.0f + e1 + e2 + e3);
                    *(int4*)(p.topi + token * 4) = make_int4(bi[0], bi[1], bi[2], bi[3]);
                    *(f32x4*)(p.topw + token * 4) = (f32x4){inv, e1 * inv, e2 * inv, e3 * inv};
#pragma unroll
                    for (int k = 0; k < 4; ++k) atomicAdd((int*)&lhist[bi[k]], 1);
                }
            }
            __syncthreads();
        }
    }
    if (MODE == 1) { __syncthreads(); if (tid < 32) p.hist[tid] = lhist[tid]; }
}

__device__ __forceinline__ void phase_place(int* route, LAS unsigned char* lds, int tid, int bx, int G) {
    const int lane = tid & 63, wave = tid >> 6;
    LAS int* ptot = (LAS int*)lds;
    LAS int* ppre = ptot + 512;
    LAS int* tot = ppre + 512;
    LAS int* pre = tot + 32;
    LAS int* pstart = pre + 32;
    const int* hist = route + R_HIST;
    { const int e = tid & 31, part = tid >> 5; int st = 0, sp = 0;
      for (int bb = part; bb < G; bb += 16) { const int h = hist[bb * 32 + e]; st += h; if (bb < bx) sp += h; }
      ptot[part * 32 + e] = st; ppre[part * 32 + e] = sp; }
    __syncthreads();
    if (tid < 32) { int st = 0, sp = 0;
#pragma unroll
        for (int q = 0; q < 16; ++q) { st += ptot[q * 32 + tid]; sp += ppre[q * 32 + tid]; }
        tot[tid] = st; pre[tid] = sp; }
    __syncthreads();
    if (tid == 0) { int acc = 0; for (int e = 0; e < 32; ++e) { pstart[e] = acc; acc += (tot[e] + 255) / 256 * 256; } pstart[32] = acc; }
    __syncthreads();
    if (bx == 0) {
        const int ntiles = pstart[32] / 256;
        if (tid == 0) route[R_NTILES] = ntiles;
        for (int t = tid; t < ntiles; t += NTHREADS) { int e = 0; for (int q = 1; q < 32; ++q) if (pstart[q] <= t * 256) e = q; route[R_TILEE + t] = e; }
    }
    for (int e = bx; e < 32; e += G) { const int s0 = pstart[e] + tot[e], s1 = pstart[e + 1]; for (int s = s0 + tid; s < s1; s += NTHREADS) route[R_BUFTOK + s] = 0; }
    if (wave == 0) {
        int run = 0;
        for (int tile = bx; tile < T / 16; tile += G) {
            const int token = tile * 16 + (lane >> 2);
            const int e = route[R_TOPI + tile * 64 + lane];
            const int base = shfl_i(run, e, lane);
            int rank = 0, add = 0;
#pragma unroll 1
            for (int x = 0; x < 32; ++x) { const unsigned long long m = __ballot(e == x); if (e == x) rank = __popcll(m & ((1ull << lane) - 1ull)); if (lane == x) add = __popcll(m); }
            run += add;
            const int ds = pstart[e] + pre[e] + base + rank;
            route[R_DEST + tile * 64 + lane] = ds;
            route[R_BUFTOK + ds] = token;
        }
    }
}

struct Unit { int pm, pn, e; const char* bt; };
constexpr int NXCD = 8, WGM = 8;
struct Sched {
    int nM, nN, nwg, G, c; const char* Bt; size_t estride; const int* tile_e; int KB;
    __device__ __forceinline__ void init(int nM_, int nN_, int G_, int c_, const void* Bt_, size_t es, const int* te, int KB_) { nM = nM_; nN = nN_; nwg = nM * nN; G = G_; c = c_; Bt = (const char*)Bt_; estride = es; tile_e = te; KB = KB_; }
    __device__ __forceinline__ bool next(int i, Unit& u) const {
        const long L = (long)i * G + c; if (L >= nwg) return false;
        int wgid = (int)L; { const int q = nwg / NXCD, r = nwg % NXCD, xcd = wgid % NXCD, off = wgid / NXCD; wgid = (xcd < r ? xcd * (q + 1) : r * (q + 1) + (xcd - r) * q) + off; }
        const int nig = WGM * nN, gid = wgid / nig, fm = gid * WGM, gsz = (nM - fm) < WGM ? (nM - fm) : WGM;
        u.pm = fm + ((wgid % nig) % gsz); u.pn = (wgid % nig) / gsz;
        u.e = tile_e ? __builtin_amdgcn_readfirstlane(tile_e[u.pm]) : 0;
        u.bt = Bt + (size_t)u.e * estride + (size_t)u.pn * 256 * KB;
        return true;
    }
};
struct EpiGlaIn { bf16* O;
    __device__ __forceinline__ const float* bias_ptr(const Unit&) const { return nullptr; }
    __device__ __forceinline__ void operator()(const f32x4 (&acc)[2][2][4][2], const Unit& u, int wr, int wc, int fr, int fq, const LAS float*) const {
        const int row0 = u.pm * 256 + wr * 64 + fr, col0 = u.pn * 256 + wc * 32 + 4 * fq; const float sc = (u.pn < 2) ? 0.08838834764831845f : 1.0f;
#pragma unroll
        for (int ai = 0; ai < 2; ++ai)
#pragma unroll
            for (int m = 0; m < 4; ++m) { bf16* rp = O + (size_t)(row0 + ai * 128 + m * 16) * GLA_MAIN + col0;
#pragma unroll
                for (int bj = 0; bj < 2; ++bj)
#pragma unroll
                    for (int n = 0; n < 2; ++n) { const f32x4 v = acc[ai][bj][m][n] * sc; u32x2 o; o.x = cvt_pk_bf16(v[0], v[1]); o.y = cvt_pk_bf16(v[2], v[3]); *(u32x2*)(rp + bj * 128 + n * 16) = o; } }
    }
};
struct EpiSguIn { bf16* O; const float* bias;
    __device__ __forceinline__ const float* bias_ptr(const Unit& u) const { return bias + u.pn * 256; }
    __device__ __forceinline__ void operator()(const f32x4 (&acc)[2][2][4][2], const Unit& u, int wr, int wc, int fr, int fq, const LAS float* lb) const {
        const int row0 = u.pm * 256 + wr * 64 + fr, col0 = u.pn * 256 + wc * 32 + 4 * fq;
        f32x4 bv[2][2];
#pragma unroll
        for (int bj = 0; bj < 2; ++bj)
#pragma unroll
            for (int n = 0; n < 2; ++n) bv[bj][n] = *(const LAS f32x4*)(lb + wc * 32 + 4 * fq + bj * 128 + n * 16);
#pragma unroll
        for (int ai = 0; ai < 2; ++ai)
#pragma unroll
            for (int m = 0; m < 4; ++m) { bf16* rp = O + (size_t)(row0 + ai * 128 + m * 16) * 2048 + col0;
#pragma unroll
                for (int bj = 0; bj < 2; ++bj)
#pragma unroll
                    for (int n = 0; n < 2; ++n) { const f32x4 v = acc[ai][bj][m][n] + bv[bj][n]; u32x2 o; o.x = cvt_pk_bf16(gelu_f(v[0]), gelu_f(v[1])); o.y = cvt_pk_bf16(gelu_f(v[2]), gelu_f(v[3])); *(u32x2*)(rp + bj * 128 + n * 16) = o; } }
    }
};
struct EpiOut { bf16* O; const float* bias;
    __device__ __forceinline__ const float* bias_ptr(const Unit& u) const { return bias ? bias + u.pn * 256 : nullptr; }
    __device__ __forceinline__ void operator()(const f32x4 (&acc)[2][2][4][2], const Unit& u, int wr, int wc, int fr, int fq, const LAS float* lb) const {
        const int row0 = u.pm * 256 + wr * 64 + fr, col0 = u.pn * 256 + wc * 32 + 4 * fq;
        f32x4 bv[2][2];
#pragma unroll
        for (int bj = 0; bj < 2; ++bj)
#pragma unroll
            for (int n = 0; n < 2; ++n) bv[bj][n] = bias ? *(const LAS f32x4*)(lb + wc * 32 + 4 * fq + bj * 128 + n * 16) : (f32x4){0.f, 0.f, 0.f, 0.f};
#pragma unroll
        for (int ai = 0; ai < 2; ++ai)
#pragma unroll
            for (int m = 0; m < 4; ++m) { bf16* rp = O + (size_t)(row0 + ai * 128 + m * 16) * D + col0;
#pragma unroll
                for (int bj = 0; bj < 2; ++bj)
#pragma unroll
                    for (int n = 0; n < 2; ++n) { const f32x4 v = acc[ai][bj][m][n] + bv[bj][n]; u32x2 o; o.x = cvt_pk_bf16(v[0], v[1]); o.y = cvt_pk_bf16(v[2], v[3]); *(u32x2*)(rp + bj * 128 + n * 16) = o; } }
    }
};
template <bool F8> struct EpiUp { unsigned char* O; const float* bias;
    __device__ __forceinline__ const float* bias_ptr(const Unit& u) const { return bias + (size_t)u.e * 2048 + u.pn * 256; }
    __device__ __forceinline__ void operator()(const f32x4 (&acc)[2][2][4][2], const Unit& u, int wr, int wc, int fr, int fq, const LAS float* lb) const {
        const int row0 = u.pm * 256 + wr * 64 + fr, a0 = u.pn * 128 + wc * 16 + 4 * fq;
        const float asc = F8 ? 1.0f / (F8_WSCALE * F8_HSCALE) : 1.0f;
        f32x4 bg[2], bl[2];
#pragma unroll
        for (int bj = 0; bj < 2; ++bj) { const LAS float* bp = lb + 2 * (wc * 16 + 4 * fq + 64 * bj); const f32x4 p0 = *(const LAS f32x4*)bp, p1 = *(const LAS f32x4*)(bp + 4);
            bg[bj] = (f32x4){p0[0], p0[2], p1[0], p1[2]}; bl[bj] = (f32x4){p0[1], p0[3], p1[1], p1[3]}; }
#pragma unroll
        for (int ai = 0; ai < 2; ++ai)
#pragma unroll
            for (int m = 0; m < 4; ++m) { const size_t ro = (size_t)(row0 + ai * 128 + m * 16) * D + a0;
#pragma unroll
                for (int bj = 0; bj < 2; ++bj) { const f32x4 g = acc[ai][bj][m][0] * asc + bg[bj], l = acc[ai][bj][m][1] * asc + bl[bj]; float r[4];
#pragma unroll
                    for (int j = 0; j < 4; ++j) { const float gg = fminf(g[j], 7.0f), ll = fminf(fmaxf(l[j], -7.0f), 7.0f); r[j] = gg * sigmoid_f(1.702f * gg) * (ll + 1.0f); }
                    if constexpr (F8) { int w = __builtin_amdgcn_cvt_pk_fp8_f32(r[0] * F8_ASCALE, r[1] * F8_ASCALE, 0, false); w = __builtin_amdgcn_cvt_pk_fp8_f32(r[2] * F8_ASCALE, r[3] * F8_ASCALE, w, true);
                        *(int*)(O + ro + bj * 64) = w; }
                    else { u32x2 o; o.x = cvt_pk_bf16(r[0], r[1]); o.y = cvt_pk_bf16(r[2], r[3]); *(u32x2*)((bf16*)O + ro + bj * 64) = o; } } }
    }
};
struct EpiDown { bf16* O; const float* bias; float asc;
    __device__ __forceinline__ const float* bias_ptr(const Unit& u) const { return bias + (size_t)u.e * 1024 + u.pn * 256; }
    __device__ __forceinline__ void operator()(const f32x4 (&acc)[2][2][4][2], const Unit& u, int wr, int wc, int fr, int fq, const LAS float* lb) const {
        const int row0 = u.pm * 256 + wr * 64 + fr, col0 = u.pn * 256 + wc * 32 + 4 * fq;
        f32x4 bv[2][2];
#pragma unroll
        for (int bj = 0; bj < 2; ++bj)
#pragma unroll
            for (int n = 0; n < 2; ++n) bv[bj][n] = *(const LAS f32x4*)(lb + wc * 32 + 4 * fq + bj * 128 + n * 16);
#pragma unroll
        for (int ai = 0; ai < 2; ++ai)
#pragma unroll
            for (int m = 0; m < 4; ++m) { bf16* rp = O + (size_t)(row0 + ai * 128 + m * 16) * D + col0;
#pragma unroll
                for (int bj = 0; bj < 2; ++bj)
#pragma unroll
                    for (int n = 0; n < 2; ++n) { const f32x4 v = acc[ai][bj][m][n] * asc + bv[bj][n]; u32x2 o; o.x = cvt_pk_bf16(v[0], v[1]); o.y = cvt_pk_bf16(v[2], v[3]); *(u32x2*)(rp + bj * 128 + n * 16) = o; } }
    }
};

constexpr int G8_BK = 64, G8_HALF = 128, G8_HTB = G8_HALF * G8_BK * 2, G8_STAGE_BYTES = 8 * G8_HTB;
__device__ __forceinline__ int g8_lds_byte(int r, int c) { const int st = (r >> 4) * 2 + (c >> 5), rr = r & 15, cc = c & 31, ob = rr * 64 + cc * 2; return st * 1024 + (ob ^ (((ob >> 9) & 1) << 5)); }
__device__ __forceinline__ void g8_stage_rc(int b, int& R, int& C) { const int st = b / 1024, sb = b % 1024, swz = sb ^ (((sb >> 9) & 1) << 5); R = (st >> 1) * 16 + swz / 64; C = (st & 1) * 32 + (swz % 64) / 2; }
__device__ __forceinline__ u32x4 g8_avoff(int pm, const int* gather, int tid, int KB) {
    int t2 = tid; asm volatile("" : "+v"(t2));
    int R, C; g8_stage_rc(t2 * 16, R, C);
    const int* gp = gather + pm * 256 + R;
    const unsigned r00 = gp[0], r01 = gp[64], r10 = gp[128], r11 = gp[192], c2 = (unsigned)(C * 2), k2 = (unsigned)KB;
    return (u32x4){r00 * k2 + c2, r01 * k2 + c2, r10 * k2 + c2, r11 * k2 + c2};
}
template <bool GATHER, bool FP8, class Epi>
__device__ __forceinline__ void gemm_fast(const void* A, const int* gather, const int K, const Sched& S, const Epi& E, LAS unsigned char* lds, int tid) {
    const int wid = __builtin_amdgcn_readfirstlane(tid >> 6), lane = tid & 63, wr = wid >> 2, wc = wid & 3, fr = lane & 15, fq = lane >> 4;
    const int KB = FP8 ? K : 2 * K, nt = KB / 128;
    unsigned voff; { int R, C; g8_stage_rc(tid * 16, R, C); voff = (unsigned)(R * KB + C * 2); }
    const size_t kstep = (size_t)128, hstep = (size_t)G8_HALF * KB, qstep = (size_t)64 * KB, tstep = 2 * hstep;
    const unsigned ldsw = (unsigned)wid * 1024u;
    const int aoff = g8_lds_byte(wr * 64 + fr, fq * (FP8 ? 16 : 8)), boff = g8_lds_byte(wc * 32 + fr, fq * (FP8 ? 16 : 8));
    constexpr int KSTR = FP8 ? 16 : 1024;
#define G8_SA(b, h) (((b) * 2 + (h)) * G8_HTB)
#define G8_SB(b, h) ((4 + (b) * 2 + (h)) * G8_HTB)
#define G8_GLDS(gp, ldsoff) __builtin_amdgcn_global_load_lds((const unsigned*)(gp), (LAS unsigned*)(lds + (ldsoff)), 16, 0, 0)
#define G8_STAGE_D(bufoff, gbase) do { G8_GLDS((const char*)(gbase) + voff, (bufoff) + ldsw); G8_GLDS((const char*)(gbase) + qstep + voff, (bufoff) + ldsw + 8192); } while (0)
#define G8_STAGE_A(bufoff, kb, h) do { if constexpr (GATHER) { G8_GLDS((kb) + va[(h) * 2], (bufoff) + ldsw); G8_GLDS((kb) + va[(h) * 2 + 1], (bufoff) + ldsw + 8192); } \
        else { G8_STAGE_D(bufoff, (kb) + (h) * hstep); } } while (0)
#define G8_LDA(dst, b, h) do { _Pragma("unroll") for (int m = 0; m < 4; ++m) _Pragma("unroll") for (int k = 0; k < 2; ++k) dst[m][k] = *(const LAS bf16x8*)(lds + G8_SA(b, h) + aoff + m * 2048 + k * KSTR); } while (0)
#define G8_LDB(dst, b, h) do { _Pragma("unroll") for (int n = 0; n < 2; ++n) _Pragma("unroll") for (int k = 0; k < 2; ++k) dst[n][k] = *(const LAS bf16x8*)(lds + G8_SB(b, h) + boff + n * 2048 + k * KSTR); } while (0)
#define G8_CAT(x) __builtin_shufflevector(__builtin_bit_cast(i32x4, (x)[0]), __builtin_bit_cast(i32x4, (x)[1]), 0, 1, 2, 3, 4, 5, 6, 7)
#define G8_MMA(ai, bj, At, Bt) do { __builtin_amdgcn_s_setprio(1); _Pragma("unroll") for (int m = 0; m < 4; ++m) _Pragma("unroll") for (int n = 0; n < 2; ++n) { \
        if constexpr (FP8) acc[ai][bj][m][n] = __builtin_amdgcn_mfma_scale_f32_16x16x128_f8f6f4(G8_CAT(Bt[n]), G8_CAT(At[m]), acc[ai][bj][m][n], 0, 0, 0, 0x7f7f7f7f, 0, 0x7f7f7f7f); \
        else { _Pragma("unroll") for (int k = 0; k < 2; ++k) acc[ai][bj][m][n] = __builtin_amdgcn_mfma_f32_16x16x32_bf16(Bt[n][k], At[m][k], acc[ai][bj][m][n], 0, 0, 0); } } \
        __builtin_amdgcn_s_setprio(0); } while (0)
#define G8_WAIT_V(n) asm volatile("s_waitcnt vmcnt(" #n ")" ::: "memory")
#define G8_WAIT_L(n) asm volatile("s_waitcnt lgkmcnt(" #n ")" ::: "memory")
#define G8_BAR __builtin_amdgcn_s_barrier()
#define G8_SCHED __builtin_amdgcn_sched_barrier(0)
    Unit cur, nxt; int ui = 0;
    if (!S.next(0, cur)) return;
    f32x4 acc[2][2][4][2];
#pragma unroll
    for (int a = 0; a < 2; ++a)
#pragma unroll
        for (int b = 0; b < 2; ++b)
#pragma unroll
            for (int m = 0; m < 4; ++m)
#pragma unroll
                for (int n = 0; n < 2; ++n) acc[a][b][m][n] = (f32x4){0.f, 0.f, 0.f, 0.f};
    bf16x8 At[4][2], B0[2][2], B1[2][2];
    u32x4 va = (u32x4){0u, 0u, 0u, 0u};
    if constexpr (GATHER) va = g8_avoff(cur.pm, gather, tid, KB);
    constexpr int G8_IDX = G8_STAGE_BYTES, G8_BIAS = G8_STAGE_BYTES + 1024;
    { const float* bp0 = E.bias_ptr(cur); if (bp0 && wid == 0) G8_GLDS((const char*)bp0 + lane * 16, G8_BIAS); }
    const char* cB = (const char*)cur.bt; const char* cA = (const char*)A + (GATHER ? (size_t)0 : (size_t)cur.pm * tstep);
    G8_STAGE_D(G8_SB(0, 0), cB); G8_STAGE_D(G8_SB(0, 1), cB + hstep); G8_STAGE_A(G8_SA(0, 0), cA, 0); G8_STAGE_A(G8_SA(0, 1), cA, 1);
    if (wr == 1) G8_BAR;
    G8_WAIT_V(2); G8_BAR;
    G8_STAGE_D(G8_SB(1, 0), cB + kstep); G8_STAGE_A(G8_SA(1, 0), cA + kstep, 0); G8_STAGE_D(G8_SB(1, 1), cB + hstep + kstep);
    G8_WAIT_V(6); G8_BAR;
    for (;;) {
        const bool has_next = S.next(ui + 1, nxt);
        if constexpr (GATHER) { if (has_next && wid == 1) G8_GLDS((const char*)(gather + nxt.pm * 256) + lane * 16, G8_IDX); }
        const char* nB = has_next ? (const char*)nxt.bt : cB;
        const char* nA = (GATHER || !has_next) ? cA : (const char*)A + (size_t)nxt.pm * tstep;
#pragma unroll 1
        for (int t = 0; t < nt; t += 2) {
            const bool last = (t == nt - 2);
            const char* a1 = cA + (size_t)(t + 1) * kstep;
            const char* a2 = last ? nA : cA + (size_t)(t + 2) * kstep; const char* b2 = last ? nB : cB + (size_t)(t + 2) * kstep;
            const char* a3 = a2 + kstep; const char* b3 = b2 + kstep;
            G8_LDB(B0, 0, 0); G8_LDB(B1, 0, 1); G8_SCHED; G8_LDA(At, 0, 0); G8_STAGE_A(G8_SA(1, 1), a1, 1);
            if (last && has_next && wid == 0) { const float* bpn = E.bias_ptr(nxt); if (bpn) G8_GLDS((const char*)bpn + lane * 16, G8_BIAS + ((ui + 1) & 1) * 1024); }
            if constexpr (GATHER) { if (last && has_next) {
                int t2 = tid; asm volatile("" : "+v"(t2)); int R, C; g8_stage_rc(t2 * 16, R, C); const LAS int* ip = (const LAS int*)(lds + G8_IDX) + R; const unsigned c2 = (unsigned)(C * 2), k2 = (unsigned)KB;
                va = (u32x4){(unsigned)ip[0] * k2 + c2, (unsigned)ip[64] * k2 + c2, (unsigned)ip[128] * k2 + c2, (unsigned)ip[192] * k2 + c2}; } }
            G8_WAIT_V(8); G8_WAIT_L(0); G8_BAR; G8_MMA(0, 0, At, B0); G8_MMA(0, 1, At, B1); G8_BAR; G8_SCHED;
            G8_LDA(At, 0, 1); G8_STAGE_D(G8_SB(0, 0), b2); G8_STAGE_D(G8_SB(0, 1), b2 + hstep); G8_STAGE_A(G8_SA(0, 0), a2, 0);
            G8_WAIT_V(8); G8_WAIT_L(0); G8_BAR; G8_MMA(1, 0, At, B0); G8_MMA(1, 1, At, B1); G8_BAR; G8_SCHED;
            G8_LDB(B0, 1, 0); G8_LDB(B1, 1, 1); G8_SCHED; G8_LDA(At, 1, 0); G8_STAGE_A(G8_SA(0, 1), a2, 1);
            G8_WAIT_V(8); G8_WAIT_L(0); G8_BAR; G8_MMA(0, 0, At, B0); G8_MMA(0, 1, At, B1); G8_BAR; G8_SCHED;
            G8_LDA(At, 1, 1); G8_STAGE_D(G8_SB(1, 0), b3); G8_STAGE_D(G8_SB(1, 1), b3 + hstep); G8_STAGE_A(G8_SA(1, 0), a3, 0);
            G8_WAIT_V(8); G8_WAIT_L(0); G8_BAR; G8_MMA(1, 0, At, B0); G8_MMA(1, 1, At, B1); G8_BAR; G8_SCHED;
        }
        if (wr == 0) G8_BAR;
        { int t3 = tid; asm volatile("" : "+v"(t3)); const int l3 = t3 & 63; E(acc, cur, wr, wc, l3 & 15, l3 >> 4, (const LAS float*)(lds + G8_BIAS + (ui & 1) * 1024)); }
        if (!has_next) break;
#pragma unroll
        for (int a = 0; a < 2; ++a)
#pragma unroll
            for (int b = 0; b < 2; ++b)
#pragma unroll
                for (int m = 0; m < 4; ++m)
#pragma unroll
                    for (int n = 0; n < 2; ++n) acc[a][b][m][n] = (f32x4){0.f, 0.f, 0.f, 0.f};
        cur = nxt; cB = nB; cA = nA; ++ui;
        if (wr == 1) G8_BAR;
    }
    G8_WAIT_V(0);
    G8_BAR;
#undef G8_SA
#undef G8_SB
#undef G8_GLDS
#undef G8_STAGE_D
#undef G8_STAGE_A
#undef G8_LDA
#undef G8_LDB
#undef G8_MMA
#undef G8_CAT
#undef G8_WAIT_V
#undef G8_WAIT_L
#undef G8_BAR
#undef G8_SCHED
}

__device__ __forceinline__ float logsigmoid_f(float x) { return fminf(x, 0.f) - log1pf(__expf(-fabsf(x))); }
__device__ __forceinline__ void phase_gla_prep(KA a, int li, LAS unsigned char* lds, int tid, int bx, int G) {
    const int lane = tid & 63, wave = __builtin_amdgcn_readfirstlane(tid >> 6), fr = lane & 15, fq = lane >> 4;
    unsigned char* ws = a->ws;
    const bf16* qkvr = (const bf16*)(ws + WS_BIG); const float* lr = (const float*)(ws + WS_LR);
    bf16* QE = (bf16*)(ws + WS_QE); bf16* KET = (bf16*)(ws + WS_KET); bf16* PP = (bf16*)(ws + WS_P); bf16* VT = (bf16*)(ws + WS_VT); float* EL = (float*)(ws + WS_EL);
    constexpr int LS = 136, VLS = 264;
    LAS bf16* qes = (LAS bf16*)lds;
    LAS bf16* kes = qes + 64 * LS;
    LAS float* lrs = (LAS float*)(kes + 64 * LS);
    LAS float* segtot = lrs + 1024;
    LAS bf16* vraw = (LAS bf16*)(segtot + 512);
    const int d = tid & 127, seg = tid >> 7;
    const int so = tid & 15, sr = tid >> 4;
    for (int it = bx; it < 4096; it += G) {
        const int chunk = it & 63, dir = (it >> 6) & 1, h = (it >> 7) & 3, b = it >> 9;
        const int row0 = b * SEQ + chunk * 64;
        const size_t cidx = (size_t)(((dir * 8 + b) * 4 + h) * 64 + chunk);
        const float* wg2 = a->in[dir ? I_GWG2B : I_GWG2F] + (size_t)li * 16 * 512 + h * 128 + d; const float bgd = a->in[dir ? I_GBGB : I_GBGF][(size_t)li * 512 + h * 128 + d];
#pragma unroll
        for (int k2 = 0; k2 < 2; ++k2) { const int p = sr + 32 * k2; const bf16* src = qkvr + (size_t)(row0 + p) * GLA_MAIN + h * 128 + 8 * so;
            const u32x4 qv = *(const u32x4*)src, kv = *(const u32x4*)(src + 512);
            *(LAS u32x4*)(qes + p * LS + 8 * so) = qv; *(LAS u32x4*)(kes + p * LS + 8 * so) = kv; }
        if (dir == 0) {
#pragma unroll
            for (int k4 = 0; k4 < 4; ++k4) { const int idx = tid + 512 * k4, p = idx >> 5, oc = idx & 31;
                *(LAS u32x4*)(vraw + p * VLS + 8 * oc) = *(const u32x4*)(qkvr + (size_t)(row0 + p) * GLA_MAIN + 1024 + h * 256 + 8 * oc); }
        }
        for (int i = tid; i < 1024; i += NTHREADS) lrs[i] = lr[(size_t)(row0 + (i >> 4)) * 32 + dir * 16 + (i & 15)];
        float wcol[16];
#pragma unroll
        for (int r = 0; r < 16; ++r) wcol[r] = wg2[r * 512];
        __syncthreads();
        float g[16];
#pragma unroll
        for (int s2 = 0; s2 < 16; ++s2) { const LAS float* lp = lrs + (seg * 16 + s2) * 16; float x = bgd;
#pragma unroll
            for (int r4 = 0; r4 < 4; ++r4) { const f32x4 l4 = *(const LAS f32x4*)(lp + 4 * r4); x += l4[0] * wcol[4 * r4] + l4[1] * wcol[4 * r4 + 1] + l4[2] * wcol[4 * r4 + 2] + l4[3] * wcol[4 * r4 + 3]; }
            g[s2] = (fminf(x, 0.f) - __logf(1.0f + __expf(-fabsf(x)))) * (1.0f / 16.0f); }
        if (dir == 0) {
#pragma unroll
            for (int s2 = 1; s2 < 16; ++s2) g[s2] += g[s2 - 1];
        } else {
#pragma unroll
            for (int s2 = 14; s2 >= 0; --s2) g[s2] += g[s2 + 1];
        }
        segtot[seg * 128 + d] = dir ? g[0] : g[15];
        __syncthreads();
        float pre = 0.f, total = 0.f;
#pragma unroll
        for (int sg = 0; sg < 4; ++sg) { const float t = segtot[sg * 128 + d]; total += t; if (dir ? (sg > seg) : (sg < seg)) pre += t; }
        if (seg == 0) EL[cidx * 128 + d] = __expf(total);
        unsigned kt[8];
#pragma unroll
        for (int s2 = 0; s2 < 16; s2 += 2) {
            unsigned kw[2];
#pragma unroll
            for (int u = 0; u < 2; ++u) { const int p = seg * 16 + s2 + u;
                const float q = bf2f(qes[p * LS + d]), k = bf2f(kes[p * LS + d]); const float bb = g[s2 + u] + pre;
                const float eb_ = __expf(bb); const unsigned qw = cvt_pk_bf16(q * eb_, 0.f) & 0xffffu; kw[u] = cvt_pk_bf16(k * __builtin_amdgcn_rcpf(eb_), 0.f) & 0xffffu;
                qes[p * LS + d] = (bf16)qw; kes[p * LS + d] = (bf16)kw[u]; }
            kt[s2 >> 1] = kw[0] | (kw[1] << 16);
        }
        { bf16* kp = KET + cidx * 8192 + (size_t)d * 64 + seg * 16; *(u32x4*)kp = (u32x4){kt[0], kt[1], kt[2], kt[3]}; *(u32x4*)(kp + 8) = (u32x4){kt[4], kt[5], kt[6], kt[7]}; }
        __syncthreads();
#pragma unroll
        for (int k2 = 0; k2 < 2; ++k2) { const int p = sr + 32 * k2; *(u32x4*)(QE + ((size_t)dir * T + row0 + p) * 512 + h * 128 + 8 * so) = *(const LAS u32x4*)(qes + p * LS + 8 * so); }
        { const int jt = wave & 3;
#pragma unroll
          for (int ii = 0; ii < 2; ++ii) { const int itile = 2 * (wave >> 2) + ii;
            f32x4 acc = (f32x4){0.f, 0.f, 0.f, 0.f};
            const bool dead = dir ? (jt < itile) : (jt > itile);
            if (!dead) {
#pragma unroll
                for (int ks = 0; ks < 4; ++ks) { const bf16x8 kf = *(const LAS bf16x8*)(kes + (jt * 16 + fr) * LS + ks * 32 + 8 * fq), qf = *(const LAS bf16x8*)(qes + (itile * 16 + fr) * LS + ks * 32 + 8 * fq);
                    acc = __builtin_amdgcn_mfma_f32_16x16x32_bf16(kf, qf, acc, 0, 0, 0); }
            }
            const int i = itile * 16 + fr, j0 = jt * 16 + 4 * fq; float pv[4];
#pragma unroll
            for (int jj = 0; jj < 4; ++jj) { const int j = j0 + jj; const bool keep = dir ? (j >= i) : (j <= i); pv[jj] = keep ? acc[jj] : 0.f; }
            u32x2 o; o.x = cvt_pk_bf16(pv[0], pv[1]); o.y = cvt_pk_bf16(pv[2], pv[3]);
            *(u32x2*)(PP + cidx * 4096 + (size_t)i * 64 + j0) = o; } }
        if (dir == 0) {
            const int e = tid & 255, jh = tid >> 8; unsigned w[16];
#pragma unroll
            for (int jj = 0; jj < 32; jj += 2) w[jj >> 1] = (unsigned)vraw[(jh * 32 + jj) * VLS + e] | ((unsigned)vraw[(jh * 32 + jj + 1) * VLS + e] << 16);
            bf16* vp = VT + ((size_t)((b * 4 + h) * 64 + chunk) * 256 + e) * 64 + jh * 32;
#pragma unroll
            for (int q4 = 0; q4 < 4; ++q4) *(u32x4*)(vp + 8 * q4) = (u32x4){w[4 * q4], w[4 * q4 + 1], w[4 * q4 + 2], w[4 * q4 + 3]};
        }
        __syncthreads();
    }
}
struct GlaFrags { bf16x8 qf[4], pf[2], vf[2][2], kf[2][2]; };
__device__ __forceinline__ void phase_gla_scan(KA a, LAS unsigned char* lds, int tid, int bx, int G) {
    const int lane = tid & 63, wave = __builtin_amdgcn_readfirstlane(tid >> 6), fr = lane & 15, fq = lane >> 4;
    unsigned char* ws = a->ws;
    const bf16* QE = (const bf16*)(ws + WS_QE); const bf16* KET = (const bf16*)(ws + WS_KET); const bf16* PP = (const bf16*)(ws + WS_P); const bf16* VT = (const bf16*)(ws + WS_VT); const float* EL = (const float*)(ws + WS_EL);
    constexpr int SS = 136;
    LAS bf16* ST = (LAS bf16*)lds;
    const int et0 = 2 * (wave & 1), dt0 = 2 * (wave >> 1), itile = wave >> 1;
    for (int it0 = bx; it0 < 256; it0 += G) {
        const int it = (G == 256) ? ((it0 & 7) * 32 + (it0 >> 3)) : it0;
        const int b = it >> 5, h = (it >> 3) & 3, dir = (it >> 2) & 1, es = it & 3;
        bf16* OO = (bf16*)(ws + (dir ? WS_OB : WS_OF));
        __syncthreads();
        for (int i = tid; i < 64 * SS / 2; i += NTHREADS) ((LAS unsigned*)ST)[i] = 0u;
        __syncthreads();
        f32x4 accS[2][2];
#pragma unroll
        for (int x = 0; x < 2; ++x)
#pragma unroll
            for (int y = 0; y < 2; ++y) accS[x][y] = (f32x4){0.f, 0.f, 0.f, 0.f};
        const size_t cbase = (size_t)((dir * 8 + b) * 4 + h) * 64;
        const char* qb = (const char*)(QE + ((size_t)dir * T + (size_t)b * SEQ + itile * 16) * 512 + h * 128);
        const char* pb = (const char*)(PP + cbase * 4096 + (size_t)(itile * 16) * 64);
        const char* vb = (const char*)(VT + ((size_t)(b * 4 + h) * 64 * 256 + es * 64 + et0 * 16) * 64);
        const char* kb = (const char*)(KET + cbase * 8192 + (size_t)(dt0 * 16) * 64);
        const char* eb = (const char*)(EL + cbase * 128 + dt0 * 16);
        char* ob = (char*)(OO + ((size_t)b * SEQ + itile * 16) * D + h * 256 + es * 64 + et0 * 16);
        const unsigned lq = (unsigned)(fr * 512 + 8 * fq) * 2u, l64 = (unsigned)(fr * 64 + 8 * fq) * 2u, le = (unsigned)fq * 16u, lo = (unsigned)(fr * D + 4 * fq) * 2u;
#define GLA_LOAD(F, c_) do { const int c__ = (c_); \
            _Pragma("unroll") for (int ks = 0; ks < 4; ++ks) F.qf[ks] = *(const bf16x8*)(qb + (size_t)c__ * (64 * 512 * 2) + ks * 64 + lq); \
            _Pragma("unroll") for (int ks = 0; ks < 2; ++ks) F.pf[ks] = *(const bf16x8*)(pb + (size_t)c__ * 8192 + ks * 64 + l64); \
            _Pragma("unroll") for (int et = 0; et < 2; ++et) _Pragma("unroll") for (int ks = 0; ks < 2; ++ks) F.vf[et][ks] = *(const bf16x8*)(vb + (size_t)c__ * 32768 + et * 2048 + ks * 64 + l64); \
            _Pragma("unroll") for (int dt = 0; dt < 2; ++dt) _Pragma("unroll") for (int ks = 0; ks < 2; ++ks) F.kf[dt][ks] = *(const bf16x8*)(kb + (size_t)c__ * 16384 + dt * 2048 + ks * 64 + l64); } while (0)
#define GLA_STEP(cc_, CUR, NXT) do { const int cc = (cc_); const int c = dir ? 63 - cc : cc; const int ccn = cc + 1 < 64 ? cc + 1 : 63; \
            GLA_LOAD(NXT, dir ? 63 - ccn : ccn); \
            const f32x4 el0 = *(const f32x4*)(eb + (size_t)c * 512 + le), el1 = *(const f32x4*)(eb + (size_t)c * 512 + 64 + le); \
            const LAS bf16* Sr = ST + (cc & 1) * 64 * SS; LAS bf16* Sw = ST + ((cc + 1) & 1) * 64 * SS; \
            _Pragma("unroll") for (int et = 0; et < 2; ++et) { f32x4 ao = (f32x4){0.f, 0.f, 0.f, 0.f}; \
                _Pragma("unroll") for (int ks = 0; ks < 4; ++ks) { const bf16x8 sf = *(const LAS bf16x8*)(Sr + ((et0 + et) * 16 + fr) * SS + ks * 32 + 8 * fq); ao = __builtin_amdgcn_mfma_f32_16x16x32_bf16(sf, CUR.qf[ks], ao, 0, 0, 0); } \
                _Pragma("unroll") for (int ks = 0; ks < 2; ++ks) ao = __builtin_amdgcn_mfma_f32_16x16x32_bf16(CUR.vf[et][ks], CUR.pf[ks], ao, 0, 0, 0); \
                u32x2 o; o.x = cvt_pk_bf16(ao[0], ao[1]); o.y = cvt_pk_bf16(ao[2], ao[3]); \
                *(u32x2*)(ob + (size_t)c * (64 * D * 2) + et * 32 + lo) = o; } \
            _Pragma("unroll") for (int dt = 0; dt < 2; ++dt) _Pragma("unroll") for (int et = 0; et < 2; ++et) { \
                _Pragma("unroll") for (int ks = 0; ks < 2; ++ks) accS[dt][et] = __builtin_amdgcn_mfma_f32_16x16x32_bf16(CUR.kf[dt][ks], CUR.vf[et][ks], accS[dt][et], 0, 0, 0); \
                accS[dt][et] = accS[dt][et] * (dt ? el1 : el0); \
                u32x2 o; o.x = cvt_pk_bf16(accS[dt][et][0], accS[dt][et][1]); o.y = cvt_pk_bf16(accS[dt][et][2], accS[dt][et][3]); \
                *(LAS u32x2*)(Sw + ((et0 + et) * 16 + fr) * SS + (dt0 + dt) * 16 + 4 * fq) = o; } \
            __syncthreads(); } while (0)
        GlaFrags FA, FB;
        GLA_LOAD(FA, dir ? 63 : 0);
#pragma unroll 1
        for (int c2 = 0; c2 < 64; c2 += 2) { GLA_STEP(c2, FA, FB); GLA_STEP(c2 + 1, FB, FA); }
#undef GLA_LOAD
#undef GLA_STEP
    }
}

__device__ __forceinline__ void phase_gla_post(KA a, int li, int tid, int bx, int G) {
    const int lane = tid & 63, wave = tid >> 6;
    const bf16* of = (const bf16*)(a->ws + WS_OF); const bf16* ob = (const bf16*)(a->ws + WS_OB); const bf16* qkvr = (const bf16*)(a->ws + WS_BIG); bf16* A2 = (bf16*)(a->ws + WS_A2);
    const float* ng = a->in[I_GNORM] + (size_t)li * 256 + (lane & 15) * 16;
    float g[16];
#pragma unroll
    for (int j = 0; j < 16; ++j) g[j] = ng[j];
    for (int token = bx * NWAVES + wave; token < T; token += G * NWAVES) {
        const u32x4 f0 = *(const u32x4*)(of + (size_t)token * D + 16 * lane), f1 = *(const u32x4*)(of + (size_t)token * D + 16 * lane + 8);
        const u32x4 b0 = *(const u32x4*)(ob + (size_t)token * D + 16 * lane), b1 = *(const u32x4*)(ob + (size_t)token * D + 16 * lane + 8);
        const u32x4 r0 = *(const u32x4*)(qkvr + (size_t)token * GLA_MAIN + 2048 + 16 * lane), r1 = *(const u32x4*)(qkvr + (size_t)token * GLA_MAIN + 2048 + 16 * lane + 8);
        float o[16], r[16];
#pragma unroll
        for (int q = 0; q < 4; ++q) { o[2 * q] = bf_lo(f0[q]) + bf_lo(b0[q]); o[2 * q + 1] = bf_hi(f0[q]) + bf_hi(b0[q]); o[8 + 2 * q] = bf_lo(f1[q]) + bf_lo(b1[q]); o[8 + 2 * q + 1] = bf_hi(f1[q]) + bf_hi(b1[q]);
            r[2 * q] = bf_lo(r0[q]); r[2 * q + 1] = bf_hi(r0[q]); r[8 + 2 * q] = bf_lo(r1[q]); r[8 + 2 * q + 1] = bf_hi(r1[q]); }
        float ss = 0.f;
#pragma unroll
        for (int j = 0; j < 16; ++j) ss += o[j] * o[j];
        ss += shfl_xor_f(ss, 1, lane); ss += shfl_xor_f(ss, 2, lane); ss += shfl_xor_f(ss, 4, lane); ss += shfl_xor_f(ss, 8, lane);
        const float rstd = 1.0f / sqrtf(ss * (1.0f / 256.0f) + LN_EPS);
        unsigned w[8];
#pragma unroll
        for (int q = 0; q < 8; ++q) w[q] = cvt_pk_bf16(o[2 * q] * rstd * g[2 * q] * silu_f(r[2 * q]), o[2 * q + 1] * rstd * g[2 * q + 1] * silu_f(r[2 * q + 1]));
        *(u32x4*)(A2 + (size_t)token * D + 16 * lane) = (u32x4){w[0], w[1], w[2], w[3]}; *(u32x4*)(A2 + (size_t)token * D + 16 * lane + 8) = (u32x4){w[4], w[5], w[6], w[7]};
    }
}

__device__ __forceinline__ void phase_sgu_core(KA a, int li, LAS unsigned char* lds, int tid, int bx, int G) {
    const int lane = tid & 63, wave = __builtin_amdgcn_readfirstlane(tid >> 6), fr = lane & 15, fq = lane >> 4;
    unsigned char* ws = a->ws;
    const bf16* z = (const bf16*)(ws + WS_BIG); bf16* A2 = (bf16*)(ws + WS_A2);
    const float* lng = a->in[I_SLNG] + (size_t)li * 1024; const float* lnb = a->in[I_SLNB] + (size_t)li * 1024;
    const bf16* wsp = (const bf16*)(ws + WS_SGUWS) + (size_t)li * 8 * 128 * 128; const float* bs = a->in[I_SBS] + (size_t)li * 8 * 128;
    constexpr int VS = 132;
    LAS bf16* vn = (LAS bf16*)lds;
    LAS float* st_mean = (LAS float*)(lds + 2 * 128 * VS * 2); LAS float* st_rstd = st_mean + 128;
    const int co = tid & 15, qr = tid >> 4;
    for (int it = bx; it < T / 128; it += G) {
        const int row0 = it * 128;
        __syncthreads();
#pragma unroll 1
        for (int rr = 0; rr < 16; ++rr) { const int q = wave * 16 + rr; const bf16* vp = z + (size_t)(row0 + q) * 2048 + 1024 + 16 * lane;
            const u32x4 v0 = *(const u32x4*)vp, v1 = *(const u32x4*)(vp + 8); float x[16];
#pragma unroll
            for (int k = 0; k < 4; ++k) { x[2 * k] = bf_lo(v0[k]); x[2 * k + 1] = bf_hi(v0[k]); x[8 + 2 * k] = bf_lo(v1[k]); x[8 + 2 * k + 1] = bf_hi(v1[k]); }
            float s1 = 0.f;
#pragma unroll
            for (int k = 0; k < 16; ++k) s1 += x[k];
            const float mean = wave_sum(s1, lane) * (1.0f / 1024.0f); float s2 = 0.f;
#pragma unroll
            for (int k = 0; k < 16; ++k) { const float dd = x[k] - mean; s2 += dd * dd; }
            const float rstd = 1.0f / sqrtf(wave_sum(s2, lane) * (1.0f / 1024.0f) + LN_EPS);
            if (lane == 0) { st_mean[q] = mean; st_rstd[q] = rstd; } }
        __syncthreads();
        const int p = wave * 16 + fr;
#pragma unroll 1
        for (int g = 0; g < 8; ++g) {
            LAS bf16* vb = vn + (g & 1) * 128 * VS;
            {
                const f32x4 g0 = *(const f32x4*)(lng + g * 128 + 8 * co), g1 = *(const f32x4*)(lng + g * 128 + 8 * co + 4), b0 = *(const f32x4*)(lnb + g * 128 + 8 * co), b1 = *(const f32x4*)(lnb + g * 128 + 8 * co + 4);
#pragma unroll
                for (int k = 0; k < 4; ++k) { const int q = qr + 32 * k; const u32x4 w = *(const u32x4*)(z + (size_t)(row0 + q) * 2048 + 1024 + g * 128 + 8 * co);
                    const float m = st_mean[q], r = st_rstd[q];
                    u32x2 o0, o1;
                    o0.x = cvt_pk_bf16((bf_lo(w.x) - m) * r * g0[0] + b0[0], (bf_hi(w.x) - m) * r * g0[1] + b0[1]); o0.y = cvt_pk_bf16((bf_lo(w.y) - m) * r * g0[2] + b0[2], (bf_hi(w.y) - m) * r * g0[3] + b0[3]);
                    o1.x = cvt_pk_bf16((bf_lo(w.z) - m) * r * g1[0] + b1[0], (bf_hi(w.z) - m) * r * g1[1] + b1[1]); o1.y = cvt_pk_bf16((bf_lo(w.w) - m) * r * g1[2] + b1[2], (bf_hi(w.w) - m) * r * g1[3] + b1[3]);
                    *(LAS u32x2*)(vb + q * VS + 8 * co) = o0; *(LAS u32x2*)(vb + q * VS + 8 * co + 4) = o1; }
            }
            bf16x8 wf[4];
#pragma unroll
            for (int ks = 0; ks < 4; ++ks) wf[ks] = *(const bf16x8*)(wsp + ((size_t)g * 128 + p) * 128 + ks * 32 + 8 * fq);
            const float bias = bs[g * 128 + p];
            __syncthreads();
#pragma unroll 2
            for (int ct = 0; ct < 8; ++ct) {
                f32x4 acc = (f32x4){0.f, 0.f, 0.f, 0.f};
#pragma unroll
                for (int ks = 0; ks < 4; ++ks) { const LAS bf16* sp = vb + (ks * 32 + 8 * fq) * VS + ct * 16 + fr; unsigned w4[4];
#pragma unroll
                    for (int j2 = 0; j2 < 4; ++j2) w4[j2] = (unsigned)sp[(2 * j2) * VS] | ((unsigned)sp[(2 * j2 + 1) * VS] << 16);
                    const bf16x8 vf = __builtin_bit_cast(bf16x8, (u32x4){w4[0], w4[1], w4[2], w4[3]});
                    acc = __builtin_amdgcn_mfma_f32_16x16x32_bf16(vf, wf[ks], acc, 0, 0, 0); }
                const int c0 = g * 128 + ct * 16 + 4 * fq;
                const u32x2 uu = *(const u32x2*)(z + (size_t)(row0 + p) * 2048 + c0);
                u32x2 o; o.x = cvt_pk_bf16(bf_lo(uu.x) * (acc[0] + bias), bf_hi(uu.x) * (acc[1] + bias)); o.y = cvt_pk_bf16(bf_lo(uu.y) * (acc[2] + bias), bf_hi(uu.y) * (acc[3] + bias));
                *(u32x2*)(A2 + (size_t)(row0 + p) * D + c0) = o;
            }
        }
    }
}

constexpr int PH_PER_LAYER = 10;
constexpr int NPHASES = 2 + PH_PER_LAYER * DEPTH;
#define GEMM_BODY(A, g, K, S, E) gemm_fast<false, false>(A, g, K, S, E, lds, tid)
#define GEMM_BODY_G(A, g, K, S, E) gemm_fast<true, false>(A, g, K, S, E, lds, tid)
#define GEMM_BODY8(A, g, K, S, E) gemm_fast<false, true>(A, g, K, S, E, lds, tid)
#define GEMM_BODY8_G(A, g, K, S, E) gemm_fast<true, true>(A, g, K, S, E, lds, tid)
__device__ __forceinline__ void ph_prologue(int wave_s) { PHASE_ENTER(); phase_prologue(a, lds, tid, bx, G); }
__device__ __forceinline__ void ph_rp_init(int wave_s) { PHASE_ENTER(); float* mod = (float*)(ws + WS_MOD);
    RowPass p{}; p.xin = a->in[I_X]; p.hout = (bf16*)(ws + WS_H); p.sc = mod + 1 * 1024; p.sh = mod + 0 * 1024; p.wside = (const bf16*)(ws + WS_GLALR_T); p.lr_out = (float*)(ws + WS_LR); p.has_h = 1; p.has_side = 1;
    row_pass<0>(p, lds, tid, bx, G); }
__device__ __forceinline__ void ph_gla_in(int wave_s, int li) { PHASE_ENTER(); Sched S; S.init(T / 256, GLA_MAIN / 256, G, bx, (const bf16*)(ws + WS_GLAIN_T) + (size_t)li * GLA_MAIN * 1024, 0, nullptr, 2048); EpiGlaIn E{(bf16*)(ws + WS_BIG)}; GEMM_BODY((const bf16*)(ws + WS_H), nullptr, 1024, S, E); }
__device__ __forceinline__ void ph_sgu_in(int wave_s, int li) { PHASE_ENTER(); Sched S; S.init(T / 256, 2048 / 256, G, bx, (const bf16*)(ws + WS_SGUIN_T) + (size_t)li * 2048 * 1024, 0, nullptr, 2048); EpiSguIn E{(bf16*)(ws + WS_BIG), a->in[I_SBIN] + (size_t)li * 2048}; GEMM_BODY((const bf16*)(ws + WS_H), nullptr, 1024, S, E); }
__device__ __forceinline__ void ph_gla_prep(int wave_s, int li) { PHASE_ENTER(); phase_gla_prep(a, li, lds, tid, bx, G); }
__device__ __forceinline__ void ph_gla_scan(int wave_s) { PHASE_ENTER(); phase_gla_scan(a, lds, tid, bx, G); }
__device__ __forceinline__ void ph_sgu_core(int wave_s, int li) { PHASE_ENTER(); phase_sgu_core(a, li, lds, tid, bx, G); }
__device__ __forceinline__ void ph_gla_post(int wave_s, int li) { PHASE_ENTER(); phase_gla_post(a, li, tid, bx, G); }
__device__ __forceinline__ void ph_out(int wave_s, int l) { PHASE_ENTER(); const int li = l >> 1; const bool sgu = (l & 1) != 0;
    Sched S; S.init(T / 256, 4, G, bx, (const bf16*)(ws + (sgu ? WS_SGUOUT_T : WS_GLAOUT_T)) + (size_t)li * 1024 * 1024, 0, nullptr, 2048);
    EpiOut E{(bf16*)(ws + WS_Y), sgu ? a->in[I_SBOUT] + (size_t)li * 1024 : nullptr}; GEMM_BODY((const bf16*)(ws + WS_A2), nullptr, 1024, S, E); }
__device__ __forceinline__ void ph_rp_mid(int wave_s, int l) { PHASE_ENTER(); float* modl = (float*)(ws + WS_MOD) + (size_t)l * 8 * 6144; int* route = (int*)(ws + WS_ROUTE);
    RowPass p{}; p.xin = (l == 0) ? a->in[I_X] : (const float*)(ws + WS_X2); p.y = (const bf16*)(ws + WS_Y); p.xout = (float*)(ws + WS_X1); p.hout = (bf16*)(ws + WS_H);
    p.gate = modl + 2 * 1024; p.lng = a->in[I_LNG] + (size_t)(l * 2 + 0) * 1024; p.lnb = a->in[I_LNB] + (size_t)(l * 2 + 0) * 1024; p.sc = modl + 4 * 1024; p.sh = modl + 3 * 1024;
    p.wside = (const bf16*)(ws + WS_ROUTER_T) + (size_t)l * 64 * 1024; p.rbias = a->in[I_RB] + (size_t)l * 32;
    p.topi = route + R_TOPI; p.topw = (float*)(route + R_TOPW); p.hist = route + R_HIST + bx * 32; p.has_h = 1; p.has_side = 1; p.h8out = MOE_FP8 ? (ws + WS_H8) : nullptr;
    row_pass<1>(p, lds, tid, bx, G); }
__device__ __forceinline__ void ph_place(int wave_s) { PHASE_ENTER(); phase_place((int*)(ws + WS_ROUTE), lds, tid, bx, G); }
__device__ __forceinline__ void ph_moe_up(int wave_s, int l) { PHASE_ENTER(); int* route = (int*)(ws + WS_ROUTE); const int ntiles = __builtin_amdgcn_readfirstlane(route[R_NTILES]);
#if MOE_FP8
    Sched S; S.init(ntiles, 8, G, bx, ws + WS_WUP_T + (size_t)l * 32 * 2048 * 1024, (size_t)2048 * 1024, route + R_TILEE, 1024);
    EpiUp<true> E{ws + WS_ACT, a->in[I_BUP] + (size_t)l * 32 * 2048}; GEMM_BODY8_G(ws + WS_H8, route + R_BUFTOK, 1024, S, E); }
#else
    Sched S; S.init(ntiles, 8, G, bx, ws + WS_WUP_T + (size_t)l * 32 * 2048 * 2048, (size_t)2048 * 2048, route + R_TILEE, 2048);
    EpiUp<false> E{ws + WS_ACT, a->in[I_BUP] + (size_t)l * 32 * 2048}; GEMM_BODY_G(ws + WS_H, route + R_BUFTOK, 1024, S, E); }
#endif
__device__ __forceinline__ void ph_moe_down(int wave_s, int l) { PHASE_ENTER(); int* route = (int*)(ws + WS_ROUTE); const int ntiles = __builtin_amdgcn_readfirstlane(route[R_NTILES]);
#if MOE_FP8
    Sched S; S.init(ntiles, 4, G, bx, ws + WS_WDN_T + (size_t)l * 32 * 1024 * 1024, (size_t)1024 * 1024, route + R_TILEE, 1024);
    EpiDown E{(bf16*)(ws + WS_YS), a->in[I_BDN] + (size_t)l * 32 * 1024, 1.0f / (F8_WSCALE * F8_ASCALE)}; GEMM_BODY8(ws + WS_ACT, nullptr, 1024, S, E); }
#else
    Sched S; S.init(ntiles, 4, G, bx, ws + WS_WDN_T + (size_t)l * 32 * 1024 * 2048, (size_t)1024 * 2048, route + R_TILEE, 2048);
    EpiDown E{(bf16*)(ws + WS_YS), a->in[I_BDN] + (size_t)l * 32 * 1024, 1.0f}; GEMM_BODY(ws + WS_ACT, nullptr, 1024, S, E); }
#endif
__device__ __forceinline__ void ph_rp_end(int wave_s, int l) { PHASE_ENTER(); float* mod = (float*)(ws + WS_MOD); float* modl = mod + (size_t)l * 8 * 6144; int* route = (int*)(ws + WS_ROUTE);
    RowPass p{}; p.xin = (const float*)(ws + WS_X1); p.xout = (l == DEPTH - 1) ? a->out : (float*)(ws + WS_X2); p.hout = (bf16*)(ws + WS_H);
    p.gate = modl + 5 * 1024; p.lng = a->in[I_LNG] + (size_t)(l * 2 + 1) * 1024; p.lnb = a->in[I_LNB] + (size_t)(l * 2 + 1) * 1024;
    p.ys = (const bf16*)(ws + WS_YS); p.dest = route + R_DEST; p.tw = (const float*)(route + R_TOPW);
    if (l < DEPTH - 1) { float* modn = mod + (size_t)(l + 1) * 8 * 6144; p.sc = modn + 1 * 1024; p.sh = modn + 0 * 1024; p.has_h = 1;
        if (((l + 1) & 1) == 0) { p.has_side = 1; p.wside = (const bf16*)(ws + WS_GLALR_T) + (size_t)((l + 1) >> 1) * 64 * 1024; p.lr_out = (float*)(ws + WS_LR); } }
    row_pass<2>(p, lds, tid, bx, G); }

__global__ void __launch_bounds__(NTHREADS, 2) fwd_kernel(Args a) {
    extern __shared__ __attribute__((aligned(16))) unsigned char lds_raw[];
    LAS unsigned char* lds = (LAS unsigned char*)lds_raw;
    volatile LAS unsigned* MISC = (volatile LAS unsigned*)(lds + MISC_OFF);
    const int tid = threadIdx.x; const int wave_s = __builtin_amdgcn_readfirstlane(tid >> 6);
    if (tid < 32) ((LAS unsigned*)(lds + MISC_OFF))[tid] = 0u;
    __syncthreads();
    unsigned* ctl = (unsigned*)(a.ws + WS_CTL);
    XcdBarrier bar = xcd_barrier_post(ctl + CW_BAR + a.li * XCD_BAR_WORDS, MISC + 8);
    const int lo = a.ph_lo, hi = a.ph_hi;
#ifndef REPK
#define REPK 0
#define REPN 1
#endif
#define REP(kind) for (int rep_ = 0; rep_ < ((REPK == (kind)) ? REPN : 1); ++rep_)
#define IN(k) (lo <= (k) && (k) < hi)
#define SEAM(k) do { if (IN(k) && IN((k) + 1)) xcd_barrier(bar); } while (0)
    if (IN(0)) { REP(3) ph_prologue(wave_s); SEAM(0); }
    if (IN(1)) { ph_rp_init(wave_s); SEAM(1); }
    for (int l = 0; l < DEPTH; ++l) {
        const int pb = 2 + PH_PER_LAYER * l, li = l >> 1; const bool sgu = (l & 1) != 0;
        if (IN(pb + 0)) { REP(10) { if (!sgu) ph_gla_in(wave_s, li); else ph_sgu_in(wave_s, li); } SEAM(pb + 0); }
        if (IN(pb + 1)) { if (!sgu) { REP(12) ph_gla_prep(wave_s, li); SEAM(pb + 1); } }
        if (IN(pb + 2)) { if (!sgu) { REP(1) ph_gla_scan(wave_s); } else { REP(2) ph_sgu_core(wave_s, li); } SEAM(pb + 2); }
        if (IN(pb + 3)) { if (!sgu) { REP(6) ph_gla_post(wave_s, li); SEAM(pb + 3); } }
        if (IN(pb + 4)) { REP(11) ph_out(wave_s, l); SEAM(pb + 4); }
        if (IN(pb + 5)) { REP(4) ph_rp_mid(wave_s, l); SEAM(pb + 5); }
        if (IN(pb + 6)) { REP(7) ph_place(wave_s); SEAM(pb + 6); }
        if (IN(pb + 7)) { REP(8) ph_moe_up(wave_s, l); SEAM(pb + 7); }
        if (IN(pb + 8)) { REP(9) ph_moe_down(wave_s, l); SEAM(pb + 8); }
        if (IN(pb + 9)) { REP(5) ph_rp_end(wave_s, l); SEAM(pb + 9); }
    }
#undef IN
#undef SEAM
}

#ifndef N_LAUNCH_MODE
#define N_LAUNCH_MODE 1
#endif
extern "C" void kernel_launch(void* const* d_in, const int* in_sizes, int n_in, void* d_out, int out_size, void* d_ws, size_t ws_size, hipStream_t stream) {
    static int grid = 0;
    if (grid == 0) {
        if (n_in != 27 || out_size != T * D || ws_size < WS_END) { fprintf(stderr, "kernel_launch: unexpected shapes (n_in %d out %d ws %zu)\n", n_in, out_size, ws_size); grid = -1; return; }
        int dev = 0, cus = 0, per_cu = 0;
        if (hipGetDevice(&dev) != hipSuccess || hipDeviceGetAttribute(&cus, hipDeviceAttributeMultiprocessorCount, dev) != hipSuccess) { grid = -1; return; }
        if (hipFuncSetAttribute((const void*)fwd_kernel, hipFuncAttributeMaxDynamicSharedMemorySize, LDS_BYTES) != hipSuccess) { fprintf(stderr, "kernel_launch: hipFuncSetAttribute failed\n"); grid = -1; return; }
        if (hipOccupancyMaxActiveBlocksPerMultiprocessor(&per_cu, (const void*)fwd_kernel, NTHREADS, LDS_BYTES) != hipSuccess || per_cu < 1) fprintf(stderr, "kernel_launch: occupancy query reports %d\n", per_cu);
        (void)hipGetLastError();
        grid = cus;
        if (grid > 1024) grid = 1024;
    }
    if (grid < 0) return;
    (void)hipMemsetAsync((char*)d_ws + WS_CTL, 0, CTL_ZERO_BYTES, stream);
    Args a{};
    for (int i = 0; i < 27; ++i) a.in[i] = (const float*)d_in[i];
    a.out = (float*)d_out; a.ws = (unsigned char*)d_ws; a.pad = 0;
#if N_LAUNCH_MODE == 1
    a.ph_lo = 0; a.ph_hi = NPHASES; a.li = 0;
    hipLaunchKernelGGL(fwd_kernel, dim3(grid), dim3(NTHREADS), LDS_BYTES, stream, a);
#else
    for (int ph = 0, li = 0; ph < NPHASES; ++ph) {
        if (ph >= 2 && (((ph - 2) % PH_PER_LAYER) == 1 || ((ph - 2) % PH_PER_LAYER) == 3) && (((ph - 2) / PH_PER_LAYER) & 1)) continue;
        a.ph_lo = ph; a.ph_hi = ph + 1; a.li = li++;
        hipLaunchKernelGGL(fwd_kernel, dim3(grid), dim3(NTHREADS), LDS_BYTES, stream, a);
    }
#endif
}
```

```cpp
#include <hip/hip_runtime.h>
#include <cstdio>
#include <cstdint>

#define LAS __attribute__((address_space(3)))
#define GAS __attribute__((address_space(1)))
typedef unsigned short bf16;
typedef short bf16x8 __attribute__((ext_vector_type(8)));
typedef float f32x4 __attribute__((ext_vector_type(4)));
typedef float f32x2 __attribute__((ext_vector_type(2)));
typedef unsigned u32x4 __attribute__((ext_vector_type(4)));
typedef unsigned u32x2 __attribute__((ext_vector_type(2)));
typedef int i32x4 __attribute__((ext_vector_type(4)));
typedef int i32x8 __attribute__((ext_vector_type(8)));

#ifndef MOE_FP8
#define MOE_FP8 1
#endif
constexpr int D = 1024, NB = 8, SEQ = 4096, T = NB * SEQ, DEPTH = 4;
constexpr int NE = 32, TOPK = 4, CAP = T * TOPK + NE * 256;
constexpr int MAXTILES = CAP / 256;
constexpr float ALPHA = 1.681792830507429f;
constexpr float LN_EPS = 1e-5f;
constexpr float F8_WSCALE = 64.0f, F8_HSCALE = 8.0f, F8_ASCALE = 4.0f;
constexpr int GLA_IN = 3104, GLA_MAIN = 3072;
constexpr int NWAVES = 8, NTHREADS = 512;
constexpr int LDS_BYTES = 147456, MISC_OFF = 139264;

constexpr size_t MiB = 1u << 20;
constexpr size_t WS_CTL = 0, CTL_ZERO_BYTES = 2 * MiB;
constexpr size_t WS_MOD = 2 * MiB;
constexpr size_t WS_ROUTE = 4 * MiB;
constexpr size_t WS_LR = 8 * MiB;
constexpr size_t WS_GLAIN_T = 16 * MiB;
constexpr size_t WS_GLALR_T = 28 * MiB;
constexpr size_t WS_ROUTER_T = 29 * MiB;
constexpr size_t WS_SGUWS = 30 * MiB;
constexpr size_t WS_GLAOUT_T = 32 * MiB;
constexpr size_t WS_SGUIN_T = 36 * MiB;
constexpr size_t WS_SGUOUT_T = 44 * MiB;
constexpr size_t WS_WUP_T = 64 * MiB;
constexpr size_t WS_WDN_T = 576 * MiB;
constexpr size_t WS_X1 = 832 * MiB;
constexpr size_t WS_X2 = 960 * MiB;
constexpr size_t WS_H = 1088 * MiB;
constexpr size_t WS_BIG = 1152 * MiB;
constexpr size_t WS_OF = 1344 * MiB;
constexpr size_t WS_OB = 1408 * MiB;
constexpr size_t WS_A2 = 1472 * MiB;
constexpr size_t WS_Y = 1536 * MiB;
constexpr size_t WS_ACT = 1664 * MiB;
constexpr size_t WS_YS = 1936 * MiB;
constexpr size_t WS_QE = 2208 * MiB;
constexpr size_t WS_KET = 2272 * MiB;
constexpr size_t WS_P = 2336 * MiB;
constexpr size_t WS_VT = 2368 * MiB;
constexpr size_t WS_EL = 2432 * MiB;
constexpr size_t WS_H8 = 2440 * MiB;
constexpr size_t WS_END = 2472 * MiB;
constexpr int R_TOPI = 0;
constexpr int R_TOPW = T * 4;
constexpr int R_DEST = 2 * T * 4;
constexpr int R_BUFTOK = 3 * T * 4;
constexpr int R_HIST = R_BUFTOK + CAP;
constexpr int R_TILEE = R_HIST + 1024 * 32;
constexpr int R_NTILES = R_TILEE + 1024;
static_assert((size_t)(R_NTILES + 64) * 4 <= 4 * MiB, "route tables");
constexpr int CW_BAR = 4096;
constexpr int MAX_LAUNCH = 64;

#define RLX_AGENT __ATOMIC_RELAXED, __HIP_MEMORY_SCOPE_AGENT
#define LDS_WAIT() asm volatile("s_waitcnt lgkmcnt(0)" ::: "memory")
#define VM_WAIT() asm volatile("s_waitcnt vmcnt(0)" ::: "memory")
typedef __bf16 bf16x2_t __attribute__((ext_vector_type(2)));
__device__ __forceinline__ unsigned cvt_pk_bf16(float lo, float hi) { const f32x2 v = {lo, hi}; const bf16x2_t r = __builtin_convertvector(v, bf16x2_t); return __builtin_bit_cast(unsigned, r); }
__device__ __forceinline__ float bf_lo(unsigned w) { return __uint_as_float(w << 16); }
__device__ __forceinline__ float bf_hi(unsigned w) { return __uint_as_float(w & 0xffff0000u); }
__device__ __forceinline__ float bf2f(bf16 b) { return __uint_as_float(((unsigned)b) << 16); }
__device__ __forceinline__ float shfl_xor_f(float v, int o, int lane) { return __builtin_bit_cast(float, __builtin_amdgcn_ds_bpermute((lane ^ o) << 2, __builtin_bit_cast(int, v))); }
__device__ __forceinline__ int shfl_i(int v, int src, int lane) { (void)lane; return __builtin_amdgcn_ds_bpermute(src << 2, v); }
__device__ __forceinline__ float wave_sum(float v, int lane) {
#pragma unroll
    for (int o = 1; o < 64; o <<= 1) v += shfl_xor_f(v, o, lane);
    return v;
}
__device__ __forceinline__ float silu_f(float x) { return x * __builtin_amdgcn_rcpf(1.0f + __expf(-x)); }
__device__ __forceinline__ float sigmoid_f(float x) { return __builtin_amdgcn_rcpf(1.0f + __expf(-x)); }
__device__ __forceinline__ float gelu_f(float v) {
    const float av = fabsf(v), t = __builtin_amdgcn_rcpf(av * 0.2316418882f + 1.0f);
    float q = t * 0.5307027145f + (-0.7265760135f); q = q * t + 0.7107068705f; q = q * t + (-0.142248368f); q = q * t + 0.127414796f; q = q * t;
    const float e = __builtin_amdgcn_exp2f((v * v) * (-0.72134752044f));
    const float m = v * (q * e);
    return v < 0.f ? m : v - m;
}

#define XB_TMO      128
#define XB_XCNT(j)  (256  + 64 * (j))
#define XB_XSUB(j)  (1280 + 64 * (j))
#define XB_XGEN(j)  (2304 + 64 * (j))
#define XB_TOP      3328
#define XB_TOPGEN   3392
#define XCD_BAR_WORDS 3456
#define XB_SPIN_CAP (1u << 18)
__device__ __forceinline__ unsigned xb_ld(unsigned* p)              { return __hip_atomic_load(p, __ATOMIC_RELAXED, __HIP_MEMORY_SCOPE_AGENT); }
__device__ __forceinline__ unsigned xb_add(unsigned* p, unsigned v) { return __hip_atomic_fetch_add(p, v, __ATOMIC_RELAXED, __HIP_MEMORY_SCOPE_AGENT); }
__device__ __forceinline__ unsigned xb_xcc_id() { return (unsigned)__builtin_amdgcn_s_getreg((3 << 11) | 20) & 0xFu; }
#define XB_SPIN(cond, bar) do { unsigned _sp = 0; while (cond) { __builtin_amdgcn_s_sleep(1); \
    if ((++_sp & 255u) == 0u) { if (xb_ld(&(bar)[XB_TMO])) break; if (_sp > XB_SPIN_CAP) { atomicAdd(&(bar)[XB_TMO], 1u); break; } } } } while (0)
struct XcdBarrier { unsigned* bar; unsigned x; volatile LAS unsigned* st; };
__device__ __forceinline__ XcdBarrier xcd_barrier_post(unsigned* bar, volatile LAS unsigned* st) {
    XcdBarrier b; b.bar = bar; b.x = xb_xcc_id(); b.st = st;
    if (threadIdx.x == 0) (void)xb_add(&bar[XB_XCNT(b.x)], 1u);
    return b;
}
__device__ __forceinline__ void xcd_barrier_complete(unsigned* bar, unsigned x, unsigned& nloc, unsigned& nx) {
    const unsigned G = gridDim.x * gridDim.y * gridDim.z;
    unsigned sum, cnt, mine, sp = 0u;
    for (;;) {
        sum = 0u; cnt = 0u; mine = 0u;
#pragma unroll
        for (unsigned j = 0; j < 16; ++j) { const unsigned c = xb_ld(&bar[XB_XCNT(j)]); sum += c; cnt += (c > 0u) ? 1u : 0u; mine = (j == x) ? c : mine; }
        if (sum == G) break;
        __builtin_amdgcn_s_sleep(1);
        if ((++sp & 255u) == 0u) { if (xb_ld(&bar[XB_TMO])) break; if (sp > XB_SPIN_CAP) { atomicAdd(&bar[XB_TMO], 1u); break; } }
    }
    nloc = mine > 0u ? mine : 1u; nx = cnt > 0u ? cnt : 1u;
}
__device__ __forceinline__ void xcd_barrier(const XcdBarrier& b) {
    asm volatile("s_waitcnt vmcnt(0)" ::: "memory");
    __syncthreads();
    if (threadIdx.x == 0) {
        unsigned* bar = b.bar;
        __builtin_amdgcn_s_waitcnt(0);
        unsigned nloc = b.st[0], nx = b.st[1];
        if (nloc == 0u) { xcd_barrier_complete(bar, b.x, nloc, nx); b.st[0] = nloc; b.st[1] = nx; }
        const unsigned old = xb_add(&bar[XB_XSUB(b.x)], 1u);
        const unsigned gen = old / nloc;
        if (old + 1u == (gen + 1u) * nloc) {
            __builtin_amdgcn_fence(__ATOMIC_RELEASE, "agent");
            asm volatile("s_waitcnt vmcnt(0)" ::: "memory");
            const unsigned og = xb_add(&bar[XB_TOP], 1u);
            const unsigned tg = og / nx;
            if (og + 1u == (tg + 1u) * nx) xb_add(&bar[XB_TOPGEN], 1u);
            else XB_SPIN(xb_ld(&bar[XB_TOPGEN]) == tg, bar);
            __builtin_amdgcn_fence(__ATOMIC_ACQUIRE, "agent");
            xb_add(&bar[XB_XGEN(b.x)], 1u);
            asm volatile("s_waitcnt vmcnt(0)" ::: "memory");
        } else {
            XB_SPIN(xb_ld(&bar[XB_XGEN(b.x)]) == gen, bar);
            __builtin_amdgcn_fence(__ATOMIC_ACQUIRE, "agent");
            asm volatile("s_waitcnt vmcnt(0)" ::: "memory");
        }
    }
    __syncthreads();
}

struct Args { const float* in[27]; float* out; unsigned char* ws; int ph_lo, ph_hi, li, pad; };
enum { I_X = 0, I_C, I_ADAW, I_ADAB, I_LNG, I_LNB, I_GWIN, I_GWG2F, I_GBGF, I_GWG2B, I_GBGB, I_GNORM, I_GWOUT, I_SWIN, I_SBIN, I_SLNG, I_SLNB, I_SWS, I_SBS, I_SWOUT, I_SBOUT, I_RW, I_RB, I_WUP, I_BUP, I_WDN, I_BDN };

typedef const __attribute__((address_space(4))) Args* KA;
#define PHASE_ENTER() unsigned m1_ = ~0u; asm volatile("" : "+s"(m1_)); int tid = (wave_s << 6) | (int)__builtin_amdgcn_mbcnt_hi(m1_, __builtin_amdgcn_mbcnt_lo(m1_, 0u)); asm volatile("" : "+v"(tid)); int bx = blockIdx.x, G = gridDim.x; asm volatile("" : "+s"(bx), "+s"(G)); \
    KA a = (KA)__builtin_amdgcn_kernarg_segment_ptr(); asm volatile("" : "+s"(a)); unsigned char* ws = a->ws; \
    extern __shared__ __attribute__((aligned(16))) unsigned char lds_raw[]; LAS unsigned char* lds = (LAS unsigned char*)lds_raw; (void)lds; (void)ws; (void)bx; (void)G; (void)tid
__device__ __forceinline__ int swiglu_perm(int o) {
    const int a = o >> 1, h = o & 1, pn = a >> 7, r = a & 127, bj = r >> 6, r2 = r & 63, wc = r2 >> 4, r3 = r2 & 15;
    return 256 * pn + 128 * bj + 32 * wc + 16 * h + r3;
}
__device__ __forceinline__ void conv_tile(const float* W, int K, int N, int k0, int n0, int nw, bf16* dst, int mode, LAS float* scr, int lane) {
    const int c4 = lane & 15, kr = lane >> 4;
    if (4 * c4 < nw) {
#pragma unroll 4
        for (int i = 0; i < 16; ++i) { const int kk = 4 * i + kr; const f32x4 v = *(const f32x4*)(W + (size_t)(k0 + kk) * N + n0 + 4 * c4);
            LAS float* s = scr + kk * 65 + 4 * c4; s[0] = v[0]; s[1] = v[1]; s[2] = v[2]; s[3] = v[3]; }
    }
    LDS_WAIT(); asm volatile("" ::: "memory");
    const int kc = lane & 7, ns = lane >> 3;
    for (int j = 0; j < nw / 8; ++j) {
        const int n = ns + 8 * j; const LAS float* s = scr + (8 * kc) * 65 + n;
        float v[8];
#pragma unroll
        for (int q = 0; q < 8; ++q) v[q] = s[q * 65];
        u32x4 o; o.x = cvt_pk_bf16(v[0], v[1]); o.y = cvt_pk_bf16(v[2], v[3]); o.z = cvt_pk_bf16(v[4], v[5]); o.w = cvt_pk_bf16(v[6], v[7]);
        const int ng = n0 + n;
        if (mode >= 3) {
            const int row = (mode == 4) ? swiglu_perm(ng) : ng;
            int w0 = __builtin_amdgcn_cvt_pk_fp8_f32(v[0] * F8_WSCALE, v[1] * F8_WSCALE, 0, false); w0 = __builtin_amdgcn_cvt_pk_fp8_f32(v[2] * F8_WSCALE, v[3] * F8_WSCALE, w0, true);
            int w1 = __builtin_amdgcn_cvt_pk_fp8_f32(v[4] * F8_WSCALE, v[5] * F8_WSCALE, 0, false); w1 = __builtin_amdgcn_cvt_pk_fp8_f32(v[6] * F8_WSCALE, v[7] * F8_WSCALE, w1, true);
            *(u32x2*)((unsigned char*)dst + (size_t)row * K + k0 + 8 * kc) = (u32x2){(unsigned)w0, (unsigned)w1};
        } else if (mode == 2) {
            *(u32x4*)(dst + (size_t)n * K + k0 + 8 * kc) = o;
            u32x4 l; l.x = cvt_pk_bf16(v[0] - bf_lo(o.x), v[1] - bf_hi(o.x)); l.y = cvt_pk_bf16(v[2] - bf_lo(o.y), v[3] - bf_hi(o.y));
            l.z = cvt_pk_bf16(v[4] - bf_lo(o.z), v[5] - bf_hi(o.z)); l.w = cvt_pk_bf16(v[6] - bf_lo(o.w), v[7] - bf_hi(o.w));
            *(u32x4*)(dst + (size_t)(32 + n) * K + k0 + 8 * kc) = l;
        } else {
            const int row = (mode == 1) ? swiglu_perm(ng) : ng;
            *(u32x4*)(dst + (size_t)row * K + k0 + 8 * kc) = o;
        }
    }
    LDS_WAIT(); asm volatile("" ::: "memory");
}

__device__ __forceinline__ void phase_prologue(KA a, LAS unsigned char* lds, int tid, int bx, int G) {
    const int lane = tid & 63, wave = __builtin_amdgcn_readfirstlane(tid >> 6);
    unsigned char* ws = a->ws;
    for (int slab = bx; slab < 192; slab += G) {
        LAS float* sc = (LAS float*)lds;
        LAS float* red = (LAS float*)(lds + 32768);
        for (int i = tid; i < 8 * 1024; i += NTHREADS) sc[i] = silu_f(a->in[I_C][i]);
        __syncthreads();
        const int g0 = slab * 128, l = g0 / 6144, e0 = g0 % 6144;
        const int c4 = tid & 31, seg = tid >> 5;
        f32x4 acc[8];
#pragma unroll
        for (int b = 0; b < 8; ++b) acc[b] = (f32x4){0.f, 0.f, 0.f, 0.f};
        const float* wp = a->in[I_ADAW] + ((size_t)l * 1024 + seg * 64) * 6144 + e0 + 4 * c4;
#pragma unroll 8
        for (int d = 0; d < 64; ++d) { const f32x4 w = *(const f32x4*)(wp + (size_t)d * 6144);
#pragma unroll
            for (int b = 0; b < 8; ++b) acc[b] += w * sc[b * 1024 + seg * 64 + d]; }
#pragma unroll
        for (int b = 0; b < 8; ++b) *(LAS f32x4*)(red + (seg * 8 + b) * 128 + 4 * c4) = acc[b];
        __syncthreads();
        for (int o = tid; o < 1024; o += NTHREADS) { const int b = o >> 7, c = o & 127; float s = a->in[I_ADAB][l * 6144 + e0 + c];
#pragma unroll
            for (int sg = 0; sg < 16; ++sg) s += red[(sg * 8 + b) * 128 + c];
            ((float*)(ws + WS_MOD))[((size_t)l * 8 + b) * 6144 + e0 + c] = s; }
        __syncthreads();
    }
    LAS float* scr = (LAS float*)(lds + wave * 16640);
    const int gw = bx * NWAVES + wave, NGW = G * NWAVES;
    constexpr int N_UP = 128 * 16 * 32, N_DN = 128 * 16 * 16, N_GIN = 2 * 16 * 48, N_GLR = 2 * 16, N_GOUT = 2 * 256, N_SIN = 2 * 16 * 32, N_SOUT = 2 * 256, N_RT = 4 * 16;
    constexpr int NITEMS = N_UP + N_DN + N_GIN + N_GLR + N_GOUT + N_SIN + N_SOUT + N_RT;
    for (int it = gw; it < NITEMS; it += NGW) {
        int r = it;
        if (r < N_UP) { const int m = r >> 9, q = r & 511, kt = q >> 5, nt = q & 31;
            conv_tile(a->in[I_WUP] + (size_t)m * 1024 * 2048, 1024, 2048, kt * 64, nt * 64, 64, (bf16*)(ws + WS_WUP_T + (size_t)m * 2048 * 1024 * (MOE_FP8 ? 1 : 2)), MOE_FP8 ? 4 : 1, scr, lane); continue; } r -= N_UP;
        if (r < N_DN) { const int m = r >> 8, q = r & 255, kt = q >> 4, nt = q & 15;
            conv_tile(a->in[I_WDN] + (size_t)m * 1024 * 1024, 1024, 1024, kt * 64, nt * 64, 64, (bf16*)(ws + WS_WDN_T + (size_t)m * 1024 * 1024 * (MOE_FP8 ? 1 : 2)), MOE_FP8 ? 3 : 0, scr, lane); continue; } r -= N_DN;
        if (r < N_GIN) { const int m = r / 768, q = r % 768, kt = q / 48, nt = q % 48;
            conv_tile(a->in[I_GWIN] + (size_t)m * 1024 * GLA_IN, 1024, GLA_IN, kt * 64, nt * 64, 64, (bf16*)(ws + WS_GLAIN_T) + (size_t)m * GLA_MAIN * 1024, 0, scr, lane); continue; } r -= N_GIN;
        if (r < N_GLR) { const int m = r >> 4, kt = r & 15;
            conv_tile(a->in[I_GWIN] + (size_t)m * 1024 * GLA_IN, 1024, GLA_IN, kt * 64, GLA_MAIN, 32, (bf16*)(ws + WS_GLALR_T) + (size_t)m * 64 * 1024, 2, scr, lane); continue; } r -= N_GLR;
        if (r < N_GOUT) { const int m = r >> 8, q = r & 255, kt = q >> 4, nt = q & 15;
            conv_tile(a->in[I_GWOUT] + (size_t)m * 1024 * 1024, 1024, 1024, kt * 64, nt * 64, 64, (bf16*)(ws + WS_GLAOUT_T) + (size_t)m * 1024 * 1024, 0, scr, lane); continue; } r -= N_GOUT;
        if (r < N_SIN) { const int m = r >> 9, q = r & 511, kt = q >> 5, nt = q & 31;
            conv_tile(a->in[I_SWIN] + (size_t)m * 1024 * 2048, 1024, 2048, kt * 64, nt * 64, 64, (bf16*)(ws + WS_SGUIN_T) + (size_t)m * 2048 * 1024, 0, scr, lane); continue; } r -= N_SIN;
        if (r < N_SOUT) { const int m = r >> 8, q = r & 255, kt = q >> 4, nt = q & 15;
            conv_tile(a->in[I_SWOUT] + (size_t)m * 1024 * 1024, 1024, 1024, kt * 64, nt * 64, 64, (bf16*)(ws + WS_SGUOUT_T) + (size_t)m * 1024 * 1024, 0, scr, lane); continue; } r -= N_SOUT;
        { const int m = r >> 4, kt = r & 15;
            conv_tile(a->in[I_RW] + (size_t)m * 1024 * 32, 1024, 32, kt * 64, 0, 32, (bf16*)(ws + WS_ROUTER_T) + (size_t)m * 64 * 1024, 2, scr, lane); }
    }
    { bf16* d = (bf16*)(ws + WS_SGUWS); const float* s = a->in[I_SWS];
      for (int i = (bx * NTHREADS + tid) * 4; i < 2 * 8 * 128 * 128; i += G * NTHREADS * 4) { const f32x4 v = *(const f32x4*)(s + i); u32x2 o; o.x = cvt_pk_bf16(v[0], v[1]); o.y = cvt_pk_bf16(v[2], v[3]); *(u32x2*)(d + i) = o; } }
}

struct RowPass {
    const void* xin; const bf16* y; void* xout; bf16* hout; unsigned char* h8out; int xin16, xout16;
    const float* gate; const float* lng; const float* lnb; const float* sc; const float* sh;
    const bf16* wside;
    float* lr_out;
    const float* rbias;
    int* topi; float* topw; int* hist;
    const bf16* ys; const int* dest; const float* tw;
    int has_h, has_side;
};
template <int MODE>
__device__ __forceinline__ void row_pass(const RowPass& p, LAS unsigned char* lds, int tid, int bx, int G) {
    const int lane = tid & 63, wave = __builtin_amdgcn_readfirstlane(tid >> 6);
    constexpr int HS = 1032;
    LAS bf16* Hhi = (LAS bf16*)lds;
    LAS bf16* Hlo = (LAS bf16*)(lds + 16 * HS * 2);
    LAS float* part = (LAS float*)(lds + 2 * 16 * HS * 2);
    LAS float* logit = part + 8 * 32 * 16;
    LAS int* lhist = (LAS int*)(logit + 16 * 32);
    if (MODE == 1) { if (tid < 32) lhist[tid] = 0; }
    const bool side = (p.has_side != 0) && (p.wside != nullptr);
    bf16x8 whi[2][4], wlo[2][4];
    if (side) {
#pragma unroll
        for (int hf = 0; hf < 2; ++hf)
#pragma unroll
            for (int s = 0; s < 4; ++s) { const size_t off = (size_t)(hf * 16 + (lane & 15)) * 1024 + 128 * wave + 32 * s + 8 * (lane >> 4);
                whi[hf][s] = *(const bf16x8*)(p.wside + off); wlo[hf][s] = *(const bf16x8*)(p.wside + 32 * 1024 + off); }
    }
    for (int tile = bx; tile < T / 16; tile += G) {
        const int b = (tile * 16) / SEQ;
#pragma unroll 1
        for (int tt = 0; tt < 2; ++tt) {
            const int tl = 2 * wave + tt, token = tile * 16 + tl;
            f32x4 v[4];
            if (p.xin16) { const bf16* xr = (const bf16*)p.xin + (size_t)token * D + 4 * lane;
#pragma unroll
                for (int j = 0; j < 4; ++j) { const u32x2 q = *(const u32x2*)(xr + 256 * j); v[j] = (f32x4){bf_lo(q.x), bf_hi(q.x), bf_lo(q.y), bf_hi(q.y)}; } }
            else { const float* xr = (const float*)p.xin + (size_t)token * D + 4 * lane;
#pragma unroll
                for (int j = 0; j < 4; ++j) v[j] = *(const f32x4*)(xr + 256 * j); }
            if (MODE == 1) {
                const bf16* yr = p.y + (size_t)token * D + 4 * lane; const float* gp = p.gate + (size_t)b * 6144 + 4 * lane;
#pragma unroll
                for (int j = 0; j < 4; ++j) { const u32x2 yq = *(const u32x2*)(yr + 256 * j); const f32x4 yy = (f32x4){bf_lo(yq.x), bf_hi(yq.x), bf_lo(yq.y), bf_hi(yq.y)}; const f32x4 g = *(const f32x4*)(gp + 256 * j); v[j] = v[j] * ALPHA + (g + 1.0f) * yy; }
            }
            if (MODE == 2) {
                f32x4 ya[4];
#pragma unroll
                for (int j = 0; j < 4; ++j) ya[j] = (f32x4){0.f, 0.f, 0.f, 0.f};
#pragma unroll
                for (int k = 0; k < 4; ++k) { const int ds = p.dest[token * 4 + k]; const float w = p.tw[token * 4 + k]; const bf16* yr = p.ys + (size_t)ds * D + 4 * lane;
#pragma unroll
                    for (int j = 0; j < 4; ++j) { const u32x2 q = *(const u32x2*)(yr + 256 * j); ya[j] += (f32x4){bf_lo(q.x), bf_hi(q.x), bf_lo(q.y), bf_hi(q.y)} * w; } }
                const float* gp = p.gate + (size_t)b * 6144 + 4 * lane;
#pragma unroll
                for (int j = 0; j < 4; ++j) { const f32x4 g = *(const f32x4*)(gp + 256 * j); v[j] = v[j] * ALPHA + (g + 1.0f) * ya[j]; }
            }
            if (MODE != 0) {
                float s = 0.f;
#pragma unroll
                for (int j = 0; j < 4; ++j) s += (v[j][0] + v[j][1]) + (v[j][2] + v[j][3]);
                const float mean = wave_sum(s, lane) * (1.0f / D); float s2 = 0.f;
#pragma unroll
                for (int j = 0; j < 4; ++j) { v[j] = v[j] - mean; s2 += (v[j][0] * v[j][0] + v[j][1] * v[j][1]) + (v[j][2] * v[j][2] + v[j][3] * v[j][3]); }
                const float rstd = 1.0f / sqrtf(wave_sum(s2, lane) * (1.0f / D) + LN_EPS);
#pragma unroll
                for (int j = 0; j < 4; ++j) { const f32x4 g = *(const f32x4*)(p.lng + 4 * lane + 256 * j), bb = *(const f32x4*)(p.lnb + 4 * lane + 256 * j); v[j] = v[j] * rstd * g + bb; }
                if (p.xout16) { bf16* xo = (bf16*)p.xout + (size_t)token * D + 4 * lane;
#pragma unroll
                    for (int j = 0; j < 4; ++j) { u32x2 o; o.x = cvt_pk_bf16(v[j][0], v[j][1]); o.y = cvt_pk_bf16(v[j][2], v[j][3]); *(u32x2*)(xo + 256 * j) = o; } }
                else { float* xo = (float*)p.xout + (size_t)token * D + 4 * lane;
#pragma unroll
                    for (int j = 0; j < 4; ++j) *(f32x4*)(xo + 256 * j) = v[j]; }
            }
            if (p.has_h) {
                const float* scp = p.sc + (size_t)b * 6144 + 4 * lane; const float* shp = p.sh + (size_t)b * 6144 + 4 * lane;
                bf16* ho = p.hout + (size_t)token * D + 4 * lane;
#pragma unroll
                for (int j = 0; j < 4; ++j) { const f32x4 s1 = *(const f32x4*)(scp + 256 * j), s0 = *(const f32x4*)(shp + 256 * j); const f32x4 h = v[j] * (s1 + 1.0f) + s0;
                    u32x2 o; o.x = cvt_pk_bf16(h[0], h[1]); o.y = cvt_pk_bf16(h[2], h[3]); *(u32x2*)(ho + 256 * j) = o;
                    if (MODE == 1 && p.h8out) { int w8 = __builtin_amdgcn_cvt_pk_fp8_f32(h[0] * F8_HSCALE, h[1] * F8_HSCALE, 0, false); w8 = __builtin_amdgcn_cvt_pk_fp8_f32(h[2] * F8_HSCALE, h[3] * F8_HSCALE, w8, true); *(int*)(p.h8out + (size_t)token * D + 4 * lane + 256 * j) = w8; }
                    if (side) { u32x2 l; l.x = cvt_pk_bf16(h[0] - bf_lo(o.x), h[1] - bf_hi(o.x)); l.y = cvt_pk_bf16(h[2] - bf_lo(o.y), h[3] - bf_hi(o.y));
                        *(LAS u32x2*)(Hhi + tl * HS + 4 * lane + 256 * j) = o; *(LAS u32x2*)(Hlo + tl * HS + 4 * lane + 256 * j) = l; } }
            }
        }
        if (side) {
            __syncthreads();
            f32x4 acc[2]; acc[0] = (f32x4){0.f, 0.f, 0.f, 0.f}; acc[1] = acc[0];
#pragma unroll
            for (int s = 0; s < 4; ++s) { const int ko = (lane & 15) * HS + 128 * wave + 32 * s + 8 * (lane >> 4);
                const bf16x8 bh = *(const LAS bf16x8*)(Hhi + ko), bl = *(const LAS bf16x8*)(Hlo + ko);
#pragma unroll
                for (int hf = 0; hf < 2; ++hf) { acc[hf] = __builtin_amdgcn_mfma_f32_16x16x32_bf16(whi[hf][s], bh, acc[hf], 0, 0, 0);
                    acc[hf] = __builtin_amdgcn_mfma_f32_16x16x32_bf16(wlo[hf][s], bh, acc[hf], 0, 0, 0); acc[hf] = __builtin_amdgcn_mfma_f32_16x16x32_bf16(whi[hf][s], bl, acc[hf], 0, 0, 0); } }
#pragma unroll
            for (int hf = 0; hf < 2; ++hf)
#pragma unroll
                for (int j = 0; j < 4; ++j) part[(wave * 32 + hf * 16 + 4 * (lane >> 4) + j) * 16 + (lane & 15)] = acc[hf][j];
            __syncthreads();
            { const int e = tid >> 4, tk = tid & 15; float s = 0.f;
#pragma unroll
              for (int w = 0; w < 8; ++w) s += part[(w * 32 + e) * 16 + tk];
              if (MODE == 1) logit[tk * 32 + e] = s + p.rbias[e];
              else p.lr_out[(size_t)(tile * 16 + tk) * 32 + e] = s; }
            if (MODE == 1) {
                __syncthreads();
                if (tid < 16) {
                    const int token = tile * 16 + tid; float lv[32];
#pragma unroll
                    for (int e = 0; e < 32; ++e) lv[e] = logit[tid * 32 + e];
                    int bi[4]; float bv[4];
#pragma unroll
                    for (int k = 0; k < 4; ++k) { float m = -3.0e38f; int mi = 0;
#pragma unroll
                        for (int e = 0; e < 32; ++e) { const bool take = lv[e] > m; m = take ? lv[e] : m; mi = take ? e : mi; }
                        bi[k] = mi; bv[k] = m;
#pragma unroll
                        for (int e = 0; e < 32; ++e) lv[e] = (e == mi) ? -3.0e38f : lv[e]; }
                    const float e1 = __expf(bv[1] - bv[0]), e2 = __expf(bv[2] - bv[0]), e3 = __expf(bv[3] - bv[0]); const float inv = 1.0f / (1.0f + e1 + e2 + e3);
                    *(int4*)(p.topi + token * 4) = make_int4(bi[0], bi[1], bi[2], bi[3]);
                    *(f32x4*)(p.topw + token * 4) = (f32x4){inv, e1 * inv, e2 * inv, e3 * inv};
#pragma unroll
                    for (int k = 0; k < 4; ++k) atomicAdd((int*)&lhist[bi[k]], 1);
                }
            }
            __syncthreads();
        }
    }
    if (MODE == 1) { __syncthreads(); if (tid < 32) p.hist[tid] = lhist[tid]; }
}

__device__ __forceinline__ void phase_place(int* route, LAS unsigned char* lds, int tid, int bx, int G) {
    const int lane = tid & 63, wave = tid >> 6;
    LAS int* ptot = (LAS int*)lds;
    LAS int* ppre = ptot + 512;
    LAS int* tot = ppre + 512;
    LAS int* pre = tot + 32;
    LAS int* pstart = pre + 32;
    const int* hist = route + R_HIST;
    { const int e = tid & 31, part = tid >> 5; int st = 0, sp = 0;
      for (int bb = part; bb < G; bb += 16) { const int h = hist[bb * 32 + e]; st += h; if (bb < bx) sp += h; }
      ptot[part * 32 + e] = st; ppre[part * 32 + e] = sp; }
    __syncthreads();
    if (tid < 32) { int st = 0, sp = 0;
#pragma unroll
        for (int q = 0; q < 16; ++q) { st += ptot[q * 32 + tid]; sp += ppre[q * 32 + tid]; }
        tot[tid] = st; pre[tid] = sp; }
    __syncthreads();
    if (tid == 0) { int acc = 0; for (int e = 0; e < 32; ++e) { pstart[e] = acc; acc += (tot[e] + 255) / 256 * 256; } pstart[32] = acc; }
    __syncthreads();
    if (bx == 0) {
        const int ntiles = pstart[32] / 256;
        if (tid == 0) route[R_NTILES] = ntiles;
        for (int t = tid; t < ntiles; t += NTHREADS) { int e = 0; for (int q = 1; q < 32; ++q) if (pstart[q] <= t * 256) e = q; route[R_TILEE + t] = e; }
    }
    for (int e = bx; e < 32; e += G) { const int s0 = pstart[e] + tot[e], s1 = pstart[e + 1]; for (int s = s0 + tid; s < s1; s += NTHREADS) route[R_BUFTOK + s] = 0; }
    if (wave == 0) {
        int run = 0;
        for (int tile = bx; tile < T / 16; tile += G) {
            const int token = tile * 16 + (lane >> 2);
            const int e = route[R_TOPI + tile * 64 + lane];
            const int base = shfl_i(run, e, lane);
            int rank = 0, add = 0;
#pragma unroll 1
            for (int x = 0; x < 32; ++x) { const unsigned long long m = __ballot(e == x); if (e == x) rank = __popcll(m & ((1ull << lane) - 1ull)); if (lane == x) add = __popcll(m); }
            run += add;
            const int ds = pstart[e] + pre[e] + base + rank;
            route[R_DEST + tile * 64 + lane] = ds;
            route[R_BUFTOK + ds] = token;
        }
    }
}

struct Unit { int pm, pn, e; const char* bt; };
constexpr int NXCD = 8, WGM = 8;
struct Sched {
    int nM, nN, nwg, G, c; const char* Bt; size_t estride; const int* tile_e; int KB;
    __device__ __forceinline__ void init(int nM_, int nN_, int G_, int c_, const void* Bt_, size_t es, const int* te, int KB_) { nM = nM_; nN = nN_; nwg = nM * nN; G = G_; c = c_; Bt = (const char*)Bt_; estride = es; tile_e = te; KB = KB_; }
    __device__ __forceinline__ bool next(int i, Unit& u) const {
        const long L = (long)i * G + c; if (L >= nwg) return false;
        int wgid = (int)L; { const int q = nwg / NXCD, r = nwg % NXCD, xcd = wgid % NXCD, off = wgid / NXCD; wgid = (xcd < r ? xcd * (q + 1) : r * (q + 1) + (xcd - r) * q) + off; }
        const int nig = WGM * nN, gid = wgid / nig, fm = gid * WGM, gsz = (nM - fm) < WGM ? (nM - fm) : WGM;
        u.pm = fm + ((wgid % nig) % gsz); u.pn = (wgid % nig) / gsz;
        u.e = tile_e ? __builtin_amdgcn_readfirstlane(tile_e[u.pm]) : 0;
        u.bt = Bt + (size_t)u.e * estride + (size_t)u.pn * 256 * KB;
        return true;
    }
};
struct EpiGlaIn { bf16* O;
    __device__ __forceinline__ const float* bias_ptr(const Unit&) const { return nullptr; }
    __device__ __forceinline__ void operator()(const f32x4 (&acc)[2][2][4][2], const Unit& u, int wr, int wc, int fr, int fq, const LAS float*) const {
        const int row0 = u.pm * 256 + wr * 64 + fr, col0 = u.pn * 256 + wc * 32 + 4 * fq; const float sc = (u.pn < 2) ? 0.08838834764831845f : 1.0f;
#pragma unroll
        for (int ai = 0; ai < 2; ++ai)
#pragma unroll
            for (int m = 0; m < 4; ++m) { bf16* rp = O + (size_t)(row0 + ai * 128 + m * 16) * GLA_MAIN + col0;
#pragma unroll
                for (int bj = 0; bj < 2; ++bj)
#pragma unroll
                    for (int n = 0; n < 2; ++n) { const f32x4 v = acc[ai][bj][m][n] * sc; u32x2 o; o.x = cvt_pk_bf16(v[0], v[1]); o.y = cvt_pk_bf16(v[2], v[3]); *(u32x2*)(rp + bj * 128 + n * 16) = o; } }
    }
};
struct EpiSguIn { bf16* O; const float* bias;
    __device__ __forceinline__ const float* bias_ptr(const Unit& u) const { return bias + u.pn * 256; }
    __device__ __forceinline__ void operator()(const f32x4 (&acc)[2][2][4][2], const Unit& u, int wr, int wc, int fr, int fq, const LAS float* lb) const {
        const int row0 = u.pm * 256 + wr * 64 + fr, col0 = u.pn * 256 + wc * 32 + 4 * fq;
        f32x4 bv[2][2];
#pragma unroll
        for (int bj = 0; bj < 2; ++bj)
#pragma unroll
            for (int n = 0; n < 2; ++n) bv[bj][n] = *(const LAS f32x4*)(lb + wc * 32 + 4 * fq + bj * 128 + n * 16);
#pragma unroll
        for (int ai = 0; ai < 2; ++ai)
#pragma unroll
            for (int m = 0; m < 4; ++m) { bf16* rp = O + (size_t)(row0 + ai * 128 + m * 16) * 2048 + col0;
#pragma unroll
                for (int bj = 0; bj < 2; ++bj)
#pragma unroll
                    for (int n = 0; n < 2; ++n) { const f32x4 v = acc[ai][bj][m][n] + bv[bj][n]; u32x2 o; o.x = cvt_pk_bf16(gelu_f(v[0]), gelu_f(v[1])); o.y = cvt_pk_bf16(gelu_f(v[2]), gelu_f(v[3])); *(u32x2*)(rp + bj * 128 + n * 16) = o; } }
    }
};
struct EpiOut { bf16* O; const float* bias;
    __device__ __forceinline__ const float* bias_ptr(const Unit& u) const { return bias ? bias + u.pn * 256 : nullptr; }
    __device__ __forceinline__ void operator()(const f32x4 (&acc)[2][2][4][2], const Unit& u, int wr, int wc, int fr, int fq, const LAS float* lb) const {
        const int row0 = u.pm * 256 + wr * 64 + fr, col0 = u.pn * 256 + wc * 32 + 4 * fq;
        f32x4 bv[2][2];
#pragma unroll
        for (int bj = 0; bj < 2; ++bj)
#pragma unroll
            for (int n = 0; n < 2; ++n) bv[bj][n] = bias ? *(const LAS f32x4*)(lb + wc * 32 + 4 * fq + bj * 128 + n * 16) : (f32x4){0.f, 0.f, 0.f, 0.f};
#pragma unroll
        for (int ai = 0; ai < 2; ++ai)
#pragma unroll
            for (int m = 0; m < 4; ++m) { bf16* rp = O + (size_t)(row0 + ai * 128 + m * 16) * D + col0;
#pragma unroll
                for (int bj = 0; bj < 2; ++bj)
#pragma unroll
                    for (int n = 0; n < 2; ++n) { const f32x4 v = acc[ai][bj][m][n] + bv[bj][n]; u32x2 o; o.x = cvt_pk_bf16(v[0], v[1]); o.y = cvt_pk_bf16(v[2], v[3]); *(u32x2*)(rp + bj * 128 + n * 16) = o; } }
    }
};
template <bool F8> struct EpiUp { unsigned char* O; const float* bias;
    __device__ __forceinline__ const float* bias_ptr(const Unit& u) const { return bias + (size_t)u.e * 2048 + u.pn * 256; }
    __device__ __forceinline__ void operator()(const f32x4 (&acc)[2][2][4][2], const Unit& u, int wr, int wc, int fr, int fq, const LAS float* lb) const {
        const int row0 = u.pm * 256 + wr * 64 + fr, a0 = u.pn * 128 + wc * 16 + 4 * fq;
        const float asc = F8 ? 1.0f / (F8_WSCALE * F8_HSCALE) : 1.0f;
        f32x4 bg[2], bl[2];
#pragma unroll
        for (int bj = 0; bj < 2; ++bj) { const LAS float* bp = lb + 2 * (wc * 16 + 4 * fq + 64 * bj); const f32x4 p0 = *(const LAS f32x4*)bp, p1 = *(const LAS f32x4*)(bp + 4);
            bg[bj] = (f32x4){p0[0], p0[2], p1[0], p1[2]}; bl[bj] = (f32x4){p0[1], p0[3], p1[1], p1[3]}; }
#pragma unroll
        for (int ai = 0; ai < 2; ++ai)
#pragma unroll
            for (int m = 0; m < 4; ++m) { const size_t ro = (size_t)(row0 + ai * 128 + m * 16) * D + a0;
#pragma unroll
                for (int bj = 0; bj < 2; ++bj) { const f32x4 g = acc[ai][bj][m][0] * asc + bg[bj], l = acc[ai][bj][m][1] * asc + bl[bj]; float r[4];
#pragma unroll
                    for (int j = 0; j < 4; ++j) { const float gg = fminf(g[j], 7.0f), ll = fminf(fmaxf(l[j], -7.0f), 7.0f); r[j] = gg * sigmoid_f(1.702f * gg) * (ll + 1.0f); }
                    if constexpr (F8) { int w = __builtin_amdgcn_cvt_pk_fp8_f32(r[0] * F8_ASCALE, r[1] * F8_ASCALE, 0, false); w = __builtin_amdgcn_cvt_pk_fp8_f32(r[2] * F8_ASCALE, r[3] * F8_ASCALE, w, true);
                        *(int*)(O + ro + bj * 64) = w; }
                    else { u32x2 o; o.x = cvt_pk_bf16(r[0], r[1]); o.y = cvt_pk_bf16(r[2], r[3]); *(u32x2*)((bf16*)O + ro + bj * 64) = o; } } }
    }
};
struct EpiDown { bf16* O; const float* bias; float asc;
    __device__ __forceinline__ const float* bias_ptr(const Unit& u) const { return bias + (size_t)u.e * 1024 + u.pn * 256; }
    __device__ __forceinline__ void operator()(const f32x4 (&acc)[2][2][4][2], const Unit& u, int wr, int wc, int fr, int fq, const LAS float* lb) const {
        const int row0 = u.pm * 256 + wr * 64 + fr, col0 = u.pn * 256 + wc * 32 + 4 * fq;
        f32x4 bv[2][2];
#pragma unroll
        for (int bj = 0; bj < 2; ++bj)
#pragma unroll
            for (int n = 0; n < 2; ++n) bv[bj][n] = *(const LAS f32x4*)(lb + wc * 32 + 4 * fq + bj * 128 + n * 16);
#pragma unroll
        for (int ai = 0; ai < 2; ++ai)
#pragma unroll
            for (int m = 0; m < 4; ++m) { bf16* rp = O + (size_t)(row0 + ai * 128 + m * 16) * D + col0;
#pragma unroll
                for (int bj = 0; bj < 2; ++bj)
#pragma unroll
                    for (int n = 0; n < 2; ++n) { const f32x4 v = acc[ai][bj][m][n] * asc + bv[bj][n]; u32x2 o; o.x = cvt_pk_bf16(v[0], v[1]); o.y = cvt_pk_bf16(v[2], v[3]); *(u32x2*)(rp + bj * 128 + n * 16) = o; } }
    }
};

constexpr int G8_BK = 64, G8_HALF = 128, G8_HTB = G8_HALF * G8_BK * 2, G8_STAGE_BYTES = 8 * G8_HTB;
__device__ __forceinline__ int g8_lds_byte(int r, int c) { const int st = (r >> 4) * 2 + (c >> 5), rr = r & 15, cc = c & 31, ob = rr * 64 + cc * 2; return st * 1024 + (ob ^ (((ob >> 9) & 1) << 5)); }
__device__ __forceinline__ void g8_stage_rc(int b, int& R, int& C) { const int st = b / 1024, sb = b % 1024, swz = sb ^ (((sb >> 9) & 1) << 5); R = (st >> 1) * 16 + swz / 64; C = (st & 1) * 32 + (swz % 64) / 2; }
__device__ __forceinline__ u32x4 g8_avoff(int pm, const int* gather, int tid, int KB) {
    int t2 = tid; asm volatile("" : "+v"(t2));
    int R, C; g8_stage_rc(t2 * 16, R, C);
    const int* gp = gather + pm * 256 + R;
    const unsigned r00 = gp[0], r01 = gp[64], r10 = gp[128], r11 = gp[192], c2 = (unsigned)(C * 2), k2 = (unsigned)KB;
    return (u32x4){r00 * k2 + c2, r01 * k2 + c2, r10 * k2 + c2, r11 * k2 + c2};
}
template <bool GATHER, bool FP8, class Epi>
__device__ __forceinline__ void gemm_fast(const void* A, const int* gather, const int K, const Sched& S, const Epi& E, LAS unsigned char* lds, int tid) {
    const int wid = __builtin_amdgcn_readfirstlane(tid >> 6), lane = tid & 63, wr = wid >> 2, wc = wid & 3, fr = lane & 15, fq = lane >> 4;
    const int KB = FP8 ? K : 2 * K, nt = KB / 128;
    unsigned voff; { int R, C; g8_stage_rc(tid * 16, R, C); voff = (unsigned)(R * KB + C * 2); }
    const size_t kstep = (size_t)128, hstep = (size_t)G8_HALF * KB, qstep = (size_t)64 * KB, tstep = 2 * hstep;
    const unsigned ldsw = (unsigned)wid * 1024u;
    const int aoff = g8_lds_byte(wr * 64 + fr, fq * (FP8 ? 16 : 8)), boff = g8_lds_byte(wc * 32 + fr, fq * (FP8 ? 16 : 8));
    constexpr int KSTR = FP8 ? 16 : 1024;
#define G8_SA(b, h) (((b) * 2 + (h)) * G8_HTB)
#define G8_SB(b, h) ((4 + (b) * 2 + (h)) * G8_HTB)
#define G8_GLDS(gp, ldsoff) __builtin_amdgcn_global_load_lds((const unsigned*)(gp), (LAS unsigned*)(lds + (ldsoff)), 16, 0, 0)
#define G8_STAGE_D(bufoff, gbase) do { G8_GLDS((const char*)(gbase) + voff, (bufoff) + ldsw); G8_GLDS((const char*)(gbase) + qstep + voff, (bufoff) + ldsw + 8192); } while (0)
#define G8_STAGE_A(bufoff, kb, h) do { if constexpr (GATHER) { G8_GLDS((kb) + va[(h) * 2], (bufoff) + ldsw); G8_GLDS((kb) + va[(h) * 2 + 1], (bufoff) + ldsw + 8192); } \
        else { G8_STAGE_D(bufoff, (kb) + (h) * hstep); } } while (0)
#define G8_LDA(dst, b, h) do { _Pragma("unroll") for (int m = 0; m < 4; ++m) _Pragma("unroll") for (int k = 0; k < 2; ++k) dst[m][k] = *(const LAS bf16x8*)(lds + G8_SA(b, h) + aoff + m * 2048 + k * KSTR); } while (0)
#define G8_LDB(dst, b, h) do { _Pragma("unroll") for (int n = 0; n < 2; ++n) _Pragma("unroll") for (int k = 0; k < 2; ++k) dst[n][k] = *(const LAS bf16x8*)(lds + G8_SB(b, h) + boff + n * 2048 + k * KSTR); } while (0)
#define G8_CAT(x) __builtin_shufflevector(__builtin_bit_cast(i32x4, (x)[0]), __builtin_bit_cast(i32x4, (x)[1]), 0, 1, 2, 3, 4, 5, 6, 7)
#define G8_MMA(ai, bj, At, Bt) do { __builtin_amdgcn_s_setprio(1); _Pragma("unroll") for (int m = 0; m < 4; ++m) _Pragma("unroll") for (int n = 0; n < 2; ++n) { \
        if constexpr (FP8) acc[ai][bj][m][n] = __builtin_amdgcn_mfma_scale_f32_16x16x128_f8f6f4(G8_CAT(Bt[n]), G8_CAT(At[m]), acc[ai][bj][m][n], 0, 0, 0, 0x7f7f7f7f, 0, 0x7f7f7f7f); \
        else { _Pragma("unroll") for (int k = 0; k < 2; ++k) acc[ai][bj][m][n] = __builtin_amdgcn_mfma_f32_16x16x32_bf16(Bt[n][k], At[m][k], acc[ai][bj][m][n], 0, 0, 0); } } \
        __builtin_amdgcn_s_setprio(0); } while (0)
#define G8_WAIT_V(n) asm volatile("s_waitcnt vmcnt(" #n ")" ::: "memory")
#define G8_WAIT_L(n) asm volatile("s_waitcnt lgkmcnt(" #n ")" ::: "memory")
#define G8_BAR __builtin_amdgcn_s_barrier()
#define G8_SCHED __builtin_amdgcn_sched_barrier(0)
    Unit cur, nxt; int ui = 0;
    if (!S.next(0, cur)) return;
    f32x4 acc[2][2][4][2];
#pragma unroll
    for (int a = 0; a < 2; ++a)
#pragma unroll
        for (int b = 0; b < 2; ++b)
#pragma unroll
            for (int m = 0; m < 4; ++m)
#pragma unroll
                for (int n = 0; n < 2; ++n) acc[a][b][m][n] = (f32x4){0.f, 0.f, 0.f, 0.f};
    bf16x8 At[4][2], B0[2][2], B1[2][2];
    u32x4 va = (u32x4){0u, 0u, 0u, 0u};
    if constexpr (GATHER) va = g8_avoff(cur.pm, gather, tid, KB);
    constexpr int G8_IDX = G8_STAGE_BYTES, G8_BIAS = G8_STAGE_BYTES + 1024;
    { const float* bp0 = E.bias_ptr(cur); if (bp0 && wid == 0) G8_GLDS((const char*)bp0 + lane * 16, G8_BIAS); }
    const char* cB = (const char*)cur.bt; const char* cA = (const char*)A + (GATHER ? (size_t)0 : (size_t)cur.pm * tstep);
    G8_STAGE_D(G8_SB(0, 0), cB); G8_STAGE_D(G8_SB(0, 1), cB + hstep); G8_STAGE_A(G8_SA(0, 0), cA, 0); G8_STAGE_A(G8_SA(0, 1), cA, 1);
    if (wr == 1) G8_BAR;
    G8_WAIT_V(2); G8_BAR;
    G8_STAGE_D(G8_SB(1, 0), cB + kstep); G8_STAGE_A(G8_SA(1, 0), cA + kstep, 0); G8_STAGE_D(G8_SB(1, 1), cB + hstep + kstep);
    G8_WAIT_V(6); G8_BAR;
    for (;;) {
        const bool has_next = S.next(ui + 1, nxt);
        if constexpr (GATHER) { if (has_next && wid == 1) G8_GLDS((const char*)(gather + nxt.pm * 256) + lane * 16, G8_IDX); }
        const char* nB = has_next ? (const char*)nxt.bt : cB;
        const char* nA = (GATHER || !has_next) ? cA : (const char*)A + (size_t)nxt.pm * tstep;
#pragma unroll 1
        for (int t = 0; t < nt; t += 2) {
            const bool last = (t == nt - 2);
            const char* a1 = cA + (size_t)(t + 1) * kstep;
            const char* a2 = last ? nA : cA + (size_t)(t + 2) * kstep; const char* b2 = last ? nB : cB + (size_t)(t + 2) * kstep;
            const char* a3 = a2 + kstep; const char* b3 = b2 + kstep;
            G8_LDB(B0, 0, 0); G8_LDB(B1, 0, 1); G8_SCHED; G8_LDA(At, 0, 0); G8_STAGE_A(G8_SA(1, 1), a1, 1);
            if (last && has_next && wid == 0) { const float* bpn = E.bias_ptr(nxt); if (bpn) G8_GLDS((const char*)bpn + lane * 16, G8_BIAS + ((ui + 1) & 1) * 1024); }
            if constexpr (GATHER) { if (last && has_next) {
                int t2 = tid; asm volatile("" : "+v"(t2)); int R, C; g8_stage_rc(t2 * 16, R, C); const LAS int* ip = (const LAS int*)(lds + G8_IDX) + R; const unsigned c2 = (unsigned)(C * 2), k2 = (unsigned)KB;
                va = (u32x4){(unsigned)ip[0] * k2 + c2, (unsigned)ip[64] * k2 + c2, (unsigned)ip[128] * k2 + c2, (unsigned)ip[192] * k2 + c2}; } }
            G8_WAIT_V(8); G8_WAIT_L(0); G8_BAR; G8_MMA(0, 0, At, B0); G8_MMA(0, 1, At, B1); G8_BAR; G8_SCHED;
            G8_LDA(At, 0, 1); G8_STAGE_D(G8_SB(0, 0), b2); G8_STAGE_D(G8_SB(0, 1), b2 + hstep); G8_STAGE_A(G8_SA(0, 0), a2, 0);
            G8_WAIT_V(8); G8_WAIT_L(0); G8_BAR; G8_MMA(1, 0, At, B0); G8_MMA(1, 1, At, B1); G8_BAR; G8_SCHED;
            G8_LDB(B0, 1, 0); G8_LDB(B1, 1, 1); G8_SCHED; G8_LDA(At, 1, 0); G8_STAGE_A(G8_SA(0, 1), a2, 1);
            G8_WAIT_V(8); G8_WAIT_L(0); G8_BAR; G8_MMA(0, 0, At, B0); G8_MMA(0, 1, At, B1); G8_BAR; G8_SCHED;
            G8_LDA(At, 1, 1); G8_STAGE_D(G8_SB(1, 0), b3); G8_STAGE_D(G8_SB(1, 1), b3 + hstep); G8_STAGE_A(G8_SA(1, 0), a3, 0);
            G8_WAIT_V(8); G8_WAIT_L(0); G8_BAR; G8_MMA(1, 0, At, B0); G8_MMA(1, 1, At, B1); G8_BAR; G8_SCHED;
        }
        if (wr == 0) G8_BAR;
        { int t3 = tid; asm volatile("" : "+v"(t3)); const int l3 = t3 & 63; E(acc, cur, wr, wc, l3 & 15, l3 >> 4, (const LAS float*)(lds + G8_BIAS + (ui & 1) * 1024)); }
        if (!has_next) break;
#pragma unroll
        for (int a = 0; a < 2; ++a)
#pragma unroll
            for (int b = 0; b < 2; ++b)
#pragma unroll
                for (int m = 0; m < 4; ++m)
#pragma unroll
                    for (int n = 0; n < 2; ++n) acc[a][b][m][n] = (f32x4){0.f, 0.f, 0.f, 0.f};
        cur = nxt; cB = nB; cA = nA; ++ui;
        if (wr == 1) G8_BAR;
    }
    G8_WAIT_V(0);
    G8_BAR;
#undef G8_SA
#undef G8_SB
#undef G8_GLDS
#undef G8_STAGE_D
#undef G8_STAGE_A
#undef G8_LDA
#undef G8_LDB
#undef G8_MMA
#undef G8_CAT
#undef G8_WAIT_V
#undef G8_WAIT_L
#undef G8_BAR
#undef G8_SCHED
}

__device__ __forceinline__ float logsigmoid_f(float x) { return fminf(x, 0.f) - log1pf(__expf(-fabsf(x))); }
__device__ __forceinline__ void phase_gla_prep(KA a, int li, LAS unsigned char* lds, int tid, int bx, int G) {
    const int lane = tid & 63, wave = __builtin_amdgcn_readfirstlane(tid >> 6), fr = lane & 15, fq = lane >> 4;
    unsigned char* ws = a->ws;
    const bf16* qkvr = (const bf16*)(ws + WS_BIG); const float* lr = (const float*)(ws + WS_LR);
    bf16* QE = (bf16*)(ws + WS_QE); bf16* KET = (bf16*)(ws + WS_KET); bf16* PP = (bf16*)(ws + WS_P); bf16* VT = (bf16*)(ws + WS_VT); float* EL = (float*)(ws + WS_EL);
    constexpr int LS = 136, VLS = 264;
    LAS bf16* qes = (LAS bf16*)lds;
    LAS bf16* kes = qes + 64 * LS;
    LAS float* lrs = (LAS float*)(kes + 64 * LS);
    LAS float* segtot = lrs + 1024;
    LAS bf16* vraw = (LAS bf16*)(segtot + 512);
    const int d = tid & 127, seg = tid >> 7;
    const int so = tid & 15, sr = tid >> 4;
    for (int it = bx; it < 4096; it += G) {
        const int chunk = it & 63, dir = (it >> 6) & 1, h = (it >> 7) & 3, b = it >> 9;
        const int row0 = b * SEQ + chunk * 64;
        const size_t cidx = (size_t)(((dir * 8 + b) * 4 + h) * 64 + chunk);
        const float* wg2 = a->in[dir ? I_GWG2B : I_GWG2F] + (size_t)li * 16 * 512 + h * 128 + d; const float bgd = a->in[dir ? I_GBGB : I_GBGF][(size_t)li * 512 + h * 128 + d];
#pragma unroll
        for (int k2 = 0; k2 < 2; ++k2) { const int p = sr + 32 * k2; const bf16* src = qkvr + (size_t)(row0 + p) * GLA_MAIN + h * 128 + 8 * so;
            const u32x4 qv = *(const u32x4*)src, kv = *(const u32x4*)(src + 512);
            *(LAS u32x4*)(qes + p * LS + 8 * so) = qv; *(LAS u32x4*)(kes + p * LS + 8 * so) = kv; }
        if (dir == 0) {
#pragma unroll
            for (int k4 = 0; k4 < 4; ++k4) { const int idx = tid + 512 * k4, p = idx >> 5, oc = idx & 31;
                *(LAS u32x4*)(vraw + p * VLS + 8 * oc) = *(const u32x4*)(qkvr + (size_t)(row0 + p) * GLA_MAIN + 1024 + h * 256 + 8 * oc); }
        }
        for (int i = tid; i < 1024; i += NTHREADS) lrs[i] = lr[(size_t)(row0 + (i >> 4)) * 32 + dir * 16 + (i & 15)];
        float wcol[16];
#pragma unroll
        for (int r = 0; r < 16; ++r) wcol[r] = wg2[r * 512];
        __syncthreads();
        float g[16];
#pragma unroll
        for (int s2 = 0; s2 < 16; ++s2) { const LAS float* lp = lrs + (seg * 16 + s2) * 16; float x = bgd;
#pragma unroll
            for (int r4 = 0; r4 < 4; ++r4) { const f32x4 l4 = *(const LAS f32x4*)(lp + 4 * r4); x += l4[0] * wcol[4 * r4] + l4[1] * wcol[4 * r4 + 1] + l4[2] * wcol[4 * r4 + 2] + l4[3] * wcol[4 * r4 + 3]; }
            g[s2] = (fminf(x, 0.f) - __logf(1.0f + __expf(-fabsf(x)))) * (1.0f / 16.0f); }
        if (dir == 0) {
#pragma unroll
            for (int s2 = 1; s2 < 16; ++s2) g[s2] += g[s2 - 1];
        } else {
#pragma unroll
            for (int s2 = 14; s2 >= 0; --s2) g[s2] += g[s2 + 1];
        }
        segtot[seg * 128 + d] = dir ? g[0] : g[15];
        __syncthreads();
        float pre = 0.f, total = 0.f;
#pragma unroll
        for (int sg = 0; sg < 4; ++sg) { const float t = segtot[sg * 128 + d]; total += t; if (dir ? (sg > seg) : (sg < seg)) pre += t; }
        if (seg == 0) EL[cidx * 128 + d] = __expf(total);
        unsigned kt[8];
#pragma unroll
        for (int s2 = 0; s2 < 16; s2 += 2) {
            unsigned kw[2];
#pragma unroll
            for (int u = 0; u < 2; ++u) { const int p = seg * 16 + s2 + u;
                const float q = bf2f(qes[p * LS + d]), k = bf2f(kes[p * LS + d]); const float bb = g[s2 + u] + pre;
                const float eb_ = __expf(bb); const unsigned qw = cvt_pk_bf16(q * eb_, 0.f) & 0xffffu; kw[u] = cvt_pk_bf16(k * __builtin_amdgcn_rcpf(eb_), 0.f) & 0xffffu;
                qes[p * LS + d] = (bf16)qw; kes[p * LS + d] = (bf16)kw[u]; }
            kt[s2 >> 1] = kw[0] | (kw[1] << 16);
        }
        { bf16* kp = KET + cidx * 8192 + (size_t)d * 64 + seg * 16; *(u32x4*)kp = (u32x4){kt[0], kt[1], kt[2], kt[3]}; *(u32x4*)(kp + 8) = (u32x4){kt[4], kt[5], kt[6], kt[7]}; }
        __syncthreads();
#pragma unroll
        for (int k2 = 0; k2 < 2; ++k2) { const int p = sr + 32 * k2; *(u32x4*)(QE + ((size_t)dir * T + row0 + p) * 512 + h * 128 + 8 * so) = *(const LAS u32x4*)(qes + p * LS + 8 * so); }
        { const int jt = wave & 3;
#pragma unroll
          for (int ii = 0; ii < 2; ++ii) { const int itile = 2 * (wave >> 2) + ii;
            f32x4 acc = (f32x4){0.f, 0.f, 0.f, 0.f};
            const bool dead = dir ? (jt < itile) : (jt > itile);
            if (!dead) {
#pragma unroll
                for (int ks = 0; ks < 4; ++ks) { const bf16x8 kf = *(const LAS bf16x8*)(kes + (jt * 16 + fr) * LS + ks * 32 + 8 * fq), qf = *(const LAS bf16x8*)(qes + (itile * 16 + fr) * LS + ks * 32 + 8 * fq);
                    acc = __builtin_amdgcn_mfma_f32_16x16x32_bf16(kf, qf, acc, 0, 0, 0); }
            }
            const int i = itile * 16 + fr, j0 = jt * 16 + 4 * fq; float pv[4];
#pragma unroll
            for (int jj = 0; jj < 4; ++jj) { const int j = j0 + jj; const bool keep = dir ? (j >= i) : (j <= i); pv[jj] = keep ? acc[jj] : 0.f; }
            u32x2 o; o.x = cvt_pk_bf16(pv[0], pv[1]); o.y = cvt_pk_bf16(pv[2], pv[3]);
            *(u32x2*)(PP + cidx * 4096 + (size_t)i * 64 + j0) = o; } }
        if (dir == 0) {
            const int e = tid & 255, jh = tid >> 8; unsigned w[16];
#pragma unroll
            for (int jj = 0; jj < 32; jj += 2) w[jj >> 1] = (unsigned)vraw[(jh * 32 + jj) * VLS + e] | ((unsigned)vraw[(jh * 32 + jj + 1) * VLS + e] << 16);
            bf16* vp = VT + ((size_t)((b * 4 + h) * 64 + chunk) * 256 + e) * 64 + jh * 32;
#pragma unroll
            for (int q4 = 0; q4 < 4; ++q4) *(u32x4*)(vp + 8 * q4) = (u32x4){w[4 * q4], w[4 * q4 + 1], w[4 * q4 + 2], w[4 * q4 + 3]};
        }
        __syncthreads();
    }
}
__device__ __forceinline__ void phase_gla_scan(KA a, LAS unsigned char* lds, int tid, int bx, int G) {
    const int lane = tid & 63, wave = __builtin_amdgcn_readfirstlane(tid >> 6), fr = lane & 15, fq = lane >> 4;
    unsigned char* ws = a->ws;
    const char* QE = (const char*)(ws + WS_QE); const char* KET = (const char*)(ws + WS_KET); const char* PP = (const char*)(ws + WS_P); const char* VT = (const char*)(ws + WS_VT); const float* EL = (const float*)(ws + WS_EL);
    constexpr int SS = 136, ST_BYTES = 2 * 64 * SS * 2, BUFB = 50176, OQ = 0, OP = 16384, OK_ = 24576, OV = 40960, OE = 49152;
    LAS bf16* ST = (LAS bf16*)lds;
    LAS unsigned char* BUF = lds + ST_BYTES;
    const int et0 = 2 * (wave & 1), dt0 = 2 * (wave >> 1), itile = wave >> 1;
    const int rq = lane >> 4, pq = lane & 15, r8 = lane >> 3, p8 = lane & 7;
    unsigned sq[2], sk[2], sp, sv;
#pragma unroll
    for (int j = 0; j < 2; ++j) { const int r = 4 * (wave + 8 * j) + rq; sq[j] = (unsigned)(r * 1024 + ((pq ^ (r & 15)) * 16)); const int dk = 8 * (wave + 8 * j) + r8; sk[j] = (unsigned)(dk * 128 + ((p8 ^ ((dk >> 1) & 7)) * 16)); }
    { const int r = 8 * wave + r8; sp = (unsigned)(r * 128 + ((p8 ^ ((r >> 1) & 7)) * 16)); sv = sp; }
    const int kx = fr >> 1;
    for (int it0 = bx; it0 < 256; it0 += G) {
        const int it = (G == 256) ? ((it0 & 7) * 32 + (it0 >> 3)) : it0;
        const int b = it >> 5, h = (it >> 3) & 3, dir = (it >> 2) & 1, es = it & 3;
        bf16* OO = (bf16*)(ws + (dir ? WS_OB : WS_OF));
        __syncthreads();
        for (int i = tid; i < 64 * SS / 2; i += NTHREADS) ((LAS unsigned*)ST)[i] = 0u;
        f32x4 accS[2][2];
#pragma unroll
        for (int x = 0; x < 2; ++x)
#pragma unroll
            for (int y = 0; y < 2; ++y) accS[x][y] = (f32x4){0.f, 0.f, 0.f, 0.f};
        const size_t cbase = (size_t)((dir * 8 + b) * 4 + h) * 64;
        const char* qsrc = QE + (((size_t)dir * T + (size_t)b * SEQ) * 512 + h * 128) * 2;
        const char* psrc = PP + cbase * 8192;
        const char* ksrc = KET + cbase * 16384;
        const char* vsrc = VT + ((size_t)(b * 4 + h) * 64 * 256 + es * 64) * 128;
        const char* esrc = (const char*)(EL + cbase * 128);
        char* ob = (char*)(OO + ((size_t)b * SEQ + itile * 16) * D + h * 256 + es * 64 + et0 * 16);
        const unsigned le = (unsigned)fq * 16u, lo = (unsigned)(fr * D + 4 * fq) * 2u;
#define SC_DMA(c_, bi_) do { const size_t c__ = (size_t)(c_); LAS unsigned char* bb_ = BUF + (bi_) * BUFB + wave * 1024; \
            __builtin_amdgcn_global_load_lds((const unsigned*)(qsrc + c__ * 65536 + sq[0]), (LAS unsigned*)(bb_ + OQ), 16, 0, 0); \
            __builtin_amdgcn_global_load_lds((const unsigned*)(qsrc + c__ * 65536 + sq[1]), (LAS unsigned*)(bb_ + OQ + 8192), 16, 0, 0); \
            __builtin_amdgcn_global_load_lds((const unsigned*)(psrc + c__ * 8192 + sp), (LAS unsigned*)(bb_ + OP), 16, 0, 0); \
            __builtin_amdgcn_global_load_lds((const unsigned*)(ksrc + c__ * 16384 + sk[0]), (LAS unsigned*)(bb_ + OK_), 16, 0, 0); \
            __builtin_amdgcn_global_load_lds((const unsigned*)(ksrc + c__ * 16384 + sk[1]), (LAS unsigned*)(bb_ + OK_ + 8192), 16, 0, 0); \
            __builtin_amdgcn_global_load_lds((const unsigned*)(vsrc + c__ * 32768 + sv), (LAS unsigned*)(bb_ + OV), 16, 0, 0); \
            if (wave == 0) __builtin_amdgcn_global_load_lds((const unsigned*)(esrc + c__ * 512 + lane * 16), (LAS unsigned*)(BUF + (bi_) * BUFB + OE), 16, 0, 0); } while (0)
        SC_DMA(dir ? 63 : 0, 0);
        asm volatile("s_waitcnt vmcnt(0)" ::: "memory");
        __syncthreads();
#pragma unroll 1
        for (int cc = 0; cc < 64; ++cc) {
            const int c = dir ? 63 - cc : cc;
            if (cc + 1 < 64) SC_DMA(dir ? 62 - cc : cc + 1, (cc + 1) & 1);
            const LAS unsigned char* B = BUF + (cc & 1) * BUFB;
            const f32x4 el0 = *(const LAS f32x4*)(B + OE + dt0 * 64 + le), el1 = *(const LAS f32x4*)(B + OE + dt0 * 64 + 64 + le);
            const LAS bf16* Sr = ST + (cc & 1) * 64 * SS; LAS bf16* Sw = ST + ((cc + 1) & 1) * 64 * SS;
            bf16x8 qf[4], pf[2], vf[2][2];
#pragma unroll
            for (int ks = 0; ks < 4; ++ks) qf[ks] = *(const LAS bf16x8*)(B + OQ + (itile * 16 + fr) * 256 + (((4 * ks + fq) ^ fr) * 16));
#pragma unroll
            for (int ks = 0; ks < 2; ++ks) pf[ks] = *(const LAS bf16x8*)(B + OP + (itile * 16 + fr) * 128 + (((4 * ks + fq) ^ kx) * 16));
#pragma unroll
            for (int et = 0; et < 2; ++et)
#pragma unroll
                for (int ks = 0; ks < 2; ++ks) vf[et][ks] = *(const LAS bf16x8*)(B + OV + ((et0 + et) * 16 + fr) * 128 + (((4 * ks + fq) ^ kx) * 16));
#pragma unroll
            for (int et = 0; et < 2; ++et) { f32x4 ao = (f32x4){0.f, 0.f, 0.f, 0.f};
#pragma unroll
                for (int ks = 0; ks < 4; ++ks) { const bf16x8 sf = *(const LAS bf16x8*)(Sr + ((et0 + et) * 16 + fr) * SS + ks * 32 + 8 * fq); ao = __builtin_amdgcn_mfma_f32_16x16x32_bf16(sf, qf[ks], ao, 0, 0, 0); }
#pragma unroll
                for (int ks = 0; ks < 2; ++ks) ao = __builtin_amdgcn_mfma_f32_16x16x32_bf16(vf[et][ks], pf[ks], ao, 0, 0, 0);
                u32x2 o; o.x = cvt_pk_bf16(ao[0], ao[1]); o.y = cvt_pk_bf16(ao[2], ao[3]);
                *(u32x2*)(ob + (size_t)c * (64 * D * 2) + et * 32 + lo) = o; }
#pragma unroll
            for (int dt = 0; dt < 2; ++dt) { bf16x8 kf[2];
#pragma unroll
                for (int ks = 0; ks < 2; ++ks) kf[ks] = *(const LAS bf16x8*)(B + OK_ + ((dt0 + dt) * 16 + fr) * 128 + (((4 * ks + fq) ^ kx) * 16));
#pragma unroll
                for (int et = 0; et < 2; ++et) {
#pragma unroll
                    for (int ks = 0; ks < 2; ++ks) accS[dt][et] = __builtin_amdgcn_mfma_f32_16x16x32_bf16(kf[ks], vf[et][ks], accS[dt][et], 0, 0, 0);
                    accS[dt][et] = accS[dt][et] * (dt ? el1 : el0);
                    u32x2 o; o.x = cvt_pk_bf16(accS[dt][et][0], accS[dt][et][1]); o.y = cvt_pk_bf16(accS[dt][et][2], accS[dt][et][3]);
                    *(LAS u32x2*)(Sw + ((et0 + et) * 16 + fr) * SS + (dt0 + dt) * 16 + 4 * fq) = o; } }
            asm volatile("s_waitcnt vmcnt(0)" ::: "memory");
            __syncthreads();
        }
#undef SC_DMA
    }
}

__device__ __forceinline__ void phase_gla_post(KA a, int li, int tid, int bx, int G) {
    const int lane = tid & 63, wave = tid >> 6;
    const bf16* of = (const bf16*)(a->ws + WS_OF); const bf16* ob = (const bf16*)(a->ws + WS_OB); const bf16* qkvr = (const bf16*)(a->ws + WS_BIG); bf16* A2 = (bf16*)(a->ws + WS_A2);
    const float* ng = a->in[I_GNORM] + (size_t)li * 256 + (lane & 15) * 16;
    float g[16];
#pragma unroll
    for (int j = 0; j < 16; ++j) g[j] = ng[j];
    for (int token = bx * NWAVES + wave; token < T; token += G * NWAVES) {
        const u32x4 f0 = *(const u32x4*)(of + (size_t)token * D + 16 * lane), f1 = *(const u32x4*)(of + (size_t)token * D + 16 * lane + 8);
        const u32x4 b0 = *(const u32x4*)(ob + (size_t)token * D + 16 * lane), b1 = *(const u32x4*)(ob + (size_t)token * D + 16 * lane + 8);
        const u32x4 r0 = *(const u32x4*)(qkvr + (size_t)token * GLA_MAIN + 2048 + 16 * lane), r1 = *(const u32x4*)(qkvr + (size_t)token * GLA_MAIN + 2048 + 16 * lane + 8);
        float o[16], r[16];
#pragma unroll
        for (int q = 0; q < 4; ++q) { o[2 * q] = bf_lo(f0[q]) + bf_lo(b0[q]); o[2 * q + 1] = bf_hi(f0[q]) + bf_hi(b0[q]); o[8 + 2 * q] = bf_lo(f1[q]) + bf_lo(b1[q]); o[8 + 2 * q + 1] = bf_hi(f1[q]) + bf_hi(b1[q]);
            r[2 * q] = bf_lo(r0[q]); r[2 * q + 1] = bf_hi(r0[q]); r[8 + 2 * q] = bf_lo(r1[q]); r[8 + 2 * q + 1] = bf_hi(r1[q]); }
        float ss = 0.f;
#pragma unroll
        for (int j = 0; j < 16; ++j) ss += o[j] * o[j];
        ss += shfl_xor_f(ss, 1, lane); ss += shfl_xor_f(ss, 2, lane); ss += shfl_xor_f(ss, 4, lane); ss += shfl_xor_f(ss, 8, lane);
        const float rstd = 1.0f / sqrtf(ss * (1.0f / 256.0f) + LN_EPS);
        unsigned w[8];
#pragma unroll
        for (int q = 0; q < 8; ++q) w[q] = cvt_pk_bf16(o[2 * q] * rstd * g[2 * q] * silu_f(r[2 * q]), o[2 * q + 1] * rstd * g[2 * q + 1] * silu_f(r[2 * q + 1]));
        *(u32x4*)(A2 + (size_t)token * D + 16 * lane) = (u32x4){w[0], w[1], w[2], w[3]}; *(u32x4*)(A2 + (size_t)token * D + 16 * lane + 8) = (u32x4){w[4], w[5], w[6], w[7]};
    }
}

__device__ __forceinline__ void phase_sgu_core(KA a, int li, LAS unsigned char* lds, int tid, int bx, int G) {
    const int lane = tid & 63, wave = __builtin_amdgcn_readfirstlane(tid >> 6), fr = lane & 15, fq = lane >> 4;
    unsigned char* ws = a->ws;
    const bf16* z = (const bf16*)(ws + WS_BIG); bf16* A2 = (bf16*)(ws + WS_A2);
    const float* lng = a->in[I_SLNG] + (size_t)li * 1024; const float* lnb = a->in[I_SLNB] + (size_t)li * 1024;
    const bf16* wsp = (const bf16*)(ws + WS_SGUWS) + (size_t)li * 8 * 128 * 128; const float* bs = a->in[I_SBS] + (size_t)li * 8 * 128;
    constexpr int VS = 132;
    LAS bf16* vn = (LAS bf16*)lds;
    LAS float* st_mean = (LAS float*)(lds + 2 * 128 * VS * 2); LAS float* st_rstd = st_mean + 128;
    const int co = tid & 15, qr = tid >> 4;
    for (int it = bx; it < T / 128; it += G) {
        const int row0 = it * 128;
        __syncthreads();
#pragma unroll 1
        for (int rr = 0; rr < 16; ++rr) { const int q = wave * 16 + rr; const bf16* vp = z + (size_t)(row0 + q) * 2048 + 1024 + 16 * lane;
            const u32x4 v0 = *(const u32x4*)vp, v1 = *(const u32x4*)(vp + 8); float x[16];
#pragma unroll
            for (int k = 0; k < 4; ++k) { x[2 * k] = bf_lo(v0[k]); x[2 * k + 1] = bf_hi(v0[k]); x[8 + 2 * k] = bf_lo(v1[k]); x[8 + 2 * k + 1] = bf_hi(v1[k]); }
            float s1 = 0.f;
#pragma unroll
            for (int k = 0; k < 16; ++k) s1 += x[k];
            const float mean = wave_sum(s1, lane) * (1.0f / 1024.0f); float s2 = 0.f;
#pragma unroll
            for (int k = 0; k < 16; ++k) { const float dd = x[k] - mean; s2 += dd * dd; }
            const float rstd = 1.0f / sqrtf(wave_sum(s2, lane) * (1.0f / 1024.0f) + LN_EPS);
            if (lane == 0) { st_mean[q] = mean; st_rstd[q] = rstd; } }
        __syncthreads();
        const int p = wave * 16 + fr;
#pragma unroll 1
        for (int g = 0; g < 8; ++g) {
            LAS bf16* vb = vn + (g & 1) * 128 * VS;
            {
                const f32x4 g0 = *(const f32x4*)(lng + g * 128 + 8 * co), g1 = *(const f32x4*)(lng + g * 128 + 8 * co + 4), b0 = *(const f32x4*)(lnb + g * 128 + 8 * co), b1 = *(const f32x4*)(lnb + g * 128 + 8 * co + 4);
#pragma unroll
                for (int k = 0; k < 4; ++k) { const int q = qr + 32 * k; const u32x4 w = *(const u32x4*)(z + (size_t)(row0 + q) * 2048 + 1024 + g * 128 + 8 * co);
                    const float m = st_mean[q], r = st_rstd[q];
                    u32x2 o0, o1;
                    o0.x = cvt_pk_bf16((bf_lo(w.x) - m) * r * g0[0] + b0[0], (bf_hi(w.x) - m) * r * g0[1] + b0[1]); o0.y = cvt_pk_bf16((bf_lo(w.y) - m) * r * g0[2] + b0[2], (bf_hi(w.y) - m) * r * g0[3] + b0[3]);
                    o1.x = cvt_pk_bf16((bf_lo(w.z) - m) * r * g1[0] + b1[0], (bf_hi(w.z) - m) * r * g1[1] + b1[1]); o1.y = cvt_pk_bf16((bf_lo(w.w) - m) * r * g1[2] + b1[2], (bf_hi(w.w) - m) * r * g1[3] + b1[3]);
                    *(LAS u32x2*)(vb + q * VS + 8 * co) = o0; *(LAS u32x2*)(vb + q * VS + 8 * co + 4) = o1; }
            }
            bf16x8 wf[4];
#pragma unroll
            for (int ks = 0; ks < 4; ++ks) wf[ks] = *(const bf16x8*)(wsp + ((size_t)g * 128 + p) * 128 + ks * 32 + 8 * fq);
            const float bias = bs[g * 128 + p];
            __syncthreads();
#pragma unroll 2
            for (int ct = 0; ct < 8; ++ct) {
                f32x4 acc = (f32x4){0.f, 0.f, 0.f, 0.f};
#pragma unroll
                for (int ks = 0; ks < 4; ++ks) { const LAS bf16* sp = vb + (ks * 32 + 8 * fq) * VS + ct * 16 + fr; unsigned w4[4];
#pragma unroll
                    for (int j2 = 0; j2 < 4; ++j2) w4[j2] = (unsigned)sp[(2 * j2) * VS] | ((unsigned)sp[(2 * j2 + 1) * VS] << 16);
                    const bf16x8 vf = __builtin_bit_cast(bf16x8, (u32x4){w4[0], w4[1], w4[2], w4[3]});
                    acc = __builtin_amdgcn_mfma_f32_16x16x32_bf16(vf, wf[ks], acc, 0, 0, 0); }
                const int c0 = g * 128 + ct * 16 + 4 * fq;
                const u32x2 uu = *(const u32x2*)(z + (size_t)(row0 + p) * 2048 + c0);
                u32x2 o; o.x = cvt_pk_bf16(bf_lo(uu.x) * (acc[0] + bias), bf_hi(uu.x) * (acc[1] + bias)); o.y = cvt_pk_bf16(bf_lo(uu.y) * (acc[2] + bias), bf_hi(uu.y) * (acc[3] + bias));
                *(u32x2*)(A2 + (size_t)(row0 + p) * D + c0) = o;
            }
        }
    }
}

constexpr int PH_PER_LAYER = 10;
constexpr int NPHASES = 2 + PH_PER_LAYER * DEPTH;
#define GEMM_BODY(A, g, K, S, E) gemm_fast<false, false>(A, g, K, S, E, lds, tid)
#define GEMM_BODY_G(A, g, K, S, E) gemm_fast<true, false>(A, g, K, S, E, lds, tid)
#define GEMM_BODY8(A, g, K, S, E) gemm_fast<false, true>(A, g, K, S, E, lds, tid)
#define GEMM_BODY8_G(A, g, K, S, E) gemm_fast<true, true>(A, g, K, S, E, lds, tid)
__device__ __forceinline__ void ph_prologue(int wave_s) { PHASE_ENTER(); phase_prologue(a, lds, tid, bx, G); }
__device__ __forceinline__ void ph_rp_init(int wave_s) { PHASE_ENTER(); float* mod = (float*)(ws + WS_MOD);
    RowPass p{}; p.xin = a->in[I_X]; p.hout = (bf16*)(ws + WS_H); p.sc = mod + 1 * 1024; p.sh = mod + 0 * 1024; p.wside = (const bf16*)(ws + WS_GLALR_T); p.lr_out = (float*)(ws + WS_LR); p.has_h = 1; p.has_side = 1;
    row_pass<0>(p, lds, tid, bx, G); }
__device__ __forceinline__ void ph_gla_in(int wave_s, int li) { PHASE_ENTER(); Sched S; S.init(T / 256, GLA_MAIN / 256, G, bx, (const bf16*)(ws + WS_GLAIN_T) + (size_t)li * GLA_MAIN * 1024, 0, nullptr, 2048); EpiGlaIn E{(bf16*)(ws + WS_BIG)}; GEMM_BODY((const bf16*)(ws + WS_H), nullptr, 1024, S, E); }
__device__ __forceinline__ void ph_sgu_in(int wave_s, int li) { PHASE_ENTER(); Sched S; S.init(T / 256, 2048 / 256, G, bx, (const bf16*)(ws + WS_SGUIN_T) + (size_t)li * 2048 * 1024, 0, nullptr, 2048); EpiSguIn E{(bf16*)(ws + WS_BIG), a->in[I_SBIN] + (size_t)li * 2048}; GEMM_BODY((const bf16*)(ws + WS_H), nullptr, 1024, S, E); }
__device__ __forceinline__ void ph_gla_prep(int wave_s, int li) { PHASE_ENTER(); phase_gla_prep(a, li, lds, tid, bx, G); }
__device__ __forceinline__ void ph_gla_scan(int wave_s) { PHASE_ENTER(); phase_gla_scan(a, lds, tid, bx, G); }
__device__ __forceinline__ void ph_sgu_core(int wave_s, int li) { PHASE_ENTER(); phase_sgu_core(a, li, lds, tid, bx, G); }
__device__ __forceinline__ void ph_gla_post(int wave_s, int li) { PHASE_ENTER(); phase_gla_post(a, li, tid, bx, G); }
__device__ __forceinline__ void ph_out(int wave_s, int l) { PHASE_ENTER(); const int li = l >> 1; const bool sgu = (l & 1) != 0;
    Sched S; S.init(T / 256, 4, G, bx, (const bf16*)(ws + (sgu ? WS_SGUOUT_T : WS_GLAOUT_T)) + (size_t)li * 1024 * 1024, 0, nullptr, 2048);
    EpiOut E{(bf16*)(ws + WS_Y), sgu ? a->in[I_SBOUT] + (size_t)li * 1024 : nullptr}; GEMM_BODY((const bf16*)(ws + WS_A2), nullptr, 1024, S, E); }
__device__ __forceinline__ void ph_rp_mid(int wave_s, int l) { PHASE_ENTER(); float* modl = (float*)(ws + WS_MOD) + (size_t)l * 8 * 6144; int* route = (int*)(ws + WS_ROUTE);
    RowPass p{}; p.xin = (l == 0) ? (const void*)a->in[I_X] : (const void*)(ws + WS_X2); p.xin16 = (l != 0); p.y = (const bf16*)(ws + WS_Y); p.xout = ws + WS_X1; p.xout16 = 1; p.hout = (bf16*)(ws + WS_H);
    p.gate = modl + 2 * 1024; p.lng = a->in[I_LNG] + (size_t)(l * 2 + 0) * 1024; p.lnb = a->in[I_LNB] + (size_t)(l * 2 + 0) * 1024; p.sc = modl + 4 * 1024; p.sh = modl + 3 * 1024;
    p.wside = (const bf16*)(ws + WS_ROUTER_T) + (size_t)l * 64 * 1024; p.rbias = a->in[I_RB] + (size_t)l * 32;
    p.topi = route + R_TOPI; p.topw = (float*)(route + R_TOPW); p.hist = route + R_HIST + bx * 32; p.has_h = 1; p.has_side = 1; p.h8out = MOE_FP8 ? (ws + WS_H8) : nullptr;
    row_pass<1>(p, lds, tid, bx, G); }
__device__ __forceinline__ void ph_place(int wave_s) { PHASE_ENTER(); phase_place((int*)(ws + WS_ROUTE), lds, tid, bx, G); }
__device__ __forceinline__ void ph_moe_up(int wave_s, int l) { PHASE_ENTER(); int* route = (int*)(ws + WS_ROUTE); const int ntiles = __builtin_amdgcn_readfirstlane(route[R_NTILES]);
#if MOE_FP8
    Sched S; S.init(ntiles, 8, G, bx, ws + WS_WUP_T + (size_t)l * 32 * 2048 * 1024, (size_t)2048 * 1024, route + R_TILEE, 1024);
    EpiUp<true> E{ws + WS_ACT, a->in[I_BUP] + (size_t)l * 32 * 2048}; GEMM_BODY8_G(ws + WS_H8, route + R_BUFTOK, 1024, S, E); }
#else
    Sched S; S.init(ntiles, 8, G, bx, ws + WS_WUP_T + (size_t)l * 32 * 2048 * 2048, (size_t)2048 * 2048, route + R_TILEE, 2048);
    EpiUp<false> E{ws + WS_ACT, a->in[I_BUP] + (size_t)l * 32 * 2048}; GEMM_BODY_G(ws + WS_H, route + R_BUFTOK, 1024, S, E); }
#endif
__device__ __forceinline__ void ph_moe_down(int wave_s, int l) { PHASE_ENTER(); int* route = (int*)(ws + WS_ROUTE); const int ntiles = __builtin_amdgcn_readfirstlane(route[R_NTILES]);
#if MOE_FP8
    Sched S; S.init(ntiles, 4, G, bx, ws + WS_WDN_T + (size_t)l * 32 * 1024 * 1024, (size_t)1024 * 1024, route + R_TILEE, 1024);
    EpiDown E{(bf16*)(ws + WS_YS), a->in[I_BDN] + (size_t)l * 32 * 1024, 1.0f / (F8_WSCALE * F8_ASCALE)}; GEMM_BODY8(ws + WS_ACT, nullptr, 1024, S, E); }
#else
    Sched S; S.init(ntiles, 4, G, bx, ws + WS_WDN_T + (size_t)l * 32 * 1024 * 2048, (size_t)1024 * 2048, route + R_TILEE, 2048);
    EpiDown E{(bf16*)(ws + WS_YS), a->in[I_BDN] + (size_t)l * 32 * 1024, 1.0f}; GEMM_BODY(ws + WS_ACT, nullptr, 1024, S, E); }
#endif
__device__ __forceinline__ void ph_rp_end(int wave_s, int l) { PHASE_ENTER(); float* mod = (float*)(ws + WS_MOD); float* modl = mod + (size_t)l * 8 * 6144; int* route = (int*)(ws + WS_ROUTE);
    RowPass p{}; p.xin = ws + WS_X1; p.xin16 = 1; p.xout = (l == DEPTH - 1) ? (void*)a->out : (void*)(ws + WS_X2); p.xout16 = (l != DEPTH - 1); p.hout = (bf16*)(ws + WS_H);
    p.gate = modl + 5 * 1024; p.lng = a->in[I_LNG] + (size_t)(l * 2 + 1) * 1024; p.lnb = a->in[I_LNB] + (size_t)(l * 2 + 1) * 1024;
    p.ys = (const bf16*)(ws + WS_YS); p.dest = route + R_DEST; p.tw = (const float*)(route + R_TOPW);
    if (l < DEPTH - 1) { float* modn = mod + (size_t)(l + 1) * 8 * 6144; p.sc = modn + 1 * 1024; p.sh = modn + 0 * 1024; p.has_h = 1;
        if (((l + 1) & 1) == 0) { p.has_side = 1; p.wside = (const bf16*)(ws + WS_GLALR_T) + (size_t)((l + 1) >> 1) * 64 * 1024; p.lr_out = (float*)(ws + WS_LR); } }
    row_pass<2>(p, lds, tid, bx, G); }

__global__ void __launch_bounds__(NTHREADS, 2) fwd_kernel(Args a) {
    extern __shared__ __attribute__((aligned(16))) unsigned char lds_raw[];
    LAS unsigned char* lds = (LAS unsigned char*)lds_raw;
    volatile LAS unsigned* MISC = (volatile LAS unsigned*)(lds + MISC_OFF);
    const int tid = threadIdx.x; const int wave_s = __builtin_amdgcn_readfirstlane(tid >> 6);
    if (tid < 32) ((LAS unsigned*)(lds + MISC_OFF))[tid] = 0u;
    __syncthreads();
    unsigned* ctl = (unsigned*)(a.ws + WS_CTL);
    XcdBarrier bar = xcd_barrier_post(ctl + CW_BAR + a.li * XCD_BAR_WORDS, MISC + 8);
    const int lo = a.ph_lo, hi = a.ph_hi;
#ifndef REPK
#define REPK 0
#define REPN 1
#endif
#define REP(kind) for (int rep_ = 0; rep_ < ((REPK == (kind)) ? REPN : 1); ++rep_)
#define IN(k) (lo <= (k) && (k) < hi)
#define SEAM(k) do { if (IN(k) && IN((k) + 1)) xcd_barrier(bar); } while (0)
    if (IN(0)) { REP(3) ph_prologue(wave_s); SEAM(0); }
    if (IN(1)) { ph_rp_init(wave_s); SEAM(1); }
    for (int l = 0; l < DEPTH; ++l) {
        const int pb = 2 + PH_PER_LAYER * l, li = l >> 1; const bool sgu = (l & 1) != 0;
        if (IN(pb + 0)) { REP(10) { if (!sgu) ph_gla_in(wave_s, li); else ph_sgu_in(wave_s, li); } SEAM(pb + 0); }
        if (IN(pb + 1)) { if (!sgu) { REP(12) ph_gla_prep(wave_s, li); SEAM(pb + 1); } }
        if (IN(pb + 2)) { if (!sgu) { REP(1) ph_gla_scan(wave_s); } else { REP(2) ph_sgu_core(wave_s, li); } SEAM(pb + 2); }
        if (IN(pb + 3)) { if (!sgu) { REP(6) ph_gla_post(wave_s, li); SEAM(pb + 3); } }
        if (IN(pb + 4)) { REP(11) ph_out(wave_s, l); SEAM(pb + 4); }
        if (IN(pb + 5)) { REP(4) ph_rp_mid(wave_s, l); SEAM(pb + 5); }
        if (IN(pb + 6)) { REP(7) ph_place(wave_s); SEAM(pb + 6); }
        if (IN(pb + 7)) { REP(8) ph_moe_up(wave_s, l); SEAM(pb + 7); }
        if (IN(pb + 8)) { REP(9) ph_moe_down(wave_s, l); SEAM(pb + 8); }
        if (IN(pb + 9)) { REP(5) ph_rp_end(wave_s, l); SEAM(pb + 9); }
    }
#undef IN
#undef SEAM
}

#ifndef N_LAUNCH_MODE
#define N_LAUNCH_MODE 1
#endif
extern "C" void kernel_launch(void* const* d_in, const int* in_sizes, int n_in, void* d_out, int out_size, void* d_ws, size_t ws_size, hipStream_t stream) {
    static int grid = 0;
    if (grid == 0) {
        if (n_in != 27 || out_size != T * D || ws_size < WS_END) { fprintf(stderr, "kernel_launch: unexpected shapes (n_in %d out %d ws %zu)\n", n_in, out_size, ws_size); grid = -1; return; }
        int dev = 0, cus = 0, per_cu = 0;
        if (hipGetDevice(&dev) != hipSuccess || hipDeviceGetAttribute(&cus, hipDeviceAttributeMultiprocessorCount, dev) != hipSuccess) { grid = -1; return; }
        if (hipFuncSetAttribute((const void*)fwd_kernel, hipFuncAttributeMaxDynamicSharedMemorySize, LDS_BYTES) != hipSuccess) { fprintf(stderr, "kernel_launch: hipFuncSetAttribute failed\n"); grid = -1; return; }
        if (hipOccupancyMaxActiveBlocksPerMultiprocessor(&per_cu, (const void*)fwd_kernel, NTHREADS, LDS_BYTES) != hipSuccess || per_cu < 1) fprintf(stderr, "kernel_launch: occupancy query reports %d\n", per_cu);
        (void)hipGetLastError();
        grid = cus;
        if (grid > 1024) grid = 1024;
    }
    if (grid < 0) return;
    (void)hipMemsetAsync((char*)d_ws + WS_CTL, 0, CTL_ZERO_BYTES, stream);
    Args a{};
    for (int i = 0; i < 27; ++i) a.in[i] = (const float*)d_in[i];
    a.out = (float*)d_out; a.ws = (unsigned char*)d_ws; a.pad = 0;
#if N_LAUNCH_MODE == 1
    a.ph_lo = 0; a.ph_hi = NPHASES; a.li = 0;
    hipLaunchKernelGGL(fwd_kernel, dim3(grid), dim3(NTHREADS), LDS_BYTES, stream, a);
#else
    for (int ph = 0, li = 0; ph < NPHASES; ++ph) {
        if (ph >= 2 && (((ph - 2) % PH_PER_LAYER) == 1 || ((ph - 2) % PH_PER_LAYER) == 3) && (((ph - 2) / PH_PER_LAYER) & 1)) continue;
        a.ph_lo = ph; a.ph_hi = ph + 1; a.li = li++;
        hipLaunchKernelGGL(fwd_kernel, dim3(grid), dim3(NTHREADS), LDS_BYTES, stream, a);
    }
#endif
}
```

```cpp
#include <hip/hip_runtime.h>
#include <cstdio>
#include <cstdint>

#define LAS __attribute__((address_space(3)))
#define GAS __attribute__((address_space(1)))
typedef unsigned short bf16;
typedef short bf16x8 __attribute__((ext_vector_type(8)));
typedef float f32x4 __attribute__((ext_vector_type(4)));
typedef float f32x2 __attribute__((ext_vector_type(2)));
typedef unsigned u32x4 __attribute__((ext_vector_type(4)));
typedef unsigned u32x2 __attribute__((ext_vector_type(2)));
typedef int i32x4 __attribute__((ext_vector_type(4)));
typedef int i32x8 __attribute__((ext_vector_type(8)));

#ifndef MOE_FP8
#define MOE_FP8 1
#endif
constexpr int D = 1024, NB = 8, SEQ = 4096, T = NB * SEQ, DEPTH = 4;
constexpr int NE = 32, TOPK = 4, CAP = T * TOPK + NE * 256;
constexpr int MAXTILES = CAP / 256;
constexpr float ALPHA = 1.681792830507429f;
constexpr float LN_EPS = 1e-5f;
constexpr float F8_WSCALE = 64.0f, F8_HSCALE = 8.0f, F8_ASCALE = 4.0f, F8_YSCALE = 64.0f;
constexpr int GLA_IN = 3104, GLA_MAIN = 3072;
constexpr int NWAVES = 8, NTHREADS = 512;
constexpr int LDS_BYTES = 147456, MISC_OFF = 139264;

constexpr size_t MiB = 1u << 20;
constexpr size_t WS_CTL = 0, CTL_ZERO_BYTES = 2 * MiB;
constexpr size_t WS_MOD = 2 * MiB;
constexpr size_t WS_ROUTE = 4 * MiB;
constexpr size_t WS_LR = 8 * MiB;
constexpr size_t WS_GLAIN_T = 16 * MiB;
constexpr size_t WS_GLALR_T = 28 * MiB;
constexpr size_t WS_ROUTER_T = 29 * MiB;
constexpr size_t WS_SGUWS = 30 * MiB;
constexpr size_t WS_GLAOUT_T = 32 * MiB;
constexpr size_t WS_SGUIN_T = 36 * MiB;
constexpr size_t WS_SGUOUT_T = 44 * MiB;
constexpr size_t WS_WUP_T = 64 * MiB;
constexpr size_t WS_WDN_T = 576 * MiB;
constexpr size_t WS_X1 = 832 * MiB;
constexpr size_t WS_X2 = 960 * MiB;
constexpr size_t WS_H = 1088 * MiB;
constexpr size_t WS_BIG = 1152 * MiB;
constexpr size_t WS_OF = 1344 * MiB;
constexpr size_t WS_OB = 1408 * MiB;
constexpr size_t WS_A2 = 1472 * MiB;
constexpr size_t WS_Y = 1536 * MiB;
constexpr size_t WS_ACT = 1664 * MiB;
constexpr size_t WS_YS = 1936 * MiB;
constexpr size_t WS_QE = 2208 * MiB;
constexpr size_t WS_KET = 2272 * MiB;
constexpr size_t WS_P = 2336 * MiB;
constexpr size_t WS_VT = 2368 * MiB;
constexpr size_t WS_EL = 2432 * MiB;
constexpr size_t WS_H8 = 2440 * MiB;
constexpr size_t WS_END = 2472 * MiB;
constexpr int R_TOPI = 0;
constexpr int R_TOPW = T * 4;
constexpr int R_DEST = 2 * T * 4;
constexpr int R_BUFTOK = 3 * T * 4;
constexpr int R_HIST = R_BUFTOK + CAP;
constexpr int R_TILEE = R_HIST + 1024 * 32;
constexpr int R_NTILES = R_TILEE + 1024;
static_assert((size_t)(R_NTILES + 64) * 4 <= 4 * MiB, "route tables");
constexpr int CW_BAR = 4096;
constexpr int MAX_LAUNCH = 64;

#define RLX_AGENT __ATOMIC_RELAXED, __HIP_MEMORY_SCOPE_AGENT
#define LDS_WAIT() asm volatile("s_waitcnt lgkmcnt(0)" ::: "memory")
#define VM_WAIT() asm volatile("s_waitcnt vmcnt(0)" ::: "memory")
typedef __bf16 bf16x2_t __attribute__((ext_vector_type(2)));
__device__ __forceinline__ unsigned cvt_pk_bf16(float lo, float hi) { const f32x2 v = {lo, hi}; const bf16x2_t r = __builtin_convertvector(v, bf16x2_t); return __builtin_bit_cast(unsigned, r); }
__device__ __forceinline__ float bf_lo(unsigned w) { return __uint_as_float(w << 16); }
__device__ __forceinline__ float bf_hi(unsigned w) { return __uint_as_float(w & 0xffff0000u); }
__device__ __forceinline__ float bf2f(bf16 b) { return __uint_as_float(((unsigned)b) << 16); }
__device__ __forceinline__ float shfl_xor_f(float v, int o, int lane) { return __builtin_bit_cast(float, __builtin_amdgcn_ds_bpermute((lane ^ o) << 2, __builtin_bit_cast(int, v))); }
__device__ __forceinline__ int shfl_i(int v, int src, int lane) { (void)lane; return __builtin_amdgcn_ds_bpermute(src << 2, v); }
__device__ __forceinline__ float wave_sum(float v, int lane) {
#pragma unroll
    for (int o = 1; o < 64; o <<= 1) v += shfl_xor_f(v, o, lane);
    return v;
}
__device__ __forceinline__ float silu_f(float x) { return x * __builtin_amdgcn_rcpf(1.0f + __expf(-x)); }
__device__ __forceinline__ float sigmoid_f(float x) { return __builtin_amdgcn_rcpf(1.0f + __expf(-x)); }
__device__ __forceinline__ float gelu_f(float v) {
    const float av = fabsf(v), t = __builtin_amdgcn_rcpf(av * 0.2316418882f + 1.0f);
    float q = t * 0.5307027145f + (-0.7265760135f); q = q * t + 0.7107068705f; q = q * t + (-0.142248368f); q = q * t + 0.127414796f; q = q * t;
    const float e = __builtin_amdgcn_exp2f((v * v) * (-0.72134752044f));
    const float m = v * (q * e);
    return v < 0.f ? m : v - m;
}

#define XB_TMO      128
#define XB_XCNT(j)  (256  + 64 * (j))
#define XB_XSUB(j)  (1280 + 64 * (j))
#define XB_XGEN(j)  (2304 + 64 * (j))
#define XB_TOP      3328
#define XB_TOPGEN   3392
#define XCD_BAR_WORDS 3456
#define XB_SPIN_CAP (1u << 18)
__device__ __forceinline__ unsigned xb_ld(unsigned* p)              { return __hip_atomic_load(p, __ATOMIC_RELAXED, __HIP_MEMORY_SCOPE_AGENT); }
__device__ __forceinline__ unsigned xb_add(unsigned* p, unsigned v) { return __hip_atomic_fetch_add(p, v, __ATOMIC_RELAXED, __HIP_MEMORY_SCOPE_AGENT); }
__device__ __forceinline__ unsigned xb_xcc_id() { return (unsigned)__builtin_amdgcn_s_getreg((3 << 11) | 20) & 0xFu; }
#define XB_SPIN(cond, bar) do { unsigned _sp = 0; while (cond) { __builtin_amdgcn_s_sleep(1); \
    if ((++_sp & 255u) == 0u) { if (xb_ld(&(bar)[XB_TMO])) break; if (_sp > XB_SPIN_CAP) { atomicAdd(&(bar)[XB_TMO], 1u); break; } } } } while (0)
struct XcdBarrier { unsigned* bar; unsigned x; volatile LAS unsigned* st; };
__device__ __forceinline__ XcdBarrier xcd_barrier_post(unsigned* bar, volatile LAS unsigned* st) {
    XcdBarrier b; b.bar = bar; b.x = xb_xcc_id(); b.st = st;
    if (threadIdx.x == 0) (void)xb_add(&bar[XB_XCNT(b.x)], 1u);
    return b;
}
__device__ __forceinline__ void xcd_barrier_complete(unsigned* bar, unsigned x, unsigned& nloc, unsigned& nx) {
    const unsigned G = gridDim.x * gridDim.y * gridDim.z;
    unsigned sum, cnt, mine, sp = 0u;
    for (;;) {
        sum = 0u; cnt = 0u; mine = 0u;
#pragma unroll
        for (unsigned j = 0; j < 16; ++j) { const unsigned c = xb_ld(&bar[XB_XCNT(j)]); sum += c; cnt += (c > 0u) ? 1u : 0u; mine = (j == x) ? c : mine; }
        if (sum == G) break;
        __builtin_amdgcn_s_sleep(1);
        if ((++sp & 255u) == 0u) { if (xb_ld(&bar[XB_TMO])) break; if (sp > XB_SPIN_CAP) { atomicAdd(&bar[XB_TMO], 1u); break; } }
    }
    nloc = mine > 0u ? mine : 1u; nx = cnt > 0u ? cnt : 1u;
}
__device__ __forceinline__ void xcd_barrier(const XcdBarrier& b) {
    asm volatile("s_waitcnt vmcnt(0)" ::: "memory");
    __syncthreads();
    if (threadIdx.x == 0) {
        unsigned* bar = b.bar;
        __builtin_amdgcn_s_waitcnt(0);
        unsigned nloc = b.st[0], nx = b.st[1];
        if (nloc == 0u) { xcd_barrier_complete(bar, b.x, nloc, nx); b.st[0] = nloc; b.st[1] = nx; }
        const unsigned old = xb_add(&bar[XB_XSUB(b.x)], 1u);
        const unsigned gen = old / nloc;
        if (old + 1u == (gen + 1u) * nloc) {
            __builtin_amdgcn_fence(__ATOMIC_RELEASE, "agent");
            asm volatile("s_waitcnt vmcnt(0)" ::: "memory");
            const unsigned og = xb_add(&bar[XB_TOP], 1u);
            const unsigned tg = og / nx;
            if (og + 1u == (tg + 1u) * nx) xb_add(&bar[XB_TOPGEN], 1u);
            else XB_SPIN(xb_ld(&bar[XB_TOPGEN]) == tg, bar);
            __builtin_amdgcn_fence(__ATOMIC_ACQUIRE, "agent");
            xb_add(&bar[XB_XGEN(b.x)], 1u);
            asm volatile("s_waitcnt vmcnt(0)" ::: "memory");
        } else {
            XB_SPIN(xb_ld(&bar[XB_XGEN(b.x)]) == gen, bar);
            __builtin_amdgcn_fence(__ATOMIC_ACQUIRE, "agent");
            asm volatile("s_waitcnt vmcnt(0)" ::: "memory");
        }
    }
    __syncthreads();
}

struct Args { const float* in[27]; float* out; unsigned char* ws; int ph_lo, ph_hi, li, pad; };
enum { I_X = 0, I_C, I_ADAW, I_ADAB, I_LNG, I_LNB, I_GWIN, I_GWG2F, I_GBGF, I_GWG2B, I_GBGB, I_GNORM, I_GWOUT, I_SWIN, I_SBIN, I_SLNG, I_SLNB, I_SWS, I_SBS, I_SWOUT, I_SBOUT, I_RW, I_RB, I_WUP, I_BUP, I_WDN, I_BDN };

typedef const __attribute__((address_space(4))) Args* KA;
#define PHASE_ENTER() unsigned m1_ = ~0u; asm volatile("" : "+s"(m1_)); int tid = (wave_s << 6) | (int)__builtin_amdgcn_mbcnt_hi(m1_, __builtin_amdgcn_mbcnt_lo(m1_, 0u)); asm volatile("" : "+v"(tid)); int bx = blockIdx.x, G = gridDim.x; asm volatile("" : "+s"(bx), "+s"(G)); \
    KA a = (KA)__builtin_amdgcn_kernarg_segment_ptr(); asm volatile("" : "+s"(a)); unsigned char* ws = a->ws; \
    extern __shared__ __attribute__((aligned(16))) unsigned char lds_raw[]; LAS unsigned char* lds = (LAS unsigned char*)lds_raw; (void)lds; (void)ws; (void)bx; (void)G; (void)tid
__device__ __forceinline__ int swiglu_perm(int o) {
    const int a = o >> 1, h = o & 1, pn = a >> 7, r = a & 127, bj = r >> 6, r2 = r & 63, wc = r2 >> 4, r3 = r2 & 15;
    return 256 * pn + 128 * bj + 32 * wc + 16 * h + r3;
}
__device__ __forceinline__ void conv_tile(const float* W, int K, int N, int k0, int n0, int nw, bf16* dst, int mode, LAS float* scr, int lane) {
    const int c4 = lane & 15, kr = lane >> 4;
    if (4 * c4 < nw) {
        f32x4 ld[16];
#pragma unroll
        for (int i = 0; i < 16; ++i) ld[i] = *(const f32x4*)(W + (size_t)(k0 + 4 * i + kr) * N + n0 + 4 * c4);
#pragma unroll
        for (int i = 0; i < 16; ++i) { LAS float* s = scr + (4 * i + kr) * 65 + 4 * c4; s[0] = ld[i][0]; s[1] = ld[i][1]; s[2] = ld[i][2]; s[3] = ld[i][3]; }
    }
    LDS_WAIT(); asm volatile("" ::: "memory");
    const int kc = lane & 7, ns = lane >> 3;
    for (int j = 0; j < nw / 8; ++j) {
        const int n = ns + 8 * j; const LAS float* s = scr + (8 * kc) * 65 + n;
        float v[8];
#pragma unroll
        for (int q = 0; q < 8; ++q) v[q] = s[q * 65];
        u32x4 o; o.x = cvt_pk_bf16(v[0], v[1]); o.y = cvt_pk_bf16(v[2], v[3]); o.z = cvt_pk_bf16(v[4], v[5]); o.w = cvt_pk_bf16(v[6], v[7]);
        const int ng = n0 + n;
        if (mode >= 3) {
            const int row = (mode == 4) ? swiglu_perm(ng) : (mode == 5) ? ((ng & ~31) + 16 * ((ng >> 2) & 1) + 4 * ((ng >> 3) & 3) + (ng & 3)) : ng;
            int w0 = __builtin_amdgcn_cvt_pk_fp8_f32(v[0] * F8_WSCALE, v[1] * F8_WSCALE, 0, false); w0 = __builtin_amdgcn_cvt_pk_fp8_f32(v[2] * F8_WSCALE, v[3] * F8_WSCALE, w0, true);
            int w1 = __builtin_amdgcn_cvt_pk_fp8_f32(v[4] * F8_WSCALE, v[5] * F8_WSCALE, 0, false); w1 = __builtin_amdgcn_cvt_pk_fp8_f32(v[6] * F8_WSCALE, v[7] * F8_WSCALE, w1, true);
            *(u32x2*)((unsigned char*)dst + (size_t)row * K + k0 + 8 * kc) = (u32x2){(unsigned)w0, (unsigned)w1};
        } else if (mode == 2) {
            *(u32x4*)(dst + (size_t)n * K + k0 + 8 * kc) = o;
            u32x4 l; l.x = cvt_pk_bf16(v[0] - bf_lo(o.x), v[1] - bf_hi(o.x)); l.y = cvt_pk_bf16(v[2] - bf_lo(o.y), v[3] - bf_hi(o.y));
            l.z = cvt_pk_bf16(v[4] - bf_lo(o.z), v[5] - bf_hi(o.z)); l.w = cvt_pk_bf16(v[6] - bf_lo(o.w), v[7] - bf_hi(o.w));
            *(u32x4*)(dst + (size_t)(32 + n) * K + k0 + 8 * kc) = l;
        } else {
            const int row = (mode == 1) ? swiglu_perm(ng) : ng;
            *(u32x4*)(dst + (size_t)row * K + k0 + 8 * kc) = o;
        }
    }
    LDS_WAIT(); asm volatile("" ::: "memory");
}

__device__ __forceinline__ void phase_prologue(KA a, LAS unsigned char* lds, int tid, int bx, int G) {
    const int lane = tid & 63, wave = __builtin_amdgcn_readfirstlane(tid >> 6);
    unsigned char* ws = a->ws;
    for (int slab = bx; slab < 192; slab += G) {
        LAS float* sc = (LAS float*)lds;
        LAS float* red = (LAS float*)(lds + 32768);
        for (int i = tid; i < 8 * 1024; i += NTHREADS) sc[i] = silu_f(a->in[I_C][i]);
        __syncthreads();
        const int g0 = slab * 128, l = g0 / 6144, e0 = g0 % 6144;
        const int c4 = tid & 31, seg = tid >> 5;
        f32x4 acc[8];
#pragma unroll
        for (int b = 0; b < 8; ++b) acc[b] = (f32x4){0.f, 0.f, 0.f, 0.f};
        const float* wp = a->in[I_ADAW] + ((size_t)l * 1024 + seg * 64) * 6144 + e0 + 4 * c4;
#pragma unroll 8
        for (int d = 0; d < 64; ++d) { const f32x4 w = *(const f32x4*)(wp + (size_t)d * 6144);
#pragma unroll
            for (int b = 0; b < 8; ++b) acc[b] += w * sc[b * 1024 + seg * 64 + d]; }
#pragma unroll
        for (int b = 0; b < 8; ++b) *(LAS f32x4*)(red + (seg * 8 + b) * 128 + 4 * c4) = acc[b];
        __syncthreads();
        for (int o = tid; o < 1024; o += NTHREADS) { const int b = o >> 7, c = o & 127; float s = a->in[I_ADAB][l * 6144 + e0 + c];
#pragma unroll
            for (int sg = 0; sg < 16; ++sg) s += red[(sg * 8 + b) * 128 + c];
            ((float*)(ws + WS_MOD))[((size_t)l * 8 + b) * 6144 + e0 + c] = s; }
        __syncthreads();
    }
    LAS float* scr = (LAS float*)(lds + wave * 16640);
    const int gw = bx * NWAVES + wave, NGW = G * NWAVES;
    constexpr int N_UP = 128 * 16 * 32, N_DN = 128 * 16 * 16, N_GIN = 2 * 16 * 48, N_GLR = 2 * 16, N_GOUT = 2 * 256, N_SIN = 2 * 16 * 32, N_SOUT = 2 * 256, N_RT = 4 * 16;
    constexpr int NITEMS = N_UP + N_DN + N_GIN + N_GLR + N_GOUT + N_SIN + N_SOUT + N_RT;
    for (int it = gw; it < NITEMS; it += NGW) {
        int r = it;
        if (r < N_UP) { const int m = r >> 9, q = r & 511, kt = q >> 5, nt = q & 31;
            conv_tile(a->in[I_WUP] + (size_t)m * 1024 * 2048, 1024, 2048, kt * 64, nt * 64, 64, (bf16*)(ws + WS_WUP_T + (size_t)m * 2048 * 1024 * (MOE_FP8 ? 1 : 2)), MOE_FP8 ? 4 : 1, scr, lane); continue; } r -= N_UP;
        if (r < N_DN) { const int m = r >> 8, q = r & 255, kt = q >> 4, nt = q & 15;
            conv_tile(a->in[I_WDN] + (size_t)m * 1024 * 1024, 1024, 1024, kt * 64, nt * 64, 64, (bf16*)(ws + WS_WDN_T + (size_t)m * 1024 * 1024 * (MOE_FP8 ? 1 : 2)), MOE_FP8 ? 5 : 0, scr, lane); continue; } r -= N_DN;
        if (r < N_GIN) { const int m = r / 768, q = r % 768, kt = q / 48, nt = q % 48;
            conv_tile(a->in[I_GWIN] + (size_t)m * 1024 * GLA_IN, 1024, GLA_IN, kt * 64, nt * 64, 64, (bf16*)(ws + WS_GLAIN_T) + (size_t)m * GLA_MAIN * 1024, 0, scr, lane); continue; } r -= N_GIN;
        if (r < N_GLR) { const int m = r >> 4, kt = r & 15;
            conv_tile(a->in[I_GWIN] + (size_t)m * 1024 * GLA_IN, 1024, GLA_IN, kt * 64, GLA_MAIN, 32, (bf16*)(ws + WS_GLALR_T) + (size_t)m * 64 * 1024, 2, scr, lane); continue; } r -= N_GLR;
        if (r < N_GOUT) { const int m = r >> 8, q = r & 255, kt = q >> 4, nt = q & 15;
            conv_tile(a->in[I_GWOUT] + (size_t)m * 1024 * 1024, 1024, 1024, kt * 64, nt * 64, 64, (bf16*)(ws + WS_GLAOUT_T) + (size_t)m * 1024 * 1024, 0, scr, lane); continue; } r -= N_GOUT;
        if (r < N_SIN) { const int m = r >> 9, q = r & 511, kt = q >> 5, nt = q & 31;
            conv_tile(a->in[I_SWIN] + (size_t)m * 1024 * 2048, 1024, 2048, kt * 64, nt * 64, 64, (bf16*)(ws + WS_SGUIN_T) + (size_t)m * 2048 * 1024, 0, scr, lane); continue; } r -= N_SIN;
        if (r < N_SOUT) { const int m = r >> 8, q = r & 255, kt = q >> 4, nt = q & 15;
            conv_tile(a->in[I_SWOUT] + (size_t)m * 1024 * 1024, 1024, 1024, kt * 64, nt * 64, 64, (bf16*)(ws + WS_SGUOUT_T) + (size_t)m * 1024 * 1024, 0, scr, lane); continue; } r -= N_SOUT;
        { const int m = r >> 4, kt = r & 15;
            conv_tile(a->in[I_RW] + (size_t)m * 1024 * 32, 1024, 32, kt * 64, 0, 32, (bf16*)(ws + WS_ROUTER_T) + (size_t)m * 64 * 1024, 2, scr, lane); }
    }
    { bf16* d = (bf16*)(ws + WS_SGUWS); const float* s = a->in[I_SWS];
      for (int i = (bx * NTHREADS + tid) * 4; i < 2 * 8 * 128 * 128; i += G * NTHREADS * 4) { const f32x4 v = *(const f32x4*)(s + i); u32x2 o; o.x = cvt_pk_bf16(v[0], v[1]); o.y = cvt_pk_bf16(v[2], v[3]); *(u32x2*)(d + i) = o; } }
}

struct RowPass {
    const void* xin; const bf16* y; void* xout; bf16* hout; unsigned char* h8out; int xin16, xout16;
    const float* gate; const float* lng; const float* lnb; const float* sc; const float* sh;
    const bf16* wside;
    float* lr_out;
    const float* rbias;
    int* topi; float* topw; int* hist;
    const void* ys; const int* dest; const float* tw;
    int has_h, has_side;
};
template <int MODE>
__device__ __forceinline__ void row_pass(const RowPass& p, LAS unsigned char* lds, int tid, int bx, int G) {
    const int lane = tid & 63, wave = __builtin_amdgcn_readfirstlane(tid >> 6);
    constexpr int HS = 1032;
    LAS bf16* Hhi = (LAS bf16*)lds;
    LAS bf16* Hlo = (LAS bf16*)(lds + 16 * HS * 2);
    LAS float* part = (LAS float*)(lds + 2 * 16 * HS * 2);
    LAS float* logit = part + 8 * 32 * 16;
    LAS int* lhist = (LAS int*)(logit + 16 * 32);
    if (MODE == 1) { if (tid < 32) lhist[tid] = 0; }
    const bool side = (p.has_side != 0) && (p.wside != nullptr);
    bf16x8 whi[2][4], wlo[2][4];
    if (side) {
#pragma unroll
        for (int hf = 0; hf < 2; ++hf)
#pragma unroll
            for (int s = 0; s < 4; ++s) { const size_t off = (size_t)(hf * 16 + (lane & 15)) * 1024 + 128 * wave + 32 * s + 8 * (lane >> 4);
                whi[hf][s] = *(const bf16x8*)(p.wside + off); wlo[hf][s] = *(const bf16x8*)(p.wside + 32 * 1024 + off); }
    }
    for (int tile = bx; tile < T / 16; tile += G) {
        const int b = (tile * 16) / SEQ;
#pragma unroll 1
        for (int tt = 0; tt < 2; ++tt) {
            const int tl = 2 * wave + tt, token = tile * 16 + tl;
            f32x4 v[4];
            if (p.xin16) { const bf16* xr = (const bf16*)p.xin + (size_t)token * D + 4 * lane;
#pragma unroll
                for (int j = 0; j < 4; ++j) { const u32x2 q = *(const u32x2*)(xr + 256 * j); v[j] = (f32x4){bf_lo(q.x), bf_hi(q.x), bf_lo(q.y), bf_hi(q.y)}; } }
            else { const float* xr = (const float*)p.xin + (size_t)token * D + 4 * lane;
#pragma unroll
                for (int j = 0; j < 4; ++j) v[j] = *(const f32x4*)(xr + 256 * j); }
            if (MODE == 1) {
                const bf16* yr = p.y + (size_t)token * D + 4 * lane; const float* gp = p.gate + (size_t)b * 6144 + 4 * lane;
#pragma unroll
                for (int j = 0; j < 4; ++j) { const u32x2 yq = *(const u32x2*)(yr + 256 * j); const f32x4 yy = (f32x4){bf_lo(yq.x), bf_hi(yq.x), bf_lo(yq.y), bf_hi(yq.y)}; const f32x4 g = *(const f32x4*)(gp + 256 * j); v[j] = v[j] * ALPHA + (g + 1.0f) * yy; }
            }
            if (MODE == 2) {
                f32x4 ya[4];
#pragma unroll
                for (int j = 0; j < 4; ++j) ya[j] = (f32x4){0.f, 0.f, 0.f, 0.f};
#pragma unroll
                for (int k = 0; k < 4; ++k) { const int ds = p.dest[token * 4 + k];
#if MOE_FP8
                    const float w = p.tw[token * 4 + k] * (1.0f / F8_YSCALE); const unsigned char* yr = (const unsigned char*)p.ys + (size_t)ds * D + 4 * lane;
#pragma unroll
                    for (int j = 0; j < 4; ++j) { const int q = *(const int*)(yr + 256 * j); const f32x2 lo2 = __builtin_amdgcn_cvt_pk_f32_fp8(q, false), hi2 = __builtin_amdgcn_cvt_pk_f32_fp8(q, true); ya[j] += (f32x4){lo2[0], lo2[1], hi2[0], hi2[1]} * w; } }
#else
                    const float w = p.tw[token * 4 + k]; const bf16* yr = (const bf16*)p.ys + (size_t)ds * D + 4 * lane;
#pragma unroll
                    for (int j = 0; j < 4; ++j) { const u32x2 q = *(const u32x2*)(yr + 256 * j); ya[j] += (f32x4){bf_lo(q.x), bf_hi(q.x), bf_lo(q.y), bf_hi(q.y)} * w; } }
#endif
                const float* gp = p.gate + (size_t)b * 6144 + 4 * lane;
#pragma unroll
                for (int j = 0; j < 4; ++j) { const f32x4 g = *(const f32x4*)(gp + 256 * j); v[j] = v[j] * ALPHA + (g + 1.0f) * ya[j]; }
            }
            if (MODE != 0) {
                float s = 0.f;
#pragma unroll
                for (int j = 0; j < 4; ++j) s += (v[j][0] + v[j][1]) + (v[j][2] + v[j][3]);
                const float mean = wave_sum(s, lane) * (1.0f / D); float s2 = 0.f;
#pragma unroll
                for (int j = 0; j < 4; ++j) { v[j] = v[j] - mean; s2 += (v[j][0] * v[j][0] + v[j][1] * v[j][1]) + (v[j][2] * v[j][2] + v[j][3] * v[j][3]); }
                const float rstd = 1.0f / sqrtf(wave_sum(s2, lane) * (1.0f / D) + LN_EPS);
#pragma unroll
                for (int j = 0; j < 4; ++j) { const f32x4 g = *(const f32x4*)(p.lng + 4 * lane + 256 * j), bb = *(const f32x4*)(p.lnb + 4 * lane + 256 * j); v[j] = v[j] * rstd * g + bb; }
                if (p.xout16) { bf16* xo = (bf16*)p.xout + (size_t)token * D + 4 * lane;
#pragma unroll
                    for (int j = 0; j < 4; ++j) { u32x2 o; o.x = cvt_pk_bf16(v[j][0], v[j][1]); o.y = cvt_pk_bf16(v[j][2], v[j][3]); *(u32x2*)(xo + 256 * j) = o; } }
                else { float* xo = (float*)p.xout + (size_t)token * D + 4 * lane;
#pragma unroll
                    for (int j = 0; j < 4; ++j) *(f32x4*)(xo + 256 * j) = v[j]; }
            }
            if (p.has_h) {
                const float* scp = p.sc + (size_t)b * 6144 + 4 * lane; const float* shp = p.sh + (size_t)b * 6144 + 4 * lane;
                bf16* ho = p.hout + (size_t)token * D + 4 * lane;
#pragma unroll
                for (int j = 0; j < 4; ++j) { const f32x4 s1 = *(const f32x4*)(scp + 256 * j), s0 = *(const f32x4*)(shp + 256 * j); const f32x4 h = v[j] * (s1 + 1.0f) + s0;
                    u32x2 o; o.x = cvt_pk_bf16(h[0], h[1]); o.y = cvt_pk_bf16(h[2], h[3]); *(u32x2*)(ho + 256 * j) = o;
                    if (MODE == 1 && p.h8out) { int w8 = __builtin_amdgcn_cvt_pk_fp8_f32(h[0] * F8_HSCALE, h[1] * F8_HSCALE, 0, false); w8 = __builtin_amdgcn_cvt_pk_fp8_f32(h[2] * F8_HSCALE, h[3] * F8_HSCALE, w8, true); *(int*)(p.h8out + (size_t)token * D + 4 * lane + 256 * j) = w8; }
                    if (side) { u32x2 l; l.x = cvt_pk_bf16(h[0] - bf_lo(o.x), h[1] - bf_hi(o.x)); l.y = cvt_pk_bf16(h[2] - bf_lo(o.y), h[3] - bf_hi(o.y));
                        *(LAS u32x2*)(Hhi + tl * HS + 4 * lane + 256 * j) = o; *(LAS u32x2*)(Hlo + tl * HS + 4 * lane + 256 * j) = l; } }
            }
        }
        if (side) {
            __syncthreads();
            f32x4 acc[2]; acc[0] = (f32x4){0.f, 0.f, 0.f, 0.f}; acc[1] = acc[0];
#pragma unroll
            for (int s = 0; s < 4; ++s) { const int ko = (lane & 15) * HS + 128 * wave + 32 * s + 8 * (lane >> 4);
                const bf16x8 bh = *(const LAS bf16x8*)(Hhi + ko), bl = *(const LAS bf16x8*)(Hlo + ko);
#pragma unroll
                for (int hf = 0; hf < 2; ++hf) { acc[hf] = __builtin_amdgcn_mfma_f32_16x16x32_bf16(whi[hf][s], bh, acc[hf], 0, 0, 0);
                    acc[hf] = __builtin_amdgcn_mfma_f32_16x16x32_bf16(wlo[hf][s], bh, acc[hf], 0, 0, 0); acc[hf] = __builtin_amdgcn_mfma_f32_16x16x32_bf16(whi[hf][s], bl, acc[hf], 0, 0, 0); } }
#pragma unroll
            for (int hf = 0; hf < 2; ++hf)
#pragma unroll
                for (int j = 0; j < 4; ++j) part[(wave * 32 + hf * 16 + 4 * (lane >> 4) + j) * 16 + (lane & 15)] = acc[hf][j];
            __syncthreads();
            { const int e = tid >> 4, tk = tid & 15; float s = 0.f;
#pragma unroll
              for (int w = 0; w < 8; ++w) s += part[(w * 32 + e) * 16 + tk];
              if (MODE == 1) logit[tk * 32 + e] = s + p.rbias[e];
              else p.lr_out[(size_t)(tile * 16 + tk) * 32 + e] = s; }
            if (MODE == 1) {
                __syncthreads();
                if (tid < 16) {
                    const int token = tile * 16 + tid; float lv[32];
#pragma unroll
                    for (int e = 0; e < 32; ++e) lv[e] = logit[tid * 32 + e];
                    int bi[4]; float bv[4];
#pragma unroll
                    for (int k = 0; k < 4; ++k) { float m = -3.0e38f; int mi = 0;
#pragma unroll
                        for (int e = 0; e < 32; ++e) { const bool take = lv[e] > m; m = take ? lv[e] : m; mi = take ? e : mi; }
                        bi[k] = mi; bv[k] = m;
#pragma unroll
                        for (int e = 0; e < 32; ++e) lv[e] = (e == mi) ? -3.0e38f : lv[e]; }
                    const float e1 = __expf(bv[1] - bv[0]), e2 = __expf(bv[2] - bv[0]), e3 = __expf(bv[3] - bv[0]); const float inv = 1.0f / (1.0f + e1 + e2 + e3);
                    *(int4*)(p.topi + token * 4) = make_int4(bi[0], bi[1], bi[2], bi[3]);
                    *(f32x4*)(p.topw + token * 4) = (f32x4){inv, e1 * inv, e2 * inv, e3 * inv};
#pragma unroll
                    for (int k = 0; k < 4; ++k) atomicAdd((int*)&lhist[bi[k]], 1);
                }
            }
            __syncthreads();
        }
    }
    if (MODE == 1) { __syncthreads(); if (tid < 32) p.hist[tid] = lhist[tid]; }
}

__device__ __forceinline__ void phase_place(int* route, LAS unsigned char* lds, int tid, int bx, int G) {
    const int lane = tid & 63, wave = tid >> 6;
    LAS int* ptot = (LAS int*)lds;
    LAS int* ppre = ptot + 512;
    LAS int* tot = ppre + 512;
    LAS int* pre = tot + 32;
    LAS int* pstart = pre + 32;
    const int* hist = route + R_HIST;
    { const int e = tid & 31, part = tid >> 5; int st = 0, sp = 0;
      for (int bb = part; bb < G; bb += 16) { const int h = hist[bb * 32 + e]; st += h; if (bb < bx) sp += h; }
      ptot[part * 32 + e] = st; ppre[part * 32 + e] = sp; }
    __syncthreads();
    if (tid < 32) { int st = 0, sp = 0;
#pragma unroll
        for (int q = 0; q < 16; ++q) { st += ptot[q * 32 + tid]; sp += ppre[q * 32 + tid]; }
        tot[tid] = st; pre[tid] = sp; }
    __syncthreads();
    if (tid == 0) { int acc = 0; for (int e = 0; e < 32; ++e) { pstart[e] = acc; acc += (tot[e] + 255) / 256 * 256; } pstart[32] = acc; }
    __syncthreads();
    if (bx == 0) {
        const int ntiles = pstart[32] / 256;
        if (tid == 0) route[R_NTILES] = ntiles;
        for (int t = tid; t < ntiles; t += NTHREADS) { int e = 0; for (int q = 1; q < 32; ++q) if (pstart[q] <= t * 256) e = q; route[R_TILEE + t] = e; }
    }
    for (int e = bx; e < 32; e += G) { const int s0 = pstart[e] + tot[e], s1 = pstart[e + 1]; for (int s = s0 + tid; s < s1; s += NTHREADS) route[R_BUFTOK + s] = 0; }
    if (wave == 0) {
        int run = 0;
        for (int tile = bx; tile < T / 16; tile += G) {
            const int token = tile * 16 + (lane >> 2);
            const int e = route[R_TOPI + tile * 64 + lane];
            const int base = shfl_i(run, e, lane);
            int rank = 0, add = 0;
#pragma unroll 1
            for (int x = 0; x < 32; ++x) { const unsigned long long m = __ballot(e == x); if (e == x) rank = __popcll(m & ((1ull << lane) - 1ull)); if (lane == x) add = __popcll(m); }
            run += add;
            const int ds = pstart[e] + pre[e] + base + rank;
            route[R_DEST + tile * 64 + lane] = ds;
            route[R_BUFTOK + ds] = token;
        }
    }
}

struct Unit { int pm, pn, e; const char* bt; };
constexpr int NXCD = 8, WGM = 8;
struct Sched {
    int nM, nN, nwg, G, c; const char* Bt; size_t estride; const int* tile_e; int KB;
    __device__ __forceinline__ void init(int nM_, int nN_, int G_, int c_, const void* Bt_, size_t es, const int* te, int KB_) { nM = nM_; nN = nN_; nwg = nM * nN; G = G_; c = c_; Bt = (const char*)Bt_; estride = es; tile_e = te; KB = KB_; }
    __device__ __forceinline__ bool next(int i, Unit& u) const {
        const long L = (long)i * G + c; if (L >= nwg) return false;
        int wgid = (int)L; { const int q = nwg / NXCD, r = nwg % NXCD, xcd = wgid % NXCD, off = wgid / NXCD; wgid = (xcd < r ? xcd * (q + 1) : r * (q + 1) + (xcd - r) * q) + off; }
        const int nig = WGM * nN, gid = wgid / nig, fm = gid * WGM, gsz = (nM - fm) < WGM ? (nM - fm) : WGM;
        u.pm = fm + ((wgid % nig) % gsz); u.pn = (wgid % nig) / gsz;
        u.e = tile_e ? __builtin_amdgcn_readfirstlane(tile_e[u.pm]) : 0;
        u.bt = Bt + (size_t)u.e * estride + (size_t)u.pn * 256 * KB;
        return true;
    }
};
struct EpiGlaIn { bf16* O;
    __device__ __forceinline__ const float* bias_ptr(const Unit&) const { return nullptr; }
    __device__ __forceinline__ void operator()(const f32x4 (&acc)[2][2][4][2], const Unit& u, int wr, int wc, int fr, int fq, const LAS float*) const {
        const int row0 = u.pm * 256 + wr * 64 + fr, col0 = u.pn * 256 + wc * 32 + 4 * fq; const float sc = (u.pn < 2) ? 0.08838834764831845f : 1.0f;
#pragma unroll
        for (int ai = 0; ai < 2; ++ai)
#pragma unroll
            for (int m = 0; m < 4; ++m) { bf16* rp = O + (size_t)(row0 + ai * 128 + m * 16) * GLA_MAIN + col0;
#pragma unroll
                for (int bj = 0; bj < 2; ++bj)
#pragma unroll
                    for (int n = 0; n < 2; ++n) { const f32x4 v = acc[ai][bj][m][n] * sc; u32x2 o; o.x = cvt_pk_bf16(v[0], v[1]); o.y = cvt_pk_bf16(v[2], v[3]); *(u32x2*)(rp + bj * 128 + n * 16) = o; } }
    }
};
struct EpiSguIn { bf16* O; const float* bias;
    __device__ __forceinline__ const float* bias_ptr(const Unit& u) const { return bias + u.pn * 256; }
    __device__ __forceinline__ void operator()(const f32x4 (&acc)[2][2][4][2], const Unit& u, int wr, int wc, int fr, int fq, const LAS float* lb) const {
        const int row0 = u.pm * 256 + wr * 64 + fr, col0 = u.pn * 256 + wc * 32 + 4 * fq;
        f32x4 bv[2][2];
#pragma unroll
        for (int bj = 0; bj < 2; ++bj)
#pragma unroll
            for (int n = 0; n < 2; ++n) bv[bj][n] = *(const LAS f32x4*)(lb + wc * 32 + 4 * fq + bj * 128 + n * 16);
#pragma unroll
        for (int ai = 0; ai < 2; ++ai)
#pragma unroll
            for (int m = 0; m < 4; ++m) { bf16* rp = O + (size_t)(row0 + ai * 128 + m * 16) * 2048 + col0;
#pragma unroll
                for (int bj = 0; bj < 2; ++bj)
#pragma unroll
                    for (int n = 0; n < 2; ++n) { const f32x4 v = acc[ai][bj][m][n] + bv[bj][n]; u32x2 o; o.x = cvt_pk_bf16(gelu_f(v[0]), gelu_f(v[1])); o.y = cvt_pk_bf16(gelu_f(v[2]), gelu_f(v[3])); *(u32x2*)(rp + bj * 128 + n * 16) = o; } }
    }
};
struct EpiOut { bf16* O; const float* bias;
    __device__ __forceinline__ const float* bias_ptr(const Unit& u) const { return bias ? bias + u.pn * 256 : nullptr; }
    __device__ __forceinline__ void operator()(const f32x4 (&acc)[2][2][4][2], const Unit& u, int wr, int wc, int fr, int fq, const LAS float* lb) const {
        const int row0 = u.pm * 256 + wr * 64 + fr, col0 = u.pn * 256 + wc * 32 + 4 * fq;
        f32x4 bv[2][2];
#pragma unroll
        for (int bj = 0; bj < 2; ++bj)
#pragma unroll
            for (int n = 0; n < 2; ++n) bv[bj][n] = bias ? *(const LAS f32x4*)(lb + wc * 32 + 4 * fq + bj * 128 + n * 16) : (f32x4){0.f, 0.f, 0.f, 0.f};
#pragma unroll
        for (int ai = 0; ai < 2; ++ai)
#pragma unroll
            for (int m = 0; m < 4; ++m) { bf16* rp = O + (size_t)(row0 + ai * 128 + m * 16) * D + col0;
#pragma unroll
                for (int bj = 0; bj < 2; ++bj)
#pragma unroll
                    for (int n = 0; n < 2; ++n) { const f32x4 v = acc[ai][bj][m][n] + bv[bj][n]; u32x2 o; o.x = cvt_pk_bf16(v[0], v[1]); o.y = cvt_pk_bf16(v[2], v[3]); *(u32x2*)(rp + bj * 128 + n * 16) = o; } }
    }
};
template <bool F8> struct EpiUp { unsigned char* O; const float* bias;
    __device__ __forceinline__ const float* bias_ptr(const Unit& u) const { return bias + (size_t)u.e * 2048 + u.pn * 256; }
    __device__ __forceinline__ void operator()(const f32x4 (&acc)[2][2][4][2], const Unit& u, int wr, int wc, int fr, int fq, const LAS float* lb) const {
        const int row0 = u.pm * 256 + wr * 64 + fr, a0 = u.pn * 128 + wc * 16 + 4 * fq;
        const float asc = F8 ? 1.0f / (F8_WSCALE * F8_HSCALE) : 1.0f;
        f32x4 bg[2], bl[2];
#pragma unroll
        for (int bj = 0; bj < 2; ++bj) { const LAS float* bp = lb + 2 * (wc * 16 + 4 * fq + 64 * bj); const f32x4 p0 = *(const LAS f32x4*)bp, p1 = *(const LAS f32x4*)(bp + 4);
            bg[bj] = (f32x4){p0[0], p0[2], p1[0], p1[2]}; bl[bj] = (f32x4){p0[1], p0[3], p1[1], p1[3]}; }
#pragma unroll
        for (int ai = 0; ai < 2; ++ai)
#pragma unroll
            for (int m = 0; m < 4; ++m) { const size_t ro = (size_t)(row0 + ai * 128 + m * 16) * D + a0;
#pragma unroll
                for (int bj = 0; bj < 2; ++bj) { const f32x4 g = acc[ai][bj][m][0] * asc + bg[bj], l = acc[ai][bj][m][1] * asc + bl[bj]; float r[4];
#pragma unroll
                    for (int j = 0; j < 4; ++j) { const float gg = fminf(g[j], 7.0f), ll = fminf(fmaxf(l[j], -7.0f), 7.0f); r[j] = gg * sigmoid_f(1.702f * gg) * (ll + 1.0f); }
                    if constexpr (F8) { int w = __builtin_amdgcn_cvt_pk_fp8_f32(r[0] * F8_ASCALE, r[1] * F8_ASCALE, 0, false); w = __builtin_amdgcn_cvt_pk_fp8_f32(r[2] * F8_ASCALE, r[3] * F8_ASCALE, w, true);
                        *(int*)(O + ro + bj * 64) = w; }
                    else { u32x2 o; o.x = cvt_pk_bf16(r[0], r[1]); o.y = cvt_pk_bf16(r[2], r[3]); *(u32x2*)((bf16*)O + ro + bj * 64) = o; } } }
    }
};
struct EpiDown8 { unsigned char* O; const float* bias; float asc;
    static constexpr int NST = 16;
    __device__ __forceinline__ const float* bias_ptr(const Unit& u) const { return bias + (size_t)u.e * 1024 + u.pn * 256; }
    __device__ __forceinline__ void operator()(const f32x4 (&acc)[2][2][4][2], const Unit& u, int wr, int wc, int fr, int fq, const LAS float* lb) const {
        const int row0 = u.pm * 256 + wr * 64 + fr, col0 = u.pn * 256 + wc * 32 + 8 * fq;
        f32x4 bv[2][2];
#pragma unroll
        for (int bj = 0; bj < 2; ++bj)
#pragma unroll
            for (int n = 0; n < 2; ++n) bv[bj][n] = *(const LAS f32x4*)(lb + wc * 32 + 8 * fq + bj * 128 + 4 * n) * F8_YSCALE;
        const float sc = asc * F8_YSCALE;
#pragma unroll
        for (int ai = 0; ai < 2; ++ai)
#pragma unroll
            for (int m = 0; m < 4; ++m) { unsigned char* rp = O + (size_t)(row0 + ai * 128 + m * 16) * D + col0;
#pragma unroll
                for (int bj = 0; bj < 2; ++bj) { const f32x4 v0 = acc[ai][bj][m][0] * sc + bv[bj][0], v1 = acc[ai][bj][m][1] * sc + bv[bj][1];
                    int w0 = __builtin_amdgcn_cvt_pk_fp8_f32(v0[0], v0[1], 0, false); w0 = __builtin_amdgcn_cvt_pk_fp8_f32(v0[2], v0[3], w0, true);
                    int w1 = __builtin_amdgcn_cvt_pk_fp8_f32(v1[0], v1[1], 0, false); w1 = __builtin_amdgcn_cvt_pk_fp8_f32(v1[2], v1[3], w1, true);
                    *(u32x2*)(rp + bj * 128) = (u32x2){(unsigned)w0, (unsigned)w1}; } }
    }
};
struct EpiDown { bf16* O; const float* bias; float asc;
    __device__ __forceinline__ const float* bias_ptr(const Unit& u) const { return bias + (size_t)u.e * 1024 + u.pn * 256; }
    __device__ __forceinline__ void operator()(const f32x4 (&acc)[2][2][4][2], const Unit& u, int wr, int wc, int fr, int fq, const LAS float* lb) const {
        const int row0 = u.pm * 256 + wr * 64 + fr, col0 = u.pn * 256 + wc * 32 + 4 * fq;
        f32x4 bv[2][2];
#pragma unroll
        for (int bj = 0; bj < 2; ++bj)
#pragma unroll
            for (int n = 0; n < 2; ++n) bv[bj][n] = *(const LAS f32x4*)(lb + wc * 32 + 4 * fq + bj * 128 + n * 16);
#pragma unroll
        for (int ai = 0; ai < 2; ++ai)
#pragma unroll
            for (int m = 0; m < 4; ++m) { bf16* rp = O + (size_t)(row0 + ai * 128 + m * 16) * D + col0;
#pragma unroll
                for (int bj = 0; bj < 2; ++bj)
#pragma unroll
                    for (int n = 0; n < 2; ++n) { const f32x4 v = acc[ai][bj][m][n] * asc + bv[bj][n]; u32x2 o; o.x = cvt_pk_bf16(v[0], v[1]); o.y = cvt_pk_bf16(v[2], v[3]); *(u32x2*)(rp + bj * 128 + n * 16) = o; } }
    }
};

constexpr int G8_BK = 64, G8_HALF = 128, G8_HTB = G8_HALF * G8_BK * 2, G8_STAGE_BYTES = 8 * G8_HTB;
__device__ __forceinline__ int g8_lds_byte(int r, int c) { const int st = (r >> 4) * 2 + (c >> 5), rr = r & 15, cc = c & 31, ob = rr * 64 + cc * 2; return st * 1024 + (ob ^ (((ob >> 9) & 1) << 5)); }
__device__ __forceinline__ void g8_stage_rc(int b, int& R, int& C) { const int st = b / 1024, sb = b % 1024, swz = sb ^ (((sb >> 9) & 1) << 5); R = (st >> 1) * 16 + swz / 64; C = (st & 1) * 32 + (swz % 64) / 2; }
__device__ __forceinline__ u32x4 g8_avoff(int pm, const int* gather, int tid, int KB) {
    int t2 = tid; asm volatile("" : "+v"(t2));
    int R, C; g8_stage_rc(t2 * 16, R, C);
    const int* gp = gather + pm * 256 + R;
    const unsigned r00 = gp[0], r01 = gp[64], r10 = gp[128], r11 = gp[192], c2 = (unsigned)(C * 2), k2 = (unsigned)KB;
    return (u32x4){r00 * k2 + c2, r01 * k2 + c2, r10 * k2 + c2, r11 * k2 + c2};
}
template <bool GATHER, bool FP8, class Epi>
__device__ __forceinline__ void gemm_fast(const void* A, const int* gather, const int K, const Sched& S, const Epi& E, LAS unsigned char* lds, int tid) {
    const int wid = __builtin_amdgcn_readfirstlane(tid >> 6), lane = tid & 63, wr = wid >> 2, wc = wid & 3, fr = lane & 15, fq = lane >> 4;
    const int KB = FP8 ? K : 2 * K, nt = KB / 128;
    unsigned voff; { int R, C; g8_stage_rc(tid * 16, R, C); voff = (unsigned)(R * KB + C * 2); }
    const size_t kstep = (size_t)128, hstep = (size_t)G8_HALF * KB, qstep = (size_t)64 * KB, tstep = 2 * hstep;
    const unsigned ldsw = (unsigned)wid * 1024u;
    const int aoff = g8_lds_byte(wr * 64 + fr, fq * (FP8 ? 16 : 8)), boff = g8_lds_byte(wc * 32 + fr, fq * (FP8 ? 16 : 8));
    constexpr int KSTR = FP8 ? 16 : 1024;
#define G8_SA(b, h) (((b) * 2 + (h)) * G8_HTB)
#define G8_SB(b, h) ((4 + (b) * 2 + (h)) * G8_HTB)
#define G8_GLDS(gp, ldsoff) __builtin_amdgcn_global_load_lds((const unsigned*)(gp), (LAS unsigned*)(lds + (ldsoff)), 16, 0, 0)
#define G8_STAGE_D(bufoff, gbase) do { G8_GLDS((const char*)(gbase) + voff, (bufoff) + ldsw); G8_GLDS((const char*)(gbase) + qstep + voff, (bufoff) + ldsw + 8192); } while (0)
#define G8_STAGE_A(bufoff, kb, h) do { if constexpr (GATHER) { G8_GLDS((kb) + va[(h) * 2], (bufoff) + ldsw); G8_GLDS((kb) + va[(h) * 2 + 1], (bufoff) + ldsw + 8192); } \
        else { G8_STAGE_D(bufoff, (kb) + (h) * hstep); } } while (0)
#define G8_LDA(dst, b, h) do { _Pragma("unroll") for (int m = 0; m < 4; ++m) _Pragma("unroll") for (int k = 0; k < 2; ++k) dst[m][k] = *(const LAS bf16x8*)(lds + G8_SA(b, h) + aoff + m * 2048 + k * KSTR); } while (0)
#define G8_LDB(dst, b, h) do { _Pragma("unroll") for (int n = 0; n < 2; ++n) _Pragma("unroll") for (int k = 0; k < 2; ++k) dst[n][k] = *(const LAS bf16x8*)(lds + G8_SB(b, h) + boff + n * 2048 + k * KSTR); } while (0)
#define G8_CAT(x) __builtin_shufflevector(__builtin_bit_cast(i32x4, (x)[0]), __builtin_bit_cast(i32x4, (x)[1]), 0, 1, 2, 3, 4, 5, 6, 7)
#define G8_MMA(ai, bj, At, Bt) do { __builtin_amdgcn_s_setprio(1); _Pragma("unroll") for (int m = 0; m < 4; ++m) _Pragma("unroll") for (int n = 0; n < 2; ++n) { \
        if constexpr (FP8) acc[ai][bj][m][n] = __builtin_amdgcn_mfma_scale_f32_16x16x128_f8f6f4(G8_CAT(Bt[n]), G8_CAT(At[m]), acc[ai][bj][m][n], 0, 0, 0, 0x7f7f7f7f, 0, 0x7f7f7f7f); \
        else { _Pragma("unroll") for (int k = 0; k < 2; ++k) acc[ai][bj][m][n] = __builtin_amdgcn_mfma_f32_16x16x32_bf16(Bt[n][k], At[m][k], acc[ai][bj][m][n], 0, 0, 0); } } \
        __builtin_amdgcn_s_setprio(0); } while (0)
#define G8_WAIT_V(n) asm volatile("s_waitcnt vmcnt(" #n ")" ::: "memory")
#define G8_WAIT_L(n) asm volatile("s_waitcnt lgkmcnt(" #n ")" ::: "memory")
#define G8_BAR __builtin_amdgcn_s_barrier()
#define G8_SCHED __builtin_amdgcn_sched_barrier(0)
    Unit cur, nxt; int ui = 0;
    if (!S.next(0, cur)) return;
    f32x4 acc[2][2][4][2];
#pragma unroll
    for (int a = 0; a < 2; ++a)
#pragma unroll
        for (int b = 0; b < 2; ++b)
#pragma unroll
            for (int m = 0; m < 4; ++m)
#pragma unroll
                for (int n = 0; n < 2; ++n) acc[a][b][m][n] = (f32x4){0.f, 0.f, 0.f, 0.f};
    bf16x8 At[4][2], B0[2][2], B1[2][2];
    u32x4 va = (u32x4){0u, 0u, 0u, 0u};
    if constexpr (GATHER) va = g8_avoff(cur.pm, gather, tid, KB);
    constexpr int G8_IDX = G8_STAGE_BYTES, G8_BIAS = G8_STAGE_BYTES + 1024;
    { const float* bp0 = E.bias_ptr(cur); if (bp0 && wid == 0) G8_GLDS((const char*)bp0 + lane * 16, G8_BIAS); }
    const char* cB = (const char*)cur.bt; const char* cA = (const char*)A + (GATHER ? (size_t)0 : (size_t)cur.pm * tstep);
    G8_STAGE_D(G8_SB(0, 0), cB); G8_STAGE_D(G8_SB(0, 1), cB + hstep); G8_STAGE_A(G8_SA(0, 0), cA, 0); G8_STAGE_A(G8_SA(0, 1), cA, 1);
    if (wr == 1) G8_BAR;
    G8_WAIT_V(2); G8_BAR;
    G8_STAGE_D(G8_SB(1, 0), cB + kstep); G8_STAGE_A(G8_SA(1, 0), cA + kstep, 0); G8_STAGE_D(G8_SB(1, 1), cB + hstep + kstep);
    G8_WAIT_V(6); G8_BAR;
    for (;;) {
        const bool has_next = S.next(ui + 1, nxt);
        if constexpr (GATHER) { if (has_next && wid == 1) G8_GLDS((const char*)(gather + nxt.pm * 256) + lane * 16, G8_IDX); }
        const char* nB = has_next ? (const char*)nxt.bt : cB;
        const char* nA = (GATHER || !has_next) ? cA : (const char*)A + (size_t)nxt.pm * tstep;
#pragma unroll 1
        for (int t = 0; t < nt; t += 2) {
            const bool last = (t == nt - 2);
            const char* a1 = cA + (size_t)(t + 1) * kstep;
            const char* a2 = last ? nA : cA + (size_t)(t + 2) * kstep; const char* b2 = last ? nB : cB + (size_t)(t + 2) * kstep;
            const char* a3 = a2 + kstep; const char* b3 = b2 + kstep;
            G8_LDB(B0, 0, 0); G8_LDB(B1, 0, 1); G8_SCHED; G8_LDA(At, 0, 0); G8_STAGE_A(G8_SA(1, 1), a1, 1);
            if (last && has_next && wid == 0) { const float* bpn = E.bias_ptr(nxt); if (bpn) G8_GLDS((const char*)bpn + lane * 16, G8_BIAS + ((ui + 1) & 1) * 1024); }
            if constexpr (GATHER) { if (last && has_next) {
                int t2 = tid; asm volatile("" : "+v"(t2)); int R, C; g8_stage_rc(t2 * 16, R, C); const LAS int* ip = (const LAS int*)(lds + G8_IDX) + R; const unsigned c2 = (unsigned)(C * 2), k2 = (unsigned)KB;
                va = (u32x4){(unsigned)ip[0] * k2 + c2, (unsigned)ip[64] * k2 + c2, (unsigned)ip[128] * k2 + c2, (unsigned)ip[192] * k2 + c2}; } }
            G8_WAIT_V(8); G8_WAIT_L(0); G8_BAR; G8_MMA(0, 0, At, B0); G8_MMA(0, 1, At, B1); G8_BAR; G8_SCHED;
            G8_LDA(At, 0, 1); G8_STAGE_D(G8_SB(0, 0), b2); G8_STAGE_D(G8_SB(0, 1), b2 + hstep); G8_STAGE_A(G8_SA(0, 0), a2, 0);
            G8_WAIT_V(8); G8_WAIT_L(0); G8_BAR; G8_MMA(1, 0, At, B0); G8_MMA(1, 1, At, B1); G8_BAR; G8_SCHED;
            G8_LDB(B0, 1, 0); G8_LDB(B1, 1, 1); G8_SCHED; G8_LDA(At, 1, 0); G8_STAGE_A(G8_SA(0, 1), a2, 1);
            G8_WAIT_V(8); G8_WAIT_L(0); G8_BAR; G8_MMA(0, 0, At, B0); G8_MMA(0, 1, At, B1); G8_BAR; G8_SCHED;
            G8_LDA(At, 1, 1); G8_STAGE_D(G8_SB(1, 0), b3); G8_STAGE_D(G8_SB(1, 1), b3 + hstep); G8_STAGE_A(G8_SA(1, 0), a3, 0);
            G8_WAIT_V(8); G8_WAIT_L(0); G8_BAR; G8_MMA(1, 0, At, B0); G8_MMA(1, 1, At, B1); G8_BAR; G8_SCHED;
        }
        if (wr == 0) G8_BAR;
        { int t3 = tid; asm volatile("" : "+v"(t3)); const int l3 = t3 & 63; E(acc, cur, wr, wc, l3 & 15, l3 >> 4, (const LAS float*)(lds + G8_BIAS + (ui & 1) * 1024)); }
        if (!has_next) break;
#pragma unroll
        for (int a = 0; a < 2; ++a)
#pragma unroll
            for (int b = 0; b < 2; ++b)
#pragma unroll
                for (int m = 0; m < 4; ++m)
#pragma unroll
                    for (int n = 0; n < 2; ++n) acc[a][b][m][n] = (f32x4){0.f, 0.f, 0.f, 0.f};
        cur = nxt; cB = nB; cA = nA; ++ui;
        if (wr == 1) G8_BAR;
    }
    G8_WAIT_V(0);
    G8_BAR;
#undef G8_SA
#undef G8_SB
#undef G8_GLDS
#undef G8_STAGE_D
#undef G8_STAGE_A
#undef G8_LDA
#undef G8_LDB
#undef G8_MMA
#undef G8_CAT
#undef G8_WAIT_V
#undef G8_WAIT_L
#undef G8_BAR
#undef G8_SCHED
}

__device__ __forceinline__ float logsigmoid_f(float x) { return fminf(x, 0.f) - log1pf(__expf(-fabsf(x))); }
__device__ __forceinline__ void phase_gla_prep(KA a, int li, LAS unsigned char* lds, int tid, int bx, int G) {
    const int lane = tid & 63, wave = __builtin_amdgcn_readfirstlane(tid >> 6), fr = lane & 15, fq = lane >> 4;
    unsigned char* ws = a->ws;
    const bf16* qkvr = (const bf16*)(ws + WS_BIG); const float* lr = (const float*)(ws + WS_LR);
    bf16* QE = (bf16*)(ws + WS_QE); bf16* KET = (bf16*)(ws + WS_KET); bf16* PP = (bf16*)(ws + WS_P); bf16* VT = (bf16*)(ws + WS_VT); float* EL = (float*)(ws + WS_EL);
    constexpr int LS = 136, VLS = 264;
    LAS bf16* qes = (LAS bf16*)lds;
    LAS bf16* kes = qes + 64 * LS;
    LAS float* lrs = (LAS float*)(kes + 64 * LS);
    LAS float* segtot = lrs + 1024;
    LAS bf16* vraw = (LAS bf16*)(segtot + 512);
    const int d = tid & 127, seg = tid >> 7;
    const int so = tid & 15, sr = tid >> 4;
    for (int it = bx; it < 4096; it += G) {
        const int chunk = it & 63, dir = (it >> 6) & 1, h = (it >> 7) & 3, b = it >> 9;
        const int row0 = b * SEQ + chunk * 64;
        const size_t cidx = (size_t)(((dir * 8 + b) * 4 + h) * 64 + chunk);
        const float* wg2 = a->in[dir ? I_GWG2B : I_GWG2F] + (size_t)li * 16 * 512 + h * 128 + d; const float bgd = a->in[dir ? I_GBGB : I_GBGF][(size_t)li * 512 + h * 128 + d];
#pragma unroll
        for (int k2 = 0; k2 < 2; ++k2) { const int p = sr + 32 * k2; const bf16* src = qkvr + (size_t)(row0 + p) * GLA_MAIN + h * 128 + 8 * so;
            const u32x4 qv = *(const u32x4*)src, kv = *(const u32x4*)(src + 512);
            *(LAS u32x4*)(qes + p * LS + 8 * so) = qv; *(LAS u32x4*)(kes + p * LS + 8 * so) = kv; }
        if (dir == 0) {
#pragma unroll
            for (int k4 = 0; k4 < 4; ++k4) { const int idx = tid + 512 * k4, p = idx >> 5, oc = idx & 31;
                *(LAS u32x4*)(vraw + p * VLS + 8 * oc) = *(const u32x4*)(qkvr + (size_t)(row0 + p) * GLA_MAIN + 1024 + h * 256 + 8 * oc); }
        }
        for (int i = tid; i < 1024; i += NTHREADS) lrs[i] = lr[(size_t)(row0 + (i >> 4)) * 32 + dir * 16 + (i & 15)];
        float wcol[16];
#pragma unroll
        for (int r = 0; r < 16; ++r) wcol[r] = wg2[r * 512];
        __syncthreads();
        float g[16];
#pragma unroll
        for (int s2 = 0; s2 < 16; ++s2) { const LAS float* lp = lrs + (seg * 16 + s2) * 16; float x = bgd;
#pragma unroll
            for (int r4 = 0; r4 < 4; ++r4) { const f32x4 l4 = *(const LAS f32x4*)(lp + 4 * r4); x += l4[0] * wcol[4 * r4] + l4[1] * wcol[4 * r4 + 1] + l4[2] * wcol[4 * r4 + 2] + l4[3] * wcol[4 * r4 + 3]; }
            g[s2] = (fminf(x, 0.f) - __logf(1.0f + __expf(-fabsf(x)))) * (1.0f / 16.0f); }
        if (dir == 0) {
#pragma unroll
            for (int s2 = 1; s2 < 16; ++s2) g[s2] += g[s2 - 1];
        } else {
#pragma unroll
            for (int s2 = 14; s2 >= 0; --s2) g[s2] += g[s2 + 1];
        }
        segtot[seg * 128 + d] = dir ? g[0] : g[15];
        __syncthreads();
        float pre = 0.f, total = 0.f;
#pragma unroll
        for (int sg = 0; sg < 4; ++sg) { const float t = segtot[sg * 128 + d]; total += t; if (dir ? (sg > seg) : (sg < seg)) pre += t; }
        if (seg == 0) EL[cidx * 128 + d] = __expf(total);
        unsigned kt[8];
#pragma unroll
        for (int s2 = 0; s2 < 16; s2 += 2) {
            unsigned kw[2];
#pragma unroll
            for (int u = 0; u < 2; ++u) { const int p = seg * 16 + s2 + u;
                const float q = bf2f(qes[p * LS + d]), k = bf2f(kes[p * LS + d]); const float bb = g[s2 + u] + pre;
                const float eb_ = __expf(bb); const unsigned qw = cvt_pk_bf16(q * eb_, 0.f) & 0xffffu; kw[u] = cvt_pk_bf16(k * __builtin_amdgcn_rcpf(eb_), 0.f) & 0xffffu;
                qes[p * LS + d] = (bf16)qw; kes[p * LS + d] = (bf16)kw[u]; }
            kt[s2 >> 1] = kw[0] | (kw[1] << 16);
        }
        { bf16* kp = KET + cidx * 8192 + (size_t)d * 64 + seg * 16; *(u32x4*)kp = (u32x4){kt[0], kt[1], kt[2], kt[3]}; *(u32x4*)(kp + 8) = (u32x4){kt[4], kt[5], kt[6], kt[7]}; }
        __syncthreads();
#pragma unroll
        for (int k2 = 0; k2 < 2; ++k2) { const int p = sr + 32 * k2; *(u32x4*)(QE + ((size_t)dir * T + row0 + p) * 512 + h * 128 + 8 * so) = *(const LAS u32x4*)(qes + p * LS + 8 * so); }
        { const int jt = wave & 3;
#pragma unroll
          for (int ii = 0; ii < 2; ++ii) { const int itile = 2 * (wave >> 2) + ii;
            f32x4 acc = (f32x4){0.f, 0.f, 0.f, 0.f};
            const bool dead = dir ? (jt < itile) : (jt > itile);
            if (!dead) {
#pragma unroll
                for (int ks = 0; ks < 4; ++ks) { const bf16x8 kf = *(const LAS bf16x8*)(kes + (jt * 16 + fr) * LS + ks * 32 + 8 * fq), qf = *(const LAS bf16x8*)(qes + (itile * 16 + fr) * LS + ks * 32 + 8 * fq);
                    acc = __builtin_amdgcn_mfma_f32_16x16x32_bf16(kf, qf, acc, 0, 0, 0); }
            }
            const int i = itile * 16 + fr, j0 = jt * 16 + 4 * fq; float pv[4];
#pragma unroll
            for (int jj = 0; jj < 4; ++jj) { const int j = j0 + jj; const bool keep = dir ? (j >= i) : (j <= i); pv[jj] = keep ? acc[jj] : 0.f; }
            u32x2 o; o.x = cvt_pk_bf16(pv[0], pv[1]); o.y = cvt_pk_bf16(pv[2], pv[3]);
            *(u32x2*)(PP + cidx * 4096 + (size_t)i * 64 + j0) = o; } }
        if (dir == 0) {
            const int e = tid & 255, jh = tid >> 8; unsigned w[16];
#pragma unroll
            for (int jj = 0; jj < 32; jj += 2) w[jj >> 1] = (unsigned)vraw[(jh * 32 + jj) * VLS + e] | ((unsigned)vraw[(jh * 32 + jj + 1) * VLS + e] << 16);
            bf16* vp = VT + ((size_t)((b * 4 + h) * 64 + chunk) * 256 + e) * 64 + jh * 32;
#pragma unroll
            for (int q4 = 0; q4 < 4; ++q4) *(u32x4*)(vp + 8 * q4) = (u32x4){w[4 * q4], w[4 * q4 + 1], w[4 * q4 + 2], w[4 * q4 + 3]};
        }
        __syncthreads();
    }
}
__device__ __forceinline__ void phase_gla_scan(KA a, LAS unsigned char* lds, int tid, int bx, int G) {
    const int lane = tid & 63, wave = __builtin_amdgcn_readfirstlane(tid >> 6), fr = lane & 15, fq = lane >> 4;
    unsigned char* ws = a->ws;
    const char* QE = (const char*)(ws + WS_QE); const char* KET = (const char*)(ws + WS_KET); const char* PP = (const char*)(ws + WS_P); const char* VT = (const char*)(ws + WS_VT); const float* EL = (const float*)(ws + WS_EL);
    constexpr int SS = 136, ST_BYTES = 2 * 64 * SS * 2, BUFB = 50176, OQ = 0, OP = 16384, OK_ = 24576, OV = 40960, OE = 49152;
    LAS bf16* ST = (LAS bf16*)lds;
    LAS unsigned char* BUF = lds + ST_BYTES;
    const int et0 = 2 * (wave & 1), dt0 = 2 * (wave >> 1), itile = wave >> 1;
    const int rq = lane >> 4, pq = lane & 15, r8 = lane >> 3, p8 = lane & 7;
    unsigned sq[2], sk[2], sp, sv;
#pragma unroll
    for (int j = 0; j < 2; ++j) { const int r = 4 * (wave + 8 * j) + rq; sq[j] = (unsigned)(r * 1024 + ((pq ^ (r & 15)) * 16)); const int dk = 8 * (wave + 8 * j) + r8; sk[j] = (unsigned)(dk * 128 + ((p8 ^ ((dk >> 1) & 7)) * 16)); }
    { const int r = 8 * wave + r8; sp = (unsigned)(r * 128 + ((p8 ^ ((r >> 1) & 7)) * 16)); sv = sp; }
    const int kx = fr >> 1;
    for (int it0 = bx; it0 < 256; it0 += G) {
        const int it = (G == 256) ? ((it0 & 7) * 32 + (it0 >> 3)) : it0;
        const int b = it >> 5, h = (it >> 3) & 3, dir = (it >> 2) & 1, es = it & 3;
        bf16* OO = (bf16*)(ws + (dir ? WS_OB : WS_OF));
        __syncthreads();
        for (int i = tid; i < 64 * SS / 2; i += NTHREADS) ((LAS unsigned*)ST)[i] = 0u;
        f32x4 accS[2][2];
#pragma unroll
        for (int x = 0; x < 2; ++x)
#pragma unroll
            for (int y = 0; y < 2; ++y) accS[x][y] = (f32x4){0.f, 0.f, 0.f, 0.f};
        const size_t cbase = (size_t)((dir * 8 + b) * 4 + h) * 64;
        const char* qsrc = QE + (((size_t)dir * T + (size_t)b * SEQ) * 512 + h * 128) * 2;
        const char* psrc = PP + cbase * 8192;
        const char* ksrc = KET + cbase * 16384;
        const char* vsrc = VT + ((size_t)(b * 4 + h) * 64 * 256 + es * 64) * 128;
        const char* esrc = (const char*)(EL + cbase * 128);
        char* ob = (char*)(OO + ((size_t)b * SEQ + itile * 16) * D + h * 256 + es * 64 + et0 * 16);
        const unsigned le = (unsigned)fq * 16u, lo = (unsigned)(fr * D + 4 * fq) * 2u;
#define SC_DMA(c_, bi_) do { const size_t c__ = (size_t)(c_); LAS unsigned char* bb_ = BUF + (bi_) * BUFB + wave * 1024; \
            __builtin_amdgcn_global_load_lds((const unsigned*)(qsrc + c__ * 65536 + sq[0]), (LAS unsigned*)(bb_ + OQ), 16, 0, 0); \
            __builtin_amdgcn_global_load_lds((const unsigned*)(qsrc + c__ * 65536 + sq[1]), (LAS unsigned*)(bb_ + OQ + 8192), 16, 0, 0); \
            __builtin_amdgcn_global_load_lds((const unsigned*)(psrc + c__ * 8192 + sp), (LAS unsigned*)(bb_ + OP), 16, 0, 0); \
            __builtin_amdgcn_global_load_lds((const unsigned*)(ksrc + c__ * 16384 + sk[0]), (LAS unsigned*)(bb_ + OK_), 16, 0, 0); \
            __builtin_amdgcn_global_load_lds((const unsigned*)(ksrc + c__ * 16384 + sk[1]), (LAS unsigned*)(bb_ + OK_ + 8192), 16, 0, 0); \
            __builtin_amdgcn_global_load_lds((const unsigned*)(vsrc + c__ * 32768 + sv), (LAS unsigned*)(bb_ + OV), 16, 0, 0); \
            if (wave == 0) __builtin_amdgcn_global_load_lds((const unsigned*)(esrc + c__ * 512 + lane * 16), (LAS unsigned*)(BUF + (bi_) * BUFB + OE), 16, 0, 0); } while (0)
        SC_DMA(dir ? 63 : 0, 0);
        asm volatile("s_waitcnt vmcnt(0)" ::: "memory");
        __syncthreads();
#pragma unroll 1
        for (int cc = 0; cc < 64; ++cc) {
            const int c = dir ? 63 - cc : cc;
            if (cc + 1 < 64) SC_DMA(dir ? 62 - cc : cc + 1, (cc + 1) & 1);
            const LAS unsigned char* B = BUF + (cc & 1) * BUFB;
            const f32x4 el0 = *(const LAS f32x4*)(B + OE + dt0 * 64 + le), el1 = *(const LAS f32x4*)(B + OE + dt0 * 64 + 64 + le);
            const LAS bf16* Sr = ST + (cc & 1) * 64 * SS; LAS bf16* Sw = ST + ((cc + 1) & 1) * 64 * SS;
            bf16x8 qf[4], pf[2], vf[2][2];
#pragma unroll
            for (int ks = 0; ks < 4; ++ks) qf[ks] = *(const LAS bf16x8*)(B + OQ + (itile * 16 + fr) * 256 + (((4 * ks + fq) ^ fr) * 16));
#pragma unroll
            for (int ks = 0; ks < 2; ++ks) pf[ks] = *(const LAS bf16x8*)(B + OP + (itile * 16 + fr) * 128 + (((4 * ks + fq) ^ kx) * 16));
#pragma unroll
            for (int et = 0; et < 2; ++et)
#pragma unroll
                for (int ks = 0; ks < 2; ++ks) vf[et][ks] = *(const LAS bf16x8*)(B + OV + ((et0 + et) * 16 + fr) * 128 + (((4 * ks + fq) ^ kx) * 16));
#pragma unroll
            for (int et = 0; et < 2; ++et) { f32x4 ao = (f32x4){0.f, 0.f, 0.f, 0.f};
#pragma unroll
                for (int ks = 0; ks < 4; ++ks) { const bf16x8 sf = *(const LAS bf16x8*)(Sr + ((et0 + et) * 16 + fr) * SS + ks * 32 + 8 * fq); ao = __builtin_amdgcn_mfma_f32_16x16x32_bf16(sf, qf[ks], ao, 0, 0, 0); }
#pragma unroll
                for (int ks = 0; ks < 2; ++ks) ao = __builtin_amdgcn_mfma_f32_16x16x32_bf16(vf[et][ks], pf[ks], ao, 0, 0, 0);
                u32x2 o; o.x = cvt_pk_bf16(ao[0], ao[1]); o.y = cvt_pk_bf16(ao[2], ao[3]);
                *(u32x2*)(ob + (size_t)c * (64 * D * 2) + et * 32 + lo) = o; }
#pragma unroll
            for (int dt = 0; dt < 2; ++dt) { bf16x8 kf[2];
#pragma unroll
                for (int ks = 0; ks < 2; ++ks) kf[ks] = *(const LAS bf16x8*)(B + OK_ + ((dt0 + dt) * 16 + fr) * 128 + (((4 * ks + fq) ^ kx) * 16));
#pragma unroll
                for (int et = 0; et < 2; ++et) {
#pragma unroll
                    for (int ks = 0; ks < 2; ++ks) accS[dt][et] = __builtin_amdgcn_mfma_f32_16x16x32_bf16(kf[ks], vf[et][ks], accS[dt][et], 0, 0, 0);
                    accS[dt][et] = accS[dt][et] * (dt ? el1 : el0);
                    u32x2 o; o.x = cvt_pk_bf16(accS[dt][et][0], accS[dt][et][1]); o.y = cvt_pk_bf16(accS[dt][et][2], accS[dt][et][3]);
                    *(LAS u32x2*)(Sw + ((et0 + et) * 16 + fr) * SS + (dt0 + dt) * 16 + 4 * fq) = o; } }
            asm volatile("s_waitcnt vmcnt(0)" ::: "memory");
            __syncthreads();
        }
#undef SC_DMA
    }
}

__device__ __forceinline__ void phase_gla_post(KA a, int li, int tid, int bx, int G) {
    const int lane = tid & 63, wave = tid >> 6;
    const bf16* of = (const bf16*)(a->ws + WS_OF); const bf16* ob = (const bf16*)(a->ws + WS_OB); const bf16* qkvr = (const bf16*)(a->ws + WS_BIG); bf16* A2 = (bf16*)(a->ws + WS_A2);
    const float* ng = a->in[I_GNORM] + (size_t)li * 256 + (lane & 15) * 16;
    float g[16];
#pragma unroll
    for (int j = 0; j < 16; ++j) g[j] = ng[j];
    for (int token = bx * NWAVES + wave; token < T; token += G * NWAVES) {
        const u32x4 f0 = *(const u32x4*)(of + (size_t)token * D + 16 * lane), f1 = *(const u32x4*)(of + (size_t)token * D + 16 * lane + 8);
        const u32x4 b0 = *(const u32x4*)(ob + (size_t)token * D + 16 * lane), b1 = *(const u32x4*)(ob + (size_t)token * D + 16 * lane + 8);
        const u32x4 r0 = *(const u32x4*)(qkvr + (size_t)token * GLA_MAIN + 2048 + 16 * lane), r1 = *(const u32x4*)(qkvr + (size_t)token * GLA_MAIN + 2048 + 16 * lane + 8);
        float o[16], r[16];
#pragma unroll
        for (int q = 0; q < 4; ++q) { o[2 * q] = bf_lo(f0[q]) + bf_lo(b0[q]); o[2 * q + 1] = bf_hi(f0[q]) + bf_hi(b0[q]); o[8 + 2 * q] = bf_lo(f1[q]) + bf_lo(b1[q]); o[8 + 2 * q + 1] = bf_hi(f1[q]) + bf_hi(b1[q]);
            r[2 * q] = bf_lo(r0[q]); r[2 * q + 1] = bf_hi(r0[q]); r[8 + 2 * q] = bf_lo(r1[q]); r[8 + 2 * q + 1] = bf_hi(r1[q]); }
        float ss = 0.f;
#pragma unroll
        for (int j = 0; j < 16; ++j) ss += o[j] * o[j];
        ss += shfl_xor_f(ss, 1, lane); ss += shfl_xor_f(ss, 2, lane); ss += shfl_xor_f(ss, 4, lane); ss += shfl_xor_f(ss, 8, lane);
        const float rstd = 1.0f / sqrtf(ss * (1.0f / 256.0f) + LN_EPS);
        unsigned w[8];
#pragma unroll
        for (int q = 0; q < 8; ++q) w[q] = cvt_pk_bf16(o[2 * q] * rstd * g[2 * q] * silu_f(r[2 * q]), o[2 * q + 1] * rstd * g[2 * q + 1] * silu_f(r[2 * q + 1]));
        *(u32x4*)(A2 + (size_t)token * D + 16 * lane) = (u32x4){w[0], w[1], w[2], w[3]}; *(u32x4*)(A2 + (size_t)token * D + 16 * lane + 8) = (u32x4){w[4], w[5], w[6], w[7]};
    }
}

__device__ __forceinline__ void phase_sgu_core(KA a, int li, LAS unsigned char* lds, int tid, int bx, int G) {
    const int lane = tid & 63, wave = __builtin_amdgcn_readfirstlane(tid >> 6), fr = lane & 15, fq = lane >> 4;
    unsigned char* ws = a->ws;
    const bf16* z = (const bf16*)(ws + WS_BIG); bf16* A2 = (bf16*)(ws + WS_A2);
    const float* lng = a->in[I_SLNG] + (size_t)li * 1024; const float* lnb = a->in[I_SLNB] + (size_t)li * 1024;
    const bf16* wsp = (const bf16*)(ws + WS_SGUWS) + (size_t)li * 8 * 128 * 128; const float* bs = a->in[I_SBS] + (size_t)li * 8 * 128;
    constexpr int VS = 132;
    LAS bf16* vn = (LAS bf16*)lds;
    LAS float* st_mean = (LAS float*)(lds + 2 * 128 * VS * 2); LAS float* st_rstd = st_mean + 128;
    const int co = tid & 15, qr = tid >> 4;
    for (int it = bx; it < T / 128; it += G) {
        const int row0 = it * 128;
        __syncthreads();
#pragma unroll 1
        for (int rr = 0; rr < 16; ++rr) { const int q = wave * 16 + rr; const bf16* vp = z + (size_t)(row0 + q) * 2048 + 1024 + 16 * lane;
            const u32x4 v0 = *(const u32x4*)vp, v1 = *(const u32x4*)(vp + 8); float x[16];
#pragma unroll
            for (int k = 0; k < 4; ++k) { x[2 * k] = bf_lo(v0[k]); x[2 * k + 1] = bf_hi(v0[k]); x[8 + 2 * k] = bf_lo(v1[k]); x[8 + 2 * k + 1] = bf_hi(v1[k]); }
            float s1 = 0.f;
#pragma unroll
            for (int k = 0; k < 16; ++k) s1 += x[k];
            const float mean = wave_sum(s1, lane) * (1.0f / 1024.0f); float s2 = 0.f;
#pragma unroll
            for (int k = 0; k < 16; ++k) { const float dd = x[k] - mean; s2 += dd * dd; }
            const float rstd = 1.0f / sqrtf(wave_sum(s2, lane) * (1.0f / 1024.0f) + LN_EPS);
            if (lane == 0) { st_mean[q] = mean; st_rstd[q] = rstd; } }
        __syncthreads();
        const int p = wave * 16 + fr;
#pragma unroll 1
        for (int g = 0; g < 8; ++g) {
            LAS bf16* vb = vn + (g & 1) * 128 * VS;
            {
                const f32x4 g0 = *(const f32x4*)(lng + g * 128 + 8 * co), g1 = *(const f32x4*)(lng + g * 128 + 8 * co + 4), b0 = *(const f32x4*)(lnb + g * 128 + 8 * co), b1 = *(const f32x4*)(lnb + g * 128 + 8 * co + 4);
#pragma unroll
                for (int k = 0; k < 4; ++k) { const int q = qr + 32 * k; const u32x4 w = *(const u32x4*)(z + (size_t)(row0 + q) * 2048 + 1024 + g * 128 + 8 * co);
                    const float m = st_mean[q], r = st_rstd[q];
                    u32x2 o0, o1;
                    o0.x = cvt_pk_bf16((bf_lo(w.x) - m) * r * g0[0] + b0[0], (bf_hi(w.x) - m) * r * g0[1] + b0[1]); o0.y = cvt_pk_bf16((bf_lo(w.y) - m) * r * g0[2] + b0[2], (bf_hi(w.y) - m) * r * g0[3] + b0[3]);
                    o1.x = cvt_pk_bf16((bf_lo(w.z) - m) * r * g1[0] + b1[0], (bf_hi(w.z) - m) * r * g1[1] + b1[1]); o1.y = cvt_pk_bf16((bf_lo(w.w) - m) * r * g1[2] + b1[2], (bf_hi(w.w) - m) * r * g1[3] + b1[3]);
                    *(LAS u32x2*)(vb + q * VS + 8 * co) = o0; *(LAS u32x2*)(vb + q * VS + 8 * co + 4) = o1; }
            }
            bf16x8 wf[4];
#pragma unroll
            for (int ks = 0; ks < 4; ++ks) wf[ks] = *(const bf16x8*)(wsp + ((size_t)g * 128 + p) * 128 + ks * 32 + 8 * fq);
            const float bias = bs[g * 128 + p];
            __syncthreads();
#pragma unroll 2
            for (int ct = 0; ct < 8; ++ct) {
                f32x4 acc = (f32x4){0.f, 0.f, 0.f, 0.f};
#pragma unroll
                for (int ks = 0; ks < 4; ++ks) { const LAS bf16* sp = vb + (ks * 32 + 8 * fq) * VS + ct * 16 + fr; unsigned w4[4];
#pragma unroll
                    for (int j2 = 0; j2 < 4; ++j2) w4[j2] = (unsigned)sp[(2 * j2) * VS] | ((unsigned)sp[(2 * j2 + 1) * VS] << 16);
                    const bf16x8 vf = __builtin_bit_cast(bf16x8, (u32x4){w4[0], w4[1], w4[2], w4[3]});
                    acc = __builtin_amdgcn_mfma_f32_16x16x32_bf16(vf, wf[ks], acc, 0, 0, 0); }
                const int c0 = g * 128 + ct * 16 + 4 * fq;
                const u32x2 uu = *(const u32x2*)(z + (size_t)(row0 + p) * 2048 + c0);
                u32x2 o; o.x = cvt_pk_bf16(bf_lo(uu.x) * (acc[0] + bias), bf_hi(uu.x) * (acc[1] + bias)); o.y = cvt_pk_bf16(bf_lo(uu.y) * (acc[2] + bias), bf_hi(uu.y) * (acc[3] + bias));
                *(u32x2*)(A2 + (size_t)(row0 + p) * D + c0) = o;
            }
        }
    }
}

constexpr int PH_PER_LAYER = 10;
constexpr int NPHASES = 2 + PH_PER_LAYER * DEPTH;
#define GEMM_BODY(A, g, K, S, E) gemm_fast<false, false>(A, g, K, S, E, lds, tid)
#define GEMM_BODY_G(A, g, K, S, E) gemm_fast<true, false>(A, g, K, S, E, lds, tid)
#define GEMM_BODY8(A, g, K, S, E) gemm_fast<false, true>(A, g, K, S, E, lds, tid)
#define GEMM_BODY8_G(A, g, K, S, E) gemm_fast<true, true>(A, g, K, S, E, lds, tid)
__device__ __forceinline__ void ph_prologue(int wave_s) { PHASE_ENTER(); phase_prologue(a, lds, tid, bx, G); }
__device__ __forceinline__ void ph_rp_init(int wave_s) { PHASE_ENTER(); float* mod = (float*)(ws + WS_MOD);
    RowPass p{}; p.xin = a->in[I_X]; p.hout = (bf16*)(ws + WS_H); p.sc = mod + 1 * 1024; p.sh = mod + 0 * 1024; p.wside = (const bf16*)(ws + WS_GLALR_T); p.lr_out = (float*)(ws + WS_LR); p.has_h = 1; p.has_side = 1;
    row_pass<0>(p, lds, tid, bx, G); }
__device__ __forceinline__ void ph_gla_in(int wave_s, int li) { PHASE_ENTER(); Sched S; S.init(T / 256, GLA_MAIN / 256, G, bx, (const bf16*)(ws + WS_GLAIN_T) + (size_t)li * GLA_MAIN * 1024, 0, nullptr, 2048); EpiGlaIn E{(bf16*)(ws + WS_BIG)}; GEMM_BODY((const bf16*)(ws + WS_H), nullptr, 1024, S, E); }
__device__ __forceinline__ void ph_sgu_in(int wave_s, int li) { PHASE_ENTER(); Sched S; S.init(T / 256, 2048 / 256, G, bx, (const bf16*)(ws + WS_SGUIN_T) + (size_t)li * 2048 * 1024, 0, nullptr, 2048); EpiSguIn E{(bf16*)(ws + WS_BIG), a->in[I_SBIN] + (size_t)li * 2048}; GEMM_BODY((const bf16*)(ws + WS_H), nullptr, 1024, S, E); }
__device__ __forceinline__ void ph_gla_prep(int wave_s, int li) { PHASE_ENTER(); phase_gla_prep(a, li, lds, tid, bx, G); }
__device__ __forceinline__ void ph_gla_scan(int wave_s) { PHASE_ENTER(); phase_gla_scan(a, lds, tid, bx, G); }
__device__ __forceinline__ void ph_sgu_core(int wave_s, int li) { PHASE_ENTER(); phase_sgu_core(a, li, lds, tid, bx, G); }
__device__ __forceinline__ void ph_gla_post(int wave_s, int li) { PHASE_ENTER(); phase_gla_post(a, li, tid, bx, G); }
__device__ __forceinline__ void ph_out(int wave_s, int l) { PHASE_ENTER(); const int li = l >> 1; const bool sgu = (l & 1) != 0;
    Sched S; S.init(T / 256, 4, G, bx, (const bf16*)(ws + (sgu ? WS_SGUOUT_T : WS_GLAOUT_T)) + (size_t)li * 1024 * 1024, 0, nullptr, 2048);
    EpiOut E{(bf16*)(ws + WS_Y), sgu ? a->in[I_SBOUT] + (size_t)li * 1024 : nullptr}; GEMM_BODY((const bf16*)(ws + WS_A2), nullptr, 1024, S, E); }
__device__ __forceinline__ void ph_rp_mid(int wave_s, int l) { PHASE_ENTER(); float* modl = (float*)(ws + WS_MOD) + (size_t)l * 8 * 6144; int* route = (int*)(ws + WS_ROUTE);
    RowPass p{}; p.xin = (l == 0) ? (const void*)a->in[I_X] : (const void*)(ws + WS_X2); p.xin16 = (l != 0); p.y = (const bf16*)(ws + WS_Y); p.xout = ws + WS_X1; p.xout16 = 1; p.hout = (bf16*)(ws + WS_H);
    p.gate = modl + 2 * 1024; p.lng = a->in[I_LNG] + (size_t)(l * 2 + 0) * 1024; p.lnb = a->in[I_LNB] + (size_t)(l * 2 + 0) * 1024; p.sc = modl + 4 * 1024; p.sh = modl + 3 * 1024;
    p.wside = (const bf16*)(ws + WS_ROUTER_T) + (size_t)l * 64 * 1024; p.rbias = a->in[I_RB] + (size_t)l * 32;
    p.topi = route + R_TOPI; p.topw = (float*)(route + R_TOPW); p.hist = route + R_HIST + bx * 32; p.has_h = 1; p.has_side = 1; p.h8out = MOE_FP8 ? (ws + WS_H8) : nullptr;
    row_pass<1>(p, lds, tid, bx, G); }
__device__ __forceinline__ void ph_place(int wave_s) { PHASE_ENTER(); phase_place((int*)(ws + WS_ROUTE), lds, tid, bx, G); }
__device__ __forceinline__ void ph_moe_up(int wave_s, int l) { PHASE_ENTER(); int* route = (int*)(ws + WS_ROUTE); const int ntiles = __builtin_amdgcn_readfirstlane(route[R_NTILES]);
#if MOE_FP8
    Sched S; S.init(ntiles, 8, G, bx, ws + WS_WUP_T + (size_t)l * 32 * 2048 * 1024, (size_t)2048 * 1024, route + R_TILEE, 1024);
    EpiUp<true> E{ws + WS_ACT, a->in[I_BUP] + (size_t)l * 32 * 2048}; GEMM_BODY8_G(ws + WS_H8, route + R_BUFTOK, 1024, S, E); }
#else
    Sched S; S.init(ntiles, 8, G, bx, ws + WS_WUP_T + (size_t)l * 32 * 2048 * 2048, (size_t)2048 * 2048, route + R_TILEE, 2048);
    EpiUp<false> E{ws + WS_ACT, a->in[I_BUP] + (size_t)l * 32 * 2048}; GEMM_BODY_G(ws + WS_H, route + R_BUFTOK, 1024, S, E); }
#endif
__device__ __forceinline__ void ph_moe_down(int wave_s, int l) { PHASE_ENTER(); int* route = (int*)(ws + WS_ROUTE); const int ntiles = __builtin_amdgcn_readfirstlane(route[R_NTILES]);
#if MOE_FP8
    Sched S; S.init(ntiles, 4, G, bx, ws + WS_WDN_T + (size_t)l * 32 * 1024 * 1024, (size_t)1024 * 1024, route + R_TILEE, 1024);
    EpiDown8 E{ws + WS_YS, a->in[I_BDN] + (size_t)l * 32 * 1024, 1.0f / (F8_WSCALE * F8_ASCALE)}; GEMM_BODY8(ws + WS_ACT, nullptr, 1024, S, E); }
#else
    Sched S; S.init(ntiles, 4, G, bx, ws + WS_WDN_T + (size_t)l * 32 * 1024 * 2048, (size_t)1024 * 2048, route + R_TILEE, 2048);
    EpiDown E{(bf16*)(ws + WS_YS), a->in[I_BDN] + (size_t)l * 32 * 1024, 1.0f}; GEMM_BODY(ws + WS_ACT, nullptr, 1024, S, E); }
#endif
__device__ __forceinline__ void ph_rp_end(int wave_s, int l) { PHASE_ENTER(); float* mod = (float*)(ws + WS_MOD); float* modl = mod + (size_t)l * 8 * 6144; int* route = (int*)(ws + WS_ROUTE);
    RowPass p{}; p.xin = ws + WS_X1; p.xin16 = 1; p.xout = (l == DEPTH - 1) ? (void*)a->out : (void*)(ws + WS_X2); p.xout16 = (l != DEPTH - 1); p.hout = (bf16*)(ws + WS_H);
    p.gate = modl + 5 * 1024; p.lng = a->in[I_LNG] + (size_t)(l * 2 + 1) * 1024; p.lnb = a->in[I_LNB] + (size_t)(l * 2 + 1) * 1024;
    p.ys = ws + WS_YS; p.dest = route + R_DEST; p.tw = (const float*)(route + R_TOPW);
    if (l < DEPTH - 1) { float* modn = mod + (size_t)(l + 1) * 8 * 6144; p.sc = modn + 1 * 1024; p.sh = modn + 0 * 1024; p.has_h = 1;
        if (((l + 1) & 1) == 0) { p.has_side = 1; p.wside = (const bf16*)(ws + WS_GLALR_T) + (size_t)((l + 1) >> 1) * 64 * 1024; p.lr_out = (float*)(ws + WS_LR); } }
    row_pass<2>(p, lds, tid, bx, G); }

__global__ void __launch_bounds__(NTHREADS, 2) fwd_kernel(Args a) {
    extern __shared__ __attribute__((aligned(16))) unsigned char lds_raw[];
    LAS unsigned char* lds = (LAS unsigned char*)lds_raw;
    volatile LAS unsigned* MISC = (volatile LAS unsigned*)(lds + MISC_OFF);
    const int tid = threadIdx.x; const int wave_s = __builtin_amdgcn_readfirstlane(tid >> 6);
    if (tid < 32) ((LAS unsigned*)(lds + MISC_OFF))[tid] = 0u;
    __syncthreads();
    unsigned* ctl = (unsigned*)(a.ws + WS_CTL);
    XcdBarrier bar = xcd_barrier_post(ctl + CW_BAR + a.li * XCD_BAR_WORDS, MISC + 8);
    const int lo = a.ph_lo, hi = a.ph_hi;
#ifndef REPK
#define REPK 0
#define REPN 1
#endif
#define REP(kind) for (int rep_ = 0; rep_ < ((REPK == (kind)) ? REPN : 1); ++rep_)
#define IN(k) (lo <= (k) && (k) < hi)
#define SEAM(k) do { if (IN(k) && IN((k) + 1)) xcd_barrier(bar); } while (0)
    if (IN(0)) { REP(3) ph_prologue(wave_s); SEAM(0); }
    if (IN(1)) { ph_rp_init(wave_s); SEAM(1); }
    for (int l = 0; l < DEPTH; ++l) {
        const int pb = 2 + PH_PER_LAYER * l, li = l >> 1; const bool sgu = (l & 1) != 0;
        if (IN(pb + 0)) { REP(10) { if (!sgu) ph_gla_in(wave_s, li); else ph_sgu_in(wave_s, li); } SEAM(pb + 0); }
        if (IN(pb + 1)) { if (!sgu) { REP(12) ph_gla_prep(wave_s, li); SEAM(pb + 1); } }
        if (IN(pb + 2)) { if (!sgu) { REP(1) ph_gla_scan(wave_s); } else { REP(2) ph_sgu_core(wave_s, li); } SEAM(pb + 2); }
        if (IN(pb + 3)) { if (!sgu) { REP(6) ph_gla_post(wave_s, li); SEAM(pb + 3); } }
        if (IN(pb + 4)) { REP(11) ph_out(wave_s, l); SEAM(pb + 4); }
        if (IN(pb + 5)) { REP(4) ph_rp_mid(wave_s, l); SEAM(pb + 5); }
        if (IN(pb + 6)) { REP(7) ph_place(wave_s); SEAM(pb + 6); }
        if (IN(pb + 7)) { REP(8) ph_moe_up(wave_s, l); SEAM(pb + 7); }
        if (IN(pb + 8)) { REP(9) ph_moe_down(wave_s, l); SEAM(pb + 8); }
        if (IN(pb + 9)) { REP(5) ph_rp_end(wave_s, l); SEAM(pb + 9); }
    }
#undef IN
#undef SEAM
}

#ifndef N_LAUNCH_MODE
#define N_LAUNCH_MODE 1
#endif
extern "C" void kernel_launch(void* const* d_in, const int* in_sizes, int n_in, void* d_out, int out_size, void* d_ws, size_t ws_size, hipStream_t stream) {
    static int grid = 0;
    if (grid == 0) {
        if (n_in != 27 || out_size != T * D || ws_size < WS_END) { fprintf(stderr, "kernel_launch: unexpected shapes (n_in %d out %d ws %zu)\n", n_in, out_size, ws_size); grid = -1; return; }
        int dev = 0, cus = 0, per_cu = 0;
        if (hipGetDevice(&dev) != hipSuccess || hipDeviceGetAttribute(&cus, hipDeviceAttributeMultiprocessorCount, dev) != hipSuccess) { grid = -1; return; }
        if (hipFuncSetAttribute((const void*)fwd_kernel, hipFuncAttributeMaxDynamicSharedMemorySize, LDS_BYTES) != hipSuccess) { fprintf(stderr, "kernel_launch: hipFuncSetAttribute failed\n"); grid = -1; return; }
        if (hipOccupancyMaxActiveBlocksPerMultiprocessor(&per_cu, (const void*)fwd_kernel, NTHREADS, LDS_BYTES) != hipSuccess || per_cu < 1) fprintf(stderr, "kernel_launch: occupancy query reports %d\n", per_cu);
        (void)hipGetLastError();
        grid = cus;
        if (grid > 1024) grid = 1024;
    }
    if (grid < 0) return;
    (void)hipMemsetAsync((char*)d_ws + WS_CTL, 0, CTL_ZERO_BYTES, stream);
    Args a{};
    for (int i = 0; i < 27; ++i) a.in[i] = (const float*)d_in[i];
    a.out = (float*)d_out; a.ws = (unsigned char*)d_ws; a.pad = 0;
#if N_LAUNCH_MODE == 1
    a.ph_lo = 0; a.ph_hi = NPHASES; a.li = 0;
    hipLaunchKernelGGL(fwd_kernel, dim3(grid), dim3(NTHREADS), LDS_BYTES, stream, a);
#else
    for (int ph = 0, li = 0; ph < NPHASES; ++ph) {
        if (ph >= 2 && (((ph - 2) % PH_PER_LAYER) == 1 || ((ph - 2) % PH_PER_LAYER) == 3) && (((ph - 2) / PH_PER_LAYER) & 1)) continue;
        a.ph_lo = ph; a.ph_hi = ph + 1; a.li = li++;
        hipLaunchKernelGGL(fwd_kernel, dim3(grid), dim3(NTHREADS), LDS_BYTES, stream, a);
    }
#endif
}
```

```cpp
#include <hip/hip_runtime.h>
#include <cstdio>
#include <cstdint>

#define LAS __attribute__((address_space(3)))
#define GAS __attribute__((address_space(1)))
typedef unsigned short bf16;
typedef short bf16x8 __attribute__((ext_vector_type(8)));
typedef float f32x4 __attribute__((ext_vector_type(4)));
typedef float f32x2 __attribute__((ext_vector_type(2)));
typedef unsigned u32x4 __attribute__((ext_vector_type(4)));
typedef unsigned u32x2 __attribute__((ext_vector_type(2)));
typedef int i32x4 __attribute__((ext_vector_type(4)));
typedef int i32x8 __attribute__((ext_vector_type(8)));

#ifndef MOE_FP8
#define MOE_FP8 1
#endif
constexpr int D = 1024, NB = 8, SEQ = 4096, T = NB * SEQ, DEPTH = 4;
constexpr int NE = 32, TOPK = 4, CAP = T * TOPK + NE * 256;
constexpr int MAXTILES = CAP / 256;
constexpr float ALPHA = 1.681792830507429f;
constexpr float LN_EPS = 1e-5f;
constexpr float F8_WSCALE = 64.0f, F8_HSCALE = 8.0f, F8_ASCALE = 4.0f, F8_YSCALE = 64.0f;
constexpr int GLA_IN = 3104, GLA_MAIN = 3072;
constexpr int NWAVES = 8, NTHREADS = 512;
constexpr int LDS_BYTES = 147456, MISC_OFF = 139264;

constexpr size_t MiB = 1u << 20;
constexpr size_t WS_CTL = 0, CTL_ZERO_BYTES = 2 * MiB;
constexpr size_t WS_MOD = 2 * MiB;
constexpr size_t WS_ROUTE = 4 * MiB;
constexpr size_t WS_LR = 8 * MiB;
constexpr size_t WS_GLAIN_T = 16 * MiB;
constexpr size_t WS_GLALR_T = 28 * MiB;
constexpr size_t WS_ROUTER_T = 29 * MiB;
constexpr size_t WS_SGUWS = 30 * MiB;
constexpr size_t WS_GLAOUT_T = 32 * MiB;
constexpr size_t WS_SGUIN_T = 36 * MiB;
constexpr size_t WS_SGUOUT_T = 44 * MiB;
constexpr size_t WS_WUP_T = 64 * MiB;
constexpr size_t WS_WDN_T = 576 * MiB;
constexpr size_t WS_X1 = 832 * MiB;
constexpr size_t WS_X2 = 960 * MiB;
constexpr size_t WS_H = 1088 * MiB;
constexpr size_t WS_BIG = 1152 * MiB;
constexpr size_t WS_OF = 1344 * MiB;
constexpr size_t WS_OB = 1408 * MiB;
constexpr size_t WS_A2 = 1472 * MiB;
constexpr size_t WS_Y = 1536 * MiB;
constexpr size_t WS_ACT = 1664 * MiB;
constexpr size_t WS_YS = 1936 * MiB;
constexpr size_t WS_QE = 2208 * MiB;
constexpr size_t WS_KET = 2272 * MiB;
constexpr size_t WS_P = 2336 * MiB;
constexpr size_t WS_VT = 2368 * MiB;
constexpr size_t WS_EL = 2432 * MiB;
constexpr size_t WS_H8 = 2440 * MiB;
constexpr size_t WS_END = 2472 * MiB;
constexpr int R_TOPI = 0;
constexpr int R_TOPW = T * 4;
constexpr int R_DEST = 2 * T * 4;
constexpr int R_BUFTOK = 3 * T * 4;
constexpr int R_HIST = R_BUFTOK + CAP;
constexpr int R_TILEE = R_HIST + 1024 * 32;
constexpr int R_NTILES = R_TILEE + 1024;
static_assert((size_t)(R_NTILES + 64) * 4 <= 4 * MiB, "route tables");
constexpr int CW_BAR = 4096;
constexpr int MAX_LAUNCH = 64;

#define RLX_AGENT __ATOMIC_RELAXED, __HIP_MEMORY_SCOPE_AGENT
#define LDS_WAIT() asm volatile("s_waitcnt lgkmcnt(0)" ::: "memory")
#define VM_WAIT() asm volatile("s_waitcnt vmcnt(0)" ::: "memory")
typedef __bf16 bf16x2_t __attribute__((ext_vector_type(2)));
__device__ __forceinline__ unsigned cvt_pk_bf16(float lo, float hi) { const f32x2 v = {lo, hi}; const bf16x2_t r = __builtin_convertvector(v, bf16x2_t); return __builtin_bit_cast(unsigned, r); }
__device__ __forceinline__ float bf_lo(unsigned w) { return __uint_as_float(w << 16); }
__device__ __forceinline__ float bf_hi(unsigned w) { return __uint_as_float(w & 0xffff0000u); }
__device__ __forceinline__ float bf2f(bf16 b) { return __uint_as_float(((unsigned)b) << 16); }
__device__ __forceinline__ float shfl_xor_f(float v, int o, int lane) { return __builtin_bit_cast(float, __builtin_amdgcn_ds_bpermute((lane ^ o) << 2, __builtin_bit_cast(int, v))); }
__device__ __forceinline__ int shfl_i(int v, int src, int lane) { (void)lane; return __builtin_amdgcn_ds_bpermute(src << 2, v); }
__device__ __forceinline__ float wave_sum(float v, int lane) {
#pragma unroll
    for (int o = 1; o < 64; o <<= 1) v += shfl_xor_f(v, o, lane);
    return v;
}
__device__ __forceinline__ float silu_f(float x) { return x * __builtin_amdgcn_rcpf(1.0f + __expf(-x)); }
__device__ __forceinline__ float sigmoid_f(float x) { return __builtin_amdgcn_rcpf(1.0f + __expf(-x)); }
__device__ __forceinline__ float gelu_f(float v) {
    const float av = fabsf(v), t = __builtin_amdgcn_rcpf(av * 0.2316418882f + 1.0f);
    float q = t * 0.5307027145f + (-0.7265760135f); q = q * t + 0.7107068705f; q = q * t + (-0.142248368f); q = q * t + 0.127414796f; q = q * t;
    const float e = __builtin_amdgcn_exp2f((v * v) * (-0.72134752044f));
    const float m = v * (q * e);
    return v < 0.f ? m : v - m;
}

#define XB_TMO      128
#define XB_XCNT(j)  (256  + 64 * (j))
#define XB_XSUB(j)  (1280 + 64 * (j))
#define XB_XGEN(j)  (2304 + 64 * (j))
#define XB_TOP      3328
#define XB_TOPGEN   3392
#define XCD_BAR_WORDS 3456
#define XB_SPIN_CAP (1u << 18)
__device__ __forceinline__ unsigned xb_ld(unsigned* p)              { return __hip_atomic_load(p, __ATOMIC_RELAXED, __HIP_MEMORY_SCOPE_AGENT); }
__device__ __forceinline__ unsigned xb_add(unsigned* p, unsigned v) { return __hip_atomic_fetch_add(p, v, __ATOMIC_RELAXED, __HIP_MEMORY_SCOPE_AGENT); }
__device__ __forceinline__ unsigned xb_xcc_id() { return (unsigned)__builtin_amdgcn_s_getreg((3 << 11) | 20) & 0xFu; }
#define XB_SPIN(cond, bar) do { unsigned _sp = 0; while (cond) { __builtin_amdgcn_s_sleep(1); \
    if ((++_sp & 255u) == 0u) { if (xb_ld(&(bar)[XB_TMO])) break; if (_sp > XB_SPIN_CAP) { atomicAdd(&(bar)[XB_TMO], 1u); break; } } } } while (0)
struct XcdBarrier { unsigned* bar; unsigned x; volatile LAS unsigned* st; };
__device__ __forceinline__ XcdBarrier xcd_barrier_post(unsigned* bar, volatile LAS unsigned* st) {
    XcdBarrier b; b.bar = bar; b.x = xb_xcc_id(); b.st = st;
    if (threadIdx.x == 0) (void)xb_add(&bar[XB_XCNT(b.x)], 1u);
    return b;
}
__device__ __forceinline__ void xcd_barrier_complete(unsigned* bar, unsigned x, unsigned& nloc, unsigned& nx) {
    const unsigned G = gridDim.x * gridDim.y * gridDim.z;
    unsigned sum, cnt, mine, sp = 0u;
    for (;;) {
        sum = 0u; cnt = 0u; mine = 0u;
#pragma unroll
        for (unsigned j = 0; j < 16; ++j) { const unsigned c = xb_ld(&bar[XB_XCNT(j)]); sum += c; cnt += (c > 0u) ? 1u : 0u; mine = (j == x) ? c : mine; }
        if (sum == G) break;
        __builtin_amdgcn_s_sleep(1);
        if ((++sp & 255u) == 0u) { if (xb_ld(&bar[XB_TMO])) break; if (sp > XB_SPIN_CAP) { atomicAdd(&bar[XB_TMO], 1u); break; } }
    }
    nloc = mine > 0u ? mine : 1u; nx = cnt > 0u ? cnt : 1u;
}
__device__ __forceinline__ void xcd_barrier(const XcdBarrier& b) {
    asm volatile("s_waitcnt vmcnt(0)" ::: "memory");
    __syncthreads();
    if (threadIdx.x == 0) {
        unsigned* bar = b.bar;
        __builtin_amdgcn_s_waitcnt(0);
        unsigned nloc = b.st[0], nx = b.st[1];
        if (nloc == 0u) { xcd_barrier_complete(bar, b.x, nloc, nx); b.st[0] = nloc; b.st[1] = nx; }
        const unsigned old = xb_add(&bar[XB_XSUB(b.x)], 1u);
        const unsigned gen = old / nloc;
        if (old + 1u == (gen + 1u) * nloc) {
            __builtin_amdgcn_fence(__ATOMIC_RELEASE, "agent");
            asm volatile("s_waitcnt vmcnt(0)" ::: "memory");
            const unsigned og = xb_add(&bar[XB_TOP], 1u);
            const unsigned tg = og / nx;
            if (og + 1u == (tg + 1u) * nx) xb_add(&bar[XB_TOPGEN], 1u);
            else XB_SPIN(xb_ld(&bar[XB_TOPGEN]) == tg, bar);
            __builtin_amdgcn_fence(__ATOMIC_ACQUIRE, "agent");
            xb_add(&bar[XB_XGEN(b.x)], 1u);
            asm volatile("s_waitcnt vmcnt(0)" ::: "memory");
        } else {
            XB_SPIN(xb_ld(&bar[XB_XGEN(b.x)]) == gen, bar);
            __builtin_amdgcn_fence(__ATOMIC_ACQUIRE, "agent");
            asm volatile("s_waitcnt vmcnt(0)" ::: "memory");
        }
    }
    __syncthreads();
}

struct Args { const float* in[27]; float* out; unsigned char* ws; int ph_lo, ph_hi, li, pad; };
enum { I_X = 0, I_C, I_ADAW, I_ADAB, I_LNG, I_LNB, I_GWIN, I_GWG2F, I_GBGF, I_GWG2B, I_GBGB, I_GNORM, I_GWOUT, I_SWIN, I_SBIN, I_SLNG, I_SLNB, I_SWS, I_SBS, I_SWOUT, I_SBOUT, I_RW, I_RB, I_WUP, I_BUP, I_WDN, I_BDN };

typedef const __attribute__((address_space(4))) Args* KA;
#define PHASE_ENTER() unsigned m1_ = ~0u; asm volatile("" : "+s"(m1_)); int tid = (wave_s << 6) | (int)__builtin_amdgcn_mbcnt_hi(m1_, __builtin_amdgcn_mbcnt_lo(m1_, 0u)); asm volatile("" : "+v"(tid)); int bx = blockIdx.x, G = gridDim.x; asm volatile("" : "+s"(bx), "+s"(G)); \
    KA a = (KA)__builtin_amdgcn_kernarg_segment_ptr(); asm volatile("" : "+s"(a)); unsigned char* ws = a->ws; \
    extern __shared__ __attribute__((aligned(16))) unsigned char lds_raw[]; LAS unsigned char* lds = (LAS unsigned char*)lds_raw; (void)lds; (void)ws; (void)bx; (void)G; (void)tid
__device__ __forceinline__ int swiglu_perm(int o) {
    const int a = o >> 1, h = o & 1, pn = a >> 7, r = a & 127, bj = r >> 6, r2 = r & 63, wc = r2 >> 4, r3 = r2 & 15;
    return 256 * pn + 128 * bj + 32 * wc + 16 * h + r3;
}
__device__ __forceinline__ void conv_tile(const float* W, int K, int N, int k0, int n0, int nw, bf16* dst, int mode, LAS float* scr, int lane) {
    const int c4 = lane & 15, kr = lane >> 4;
    if (4 * c4 < nw) {
        f32x4 ld[16];
#pragma unroll
        for (int i = 0; i < 16; ++i) ld[i] = __builtin_nontemporal_load((const f32x4*)(W + (size_t)(k0 + 4 * i + kr) * N + n0 + 4 * c4));
#pragma unroll
        for (int i = 0; i < 16; ++i) { LAS float* s = scr + (4 * i + kr) * 65 + 4 * c4; s[0] = ld[i][0]; s[1] = ld[i][1]; s[2] = ld[i][2]; s[3] = ld[i][3]; }
    }
    LDS_WAIT(); asm volatile("" ::: "memory");
    const int kc = lane & 7, ns = lane >> 3;
    for (int j = 0; j < nw / 8; ++j) {
        const int n = ns + 8 * j; const LAS float* s = scr + (8 * kc) * 65 + n;
        float v[8];
#pragma unroll
        for (int q = 0; q < 8; ++q) v[q] = s[q * 65];
        u32x4 o; o.x = cvt_pk_bf16(v[0], v[1]); o.y = cvt_pk_bf16(v[2], v[3]); o.z = cvt_pk_bf16(v[4], v[5]); o.w = cvt_pk_bf16(v[6], v[7]);
        const int ng = n0 + n;
        if (mode >= 3 && mode <= 5) {
            const int row = (mode == 4) ? swiglu_perm(ng) : (mode == 5) ? ((ng & ~31) + 16 * ((ng >> 2) & 1) + 4 * ((ng >> 3) & 3) + (ng & 3)) : ng;
            int w0 = __builtin_amdgcn_cvt_pk_fp8_f32(v[0] * F8_WSCALE, v[1] * F8_WSCALE, 0, false); w0 = __builtin_amdgcn_cvt_pk_fp8_f32(v[2] * F8_WSCALE, v[3] * F8_WSCALE, w0, true);
            int w1 = __builtin_amdgcn_cvt_pk_fp8_f32(v[4] * F8_WSCALE, v[5] * F8_WSCALE, 0, false); w1 = __builtin_amdgcn_cvt_pk_fp8_f32(v[6] * F8_WSCALE, v[7] * F8_WSCALE, w1, true);
            *(u32x2*)((unsigned char*)dst + (size_t)row * K + k0 + 8 * kc) = (u32x2){(unsigned)w0, (unsigned)w1};
        } else if (mode == 2) {
            *(u32x4*)(dst + (size_t)n * K + k0 + 8 * kc) = o;
            u32x4 l; l.x = cvt_pk_bf16(v[0] - bf_lo(o.x), v[1] - bf_hi(o.x)); l.y = cvt_pk_bf16(v[2] - bf_lo(o.y), v[3] - bf_hi(o.y));
            l.z = cvt_pk_bf16(v[4] - bf_lo(o.z), v[5] - bf_hi(o.z)); l.w = cvt_pk_bf16(v[6] - bf_lo(o.w), v[7] - bf_hi(o.w));
            *(u32x4*)(dst + (size_t)(32 + n) * K + k0 + 8 * kc) = l;
        } else {
            const int row = (mode == 1) ? swiglu_perm(ng) : (mode == 6) ? ((ng & ~31) + 16 * ((ng >> 2) & 1) + 4 * ((ng >> 3) & 3) + (ng & 3)) : ng;
            *(u32x4*)(dst + (size_t)row * K + k0 + 8 * kc) = o;
        }
    }
    LDS_WAIT(); asm volatile("" ::: "memory");
}

__device__ __forceinline__ void phase_prologue(KA a, LAS unsigned char* lds, int tid, int bx, int G) {
    const int lane = tid & 63, wave = __builtin_amdgcn_readfirstlane(tid >> 6);
    unsigned char* ws = a->ws;
    for (int slab = bx; slab < 192; slab += G) {
        LAS float* sc = (LAS float*)lds;
        LAS float* red = (LAS float*)(lds + 32768);
        for (int i = tid; i < 8 * 1024; i += NTHREADS) sc[i] = silu_f(a->in[I_C][i]);
        __syncthreads();
        const int g0 = slab * 128, l = g0 / 6144, e0 = g0 % 6144;
        const int c4 = tid & 31, seg = tid >> 5;
        f32x4 acc[8];
#pragma unroll
        for (int b = 0; b < 8; ++b) acc[b] = (f32x4){0.f, 0.f, 0.f, 0.f};
        const float* wp = a->in[I_ADAW] + ((size_t)l * 1024 + seg * 64) * 6144 + e0 + 4 * c4;
#pragma unroll 8
        for (int d = 0; d < 64; ++d) { const f32x4 w = __builtin_nontemporal_load((const f32x4*)(wp + (size_t)d * 6144));
#pragma unroll
            for (int b = 0; b < 8; ++b) acc[b] += w * sc[b * 1024 + seg * 64 + d]; }
#pragma unroll
        for (int b = 0; b < 8; ++b) *(LAS f32x4*)(red + (seg * 8 + b) * 128 + 4 * c4) = acc[b];
        __syncthreads();
        for (int o = tid; o < 1024; o += NTHREADS) { const int b = o >> 7, c = o & 127; float s = a->in[I_ADAB][l * 6144 + e0 + c];
#pragma unroll
            for (int sg = 0; sg < 16; ++sg) s += red[(sg * 8 + b) * 128 + c];
            ((float*)(ws + WS_MOD))[((size_t)l * 8 + b) * 6144 + e0 + c] = s; }
        __syncthreads();
    }
    LAS float* scr = (LAS float*)(lds + wave * 16640);
    const int gw = bx * NWAVES + wave, NGW = G * NWAVES;
    constexpr int N_UP = 128 * 16 * 32, N_DN = 128 * 16 * 16, N_GIN = 2 * 16 * 48, N_GLR = 2 * 16, N_GOUT = 2 * 256, N_SIN = 2 * 16 * 32, N_SOUT = 2 * 256, N_RT = 4 * 16;
    constexpr int NITEMS = N_UP + N_DN + N_GIN + N_GLR + N_GOUT + N_SIN + N_SOUT + N_RT;
    for (int it = gw; it < NITEMS; it += NGW) {
        int r = it;
        if (r < N_UP) { const int m = r >> 9, q = r & 511, kt = q >> 5, nt = q & 31;
            conv_tile(a->in[I_WUP] + (size_t)m * 1024 * 2048, 1024, 2048, kt * 64, nt * 64, 64, (bf16*)(ws + WS_WUP_T + (size_t)m * 2048 * 1024 * (MOE_FP8 ? 1 : 2)), MOE_FP8 ? 4 : 1, scr, lane); continue; } r -= N_UP;
        if (r < N_DN) { const int m = r >> 8, q = r & 255, kt = q >> 4, nt = q & 15;
            conv_tile(a->in[I_WDN] + (size_t)m * 1024 * 1024, 1024, 1024, kt * 64, nt * 64, 64, (bf16*)(ws + WS_WDN_T + (size_t)m * 1024 * 1024 * (MOE_FP8 ? 1 : 2)), MOE_FP8 ? 5 : 0, scr, lane); continue; } r -= N_DN;
        if (r < N_GIN) { const int m = r / 768, q = r % 768, kt = q / 48, nt = q % 48;
            conv_tile(a->in[I_GWIN] + (size_t)m * 1024 * GLA_IN, 1024, GLA_IN, kt * 64, nt * 64, 64, (bf16*)(ws + WS_GLAIN_T) + (size_t)m * GLA_MAIN * 1024, 6, scr, lane); continue; } r -= N_GIN;
        if (r < N_GLR) { const int m = r >> 4, kt = r & 15;
            conv_tile(a->in[I_GWIN] + (size_t)m * 1024 * GLA_IN, 1024, GLA_IN, kt * 64, GLA_MAIN, 32, (bf16*)(ws + WS_GLALR_T) + (size_t)m * 64 * 1024, 2, scr, lane); continue; } r -= N_GLR;
        if (r < N_GOUT) { const int m = r >> 8, q = r & 255, kt = q >> 4, nt = q & 15;
            conv_tile(a->in[I_GWOUT] + (size_t)m * 1024 * 1024, 1024, 1024, kt * 64, nt * 64, 64, (bf16*)(ws + WS_GLAOUT_T) + (size_t)m * 1024 * 1024, 6, scr, lane); continue; } r -= N_GOUT;
        if (r < N_SIN) { const int m = r >> 9, q = r & 511, kt = q >> 5, nt = q & 31;
            conv_tile(a->in[I_SWIN] + (size_t)m * 1024 * 2048, 1024, 2048, kt * 64, nt * 64, 64, (bf16*)(ws + WS_SGUIN_T) + (size_t)m * 2048 * 1024, 6, scr, lane); continue; } r -= N_SIN;
        if (r < N_SOUT) { const int m = r >> 8, q = r & 255, kt = q >> 4, nt = q & 15;
            conv_tile(a->in[I_SWOUT] + (size_t)m * 1024 * 1024, 1024, 1024, kt * 64, nt * 64, 64, (bf16*)(ws + WS_SGUOUT_T) + (size_t)m * 1024 * 1024, 6, scr, lane); continue; } r -= N_SOUT;
        { const int m = r >> 4, kt = r & 15;
            conv_tile(a->in[I_RW] + (size_t)m * 1024 * 32, 1024, 32, kt * 64, 0, 32, (bf16*)(ws + WS_ROUTER_T) + (size_t)m * 64 * 1024, 2, scr, lane); }
    }
    { bf16* d = (bf16*)(ws + WS_SGUWS); const float* s = a->in[I_SWS];
      for (int i = (bx * NTHREADS + tid) * 4; i < 2 * 8 * 128 * 128; i += G * NTHREADS * 4) { const f32x4 v = *(const f32x4*)(s + i); u32x2 o; o.x = cvt_pk_bf16(v[0], v[1]); o.y = cvt_pk_bf16(v[2], v[3]); *(u32x2*)(d + i) = o; } }
}

struct RowPass {
    const void* xin; const bf16* y; void* xout; bf16* hout; unsigned char* h8out; int xin16, xout16;
    const float* gate; const float* lng; const float* lnb; const float* sc; const float* sh;
    const bf16* wside;
    float* lr_out;
    const float* rbias;
    int* topi; float* topw; int* hist;
    const void* ys; const int* dest; const float* tw;
    int has_h, has_side;
};
template <int MODE>
__device__ __forceinline__ void row_pass(const RowPass& p, LAS unsigned char* lds, int tid, int bx, int G) {
    const int lane = tid & 63, wave = __builtin_amdgcn_readfirstlane(tid >> 6);
    constexpr int HS = 1032;
    LAS bf16* Hhi = (LAS bf16*)lds;
    LAS bf16* Hlo = (LAS bf16*)(lds + 16 * HS * 2);
    LAS float* part = (LAS float*)(lds + 2 * 16 * HS * 2);
    LAS float* logit = part + 8 * 32 * 16;
    LAS int* lhist = (LAS int*)(logit + 16 * 32);
    if (MODE == 1) { if (tid < 32) lhist[tid] = 0; }
    const bool side = (p.has_side != 0) && (p.wside != nullptr);
    bf16x8 whi[2][4], wlo[2][4];
    if (side) {
#pragma unroll
        for (int hf = 0; hf < 2; ++hf)
#pragma unroll
            for (int s = 0; s < 4; ++s) { const size_t off = (size_t)(hf * 16 + (lane & 15)) * 1024 + 128 * wave + 32 * s + 8 * (lane >> 4);
                whi[hf][s] = *(const bf16x8*)(p.wside + off); wlo[hf][s] = *(const bf16x8*)(p.wside + 32 * 1024 + off); }
    }
    for (int tile = bx; tile < T / 16; tile += G) {
        const int b = (tile * 16) / SEQ;
#pragma unroll 1
        for (int tt = 0; tt < 2; ++tt) {
            const int tl = 2 * wave + tt, token = tile * 16 + tl;
            f32x4 v[4];
            if (p.xin16) { const bf16* xr = (const bf16*)p.xin + (size_t)token * D + 4 * lane;
#pragma unroll
                for (int j = 0; j < 4; ++j) { const u32x2 q = *(const u32x2*)(xr + 256 * j); v[j] = (f32x4){bf_lo(q.x), bf_hi(q.x), bf_lo(q.y), bf_hi(q.y)}; } }
            else { const float* xr = (const float*)p.xin + (size_t)token * D + 4 * lane;
#pragma unroll
                for (int j = 0; j < 4; ++j) v[j] = *(const f32x4*)(xr + 256 * j); }
            if (MODE == 1) {
                const bf16* yr = p.y + (size_t)token * D + 4 * lane; const float* gp = p.gate + (size_t)b * 6144 + 4 * lane;
#pragma unroll
                for (int j = 0; j < 4; ++j) { const u32x2 yq = *(const u32x2*)(yr + 256 * j); const f32x4 yy = (f32x4){bf_lo(yq.x), bf_hi(yq.x), bf_lo(yq.y), bf_hi(yq.y)}; const f32x4 g = *(const f32x4*)(gp + 256 * j); v[j] = v[j] * ALPHA + (g + 1.0f) * yy; }
            }
            if (MODE == 2) {
                f32x4 ya[4];
#pragma unroll
                for (int j = 0; j < 4; ++j) ya[j] = (f32x4){0.f, 0.f, 0.f, 0.f};
#pragma unroll
                for (int k = 0; k < 4; ++k) { const int ds = p.dest[token * 4 + k];
#if MOE_FP8
                    const float w = p.tw[token * 4 + k] * (1.0f / F8_YSCALE); const unsigned char* yr = (const unsigned char*)p.ys + (size_t)ds * D + 4 * lane;
#pragma unroll
                    for (int j = 0; j < 4; ++j) { const int q = *(const int*)(yr + 256 * j); const f32x2 lo2 = __builtin_amdgcn_cvt_pk_f32_fp8(q, false), hi2 = __builtin_amdgcn_cvt_pk_f32_fp8(q, true); ya[j] += (f32x4){lo2[0], lo2[1], hi2[0], hi2[1]} * w; } }
#else
                    const float w = p.tw[token * 4 + k]; const bf16* yr = (const bf16*)p.ys + (size_t)ds * D + 4 * lane;
#pragma unroll
                    for (int j = 0; j < 4; ++j) { const u32x2 q = *(const u32x2*)(yr + 256 * j); ya[j] += (f32x4){bf_lo(q.x), bf_hi(q.x), bf_lo(q.y), bf_hi(q.y)} * w; } }
#endif
                const float* gp = p.gate + (size_t)b * 6144 + 4 * lane;
#pragma unroll
                for (int j = 0; j < 4; ++j) { const f32x4 g = *(const f32x4*)(gp + 256 * j); v[j] = v[j] * ALPHA + (g + 1.0f) * ya[j]; }
            }
            if (MODE != 0) {
                float s = 0.f;
#pragma unroll
                for (int j = 0; j < 4; ++j) s += (v[j][0] + v[j][1]) + (v[j][2] + v[j][3]);
                const float mean = wave_sum(s, lane) * (1.0f / D); float s2 = 0.f;
#pragma unroll
                for (int j = 0; j < 4; ++j) { v[j] = v[j] - mean; s2 += (v[j][0] * v[j][0] + v[j][1] * v[j][1]) + (v[j][2] * v[j][2] + v[j][3] * v[j][3]); }
                const float rstd = 1.0f / sqrtf(wave_sum(s2, lane) * (1.0f / D) + LN_EPS);
#pragma unroll
                for (int j = 0; j < 4; ++j) { const f32x4 g = *(const f32x4*)(p.lng + 4 * lane + 256 * j), bb = *(const f32x4*)(p.lnb + 4 * lane + 256 * j); v[j] = v[j] * rstd * g + bb; }
                if (p.xout16) { bf16* xo = (bf16*)p.xout + (size_t)token * D + 4 * lane;
#pragma unroll
                    for (int j = 0; j < 4; ++j) { u32x2 o; o.x = cvt_pk_bf16(v[j][0], v[j][1]); o.y = cvt_pk_bf16(v[j][2], v[j][3]); *(u32x2*)(xo + 256 * j) = o; } }
                else { float* xo = (float*)p.xout + (size_t)token * D + 4 * lane;
#pragma unroll
                    for (int j = 0; j < 4; ++j) *(f32x4*)(xo + 256 * j) = v[j]; }
            }
            if (p.has_h) {
                const float* scp = p.sc + (size_t)b * 6144 + 4 * lane; const float* shp = p.sh + (size_t)b * 6144 + 4 * lane;
                bf16* ho = p.hout + (size_t)token * D + 4 * lane;
#pragma unroll
                for (int j = 0; j < 4; ++j) { const f32x4 s1 = *(const f32x4*)(scp + 256 * j), s0 = *(const f32x4*)(shp + 256 * j); const f32x4 h = v[j] * (s1 + 1.0f) + s0;
                    u32x2 o; o.x = cvt_pk_bf16(h[0], h[1]); o.y = cvt_pk_bf16(h[2], h[3]); *(u32x2*)(ho + 256 * j) = o;
                    if (MODE == 1 && p.h8out) { int w8 = __builtin_amdgcn_cvt_pk_fp8_f32(h[0] * F8_HSCALE, h[1] * F8_HSCALE, 0, false); w8 = __builtin_amdgcn_cvt_pk_fp8_f32(h[2] * F8_HSCALE, h[3] * F8_HSCALE, w8, true); *(int*)(p.h8out + (size_t)token * D + 4 * lane + 256 * j) = w8; }
                    if (side) { u32x2 l; l.x = cvt_pk_bf16(h[0] - bf_lo(o.x), h[1] - bf_hi(o.x)); l.y = cvt_pk_bf16(h[2] - bf_lo(o.y), h[3] - bf_hi(o.y));
                        *(LAS u32x2*)(Hhi + tl * HS + 4 * lane + 256 * j) = o; *(LAS u32x2*)(Hlo + tl * HS + 4 * lane + 256 * j) = l; } }
            }
        }
        if (side) {
            __syncthreads();
            f32x4 acc[2]; acc[0] = (f32x4){0.f, 0.f, 0.f, 0.f}; acc[1] = acc[0];
#pragma unroll
            for (int s = 0; s < 4; ++s) { const int ko = (lane & 15) * HS + 128 * wave + 32 * s + 8 * (lane >> 4);
                const bf16x8 bh = *(const LAS bf16x8*)(Hhi + ko), bl = *(const LAS bf16x8*)(Hlo + ko);
#pragma unroll
                for (int hf = 0; hf < 2; ++hf) { acc[hf] = __builtin_amdgcn_mfma_f32_16x16x32_bf16(whi[hf][s], bh, acc[hf], 0, 0, 0);
                    acc[hf] = __builtin_amdgcn_mfma_f32_16x16x32_bf16(wlo[hf][s], bh, acc[hf], 0, 0, 0); acc[hf] = __builtin_amdgcn_mfma_f32_16x16x32_bf16(whi[hf][s], bl, acc[hf], 0, 0, 0); } }
#pragma unroll
            for (int hf = 0; hf < 2; ++hf)
#pragma unroll
                for (int j = 0; j < 4; ++j) part[(wave * 32 + hf * 16 + 4 * (lane >> 4) + j) * 16 + (lane & 15)] = acc[hf][j];
            __syncthreads();
            { const int e = tid >> 4, tk = tid & 15; float s = 0.f;
#pragma unroll
              for (int w = 0; w < 8; ++w) s += part[(w * 32 + e) * 16 + tk];
              if (MODE == 1) logit[tk * 32 + e] = s + p.rbias[e];
              else p.lr_out[(size_t)(tile * 16 + tk) * 32 + e] = s; }
            if (MODE == 1) {
                __syncthreads();
                if (tid < 16) {
                    const int token = tile * 16 + tid; float lv[32];
#pragma unroll
                    for (int e = 0; e < 32; ++e) lv[e] = logit[tid * 32 + e];
                    int bi[4]; float bv[4];
#pragma unroll
                    for (int k = 0; k < 4; ++k) { float m = -3.0e38f; int mi = 0;
#pragma unroll
                        for (int e = 0; e < 32; ++e) { const bool take = lv[e] > m; m = take ? lv[e] : m; mi = take ? e : mi; }
                        bi[k] = mi; bv[k] = m;
#pragma unroll
                        for (int e = 0; e < 32; ++e) lv[e] = (e == mi) ? -3.0e38f : lv[e]; }
                    const float e1 = __expf(bv[1] - bv[0]), e2 = __expf(bv[2] - bv[0]), e3 = __expf(bv[3] - bv[0]); const float inv = 1.0f / (1.0f + e1 + e2 + e3);
                    *(int4*)(p.topi + token * 4) = make_int4(bi[0], bi[1], bi[2], bi[3]);
                    *(f32x4*)(p.topw + token * 4) = (f32x4){inv, e1 * inv, e2 * inv, e3 * inv};
#pragma unroll
                    for (int k = 0; k < 4; ++k) atomicAdd((int*)&lhist[bi[k]], 1);
                }
            }
            __syncthreads();
        }
    }
    if (MODE == 1) { __syncthreads(); if (tid < 32) p.hist[tid] = lhist[tid]; }
}

__device__ __forceinline__ void phase_place(int* route, LAS unsigned char* lds, int tid, int bx, int G) {
    const int lane = tid & 63, wave = tid >> 6;
    LAS int* ptot = (LAS int*)lds;
    LAS int* ppre = ptot + 512;
    LAS int* tot = ppre + 512;
    LAS int* pre = tot + 32;
    LAS int* pstart = pre + 32;
    const int* hist = route + R_HIST;
    { const int e = tid & 31, part = tid >> 5; int st = 0, sp = 0;
      for (int bb = part; bb < G; bb += 16) { const int h = hist[bb * 32 + e]; st += h; if (bb < bx) sp += h; }
      ptot[part * 32 + e] = st; ppre[part * 32 + e] = sp; }
    __syncthreads();
    if (tid < 32) { int st = 0, sp = 0;
#pragma unroll
        for (int q = 0; q < 16; ++q) { st += ptot[q * 32 + tid]; sp += ppre[q * 32 + tid]; }
        tot[tid] = st; pre[tid] = sp; }
    __syncthreads();
    if (tid == 0) { int acc = 0; for (int e = 0; e < 32; ++e) { pstart[e] = acc; acc += (tot[e] + 255) / 256 * 256; } pstart[32] = acc; }
    __syncthreads();
    if (bx == 0) {
        const int ntiles = pstart[32] / 256;
        if (tid == 0) route[R_NTILES] = ntiles;
        for (int t = tid; t < ntiles; t += NTHREADS) { int e = 0; for (int q = 1; q < 32; ++q) if (pstart[q] <= t * 256) e = q; route[R_TILEE + t] = e; }
    }
    for (int e = bx; e < 32; e += G) { const int s0 = pstart[e] + tot[e], s1 = pstart[e + 1]; for (int s = s0 + tid; s < s1; s += NTHREADS) route[R_BUFTOK + s] = 0; }
    if (wave == 0) {
        int run = 0;
        for (int tile = bx; tile < T / 16; tile += G) {
            const int token = tile * 16 + (lane >> 2);
            const int e = route[R_TOPI + tile * 64 + lane];
            const int base = shfl_i(run, e, lane);
            int rank = 0, add = 0;
#pragma unroll 1
            for (int x = 0; x < 32; ++x) { const unsigned long long m = __ballot(e == x); if (e == x) rank = __popcll(m & ((1ull << lane) - 1ull)); if (lane == x) add = __popcll(m); }
            run += add;
            const int ds = pstart[e] + pre[e] + base + rank;
            route[R_DEST + tile * 64 + lane] = ds;
            route[R_BUFTOK + ds] = token;
        }
    }
}

struct Unit { int pm, pn, e; const char* bt; };
constexpr int NXCD = 8, WGM = 8;
struct Sched {
    int nM, nN, nwg, G, c; const char* Bt; size_t estride; const int* tile_e; int KB;
    __device__ __forceinline__ void init(int nM_, int nN_, int G_, int c_, const void* Bt_, size_t es, const int* te, int KB_) { nM = nM_; nN = nN_; nwg = nM * nN; G = G_; c = c_; Bt = (const char*)Bt_; estride = es; tile_e = te; KB = KB_; }
    __device__ __forceinline__ bool next(int i, Unit& u) const {
        const long L = (long)i * G + c; if (L >= nwg) return false;
        int wgid = (int)L; { const int q = nwg / NXCD, r = nwg % NXCD, xcd = wgid % NXCD, off = wgid / NXCD; wgid = (xcd < r ? xcd * (q + 1) : r * (q + 1) + (xcd - r) * q) + off; }
        const int nig = WGM * nN, gid = wgid / nig, fm = gid * WGM, gsz = (nM - fm) < WGM ? (nM - fm) : WGM;
        u.pm = fm + ((wgid % nig) % gsz); u.pn = (wgid % nig) / gsz;
        u.e = tile_e ? __builtin_amdgcn_readfirstlane(tile_e[u.pm]) : 0;
        u.bt = Bt + (size_t)u.e * estride + (size_t)u.pn * 256 * KB;
        return true;
    }
};
struct EpiGlaIn { bf16* O;
    static constexpr int NST = 16;
    __device__ __forceinline__ const float* bias_ptr(const Unit&) const { return nullptr; }
    __device__ __forceinline__ void operator()(const f32x4 (&acc)[2][2][4][2], const Unit& u, int wr, int wc, int fr, int fq, const LAS float*) const {
        const int row0 = u.pm * 256 + wr * 64 + fr, col0 = u.pn * 256 + wc * 32 + 8 * fq; const float sc = (u.pn < 2) ? 0.08838834764831845f : 1.0f;
#pragma unroll
        for (int ai = 0; ai < 2; ++ai)
#pragma unroll
            for (int m = 0; m < 4; ++m) { bf16* rp = O + (size_t)(row0 + ai * 128 + m * 16) * GLA_MAIN + col0;
#pragma unroll
                for (int bj = 0; bj < 2; ++bj) { const f32x4 v0 = acc[ai][bj][m][0] * sc, v1 = acc[ai][bj][m][1] * sc;
                    *(u32x4*)(rp + bj * 128) = (u32x4){cvt_pk_bf16(v0[0], v0[1]), cvt_pk_bf16(v0[2], v0[3]), cvt_pk_bf16(v1[0], v1[1]), cvt_pk_bf16(v1[2], v1[3])}; } }
    }
};
struct EpiSguIn { bf16* O; const float* bias;
    static constexpr int NST = 16;
    __device__ __forceinline__ const float* bias_ptr(const Unit& u) const { return bias + u.pn * 256; }
    __device__ __forceinline__ void operator()(const f32x4 (&acc)[2][2][4][2], const Unit& u, int wr, int wc, int fr, int fq, const LAS float* lb) const {
        const int row0 = u.pm * 256 + wr * 64 + fr, col0 = u.pn * 256 + wc * 32 + 8 * fq;
        f32x4 bv[2][2];
#pragma unroll
        for (int bj = 0; bj < 2; ++bj)
#pragma unroll
            for (int n = 0; n < 2; ++n) bv[bj][n] = *(const LAS f32x4*)(lb + wc * 32 + 8 * fq + bj * 128 + 4 * n);
#pragma unroll
        for (int ai = 0; ai < 2; ++ai)
#pragma unroll
            for (int m = 0; m < 4; ++m) { bf16* rp = O + (size_t)(row0 + ai * 128 + m * 16) * 2048 + col0;
#pragma unroll
                for (int bj = 0; bj < 2; ++bj) { const f32x4 v0 = acc[ai][bj][m][0] + bv[bj][0], v1 = acc[ai][bj][m][1] + bv[bj][1];
                    *(u32x4*)(rp + bj * 128) = (u32x4){cvt_pk_bf16(gelu_f(v0[0]), gelu_f(v0[1])), cvt_pk_bf16(gelu_f(v0[2]), gelu_f(v0[3])), cvt_pk_bf16(gelu_f(v1[0]), gelu_f(v1[1])), cvt_pk_bf16(gelu_f(v1[2]), gelu_f(v1[3]))}; } }
    }
};
struct EpiOut { bf16* O; const float* bias;
    static constexpr int NST = 16;
    __device__ __forceinline__ const float* bias_ptr(const Unit& u) const { return bias ? bias + u.pn * 256 : nullptr; }
    __device__ __forceinline__ void operator()(const f32x4 (&acc)[2][2][4][2], const Unit& u, int wr, int wc, int fr, int fq, const LAS float* lb) const {
        const int row0 = u.pm * 256 + wr * 64 + fr, col0 = u.pn * 256 + wc * 32 + 8 * fq;
        f32x4 bv[2][2];
#pragma unroll
        for (int bj = 0; bj < 2; ++bj)
#pragma unroll
            for (int n = 0; n < 2; ++n) bv[bj][n] = bias ? *(const LAS f32x4*)(lb + wc * 32 + 8 * fq + bj * 128 + 4 * n) : (f32x4){0.f, 0.f, 0.f, 0.f};
#pragma unroll
        for (int ai = 0; ai < 2; ++ai)
#pragma unroll
            for (int m = 0; m < 4; ++m) { bf16* rp = O + (size_t)(row0 + ai * 128 + m * 16) * D + col0;
#pragma unroll
                for (int bj = 0; bj < 2; ++bj) { const f32x4 v0 = acc[ai][bj][m][0] + bv[bj][0], v1 = acc[ai][bj][m][1] + bv[bj][1];
                    *(u32x4*)(rp + bj * 128) = (u32x4){cvt_pk_bf16(v0[0], v0[1]), cvt_pk_bf16(v0[2], v0[3]), cvt_pk_bf16(v1[0], v1[1]), cvt_pk_bf16(v1[2], v1[3])}; } }
    }
};
template <bool F8> struct EpiUp { unsigned char* O; const float* bias;
    __device__ __forceinline__ const float* bias_ptr(const Unit& u) const { return bias + (size_t)u.e * 2048 + u.pn * 256; }
    __device__ __forceinline__ void operator()(const f32x4 (&acc)[2][2][4][2], const Unit& u, int wr, int wc, int fr, int fq, const LAS float* lb) const {
        const int row0 = u.pm * 256 + wr * 64 + fr, a0 = u.pn * 128 + wc * 16 + 4 * fq;
        const float asc = F8 ? 1.0f / (F8_WSCALE * F8_HSCALE) : 1.0f;
        f32x4 bg[2], bl[2];
#pragma unroll
        for (int bj = 0; bj < 2; ++bj) { const LAS float* bp = lb + 2 * (wc * 16 + 4 * fq + 64 * bj); const f32x4 p0 = *(const LAS f32x4*)bp, p1 = *(const LAS f32x4*)(bp + 4);
            bg[bj] = (f32x4){p0[0], p0[2], p1[0], p1[2]}; bl[bj] = (f32x4){p0[1], p0[3], p1[1], p1[3]}; }
#pragma unroll
        for (int ai = 0; ai < 2; ++ai)
#pragma unroll
            for (int m = 0; m < 4; ++m) { const size_t ro = (size_t)(row0 + ai * 128 + m * 16) * D + a0;
#pragma unroll
                for (int bj = 0; bj < 2; ++bj) { const f32x4 g = acc[ai][bj][m][0] * asc + bg[bj], l = acc[ai][bj][m][1] * asc + bl[bj]; float r[4];
#pragma unroll
                    for (int j = 0; j < 4; ++j) { const float gg = fminf(g[j], 7.0f), ll = fminf(fmaxf(l[j], -7.0f), 7.0f); r[j] = gg * sigmoid_f(1.702f * gg) * (ll + 1.0f); }
                    if constexpr (F8) { int w = __builtin_amdgcn_cvt_pk_fp8_f32(r[0] * F8_ASCALE, r[1] * F8_ASCALE, 0, false); w = __builtin_amdgcn_cvt_pk_fp8_f32(r[2] * F8_ASCALE, r[3] * F8_ASCALE, w, true);
                        *(int*)(O + ro + bj * 64) = w; }
                    else { u32x2 o; o.x = cvt_pk_bf16(r[0], r[1]); o.y = cvt_pk_bf16(r[2], r[3]); *(u32x2*)((bf16*)O + ro + bj * 64) = o; } } }
    }
};
struct EpiDown8 { unsigned char* O; const float* bias; float asc;
    static constexpr int NST = 16;
    __device__ __forceinline__ const float* bias_ptr(const Unit& u) const { return bias + (size_t)u.e * 1024 + u.pn * 256; }
    __device__ __forceinline__ void operator()(const f32x4 (&acc)[2][2][4][2], const Unit& u, int wr, int wc, int fr, int fq, const LAS float* lb) const {
        const int row0 = u.pm * 256 + wr * 64 + fr, col0 = u.pn * 256 + wc * 32 + 8 * fq;
        f32x4 bv[2][2];
#pragma unroll
        for (int bj = 0; bj < 2; ++bj)
#pragma unroll
            for (int n = 0; n < 2; ++n) bv[bj][n] = *(const LAS f32x4*)(lb + wc * 32 + 8 * fq + bj * 128 + 4 * n) * F8_YSCALE;
        const float sc = asc * F8_YSCALE;
#pragma unroll
        for (int ai = 0; ai < 2; ++ai)
#pragma unroll
            for (int m = 0; m < 4; ++m) { unsigned char* rp = O + (size_t)(row0 + ai * 128 + m * 16) * D + col0;
#pragma unroll
                for (int bj = 0; bj < 2; ++bj) { const f32x4 v0 = acc[ai][bj][m][0] * sc + bv[bj][0], v1 = acc[ai][bj][m][1] * sc + bv[bj][1];
                    int w0 = __builtin_amdgcn_cvt_pk_fp8_f32(v0[0], v0[1], 0, false); w0 = __builtin_amdgcn_cvt_pk_fp8_f32(v0[2], v0[3], w0, true);
                    int w1 = __builtin_amdgcn_cvt_pk_fp8_f32(v1[0], v1[1], 0, false); w1 = __builtin_amdgcn_cvt_pk_fp8_f32(v1[2], v1[3], w1, true);
                    *(u32x2*)(rp + bj * 128) = (u32x2){(unsigned)w0, (unsigned)w1}; } }
    }
};
struct EpiDown { bf16* O; const float* bias; float asc;
    __device__ __forceinline__ const float* bias_ptr(const Unit& u) const { return bias + (size_t)u.e * 1024 + u.pn * 256; }
    __device__ __forceinline__ void operator()(const f32x4 (&acc)[2][2][4][2], const Unit& u, int wr, int wc, int fr, int fq, const LAS float* lb) const {
        const int row0 = u.pm * 256 + wr * 64 + fr, col0 = u.pn * 256 + wc * 32 + 4 * fq;
        f32x4 bv[2][2];
#pragma unroll
        for (int bj = 0; bj < 2; ++bj)
#pragma unroll
            for (int n = 0; n < 2; ++n) bv[bj][n] = *(const LAS f32x4*)(lb + wc * 32 + 4 * fq + bj * 128 + n * 16);
#pragma unroll
        for (int ai = 0; ai < 2; ++ai)
#pragma unroll
            for (int m = 0; m < 4; ++m) { bf16* rp = O + (size_t)(row0 + ai * 128 + m * 16) * D + col0;
#pragma unroll
                for (int bj = 0; bj < 2; ++bj)
#pragma unroll
                    for (int n = 0; n < 2; ++n) { const f32x4 v = acc[ai][bj][m][n] * asc + bv[bj][n]; u32x2 o; o.x = cvt_pk_bf16(v[0], v[1]); o.y = cvt_pk_bf16(v[2], v[3]); *(u32x2*)(rp + bj * 128 + n * 16) = o; } }
    }
};

constexpr int G8_BK = 64, G8_HALF = 128, G8_HTB = G8_HALF * G8_BK * 2, G8_STAGE_BYTES = 8 * G8_HTB;
__device__ __forceinline__ int g8_lds_byte(int r, int c) { const int st = (r >> 4) * 2 + (c >> 5), rr = r & 15, cc = c & 31, ob = rr * 64 + cc * 2; return st * 1024 + (ob ^ (((ob >> 9) & 1) << 5)); }
__device__ __forceinline__ void g8_stage_rc(int b, int& R, int& C) { const int st = b / 1024, sb = b % 1024, swz = sb ^ (((sb >> 9) & 1) << 5); R = (st >> 1) * 16 + swz / 64; C = (st & 1) * 32 + (swz % 64) / 2; }
__device__ __forceinline__ u32x4 g8_avoff(int pm, const int* gather, int tid, int KB) {
    int t2 = tid; asm volatile("" : "+v"(t2));
    int R, C; g8_stage_rc(t2 * 16, R, C);
    const int* gp = gather + pm * 256 + R;
    const unsigned r00 = gp[0], r01 = gp[64], r10 = gp[128], r11 = gp[192], c2 = (unsigned)(C * 2), k2 = (unsigned)KB;
    return (u32x4){r00 * k2 + c2, r01 * k2 + c2, r10 * k2 + c2, r11 * k2 + c2};
}
template <bool GATHER, bool FP8, class Epi>
__device__ __forceinline__ void gemm_fast(const void* A, const int* gather, const int K, const Sched& S, const Epi& E, LAS unsigned char* lds, int tid) {
    const int wid = __builtin_amdgcn_readfirstlane(tid >> 6), lane = tid & 63, wr = wid >> 2, wc = wid & 3, fr = lane & 15, fq = lane >> 4;
    const int KB = FP8 ? K : 2 * K, nt = KB / 128;
    unsigned voff; { int R, C; g8_stage_rc(tid * 16, R, C); voff = (unsigned)(R * KB + C * 2); }
    const size_t kstep = (size_t)128, hstep = (size_t)G8_HALF * KB, qstep = (size_t)64 * KB, tstep = 2 * hstep;
    const unsigned ldsw = (unsigned)wid * 1024u;
    const int aoff = g8_lds_byte(wr * 64 + fr, fq * (FP8 ? 16 : 8)), boff = g8_lds_byte(wc * 32 + fr, fq * (FP8 ? 16 : 8));
    constexpr int KSTR = FP8 ? 16 : 1024;
#define G8_SA(b, h) (((b) * 2 + (h)) * G8_HTB)
#define G8_SB(b, h) ((4 + (b) * 2 + (h)) * G8_HTB)
#define G8_GLDS(gp, ldsoff) __builtin_amdgcn_global_load_lds((const unsigned*)(gp), (LAS unsigned*)(lds + (ldsoff)), 16, 0, 0)
#define G8_STAGE_D(bufoff, gbase) do { G8_GLDS((const char*)(gbase) + voff, (bufoff) + ldsw); G8_GLDS((const char*)(gbase) + qstep + voff, (bufoff) + ldsw + 8192); } while (0)
#define G8_STAGE_A(bufoff, kb, h) do { if constexpr (GATHER) { G8_GLDS((kb) + va[(h) * 2], (bufoff) + ldsw); G8_GLDS((kb) + va[(h) * 2 + 1], (bufoff) + ldsw + 8192); } \
        else { G8_STAGE_D(bufoff, (kb) + (h) * hstep); } } while (0)
#define G8_LDA(dst, b, h) do { _Pragma("unroll") for (int m = 0; m < 4; ++m) _Pragma("unroll") for (int k = 0; k < 2; ++k) dst[m][k] = *(const LAS bf16x8*)(lds + G8_SA(b, h) + aoff + m * 2048 + k * KSTR); } while (0)
#define G8_LDB(dst, b, h) do { _Pragma("unroll") for (int n = 0; n < 2; ++n) _Pragma("unroll") for (int k = 0; k < 2; ++k) dst[n][k] = *(const LAS bf16x8*)(lds + G8_SB(b, h) + boff + n * 2048 + k * KSTR); } while (0)
#define G8_CAT(x) __builtin_shufflevector(__builtin_bit_cast(i32x4, (x)[0]), __builtin_bit_cast(i32x4, (x)[1]), 0, 1, 2, 3, 4, 5, 6, 7)
#define G8_MMA(ai, bj, At, Bt) do { __builtin_amdgcn_s_setprio(1); _Pragma("unroll") for (int m = 0; m < 4; ++m) _Pragma("unroll") for (int n = 0; n < 2; ++n) { \
        if constexpr (FP8) acc[ai][bj][m][n] = __builtin_amdgcn_mfma_scale_f32_16x16x128_f8f6f4(G8_CAT(Bt[n]), G8_CAT(At[m]), acc[ai][bj][m][n], 0, 0, 0, 0x7f7f7f7f, 0, 0x7f7f7f7f); \
        else { _Pragma("unroll") for (int k = 0; k < 2; ++k) acc[ai][bj][m][n] = __builtin_amdgcn_mfma_f32_16x16x32_bf16(Bt[n][k], At[m][k], acc[ai][bj][m][n], 0, 0, 0); } } \
        __builtin_amdgcn_s_setprio(0); } while (0)
#define G8_WAIT_V(n) asm volatile("s_waitcnt vmcnt(" #n ")" ::: "memory")
#define G8_WAIT_L(n) asm volatile("s_waitcnt lgkmcnt(" #n ")" ::: "memory")
#define G8_BAR __builtin_amdgcn_s_barrier()
#define G8_SCHED __builtin_amdgcn_sched_barrier(0)
    Unit cur, nxt; int ui = 0;
    if (!S.next(0, cur)) return;
    f32x4 acc[2][2][4][2];
#pragma unroll
    for (int a = 0; a < 2; ++a)
#pragma unroll
        for (int b = 0; b < 2; ++b)
#pragma unroll
            for (int m = 0; m < 4; ++m)
#pragma unroll
                for (int n = 0; n < 2; ++n) acc[a][b][m][n] = (f32x4){0.f, 0.f, 0.f, 0.f};
    bf16x8 At[4][2], B0[2][2], B1[2][2];
    u32x4 va = (u32x4){0u, 0u, 0u, 0u};
    if constexpr (GATHER) va = g8_avoff(cur.pm, gather, tid, KB);
    constexpr int G8_IDX = G8_STAGE_BYTES, G8_BIAS = G8_STAGE_BYTES + 1024;
    { const float* bp0 = E.bias_ptr(cur); if (bp0 && wid == 0) G8_GLDS((const char*)bp0 + lane * 16, G8_BIAS); }
    const char* cB = (const char*)cur.bt; const char* cA = (const char*)A + (GATHER ? (size_t)0 : (size_t)cur.pm * tstep);
    G8_STAGE_D(G8_SB(0, 0), cB); G8_STAGE_D(G8_SB(0, 1), cB + hstep); G8_STAGE_A(G8_SA(0, 0), cA, 0); G8_STAGE_A(G8_SA(0, 1), cA, 1);
    if (wr == 1) G8_BAR;
    G8_WAIT_V(2); G8_BAR;
    G8_STAGE_D(G8_SB(1, 0), cB + kstep); G8_STAGE_A(G8_SA(1, 0), cA + kstep, 0); G8_STAGE_D(G8_SB(1, 1), cB + hstep + kstep);
    G8_WAIT_V(6); G8_BAR;
    for (;;) {
        const bool has_next = S.next(ui + 1, nxt);
        if constexpr (GATHER) { if (has_next && wid == 1) G8_GLDS((const char*)(gather + nxt.pm * 256) + lane * 16, G8_IDX); }
        const char* nB = has_next ? (const char*)nxt.bt : cB;
        const char* nA = (GATHER || !has_next) ? cA : (const char*)A + (size_t)nxt.pm * tstep;
#pragma unroll 1
        for (int t = 0; t < nt; t += 2) {
            const bool last = (t == nt - 2);
            const char* a1 = cA + (size_t)(t + 1) * kstep;
            const char* a2 = last ? nA : cA + (size_t)(t + 2) * kstep; const char* b2 = last ? nB : cB + (size_t)(t + 2) * kstep;
            const char* a3 = a2 + kstep; const char* b3 = b2 + kstep;
            G8_LDB(B0, 0, 0); G8_LDB(B1, 0, 1); G8_SCHED; G8_LDA(At, 0, 0); G8_STAGE_A(G8_SA(1, 1), a1, 1);
            if (last && has_next && wid == 0) { const float* bpn = E.bias_ptr(nxt); if (bpn) G8_GLDS((const char*)bpn + lane * 16, G8_BIAS + ((ui + 1) & 1) * 1024); }
            if constexpr (GATHER) { if (last && has_next) {
                int t2 = tid; asm volatile("" : "+v"(t2)); int R, C; g8_stage_rc(t2 * 16, R, C); const LAS int* ip = (const LAS int*)(lds + G8_IDX) + R; const unsigned c2 = (unsigned)(C * 2), k2 = (unsigned)KB;
                va = (u32x4){(unsigned)ip[0] * k2 + c2, (unsigned)ip[64] * k2 + c2, (unsigned)ip[128] * k2 + c2, (unsigned)ip[192] * k2 + c2}; } }
            G8_WAIT_V(8); G8_WAIT_L(0); G8_BAR; G8_MMA(0, 0, At, B0); G8_MMA(0, 1, At, B1); G8_BAR; G8_SCHED;
            G8_LDA(At, 0, 1); G8_STAGE_D(G8_SB(0, 0), b2); G8_STAGE_D(G8_SB(0, 1), b2 + hstep); G8_STAGE_A(G8_SA(0, 0), a2, 0);
            G8_WAIT_V(8); G8_WAIT_L(0); G8_BAR; G8_MMA(1, 0, At, B0); G8_MMA(1, 1, At, B1); G8_BAR; G8_SCHED;
            G8_LDB(B0, 1, 0); G8_LDB(B1, 1, 1); G8_SCHED; G8_LDA(At, 1, 0); G8_STAGE_A(G8_SA(0, 1), a2, 1);
            G8_WAIT_V(8); G8_WAIT_L(0); G8_BAR; G8_MMA(0, 0, At, B0); G8_MMA(0, 1, At, B1); G8_BAR; G8_SCHED;
            G8_LDA(At, 1, 1); G8_STAGE_D(G8_SB(1, 0), b3); G8_STAGE_D(G8_SB(1, 1), b3 + hstep); G8_STAGE_A(G8_SA(1, 0), a3, 0);
            G8_WAIT_V(8); G8_WAIT_L(0); G8_BAR; G8_MMA(1, 0, At, B0); G8_MMA(1, 1, At, B1); G8_BAR; G8_SCHED;
        }
        if (wr == 0) G8_BAR;
        { int t3 = tid; asm volatile("" : "+v"(t3)); const int l3 = t3 & 63; E(acc, cur, wr, wc, l3 & 15, l3 >> 4, (const LAS float*)(lds + G8_BIAS + (ui & 1) * 1024)); }
        if (!has_next) break;
#pragma unroll
        for (int a = 0; a < 2; ++a)
#pragma unroll
            for (int b = 0; b < 2; ++b)
#pragma unroll
                for (int m = 0; m < 4; ++m)
#pragma unroll
                    for (int n = 0; n < 2; ++n) acc[a][b][m][n] = (f32x4){0.f, 0.f, 0.f, 0.f};
        cur = nxt; cB = nB; cA = nA; ++ui;
        if (wr == 1) G8_BAR;
    }
    G8_WAIT_V(0);
    G8_BAR;
#undef G8_SA
#undef G8_SB
#undef G8_GLDS
#undef G8_STAGE_D
#undef G8_STAGE_A
#undef G8_LDA
#undef G8_LDB
#undef G8_MMA
#undef G8_CAT
#undef G8_WAIT_V
#undef G8_WAIT_L
#undef G8_BAR
#undef G8_SCHED
}

__device__ __forceinline__ float logsigmoid_f(float x) { return fminf(x, 0.f) - log1pf(__expf(-fabsf(x))); }
__device__ __forceinline__ void phase_gla_prep(KA a, int li, LAS unsigned char* lds, int tid, int bx, int G) {
    const int lane = tid & 63, wave = __builtin_amdgcn_readfirstlane(tid >> 6), fr = lane & 15, fq = lane >> 4;
    unsigned char* ws = a->ws;
    const bf16* qkvr = (const bf16*)(ws + WS_BIG); const float* lr = (const float*)(ws + WS_LR);
    bf16* QE = (bf16*)(ws + WS_QE); bf16* KET = (bf16*)(ws + WS_KET); bf16* PP = (bf16*)(ws + WS_P); bf16* VT = (bf16*)(ws + WS_VT); float* EL = (float*)(ws + WS_EL);
    constexpr int LS = 136, VLS = 264;
    LAS bf16* qes = (LAS bf16*)lds;
    LAS bf16* kes = qes + 64 * LS;
    LAS float* lrs = (LAS float*)(kes + 64 * LS);
    LAS float* segtot = lrs + 1024;
    LAS bf16* vraw = (LAS bf16*)(segtot + 512);
    const int d = tid & 127, seg = tid >> 7;
    const int so = tid & 15, sr = tid >> 4;
    for (int it = bx; it < 4096; it += G) {
        const int chunk = it & 63, dir = (it >> 6) & 1, h = (it >> 7) & 3, b = it >> 9;
        const int row0 = b * SEQ + chunk * 64;
        const size_t cidx = (size_t)(((dir * 8 + b) * 4 + h) * 64 + chunk);
        const float* wg2 = a->in[dir ? I_GWG2B : I_GWG2F] + (size_t)li * 16 * 512 + h * 128 + d; const float bgd = a->in[dir ? I_GBGB : I_GBGF][(size_t)li * 512 + h * 128 + d];
#pragma unroll
        for (int k2 = 0; k2 < 2; ++k2) { const int p = sr + 32 * k2; const bf16* src = qkvr + (size_t)(row0 + p) * GLA_MAIN + h * 128 + 8 * so;
            const u32x4 qv = *(const u32x4*)src, kv = *(const u32x4*)(src + 512);
            *(LAS u32x4*)(qes + p * LS + 8 * so) = qv; *(LAS u32x4*)(kes + p * LS + 8 * so) = kv; }
        if (dir == 0) {
#pragma unroll
            for (int k4 = 0; k4 < 4; ++k4) { const int idx = tid + 512 * k4, p = idx >> 5, oc = idx & 31;
                *(LAS u32x4*)(vraw + p * VLS + 8 * oc) = *(const u32x4*)(qkvr + (size_t)(row0 + p) * GLA_MAIN + 1024 + h * 256 + 8 * oc); }
        }
        for (int i = tid; i < 1024; i += NTHREADS) lrs[i] = lr[(size_t)(row0 + (i >> 4)) * 32 + dir * 16 + (i & 15)];
        float wcol[16];
#pragma unroll
        for (int r = 0; r < 16; ++r) wcol[r] = wg2[r * 512];
        __syncthreads();
        float g[16];
#pragma unroll
        for (int s2 = 0; s2 < 16; ++s2) { const LAS float* lp = lrs + (seg * 16 + s2) * 16; float x = bgd;
#pragma unroll
            for (int r4 = 0; r4 < 4; ++r4) { const f32x4 l4 = *(const LAS f32x4*)(lp + 4 * r4); x += l4[0] * wcol[4 * r4] + l4[1] * wcol[4 * r4 + 1] + l4[2] * wcol[4 * r4 + 2] + l4[3] * wcol[4 * r4 + 3]; }
            g[s2] = (fminf(x, 0.f) - __logf(1.0f + __expf(-fabsf(x)))) * (1.0f / 16.0f); }
        if (dir == 0) {
#pragma unroll
            for (int s2 = 1; s2 < 16; ++s2) g[s2] += g[s2 - 1];
        } else {
#pragma unroll
            for (int s2 = 14; s2 >= 0; --s2) g[s2] += g[s2 + 1];
        }
        segtot[seg * 128 + d] = dir ? g[0] : g[15];
        __syncthreads();
        float pre = 0.f, total = 0.f;
#pragma unroll
        for (int sg = 0; sg < 4; ++sg) { const float t = segtot[sg * 128 + d]; total += t; if (dir ? (sg > seg) : (sg < seg)) pre += t; }
        if (seg == 0) EL[cidx * 128 + d] = __expf(total);
        unsigned kt[8];
#pragma unroll
        for (int s2 = 0; s2 < 16; s2 += 2) {
            unsigned kw[2];
#pragma unroll
            for (int u = 0; u < 2; ++u) { const int p = seg * 16 + s2 + u;
                const float q = bf2f(qes[p * LS + d]), k = bf2f(kes[p * LS + d]); const float bb = g[s2 + u] + pre;
                const float eb_ = __expf(bb); const unsigned qw = cvt_pk_bf16(q * eb_, 0.f) & 0xffffu; kw[u] = cvt_pk_bf16(k * __builtin_amdgcn_rcpf(eb_), 0.f) & 0xffffu;
                qes[p * LS + d] = (bf16)qw; kes[p * LS + d] = (bf16)kw[u]; }
            kt[s2 >> 1] = kw[0] | (kw[1] << 16);
        }
        { bf16* kp = KET + cidx * 8192 + (size_t)d * 64 + seg * 16; *(u32x4*)kp = (u32x4){kt[0], kt[1], kt[2], kt[3]}; *(u32x4*)(kp + 8) = (u32x4){kt[4], kt[5], kt[6], kt[7]}; }
        __syncthreads();
#pragma unroll
        for (int k2 = 0; k2 < 2; ++k2) { const int p = sr + 32 * k2; *(u32x4*)(QE + ((size_t)dir * T + row0 + p) * 512 + h * 128 + 8 * so) = *(const LAS u32x4*)(qes + p * LS + 8 * so); }
        { const int jt = wave & 3;
#pragma unroll
          for (int ii = 0; ii < 2; ++ii) { const int itile = 2 * (wave >> 2) + ii;
            f32x4 acc = (f32x4){0.f, 0.f, 0.f, 0.f};
            const bool dead = dir ? (jt < itile) : (jt > itile);
            if (!dead) {
#pragma unroll
                for (int ks = 0; ks < 4; ++ks) { const bf16x8 kf = *(const LAS bf16x8*)(kes + (jt * 16 + fr) * LS + ks * 32 + 8 * fq), qf = *(const LAS bf16x8*)(qes + (itile * 16 + fr) * LS + ks * 32 + 8 * fq);
                    acc = __builtin_amdgcn_mfma_f32_16x16x32_bf16(kf, qf, acc, 0, 0, 0); }
            }
            const int i = itile * 16 + fr, j0 = jt * 16 + 4 * fq; float pv[4];
#pragma unroll
            for (int jj = 0; jj < 4; ++jj) { const int j = j0 + jj; const bool keep = dir ? (j >= i) : (j <= i); pv[jj] = keep ? acc[jj] : 0.f; }
            u32x2 o; o.x = cvt_pk_bf16(pv[0], pv[1]); o.y = cvt_pk_bf16(pv[2], pv[3]);
            *(u32x2*)(PP + cidx * 4096 + (size_t)i * 64 + j0) = o; } }
        if (dir == 0) {
            const int e = tid & 255, jh = tid >> 8; unsigned w[16];
#pragma unroll
            for (int jj = 0; jj < 32; jj += 2) w[jj >> 1] = (unsigned)vraw[(jh * 32 + jj) * VLS + e] | ((unsigned)vraw[(jh * 32 + jj + 1) * VLS + e] << 16);
            bf16* vp = VT + ((size_t)((b * 4 + h) * 64 + chunk) * 256 + e) * 64 + jh * 32;
#pragma unroll
            for (int q4 = 0; q4 < 4; ++q4) *(u32x4*)(vp + 8 * q4) = (u32x4){w[4 * q4], w[4 * q4 + 1], w[4 * q4 + 2], w[4 * q4 + 3]};
        }
        __syncthreads();
    }
}
__device__ __forceinline__ void phase_gla_scan(KA a, LAS unsigned char* lds, int tid, int bx, int G) {
    const int lane = tid & 63, wave = __builtin_amdgcn_readfirstlane(tid >> 6), fr = lane & 15, fq = lane >> 4;
    unsigned char* ws = a->ws;
    const char* QE = (const char*)(ws + WS_QE); const char* KET = (const char*)(ws + WS_KET); const char* PP = (const char*)(ws + WS_P); const char* VT = (const char*)(ws + WS_VT); const float* EL = (const float*)(ws + WS_EL);
    constexpr int SS = 136, ST_BYTES = 2 * 64 * SS * 2, BUFB = 50176, OQ = 0, OP = 16384, OK_ = 24576, OV = 40960, OE = 49152;
    LAS bf16* ST = (LAS bf16*)lds;
    LAS unsigned char* BUF = lds + ST_BYTES;
    const int et0 = 2 * (wave & 1), dt0 = 2 * (wave >> 1), itile = wave >> 1;
    const int rq = lane >> 4, pq = lane & 15, r8 = lane >> 3, p8 = lane & 7;
    unsigned sq[2], sk[2], sp, sv;
#pragma unroll
    for (int j = 0; j < 2; ++j) { const int r = 4 * (wave + 8 * j) + rq; sq[j] = (unsigned)(r * 1024 + ((pq ^ (r & 15)) * 16)); const int dk = 8 * (wave + 8 * j) + r8; sk[j] = (unsigned)(dk * 128 + ((p8 ^ ((dk >> 1) & 7)) * 16)); }
    { const int r = 8 * wave + r8; sp = (unsigned)(r * 128 + ((p8 ^ ((r >> 1) & 7)) * 16)); sv = sp; }
    const int kx = fr >> 1;
    for (int it0 = bx; it0 < 256; it0 += G) {
        const int it = (G == 256) ? ((it0 & 7) * 32 + (it0 >> 3)) : it0;
        const int b = it >> 5, h = (it >> 3) & 3, dir = (it >> 2) & 1, es = it & 3;
        bf16* OO = (bf16*)(ws + (dir ? WS_OB : WS_OF));
        __syncthreads();
        for (int i = tid; i < 64 * SS / 2; i += NTHREADS) ((LAS unsigned*)ST)[i] = 0u;
        f32x4 accS[2][2];
#pragma unroll
        for (int x = 0; x < 2; ++x)
#pragma unroll
            for (int y = 0; y < 2; ++y) accS[x][y] = (f32x4){0.f, 0.f, 0.f, 0.f};
        const size_t cbase = (size_t)((dir * 8 + b) * 4 + h) * 64;
        const char* qsrc = QE + (((size_t)dir * T + (size_t)b * SEQ) * 512 + h * 128) * 2;
        const char* psrc = PP + cbase * 8192;
        const char* ksrc = KET + cbase * 16384;
        const char* vsrc = VT + ((size_t)(b * 4 + h) * 64 * 256 + es * 64) * 128;
        const char* esrc = (const char*)(EL + cbase * 128);
        char* ob = (char*)(OO + ((size_t)b * SEQ + itile * 16) * D + h * 256 + es * 64 + et0 * 16);
        const unsigned le = (unsigned)fq * 16u, lo = (unsigned)(fr * D + 4 * fq) * 2u;
#define SC_DMA(c_, bi_) do { const size_t c__ = (size_t)(c_); LAS unsigned char* bb_ = BUF + (bi_) * BUFB + wave * 1024; \
            __builtin_amdgcn_global_load_lds((const unsigned*)(qsrc + c__ * 65536 + sq[0]), (LAS unsigned*)(bb_ + OQ), 16, 0, 0); \
            __builtin_amdgcn_global_load_lds((const unsigned*)(qsrc + c__ * 65536 + sq[1]), (LAS unsigned*)(bb_ + OQ + 8192), 16, 0, 0); \
            __builtin_amdgcn_global_load_lds((const unsigned*)(psrc + c__ * 8192 + sp), (LAS unsigned*)(bb_ + OP), 16, 0, 0); \
            __builtin_amdgcn_global_load_lds((const unsigned*)(ksrc + c__ * 16384 + sk[0]), (LAS unsigned*)(bb_ + OK_), 16, 0, 0); \
            __builtin_amdgcn_global_load_lds((const unsigned*)(ksrc + c__ * 16384 + sk[1]), (LAS unsigned*)(bb_ + OK_ + 8192), 16, 0, 0); \
            __builtin_amdgcn_global_load_lds((const unsigned*)(vsrc + c__ * 32768 + sv), (LAS unsigned*)(bb_ + OV), 16, 0, 0); \
            if (wave == 0) __builtin_amdgcn_global_load_lds((const unsigned*)(esrc + c__ * 512 + lane * 16), (LAS unsigned*)(BUF + (bi_) * BUFB + OE), 16, 0, 0); } while (0)
        SC_DMA(dir ? 63 : 0, 0);
        asm volatile("s_waitcnt vmcnt(0)" ::: "memory");
        __syncthreads();
#pragma unroll 1
        for (int cc = 0; cc < 64; ++cc) {
            const int c = dir ? 63 - cc : cc;
            if (cc + 1 < 64) SC_DMA(dir ? 62 - cc : cc + 1, (cc + 1) & 1);
            const LAS unsigned char* B = BUF + (cc & 1) * BUFB;
            const f32x4 el0 = *(const LAS f32x4*)(B + OE + dt0 * 64 + le), el1 = *(const LAS f32x4*)(B + OE + dt0 * 64 + 64 + le);
            const LAS bf16* Sr = ST + (cc & 1) * 64 * SS; LAS bf16* Sw = ST + ((cc + 1) & 1) * 64 * SS;
            bf16x8 qf[4], pf[2], vf[2][2];
#pragma unroll
            for (int ks = 0; ks < 4; ++ks) qf[ks] = *(const LAS bf16x8*)(B + OQ + (itile * 16 + fr) * 256 + (((4 * ks + fq) ^ fr) * 16));
#pragma unroll
            for (int ks = 0; ks < 2; ++ks) pf[ks] = *(const LAS bf16x8*)(B + OP + (itile * 16 + fr) * 128 + (((4 * ks + fq) ^ kx) * 16));
#pragma unroll
            for (int et = 0; et < 2; ++et)
#pragma unroll
                for (int ks = 0; ks < 2; ++ks) vf[et][ks] = *(const LAS bf16x8*)(B + OV + ((et0 + et) * 16 + fr) * 128 + (((4 * ks + fq) ^ kx) * 16));
#pragma unroll
            for (int et = 0; et < 2; ++et) { f32x4 ao = (f32x4){0.f, 0.f, 0.f, 0.f};
#pragma unroll
                for (int ks = 0; ks < 4; ++ks) { const bf16x8 sf = *(const LAS bf16x8*)(Sr + ((et0 + et) * 16 + fr) * SS + ks * 32 + 8 * fq); ao = __builtin_amdgcn_mfma_f32_16x16x32_bf16(sf, qf[ks], ao, 0, 0, 0); }
#pragma unroll
                for (int ks = 0; ks < 2; ++ks) ao = __builtin_amdgcn_mfma_f32_16x16x32_bf16(vf[et][ks], pf[ks], ao, 0, 0, 0);
                u32x2 o; o.x = cvt_pk_bf16(ao[0], ao[1]); o.y = cvt_pk_bf16(ao[2], ao[3]);
                *(u32x2*)(ob + (size_t)c * (64 * D * 2) + et * 32 + lo) = o; }
#pragma unroll
            for (int dt = 0; dt < 2; ++dt) { bf16x8 kf[2];
#pragma unroll
                for (int ks = 0; ks < 2; ++ks) kf[ks] = *(const LAS bf16x8*)(B + OK_ + ((dt0 + dt) * 16 + fr) * 128 + (((4 * ks + fq) ^ kx) * 16));
#pragma unroll
                for (int et = 0; et < 2; ++et) {
#pragma unroll
                    for (int ks = 0; ks < 2; ++ks) accS[dt][et] = __builtin_amdgcn_mfma_f32_16x16x32_bf16(kf[ks], vf[et][ks], accS[dt][et], 0, 0, 0);
                    accS[dt][et] = accS[dt][et] * (dt ? el1 : el0);
                    u32x2 o; o.x = cvt_pk_bf16(accS[dt][et][0], accS[dt][et][1]); o.y = cvt_pk_bf16(accS[dt][et][2], accS[dt][et][3]);
                    *(LAS u32x2*)(Sw + ((et0 + et) * 16 + fr) * SS + (dt0 + dt) * 16 + 4 * fq) = o; } }
            asm volatile("s_waitcnt vmcnt(0)" ::: "memory");
            __syncthreads();
        }
#undef SC_DMA
    }
}

__device__ __forceinline__ void phase_gla_post(KA a, int li, int tid, int bx, int G) {
    const int lane = tid & 63, wave = tid >> 6;
    const bf16* of = (const bf16*)(a->ws + WS_OF); const bf16* ob = (const bf16*)(a->ws + WS_OB); const bf16* qkvr = (const bf16*)(a->ws + WS_BIG); bf16* A2 = (bf16*)(a->ws + WS_A2);
    const float* ng = a->in[I_GNORM] + (size_t)li * 256 + (lane & 15) * 16;
    float g[16];
#pragma unroll
    for (int j = 0; j < 16; ++j) g[j] = ng[j];
    for (int token = bx * NWAVES + wave; token < T; token += G * NWAVES) {
        const u32x4 f0 = *(const u32x4*)(of + (size_t)token * D + 16 * lane), f1 = *(const u32x4*)(of + (size_t)token * D + 16 * lane + 8);
        const u32x4 b0 = *(const u32x4*)(ob + (size_t)token * D + 16 * lane), b1 = *(const u32x4*)(ob + (size_t)token * D + 16 * lane + 8);
        const u32x4 r0 = *(const u32x4*)(qkvr + (size_t)token * GLA_MAIN + 2048 + 16 * lane), r1 = *(const u32x4*)(qkvr + (size_t)token * GLA_MAIN + 2048 + 16 * lane + 8);
        float o[16], r[16];
#pragma unroll
        for (int q = 0; q < 4; ++q) { o[2 * q] = bf_lo(f0[q]) + bf_lo(b0[q]); o[2 * q + 1] = bf_hi(f0[q]) + bf_hi(b0[q]); o[8 + 2 * q] = bf_lo(f1[q]) + bf_lo(b1[q]); o[8 + 2 * q + 1] = bf_hi(f1[q]) + bf_hi(b1[q]);
            r[2 * q] = bf_lo(r0[q]); r[2 * q + 1] = bf_hi(r0[q]); r[8 + 2 * q] = bf_lo(r1[q]); r[8 + 2 * q + 1] = bf_hi(r1[q]); }
        float ss = 0.f;
#pragma unroll
        for (int j = 0; j < 16; ++j) ss += o[j] * o[j];
        ss += shfl_xor_f(ss, 1, lane); ss += shfl_xor_f(ss, 2, lane); ss += shfl_xor_f(ss, 4, lane); ss += shfl_xor_f(ss, 8, lane);
        const float rstd = 1.0f / sqrtf(ss * (1.0f / 256.0f) + LN_EPS);
        unsigned w[8];
#pragma unroll
        for (int q = 0; q < 8; ++q) w[q] = cvt_pk_bf16(o[2 * q] * rstd * g[2 * q] * silu_f(r[2 * q]), o[2 * q + 1] * rstd * g[2 * q + 1] * silu_f(r[2 * q + 1]));
        *(u32x4*)(A2 + (size_t)token * D + 16 * lane) = (u32x4){w[0], w[1], w[2], w[3]}; *(u32x4*)(A2 + (size_t)token * D + 16 * lane + 8) = (u32x4){w[4], w[5], w[6], w[7]};
    }
}

__device__ __forceinline__ void phase_sgu_core(KA a, int li, LAS unsigned char* lds, int tid, int bx, int G) {
    const int lane = tid & 63, wave = __builtin_amdgcn_readfirstlane(tid >> 6), fr = lane & 15, fq = lane >> 4;
    unsigned char* ws = a->ws;
    const bf16* z = (const bf16*)(ws + WS_BIG); bf16* A2 = (bf16*)(ws + WS_A2);
    const float* lng = a->in[I_SLNG] + (size_t)li * 1024; const float* lnb = a->in[I_SLNB] + (size_t)li * 1024;
    const bf16* wsp = (const bf16*)(ws + WS_SGUWS) + (size_t)li * 8 * 128 * 128; const float* bs = a->in[I_SBS] + (size_t)li * 8 * 128;
    constexpr int VS = 132;
    LAS bf16* vn = (LAS bf16*)lds;
    LAS float* st_mean = (LAS float*)(lds + 2 * 128 * VS * 2); LAS float* st_rstd = st_mean + 128;
    const int co = tid & 15, qr = tid >> 4;
    for (int it = bx; it < T / 128; it += G) {
        const int row0 = it * 128;
        __syncthreads();
#pragma unroll 1
        for (int rr = 0; rr < 16; ++rr) { const int q = wave * 16 + rr; const bf16* vp = z + (size_t)(row0 + q) * 2048 + 1024 + 16 * lane;
            const u32x4 v0 = *(const u32x4*)vp, v1 = *(const u32x4*)(vp + 8); float x[16];
#pragma unroll
            for (int k = 0; k < 4; ++k) { x[2 * k] = bf_lo(v0[k]); x[2 * k + 1] = bf_hi(v0[k]); x[8 + 2 * k] = bf_lo(v1[k]); x[8 + 2 * k + 1] = bf_hi(v1[k]); }
            float s1 = 0.f;
#pragma unroll
            for (int k = 0; k < 16; ++k) s1 += x[k];
            const float mean = wave_sum(s1, lane) * (1.0f / 1024.0f); float s2 = 0.f;
#pragma unroll
            for (int k = 0; k < 16; ++k) { const float dd = x[k] - mean; s2 += dd * dd; }
            const float rstd = 1.0f / sqrtf(wave_sum(s2, lane) * (1.0f / 1024.0f) + LN_EPS);
            if (lane == 0) { st_mean[q] = mean; st_rstd[q] = rstd; } }
        __syncthreads();
        const int p = wave * 16 + fr;
#pragma unroll 1
        for (int g = 0; g < 8; ++g) {
            LAS bf16* vb = vn + (g & 1) * 128 * VS;
            {
                const f32x4 g0 = *(const f32x4*)(lng + g * 128 + 8 * co), g1 = *(const f32x4*)(lng + g * 128 + 8 * co + 4), b0 = *(const f32x4*)(lnb + g * 128 + 8 * co), b1 = *(const f32x4*)(lnb + g * 128 + 8 * co + 4);
#pragma unroll
                for (int k = 0; k < 4; ++k) { const int q = qr + 32 * k; const u32x4 w = *(const u32x4*)(z + (size_t)(row0 + q) * 2048 + 1024 + g * 128 + 8 * co);
                    const float m = st_mean[q], r = st_rstd[q];
                    u32x2 o0, o1;
                    o0.x = cvt_pk_bf16((bf_lo(w.x) - m) * r * g0[0] + b0[0], (bf_hi(w.x) - m) * r * g0[1] + b0[1]); o0.y = cvt_pk_bf16((bf_lo(w.y) - m) * r * g0[2] + b0[2], (bf_hi(w.y) - m) * r * g0[3] + b0[3]);
                    o1.x = cvt_pk_bf16((bf_lo(w.z) - m) * r * g1[0] + b1[0], (bf_hi(w.z) - m) * r * g1[1] + b1[1]); o1.y = cvt_pk_bf16((bf_lo(w.w) - m) * r * g1[2] + b1[2], (bf_hi(w.w) - m) * r * g1[3] + b1[3]);
                    *(LAS u32x2*)(vb + q * VS + 8 * co) = o0; *(LAS u32x2*)(vb + q * VS + 8 * co + 4) = o1; }
            }
            bf16x8 wf[4];
#pragma unroll
            for (int ks = 0; ks < 4; ++ks) wf[ks] = *(const bf16x8*)(wsp + ((size_t)g * 128 + p) * 128 + ks * 32 + 8 * fq);
            const float bias = bs[g * 128 + p];
            __syncthreads();
#pragma unroll 2
            for (int ct = 0; ct < 8; ++ct) {
                f32x4 acc = (f32x4){0.f, 0.f, 0.f, 0.f};
#pragma unroll
                for (int ks = 0; ks < 4; ++ks) { const LAS bf16* sp = vb + (ks * 32 + 8 * fq) * VS + ct * 16 + fr; unsigned w4[4];
#pragma unroll
                    for (int j2 = 0; j2 < 4; ++j2) w4[j2] = (unsigned)sp[(2 * j2) * VS] | ((unsigned)sp[(2 * j2 + 1) * VS] << 16);
                    const bf16x8 vf = __builtin_bit_cast(bf16x8, (u32x4){w4[0], w4[1], w4[2], w4[3]});
                    acc = __builtin_amdgcn_mfma_f32_16x16x32_bf16(vf, wf[ks], acc, 0, 0, 0); }
                const int c0 = g * 128 + ct * 16 + 4 * fq;
                const u32x2 uu = *(const u32x2*)(z + (size_t)(row0 + p) * 2048 + c0);
                u32x2 o; o.x = cvt_pk_bf16(bf_lo(uu.x) * (acc[0] + bias), bf_hi(uu.x) * (acc[1] + bias)); o.y = cvt_pk_bf16(bf_lo(uu.y) * (acc[2] + bias), bf_hi(uu.y) * (acc[3] + bias));
                *(u32x2*)(A2 + (size_t)(row0 + p) * D + c0) = o;
            }
        }
    }
}

constexpr int PH_PER_LAYER = 10;
constexpr int NPHASES = 2 + PH_PER_LAYER * DEPTH;
#define GEMM_BODY(A, g, K, S, E) gemm_fast<false, false>(A, g, K, S, E, lds, tid)
#define GEMM_BODY_G(A, g, K, S, E) gemm_fast<true, false>(A, g, K, S, E, lds, tid)
#define GEMM_BODY8(A, g, K, S, E) gemm_fast<false, true>(A, g, K, S, E, lds, tid)
#define GEMM_BODY8_G(A, g, K, S, E) gemm_fast<true, true>(A, g, K, S, E, lds, tid)
__device__ __forceinline__ void ph_prologue(int wave_s) { PHASE_ENTER(); phase_prologue(a, lds, tid, bx, G); }
__device__ __forceinline__ void ph_rp_init(int wave_s) { PHASE_ENTER(); float* mod = (float*)(ws + WS_MOD);
    RowPass p{}; p.xin = a->in[I_X]; p.hout = (bf16*)(ws + WS_H); p.sc = mod + 1 * 1024; p.sh = mod + 0 * 1024; p.wside = (const bf16*)(ws + WS_GLALR_T); p.lr_out = (float*)(ws + WS_LR); p.has_h = 1; p.has_side = 1;
    row_pass<0>(p, lds, tid, bx, G); }
__device__ __forceinline__ void ph_gla_in(int wave_s, int li) { PHASE_ENTER(); Sched S; S.init(T / 256, GLA_MAIN / 256, G, bx, (const bf16*)(ws + WS_GLAIN_T) + (size_t)li * GLA_MAIN * 1024, 0, nullptr, 2048); EpiGlaIn E{(bf16*)(ws + WS_BIG)}; GEMM_BODY((const bf16*)(ws + WS_H), nullptr, 1024, S, E); }
__device__ __forceinline__ void ph_sgu_in(int wave_s, int li) { PHASE_ENTER(); Sched S; S.init(T / 256, 2048 / 256, G, bx, (const bf16*)(ws + WS_SGUIN_T) + (size_t)li * 2048 * 1024, 0, nullptr, 2048); EpiSguIn E{(bf16*)(ws + WS_BIG), a->in[I_SBIN] + (size_t)li * 2048}; GEMM_BODY((const bf16*)(ws + WS_H), nullptr, 1024, S, E); }
__device__ __forceinline__ void ph_gla_prep(int wave_s, int li) { PHASE_ENTER(); phase_gla_prep(a, li, lds, tid, bx, G); }
__device__ __forceinline__ void ph_gla_scan(int wave_s) { PHASE_ENTER(); phase_gla_scan(a, lds, tid, bx, G); }
__device__ __forceinline__ void ph_sgu_core(int wave_s, int li) { PHASE_ENTER(); phase_sgu_core(a, li, lds, tid, bx, G); }
__device__ __forceinline__ void ph_gla_post(int wave_s, int li) { PHASE_ENTER(); phase_gla_post(a, li, tid, bx, G); }
__device__ __forceinline__ void ph_out(int wave_s, int l) { PHASE_ENTER(); const int li = l >> 1; const bool sgu = (l & 1) != 0;
    Sched S; S.init(T / 256, 4, G, bx, (const bf16*)(ws + (sgu ? WS_SGUOUT_T : WS_GLAOUT_T)) + (size_t)li * 1024 * 1024, 0, nullptr, 2048);
    EpiOut E{(bf16*)(ws + WS_Y), sgu ? a->in[I_SBOUT] + (size_t)li * 1024 : nullptr}; GEMM_BODY((const bf16*)(ws + WS_A2), nullptr, 1024, S, E); }
__device__ __forceinline__ void ph_rp_mid(int wave_s, int l) { PHASE_ENTER(); float* modl = (float*)(ws + WS_MOD) + (size_t)l * 8 * 6144; int* route = (int*)(ws + WS_ROUTE);
    RowPass p{}; p.xin = (l == 0) ? (const void*)a->in[I_X] : (const void*)(ws + WS_X2); p.xin16 = (l != 0); p.y = (const bf16*)(ws + WS_Y); p.xout = ws + WS_X1; p.xout16 = 1; p.hout = (bf16*)(ws + WS_H);
    p.gate = modl + 2 * 1024; p.lng = a->in[I_LNG] + (size_t)(l * 2 + 0) * 1024; p.lnb = a->in[I_LNB] + (size_t)(l * 2 + 0) * 1024; p.sc = modl + 4 * 1024; p.sh = modl + 3 * 1024;
    p.wside = (const bf16*)(ws + WS_ROUTER_T) + (size_t)l * 64 * 1024; p.rbias = a->in[I_RB] + (size_t)l * 32;
    p.topi = route + R_TOPI; p.topw = (float*)(route + R_TOPW); p.hist = route + R_HIST + bx * 32; p.has_h = 1; p.has_side = 1; p.h8out = MOE_FP8 ? (ws + WS_H8) : nullptr;
    row_pass<1>(p, lds, tid, bx, G); }
__device__ __forceinline__ void ph_place(int wave_s) { PHASE_ENTER(); phase_place((int*)(ws + WS_ROUTE), lds, tid, bx, G); }
__device__ __forceinline__ void ph_moe_up(int wave_s, int l) { PHASE_ENTER(); int* route = (int*)(ws + WS_ROUTE); const int ntiles = __builtin_amdgcn_readfirstlane(route[R_NTILES]);
#if MOE_FP8
    Sched S; S.init(ntiles, 8, G, bx, ws + WS_WUP_T + (size_t)l * 32 * 2048 * 1024, (size_t)2048 * 1024, route + R_TILEE, 1024);
    EpiUp<true> E{ws + WS_ACT, a->in[I_BUP] + (size_t)l * 32 * 2048}; GEMM_BODY8_G(ws + WS_H8, route + R_BUFTOK, 1024, S, E); }
#else
    Sched S; S.init(ntiles, 8, G, bx, ws + WS_WUP_T + (size_t)l * 32 * 2048 * 2048, (size_t)2048 * 2048, route + R_TILEE, 2048);
    EpiUp<false> E{ws + WS_ACT, a->in[I_BUP] + (size_t)l * 32 * 2048}; GEMM_BODY_G(ws + WS_H, route + R_BUFTOK, 1024, S, E); }
#endif
__device__ __forceinline__ void ph_moe_down(int wave_s, int l) { PHASE_ENTER(); int* route = (int*)(ws + WS_ROUTE); const int ntiles = __builtin_amdgcn_readfirstlane(route[R_NTILES]);
#if MOE_FP8
    Sched S; S.init(ntiles, 4, G, bx, ws + WS_WDN_T + (size_t)l * 32 * 1024 * 1024, (size_t)1024 * 1024, route + R_TILEE, 1024);
    EpiDown8 E{ws + WS_YS, a->in[I_BDN] + (size_t)l * 32 * 1024, 1.0f / (F8_WSCALE * F8_ASCALE)}; GEMM_BODY8(ws + WS_ACT, nullptr, 1024, S, E); }
#else
    Sched S; S.init(ntiles, 4, G, bx, ws + WS_WDN_T + (size_t)l * 32 * 1024 * 2048, (size_t)1024 * 2048, route + R_TILEE, 2048);
    EpiDown E{(bf16*)(ws + WS_YS), a->in[I_BDN] + (size_t)l * 32 * 1024, 1.0f}; GEMM_BODY(ws + WS_ACT, nullptr, 1024, S, E); }
#endif
__device__ __forceinline__ void ph_rp_end(int wave_s, int l) { PHASE_ENTER(); float* mod = (float*)(ws + WS_MOD); float* modl = mod + (size_t)l * 8 * 6144; int* route = (int*)(ws + WS_ROUTE);
    RowPass p{}; p.xin = ws + WS_X1; p.xin16 = 1; p.xout = (l == DEPTH - 1) ? (void*)a->out : (void*)(ws + WS_X2); p.xout16 = (l != DEPTH - 1); p.hout = (bf16*)(ws + WS_H);
    p.gate = modl + 5 * 1024; p.lng = a->in[I_LNG] + (size_t)(l * 2 + 1) * 1024; p.lnb = a->in[I_LNB] + (size_t)(l * 2 + 1) * 1024;
    p.ys = ws + WS_YS; p.dest = route + R_DEST; p.tw = (const float*)(route + R_TOPW);
    if (l < DEPTH - 1) { float* modn = mod + (size_t)(l + 1) * 8 * 6144; p.sc = modn + 1 * 1024; p.sh = modn + 0 * 1024; p.has_h = 1;
        if (((l + 1) & 1) == 0) { p.has_side = 1; p.wside = (const bf16*)(ws + WS_GLALR_T) + (size_t)((l + 1) >> 1) * 64 * 1024; p.lr_out = (float*)(ws + WS_LR); } }
    row_pass<2>(p, lds, tid, bx, G); }

__global__ void __launch_bounds__(NTHREADS, 2) fwd_kernel(Args a) {
    extern __shared__ __attribute__((aligned(16))) unsigned char lds_raw[];
    LAS unsigned char* lds = (LAS unsigned char*)lds_raw;
    volatile LAS unsigned* MISC = (volatile LAS unsigned*)(lds + MISC_OFF);
    const int tid = threadIdx.x; const int wave_s = __builtin_amdgcn_readfirstlane(tid >> 6);
    if (tid < 32) ((LAS unsigned*)(lds + MISC_OFF))[tid] = 0u;
    __syncthreads();
    unsigned* ctl = (unsigned*)(a.ws + WS_CTL);
    XcdBarrier bar = xcd_barrier_post(ctl + CW_BAR + a.li * XCD_BAR_WORDS, MISC + 8);
    const int lo = a.ph_lo, hi = a.ph_hi;
#ifndef REPK
#define REPK 0
#define REPN 1
#endif
#define REP(kind) for (int rep_ = 0; rep_ < ((REPK == (kind)) ? REPN : 1); ++rep_)
#define IN(k) (lo <= (k) && (k) < hi)
#define SEAM(k) do { if (IN(k) && IN((k) + 1)) xcd_barrier(bar); } while (0)
    if (IN(0)) { REP(3) ph_prologue(wave_s); SEAM(0); }
    if (IN(1)) { ph_rp_init(wave_s); SEAM(1); }
    for (int l = 0; l < DEPTH; ++l) {
        const int pb = 2 + PH_PER_LAYER * l, li = l >> 1; const bool sgu = (l & 1) != 0;
        if (IN(pb + 0)) { REP(10) { if (!sgu) ph_gla_in(wave_s, li); else ph_sgu_in(wave_s, li); } SEAM(pb + 0); }
        if (IN(pb + 1)) { if (!sgu) { REP(12) ph_gla_prep(wave_s, li); SEAM(pb + 1); } }
        if (IN(pb + 2)) { if (!sgu) { REP(1) ph_gla_scan(wave_s); } else { REP(2) ph_sgu_core(wave_s, li); } SEAM(pb + 2); }
        if (IN(pb + 3)) { if (!sgu) { REP(6) ph_gla_post(wave_s, li); SEAM(pb + 3); } }
        if (IN(pb + 4)) { REP(11) ph_out(wave_s, l); SEAM(pb + 4); }
        if (IN(pb + 5)) { REP(4) ph_rp_mid(wave_s, l); SEAM(pb + 5); }
        if (IN(pb + 6)) { REP(7) ph_place(wave_s); SEAM(pb + 6); }
        if (IN(pb + 7)) { REP(8) ph_moe_up(wave_s, l); SEAM(pb + 7); }
        if (IN(pb + 8)) { REP(9) ph_moe_down(wave_s, l); SEAM(pb + 8); }
        if (IN(pb + 9)) { REP(5) ph_rp_end(wave_s, l); SEAM(pb + 9); }
    }
#undef IN
#undef SEAM
}

#ifndef N_LAUNCH_MODE
#define N_LAUNCH_MODE 1
#endif
extern "C" void kernel_launch(void* const* d_in, const int* in_sizes, int n_in, void* d_out, int out_size, void* d_ws, size_t ws_size, hipStream_t stream) {
    static int grid = 0;
    if (grid == 0) {
        if (n_in != 27 || out_size != T * D || ws_size < WS_END) { fprintf(stderr, "kernel_launch: unexpected shapes (n_in %d out %d ws %zu)\n", n_in, out_size, ws_size); grid = -1; return; }
        int dev = 0, cus = 0, per_cu = 0;
        if (hipGetDevice(&dev) != hipSuccess || hipDeviceGetAttribute(&cus, hipDeviceAttributeMultiprocessorCount, dev) != hipSuccess) { grid = -1; return; }
        if (hipFuncSetAttribute((const void*)fwd_kernel, hipFuncAttributeMaxDynamicSharedMemorySize, LDS_BYTES) != hipSuccess) { fprintf(stderr, "kernel_launch: hipFuncSetAttribute failed\n"); grid = -1; return; }
        if (hipOccupancyMaxActiveBlocksPerMultiprocessor(&per_cu, (const void*)fwd_kernel, NTHREADS, LDS_BYTES) != hipSuccess || per_cu < 1) fprintf(stderr, "kernel_launch: occupancy query reports %d\n", per_cu);
        (void)hipGetLastError();
        grid = cus;
        if (grid > 1024) grid = 1024;
    }
    if (grid < 0) return;
    (void)hipMemsetAsync((char*)d_ws + WS_CTL, 0, CTL_ZERO_BYTES, stream);
    Args a{};
    for (int i = 0; i < 27; ++i) a.in[i] = (const float*)d_in[i];
    a.out = (float*)d_out; a.ws = (unsigned char*)d_ws; a.pad = 0;
#if N_LAUNCH_MODE == 1
    a.ph_lo = 0; a.ph_hi = NPHASES; a.li = 0;
    hipLaunchKernelGGL(fwd_kernel, dim3(grid), dim3(NTHREADS), LDS_BYTES, stream, a);
#else
    for (int ph = 0, li = 0; ph < NPHASES; ++ph) {
        if (ph >= 2 && (((ph - 2) % PH_PER_LAYER) == 1 || ((ph - 2) % PH_PER_LAYER) == 3) && (((ph - 2) / PH_PER_LAYER) & 1)) continue;
        a.ph_lo = ph; a.ph_hi = ph + 1; a.li = li++;
        hipLaunchKernelGGL(fwd_kernel, dim3(grid), dim3(NTHREADS), LDS_BYTES, stream, a);
    }
#endif
}
```

```cpp
#include <hip/hip_runtime.h>
#include <cstdio>
#include <cstdint>

#define LAS __attribute__((address_space(3)))
#define GAS __attribute__((address_space(1)))
typedef unsigned short bf16;
typedef short bf16x8 __attribute__((ext_vector_type(8)));
typedef float f32x4 __attribute__((ext_vector_type(4)));
typedef float f32x2 __attribute__((ext_vector_type(2)));
typedef unsigned u32x4 __attribute__((ext_vector_type(4)));
typedef unsigned u32x2 __attribute__((ext_vector_type(2)));
typedef int i32x4 __attribute__((ext_vector_type(4)));
typedef int i32x8 __attribute__((ext_vector_type(8)));

#ifndef MOE_FP8
#define MOE_FP8 1
#endif
constexpr int D = 1024, NB = 8, SEQ = 4096, T = NB * SEQ, DEPTH = 4;
constexpr int NE = 32, TOPK = 4, CAP = T * TOPK + NE * 256;
constexpr int MAXTILES = CAP / 256;
constexpr float ALPHA = 1.681792830507429f;
constexpr float LN_EPS = 1e-5f;
constexpr float F8_WSCALE = 64.0f, F8_HSCALE = 8.0f, F8_ASCALE = 4.0f, F8_YSCALE = 64.0f;
constexpr int GLA_IN = 3104, GLA_MAIN = 3072;
constexpr int NWAVES = 8, NTHREADS = 512;
constexpr int LDS_BYTES = 147456, MISC_OFF = 139264;

constexpr size_t MiB = 1u << 20;
constexpr size_t WS_CTL = 0, CTL_ZERO_BYTES = 2 * MiB;
constexpr size_t WS_MOD = 2 * MiB;
constexpr size_t WS_ROUTE = 4 * MiB;
constexpr size_t WS_LR = 8 * MiB;
constexpr size_t WS_GLAIN_T = 16 * MiB;
constexpr size_t WS_GLALR_T = 28 * MiB;
constexpr size_t WS_ROUTER_T = 29 * MiB;
constexpr size_t WS_SGUWS = 30 * MiB;
constexpr size_t WS_GLAOUT_T = 32 * MiB;
constexpr size_t WS_SGUIN_T = 36 * MiB;
constexpr size_t WS_SGUOUT_T = 44 * MiB;
constexpr size_t WS_WUP_T = 64 * MiB;
constexpr size_t WS_WDN_T = 576 * MiB;
constexpr size_t WS_X1 = 832 * MiB;
constexpr size_t WS_X2 = 960 * MiB;
constexpr size_t WS_H = 1088 * MiB;
constexpr size_t WS_BIG = 1152 * MiB;
constexpr size_t WS_OF = 1344 * MiB;
constexpr size_t WS_OB = 1408 * MiB;
constexpr size_t WS_A2 = 1472 * MiB;
constexpr size_t WS_Y = 1536 * MiB;
constexpr size_t WS_ACT = 1664 * MiB;
constexpr size_t WS_YS = 1936 * MiB;
constexpr size_t WS_QE = 2208 * MiB;
constexpr size_t WS_KET = 2272 * MiB;
constexpr size_t WS_P = 2336 * MiB;
constexpr size_t WS_VT = 2368 * MiB;
constexpr size_t WS_EL = 2432 * MiB;
constexpr size_t WS_H8 = 2440 * MiB;
constexpr size_t WS_END = 2472 * MiB;
constexpr int R_TOPI = 0;
constexpr int R_TOPW = T * 4;
constexpr int R_DEST = 2 * T * 4;
constexpr int R_BUFTOK = 3 * T * 4;
constexpr int R_HIST = R_BUFTOK + CAP;
constexpr int R_TILEE = R_HIST + 1024 * 32;
constexpr int R_NTILES = R_TILEE + 1024;
static_assert((size_t)(R_NTILES + 64) * 4 <= 4 * MiB, "route tables");
constexpr int CW_BAR = 4096;
constexpr int MAX_LAUNCH = 64;

#define RLX_AGENT __ATOMIC_RELAXED, __HIP_MEMORY_SCOPE_AGENT
#define LDS_WAIT() asm volatile("s_waitcnt lgkmcnt(0)" ::: "memory")
#define VM_WAIT() asm volatile("s_waitcnt vmcnt(0)" ::: "memory")
typedef __bf16 bf16x2_t __attribute__((ext_vector_type(2)));
__device__ __forceinline__ unsigned cvt_pk_bf16(float lo, float hi) { const f32x2 v = {lo, hi}; const bf16x2_t r = __builtin_convertvector(v, bf16x2_t); return __builtin_bit_cast(unsigned, r); }
__device__ __forceinline__ float bf_lo(unsigned w) { return __uint_as_float(w << 16); }
__device__ __forceinline__ float bf_hi(unsigned w) { return __uint_as_float(w & 0xffff0000u); }
__device__ __forceinline__ float bf2f(bf16 b) { return __uint_as_float(((unsigned)b) << 16); }
__device__ __forceinline__ float shfl_xor_f(float v, int o, int lane) { return __builtin_bit_cast(float, __builtin_amdgcn_ds_bpermute((lane ^ o) << 2, __builtin_bit_cast(int, v))); }
__device__ __forceinline__ int shfl_i(int v, int src, int lane) { (void)lane; return __builtin_amdgcn_ds_bpermute(src << 2, v); }
__device__ __forceinline__ float wave_sum(float v, int lane) {
#pragma unroll
    for (int o = 1; o < 64; o <<= 1) v += shfl_xor_f(v, o, lane);
    return v;
}
__device__ __forceinline__ float silu_f(float x) { return x * __builtin_amdgcn_rcpf(1.0f + __expf(-x)); }
__device__ __forceinline__ float sigmoid_f(float x) { return __builtin_amdgcn_rcpf(1.0f + __expf(-x)); }
__device__ __forceinline__ float gelu_f(float v) {
    const float av = fabsf(v), t = __builtin_amdgcn_rcpf(av * 0.2316418882f + 1.0f);
    float q = t * 0.5307027145f + (-0.7265760135f); q = q * t + 0.7107068705f; q = q * t + (-0.142248368f); q = q * t + 0.127414796f; q = q * t;
    const float e = __builtin_amdgcn_exp2f((v * v) * (-0.72134752044f));
    const float m = v * (q * e);
    return v < 0.f ? m : v - m;
}

#define XB_TMO      128
#define XB_XCNT(j)  (256  + 64 * (j))
#define XB_XSUB(j)  (1280 + 64 * (j))
#define XB_XGEN(j)  (2304 + 64 * (j))
#define XB_TOP      3328
#define XB_TOPGEN   3392
#define XCD_BAR_WORDS 3456
#define XB_SPIN_CAP (1u << 18)
__device__ __forceinline__ unsigned xb_ld(unsigned* p)              { return __hip_atomic_load(p, __ATOMIC_RELAXED, __HIP_MEMORY_SCOPE_AGENT); }
__device__ __forceinline__ unsigned xb_add(unsigned* p, unsigned v) { return __hip_atomic_fetch_add(p, v, __ATOMIC_RELAXED, __HIP_MEMORY_SCOPE_AGENT); }
__device__ __forceinline__ unsigned xb_xcc_id() { return (unsigned)__builtin_amdgcn_s_getreg((3 << 11) | 20) & 0xFu; }
#define XB_SPIN(cond, bar) do { unsigned _sp = 0; while (cond) { __builtin_amdgcn_s_sleep(1); \
    if ((++_sp & 255u) == 0u) { if (xb_ld(&(bar)[XB_TMO])) break; if (_sp > XB_SPIN_CAP) { atomicAdd(&(bar)[XB_TMO], 1u); break; } } } } while (0)
struct XcdBarrier { unsigned* bar; unsigned x; volatile LAS unsigned* st; };
__device__ __forceinline__ XcdBarrier xcd_barrier_post(unsigned* bar, volatile LAS unsigned* st) {
    XcdBarrier b; b.bar = bar; b.x = xb_xcc_id(); b.st = st;
    if (threadIdx.x == 0) (void)xb_add(&bar[XB_XCNT(b.x)], 1u);
    return b;
}
__device__ __forceinline__ void xcd_barrier_complete(unsigned* bar, unsigned x, unsigned& nloc, unsigned& nx) {
    const unsigned G = gridDim.x * gridDim.y * gridDim.z;
    unsigned sum, cnt, mine, sp = 0u;
    for (;;) {
        sum = 0u; cnt = 0u; mine = 0u;
#pragma unroll
        for (unsigned j = 0; j < 16; ++j) { const unsigned c = xb_ld(&bar[XB_XCNT(j)]); sum += c; cnt += (c > 0u) ? 1u : 0u; mine = (j == x) ? c : mine; }
        if (sum == G) break;
        __builtin_amdgcn_s_sleep(1);
        if ((++sp & 255u) == 0u) { if (xb_ld(&bar[XB_TMO])) break; if (sp > XB_SPIN_CAP) { atomicAdd(&bar[XB_TMO], 1u); break; } }
    }
    nloc = mine > 0u ? mine : 1u; nx = cnt > 0u ? cnt : 1u;
}
__device__ __forceinline__ void xcd_barrier(const XcdBarrier& b) {
    asm volatile("s_waitcnt vmcnt(0)" ::: "memory");
    __syncthreads();
    if (threadIdx.x == 0) {
        unsigned* bar = b.bar;
        __builtin_amdgcn_s_waitcnt(0);
        unsigned nloc = b.st[0], nx = b.st[1];
        if (nloc == 0u) { xcd_barrier_complete(bar, b.x, nloc, nx); b.st[0] = nloc; b.st[1] = nx; }
        const unsigned old = xb_add(&bar[XB_XSUB(b.x)], 1u);
        const unsigned gen = old / nloc;
        if (old + 1u == (gen + 1u) * nloc) {
            __builtin_amdgcn_fence(__ATOMIC_RELEASE, "agent");
            asm volatile("s_waitcnt vmcnt(0)" ::: "memory");
            const unsigned og = xb_add(&bar[XB_TOP], 1u);
            const unsigned tg = og / nx;
            if (og + 1u == (tg + 1u) * nx) xb_add(&bar[XB_TOPGEN], 1u);
            else XB_SPIN(xb_ld(&bar[XB_TOPGEN]) == tg, bar);
            __builtin_amdgcn_fence(__ATOMIC_ACQUIRE, "agent");
            xb_add(&bar[XB_XGEN(b.x)], 1u);
            asm volatile("s_waitcnt vmcnt(0)" ::: "memory");
        } else {
            XB_SPIN(xb_ld(&bar[XB_XGEN(b.x)]) == gen, bar);
            __builtin_amdgcn_fence(__ATOMIC_ACQUIRE, "agent");
            asm volatile("s_waitcnt vmcnt(0)" ::: "memory");
        }
    }
    __syncthreads();
}

struct Args { const float* in[27]; float* out; unsigned char* ws; int ph_lo, ph_hi, li, pad; };
enum { I_X = 0, I_C, I_ADAW, I_ADAB, I_LNG, I_LNB, I_GWIN, I_GWG2F, I_GBGF, I_GWG2B, I_GBGB, I_GNORM, I_GWOUT, I_SWIN, I_SBIN, I_SLNG, I_SLNB, I_SWS, I_SBS, I_SWOUT, I_SBOUT, I_RW, I_RB, I_WUP, I_BUP, I_WDN, I_BDN };

typedef const __attribute__((address_space(4))) Args* KA;
#define PHASE_ENTER() unsigned m1_ = ~0u; asm volatile("" : "+s"(m1_)); int tid = (wave_s << 6) | (int)__builtin_amdgcn_mbcnt_hi(m1_, __builtin_amdgcn_mbcnt_lo(m1_, 0u)); asm volatile("" : "+v"(tid)); int bx = blockIdx.x, G = gridDim.x; asm volatile("" : "+s"(bx), "+s"(G)); \
    KA a = (KA)__builtin_amdgcn_kernarg_segment_ptr(); asm volatile("" : "+s"(a)); unsigned char* ws = a->ws; \
    extern __shared__ __attribute__((aligned(16))) unsigned char lds_raw[]; LAS unsigned char* lds = (LAS unsigned char*)lds_raw; (void)lds; (void)ws; (void)bx; (void)G; (void)tid
__device__ __forceinline__ int swiglu_perm(int o) {
    const int a = o >> 1, h = o & 1, pn = a >> 7, r = a & 127, bj = r >> 6, r2 = r & 63, wc = r2 >> 4, r3 = r2 & 15;
    return 256 * pn + 128 * bj + 32 * wc + 16 * h + r3;
}
__device__ __forceinline__ void conv_tile(const float* W, int K, int N, int k0, int n0, int nw, bf16* dst, int mode, LAS float* scr, int lane) {
    const int c4 = lane & 15, kr = lane >> 4;
    if (4 * c4 < nw) {
        f32x4 ld[16];
#pragma unroll
        for (int i = 0; i < 16; ++i) ld[i] = __builtin_nontemporal_load((const f32x4*)(W + (size_t)(k0 + 4 * i + kr) * N + n0 + 4 * c4));
#pragma unroll
        for (int i = 0; i < 16; ++i) { LAS float* s = scr + (4 * i + kr) * 65 + 4 * c4; s[0] = ld[i][0]; s[1] = ld[i][1]; s[2] = ld[i][2]; s[3] = ld[i][3]; }
    }
    LDS_WAIT(); asm volatile("" ::: "memory");
    const int kc = lane & 7, ns = lane >> 3;
    for (int j = 0; j < nw / 8; ++j) {
        const int n = ns + 8 * j; const LAS float* s = scr + (8 * kc) * 65 + n;
        float v[8];
#pragma unroll
        for (int q = 0; q < 8; ++q) v[q] = s[q * 65];
        u32x4 o; o.x = cvt_pk_bf16(v[0], v[1]); o.y = cvt_pk_bf16(v[2], v[3]); o.z = cvt_pk_bf16(v[4], v[5]); o.w = cvt_pk_bf16(v[6], v[7]);
        const int ng = n0 + n;
        if (mode >= 3 && mode <= 5) {
            const int row = (mode == 4) ? swiglu_perm(ng) : (mode == 5) ? ((ng & ~31) + 16 * ((ng >> 2) & 1) + 4 * ((ng >> 3) & 3) + (ng & 3)) : ng;
            int w0 = __builtin_amdgcn_cvt_pk_fp8_f32(v[0] * F8_WSCALE, v[1] * F8_WSCALE, 0, false); w0 = __builtin_amdgcn_cvt_pk_fp8_f32(v[2] * F8_WSCALE, v[3] * F8_WSCALE, w0, true);
            int w1 = __builtin_amdgcn_cvt_pk_fp8_f32(v[4] * F8_WSCALE, v[5] * F8_WSCALE, 0, false); w1 = __builtin_amdgcn_cvt_pk_fp8_f32(v[6] * F8_WSCALE, v[7] * F8_WSCALE, w1, true);
            *(u32x2*)((unsigned char*)dst + (size_t)row * K + k0 + 8 * kc) = (u32x2){(unsigned)w0, (unsigned)w1};
        } else if (mode == 2) {
            *(u32x4*)(dst + (size_t)n * K + k0 + 8 * kc) = o;
            u32x4 l; l.x = cvt_pk_bf16(v[0] - bf_lo(o.x), v[1] - bf_hi(o.x)); l.y = cvt_pk_bf16(v[2] - bf_lo(o.y), v[3] - bf_hi(o.y));
            l.z = cvt_pk_bf16(v[4] - bf_lo(o.z), v[5] - bf_hi(o.z)); l.w = cvt_pk_bf16(v[6] - bf_lo(o.w), v[7] - bf_hi(o.w));
            *(u32x4*)(dst + (size_t)(32 + n) * K + k0 + 8 * kc) = l;
        } else {
            const int row = (mode == 1) ? swiglu_perm(ng) : (mode == 6) ? ((ng & ~31) + 16 * ((ng >> 2) & 1) + 4 * ((ng >> 3) & 3) + (ng & 3)) : ng;
            *(u32x4*)(dst + (size_t)row * K + k0 + 8 * kc) = o;
        }
    }
    LDS_WAIT(); asm volatile("" ::: "memory");
}

__device__ __forceinline__ void phase_prologue(KA a, LAS unsigned char* lds, int tid, int bx, int G) {
    const int lane = tid & 63, wave = __builtin_amdgcn_readfirstlane(tid >> 6);
    unsigned char* ws = a->ws;
    for (int slab = bx; slab < 192; slab += G) {
        LAS float* sc = (LAS float*)lds;
        LAS float* red = (LAS float*)(lds + 32768);
        for (int i = tid; i < 8 * 1024; i += NTHREADS) sc[i] = silu_f(a->in[I_C][i]);
        __syncthreads();
        const int g0 = slab * 128, l = g0 / 6144, e0 = g0 % 6144;
        const int c4 = tid & 31, seg = tid >> 5;
        f32x4 acc[8];
#pragma unroll
        for (int b = 0; b < 8; ++b) acc[b] = (f32x4){0.f, 0.f, 0.f, 0.f};
        const float* wp = a->in[I_ADAW] + ((size_t)l * 1024 + seg * 64) * 6144 + e0 + 4 * c4;
#pragma unroll 8
        for (int d = 0; d < 64; ++d) { const f32x4 w = __builtin_nontemporal_load((const f32x4*)(wp + (size_t)d * 6144));
#pragma unroll
            for (int b = 0; b < 8; ++b) acc[b] += w * sc[b * 1024 + seg * 64 + d]; }
#pragma unroll
        for (int b = 0; b < 8; ++b) *(LAS f32x4*)(red + (seg * 8 + b) * 128 + 4 * c4) = acc[b];
        __syncthreads();
        for (int o = tid; o < 1024; o += NTHREADS) { const int b = o >> 7, c = o & 127; float s = a->in[I_ADAB][l * 6144 + e0 + c];
#pragma unroll
            for (int sg = 0; sg < 16; ++sg) s += red[(sg * 8 + b) * 128 + c];
            ((float*)(ws + WS_MOD))[((size_t)l * 8 + b) * 6144 + e0 + c] = s; }
        __syncthreads();
    }
    LAS float* scr = (LAS float*)(lds + wave * 16640);
    const int gw = bx * NWAVES + wave, NGW = G * NWAVES;
    constexpr int N_UP = 128 * 16 * 32, N_DN = 128 * 16 * 16, N_GIN = 2 * 16 * 48, N_GLR = 2 * 16, N_GOUT = 2 * 256, N_SIN = 2 * 16 * 32, N_SOUT = 2 * 256, N_RT = 4 * 16;
    constexpr int NITEMS = N_UP + N_DN + N_GIN + N_GLR + N_GOUT + N_SIN + N_SOUT + N_RT;
    for (int it = gw; it < NITEMS; it += NGW) {
        int r = it;
        if (r < N_UP) { const int m = r >> 9, q = r & 511, kt = q >> 5, nt = q & 31;
            conv_tile(a->in[I_WUP] + (size_t)m * 1024 * 2048, 1024, 2048, kt * 64, nt * 64, 64, (bf16*)(ws + WS_WUP_T + (size_t)m * 2048 * 1024 * (MOE_FP8 ? 1 : 2)), MOE_FP8 ? 4 : 1, scr, lane); continue; } r -= N_UP;
        if (r < N_DN) { const int m = r >> 8, q = r & 255, kt = q >> 4, nt = q & 15;
            conv_tile(a->in[I_WDN] + (size_t)m * 1024 * 1024, 1024, 1024, kt * 64, nt * 64, 64, (bf16*)(ws + WS_WDN_T + (size_t)m * 1024 * 1024 * (MOE_FP8 ? 1 : 2)), MOE_FP8 ? 5 : 0, scr, lane); continue; } r -= N_DN;
        if (r < N_GIN) { const int m = r / 768, q = r % 768, kt = q / 48, nt = q % 48;
            conv_tile(a->in[I_GWIN] + (size_t)m * 1024 * GLA_IN, 1024, GLA_IN, kt * 64, nt * 64, 64, (bf16*)(ws + WS_GLAIN_T) + (size_t)m * GLA_MAIN * 1024, 6, scr, lane); continue; } r -= N_GIN;
        if (r < N_GLR) { const int m = r >> 4, kt = r & 15;
            conv_tile(a->in[I_GWIN] + (size_t)m * 1024 * GLA_IN, 1024, GLA_IN, kt * 64, GLA_MAIN, 32, (bf16*)(ws + WS_GLALR_T) + (size_t)m * 64 * 1024, 2, scr, lane); continue; } r -= N_GLR;
        if (r < N_GOUT) { const int m = r >> 8, q = r & 255, kt = q >> 4, nt = q & 15;
            conv_tile(a->in[I_GWOUT] + (size_t)m * 1024 * 1024, 1024, 1024, kt * 64, nt * 64, 64, (bf16*)(ws + WS_GLAOUT_T) + (size_t)m * 1024 * 1024, 6, scr, lane); continue; } r -= N_GOUT;
        if (r < N_SIN) { const int m = r >> 9, q = r & 511, kt = q >> 5, nt = q & 31;
            conv_tile(a->in[I_SWIN] + (size_t)m * 1024 * 2048, 1024, 2048, kt * 64, nt * 64, 64, (bf16*)(ws + WS_SGUIN_T) + (size_t)m * 2048 * 1024, 6, scr, lane); continue; } r -= N_SIN;
        if (r < N_SOUT) { const int m = r >> 8, q = r & 255, kt = q >> 4, nt = q & 15;
            conv_tile(a->in[I_SWOUT] + (size_t)m * 1024 * 1024, 1024, 1024, kt * 64, nt * 64, 64, (bf16*)(ws + WS_SGUOUT_T) + (size_t)m * 1024 * 1024, 6, scr, lane); continue; } r -= N_SOUT;
        { const int m = r >> 4, kt = r & 15;
            conv_tile(a->in[I_RW] + (size_t)m * 1024 * 32, 1024, 32, kt * 64, 0, 32, (bf16*)(ws + WS_ROUTER_T) + (size_t)m * 64 * 1024, 2, scr, lane); }
    }
    { bf16* d = (bf16*)(ws + WS_SGUWS); const float* s = a->in[I_SWS];
      for (int i = (bx * NTHREADS + tid) * 4; i < 2 * 8 * 128 * 128; i += G * NTHREADS * 4) { const f32x4 v = *(const f32x4*)(s + i); u32x2 o; o.x = cvt_pk_bf16(v[0], v[1]); o.y = cvt_pk_bf16(v[2], v[3]); *(u32x2*)(d + i) = o; } }
}

struct RowPass {
    const void* xin; const bf16* y; void* xout; bf16* hout; unsigned char* h8out; int xin16, xout16;
    const float* gate; const float* lng; const float* lnb; const float* sc; const float* sh;
    const bf16* wside;
    float* lr_out;
    const float* rbias;
    int* topi; float* topw; int* hist;
    const void* ys; const int* dest; const float* tw;
    int has_h, has_side;
};
template <int MODE>
__device__ __forceinline__ void row_pass(const RowPass& p, LAS unsigned char* lds, int tid, int bx, int G) {
    const int lane = tid & 63, wave = __builtin_amdgcn_readfirstlane(tid >> 6);
    constexpr int HS = 1032;
    LAS bf16* Hhi = (LAS bf16*)lds;
    LAS bf16* Hlo = (LAS bf16*)(lds + 16 * HS * 2);
    LAS float* part = (LAS float*)(lds + 2 * 16 * HS * 2);
    LAS float* logit = part + 8 * 32 * 16;
    LAS int* lhist = (LAS int*)(logit + 16 * 32);
    if (MODE == 1) { if (tid < 32) lhist[tid] = 0; }
    const bool side = (p.has_side != 0) && (p.wside != nullptr);
    bf16x8 whi[2][4], wlo[2][4];
    if (side) {
#pragma unroll
        for (int hf = 0; hf < 2; ++hf)
#pragma unroll
            for (int s = 0; s < 4; ++s) { const size_t off = (size_t)(hf * 16 + (lane & 15)) * 1024 + 128 * wave + 32 * s + 8 * (lane >> 4);
                whi[hf][s] = *(const bf16x8*)(p.wside + off); wlo[hf][s] = *(const bf16x8*)(p.wside + 32 * 1024 + off); }
    }
    for (int tile = bx; tile < T / 16; tile += G) {
        const int b = (tile * 16) / SEQ;
#pragma unroll 1
        for (int tt = 0; tt < 2; ++tt) {
            const int tl = 2 * wave + tt, token = tile * 16 + tl;
            f32x4 v[4];
            if (p.xin16) { const bf16* xr = (const bf16*)p.xin + (size_t)token * D + 4 * lane;
#pragma unroll
                for (int j = 0; j < 4; ++j) { const u32x2 q = *(const u32x2*)(xr + 256 * j); v[j] = (f32x4){bf_lo(q.x), bf_hi(q.x), bf_lo(q.y), bf_hi(q.y)}; } }
            else { const float* xr = (const float*)p.xin + (size_t)token * D + 4 * lane;
#pragma unroll
                for (int j = 0; j < 4; ++j) v[j] = *(const f32x4*)(xr + 256 * j); }
            if (MODE == 1) {
                const bf16* yr = p.y + (size_t)token * D + 4 * lane; const float* gp = p.gate + (size_t)b * 6144 + 4 * lane;
#pragma unroll
                for (int j = 0; j < 4; ++j) { const u32x2 yq = *(const u32x2*)(yr + 256 * j); const f32x4 yy = (f32x4){bf_lo(yq.x), bf_hi(yq.x), bf_lo(yq.y), bf_hi(yq.y)}; const f32x4 g = *(const f32x4*)(gp + 256 * j); v[j] = v[j] * ALPHA + (g + 1.0f) * yy; }
            }
            if (MODE == 2) {
                f32x4 ya[4];
#pragma unroll
                for (int j = 0; j < 4; ++j) ya[j] = (f32x4){0.f, 0.f, 0.f, 0.f};
#pragma unroll
                for (int k = 0; k < 4; ++k) { const int ds = p.dest[token * 4 + k];
#if MOE_FP8
                    const float w = p.tw[token * 4 + k] * (1.0f / F8_YSCALE); const unsigned char* yr = (const unsigned char*)p.ys + (size_t)ds * D + 4 * lane;
#pragma unroll
                    for (int j = 0; j < 4; ++j) { const int q = *(const int*)(yr + 256 * j); const f32x2 lo2 = __builtin_amdgcn_cvt_pk_f32_fp8(q, false), hi2 = __builtin_amdgcn_cvt_pk_f32_fp8(q, true); ya[j] += (f32x4){lo2[0], lo2[1], hi2[0], hi2[1]} * w; } }
#else
                    const float w = p.tw[token * 4 + k]; const bf16* yr = (const bf16*)p.ys + (size_t)ds * D + 4 * lane;
#pragma unroll
                    for (int j = 0; j < 4; ++j) { const u32x2 q = *(const u32x2*)(yr + 256 * j); ya[j] += (f32x4){bf_lo(q.x), bf_hi(q.x), bf_lo(q.y), bf_hi(q.y)} * w; } }
#endif
                const float* gp = p.gate + (size_t)b * 6144 + 4 * lane;
#pragma unroll
                for (int j = 0; j < 4; ++j) { const f32x4 g = *(const f32x4*)(gp + 256 * j); v[j] = v[j] * ALPHA + (g + 1.0f) * ya[j]; }
            }
            if (MODE != 0) {
                float s = 0.f;
#pragma unroll
                for (int j = 0; j < 4; ++j) s += (v[j][0] + v[j][1]) + (v[j][2] + v[j][3]);
                const float mean = wave_sum(s, lane) * (1.0f / D); float s2 = 0.f;
#pragma unroll
                for (int j = 0; j < 4; ++j) { v[j] = v[j] - mean; s2 += (v[j][0] * v[j][0] + v[j][1] * v[j][1]) + (v[j][2] * v[j][2] + v[j][3] * v[j][3]); }
                const float rstd = 1.0f / sqrtf(wave_sum(s2, lane) * (1.0f / D) + LN_EPS);
#pragma unroll
                for (int j = 0; j < 4; ++j) { const f32x4 g = *(const f32x4*)(p.lng + 4 * lane + 256 * j), bb = *(const f32x4*)(p.lnb + 4 * lane + 256 * j); v[j] = v[j] * rstd * g + bb; }
                if (p.xout16) { bf16* xo = (bf16*)p.xout + (size_t)token * D + 4 * lane;
#pragma unroll
                    for (int j = 0; j < 4; ++j) { u32x2 o; o.x = cvt_pk_bf16(v[j][0], v[j][1]); o.y = cvt_pk_bf16(v[j][2], v[j][3]); *(u32x2*)(xo + 256 * j) = o; } }
                else { float* xo = (float*)p.xout + (size_t)token * D + 4 * lane;
#pragma unroll
                    for (int j = 0; j < 4; ++j) *(f32x4*)(xo + 256 * j) = v[j]; }
            }
            if (p.has_h) {
                const float* scp = p.sc + (size_t)b * 6144 + 4 * lane; const float* shp = p.sh + (size_t)b * 6144 + 4 * lane;
                bf16* ho = p.hout + (size_t)token * D + 4 * lane;
#pragma unroll
                for (int j = 0; j < 4; ++j) { const f32x4 s1 = *(const f32x4*)(scp + 256 * j), s0 = *(const f32x4*)(shp + 256 * j); const f32x4 h = v[j] * (s1 + 1.0f) + s0;
                    u32x2 o; o.x = cvt_pk_bf16(h[0], h[1]); o.y = cvt_pk_bf16(h[2], h[3]); if (!(MODE == 1 && MOE_FP8)) *(u32x2*)(ho + 256 * j) = o;
                    if (MODE == 1 && p.h8out) { int w8 = __builtin_amdgcn_cvt_pk_fp8_f32(h[0] * F8_HSCALE, h[1] * F8_HSCALE, 0, false); w8 = __builtin_amdgcn_cvt_pk_fp8_f32(h[2] * F8_HSCALE, h[3] * F8_HSCALE, w8, true); *(int*)(p.h8out + (size_t)token * D + 4 * lane + 256 * j) = w8; }
                    if (side) { u32x2 l; l.x = cvt_pk_bf16(h[0] - bf_lo(o.x), h[1] - bf_hi(o.x)); l.y = cvt_pk_bf16(h[2] - bf_lo(o.y), h[3] - bf_hi(o.y));
                        *(LAS u32x2*)(Hhi + tl * HS + 4 * lane + 256 * j) = o; *(LAS u32x2*)(Hlo + tl * HS + 4 * lane + 256 * j) = l; } }
            }
        }
        if (side) {
            __syncthreads();
            f32x4 acc[2]; acc[0] = (f32x4){0.f, 0.f, 0.f, 0.f}; acc[1] = acc[0];
#pragma unroll
            for (int s = 0; s < 4; ++s) { const int ko = (lane & 15) * HS + 128 * wave + 32 * s + 8 * (lane >> 4);
                const bf16x8 bh = *(const LAS bf16x8*)(Hhi + ko), bl = *(const LAS bf16x8*)(Hlo + ko);
#pragma unroll
                for (int hf = 0; hf < 2; ++hf) { acc[hf] = __builtin_amdgcn_mfma_f32_16x16x32_bf16(whi[hf][s], bh, acc[hf], 0, 0, 0);
                    acc[hf] = __builtin_amdgcn_mfma_f32_16x16x32_bf16(wlo[hf][s], bh, acc[hf], 0, 0, 0); acc[hf] = __builtin_amdgcn_mfma_f32_16x16x32_bf16(whi[hf][s], bl, acc[hf], 0, 0, 0); } }
#pragma unroll
            for (int hf = 0; hf < 2; ++hf)
#pragma unroll
                for (int j = 0; j < 4; ++j) part[(wave * 32 + hf * 16 + 4 * (lane >> 4) + j) * 16 + (lane & 15)] = acc[hf][j];
            __syncthreads();
            { const int e = tid >> 4, tk = tid & 15; float s = 0.f;
#pragma unroll
              for (int w = 0; w < 8; ++w) s += part[(w * 32 + e) * 16 + tk];
              if (MODE == 1) logit[tk * 32 + e] = s + p.rbias[e];
              else p.lr_out[(size_t)(tile * 16 + tk) * 32 + e] = s; }
            if (MODE == 1) {
                __syncthreads();
                if (tid < 16) {
                    const int token = tile * 16 + tid; float lv[32];
#pragma unroll
                    for (int e = 0; e < 32; ++e) lv[e] = logit[tid * 32 + e];
                    int bi[4]; float bv[4];
#pragma unroll
                    for (int k = 0; k < 4; ++k) { float m = -3.0e38f; int mi = 0;
#pragma unroll
                        for (int e = 0; e < 32; ++e) { const bool take = lv[e] > m; m = take ? lv[e] : m; mi = take ? e : mi; }
                        bi[k] = mi; bv[k] = m;
#pragma unroll
                        for (int e = 0; e < 32; ++e) lv[e] = (e == mi) ? -3.0e38f : lv[e]; }
                    const float e1 = __expf(bv[1] - bv[0]), e2 = __expf(bv[2] - bv[0]), e3 = __expf(bv[3] - bv[0]); const float inv = 1.0f / (1.0f + e1 + e2 + e3);
                    *(int4*)(p.topi + token * 4) = make_int4(bi[0], bi[1], bi[2], bi[3]);
                    *(f32x4*)(p.topw + token * 4) = (f32x4){inv, e1 * inv, e2 * inv, e3 * inv};
#pragma unroll
                    for (int k = 0; k < 4; ++k) atomicAdd((int*)&lhist[bi[k]], 1);
                }
            }
            __syncthreads();
        }
    }
    if (MODE == 1) { __syncthreads(); if (tid < 32) p.hist[tid] = lhist[tid]; }
}

__device__ __forceinline__ void phase_place(int* route, LAS unsigned char* lds, int tid, int bx, int G) {
    const int lane = tid & 63, wave = tid >> 6;
    LAS int* ptot = (LAS int*)lds;
    LAS int* ppre = ptot + 512;
    LAS int* tot = ppre + 512;
    LAS int* pre = tot + 32;
    LAS int* pstart = pre + 32;
    const int* hist = route + R_HIST;
    { const int e = tid & 31, part = tid >> 5; int st = 0, sp = 0;
      for (int bb = part; bb < G; bb += 16) { const int h = hist[bb * 32 + e]; st += h; if (bb < bx) sp += h; }
      ptot[part * 32 + e] = st; ppre[part * 32 + e] = sp; }
    __syncthreads();
    if (tid < 32) { int st = 0, sp = 0;
#pragma unroll
        for (int q = 0; q < 16; ++q) { st += ptot[q * 32 + tid]; sp += ppre[q * 32 + tid]; }
        tot[tid] = st; pre[tid] = sp; }
    __syncthreads();
    if (tid == 0) { int acc = 0; for (int e = 0; e < 32; ++e) { pstart[e] = acc; acc += (tot[e] + 255) / 256 * 256; } pstart[32] = acc; }
    __syncthreads();
    if (bx == 0) {
        const int ntiles = pstart[32] / 256;
        if (tid == 0) route[R_NTILES] = ntiles;
        for (int t = tid; t < ntiles; t += NTHREADS) { int e = 0; for (int q = 1; q < 32; ++q) if (pstart[q] <= t * 256) e = q; route[R_TILEE + t] = e; }
    }
    for (int e = bx; e < 32; e += G) { const int s0 = pstart[e] + tot[e], s1 = pstart[e + 1]; for (int s = s0 + tid; s < s1; s += NTHREADS) route[R_BUFTOK + s] = 0; }
    if (wave == 0) {
        int run = 0;
        for (int tile = bx; tile < T / 16; tile += G) {
            const int token = tile * 16 + (lane >> 2);
            const int e = route[R_TOPI + tile * 64 + lane];
            const int base = shfl_i(run, e, lane);
            int rank = 0, add = 0;
#pragma unroll 1
            for (int x = 0; x < 32; ++x) { const unsigned long long m = __ballot(e == x); if (e == x) rank = __popcll(m & ((1ull << lane) - 1ull)); if (lane == x) add = __popcll(m); }
            run += add;
            const int ds = pstart[e] + pre[e] + base + rank;
            route[R_DEST + tile * 64 + lane] = ds;
            route[R_BUFTOK + ds] = token;
        }
    }
}

struct Unit { int pm, pn, e; const char* bt; };
constexpr int NXCD = 8, WGM = 8;
struct Sched {
    int nM, nN, nwg, G, c; const char* Bt; size_t estride; const int* tile_e; int KB;
    __device__ __forceinline__ void init(int nM_, int nN_, int G_, int c_, const void* Bt_, size_t es, const int* te, int KB_) { nM = nM_; nN = nN_; nwg = nM * nN; G = G_; c = c_; Bt = (const char*)Bt_; estride = es; tile_e = te; KB = KB_; }
    __device__ __forceinline__ bool next(int i, Unit& u) const {
        const long L = (long)i * G + c; if (L >= nwg) return false;
        int wgid = (int)L; { const int q = nwg / NXCD, r = nwg % NXCD, xcd = wgid % NXCD, off = wgid / NXCD; wgid = (xcd < r ? xcd * (q + 1) : r * (q + 1) + (xcd - r) * q) + off; }
        const int nig = WGM * nN, gid = wgid / nig, fm = gid * WGM, gsz = (nM - fm) < WGM ? (nM - fm) : WGM;
        u.pm = fm + ((wgid % nig) % gsz); u.pn = (wgid % nig) / gsz;
        u.e = tile_e ? __builtin_amdgcn_readfirstlane(tile_e[u.pm]) : 0;
        u.bt = Bt + (size_t)u.e * estride + (size_t)u.pn * 256 * KB;
        return true;
    }
};
struct EpiGlaIn { bf16* O;
    static constexpr int NST = 16;
    __device__ __forceinline__ const float* bias_ptr(const Unit&) const { return nullptr; }
    __device__ __forceinline__ void operator()(const f32x4 (&acc)[2][2][4][2], const Unit& u, int wr, int wc, int fr, int fq, const LAS float*) const {
        const int row0 = u.pm * 256 + wr * 64 + fr, col0 = u.pn * 256 + wc * 32 + 8 * fq; const float sc = (u.pn < 2) ? 0.08838834764831845f : 1.0f;
#pragma unroll
        for (int ai = 0; ai < 2; ++ai)
#pragma unroll
            for (int m = 0; m < 4; ++m) { bf16* rp = O + (size_t)(row0 + ai * 128 + m * 16) * GLA_MAIN + col0;
#pragma unroll
                for (int bj = 0; bj < 2; ++bj) { const f32x4 v0 = acc[ai][bj][m][0] * sc, v1 = acc[ai][bj][m][1] * sc;
                    *(u32x4*)(rp + bj * 128) = (u32x4){cvt_pk_bf16(v0[0], v0[1]), cvt_pk_bf16(v0[2], v0[3]), cvt_pk_bf16(v1[0], v1[1]), cvt_pk_bf16(v1[2], v1[3])}; } }
    }
};
struct EpiSguIn { bf16* O; const float* bias;
    static constexpr int NST = 16;
    __device__ __forceinline__ const float* bias_ptr(const Unit& u) const { return bias + u.pn * 256; }
    __device__ __forceinline__ void operator()(const f32x4 (&acc)[2][2][4][2], const Unit& u, int wr, int wc, int fr, int fq, const LAS float* lb) const {
        const int row0 = u.pm * 256 + wr * 64 + fr, col0 = u.pn * 256 + wc * 32 + 8 * fq;
        f32x4 bv[2][2];
#pragma unroll
        for (int bj = 0; bj < 2; ++bj)
#pragma unroll
            for (int n = 0; n < 2; ++n) bv[bj][n] = *(const LAS f32x4*)(lb + wc * 32 + 8 * fq + bj * 128 + 4 * n);
#pragma unroll
        for (int ai = 0; ai < 2; ++ai)
#pragma unroll
            for (int m = 0; m < 4; ++m) { bf16* rp = O + (size_t)(row0 + ai * 128 + m * 16) * 2048 + col0;
#pragma unroll
                for (int bj = 0; bj < 2; ++bj) { const f32x4 v0 = acc[ai][bj][m][0] + bv[bj][0], v1 = acc[ai][bj][m][1] + bv[bj][1];
                    *(u32x4*)(rp + bj * 128) = (u32x4){cvt_pk_bf16(gelu_f(v0[0]), gelu_f(v0[1])), cvt_pk_bf16(gelu_f(v0[2]), gelu_f(v0[3])), cvt_pk_bf16(gelu_f(v1[0]), gelu_f(v1[1])), cvt_pk_bf16(gelu_f(v1[2]), gelu_f(v1[3]))}; } }
    }
};
struct EpiOut { bf16* O; const float* bias;
    static constexpr int NST = 16;
    __device__ __forceinline__ const float* bias_ptr(const Unit& u) const { return bias ? bias + u.pn * 256 : nullptr; }
    __device__ __forceinline__ void operator()(const f32x4 (&acc)[2][2][4][2], const Unit& u, int wr, int wc, int fr, int fq, const LAS float* lb) const {
        const int row0 = u.pm * 256 + wr * 64 + fr, col0 = u.pn * 256 + wc * 32 + 8 * fq;
        f32x4 bv[2][2];
#pragma unroll
        for (int bj = 0; bj < 2; ++bj)
#pragma unroll
            for (int n = 0; n < 2; ++n) bv[bj][n] = bias ? *(const LAS f32x4*)(lb + wc * 32 + 8 * fq + bj * 128 + 4 * n) : (f32x4){0.f, 0.f, 0.f, 0.f};
#pragma unroll
        for (int ai = 0; ai < 2; ++ai)
#pragma unroll
            for (int m = 0; m < 4; ++m) { bf16* rp = O + (size_t)(row0 + ai * 128 + m * 16) * D + col0;
#pragma unroll
                for (int bj = 0; bj < 2; ++bj) { const f32x4 v0 = acc[ai][bj][m][0] + bv[bj][0], v1 = acc[ai][bj][m][1] + bv[bj][1];
                    *(u32x4*)(rp + bj * 128) = (u32x4){cvt_pk_bf16(v0[0], v0[1]), cvt_pk_bf16(v0[2], v0[3]), cvt_pk_bf16(v1[0], v1[1]), cvt_pk_bf16(v1[2], v1[3])}; } }
    }
};
template <bool F8> struct EpiUp { unsigned char* O; const float* bias;
    __device__ __forceinline__ const float* bias_ptr(const Unit& u) const { return bias + (size_t)u.e * 2048 + u.pn * 256; }
    __device__ __forceinline__ void operator()(const f32x4 (&acc)[2][2][4][2], const Unit& u, int wr, int wc, int fr, int fq, const LAS float* lb) const {
        const int row0 = u.pm * 256 + wr * 64 + fr, a0 = u.pn * 128 + wc * 16 + 4 * fq;
        const float asc = F8 ? 1.0f / (F8_WSCALE * F8_HSCALE) : 1.0f;
        f32x4 bg[2], bl[2];
#pragma unroll
        for (int bj = 0; bj < 2; ++bj) { const LAS float* bp = lb + 2 * (wc * 16 + 4 * fq + 64 * bj); const f32x4 p0 = *(const LAS f32x4*)bp, p1 = *(const LAS f32x4*)(bp + 4);
            bg[bj] = (f32x4){p0[0], p0[2], p1[0], p1[2]}; bl[bj] = (f32x4){p0[1], p0[3], p1[1], p1[3]}; }
#pragma unroll
        for (int ai = 0; ai < 2; ++ai)
#pragma unroll
            for (int m = 0; m < 4; ++m) { const size_t ro = (size_t)(row0 + ai * 128 + m * 16) * D + a0;
#pragma unroll
                for (int bj = 0; bj < 2; ++bj) { const f32x4 g = acc[ai][bj][m][0] * asc + bg[bj], l = acc[ai][bj][m][1] * asc + bl[bj]; float r[4];
#pragma unroll
                    for (int j = 0; j < 4; ++j) { const float gg = fminf(g[j], 7.0f), ll = fminf(fmaxf(l[j], -7.0f), 7.0f); r[j] = gg * sigmoid_f(1.702f * gg) * (ll + 1.0f); }
                    if constexpr (F8) { int w = __builtin_amdgcn_cvt_pk_fp8_f32(r[0] * F8_ASCALE, r[1] * F8_ASCALE, 0, false); w = __builtin_amdgcn_cvt_pk_fp8_f32(r[2] * F8_ASCALE, r[3] * F8_ASCALE, w, true);
                        *(int*)(O + ro + bj * 64) = w; }
                    else { u32x2 o; o.x = cvt_pk_bf16(r[0], r[1]); o.y = cvt_pk_bf16(r[2], r[3]); *(u32x2*)((bf16*)O + ro + bj * 64) = o; } } }
    }
};
struct EpiDown8 { unsigned char* O; const float* bias; float asc;
    static constexpr int NST = 16;
    __device__ __forceinline__ const float* bias_ptr(const Unit& u) const { return bias + (size_t)u.e * 1024 + u.pn * 256; }
    __device__ __forceinline__ void operator()(const f32x4 (&acc)[2][2][4][2], const Unit& u, int wr, int wc, int fr, int fq, const LAS float* lb) const {
        const int row0 = u.pm * 256 + wr * 64 + fr, col0 = u.pn * 256 + wc * 32 + 8 * fq;
        f32x4 bv[2][2];
#pragma unroll
        for (int bj = 0; bj < 2; ++bj)
#pragma unroll
            for (int n = 0; n < 2; ++n) bv[bj][n] = *(const LAS f32x4*)(lb + wc * 32 + 8 * fq + bj * 128 + 4 * n) * F8_YSCALE;
        const float sc = asc * F8_YSCALE;
#pragma unroll
        for (int ai = 0; ai < 2; ++ai)
#pragma unroll
            for (int m = 0; m < 4; ++m) { unsigned char* rp = O + (size_t)(row0 + ai * 128 + m * 16) * D + col0;
#pragma unroll
                for (int bj = 0; bj < 2; ++bj) { const f32x4 v0 = acc[ai][bj][m][0] * sc + bv[bj][0], v1 = acc[ai][bj][m][1] * sc + bv[bj][1];
                    int w0 = __builtin_amdgcn_cvt_pk_fp8_f32(v0[0], v0[1], 0, false); w0 = __builtin_amdgcn_cvt_pk_fp8_f32(v0[2], v0[3], w0, true);
                    int w1 = __builtin_amdgcn_cvt_pk_fp8_f32(v1[0], v1[1], 0, false); w1 = __builtin_amdgcn_cvt_pk_fp8_f32(v1[2], v1[3], w1, true);
                    *(u32x2*)(rp + bj * 128) = (u32x2){(unsigned)w0, (unsigned)w1}; } }
    }
};
struct EpiDown { bf16* O; const float* bias; float asc;
    __device__ __forceinline__ const float* bias_ptr(const Unit& u) const { return bias + (size_t)u.e * 1024 + u.pn * 256; }
    __device__ __forceinline__ void operator()(const f32x4 (&acc)[2][2][4][2], const Unit& u, int wr, int wc, int fr, int fq, const LAS float* lb) const {
        const int row0 = u.pm * 256 + wr * 64 + fr, col0 = u.pn * 256 + wc * 32 + 4 * fq;
        f32x4 bv[2][2];
#pragma unroll
        for (int bj = 0; bj < 2; ++bj)
#pragma unroll
            for (int n = 0; n < 2; ++n) bv[bj][n] = *(const LAS f32x4*)(lb + wc * 32 + 4 * fq + bj * 128 + n * 16);
#pragma unroll
        for (int ai = 0; ai < 2; ++ai)
#pragma unroll
            for (int m = 0; m < 4; ++m) { bf16* rp = O + (size_t)(row0 + ai * 128 + m * 16) * D + col0;
#pragma unroll
                for (int bj = 0; bj < 2; ++bj)
#pragma unroll
                    for (int n = 0; n < 2; ++n) { const f32x4 v = acc[ai][bj][m][n] * asc + bv[bj][n]; u32x2 o; o.x = cvt_pk_bf16(v[0], v[1]); o.y = cvt_pk_bf16(v[2], v[3]); *(u32x2*)(rp + bj * 128 + n * 16) = o; } }
    }
};

constexpr int G8_BK = 64, G8_HALF = 128, G8_HTB = G8_HALF * G8_BK * 2, G8_STAGE_BYTES = 8 * G8_HTB;
__device__ __forceinline__ int g8_lds_byte(int r, int c) { const int st = (r >> 4) * 2 + (c >> 5), rr = r & 15, cc = c & 31, ob = rr * 64 + cc * 2; return st * 1024 + (ob ^ (((ob >> 9) & 1) << 5)); }
__device__ __forceinline__ void g8_stage_rc(int b, int& R, int& C) { const int st = b / 1024, sb = b % 1024, swz = sb ^ (((sb >> 9) & 1) << 5); R = (st >> 1) * 16 + swz / 64; C = (st & 1) * 32 + (swz % 64) / 2; }
__device__ __forceinline__ u32x4 g8_avoff(int pm, const int* gather, int tid, int KB) {
    int t2 = tid; asm volatile("" : "+v"(t2));
    int R, C; g8_stage_rc(t2 * 16, R, C);
    const int* gp = gather + pm * 256 + R;
    const unsigned r00 = gp[0], r01 = gp[64], r10 = gp[128], r11 = gp[192], c2 = (unsigned)(C * 2), k2 = (unsigned)KB;
    return (u32x4){r00 * k2 + c2, r01 * k2 + c2, r10 * k2 + c2, r11 * k2 + c2};
}
template <bool GATHER, bool FP8, class Epi>
__device__ __forceinline__ void gemm_fast(const void* A, const int* gather, const int K, const Sched& S, const Epi& E, LAS unsigned char* lds, int tid) {
    const int wid = __builtin_amdgcn_readfirstlane(tid >> 6), lane = tid & 63, wr = wid >> 2, wc = wid & 3, fr = lane & 15, fq = lane >> 4;
    const int KB = FP8 ? K : 2 * K, nt = KB / 128;
    unsigned voff; { int R, C; g8_stage_rc(tid * 16, R, C); voff = (unsigned)(R * KB + C * 2); }
    const size_t kstep = (size_t)128, hstep = (size_t)G8_HALF * KB, qstep = (size_t)64 * KB, tstep = 2 * hstep;
    const unsigned ldsw = (unsigned)wid * 1024u;
    const int aoff = g8_lds_byte(wr * 64 + fr, fq * (FP8 ? 16 : 8)), boff = g8_lds_byte(wc * 32 + fr, fq * (FP8 ? 16 : 8));
    constexpr int KSTR = FP8 ? 16 : 1024;
#define G8_SA(b, h) (((b) * 2 + (h)) * G8_HTB)
#define G8_SB(b, h) ((4 + (b) * 2 + (h)) * G8_HTB)
#define G8_GLDS(gp, ldsoff) __builtin_amdgcn_global_load_lds((const unsigned*)(gp), (LAS unsigned*)(lds + (ldsoff)), 16, 0, 0)
#define G8_STAGE_D(bufoff, gbase) do { G8_GLDS((const char*)(gbase) + voff, (bufoff) + ldsw); G8_GLDS((const char*)(gbase) + qstep + voff, (bufoff) + ldsw + 8192); } while (0)
#define G8_STAGE_A(bufoff, kb, h) do { if constexpr (GATHER) { G8_GLDS((kb) + va[(h) * 2], (bufoff) + ldsw); G8_GLDS((kb) + va[(h) * 2 + 1], (bufoff) + ldsw + 8192); } \
        else { G8_STAGE_D(bufoff, (kb) + (h) * hstep); } } while (0)
#define G8_LDA(dst, b, h) do { _Pragma("unroll") for (int m = 0; m < 4; ++m) _Pragma("unroll") for (int k = 0; k < 2; ++k) dst[m][k] = *(const LAS bf16x8*)(lds + G8_SA(b, h) + aoff + m * 2048 + k * KSTR); } while (0)
#define G8_LDB(dst, b, h) do { _Pragma("unroll") for (int n = 0; n < 2; ++n) _Pragma("unroll") for (int k = 0; k < 2; ++k) dst[n][k] = *(const LAS bf16x8*)(lds + G8_SB(b, h) + boff + n * 2048 + k * KSTR); } while (0)
#define G8_CAT(x) __builtin_shufflevector(__builtin_bit_cast(i32x4, (x)[0]), __builtin_bit_cast(i32x4, (x)[1]), 0, 1, 2, 3, 4, 5, 6, 7)
#define G8_MMA(ai, bj, At, Bt) do { __builtin_amdgcn_s_setprio(1); _Pragma("unroll") for (int m = 0; m < 4; ++m) _Pragma("unroll") for (int n = 0; n < 2; ++n) { \
        if constexpr (FP8) acc[ai][bj][m][n] = __builtin_amdgcn_mfma_scale_f32_16x16x128_f8f6f4(G8_CAT(Bt[n]), G8_CAT(At[m]), acc[ai][bj][m][n], 0, 0, 0, 0x7f7f7f7f, 0, 0x7f7f7f7f); \
        else { _Pragma("unroll") for (int k = 0; k < 2; ++k) acc[ai][bj][m][n] = __builtin_amdgcn_mfma_f32_16x16x32_bf16(Bt[n][k], At[m][k], acc[ai][bj][m][n], 0, 0, 0); } } \
        __builtin_amdgcn_s_setprio(0); } while (0)
#define G8_WAIT_V(n) asm volatile("s_waitcnt vmcnt(" #n ")" ::: "memory")
#define G8_WAIT_L(n) asm volatile("s_waitcnt lgkmcnt(" #n ")" ::: "memory")
#define G8_BAR __builtin_amdgcn_s_barrier()
#define G8_SCHED __builtin_amdgcn_sched_barrier(0)
    Unit cur, nxt; int ui = 0;
    if (!S.next(0, cur)) return;
    f32x4 acc[2][2][4][2];
#pragma unroll
    for (int a = 0; a < 2; ++a)
#pragma unroll
        for (int b = 0; b < 2; ++b)
#pragma unroll
            for (int m = 0; m < 4; ++m)
#pragma unroll
                for (int n = 0; n < 2; ++n) acc[a][b][m][n] = (f32x4){0.f, 0.f, 0.f, 0.f};
    bf16x8 At[4][2], B0[2][2], B1[2][2];
    u32x4 va = (u32x4){0u, 0u, 0u, 0u};
    if constexpr (GATHER) va = g8_avoff(cur.pm, gather, tid, KB);
    constexpr int G8_IDX = G8_STAGE_BYTES, G8_BIAS = G8_STAGE_BYTES + 1024;
    { const float* bp0 = E.bias_ptr(cur); if (bp0 && wid == 0) G8_GLDS((const char*)bp0 + lane * 16, G8_BIAS); }
    const char* cB = (const char*)cur.bt; const char* cA = (const char*)A + (GATHER ? (size_t)0 : (size_t)cur.pm * tstep);
    G8_STAGE_D(G8_SB(0, 0), cB); G8_STAGE_D(G8_SB(0, 1), cB + hstep); G8_STAGE_A(G8_SA(0, 0), cA, 0); G8_STAGE_A(G8_SA(0, 1), cA, 1);
    if (wr == 1) G8_BAR;
    G8_WAIT_V(2); G8_BAR;
    G8_STAGE_D(G8_SB(1, 0), cB + kstep); G8_STAGE_A(G8_SA(1, 0), cA + kstep, 0); G8_STAGE_D(G8_SB(1, 1), cB + hstep + kstep);
    G8_WAIT_V(6); G8_BAR;
    for (;;) {
        const bool has_next = S.next(ui + 1, nxt);
        if constexpr (GATHER) { if (has_next && wid == 1) G8_GLDS((const char*)(gather + nxt.pm * 256) + lane * 16, G8_IDX); }
        const char* nB = has_next ? (const char*)nxt.bt : cB;
        const char* nA = (GATHER || !has_next) ? cA : (const char*)A + (size_t)nxt.pm * tstep;
#pragma unroll 1
        for (int t = 0; t < nt; t += 2) {
            const bool last = (t == nt - 2);
            const char* a1 = cA + (size_t)(t + 1) * kstep;
            const char* a2 = last ? nA : cA + (size_t)(t + 2) * kstep; const char* b2 = last ? nB : cB + (size_t)(t + 2) * kstep;
            const char* a3 = a2 + kstep; const char* b3 = b2 + kstep;
            G8_LDB(B0, 0, 0); G8_LDB(B1, 0, 1); G8_SCHED; G8_LDA(At, 0, 0); G8_STAGE_A(G8_SA(1, 1), a1, 1);
            if (last && has_next && wid == 0) { const float* bpn = E.bias_ptr(nxt); if (bpn) G8_GLDS((const char*)bpn + lane * 16, G8_BIAS + ((ui + 1) & 1) * 1024); }
            if constexpr (GATHER) { if (last && has_next) {
                int t2 = tid; asm volatile("" : "+v"(t2)); int R, C; g8_stage_rc(t2 * 16, R, C); const LAS int* ip = (const LAS int*)(lds + G8_IDX) + R; const unsigned c2 = (unsigned)(C * 2), k2 = (unsigned)KB;
                va = (u32x4){(unsigned)ip[0] * k2 + c2, (unsigned)ip[64] * k2 + c2, (unsigned)ip[128] * k2 + c2, (unsigned)ip[192] * k2 + c2}; } }
            G8_WAIT_V(8); G8_WAIT_L(0); G8_BAR; G8_MMA(0, 0, At, B0); G8_MMA(0, 1, At, B1); G8_BAR; G8_SCHED;
            G8_LDA(At, 0, 1); G8_STAGE_D(G8_SB(0, 0), b2); G8_STAGE_D(G8_SB(0, 1), b2 + hstep); G8_STAGE_A(G8_SA(0, 0), a2, 0);
            G8_WAIT_V(8); G8_WAIT_L(0); G8_BAR; G8_MMA(1, 0, At, B0); G8_MMA(1, 1, At, B1); G8_BAR; G8_SCHED;
            G8_LDB(B0, 1, 0); G8_LDB(B1, 1, 1); G8_SCHED; G8_LDA(At, 1, 0); G8_STAGE_A(G8_SA(0, 1), a2, 1);
            G8_WAIT_V(8); G8_WAIT_L(0); G8_BAR; G8_MMA(0, 0, At, B0); G8_MMA(0, 1, At, B1); G8_BAR; G8_SCHED;
            G8_LDA(At, 1, 1); G8_STAGE_D(G8_SB(1, 0), b3); G8_STAGE_D(G8_SB(1, 1), b3 + hstep); G8_STAGE_A(G8_SA(1, 0), a3, 0);
            G8_WAIT_V(8); G8_WAIT_L(0); G8_BAR; G8_MMA(1, 0, At, B0); G8_MMA(1, 1, At, B1); G8_BAR; G8_SCHED;
        }
        if (wr == 0) G8_BAR;
        { int t3 = tid; asm volatile("" : "+v"(t3)); const int l3 = t3 & 63; E(acc, cur, wr, wc, l3 & 15, l3 >> 4, (const LAS float*)(lds + G8_BIAS + (ui & 1) * 1024)); }
        if (!has_next) break;
#pragma unroll
        for (int a = 0; a < 2; ++a)
#pragma unroll
            for (int b = 0; b < 2; ++b)
#pragma unroll
                for (int m = 0; m < 4; ++m)
#pragma unroll
                    for (int n = 0; n < 2; ++n) acc[a][b][m][n] = (f32x4){0.f, 0.f, 0.f, 0.f};
        cur = nxt; cB = nB; cA = nA; ++ui;
        if (wr == 1) G8_BAR;
    }
    G8_WAIT_V(0);
    G8_BAR;
#undef G8_SA
#undef G8_SB
#undef G8_GLDS
#undef G8_STAGE_D
#undef G8_STAGE_A
#undef G8_LDA
#undef G8_LDB
#undef G8_MMA
#undef G8_CAT
#undef G8_WAIT_V
#undef G8_WAIT_L
#undef G8_BAR
#undef G8_SCHED
}

__device__ __forceinline__ float logsigmoid_f(float x) { return fminf(x, 0.f) - log1pf(__expf(-fabsf(x))); }
__device__ __forceinline__ void phase_gla_prep(KA a, int li, LAS unsigned char* lds, int tid, int bx, int G) {
    const int lane = tid & 63, wave = __builtin_amdgcn_readfirstlane(tid >> 6), fr = lane & 15, fq = lane >> 4;
    unsigned char* ws = a->ws;
    const bf16* qkvr = (const bf16*)(ws + WS_BIG); const float* lr = (const float*)(ws + WS_LR);
    bf16* QE = (bf16*)(ws + WS_QE); bf16* KET = (bf16*)(ws + WS_KET); bf16* PP = (bf16*)(ws + WS_P); bf16* VT = (bf16*)(ws + WS_VT); float* EL = (float*)(ws + WS_EL);
    constexpr int LS = 136, VLS = 264;
    LAS bf16* qes = (LAS bf16*)lds;
    LAS bf16* kes = qes + 64 * LS;
    LAS float* lrs = (LAS float*)(kes + 64 * LS);
    LAS float* segtot = lrs + 1024;
    LAS bf16* vraw = (LAS bf16*)(segtot + 512);
    const int d = tid & 127, seg = tid >> 7;
    const int so = tid & 15, sr = tid >> 4;
    for (int it = bx; it < 4096; it += G) {
        const int chunk = it & 63, dir = (it >> 6) & 1, h = (it >> 7) & 3, b = it >> 9;
        const int row0 = b * SEQ + chunk * 64;
        const size_t cidx = (size_t)(((dir * 8 + b) * 4 + h) * 64 + chunk);
        const float* wg2 = a->in[dir ? I_GWG2B : I_GWG2F] + (size_t)li * 16 * 512 + h * 128 + d; const float bgd = a->in[dir ? I_GBGB : I_GBGF][(size_t)li * 512 + h * 128 + d];
#pragma unroll
        for (int k2 = 0; k2 < 2; ++k2) { const int p = sr + 32 * k2; const bf16* src = qkvr + (size_t)(row0 + p) * GLA_MAIN + h * 128 + 8 * so;
            const u32x4 qv = *(const u32x4*)src, kv = *(const u32x4*)(src + 512);
            *(LAS u32x4*)(qes + p * LS + 8 * so) = qv; *(LAS u32x4*)(kes + p * LS + 8 * so) = kv; }
        if (dir == 0) {
#pragma unroll
            for (int k4 = 0; k4 < 4; ++k4) { const int idx = tid + 512 * k4, p = idx >> 5, oc = idx & 31;
                *(LAS u32x4*)(vraw + p * VLS + 8 * oc) = *(const u32x4*)(qkvr + (size_t)(row0 + p) * GLA_MAIN + 1024 + h * 256 + 8 * oc); }
        }
        for (int i = tid; i < 1024; i += NTHREADS) lrs[i] = lr[(size_t)(row0 + (i >> 4)) * 32 + dir * 16 + (i & 15)];
        float wcol[16];
#pragma unroll
        for (int r = 0; r < 16; ++r) wcol[r] = wg2[r * 512];
        __syncthreads();
        float g[16];
#pragma unroll
        for (int s2 = 0; s2 < 16; ++s2) { const LAS float* lp = lrs + (seg * 16 + s2) * 16; float x = bgd;
#pragma unroll
            for (int r4 = 0; r4 < 4; ++r4) { const f32x4 l4 = *(const LAS f32x4*)(lp + 4 * r4); x += l4[0] * wcol[4 * r4] + l4[1] * wcol[4 * r4 + 1] + l4[2] * wcol[4 * r4 + 2] + l4[3] * wcol[4 * r4 + 3]; }
            g[s2] = (fminf(x, 0.f) - __logf(1.0f + __expf(-fabsf(x)))) * (1.0f / 16.0f); }
        if (dir == 0) {
#pragma unroll
            for (int s2 = 1; s2 < 16; ++s2) g[s2] += g[s2 - 1];
        } else {
#pragma unroll
            for (int s2 = 14; s2 >= 0; --s2) g[s2] += g[s2 + 1];
        }
        segtot[seg * 128 + d] = dir ? g[0] : g[15];
        __syncthreads();
        float pre = 0.f, total = 0.f;
#pragma unroll
        for (int sg = 0; sg < 4; ++sg) { const float t = segtot[sg * 128 + d]; total += t; if (dir ? (sg > seg) : (sg < seg)) pre += t; }
        if (seg == 0) EL[cidx * 128 + d] = __expf(total);
        unsigned kt[8];
#pragma unroll
        for (int s2 = 0; s2 < 16; s2 += 2) {
            unsigned kw[2];
#pragma unroll
            for (int u = 0; u < 2; ++u) { const int p = seg * 16 + s2 + u;
                const float q = bf2f(qes[p * LS + d]), k = bf2f(kes[p * LS + d]); const float bb = g[s2 + u] + pre;
                const float eb_ = __expf(bb); const unsigned qw = cvt_pk_bf16(q * eb_, 0.f) & 0xffffu; kw[u] = cvt_pk_bf16(k * __builtin_amdgcn_rcpf(eb_), 0.f) & 0xffffu;
                qes[p * LS + d] = (bf16)qw; kes[p * LS + d] = (bf16)kw[u]; }
            kt[s2 >> 1] = kw[0] | (kw[1] << 16);
        }
        { bf16* kp = KET + cidx * 8192 + (size_t)d * 64 + seg * 16; *(u32x4*)kp = (u32x4){kt[0], kt[1], kt[2], kt[3]}; *(u32x4*)(kp + 8) = (u32x4){kt[4], kt[5], kt[6], kt[7]}; }
        __syncthreads();
#pragma unroll
        for (int k2 = 0; k2 < 2; ++k2) { const int p = sr + 32 * k2; *(u32x4*)(QE + ((size_t)dir * T + row0 + p) * 512 + h * 128 + 8 * so) = *(const LAS u32x4*)(qes + p * LS + 8 * so); }
        { const int jt = wave & 3;
#pragma unroll
          for (int ii = 0; ii < 2; ++ii) { const int itile = 2 * (wave >> 2) + ii;
            f32x4 acc = (f32x4){0.f, 0.f, 0.f, 0.f};
            const bool dead = dir ? (jt < itile) : (jt > itile);
            if (!dead) {
#pragma unroll
                for (int ks = 0; ks < 4; ++ks) { const bf16x8 kf = *(const LAS bf16x8*)(kes + (jt * 16 + fr) * LS + ks * 32 + 8 * fq), qf = *(const LAS bf16x8*)(qes + (itile * 16 + fr) * LS + ks * 32 + 8 * fq);
                    acc = __builtin_amdgcn_mfma_f32_16x16x32_bf16(kf, qf, acc, 0, 0, 0); }
            }
            const int i = itile * 16 + fr, j0 = jt * 16 + 4 * fq; float pv[4];
#pragma unroll
            for (int jj = 0; jj < 4; ++jj) { const int j = j0 + jj; const bool keep = dir ? (j >= i) : (j <= i); pv[jj] = keep ? acc[jj] : 0.f; }
            u32x2 o; o.x = cvt_pk_bf16(pv[0], pv[1]); o.y = cvt_pk_bf16(pv[2], pv[3]);
            *(u32x2*)(PP + cidx * 4096 + (size_t)i * 64 + j0) = o; } }
        if (dir == 0) {
            const int e = tid & 255, jh = tid >> 8; unsigned w[16];
#pragma unroll
            for (int jj = 0; jj < 32; jj += 2) w[jj >> 1] = (unsigned)vraw[(jh * 32 + jj) * VLS + e] | ((unsigned)vraw[(jh * 32 + jj + 1) * VLS + e] << 16);
            bf16* vp = VT + ((size_t)((b * 4 + h) * 64 + chunk) * 256 + e) * 64 + jh * 32;
#pragma unroll
            for (int q4 = 0; q4 < 4; ++q4) *(u32x4*)(vp + 8 * q4) = (u32x4){w[4 * q4], w[4 * q4 + 1], w[4 * q4 + 2], w[4 * q4 + 3]};
        }
        __syncthreads();
    }
}
__device__ __forceinline__ void phase_gla_scan(KA a, LAS unsigned char* lds, int tid, int bx, int G) {
    const int lane = tid & 63, wave = __builtin_amdgcn_readfirstlane(tid >> 6), fr = lane & 15, fq = lane >> 4;
    unsigned char* ws = a->ws;
    const char* QE = (const char*)(ws + WS_QE); const char* KET = (const char*)(ws + WS_KET); const char* PP = (const char*)(ws + WS_P); const char* VT = (const char*)(ws + WS_VT); const float* EL = (const float*)(ws + WS_EL);
    constexpr int SS = 136, ST_BYTES = 2 * 64 * SS * 2, BUFB = 50176, OQ = 0, OP = 16384, OK_ = 24576, OV = 40960, OE = 49152;
    LAS bf16* ST = (LAS bf16*)lds;
    LAS unsigned char* BUF = lds + ST_BYTES;
    const int et0 = 2 * (wave & 1), dt0 = 2 * (wave >> 1), itile = wave >> 1;
    const int rq = lane >> 4, pq = lane & 15, r8 = lane >> 3, p8 = lane & 7;
    unsigned sq[2], sk[2], sp, sv;
#pragma unroll
    for (int j = 0; j < 2; ++j) { const int r = 4 * (wave + 8 * j) + rq; sq[j] = (unsigned)(r * 1024 + ((pq ^ (r & 15)) * 16)); const int dk = 8 * (wave + 8 * j) + r8; sk[j] = (unsigned)(dk * 128 + ((p8 ^ ((dk >> 1) & 7)) * 16)); }
    { const int r = 8 * wave + r8; sp = (unsigned)(r * 128 + ((p8 ^ ((r >> 1) & 7)) * 16)); sv = sp; }
    const int kx = fr >> 1;
    for (int it0 = bx; it0 < 256; it0 += G) {
        const int it = (G == 256) ? ((it0 & 7) * 32 + (it0 >> 3)) : it0;
        const int b = it >> 5, h = (it >> 3) & 3, dir = (it >> 2) & 1, es = it & 3;
        bf16* OO = (bf16*)(ws + (dir ? WS_OB : WS_OF));
        __syncthreads();
        for (int i = tid; i < 64 * SS / 2; i += NTHREADS) ((LAS unsigned*)ST)[i] = 0u;
        f32x4 accS[2][2];
#pragma unroll
        for (int x = 0; x < 2; ++x)
#pragma unroll
            for (int y = 0; y < 2; ++y) accS[x][y] = (f32x4){0.f, 0.f, 0.f, 0.f};
        const size_t cbase = (size_t)((dir * 8 + b) * 4 + h) * 64;
        const char* qsrc = QE + (((size_t)dir * T + (size_t)b * SEQ) * 512 + h * 128) * 2;
        const char* psrc = PP + cbase * 8192;
        const char* ksrc = KET + cbase * 16384;
        const char* vsrc = VT + ((size_t)(b * 4 + h) * 64 * 256 + es * 64) * 128;
        const char* esrc = (const char*)(EL + cbase * 128);
        char* ob = (char*)(OO + ((size_t)b * SEQ + itile * 16) * D + h * 256 + es * 64 + et0 * 16);
        const unsigned le = (unsigned)fq * 16u, lo = (unsigned)(fr * D + 4 * fq) * 2u;
#define SC_DMA(c_, bi_) do { const size_t c__ = (size_t)(c_); LAS unsigned char* bb_ = BUF + (bi_) * BUFB + wave * 1024; \
            __builtin_amdgcn_global_load_lds((const unsigned*)(qsrc + c__ * 65536 + sq[0]), (LAS unsigned*)(bb_ + OQ), 16, 0, 0); \
            __builtin_amdgcn_global_load_lds((const unsigned*)(qsrc + c__ * 65536 + sq[1]), (LAS unsigned*)(bb_ + OQ + 8192), 16, 0, 0); \
            __builtin_amdgcn_global_load_lds((const unsigned*)(psrc + c__ * 8192 + sp), (LAS unsigned*)(bb_ + OP), 16, 0, 0); \
            __builtin_amdgcn_global_load_lds((const unsigned*)(ksrc + c__ * 16384 + sk[0]), (LAS unsigned*)(bb_ + OK_), 16, 0, 0); \
            __builtin_amdgcn_global_load_lds((const unsigned*)(ksrc + c__ * 16384 + sk[1]), (LAS unsigned*)(bb_ + OK_ + 8192), 16, 0, 0); \
            __builtin_amdgcn_global_load_lds((const unsigned*)(vsrc + c__ * 32768 + sv), (LAS unsigned*)(bb_ + OV), 16, 0, 0); \
            if (wave == 0) __builtin_amdgcn_global_load_lds((const unsigned*)(esrc + c__ * 512 + lane * 16), (LAS unsigned*)(BUF + (bi_) * BUFB + OE), 16, 0, 0); } while (0)
        SC_DMA(dir ? 63 : 0, 0);
        asm volatile("s_waitcnt vmcnt(0)" ::: "memory");
        __syncthreads();
#pragma unroll 1
        for (int cc = 0; cc < 64; ++cc) {
            const int c = dir ? 63 - cc : cc;
            if (cc + 1 < 64) SC_DMA(dir ? 62 - cc : cc + 1, (cc + 1) & 1);
            const LAS unsigned char* B = BUF + (cc & 1) * BUFB;
            const f32x4 el0 = *(const LAS f32x4*)(B + OE + dt0 * 64 + le), el1 = *(const LAS f32x4*)(B + OE + dt0 * 64 + 64 + le);
            const LAS bf16* Sr = ST + (cc & 1) * 64 * SS; LAS bf16* Sw = ST + ((cc + 1) & 1) * 64 * SS;
            bf16x8 qf[4], pf[2], vf[2][2];
#pragma unroll
            for (int ks = 0; ks < 4; ++ks) qf[ks] = *(const LAS bf16x8*)(B + OQ + (itile * 16 + fr) * 256 + (((4 * ks + fq) ^ fr) * 16));
#pragma unroll
            for (int ks = 0; ks < 2; ++ks) pf[ks] = *(const LAS bf16x8*)(B + OP + (itile * 16 + fr) * 128 + (((4 * ks + fq) ^ kx) * 16));
#pragma unroll
            for (int et = 0; et < 2; ++et)
#pragma unroll
                for (int ks = 0; ks < 2; ++ks) vf[et][ks] = *(const LAS bf16x8*)(B + OV + ((et0 + et) * 16 + fr) * 128 + (((4 * ks + fq) ^ kx) * 16));
#pragma unroll
            for (int et = 0; et < 2; ++et) { f32x4 ao = (f32x4){0.f, 0.f, 0.f, 0.f};
#pragma unroll
                for (int ks = 0; ks < 4; ++ks) { const bf16x8 sf = *(const LAS bf16x8*)(Sr + ((et0 + et) * 16 + fr) * SS + ks * 32 + 8 * fq); ao = __builtin_amdgcn_mfma_f32_16x16x32_bf16(sf, qf[ks], ao, 0, 0, 0); }
#pragma unroll
                for (int ks = 0; ks < 2; ++ks) ao = __builtin_amdgcn_mfma_f32_16x16x32_bf16(vf[et][ks], pf[ks], ao, 0, 0, 0);
                u32x2 o; o.x = cvt_pk_bf16(ao[0], ao[1]); o.y = cvt_pk_bf16(ao[2], ao[3]);
                *(u32x2*)(ob + (size_t)c * (64 * D * 2) + et * 32 + lo) = o; }
#pragma unroll
            for (int dt = 0; dt < 2; ++dt) { bf16x8 kf[2];
#pragma unroll
                for (int ks = 0; ks < 2; ++ks) kf[ks] = *(const LAS bf16x8*)(B + OK_ + ((dt0 + dt) * 16 + fr) * 128 + (((4 * ks + fq) ^ kx) * 16));
#pragma unroll
                for (int et = 0; et < 2; ++et) {
#pragma unroll
                    for (int ks = 0; ks < 2; ++ks) accS[dt][et] = __builtin_amdgcn_mfma_f32_16x16x32_bf16(kf[ks], vf[et][ks], accS[dt][et], 0, 0, 0);
                    accS[dt][et] = accS[dt][et] * (dt ? el1 : el0);
                    u32x2 o; o.x = cvt_pk_bf16(accS[dt][et][0], accS[dt][et][1]); o.y = cvt_pk_bf16(accS[dt][et][2], accS[dt][et][3]);
                    *(LAS u32x2*)(Sw + ((et0 + et) * 16 + fr) * SS + (dt0 + dt) * 16 + 4 * fq) = o; } }
            asm volatile("s_waitcnt vmcnt(0)" ::: "memory");
            __syncthreads();
        }
#undef SC_DMA
    }
}

__device__ __forceinline__ void phase_gla_post(KA a, int li, int tid, int bx, int G) {
    const int lane = tid & 63, wave = tid >> 6;
    const bf16* of = (const bf16*)(a->ws + WS_OF); const bf16* ob = (const bf16*)(a->ws + WS_OB); const bf16* qkvr = (const bf16*)(a->ws + WS_BIG); bf16* A2 = (bf16*)(a->ws + WS_A2);
    const float* ng = a->in[I_GNORM] + (size_t)li * 256 + (lane & 15) * 16;
    float g[16];
#pragma unroll
    for (int j = 0; j < 16; ++j) g[j] = ng[j];
    for (int token = bx * NWAVES + wave; token < T; token += G * NWAVES) {
        const u32x4 f0 = *(const u32x4*)(of + (size_t)token * D + 16 * lane), f1 = *(const u32x4*)(of + (size_t)token * D + 16 * lane + 8);
        const u32x4 b0 = *(const u32x4*)(ob + (size_t)token * D + 16 * lane), b1 = *(const u32x4*)(ob + (size_t)token * D + 16 * lane + 8);
        const u32x4 r0 = *(const u32x4*)(qkvr + (size_t)token * GLA_MAIN + 2048 + 16 * lane), r1 = *(const u32x4*)(qkvr + (size_t)token * GLA_MAIN + 2048 + 16 * lane + 8);
        float o[16], r[16];
#pragma unroll
        for (int q = 0; q < 4; ++q) { o[2 * q] = bf_lo(f0[q]) + bf_lo(b0[q]); o[2 * q + 1] = bf_hi(f0[q]) + bf_hi(b0[q]); o[8 + 2 * q] = bf_lo(f1[q]) + bf_lo(b1[q]); o[8 + 2 * q + 1] = bf_hi(f1[q]) + bf_hi(b1[q]);
            r[2 * q] = bf_lo(r0[q]); r[2 * q + 1] = bf_hi(r0[q]); r[8 + 2 * q] = bf_lo(r1[q]); r[8 + 2 * q + 1] = bf_hi(r1[q]); }
        float ss = 0.f;
#pragma unroll
        for (int j = 0; j < 16; ++j) ss += o[j] * o[j];
        ss += shfl_xor_f(ss, 1, lane); ss += shfl_xor_f(ss, 2, lane); ss += shfl_xor_f(ss, 4, lane); ss += shfl_xor_f(ss, 8, lane);
        const float rstd = 1.0f / sqrtf(ss * (1.0f / 256.0f) + LN_EPS);
        unsigned w[8];
#pragma unroll
        for (int q = 0; q < 8; ++q) w[q] = cvt_pk_bf16(o[2 * q] * rstd * g[2 * q] * silu_f(r[2 * q]), o[2 * q + 1] * rstd * g[2 * q + 1] * silu_f(r[2 * q + 1]));
        *(u32x4*)(A2 + (size_t)token * D + 16 * lane) = (u32x4){w[0], w[1], w[2], w[3]}; *(u32x4*)(A2 + (size_t)token * D + 16 * lane + 8) = (u32x4){w[4], w[5], w[6], w[7]};
    }
}

__device__ __forceinline__ void phase_sgu_core(KA a, int li, LAS unsigned char* lds, int tid, int bx, int G) {
    const int lane = tid & 63, wave = __builtin_amdgcn_readfirstlane(tid >> 6), fr = lane & 15, fq = lane >> 4;
    unsigned char* ws = a->ws;
    const bf16* z = (const bf16*)(ws + WS_BIG); bf16* A2 = (bf16*)(ws + WS_A2);
    const float* lng = a->in[I_SLNG] + (size_t)li * 1024; const float* lnb = a->in[I_SLNB] + (size_t)li * 1024;
    const bf16* wsp = (const bf16*)(ws + WS_SGUWS) + (size_t)li * 8 * 128 * 128; const float* bs = a->in[I_SBS] + (size_t)li * 8 * 128;
    constexpr int VS = 132;
    LAS bf16* vn = (LAS bf16*)lds;
    LAS float* st_mean = (LAS float*)(lds + 2 * 128 * VS * 2); LAS float* st_rstd = st_mean + 128;
    const int co = tid & 15, qr = tid >> 4;
    for (int it = bx; it < T / 128; it += G) {
        const int row0 = it * 128;
        __syncthreads();
#pragma unroll 1
        for (int rr = 0; rr < 16; ++rr) { const int q = wave * 16 + rr; const bf16* vp = z + (size_t)(row0 + q) * 2048 + 1024 + 16 * lane;
            const u32x4 v0 = *(const u32x4*)vp, v1 = *(const u32x4*)(vp + 8); float x[16];
#pragma unroll
            for (int k = 0; k < 4; ++k) { x[2 * k] = bf_lo(v0[k]); x[2 * k + 1] = bf_hi(v0[k]); x[8 + 2 * k] = bf_lo(v1[k]); x[8 + 2 * k + 1] = bf_hi(v1[k]); }
            float s1 = 0.f;
#pragma unroll
            for (int k = 0; k < 16; ++k) s1 += x[k];
            const float mean = wave_sum(s1, lane) * (1.0f / 1024.0f); float s2 = 0.f;
#pragma unroll
            for (int k = 0; k < 16; ++k) { const float dd = x[k] - mean; s2 += dd * dd; }
            const float rstd = 1.0f / sqrtf(wave_sum(s2, lane) * (1.0f / 1024.0f) + LN_EPS);
            if (lane == 0) { st_mean[q] = mean; st_rstd[q] = rstd; } }
        __syncthreads();
        const int p = wave * 16 + fr;
#pragma unroll 1
        for (int g = 0; g < 8; ++g) {
            LAS bf16* vb = vn + (g & 1) * 128 * VS;
            {
                const f32x4 g0 = *(const f32x4*)(lng + g * 128 + 8 * co), g1 = *(const f32x4*)(lng + g * 128 + 8 * co + 4), b0 = *(const f32x4*)(lnb + g * 128 + 8 * co), b1 = *(const f32x4*)(lnb + g * 128 + 8 * co + 4);
#pragma unroll
                for (int k = 0; k < 4; ++k) { const int q = qr + 32 * k; const u32x4 w = *(const u32x4*)(z + (size_t)(row0 + q) * 2048 + 1024 + g * 128 + 8 * co);
                    const float m = st_mean[q], r = st_rstd[q];
                    u32x2 o0, o1;
                    o0.x = cvt_pk_bf16((bf_lo(w.x) - m) * r * g0[0] + b0[0], (bf_hi(w.x) - m) * r * g0[1] + b0[1]); o0.y = cvt_pk_bf16((bf_lo(w.y) - m) * r * g0[2] + b0[2], (bf_hi(w.y) - m) * r * g0[3] + b0[3]);
                    o1.x = cvt_pk_bf16((bf_lo(w.z) - m) * r * g1[0] + b1[0], (bf_hi(w.z) - m) * r * g1[1] + b1[1]); o1.y = cvt_pk_bf16((bf_lo(w.w) - m) * r * g1[2] + b1[2], (bf_hi(w.w) - m) * r * g1[3] + b1[3]);
                    *(LAS u32x2*)(vb + q * VS + 8 * co) = o0; *(LAS u32x2*)(vb + q * VS + 8 * co + 4) = o1; }
            }
            bf16x8 wf[4];
#pragma unroll
            for (int ks = 0; ks < 4; ++ks) wf[ks] = *(const bf16x8*)(wsp + ((size_t)g * 128 + p) * 128 + ks * 32 + 8 * fq);
            const float bias = bs[g * 128 + p];
            __syncthreads();
#pragma unroll 2
            for (int ct = 0; ct < 8; ++ct) {
                f32x4 acc = (f32x4){0.f, 0.f, 0.f, 0.f};
#pragma unroll
                for (int ks = 0; ks < 4; ++ks) { const LAS bf16* sp = vb + (ks * 32 + 8 * fq) * VS + ct * 16 + fr; unsigned w4[4];
#pragma unroll
                    for (int j2 = 0; j2 < 4; ++j2) w4[j2] = (unsigned)sp[(2 * j2) * VS] | ((unsigned)sp[(2 * j2 + 1) * VS] << 16);
                    const bf16x8 vf = __builtin_bit_cast(bf16x8, (u32x4){w4[0], w4[1], w4[2], w4[3]});
                    acc = __builtin_amdgcn_mfma_f32_16x16x32_bf16(vf, wf[ks], acc, 0, 0, 0); }
                const int c0 = g * 128 + ct * 16 + 4 * fq;
                const u32x2 uu = *(const u32x2*)(z + (size_t)(row0 + p) * 2048 + c0);
                u32x2 o; o.x = cvt_pk_bf16(bf_lo(uu.x) * (acc[0] + bias), bf_hi(uu.x) * (acc[1] + bias)); o.y = cvt_pk_bf16(bf_lo(uu.y) * (acc[2] + bias), bf_hi(uu.y) * (acc[3] + bias));
                *(u32x2*)(A2 + (size_t)(row0 + p) * D + c0) = o;
            }
        }
    }
}

constexpr int PH_PER_LAYER = 10;
constexpr int NPHASES = 2 + PH_PER_LAYER * DEPTH;
#define GEMM_BODY(A, g, K, S, E) gemm_fast<false, false>(A, g, K, S, E, lds, tid)
#define GEMM_BODY_G(A, g, K, S, E) gemm_fast<true, false>(A, g, K, S, E, lds, tid)
#define GEMM_BODY8(A, g, K, S, E) gemm_fast<false, true>(A, g, K, S, E, lds, tid)
#define GEMM_BODY8_G(A, g, K, S, E) gemm_fast<true, true>(A, g, K, S, E, lds, tid)
__device__ __forceinline__ void ph_prologue(int wave_s) { PHASE_ENTER(); phase_prologue(a, lds, tid, bx, G); }
__device__ __forceinline__ void ph_rp_init(int wave_s) { PHASE_ENTER(); float* mod = (float*)(ws + WS_MOD);
    RowPass p{}; p.xin = a->in[I_X]; p.hout = (bf16*)(ws + WS_H); p.sc = mod + 1 * 1024; p.sh = mod + 0 * 1024; p.wside = (const bf16*)(ws + WS_GLALR_T); p.lr_out = (float*)(ws + WS_LR); p.has_h = 1; p.has_side = 1;
    row_pass<0>(p, lds, tid, bx, G); }
__device__ __forceinline__ void ph_gla_in(int wave_s, int li) { PHASE_ENTER(); Sched S; S.init(T / 256, GLA_MAIN / 256, G, bx, (const bf16*)(ws + WS_GLAIN_T) + (size_t)li * GLA_MAIN * 1024, 0, nullptr, 2048); EpiGlaIn E{(bf16*)(ws + WS_BIG)}; GEMM_BODY((const bf16*)(ws + WS_H), nullptr, 1024, S, E); }
__device__ __forceinline__ void ph_sgu_in(int wave_s, int li) { PHASE_ENTER(); Sched S; S.init(T / 256, 2048 / 256, G, bx, (const bf16*)(ws + WS_SGUIN_T) + (size_t)li * 2048 * 1024, 0, nullptr, 2048); EpiSguIn E{(bf16*)(ws + WS_BIG), a->in[I_SBIN] + (size_t)li * 2048}; GEMM_BODY((const bf16*)(ws + WS_H), nullptr, 1024, S, E); }
__device__ __forceinline__ void ph_gla_prep(int wave_s, int li) { PHASE_ENTER(); phase_gla_prep(a, li, lds, tid, bx, G); }
__device__ __forceinline__ void ph_gla_scan(int wave_s) { PHASE_ENTER(); phase_gla_scan(a, lds, tid, bx, G); }
__device__ __forceinline__ void ph_sgu_core(int wave_s, int li) { PHASE_ENTER(); phase_sgu_core(a, li, lds, tid, bx, G); }
__device__ __forceinline__ void ph_gla_post(int wave_s, int li) { PHASE_ENTER(); phase_gla_post(a, li, tid, bx, G); }
__device__ __forceinline__ void ph_out(int wave_s, int l) { PHASE_ENTER(); const int li = l >> 1; const bool sgu = (l & 1) != 0;
    Sched S; S.init(T / 256, 4, G, bx, (const bf16*)(ws + (sgu ? WS_SGUOUT_T : WS_GLAOUT_T)) + (size_t)li * 1024 * 1024, 0, nullptr, 2048);
    EpiOut E{(bf16*)(ws + WS_Y), sgu ? a->in[I_SBOUT] + (size_t)li * 1024 : nullptr}; GEMM_BODY((const bf16*)(ws + WS_A2), nullptr, 1024, S, E); }
__device__ __forceinline__ void ph_rp_mid(int wave_s, int l) { PHASE_ENTER(); float* modl = (float*)(ws + WS_MOD) + (size_t)l * 8 * 6144; int* route = (int*)(ws + WS_ROUTE);
    RowPass p{}; p.xin = (l == 0) ? (const void*)a->in[I_X] : (const void*)(ws + WS_X2); p.xin16 = (l != 0); p.y = (const bf16*)(ws + WS_Y); p.xout = ws + WS_X1; p.xout16 = 1; p.hout = (bf16*)(ws + WS_H);
    p.gate = modl + 2 * 1024; p.lng = a->in[I_LNG] + (size_t)(l * 2 + 0) * 1024; p.lnb = a->in[I_LNB] + (size_t)(l * 2 + 0) * 1024; p.sc = modl + 4 * 1024; p.sh = modl + 3 * 1024;
    p.wside = (const bf16*)(ws + WS_ROUTER_T) + (size_t)l * 64 * 1024; p.rbias = a->in[I_RB] + (size_t)l * 32;
    p.topi = route + R_TOPI; p.topw = (float*)(route + R_TOPW); p.hist = route + R_HIST + bx * 32; p.has_h = 1; p.has_side = 1; p.h8out = MOE_FP8 ? (ws + WS_H8) : nullptr;
    row_pass<1>(p, lds, tid, bx, G); }
__device__ __forceinline__ void ph_place(int wave_s) { PHASE_ENTER(); phase_place((int*)(ws + WS_ROUTE), lds, tid, bx, G); }
__device__ __forceinline__ void ph_moe_up(int wave_s, int l) { PHASE_ENTER(); int* route = (int*)(ws + WS_ROUTE); const int ntiles = __builtin_amdgcn_readfirstlane(route[R_NTILES]);
#if MOE_FP8
    Sched S; S.init(ntiles, 8, G, bx, ws + WS_WUP_T + (size_t)l * 32 * 2048 * 1024, (size_t)2048 * 1024, route + R_TILEE, 1024);
    EpiUp<true> E{ws + WS_ACT, a->in[I_BUP] + (size_t)l * 32 * 2048}; GEMM_BODY8_G(ws + WS_H8, route + R_BUFTOK, 1024, S, E); }
#else
    Sched S; S.init(ntiles, 8, G, bx, ws + WS_WUP_T + (size_t)l * 32 * 2048 * 2048, (size_t)2048 * 2048, route + R_TILEE, 2048);
    EpiUp<false> E{ws + WS_ACT, a->in[I_BUP] + (size_t)l * 32 * 2048}; GEMM_BODY_G(ws + WS_H, route + R_BUFTOK, 1024, S, E); }
#endif
__device__ __forceinline__ void ph_moe_down(int wave_s, int l) { PHASE_ENTER(); int* route = (int*)(ws + WS_ROUTE); const int ntiles = __builtin_amdgcn_readfirstlane(route[R_NTILES]);
#if MOE_FP8
    Sched S; S.init(ntiles, 4, G, bx, ws + WS_WDN_T + (size_t)l * 32 * 1024 * 1024, (size_t)1024 * 1024, route + R_TILEE, 1024);
    EpiDown8 E{ws + WS_YS, a->in[I_BDN] + (size_t)l * 32 * 1024, 1.0f / (F8_WSCALE * F8_ASCALE)}; GEMM_BODY8(ws + WS_ACT, nullptr, 1024, S, E); }
#else
    Sched S; S.init(ntiles, 4, G, bx, ws + WS_WDN_T + (size_t)l * 32 * 1024 * 2048, (size_t)1024 * 2048, route + R_TILEE, 2048);
    EpiDown E{(bf16*)(ws + WS_YS), a->in[I_BDN] + (size_t)l * 32 * 1024, 1.0f}; GEMM_BODY(ws + WS_ACT, nullptr, 1024, S, E); }
#endif
__device__ __forceinline__ void ph_rp_end(int wave_s, int l) { PHASE_ENTER(); float* mod = (float*)(ws + WS_MOD); float* modl = mod + (size_t)l * 8 * 6144; int* route = (int*)(ws + WS_ROUTE);
    RowPass p{}; p.xin = ws + WS_X1; p.xin16 = 1; p.xout = (l == DEPTH - 1) ? (void*)a->out : (void*)(ws + WS_X2); p.xout16 = (l != DEPTH - 1); p.hout = (bf16*)(ws + WS_H);
    p.gate = modl + 5 * 1024; p.lng = a->in[I_LNG] + (size_t)(l * 2 + 1) * 1024; p.lnb = a->in[I_LNB] + (size_t)(l * 2 + 1) * 1024;
    p.ys = ws + WS_YS; p.dest = route + R_DEST; p.tw = (const float*)(route + R_TOPW);
    if (l < DEPTH - 1) { float* modn = mod + (size_t)(l + 1) * 8 * 6144; p.sc = modn + 1 * 1024; p.sh = modn + 0 * 1024; p.has_h = 1;
        if (((l + 1) & 1) == 0) { p.has_side = 1; p.wside = (const bf16*)(ws + WS_GLALR_T) + (size_t)((l + 1) >> 1) * 64 * 1024; p.lr_out = (float*)(ws + WS_LR); } }
    row_pass<2>(p, lds, tid, bx, G); }

__global__ void __launch_bounds__(NTHREADS, 2) fwd_kernel(Args a) {
    extern __shared__ __attribute__((aligned(16))) unsigned char lds_raw[];
    LAS unsigned char* lds = (LAS unsigned char*)lds_raw;
    volatile LAS unsigned* MISC = (volatile LAS unsigned*)(lds + MISC_OFF);
    const int tid = threadIdx.x; const int wave_s = __builtin_amdgcn_readfirstlane(tid >> 6);
    if (tid < 32) ((LAS unsigned*)(lds + MISC_OFF))[tid] = 0u;
    __syncthreads();
    unsigned* ctl = (unsigned*)(a.ws + WS_CTL);
    XcdBarrier bar = xcd_barrier_post(ctl + CW_BAR + a.li * XCD_BAR_WORDS, MISC + 8);
    const int lo = a.ph_lo, hi = a.ph_hi;
#ifndef REPK
#define REPK 0
#define REPN 1
#endif
#define REP(kind) for (int rep_ = 0; rep_ < ((REPK == (kind)) ? REPN : 1); ++rep_)
#define IN(k) (lo <= (k) && (k) < hi)
#define SEAM(k) do { if (IN(k) && IN((k) + 1)) xcd_barrier(bar); } while (0)
    if (IN(0)) { REP(3) ph_prologue(wave_s); SEAM(0); }
    if (IN(1)) { ph_rp_init(wave_s); SEAM(1); }
    for (int l = 0; l < DEPTH; ++l) {
        const int pb = 2 + PH_PER_LAYER * l, li = l >> 1; const bool sgu = (l & 1) != 0;
        if (IN(pb + 0)) { REP(10) { if (!sgu) ph_gla_in(wave_s, li); else ph_sgu_in(wave_s, li); } SEAM(pb + 0); }
        if (IN(pb + 1)) { if (!sgu) { REP(12) ph_gla_prep(wave_s, li); SEAM(pb + 1); } }
        if (IN(pb + 2)) { if (!sgu) { REP(1) ph_gla_scan(wave_s); } else { REP(2) ph_sgu_core(wave_s, li); } SEAM(pb + 2); }
        if (IN(pb + 3)) { if (!sgu) { REP(6) ph_gla_post(wave_s, li); SEAM(pb + 3); } }
        if (IN(pb + 4)) { REP(11) ph_out(wave_s, l); SEAM(pb + 4); }
        if (IN(pb + 5)) { REP(4) ph_rp_mid(wave_s, l); SEAM(pb + 5); }
        if (IN(pb + 6)) { REP(7) ph_place(wave_s); SEAM(pb + 6); }
        if (IN(pb + 7)) { REP(8) ph_moe_up(wave_s, l); SEAM(pb + 7); }
        if (IN(pb + 8)) { REP(9) ph_moe_down(wave_s, l); SEAM(pb + 8); }
        if (IN(pb + 9)) { REP(5) ph_rp_end(wave_s, l); SEAM(pb + 9); }
    }
#undef IN
#undef SEAM
}

#ifndef N_LAUNCH_MODE
#define N_LAUNCH_MODE 1
#endif
extern "C" void kernel_launch(void* const* d_in, const int* in_sizes, int n_in, void* d_out, int out_size, void* d_ws, size_t ws_size, hipStream_t stream) {
    static int grid = 0;
    if (grid == 0) {
        if (n_in != 27 || out_size != T * D || ws_size < WS_END) { fprintf(stderr, "kernel_launch: unexpected shapes (n_in %d out %d ws %zu)\n", n_in, out_size, ws_size); grid = -1; return; }
        int dev = 0, cus = 0, per_cu = 0;
        if (hipGetDevice(&dev) != hipSuccess || hipDeviceGetAttribute(&cus, hipDeviceAttributeMultiprocessorCount, dev) != hipSuccess) { grid = -1; return; }
        if (hipFuncSetAttribute((const void*)fwd_kernel, hipFuncAttributeMaxDynamicSharedMemorySize, LDS_BYTES) != hipSuccess) { fprintf(stderr, "kernel_launch: hipFuncSetAttribute failed\n"); grid = -1; return; }
        if (hipOccupancyMaxActiveBlocksPerMultiprocessor(&per_cu, (const void*)fwd_kernel, NTHREADS, LDS_BYTES) != hipSuccess || per_cu < 1) fprintf(stderr, "kernel_launch: occupancy query reports %d\n", per_cu);
        (void)hipGetLastError();
        grid = cus;
        if (grid > 1024) grid = 1024;
    }
    if (grid < 0) return;
    (void)hipMemsetAsync((char*)d_ws + WS_CTL, 0, CTL_ZERO_BYTES, stream);
    Args a{};
    for (int i = 0; i < 27; ++i) a.in[i] = (const float*)d_in[i];
    a.out = (float*)d_out; a.ws = (unsigned char*)d_ws; a.pad = 0;
#if N_LAUNCH_MODE == 1
    a.ph_lo = 0; a.ph_hi = NPHASES; a.li = 0;
    hipLaunchKernelGGL(fwd_kernel, dim3(grid), dim3(NTHREADS), LDS_BYTES, stream, a);
#else
    for (int ph = 0, li = 0; ph < NPHASES; ++ph) {
        if (ph >= 2 && (((ph - 2) % PH_PER_LAYER) == 1 || ((ph - 2) % PH_PER_LAYER) == 3) && (((ph - 2) / PH_PER_LAYER) & 1)) continue;
        a.ph_lo = ph; a.ph_hi = ph + 1; a.li = li++;
        hipLaunchKernelGGL(fwd_kernel, dim3(grid), dim3(NTHREADS), LDS_BYTES, stream, a);
    }
#endif
}
```

```cpp
#include <hip/hip_runtime.h>
#include <cstdio>
#include <cstdint>

#define LAS __attribute__((address_space(3)))
#define GAS __attribute__((address_space(1)))
typedef unsigned short bf16;
typedef short bf16x8 __attribute__((ext_vector_type(8)));
typedef float f32x4 __attribute__((ext_vector_type(4)));
typedef float f32x2 __attribute__((ext_vector_type(2)));
typedef unsigned u32x4 __attribute__((ext_vector_type(4)));
typedef unsigned u32x2 __attribute__((ext_vector_type(2)));
typedef int i32x4 __attribute__((ext_vector_type(4)));
typedef int i32x8 __attribute__((ext_vector_type(8)));

#ifndef MOE_FP8
#define MOE_FP8 1
#endif
constexpr int D = 1024, NB = 8, SEQ = 4096, T = NB * SEQ, DEPTH = 4;
constexpr int NE = 32, TOPK = 4, CAP = T * TOPK + NE * 256;
constexpr int MAXTILES = CAP / 256;
constexpr float ALPHA = 1.681792830507429f;
constexpr float LN_EPS = 1e-5f;
constexpr float F8_WSCALE = 64.0f, F8_HSCALE = 8.0f, F8_ASCALE = 4.0f, F8_YSCALE = 64.0f;
constexpr int GLA_IN = 3104, GLA_MAIN = 3072;
constexpr int NWAVES = 8, NTHREADS = 512;
constexpr int LDS_BYTES = 147456, MISC_OFF = 139264;

constexpr size_t MiB = 1u << 20;
constexpr size_t WS_CTL = 0, CTL_ZERO_BYTES = 2 * MiB;
constexpr size_t WS_MOD = 2 * MiB;
constexpr size_t WS_ROUTE = 4 * MiB;
constexpr size_t WS_LR = 8 * MiB;
constexpr size_t WS_GLAIN_T = 16 * MiB;
constexpr size_t WS_GLALR_T = 28 * MiB;
constexpr size_t WS_ROUTER_T = 29 * MiB;
constexpr size_t WS_SGUWS = 30 * MiB;
constexpr size_t WS_GLAOUT_T = 32 * MiB;
constexpr size_t WS_SGUIN_T = 36 * MiB;
constexpr size_t WS_SGUOUT_T = 44 * MiB;
constexpr size_t WS_WUP_T = 64 * MiB;
constexpr size_t WS_WDN_T = 576 * MiB;
constexpr size_t WS_X1 = 832 * MiB;
constexpr size_t WS_X2 = 960 * MiB;
constexpr size_t WS_H = 1088 * MiB;
constexpr size_t WS_BIG = 1152 * MiB;
constexpr size_t WS_OF = 1344 * MiB;
constexpr size_t WS_OB = 1408 * MiB;
constexpr size_t WS_A2 = 1472 * MiB;
constexpr size_t WS_Y = 1536 * MiB;
constexpr size_t WS_ACT = 1664 * MiB;
constexpr size_t WS_YS = 1936 * MiB;
constexpr size_t WS_QE = 2208 * MiB;
constexpr size_t WS_KET = 2272 * MiB;
constexpr size_t WS_P = 2336 * MiB;
constexpr size_t WS_VT = 2368 * MiB;
constexpr size_t WS_EL = 2432 * MiB;
constexpr size_t WS_H8 = 2440 * MiB;
constexpr size_t WS_END = 2472 * MiB;
constexpr int R_TOPI = 0;
constexpr int R_TOPW = T * 4;
constexpr int R_DEST = 2 * T * 4;
constexpr int R_BUFTOK = 3 * T * 4;
constexpr int R_HIST = R_BUFTOK + CAP;
constexpr int R_TILEE = R_HIST + 1024 * 32;
constexpr int R_NTILES = R_TILEE + 1024;
static_assert((size_t)(R_NTILES + 64) * 4 <= 4 * MiB, "route tables");
constexpr int CW_BAR = 4096;
constexpr int MAX_LAUNCH = 64;

#define RLX_AGENT __ATOMIC_RELAXED, __HIP_MEMORY_SCOPE_AGENT
#define LDS_WAIT() asm volatile("s_waitcnt lgkmcnt(0)" ::: "memory")
#define VM_WAIT() asm volatile("s_waitcnt vmcnt(0)" ::: "memory")
typedef __bf16 bf16x2_t __attribute__((ext_vector_type(2)));
__device__ __forceinline__ unsigned cvt_pk_bf16(float lo, float hi) { const f32x2 v = {lo, hi}; const bf16x2_t r = __builtin_convertvector(v, bf16x2_t); return __builtin_bit_cast(unsigned, r); }
__device__ __forceinline__ float bf_lo(unsigned w) { return __uint_as_float(w << 16); }
__device__ __forceinline__ float bf_hi(unsigned w) { return __uint_as_float(w & 0xffff0000u); }
__device__ __forceinline__ float bf2f(bf16 b) { return __uint_as_float(((unsigned)b) << 16); }
__device__ __forceinline__ float shfl_xor_f(float v, int o, int lane) { return __builtin_bit_cast(float, __builtin_amdgcn_ds_bpermute((lane ^ o) << 2, __builtin_bit_cast(int, v))); }
__device__ __forceinline__ int shfl_i(int v, int src, int lane) { (void)lane; return __builtin_amdgcn_ds_bpermute(src << 2, v); }
__device__ __forceinline__ float wave_sum(float v, int lane) {
#pragma unroll
    for (int o = 1; o < 64; o <<= 1) v += shfl_xor_f(v, o, lane);
    return v;
}
__device__ __forceinline__ float silu_f(float x) { return x * __builtin_amdgcn_rcpf(1.0f + __expf(-x)); }
__device__ __forceinline__ float sigmoid_f(float x) { return __builtin_amdgcn_rcpf(1.0f + __expf(-x)); }
__device__ __forceinline__ float gelu_f(float v) {
    const float av = fabsf(v), t = __builtin_amdgcn_rcpf(av * 0.2316418882f + 1.0f);
    float q = t * 0.5307027145f + (-0.7265760135f); q = q * t + 0.7107068705f; q = q * t + (-0.142248368f); q = q * t + 0.127414796f; q = q * t;
    const float e = __builtin_amdgcn_exp2f((v * v) * (-0.72134752044f));
    const float m = v * (q * e);
    return v < 0.f ? m : v - m;
}

#define XB_TMO      128
#define XB_XCNT(j)  (256  + 64 * (j))
#define XB_XSUB(j)  (1280 + 64 * (j))
#define XB_XGEN(j)  (2304 + 64 * (j))
#define XB_TOP      3328
#define XB_TOPGEN   3392
#define XCD_BAR_WORDS 3456
#define XB_SPIN_CAP (1u << 18)
__device__ __forceinline__ unsigned xb_ld(unsigned* p)              { return __hip_atomic_load(p, __ATOMIC_RELAXED, __HIP_MEMORY_SCOPE_AGENT); }
__device__ __forceinline__ unsigned xb_add(unsigned* p, unsigned v) { return __hip_atomic_fetch_add(p, v, __ATOMIC_RELAXED, __HIP_MEMORY_SCOPE_AGENT); }
__device__ __forceinline__ unsigned xb_xcc_id() { return (unsigned)__builtin_amdgcn_s_getreg((3 << 11) | 20) & 0xFu; }
#define XB_SPIN(cond, bar) do { unsigned _sp = 0; while (cond) { __builtin_amdgcn_s_sleep(1); \
    if ((++_sp & 255u) == 0u) { if (xb_ld(&(bar)[XB_TMO])) break; if (_sp > XB_SPIN_CAP) { atomicAdd(&(bar)[XB_TMO], 1u); break; } } } } while (0)
struct XcdBarrier { unsigned* bar; unsigned x; volatile LAS unsigned* st; };
__device__ __forceinline__ XcdBarrier xcd_barrier_post(unsigned* bar, volatile LAS unsigned* st) {
    XcdBarrier b; b.bar = bar; b.x = xb_xcc_id(); b.st = st;
    if (threadIdx.x == 0) (void)xb_add(&bar[XB_XCNT(b.x)], 1u);
    return b;
}
__device__ __forceinline__ void xcd_barrier_complete(unsigned* bar, unsigned x, unsigned& nloc, unsigned& nx) {
    const unsigned G = gridDim.x * gridDim.y * gridDim.z;
    unsigned sum, cnt, mine, sp = 0u;
    for (;;) {
        sum = 0u; cnt = 0u; mine = 0u;
#pragma unroll
        for (unsigned j = 0; j < 16; ++j) { const unsigned c = xb_ld(&bar[XB_XCNT(j)]); sum += c; cnt += (c > 0u) ? 1u : 0u; mine = (j == x) ? c : mine; }
        if (sum == G) break;
        __builtin_amdgcn_s_sleep(1);
        if ((++sp & 255u) == 0u) { if (xb_ld(&bar[XB_TMO])) break; if (sp > XB_SPIN_CAP) { atomicAdd(&bar[XB_TMO], 1u); break; } }
    }
    nloc = mine > 0u ? mine : 1u; nx = cnt > 0u ? cnt : 1u;
}
__device__ __forceinline__ void xcd_barrier(const XcdBarrier& b) {
    asm volatile("s_waitcnt vmcnt(0)" ::: "memory");
    __syncthreads();
    if (threadIdx.x == 0) {
        unsigned* bar = b.bar;
        __builtin_amdgcn_s_waitcnt(0);
        unsigned nloc = b.st[0], nx = b.st[1];
        if (nloc == 0u) { xcd_barrier_complete(bar, b.x, nloc, nx); b.st[0] = nloc; b.st[1] = nx; }
        const unsigned old = xb_add(&bar[XB_XSUB(b.x)], 1u);
        const unsigned gen = old / nloc;
        if (old + 1u == (gen + 1u) * nloc) {
            __builtin_amdgcn_fence(__ATOMIC_RELEASE, "agent");
            asm volatile("s_waitcnt vmcnt(0)" ::: "memory");
            const unsigned og = xb_add(&bar[XB_TOP], 1u);
            const unsigned tg = og / nx;
            if (og + 1u == (tg + 1u) * nx) xb_add(&bar[XB_TOPGEN], 1u);
            else XB_SPIN(xb_ld(&bar[XB_TOPGEN]) == tg, bar);
            __builtin_amdgcn_fence(__ATOMIC_ACQUIRE, "agent");
            xb_add(&bar[XB_XGEN(b.x)], 1u);
            asm volatile("s_waitcnt vmcnt(0)" ::: "memory");
        } else {
            XB_SPIN(xb_ld(&bar[XB_XGEN(b.x)]) == gen, bar);
            __builtin_amdgcn_fence(__ATOMIC_ACQUIRE, "agent");
            asm volatile("s_waitcnt vmcnt(0)" ::: "memory");
        }
    }
    __syncthreads();
}

struct Args { const float* in[27]; float* out; unsigned char* ws; int ph_lo, ph_hi, li, pad; };
enum { I_X = 0, I_C, I_ADAW, I_ADAB, I_LNG, I_LNB, I_GWIN, I_GWG2F, I_GBGF, I_GWG2B, I_GBGB, I_GNORM, I_GWOUT, I_SWIN, I_SBIN, I_SLNG, I_SLNB, I_SWS, I_SBS, I_SWOUT, I_SBOUT, I_RW, I_RB, I_WUP, I_BUP, I_WDN, I_BDN };

typedef const __attribute__((address_space(4))) Args* KA;
#define PHASE_ENTER() unsigned m1_ = ~0u; asm volatile("" : "+s"(m1_)); int tid = (wave_s << 6) | (int)__builtin_amdgcn_mbcnt_hi(m1_, __builtin_amdgcn_mbcnt_lo(m1_, 0u)); asm volatile("" : "+v"(tid)); int bx = blockIdx.x, G = gridDim.x; asm volatile("" : "+s"(bx), "+s"(G)); \
    KA a = (KA)__builtin_amdgcn_kernarg_segment_ptr(); asm volatile("" : "+s"(a)); unsigned char* ws = a->ws; \
    extern __shared__ __attribute__((aligned(16))) unsigned char lds_raw[]; LAS unsigned char* lds = (LAS unsigned char*)lds_raw; (void)lds; (void)ws; (void)bx; (void)G; (void)tid
__device__ __forceinline__ int swiglu_perm(int o) {
    const int a = o >> 1, h = o & 1, pn = a >> 7, r = a & 127, bj = r >> 6, r2 = r & 63, wc = r2 >> 4, r3 = r2 & 15;
    return 256 * pn + 128 * bj + 32 * wc + 16 * h + r3;
}
__device__ __forceinline__ void conv_tile(const float* W, int K, int N, int k0, int n0, int nw, bf16* dst, int mode, LAS float* scr, int lane) {
    const int c4 = lane & 15, kr = lane >> 4;
    if (4 * c4 < nw) {
        f32x4 ld[16];
#pragma unroll
        for (int i = 0; i < 16; ++i) ld[i] = __builtin_nontemporal_load((const f32x4*)(W + (size_t)(k0 + 4 * i + kr) * N + n0 + 4 * c4));
#pragma unroll
        for (int i = 0; i < 16; ++i) { LAS float* s = scr + (4 * i + kr) * 65 + 4 * c4; s[0] = ld[i][0]; s[1] = ld[i][1]; s[2] = ld[i][2]; s[3] = ld[i][3]; }
    }
    LDS_WAIT(); asm volatile("" ::: "memory");
    const int kc = lane & 7, ns = lane >> 3;
    for (int j = 0; j < nw / 8; ++j) {
        const int n = ns + 8 * j; const LAS float* s = scr + (8 * kc) * 65 + n;
        float v[8];
#pragma unroll
        for (int q = 0; q < 8; ++q) v[q] = s[q * 65];
        u32x4 o; o.x = cvt_pk_bf16(v[0], v[1]); o.y = cvt_pk_bf16(v[2], v[3]); o.z = cvt_pk_bf16(v[4], v[5]); o.w = cvt_pk_bf16(v[6], v[7]);
        const int ng = n0 + n;
        if (mode >= 3 && mode <= 5) {
            const int row = (mode == 4) ? swiglu_perm(ng) : (mode == 5) ? ((ng & ~31) + 16 * ((ng >> 2) & 1) + 4 * ((ng >> 3) & 3) + (ng & 3)) : ng;
            int w0 = __builtin_amdgcn_cvt_pk_fp8_f32(v[0] * F8_WSCALE, v[1] * F8_WSCALE, 0, false); w0 = __builtin_amdgcn_cvt_pk_fp8_f32(v[2] * F8_WSCALE, v[3] * F8_WSCALE, w0, true);
            int w1 = __builtin_amdgcn_cvt_pk_fp8_f32(v[4] * F8_WSCALE, v[5] * F8_WSCALE, 0, false); w1 = __builtin_amdgcn_cvt_pk_fp8_f32(v[6] * F8_WSCALE, v[7] * F8_WSCALE, w1, true);
            *(u32x2*)((unsigned char*)dst + (size_t)row * K + k0 + 8 * kc) = (u32x2){(unsigned)w0, (unsigned)w1};
        } else if (mode == 2) {
            *(u32x4*)(dst + (size_t)n * K + k0 + 8 * kc) = o;
            u32x4 l; l.x = cvt_pk_bf16(v[0] - bf_lo(o.x), v[1] - bf_hi(o.x)); l.y = cvt_pk_bf16(v[2] - bf_lo(o.y), v[3] - bf_hi(o.y));
            l.z = cvt_pk_bf16(v[4] - bf_lo(o.z), v[5] - bf_hi(o.z)); l.w = cvt_pk_bf16(v[6] - bf_lo(o.w), v[7] - bf_hi(o.w));
            *(u32x4*)(dst + (size_t)(32 + n) * K + k0 + 8 * kc) = l;
        } else {
            const int row = (mode == 1) ? swiglu_perm(ng) : (mode == 6) ? ((ng & ~31) + 16 * ((ng >> 2) & 1) + 4 * ((ng >> 3) & 3) + (ng & 3)) : ng;
            *(u32x4*)(dst + (size_t)row * K + k0 + 8 * kc) = o;
        }
    }
    LDS_WAIT(); asm volatile("" ::: "memory");
}

__device__ __forceinline__ void phase_prologue(KA a, LAS unsigned char* lds, int tid, int bx, int G) {
    const int lane = tid & 63, wave = __builtin_amdgcn_readfirstlane(tid >> 6);
    unsigned char* ws = a->ws;
    for (int slab = bx; slab < 192; slab += G) {
        LAS float* sc = (LAS float*)lds;
        LAS float* red = (LAS float*)(lds + 32768);
        for (int i = tid; i < 8 * 1024; i += NTHREADS) sc[i] = silu_f(a->in[I_C][i]);
        __syncthreads();
        const int g0 = slab * 128, l = g0 / 6144, e0 = g0 % 6144;
        const int c4 = tid & 31, seg = tid >> 5;
        f32x4 acc[8];
#pragma unroll
        for (int b = 0; b < 8; ++b) acc[b] = (f32x4){0.f, 0.f, 0.f, 0.f};
        const float* wp = a->in[I_ADAW] + ((size_t)l * 1024 + seg * 64) * 6144 + e0 + 4 * c4;
#pragma unroll 8
        for (int d = 0; d < 64; ++d) { const f32x4 w = __builtin_nontemporal_load((const f32x4*)(wp + (size_t)d * 6144));
#pragma unroll
            for (int b = 0; b < 8; ++b) acc[b] += w * sc[b * 1024 + seg * 64 + d]; }
#pragma unroll
        for (int b = 0; b < 8; ++b) *(LAS f32x4*)(red + (seg * 8 + b) * 128 + 4 * c4) = acc[b];
        __syncthreads();
        for (int o = tid; o < 1024; o += NTHREADS) { const int b = o >> 7, c = o & 127; float s = a->in[I_ADAB][l * 6144 + e0 + c];
#pragma unroll
            for (int sg = 0; sg < 16; ++sg) s += red[(sg * 8 + b) * 128 + c];
            ((float*)(ws + WS_MOD))[((size_t)l * 8 + b) * 6144 + e0 + c] = s; }
        __syncthreads();
    }
    LAS float* scr = (LAS float*)(lds + wave * 16640);
    const int gw = bx * NWAVES + wave, NGW = G * NWAVES;
    constexpr int N_UP = 128 * 16 * 32, N_DN = 128 * 16 * 16, N_GIN = 2 * 16 * 48, N_GLR = 2 * 16, N_GOUT = 2 * 256, N_SIN = 2 * 16 * 32, N_SOUT = 2 * 256, N_RT = 4 * 16;
    constexpr int NITEMS = N_UP + N_DN + N_GIN + N_GLR + N_GOUT + N_SIN + N_SOUT + N_RT;
    for (int it = gw; it < NITEMS; it += NGW) {
        int r = it;
        if (r < N_UP) { const int m = r >> 9, q = r & 511, kt = q >> 5, nt = q & 31;
            conv_tile(a->in[I_WUP] + (size_t)m * 1024 * 2048, 1024, 2048, kt * 64, nt * 64, 64, (bf16*)(ws + WS_WUP_T + (size_t)m * 2048 * 1024 * (MOE_FP8 ? 1 : 2)), MOE_FP8 ? 4 : 1, scr, lane); continue; } r -= N_UP;
        if (r < N_DN) { const int m = r >> 8, q = r & 255, kt = q >> 4, nt = q & 15;
            conv_tile(a->in[I_WDN] + (size_t)m * 1024 * 1024, 1024, 1024, kt * 64, nt * 64, 64, (bf16*)(ws + WS_WDN_T + (size_t)m * 1024 * 1024 * (MOE_FP8 ? 1 : 2)), MOE_FP8 ? 5 : 0, scr, lane); continue; } r -= N_DN;
        if (r < N_GIN) { const int m = r / 768, q = r % 768, kt = q / 48, nt = q % 48;
            conv_tile(a->in[I_GWIN] + (size_t)m * 1024 * GLA_IN, 1024, GLA_IN, kt * 64, nt * 64, 64, (bf16*)(ws + WS_GLAIN_T) + (size_t)m * GLA_MAIN * 1024, 6, scr, lane); continue; } r -= N_GIN;
        if (r < N_GLR) { const int m = r >> 4, kt = r & 15;
            conv_tile(a->in[I_GWIN] + (size_t)m * 1024 * GLA_IN, 1024, GLA_IN, kt * 64, GLA_MAIN, 32, (bf16*)(ws + WS_GLALR_T) + (size_t)m * 64 * 1024, 2, scr, lane); continue; } r -= N_GLR;
        if (r < N_GOUT) { const int m = r >> 8, q = r & 255, kt = q >> 4, nt = q & 15;
            conv_tile(a->in[I_GWOUT] + (size_t)m * 1024 * 1024, 1024, 1024, kt * 64, nt * 64, 64, (bf16*)(ws + WS_GLAOUT_T) + (size_t)m * 1024 * 1024, 6, scr, lane); continue; } r -= N_GOUT;
        if (r < N_SIN) { const int m = r >> 9, q = r & 511, kt = q >> 5, nt = q & 31;
            conv_tile(a->in[I_SWIN] + (size_t)m * 1024 * 2048, 1024, 2048, kt * 64, nt * 64, 64, (bf16*)(ws + WS_SGUIN_T) + (size_t)m * 2048 * 1024, 6, scr, lane); continue; } r -= N_SIN;
        if (r < N_SOUT) { const int m = r >> 8, q = r & 255, kt = q >> 4, nt = q & 15;
            conv_tile(a->in[I_SWOUT] + (size_t)m * 1024 * 1024, 1024, 1024, kt * 64, nt * 64, 64, (bf16*)(ws + WS_SGUOUT_T) + (size_t)m * 1024 * 1024, 6, scr, lane); continue; } r -= N_SOUT;
        { const int m = r >> 4, kt = r & 15;
            conv_tile(a->in[I_RW] + (size_t)m * 1024 * 32, 1024, 32, kt * 64, 0, 32, (bf16*)(ws + WS_ROUTER_T) + (size_t)m * 64 * 1024, 2, scr, lane); }
    }
    { bf16* d = (bf16*)(ws + WS_SGUWS); const float* s = a->in[I_SWS];
      for (int i = (bx * NTHREADS + tid) * 4; i < 2 * 8 * 128 * 128; i += G * NTHREADS * 4) { const f32x4 v = *(const f32x4*)(s + i); u32x2 o; o.x = cvt_pk_bf16(v[0], v[1]); o.y = cvt_pk_bf16(v[2], v[3]); *(u32x2*)(d + i) = o; } }
}

struct RowPass {
    const void* xin; const bf16* y; void* xout; bf16* hout; unsigned char* h8out; int xin16, xout16;
    const float* gate; const float* lng; const float* lnb; const float* sc; const float* sh;
    const bf16* wside;
    float* lr_out;
    const float* rbias;
    int* topi; float* topw; int* hist;
    const void* ys; const int* dest; const float* tw;
    int has_h, has_side;
};
template <int MODE>
__device__ __forceinline__ void row_pass(const RowPass& p, LAS unsigned char* lds, int tid, int bx, int G) {
    const int lane = tid & 63, wave = __builtin_amdgcn_readfirstlane(tid >> 6);
    constexpr int HS = 1032;
    LAS bf16* Hhi = (LAS bf16*)lds;
    LAS bf16* Hlo = (LAS bf16*)(lds + 16 * HS * 2);
    LAS float* part = (LAS float*)(lds + 2 * 16 * HS * 2);
    LAS float* logit = part + 8 * 32 * 16;
    LAS int* lhist = (LAS int*)(logit + 16 * 32);
    if (MODE == 1) { if (tid < 32) lhist[tid] = 0; }
    const bool side = (p.has_side != 0) && (p.wside != nullptr);
    bf16x8 whi[2][4], wlo[2][4];
    if (side) {
#pragma unroll
        for (int hf = 0; hf < 2; ++hf)
#pragma unroll
            for (int s = 0; s < 4; ++s) { const size_t off = (size_t)(hf * 16 + (lane & 15)) * 1024 + 128 * wave + 32 * s + 8 * (lane >> 4);
                whi[hf][s] = *(const bf16x8*)(p.wside + off); wlo[hf][s] = *(const bf16x8*)(p.wside + 32 * 1024 + off); }
    }
    for (int tile = bx; tile < T / 16; tile += G) {
        const int b = (tile * 16) / SEQ;
#pragma unroll 1
        for (int tt = 0; tt < 2; ++tt) {
            const int tl = 2 * wave + tt, token = tile * 16 + tl;
            f32x4 v[4];
            if (p.xin16) { const bf16* xr = (const bf16*)p.xin + (size_t)token * D + 4 * lane;
#pragma unroll
                for (int j = 0; j < 4; ++j) { const u32x2 q = *(const u32x2*)(xr + 256 * j); v[j] = (f32x4){bf_lo(q.x), bf_hi(q.x), bf_lo(q.y), bf_hi(q.y)}; } }
            else { const float* xr = (const float*)p.xin + (size_t)token * D + 4 * lane;
#pragma unroll
                for (int j = 0; j < 4; ++j) v[j] = *(const f32x4*)(xr + 256 * j); }
            if (MODE == 1) {
                const bf16* yr = p.y + (size_t)token * D + 4 * lane; const float* gp = p.gate + (size_t)b * 6144 + 4 * lane;
#pragma unroll
                for (int j = 0; j < 4; ++j) { const u32x2 yq = *(const u32x2*)(yr + 256 * j); const f32x4 yy = (f32x4){bf_lo(yq.x), bf_hi(yq.x), bf_lo(yq.y), bf_hi(yq.y)}; const f32x4 g = *(const f32x4*)(gp + 256 * j); v[j] = v[j] * ALPHA + (g + 1.0f) * yy; }
            }
            if (MODE == 2) {
                f32x4 ya[4];
#pragma unroll
                for (int j = 0; j < 4; ++j) ya[j] = (f32x4){0.f, 0.f, 0.f, 0.f};
#pragma unroll
                for (int k = 0; k < 4; ++k) { const int ds = p.dest[token * 4 + k];
#if MOE_FP8
                    const float w = p.tw[token * 4 + k] * (1.0f / F8_YSCALE); const unsigned char* yr = (const unsigned char*)p.ys + (size_t)ds * D + 4 * lane;
#pragma unroll
                    for (int j = 0; j < 4; ++j) { const int q = *(const int*)(yr + 256 * j); const f32x2 lo2 = __builtin_amdgcn_cvt_pk_f32_fp8(q, false), hi2 = __builtin_amdgcn_cvt_pk_f32_fp8(q, true); ya[j] += (f32x4){lo2[0], lo2[1], hi2[0], hi2[1]} * w; } }
#else
                    const float w = p.tw[token * 4 + k]; const bf16* yr = (const bf16*)p.ys + (size_t)ds * D + 4 * lane;
#pragma unroll
                    for (int j = 0; j < 4; ++j) { const u32x2 q = *(const u32x2*)(yr + 256 * j); ya[j] += (f32x4){bf_lo(q.x), bf_hi(q.x), bf_lo(q.y), bf_hi(q.y)} * w; } }
#endif
                const float* gp = p.gate + (size_t)b * 6144 + 4 * lane;
#pragma unroll
                for (int j = 0; j < 4; ++j) { const f32x4 g = *(const f32x4*)(gp + 256 * j); v[j] = v[j] * ALPHA + (g + 1.0f) * ya[j]; }
            }
            if (MODE != 0) {
                float s = 0.f;
#pragma unroll
                for (int j = 0; j < 4; ++j) s += (v[j][0] + v[j][1]) + (v[j][2] + v[j][3]);
                const float mean = wave_sum(s, lane) * (1.0f / D); float s2 = 0.f;
#pragma unroll
                for (int j = 0; j < 4; ++j) { v[j] = v[j] - mean; s2 += (v[j][0] * v[j][0] + v[j][1] * v[j][1]) + (v[j][2] * v[j][2] + v[j][3] * v[j][3]); }
                const float rstd = 1.0f / sqrtf(wave_sum(s2, lane) * (1.0f / D) + LN_EPS);
#pragma unroll
                for (int j = 0; j < 4; ++j) { const f32x4 g = *(const f32x4*)(p.lng + 4 * lane + 256 * j), bb = *(const f32x4*)(p.lnb + 4 * lane + 256 * j); v[j] = v[j] * rstd * g + bb; }
                if (p.xout16) { bf16* xo = (bf16*)p.xout + (size_t)token * D + 4 * lane;
#pragma unroll
                    for (int j = 0; j < 4; ++j) { u32x2 o; o.x = cvt_pk_bf16(v[j][0], v[j][1]); o.y = cvt_pk_bf16(v[j][2], v[j][3]); *(u32x2*)(xo + 256 * j) = o; } }
                else { float* xo = (float*)p.xout + (size_t)token * D + 4 * lane;
#pragma unroll
                    for (int j = 0; j < 4; ++j) *(f32x4*)(xo + 256 * j) = v[j]; }
            }
            if (p.has_h) {
                const float* scp = p.sc + (size_t)b * 6144 + 4 * lane; const float* shp = p.sh + (size_t)b * 6144 + 4 * lane;
                bf16* ho = p.hout + (size_t)token * D + 4 * lane;
#pragma unroll
                for (int j = 0; j < 4; ++j) { const f32x4 s1 = *(const f32x4*)(scp + 256 * j), s0 = *(const f32x4*)(shp + 256 * j); const f32x4 h = v[j] * (s1 + 1.0f) + s0;
                    u32x2 o; o.x = cvt_pk_bf16(h[0], h[1]); o.y = cvt_pk_bf16(h[2], h[3]); if (!(MODE == 1 && MOE_FP8)) *(u32x2*)(ho + 256 * j) = o;
                    if (MODE == 1 && p.h8out) { int w8 = __builtin_amdgcn_cvt_pk_fp8_f32(h[0] * F8_HSCALE, h[1] * F8_HSCALE, 0, false); w8 = __builtin_amdgcn_cvt_pk_fp8_f32(h[2] * F8_HSCALE, h[3] * F8_HSCALE, w8, true); *(int*)(p.h8out + (size_t)token * D + 4 * lane + 256 * j) = w8; }
                    if (side) { u32x2 l; l.x = cvt_pk_bf16(h[0] - bf_lo(o.x), h[1] - bf_hi(o.x)); l.y = cvt_pk_bf16(h[2] - bf_lo(o.y), h[3] - bf_hi(o.y));
                        *(LAS u32x2*)(Hhi + tl * HS + 4 * lane + 256 * j) = o; *(LAS u32x2*)(Hlo + tl * HS + 4 * lane + 256 * j) = l; } }
            }
        }
        if (side) {
            __syncthreads();
            f32x4 acc[2]; acc[0] = (f32x4){0.f, 0.f, 0.f, 0.f}; acc[1] = acc[0];
#pragma unroll
            for (int s = 0; s < 4; ++s) { const int ko = (lane & 15) * HS + 128 * wave + 32 * s + 8 * (lane >> 4);
                const bf16x8 bh = *(const LAS bf16x8*)(Hhi + ko), bl = *(const LAS bf16x8*)(Hlo + ko);
#pragma unroll
                for (int hf = 0; hf < 2; ++hf) { acc[hf] = __builtin_amdgcn_mfma_f32_16x16x32_bf16(whi[hf][s], bh, acc[hf], 0, 0, 0);
                    acc[hf] = __builtin_amdgcn_mfma_f32_16x16x32_bf16(wlo[hf][s], bh, acc[hf], 0, 0, 0); acc[hf] = __builtin_amdgcn_mfma_f32_16x16x32_bf16(whi[hf][s], bl, acc[hf], 0, 0, 0); } }
#pragma unroll
            for (int hf = 0; hf < 2; ++hf)
#pragma unroll
                for (int j = 0; j < 4; ++j) part[(wave * 32 + hf * 16 + 4 * (lane >> 4) + j) * 16 + (lane & 15)] = acc[hf][j];
            __syncthreads();
            { const int e = tid >> 4, tk = tid & 15; float s = 0.f;
#pragma unroll
              for (int w = 0; w < 8; ++w) s += part[(w * 32 + e) * 16 + tk];
              if (MODE == 1) logit[tk * 32 + e] = s + p.rbias[e];
              else p.lr_out[(size_t)(tile * 16 + tk) * 32 + e] = s; }
            if (MODE == 1) {
                __syncthreads();
                if (tid < 16) {
                    const int token = tile * 16 + tid; float lv[32];
#pragma unroll
                    for (int e = 0; e < 32; ++e) lv[e] = logit[tid * 32 + e];
                    int bi[4]; float bv[4];
#pragma unroll
                    for (int k = 0; k < 4; ++k) { float m = -3.0e38f; int mi = 0;
#pragma unroll
                        for (int e = 0; e < 32; ++e) { const bool take = lv[e] > m; m = take ? lv[e] : m; mi = take ? e : mi; }
                        bi[k] = mi; bv[k] = m;
#pragma unroll
                        for (int e = 0; e < 32; ++e) lv[e] = (e == mi) ? -3.0e38f : lv[e]; }
                    const float e1 = __expf(bv[1] - bv[0]), e2 = __expf(bv[2] - bv[0]), e3 = __expf(bv[3] - bv[0]); const float inv = 1.0f / (1.0f + e1 + e2 + e3);
                    *(int4*)(p.topi + token * 4) = make_int4(bi[0], bi[1], bi[2], bi[3]);
                    *(f32x4*)(p.topw + token * 4) = (f32x4){inv, e1 * inv, e2 * inv, e3 * inv};
#pragma unroll
                    for (int k = 0; k < 4; ++k) atomicAdd((int*)&lhist[bi[k]], 1);
                }
            }
            __syncthreads();
        }
    }
    if (MODE == 1) { __syncthreads(); if (tid < 32) p.hist[tid] = lhist[tid]; }
}

__device__ __forceinline__ void phase_place(int* route, LAS unsigned char* lds, int tid, int bx, int G) {
    const int lane = tid & 63, wave = tid >> 6;
    LAS int* ptot = (LAS int*)lds;
    LAS int* ppre = ptot + 512;
    LAS int* tot = ppre + 512;
    LAS int* pre = tot + 32;
    LAS int* pstart = pre + 32;
    const int* hist = route + R_HIST;
    { const int e = tid & 31, part = tid >> 5; int st = 0, sp = 0;
      for (int bb = part; bb < G; bb += 16) { const int h = hist[bb * 32 + e]; st += h; if (bb < bx) sp += h; }
      ptot[part * 32 + e] = st; ppre[part * 32 + e] = sp; }
    __syncthreads();
    if (tid < 32) { int st = 0, sp = 0;
#pragma unroll
        for (int q = 0; q < 16; ++q) { st += ptot[q * 32 + tid]; sp += ppre[q * 32 + tid]; }
        tot[tid] = st; pre[tid] = sp; }
    __syncthreads();
    if (tid == 0) { int acc = 0; for (int e = 0; e < 32; ++e) { pstart[e] = acc; acc += (tot[e] + 255) / 256 * 256; } pstart[32] = acc; }
    __syncthreads();
    if (bx == 0) {
        const int ntiles = pstart[32] / 256;
        if (tid == 0) route[R_NTILES] = ntiles;
        for (int t = tid; t < ntiles; t += NTHREADS) { int e = 0; for (int q = 1; q < 32; ++q) if (pstart[q] <= t * 256) e = q; route[R_TILEE + t] = e; }
    }
    for (int e = bx; e < 32; e += G) { const int s0 = pstart[e] + tot[e], s1 = pstart[e + 1]; for (int s = s0 + tid; s < s1; s += NTHREADS) route[R_BUFTOK + s] = 0; }
    if (wave == 0) {
        int run = 0;
        for (int tile = bx; tile < T / 16; tile += G) {
            const int token = tile * 16 + (lane >> 2);
            const int e = route[R_TOPI + tile * 64 + lane];
            const int base = shfl_i(run, e, lane);
            int rank = 0, add = 0;
#pragma unroll 1
            for (int x = 0; x < 32; ++x) { const unsigned long long m = __ballot(e == x); if (e == x) rank = __popcll(m & ((1ull << lane) - 1ull)); if (lane == x) add = __popcll(m); }
            run += add;
            const int ds = pstart[e] + pre[e] + base + rank;
            route[R_DEST + tile * 64 + lane] = ds;
            route[R_BUFTOK + ds] = token;
        }
    }
}

struct Unit { int pm, pn, e; const char* bt; };
constexpr int NXCD = 8, WGM = 8;
struct Sched {
    int nM, nN, nwg, G, c; const char* Bt; size_t estride; const int* tile_e; int KB;
    __device__ __forceinline__ void init(int nM_, int nN_, int G_, int c_, const void* Bt_, size_t es, const int* te, int KB_) { nM = nM_; nN = nN_; nwg = nM * nN; G = G_; c = c_; Bt = (const char*)Bt_; estride = es; tile_e = te; KB = KB_; }
    __device__ __forceinline__ bool next(int i, Unit& u) const {
        const long L = (long)i * G + c; if (L >= nwg) return false;
        int wgid = (int)L; { const int q = nwg / NXCD, r = nwg % NXCD, xcd = wgid % NXCD, off = wgid / NXCD; wgid = (xcd < r ? xcd * (q + 1) : r * (q + 1) + (xcd - r) * q) + off; }
        const int nig = WGM * nN, gid = wgid / nig, fm = gid * WGM, gsz = (nM - fm) < WGM ? (nM - fm) : WGM;
        u.pm = fm + ((wgid % nig) % gsz); u.pn = (wgid % nig) / gsz;
        u.e = tile_e ? __builtin_amdgcn_readfirstlane(tile_e[u.pm]) : 0;
        u.bt = Bt + (size_t)u.e * estride + (size_t)u.pn * 256 * KB;
        return true;
    }
};
struct EpiGlaIn { bf16* O;
    static constexpr int NST = 16;
    __device__ __forceinline__ const float* bias_ptr(const Unit&) const { return nullptr; }
    __device__ __forceinline__ void operator()(const f32x4 (&acc)[2][2][4][2], const Unit& u, int wr, int wc, int fr, int fq, const LAS float*) const {
        const int row0 = u.pm * 256 + wr * 64 + fr, col0 = u.pn * 256 + wc * 32 + 8 * fq; const float sc = (u.pn < 2) ? 0.08838834764831845f : 1.0f;
#pragma unroll
        for (int ai = 0; ai < 2; ++ai)
#pragma unroll
            for (int m = 0; m < 4; ++m) { bf16* rp = O + (size_t)(row0 + ai * 128 + m * 16) * GLA_MAIN + col0;
#pragma unroll
                for (int bj = 0; bj < 2; ++bj) { const f32x4 v0 = acc[ai][bj][m][0] * sc, v1 = acc[ai][bj][m][1] * sc;
                    *(u32x4*)(rp + bj * 128) = (u32x4){cvt_pk_bf16(v0[0], v0[1]), cvt_pk_bf16(v0[2], v0[3]), cvt_pk_bf16(v1[0], v1[1]), cvt_pk_bf16(v1[2], v1[3])}; } }
    }
};
struct EpiSguIn { bf16* O; const float* bias;
    static constexpr int NST = 16;
    __device__ __forceinline__ const float* bias_ptr(const Unit& u) const { return bias + u.pn * 256; }
    __device__ __forceinline__ void operator()(const f32x4 (&acc)[2][2][4][2], const Unit& u, int wr, int wc, int fr, int fq, const LAS float* lb) const {
        const int row0 = u.pm * 256 + wr * 64 + fr, col0 = u.pn * 256 + wc * 32 + 8 * fq;
        f32x4 bv[2][2];
#pragma unroll
        for (int bj = 0; bj < 2; ++bj)
#pragma unroll
            for (int n = 0; n < 2; ++n) bv[bj][n] = *(const LAS f32x4*)(lb + wc * 32 + 8 * fq + bj * 128 + 4 * n);
#pragma unroll
        for (int ai = 0; ai < 2; ++ai)
#pragma unroll
            for (int m = 0; m < 4; ++m) { bf16* rp = O + (size_t)(row0 + ai * 128 + m * 16) * 2048 + col0;
#pragma unroll
                for (int bj = 0; bj < 2; ++bj) { const f32x4 v0 = acc[ai][bj][m][0] + bv[bj][0], v1 = acc[ai][bj][m][1] + bv[bj][1];
                    *(u32x4*)(rp + bj * 128) = (u32x4){cvt_pk_bf16(gelu_f(v0[0]), gelu_f(v0[1])), cvt_pk_bf16(gelu_f(v0[2]), gelu_f(v0[3])), cvt_pk_bf16(gelu_f(v1[0]), gelu_f(v1[1])), cvt_pk_bf16(gelu_f(v1[2]), gelu_f(v1[3]))}; } }
    }
};
struct EpiOut { bf16* O; const float* bias;
    static constexpr int NST = 16;
    __device__ __forceinline__ const float* bias_ptr(const Unit& u) const { return bias ? bias + u.pn * 256 : nullptr; }
    __device__ __forceinline__ void operator()(const f32x4 (&acc)[2][2][4][2], const Unit& u, int wr, int wc, int fr, int fq, const LAS float* lb) const {
        const int row0 = u.pm * 256 + wr * 64 + fr, col0 = u.pn * 256 + wc * 32 + 8 * fq;
        f32x4 bv[2][2];
#pragma unroll
        for (int bj = 0; bj < 2; ++bj)
#pragma unroll
            for (int n = 0; n < 2; ++n) bv[bj][n] = bias ? *(const LAS f32x4*)(lb + wc * 32 + 8 * fq + bj * 128 + 4 * n) : (f32x4){0.f, 0.f, 0.f, 0.f};
#pragma unroll
        for (int ai = 0; ai < 2; ++ai)
#pragma unroll
            for (int m = 0; m < 4; ++m) { bf16* rp = O + (size_t)(row0 + ai * 128 + m * 16) * D + col0;
#pragma unroll
                for (int bj = 0; bj < 2; ++bj) { const f32x4 v0 = acc[ai][bj][m][0] + bv[bj][0], v1 = acc[ai][bj][m][1] + bv[bj][1];
                    *(u32x4*)(rp + bj * 128) = (u32x4){cvt_pk_bf16(v0[0], v0[1]), cvt_pk_bf16(v0[2], v0[3]), cvt_pk_bf16(v1[0], v1[1]), cvt_pk_bf16(v1[2], v1[3])}; } }
    }
};
template <bool F8> struct EpiUp { unsigned char* O; const float* bias;
    __device__ __forceinline__ const float* bias_ptr(const Unit& u) const { return bias + (size_t)u.e * 2048 + u.pn * 256; }
    __device__ __forceinline__ void operator()(const f32x4 (&acc)[2][2][4][2], const Unit& u, int wr, int wc, int fr, int fq, const LAS float* lb) const {
        const int row0 = u.pm * 256 + wr * 64 + fr, a0 = u.pn * 128 + wc * 16 + 4 * fq;
        const float asc = F8 ? 1.0f / (F8_WSCALE * F8_HSCALE) : 1.0f;
        f32x4 bg[2], bl[2];
#pragma unroll
        for (int bj = 0; bj < 2; ++bj) { const LAS float* bp = lb + 2 * (wc * 16 + 4 * fq + 64 * bj); const f32x4 p0 = *(const LAS f32x4*)bp, p1 = *(const LAS f32x4*)(bp + 4);
            bg[bj] = (f32x4){p0[0], p0[2], p1[0], p1[2]}; bl[bj] = (f32x4){p0[1], p0[3], p1[1], p1[3]}; }
#pragma unroll
        for (int ai = 0; ai < 2; ++ai)
#pragma unroll
            for (int m = 0; m < 4; ++m) { const size_t ro = (size_t)(row0 + ai * 128 + m * 16) * D + a0;
#pragma unroll
                for (int bj = 0; bj < 2; ++bj) { const f32x4 g = acc[ai][bj][m][0] * asc + bg[bj], l = acc[ai][bj][m][1] * asc + bl[bj]; float r[4];
#pragma unroll
                    for (int j = 0; j < 4; ++j) { const float gg = fminf(g[j], 7.0f), ll = fminf(fmaxf(l[j], -7.0f), 7.0f); r[j] = gg * sigmoid_f(1.702f * gg) * (ll + 1.0f); }
                    if constexpr (F8) { int w = __builtin_amdgcn_cvt_pk_fp8_f32(r[0] * F8_ASCALE, r[1] * F8_ASCALE, 0, false); w = __builtin_amdgcn_cvt_pk_fp8_f32(r[2] * F8_ASCALE, r[3] * F8_ASCALE, w, true);
                        *(int*)(O + ro + bj * 64) = w; }
                    else { u32x2 o; o.x = cvt_pk_bf16(r[0], r[1]); o.y = cvt_pk_bf16(r[2], r[3]); *(u32x2*)((bf16*)O + ro + bj * 64) = o; } } }
    }
};
struct EpiDown8 { unsigned char* O; const float* bias; float asc;
    static constexpr int NST = 16;
    __device__ __forceinline__ const float* bias_ptr(const Unit& u) const { return bias + (size_t)u.e * 1024 + u.pn * 256; }
    __device__ __forceinline__ void operator()(const f32x4 (&acc)[2][2][4][2], const Unit& u, int wr, int wc, int fr, int fq, const LAS float* lb) const {
        const int row0 = u.pm * 256 + wr * 64 + fr, col0 = u.pn * 256 + wc * 32 + 8 * fq;
        f32x4 bv[2][2];
#pragma unroll
        for (int bj = 0; bj < 2; ++bj)
#pragma unroll
            for (int n = 0; n < 2; ++n) bv[bj][n] = *(const LAS f32x4*)(lb + wc * 32 + 8 * fq + bj * 128 + 4 * n) * F8_YSCALE;
        const float sc = asc * F8_YSCALE;
#pragma unroll
        for (int ai = 0; ai < 2; ++ai)
#pragma unroll
            for (int m = 0; m < 4; ++m) { unsigned char* rp = O + (size_t)(row0 + ai * 128 + m * 16) * D + col0;
#pragma unroll
                for (int bj = 0; bj < 2; ++bj) { const f32x4 v0 = acc[ai][bj][m][0] * sc + bv[bj][0], v1 = acc[ai][bj][m][1] * sc + bv[bj][1];
                    int w0 = __builtin_amdgcn_cvt_pk_fp8_f32(v0[0], v0[1], 0, false); w0 = __builtin_amdgcn_cvt_pk_fp8_f32(v0[2], v0[3], w0, true);
                    int w1 = __builtin_amdgcn_cvt_pk_fp8_f32(v1[0], v1[1], 0, false); w1 = __builtin_amdgcn_cvt_pk_fp8_f32(v1[2], v1[3], w1, true);
                    *(u32x2*)(rp + bj * 128) = (u32x2){(unsigned)w0, (unsigned)w1}; } }
    }
};
struct EpiDown { bf16* O; const float* bias; float asc;
    __device__ __forceinline__ const float* bias_ptr(const Unit& u) const { return bias + (size_t)u.e * 1024 + u.pn * 256; }
    __device__ __forceinline__ void operator()(const f32x4 (&acc)[2][2][4][2], const Unit& u, int wr, int wc, int fr, int fq, const LAS float* lb) const {
        const int row0 = u.pm * 256 + wr * 64 + fr, col0 = u.pn * 256 + wc * 32 + 4 * fq;
        f32x4 bv[2][2];
#pragma unroll
        for (int bj = 0; bj < 2; ++bj)
#pragma unroll
            for (int n = 0; n < 2; ++n) bv[bj][n] = *(const LAS f32x4*)(lb + wc * 32 + 4 * fq + bj * 128 + n * 16);
#pragma unroll
        for (int ai = 0; ai < 2; ++ai)
#pragma unroll
            for (int m = 0; m < 4; ++m) { bf16* rp = O + (size_t)(row0 + ai * 128 + m * 16) * D + col0;
#pragma unroll
                for (int bj = 0; bj < 2; ++bj)
#pragma unroll
                    for (int n = 0; n < 2; ++n) { const f32x4 v = acc[ai][bj][m][n] * asc + bv[bj][n]; u32x2 o; o.x = cvt_pk_bf16(v[0], v[1]); o.y = cvt_pk_bf16(v[2], v[3]); *(u32x2*)(rp + bj * 128 + n * 16) = o; } }
    }
};

constexpr int G8_BK = 64, G8_HALF = 128, G8_HTB = G8_HALF * G8_BK * 2, G8_STAGE_BYTES = 8 * G8_HTB;
__device__ __forceinline__ int g8_lds_byte(int r, int c) { const int st = (r >> 4) * 2 + (c >> 5), rr = r & 15, cc = c & 31, ob = rr * 64 + cc * 2; return st * 1024 + (ob ^ (((ob >> 9) & 1) << 5)); }
__device__ __forceinline__ void g8_stage_rc(int b, int& R, int& C) { const int st = b / 1024, sb = b % 1024, swz = sb ^ (((sb >> 9) & 1) << 5); R = (st >> 1) * 16 + swz / 64; C = (st & 1) * 32 + (swz % 64) / 2; }
__device__ __forceinline__ u32x4 g8_avoff(int pm, const int* gather, int tid, int KB) {
    int t2 = tid; asm volatile("" : "+v"(t2));
    int R, C; g8_stage_rc(t2 * 16, R, C);
    const int* gp = gather + pm * 256 + R;
    const unsigned r00 = gp[0], r01 = gp[64], r10 = gp[128], r11 = gp[192], c2 = (unsigned)(C * 2), k2 = (unsigned)KB;
    return (u32x4){r00 * k2 + c2, r01 * k2 + c2, r10 * k2 + c2, r11 * k2 + c2};
}
template <bool GATHER, bool FP8, class Epi>
__device__ __forceinline__ void gemm_fast(const void* A, const int* gather, const int K, const Sched& S, const Epi& E, LAS unsigned char* lds, int tid) {
    const int wid = __builtin_amdgcn_readfirstlane(tid >> 6), lane = tid & 63, wr = wid >> 2, wc = wid & 3, fr = lane & 15, fq = lane >> 4;
    const int KB = FP8 ? K : 2 * K, nt = KB / 128;
    unsigned voff; { int R, C; g8_stage_rc(tid * 16, R, C); voff = (unsigned)(R * KB + C * 2); }
    const size_t kstep = (size_t)128, hstep = (size_t)G8_HALF * KB, qstep = (size_t)64 * KB, tstep = 2 * hstep;
    const unsigned ldsw = (unsigned)wid * 1024u;
    const int aoff = g8_lds_byte(wr * 64 + fr, fq * (FP8 ? 16 : 8)), boff = g8_lds_byte(wc * 32 + fr, fq * (FP8 ? 16 : 8));
    constexpr int KSTR = FP8 ? 16 : 1024;
#define G8_SA(b, h) (((b) * 2 + (h)) * G8_HTB)
#define G8_SB(b, h) ((4 + (b) * 2 + (h)) * G8_HTB)
#define G8_GLDS(gp, ldsoff) __builtin_amdgcn_global_load_lds((const unsigned*)(gp), (LAS unsigned*)(lds + (ldsoff)), 16, 0, 0)
#define G8_STAGE_D(bufoff, gbase) do { G8_GLDS((const char*)(gbase) + voff, (bufoff) + ldsw); G8_GLDS((const char*)(gbase) + qstep + voff, (bufoff) + ldsw + 8192); } while (0)
#define G8_STAGE_A(bufoff, kb, h) do { if constexpr (GATHER) { G8_GLDS((kb) + va[(h) * 2], (bufoff) + ldsw); G8_GLDS((kb) + va[(h) * 2 + 1], (bufoff) + ldsw + 8192); } \
        else { G8_STAGE_D(bufoff, (kb) + (h) * hstep); } } while (0)
#define G8_LDA(dst, b, h) do { _Pragma("unroll") for (int m = 0; m < 4; ++m) _Pragma("unroll") for (int k = 0; k < 2; ++k) dst[m][k] = *(const LAS bf16x8*)(lds + G8_SA(b, h) + aoff + m * 2048 + k * KSTR); } while (0)
#define G8_LDB(dst, b, h) do { _Pragma("unroll") for (int n = 0; n < 2; ++n) _Pragma("unroll") for (int k = 0; k < 2; ++k) dst[n][k] = *(const LAS bf16x8*)(lds + G8_SB(b, h) + boff + n * 2048 + k * KSTR); } while (0)
#define G8_CAT(x) __builtin_shufflevector(__builtin_bit_cast(i32x4, (x)[0]), __builtin_bit_cast(i32x4, (x)[1]), 0, 1, 2, 3, 4, 5, 6, 7)
#define G8_MMA(ai, bj, At, Bt) do { __builtin_amdgcn_s_setprio(1); _Pragma("unroll") for (int m = 0; m < 4; ++m) _Pragma("unroll") for (int n = 0; n < 2; ++n) { \
        if constexpr (FP8) acc[ai][bj][m][n] = __builtin_amdgcn_mfma_scale_f32_16x16x128_f8f6f4(G8_CAT(Bt[n]), G8_CAT(At[m]), acc[ai][bj][m][n], 0, 0, 0, 0x7f7f7f7f, 0, 0x7f7f7f7f); \
        else { _Pragma("unroll") for (int k = 0; k < 2; ++k) acc[ai][bj][m][n] = __builtin_amdgcn_mfma_f32_16x16x32_bf16(Bt[n][k], At[m][k], acc[ai][bj][m][n], 0, 0, 0); } } \
        __builtin_amdgcn_s_setprio(0); } while (0)
#define G8_WAIT_V(n) asm volatile("s_waitcnt vmcnt(" #n ")" ::: "memory")
#define G8_WAIT_L(n) asm volatile("s_waitcnt lgkmcnt(" #n ")" ::: "memory")
#define G8_BAR __builtin_amdgcn_s_barrier()
#define G8_SCHED __builtin_amdgcn_sched_barrier(0)
    Unit cur, nxt; int ui = 0;
    if (!S.next(0, cur)) return;
    f32x4 acc[2][2][4][2];
#pragma unroll
    for (int a = 0; a < 2; ++a)
#pragma unroll
        for (int b = 0; b < 2; ++b)
#pragma unroll
            for (int m = 0; m < 4; ++m)
#pragma unroll
                for (int n = 0; n < 2; ++n) acc[a][b][m][n] = (f32x4){0.f, 0.f, 0.f, 0.f};
    bf16x8 At[4][2], B0[2][2], B1[2][2];
    u32x4 va = (u32x4){0u, 0u, 0u, 0u};
    if constexpr (GATHER) va = g8_avoff(cur.pm, gather, tid, KB);
    constexpr int G8_IDX = G8_STAGE_BYTES, G8_BIAS = G8_STAGE_BYTES + 1024;
    { const float* bp0 = E.bias_ptr(cur); if (bp0 && wid == 0) G8_GLDS((const char*)bp0 + lane * 16, G8_BIAS); }
    const char* cB = (const char*)cur.bt; const char* cA = (const char*)A + (GATHER ? (size_t)0 : (size_t)cur.pm * tstep);
    G8_STAGE_D(G8_SB(0, 0), cB); G8_STAGE_D(G8_SB(0, 1), cB + hstep); G8_STAGE_A(G8_SA(0, 0), cA, 0); G8_STAGE_A(G8_SA(0, 1), cA, 1);
    if (wr == 1) G8_BAR;
    G8_WAIT_V(2); G8_BAR;
    G8_STAGE_D(G8_SB(1, 0), cB + kstep); G8_STAGE_A(G8_SA(1, 0), cA + kstep, 0); G8_STAGE_D(G8_SB(1, 1), cB + hstep + kstep);
    G8_WAIT_V(6); G8_BAR;
    for (;;) {
        const bool has_next = S.next(ui + 1, nxt);
        if constexpr (GATHER) { if (has_next && wid == 1) G8_GLDS((const char*)(gather + nxt.pm * 256) + lane * 16, G8_IDX); }
        const char* nB = has_next ? (const char*)nxt.bt : cB;
        const char* nA = (GATHER || !has_next) ? cA : (const char*)A + (size_t)nxt.pm * tstep;
#pragma unroll 1
        for (int t = 0; t < nt; t += 2) {
            const bool last = (t == nt - 2);
            const char* a1 = cA + (size_t)(t + 1) * kstep;
            const char* a2 = last ? nA : cA + (size_t)(t + 2) * kstep; const char* b2 = last ? nB : cB + (size_t)(t + 2) * kstep;
            const char* a3 = a2 + kstep; const char* b3 = b2 + kstep;
            G8_LDB(B0, 0, 0); G8_LDB(B1, 0, 1); G8_SCHED; G8_LDA(At, 0, 0); G8_STAGE_A(G8_SA(1, 1), a1, 1);
            if (last && has_next && wid == 0) { const float* bpn = E.bias_ptr(nxt); if (bpn) G8_GLDS((const char*)bpn + lane * 16, G8_BIAS + ((ui + 1) & 1) * 1024); }
            if constexpr (GATHER) { if (last && has_next) {
                int t2 = tid; asm volatile("" : "+v"(t2)); int R, C; g8_stage_rc(t2 * 16, R, C); const LAS int* ip = (const LAS int*)(lds + G8_IDX) + R; const unsigned c2 = (unsigned)(C * 2), k2 = (unsigned)KB;
                va = (u32x4){(unsigned)ip[0] * k2 + c2, (unsigned)ip[64] * k2 + c2, (unsigned)ip[128] * k2 + c2, (unsigned)ip[192] * k2 + c2}; } }
            G8_WAIT_V(8); G8_WAIT_L(0); G8_BAR; G8_MMA(0, 0, At, B0); G8_MMA(0, 1, At, B1); G8_BAR; G8_SCHED;
            G8_LDA(At, 0, 1); G8_STAGE_D(G8_SB(0, 0), b2); G8_STAGE_D(G8_SB(0, 1), b2 + hstep); G8_STAGE_A(G8_SA(0, 0), a2, 0);
            G8_WAIT_V(8); G8_WAIT_L(0); G8_BAR; G8_MMA(1, 0, At, B0); G8_MMA(1, 1, At, B1); G8_BAR; G8_SCHED;
            G8_LDB(B0, 1, 0); G8_LDB(B1, 1, 1); G8_SCHED; G8_LDA(At, 1, 0); G8_STAGE_A(G8_SA(0, 1), a2, 1);
            G8_WAIT_V(8); G8_WAIT_L(0); G8_BAR; G8_MMA(0, 0, At, B0); G8_MMA(0, 1, At, B1); G8_BAR; G8_SCHED;
            G8_LDA(At, 1, 1); G8_STAGE_D(G8_SB(1, 0), b3); G8_STAGE_D(G8_SB(1, 1), b3 + hstep); G8_STAGE_A(G8_SA(1, 0), a3, 0);
            G8_WAIT_V(8); G8_WAIT_L(0); G8_BAR; G8_MMA(1, 0, At, B0); G8_MMA(1, 1, At, B1); G8_BAR; G8_SCHED;
        }
        if (wr == 0) G8_BAR;
        { int t3 = tid; asm volatile("" : "+v"(t3)); const int l3 = t3 & 63; E(acc, cur, wr, wc, l3 & 15, l3 >> 4, (const LAS float*)(lds + G8_BIAS + (ui & 1) * 1024)); }
        if (!has_next) break;
#pragma unroll
        for (int a = 0; a < 2; ++a)
#pragma unroll
            for (int b = 0; b < 2; ++b)
#pragma unroll
                for (int m = 0; m < 4; ++m)
#pragma unroll
                    for (int n = 0; n < 2; ++n) acc[a][b][m][n] = (f32x4){0.f, 0.f, 0.f, 0.f};
        cur = nxt; cB = nB; cA = nA; ++ui;
        if (wr == 1) G8_BAR;
    }
    G8_WAIT_V(0);
    G8_BAR;
#undef G8_SA
#undef G8_SB
#undef G8_GLDS
#undef G8_STAGE_D
#undef G8_STAGE_A
#undef G8_LDA
#undef G8_LDB
#undef G8_MMA
#undef G8_CAT
#undef G8_WAIT_V
#undef G8_WAIT_L
#undef G8_BAR
#undef G8_SCHED
}

__device__ __forceinline__ float logsigmoid_f(float x) { return fminf(x, 0.f) - log1pf(__expf(-fabsf(x))); }
__device__ __forceinline__ void phase_gla_prep(KA a, int li, LAS unsigned char* lds, int tid, int bx, int G) {
    const int lane = tid & 63, wave = __builtin_amdgcn_readfirstlane(tid >> 6), fr = lane & 15, fq = lane >> 4;
    unsigned char* ws = a->ws;
    const bf16* qkvr = (const bf16*)(ws + WS_BIG); const float* lr = (const float*)(ws + WS_LR);
    bf16* QE = (bf16*)(ws + WS_QE); bf16* KET = (bf16*)(ws + WS_KET); bf16* PP = (bf16*)(ws + WS_P); bf16* VT = (bf16*)(ws + WS_VT); float* EL = (float*)(ws + WS_EL);
    constexpr int LS = 136, VLS = 264;
    LAS bf16* qes = (LAS bf16*)lds;
    LAS bf16* kes = qes + 64 * LS;
    LAS float* lrs = (LAS float*)(kes + 64 * LS);
    LAS float* segtot = lrs + 1024;
    LAS bf16* vraw = (LAS bf16*)(segtot + 512);
    const int d = tid & 127, seg = tid >> 7;
    const int so = tid & 15, sr = tid >> 4;
    u32x4 pq[2], pk[2], pv[4]; float plr[2], pw[16], pbg;
#define PF_LOAD(it_) do { const int it__ = (it_); const int chunk_ = it__ & 63, dir_ = (it__ >> 6) & 1, h_ = (it__ >> 7) & 3, b_ = it__ >> 9; const int row0_ = b_ * SEQ + chunk_ * 64; \
        _Pragma("unroll") for (int k2 = 0; k2 < 2; ++k2) { const bf16* src = qkvr + (size_t)(row0_ + sr + 32 * k2) * GLA_MAIN + h_ * 128 + 8 * so; pq[k2] = *(const u32x4*)src; pk[k2] = *(const u32x4*)(src + 512); } \
        if (dir_ == 0) { _Pragma("unroll") for (int k4 = 0; k4 < 4; ++k4) { const int idx = tid + 512 * k4; pv[k4] = *(const u32x4*)(qkvr + (size_t)(row0_ + (idx >> 5)) * GLA_MAIN + 1024 + h_ * 256 + 8 * (idx & 31)); } } \
        _Pragma("unroll") for (int k2 = 0; k2 < 2; ++k2) { const int i = tid + 512 * k2; plr[k2] = lr[(size_t)(row0_ + (i >> 4)) * 32 + dir_ * 16 + (i & 15)]; } \
        { const float* wg2_ = a->in[dir_ ? I_GWG2B : I_GWG2F] + (size_t)li * 16 * 512 + h_ * 128 + d; _Pragma("unroll") for (int r = 0; r < 16; ++r) pw[r] = wg2_[r * 512]; pbg = a->in[dir_ ? I_GBGB : I_GBGF][(size_t)li * 512 + h_ * 128 + d]; } } while (0)
    if (bx < 4096) PF_LOAD(bx);
    for (int it = bx; it < 4096; it += G) {
        const int chunk = it & 63, dir = (it >> 6) & 1, h = (it >> 7) & 3, b = it >> 9;
        const int row0 = b * SEQ + chunk * 64;
        const size_t cidx = (size_t)(((dir * 8 + b) * 4 + h) * 64 + chunk);
#pragma unroll
        for (int k2 = 0; k2 < 2; ++k2) { const int p = sr + 32 * k2; *(LAS u32x4*)(qes + p * LS + 8 * so) = pq[k2]; *(LAS u32x4*)(kes + p * LS + 8 * so) = pk[k2]; }
        if (dir == 0) {
#pragma unroll
            for (int k4 = 0; k4 < 4; ++k4) { const int idx = tid + 512 * k4; *(LAS u32x4*)(vraw + (idx >> 5) * VLS + 8 * (idx & 31)) = pv[k4]; }
        }
#pragma unroll
        for (int k2 = 0; k2 < 2; ++k2) lrs[tid + 512 * k2] = plr[k2];
        float wcol[16];
#pragma unroll
        for (int r = 0; r < 16; ++r) wcol[r] = pw[r];
        const float bgd = pbg;
        __syncthreads();
        if (it + G < 4096) PF_LOAD(it + G);
        float g[16];
#pragma unroll
        for (int s2 = 0; s2 < 16; ++s2) { const LAS float* lp = lrs + (seg * 16 + s2) * 16; float x = bgd;
#pragma unroll
            for (int r4 = 0; r4 < 4; ++r4) { const f32x4 l4 = *(const LAS f32x4*)(lp + 4 * r4); x += l4[0] * wcol[4 * r4] + l4[1] * wcol[4 * r4 + 1] + l4[2] * wcol[4 * r4 + 2] + l4[3] * wcol[4 * r4 + 3]; }
            g[s2] = (fminf(x, 0.f) - __logf(1.0f + __expf(-fabsf(x)))) * (1.0f / 16.0f); }
        if (dir == 0) {
#pragma unroll
            for (int s2 = 1; s2 < 16; ++s2) g[s2] += g[s2 - 1];
        } else {
#pragma unroll
            for (int s2 = 14; s2 >= 0; --s2) g[s2] += g[s2 + 1];
        }
        segtot[seg * 128 + d] = dir ? g[0] : g[15];
        __syncthreads();
        float pre = 0.f, total = 0.f;
#pragma unroll
        for (int sg = 0; sg < 4; ++sg) { const float t = segtot[sg * 128 + d]; total += t; if (dir ? (sg > seg) : (sg < seg)) pre += t; }
        if (seg == 0) EL[cidx * 128 + d] = __expf(total);
        unsigned kt[8];
#pragma unroll
        for (int s2 = 0; s2 < 16; s2 += 2) {
            unsigned kw[2];
#pragma unroll
            for (int u = 0; u < 2; ++u) { const int p = seg * 16 + s2 + u;
                const float q = bf2f(qes[p * LS + d]), k = bf2f(kes[p * LS + d]); const float bb = g[s2 + u] + pre;
                const float eb_ = __expf(bb); const unsigned qw = cvt_pk_bf16(q * eb_, 0.f) & 0xffffu; kw[u] = cvt_pk_bf16(k * __builtin_amdgcn_rcpf(eb_), 0.f) & 0xffffu;
                qes[p * LS + d] = (bf16)qw; kes[p * LS + d] = (bf16)kw[u]; }
            kt[s2 >> 1] = kw[0] | (kw[1] << 16);
        }
        { bf16* kp = KET + cidx * 8192 + (size_t)d * 64 + seg * 16; *(u32x4*)kp = (u32x4){kt[0], kt[1], kt[2], kt[3]}; *(u32x4*)(kp + 8) = (u32x4){kt[4], kt[5], kt[6], kt[7]}; }
        __syncthreads();
#pragma unroll
        for (int k2 = 0; k2 < 2; ++k2) { const int p = sr + 32 * k2; *(u32x4*)(QE + ((size_t)dir * T + row0 + p) * 512 + h * 128 + 8 * so) = *(const LAS u32x4*)(qes + p * LS + 8 * so); }
        { const int jt = wave & 3;
#pragma unroll
          for (int ii = 0; ii < 2; ++ii) { const int itile = 2 * (wave >> 2) + ii;
            f32x4 acc = (f32x4){0.f, 0.f, 0.f, 0.f};
            const bool dead = dir ? (jt < itile) : (jt > itile);
            if (!dead) {
#pragma unroll
                for (int ks = 0; ks < 4; ++ks) { const bf16x8 kf = *(const LAS bf16x8*)(kes + (jt * 16 + fr) * LS + ks * 32 + 8 * fq), qf = *(const LAS bf16x8*)(qes + (itile * 16 + fr) * LS + ks * 32 + 8 * fq);
                    acc = __builtin_amdgcn_mfma_f32_16x16x32_bf16(kf, qf, acc, 0, 0, 0); }
            }
            const int i = itile * 16 + fr, j0 = jt * 16 + 4 * fq; float pv[4];
#pragma unroll
            for (int jj = 0; jj < 4; ++jj) { const int j = j0 + jj; const bool keep = dir ? (j >= i) : (j <= i); pv[jj] = keep ? acc[jj] : 0.f; }
            u32x2 o; o.x = cvt_pk_bf16(pv[0], pv[1]); o.y = cvt_pk_bf16(pv[2], pv[3]);
            *(u32x2*)(PP + cidx * 4096 + (size_t)i * 64 + j0) = o; } }
        if (dir == 0) {
            const int e = tid & 255, jh = tid >> 8; unsigned w[16];
#pragma unroll
            for (int jj = 0; jj < 32; jj += 2) w[jj >> 1] = (unsigned)vraw[(jh * 32 + jj) * VLS + e] | ((unsigned)vraw[(jh * 32 + jj + 1) * VLS + e] << 16);
            bf16* vp = VT + ((size_t)((b * 4 + h) * 64 + chunk) * 256 + e) * 64 + jh * 32;
#pragma unroll
            for (int q4 = 0; q4 < 4; ++q4) *(u32x4*)(vp + 8 * q4) = (u32x4){w[4 * q4], w[4 * q4 + 1], w[4 * q4 + 2], w[4 * q4 + 3]};
        }
        __syncthreads();
    }
}
#undef PF_LOAD
__device__ __forceinline__ void phase_gla_scan(KA a, LAS unsigned char* lds, int tid, int bx, int G) {
    const int lane = tid & 63, wave = __builtin_amdgcn_readfirstlane(tid >> 6), fr = lane & 15, fq = lane >> 4;
    unsigned char* ws = a->ws;
    const char* QE = (const char*)(ws + WS_QE); const char* KET = (const char*)(ws + WS_KET); const char* PP = (const char*)(ws + WS_P); const char* VT = (const char*)(ws + WS_VT); const float* EL = (const float*)(ws + WS_EL);
    constexpr int SS = 136, ST_BYTES = 2 * 64 * SS * 2, BUFB = 50176, OQ = 0, OP = 16384, OK_ = 24576, OV = 40960, OE = 49152;
    LAS bf16* ST = (LAS bf16*)lds;
    LAS unsigned char* BUF = lds + ST_BYTES;
    const int et0 = 2 * (wave & 1), dt0 = 2 * (wave >> 1), itile = wave >> 1;
    const int rq = lane >> 4, pq = lane & 15, r8 = lane >> 3, p8 = lane & 7;
    unsigned sq[2], sk[2], sp, sv;
#pragma unroll
    for (int j = 0; j < 2; ++j) { const int r = 4 * (wave + 8 * j) + rq; sq[j] = (unsigned)(r * 1024 + ((pq ^ (r & 15)) * 16)); const int dk = 8 * (wave + 8 * j) + r8; sk[j] = (unsigned)(dk * 128 + ((p8 ^ ((dk >> 1) & 7)) * 16)); }
    { const int r = 8 * wave + r8; sp = (unsigned)(r * 128 + ((p8 ^ ((r >> 1) & 7)) * 16)); sv = sp; }
    const int kx = fr >> 1;
    for (int it0 = bx; it0 < 256; it0 += G) {
        const int it = (G == 256) ? ((it0 & 7) * 32 + (it0 >> 3)) : it0;
        const int b = it >> 5, h = (it >> 3) & 3, dir = (it >> 2) & 1, es = it & 3;
        bf16* OO = (bf16*)(ws + (dir ? WS_OB : WS_OF));
        __syncthreads();
        for (int i = tid; i < 64 * SS / 2; i += NTHREADS) ((LAS unsigned*)ST)[i] = 0u;
        f32x4 accS[2][2];
#pragma unroll
        for (int x = 0; x < 2; ++x)
#pragma unroll
            for (int y = 0; y < 2; ++y) accS[x][y] = (f32x4){0.f, 0.f, 0.f, 0.f};
        const size_t cbase = (size_t)((dir * 8 + b) * 4 + h) * 64;
        const char* qsrc = QE + (((size_t)dir * T + (size_t)b * SEQ) * 512 + h * 128) * 2;
        const char* psrc = PP + cbase * 8192;
        const char* ksrc = KET + cbase * 16384;
        const char* vsrc = VT + ((size_t)(b * 4 + h) * 64 * 256 + es * 64) * 128;
        const char* esrc = (const char*)(EL + cbase * 128);
        char* ob = (char*)(OO + ((size_t)b * SEQ + itile * 16) * D + h * 256 + es * 64 + et0 * 16);
        const unsigned le = (unsigned)fq * 16u, lo = (unsigned)(fr * D + 4 * fq) * 2u;
#define SC_DMA(c_, bi_) do { const size_t c__ = (size_t)(c_); LAS unsigned char* bb_ = BUF + (bi_) * BUFB + wave * 1024; \
            __builtin_amdgcn_global_load_lds((const unsigned*)(qsrc + c__ * 65536 + sq[0]), (LAS unsigned*)(bb_ + OQ), 16, 0, 0); \
            __builtin_amdgcn_global_load_lds((const unsigned*)(qsrc + c__ * 65536 + sq[1]), (LAS unsigned*)(bb_ + OQ + 8192), 16, 0, 0); \
            __builtin_amdgcn_global_load_lds((const unsigned*)(psrc + c__ * 8192 + sp), (LAS unsigned*)(bb_ + OP), 16, 0, 0); \
            __builtin_amdgcn_global_load_lds((const unsigned*)(ksrc + c__ * 16384 + sk[0]), (LAS unsigned*)(bb_ + OK_), 16, 0, 0); \
            __builtin_amdgcn_global_load_lds((const unsigned*)(ksrc + c__ * 16384 + sk[1]), (LAS unsigned*)(bb_ + OK_ + 8192), 16, 0, 0); \
            __builtin_amdgcn_global_load_lds((const unsigned*)(vsrc + c__ * 32768 + sv), (LAS unsigned*)(bb_ + OV), 16, 0, 0); \
            if (wave == 0) __builtin_amdgcn_global_load_lds((const unsigned*)(esrc + c__ * 512 + lane * 16), (LAS unsigned*)(BUF + (bi_) * BUFB + OE), 16, 0, 0); } while (0)
        SC_DMA(dir ? 63 : 0, 0);
        asm volatile("s_waitcnt vmcnt(0)" ::: "memory");
        __syncthreads();
#pragma unroll 1
        for (int cc = 0; cc < 64; ++cc) {
            const int c = dir ? 63 - cc : cc;
            if (cc + 1 < 64) SC_DMA(dir ? 62 - cc : cc + 1, (cc + 1) & 1);
            const LAS unsigned char* B = BUF + (cc & 1) * BUFB;
            const f32x4 el0 = *(const LAS f32x4*)(B + OE + dt0 * 64 + le), el1 = *(const LAS f32x4*)(B + OE + dt0 * 64 + 64 + le);
            const LAS bf16* Sr = ST + (cc & 1) * 64 * SS; LAS bf16* Sw = ST + ((cc + 1) & 1) * 64 * SS;
            bf16x8 qf[4], pf[2], vf[2][2];
#pragma unroll
            for (int ks = 0; ks < 4; ++ks) qf[ks] = *(const LAS bf16x8*)(B + OQ + (itile * 16 + fr) * 256 + (((4 * ks + fq) ^ fr) * 16));
#pragma unroll
            for (int ks = 0; ks < 2; ++ks) pf[ks] = *(const LAS bf16x8*)(B + OP + (itile * 16 + fr) * 128 + (((4 * ks + fq) ^ kx) * 16));
#pragma unroll
            for (int et = 0; et < 2; ++et)
#pragma unroll
                for (int ks = 0; ks < 2; ++ks) vf[et][ks] = *(const LAS bf16x8*)(B + OV + ((et0 + et) * 16 + fr) * 128 + (((4 * ks + fq) ^ kx) * 16));
#pragma unroll
            for (int et = 0; et < 2; ++et) { f32x4 ao = (f32x4){0.f, 0.f, 0.f, 0.f};
#pragma unroll
                for (int ks = 0; ks < 4; ++ks) { const bf16x8 sf = *(const LAS bf16x8*)(Sr + ((et0 + et) * 16 + fr) * SS + ks * 32 + 8 * fq); ao = __builtin_amdgcn_mfma_f32_16x16x32_bf16(sf, qf[ks], ao, 0, 0, 0); }
#pragma unroll
                for (int ks = 0; ks < 2; ++ks) ao = __builtin_amdgcn_mfma_f32_16x16x32_bf16(vf[et][ks], pf[ks], ao, 0, 0, 0);
                u32x2 o; o.x = cvt_pk_bf16(ao[0], ao[1]); o.y = cvt_pk_bf16(ao[2], ao[3]);
                *(u32x2*)(ob + (size_t)c * (64 * D * 2) + et * 32 + lo) = o; }
#pragma unroll
            for (int dt = 0; dt < 2; ++dt) { bf16x8 kf[2];
#pragma unroll
                for (int ks = 0; ks < 2; ++ks) kf[ks] = *(const LAS bf16x8*)(B + OK_ + ((dt0 + dt) * 16 + fr) * 128 + (((4 * ks + fq) ^ kx) * 16));
#pragma unroll
                for (int et = 0; et < 2; ++et) {
#pragma unroll
                    for (int ks = 0; ks < 2; ++ks) accS[dt][et] = __builtin_amdgcn_mfma_f32_16x16x32_bf16(kf[ks], vf[et][ks], accS[dt][et], 0, 0, 0);
                    accS[dt][et] = accS[dt][et] * (dt ? el1 : el0);
                    u32x2 o; o.x = cvt_pk_bf16(accS[dt][et][0], accS[dt][et][1]); o.y = cvt_pk_bf16(accS[dt][et][2], accS[dt][et][3]);
                    *(LAS u32x2*)(Sw + ((et0 + et) * 16 + fr) * SS + (dt0 + dt) * 16 + 4 * fq) = o; } }
            asm volatile("s_waitcnt vmcnt(0)" ::: "memory");
            __syncthreads();
        }
#undef SC_DMA
    }
}

__device__ __forceinline__ void phase_gla_post(KA a, int li, int tid, int bx, int G) {
    const int lane = tid & 63, wave = tid >> 6;
    const bf16* of = (const bf16*)(a->ws + WS_OF); const bf16* ob = (const bf16*)(a->ws + WS_OB); const bf16* qkvr = (const bf16*)(a->ws + WS_BIG); bf16* A2 = (bf16*)(a->ws + WS_A2);
    const float* ng = a->in[I_GNORM] + (size_t)li * 256 + (lane & 15) * 16;
    float g[16];
#pragma unroll
    for (int j = 0; j < 16; ++j) g[j] = ng[j];
    for (int token = bx * NWAVES + wave; token < T; token += G * NWAVES) {
        const u32x4 f0 = *(const u32x4*)(of + (size_t)token * D + 16 * lane), f1 = *(const u32x4*)(of + (size_t)token * D + 16 * lane + 8);
        const u32x4 b0 = *(const u32x4*)(ob + (size_t)token * D + 16 * lane), b1 = *(const u32x4*)(ob + (size_t)token * D + 16 * lane + 8);
        const u32x4 r0 = *(const u32x4*)(qkvr + (size_t)token * GLA_MAIN + 2048 + 16 * lane), r1 = *(const u32x4*)(qkvr + (size_t)token * GLA_MAIN + 2048 + 16 * lane + 8);
        float o[16], r[16];
#pragma unroll
        for (int q = 0; q < 4; ++q) { o[2 * q] = bf_lo(f0[q]) + bf_lo(b0[q]); o[2 * q + 1] = bf_hi(f0[q]) + bf_hi(b0[q]); o[8 + 2 * q] = bf_lo(f1[q]) + bf_lo(b1[q]); o[8 + 2 * q + 1] = bf_hi(f1[q]) + bf_hi(b1[q]);
            r[2 * q] = bf_lo(r0[q]); r[2 * q + 1] = bf_hi(r0[q]); r[8 + 2 * q] = bf_lo(r1[q]); r[8 + 2 * q + 1] = bf_hi(r1[q]); }
        float ss = 0.f;
#pragma unroll
        for (int j = 0; j < 16; ++j) ss += o[j] * o[j];
        ss += shfl_xor_f(ss, 1, lane); ss += shfl_xor_f(ss, 2, lane); ss += shfl_xor_f(ss, 4, lane); ss += shfl_xor_f(ss, 8, lane);
        const float rstd = 1.0f / sqrtf(ss * (1.0f / 256.0f) + LN_EPS);
        unsigned w[8];
#pragma unroll
        for (int q = 0; q < 8; ++q) w[q] = cvt_pk_bf16(o[2 * q] * rstd * g[2 * q] * silu_f(r[2 * q]), o[2 * q + 1] * rstd * g[2 * q + 1] * silu_f(r[2 * q + 1]));
        *(u32x4*)(A2 + (size_t)token * D + 16 * lane) = (u32x4){w[0], w[1], w[2], w[3]}; *(u32x4*)(A2 + (size_t)token * D + 16 * lane + 8) = (u32x4){w[4], w[5], w[6], w[7]};
    }
}

__device__ __forceinline__ void phase_sgu_core(KA a, int li, LAS unsigned char* lds, int tid, int bx, int G) {
    const int lane = tid & 63, wave = __builtin_amdgcn_readfirstlane(tid >> 6), fr = lane & 15, fq = lane >> 4;
    unsigned char* ws = a->ws;
    const bf16* z = (const bf16*)(ws + WS_BIG); bf16* A2 = (bf16*)(ws + WS_A2);
    const float* lng = a->in[I_SLNG] + (size_t)li * 1024; const float* lnb = a->in[I_SLNB] + (size_t)li * 1024;
    const bf16* wsp = (const bf16*)(ws + WS_SGUWS) + (size_t)li * 8 * 128 * 128; const float* bs = a->in[I_SBS] + (size_t)li * 8 * 128;
    constexpr int VS = 132;
    LAS bf16* vn = (LAS bf16*)lds;
    LAS float* st_mean = (LAS float*)(lds + 2 * 128 * VS * 2); LAS float* st_rstd = st_mean + 128;
    const int co = tid & 15, qr = tid >> 4;
    for (int it = bx; it < T / 128; it += G) {
        const int row0 = it * 128;
        __syncthreads();
#pragma unroll 1
        for (int rr = 0; rr < 16; ++rr) { const int q = wave * 16 + rr; const bf16* vp = z + (size_t)(row0 + q) * 2048 + 1024 + 16 * lane;
            const u32x4 v0 = *(const u32x4*)vp, v1 = *(const u32x4*)(vp + 8); float x[16];
#pragma unroll
            for (int k = 0; k < 4; ++k) { x[2 * k] = bf_lo(v0[k]); x[2 * k + 1] = bf_hi(v0[k]); x[8 + 2 * k] = bf_lo(v1[k]); x[8 + 2 * k + 1] = bf_hi(v1[k]); }
            float s1 = 0.f;
#pragma unroll
            for (int k = 0; k < 16; ++k) s1 += x[k];
            const float mean = wave_sum(s1, lane) * (1.0f / 1024.0f); float s2 = 0.f;
#pragma unroll
            for (int k = 0; k < 16; ++k) { const float dd = x[k] - mean; s2 += dd * dd; }
            const float rstd = 1.0f / sqrtf(wave_sum(s2, lane) * (1.0f / 1024.0f) + LN_EPS);
            if (lane == 0) { st_mean[q] = mean; st_rstd[q] = rstd; } }
        __syncthreads();
        const int p = wave * 16 + fr;
#pragma unroll 1
        for (int g = 0; g < 8; ++g) {
            LAS bf16* vb = vn + (g & 1) * 128 * VS;
            {
                const f32x4 g0 = *(const f32x4*)(lng + g * 128 + 8 * co), g1 = *(const f32x4*)(lng + g * 128 + 8 * co + 4), b0 = *(const f32x4*)(lnb + g * 128 + 8 * co), b1 = *(const f32x4*)(lnb + g * 128 + 8 * co + 4);
#pragma unroll
                for (int k = 0; k < 4; ++k) { const int q = qr + 32 * k; const u32x4 w = *(const u32x4*)(z + (size_t)(row0 + q) * 2048 + 1024 + g * 128 + 8 * co);
                    const float m = st_mean[q], r = st_rstd[q];
                    u32x2 o0, o1;
                    o0.x = cvt_pk_bf16((bf_lo(w.x) - m) * r * g0[0] + b0[0], (bf_hi(w.x) - m) * r * g0[1] + b0[1]); o0.y = cvt_pk_bf16((bf_lo(w.y) - m) * r * g0[2] + b0[2], (bf_hi(w.y) - m) * r * g0[3] + b0[3]);
                    o1.x = cvt_pk_bf16((bf_lo(w.z) - m) * r * g1[0] + b1[0], (bf_hi(w.z) - m) * r * g1[1] + b1[1]); o1.y = cvt_pk_bf16((bf_lo(w.w) - m) * r * g1[2] + b1[2], (bf_hi(w.w) - m) * r * g1[3] + b1[3]);
                    *(LAS u32x2*)(vb + q * VS + 8 * co) = o0; *(LAS u32x2*)(vb + q * VS + 8 * co + 4) = o1; }
            }
            bf16x8 wf[4];
#pragma unroll
            for (int ks = 0; ks < 4; ++ks) wf[ks] = *(const bf16x8*)(wsp + ((size_t)g * 128 + p) * 128 + ks * 32 + 8 * fq);
            const float bias = bs[g * 128 + p];
            __syncthreads();
#pragma unroll 2
            for (int ct = 0; ct < 8; ++ct) {
                f32x4 acc = (f32x4){0.f, 0.f, 0.f, 0.f};
#pragma unroll
                for (int ks = 0; ks < 4; ++ks) { const LAS bf16* sp = vb + (ks * 32 + 8 * fq) * VS + ct * 16 + fr; unsigned w4[4];
#pragma unroll
                    for (int j2 = 0; j2 < 4; ++j2) w4[j2] = (unsigned)sp[(2 * j2) * VS] | ((unsigned)sp[(2 * j2 + 1) * VS] << 16);
                    const bf16x8 vf = __builtin_bit_cast(bf16x8, (u32x4){w4[0], w4[1], w4[2], w4[3]});
                    acc = __builtin_amdgcn_mfma_f32_16x16x32_bf16(vf, wf[ks], acc, 0, 0, 0); }
                const int c0 = g * 128 + ct * 16 + 4 * fq;
                const u32x2 uu = *(const u32x2*)(z + (size_t)(row0 + p) * 2048 + c0);
                u32x2 o; o.x = cvt_pk_bf16(bf_lo(uu.x) * (acc[0] + bias), bf_hi(uu.x) * (acc[1] + bias)); o.y = cvt_pk_bf16(bf_lo(uu.y) * (acc[2] + bias), bf_hi(uu.y) * (acc[3] + bias));
                *(u32x2*)(A2 + (size_t)(row0 + p) * D + c0) = o;
            }
        }
    }
}

constexpr int PH_PER_LAYER = 10;
constexpr int NPHASES = 2 + PH_PER_LAYER * DEPTH;
#define GEMM_BODY(A, g, K, S, E) gemm_fast<false, false>(A, g, K, S, E, lds, tid)
#define GEMM_BODY_G(A, g, K, S, E) gemm_fast<true, false>(A, g, K, S, E, lds, tid)
#define GEMM_BODY8(A, g, K, S, E) gemm_fast<false, true>(A, g, K, S, E, lds, tid)
#define GEMM_BODY8_G(A, g, K, S, E) gemm_fast<true, true>(A, g, K, S, E, lds, tid)
__device__ __forceinline__ void ph_prologue(int wave_s) { PHASE_ENTER(); phase_prologue(a, lds, tid, bx, G); }
__device__ __forceinline__ void ph_rp_init(int wave_s) { PHASE_ENTER(); float* mod = (float*)(ws + WS_MOD);
    RowPass p{}; p.xin = a->in[I_X]; p.hout = (bf16*)(ws + WS_H); p.sc = mod + 1 * 1024; p.sh = mod + 0 * 1024; p.wside = (const bf16*)(ws + WS_GLALR_T); p.lr_out = (float*)(ws + WS_LR); p.has_h = 1; p.has_side = 1;
    row_pass<0>(p, lds, tid, bx, G); }
__device__ __forceinline__ void ph_gla_in(int wave_s, int li) { PHASE_ENTER(); Sched S; S.init(T / 256, GLA_MAIN / 256, G, bx, (const bf16*)(ws + WS_GLAIN_T) + (size_t)li * GLA_MAIN * 1024, 0, nullptr, 2048); EpiGlaIn E{(bf16*)(ws + WS_BIG)}; GEMM_BODY((const bf16*)(ws + WS_H), nullptr, 1024, S, E); }
__device__ __forceinline__ void ph_sgu_in(int wave_s, int li) { PHASE_ENTER(); Sched S; S.init(T / 256, 2048 / 256, G, bx, (const bf16*)(ws + WS_SGUIN_T) + (size_t)li * 2048 * 1024, 0, nullptr, 2048); EpiSguIn E{(bf16*)(ws + WS_BIG), a->in[I_SBIN] + (size_t)li * 2048}; GEMM_BODY((const bf16*)(ws + WS_H), nullptr, 1024, S, E); }
__device__ __forceinline__ void ph_gla_prep(int wave_s, int li) { PHASE_ENTER(); phase_gla_prep(a, li, lds, tid, bx, G); }
__device__ __forceinline__ void ph_gla_scan(int wave_s) { PHASE_ENTER(); phase_gla_scan(a, lds, tid, bx, G); }
__device__ __forceinline__ void ph_sgu_core(int wave_s, int li) { PHASE_ENTER(); phase_sgu_core(a, li, lds, tid, bx, G); }
__device__ __forceinline__ void ph_gla_post(int wave_s, int li) { PHASE_ENTER(); phase_gla_post(a, li, tid, bx, G); }
__device__ __forceinline__ void ph_out(int wave_s, int l) { PHASE_ENTER(); const int li = l >> 1; const bool sgu = (l & 1) != 0;
    Sched S; S.init(T / 256, 4, G, bx, (const bf16*)(ws + (sgu ? WS_SGUOUT_T : WS_GLAOUT_T)) + (size_t)li * 1024 * 1024, 0, nullptr, 2048);
    EpiOut E{(bf16*)(ws + WS_Y), sgu ? a->in[I_SBOUT] + (size_t)li * 1024 : nullptr}; GEMM_BODY((const bf16*)(ws + WS_A2), nullptr, 1024, S, E); }
__device__ __forceinline__ void ph_rp_mid(int wave_s, int l) { PHASE_ENTER(); float* modl = (float*)(ws + WS_MOD) + (size_t)l * 8 * 6144; int* route = (int*)(ws + WS_ROUTE);
    RowPass p{}; p.xin = (l == 0) ? (const void*)a->in[I_X] : (const void*)(ws + WS_X2); p.xin16 = (l != 0); p.y = (const bf16*)(ws + WS_Y); p.xout = ws + WS_X1; p.xout16 = 1; p.hout = (bf16*)(ws + WS_H);
    p.gate = modl + 2 * 1024; p.lng = a->in[I_LNG] + (size_t)(l * 2 + 0) * 1024; p.lnb = a->in[I_LNB] + (size_t)(l * 2 + 0) * 1024; p.sc = modl + 4 * 1024; p.sh = modl + 3 * 1024;
    p.wside = (const bf16*)(ws + WS_ROUTER_T) + (size_t)l * 64 * 1024; p.rbias = a->in[I_RB] + (size_t)l * 32;
    p.topi = route + R_TOPI; p.topw = (float*)(route + R_TOPW); p.hist = route + R_HIST + bx * 32; p.has_h = 1; p.has_side = 1; p.h8out = MOE_FP8 ? (ws + WS_H8) : nullptr;
    row_pass<1>(p, lds, tid, bx, G); }
__device__ __forceinline__ void ph_place(int wave_s) { PHASE_ENTER(); phase_place((int*)(ws + WS_ROUTE), lds, tid, bx, G); }
__device__ __forceinline__ void ph_moe_up(int wave_s, int l) { PHASE_ENTER(); int* route = (int*)(ws + WS_ROUTE); const int ntiles = __builtin_amdgcn_readfirstlane(route[R_NTILES]);
#if MOE_FP8
    Sched S; S.init(ntiles, 8, G, bx, ws + WS_WUP_T + (size_t)l * 32 * 2048 * 1024, (size_t)2048 * 1024, route + R_TILEE, 1024);
    EpiUp<true> E{ws + WS_ACT, a->in[I_BUP] + (size_t)l * 32 * 2048}; GEMM_BODY8_G(ws + WS_H8, route + R_BUFTOK, 1024, S, E); }
#else
    Sched S; S.init(ntiles, 8, G, bx, ws + WS_WUP_T + (size_t)l * 32 * 2048 * 2048, (size_t)2048 * 2048, route + R_TILEE, 2048);
    EpiUp<false> E{ws + WS_ACT, a->in[I_BUP] + (size_t)l * 32 * 2048}; GEMM_BODY_G(ws + WS_H, route + R_BUFTOK, 1024, S, E); }
#endif
__device__ __forceinline__ void ph_moe_down(int wave_s, int l) { PHASE_ENTER(); int* route = (int*)(ws + WS_ROUTE); const int ntiles = __builtin_amdgcn_readfirstlane(route[R_NTILES]);
#if MOE_FP8
    Sched S; S.init(ntiles, 4, G, bx, ws + WS_WDN_T + (size_t)l * 32 * 1024 * 1024, (size_t)1024 * 1024, route + R_TILEE, 1024);
    EpiDown8 E{ws + WS_YS, a->in[I_BDN] + (size_t)l * 32 * 1024, 1.0f / (F8_WSCALE * F8_ASCALE)}; GEMM_BODY8(ws + WS_ACT, nullptr, 1024, S, E); }
#else
    Sched S; S.init(ntiles, 4, G, bx, ws + WS_WDN_T + (size_t)l * 32 * 1024 * 2048, (size_t)1024 * 2048, route + R_TILEE, 2048);
    EpiDown E{(bf16*)(ws + WS_YS), a->in[I_BDN] + (size_t)l * 32 * 1024, 1.0f}; GEMM_BODY(ws + WS_ACT, nullptr, 1024, S, E); }
#endif
__device__ __forceinline__ void ph_rp_end(int wave_s, int l) { PHASE_ENTER(); float* mod = (float*)(ws + WS_MOD); float* modl = mod + (size_t)l * 8 * 6144; int* route = (int*)(ws + WS_ROUTE);
    RowPass p{}; p.xin = ws + WS_X1; p.xin16 = 1; p.xout = (l == DEPTH - 1) ? (void*)a->out : (void*)(ws + WS_X2); p.xout16 = (l != DEPTH - 1); p.hout = (bf16*)(ws + WS_H);
    p.gate = modl + 5 * 1024; p.lng = a->in[I_LNG] + (size_t)(l * 2 + 1) * 1024; p.lnb = a->in[I_LNB] + (size_t)(l * 2 + 1) * 1024;
    p.ys = ws + WS_YS; p.dest = route + R_DEST; p.tw = (const float*)(route + R_TOPW);
    if (l < DEPTH - 1) { float* modn = mod + (size_t)(l + 1) * 8 * 6144; p.sc = modn + 1 * 1024; p.sh = modn + 0 * 1024; p.has_h = 1;
        if (((l + 1) & 1) == 0) { p.has_side = 1; p.wside = (const bf16*)(ws + WS_GLALR_T) + (size_t)((l + 1) >> 1) * 64 * 1024; p.lr_out = (float*)(ws + WS_LR); } }
    row_pass<2>(p, lds, tid, bx, G); }

__global__ void __launch_bounds__(NTHREADS, 2) fwd_kernel(Args a) {
    extern __shared__ __attribute__((aligned(16))) unsigned char lds_raw[];
    LAS unsigned char* lds = (LAS unsigned char*)lds_raw;
    volatile LAS unsigned* MISC = (volatile LAS unsigned*)(lds + MISC_OFF);
    const int tid = threadIdx.x; const int wave_s = __builtin_amdgcn_readfirstlane(tid >> 6);
    if (tid < 32) ((LAS unsigned*)(lds + MISC_OFF))[tid] = 0u;
    __syncthreads();
    unsigned* ctl = (unsigned*)(a.ws + WS_CTL);
    XcdBarrier bar = xcd_barrier_post(ctl + CW_BAR + a.li * XCD_BAR_WORDS, MISC + 8);
    const int lo = a.ph_lo, hi = a.ph_hi;
#ifndef REPK
#define REPK 0
#define REPN 1
#endif
#define REP(kind) for (int rep_ = 0; rep_ < ((REPK == (kind)) ? REPN : 1); ++rep_)
#define IN(k) (lo <= (k) && (k) < hi)
#define SEAM(k) do { if (IN(k) && IN((k) + 1)) xcd_barrier(bar); } while (0)
    if (IN(0)) { REP(3) ph_prologue(wave_s); SEAM(0); }
    if (IN(1)) { ph_rp_init(wave_s); SEAM(1); }
    for (int l = 0; l < DEPTH; ++l) {
        const int pb = 2 + PH_PER_LAYER * l, li = l >> 1; const bool sgu = (l & 1) != 0;
        if (IN(pb + 0)) { REP(10) { if (!sgu) ph_gla_in(wave_s, li); else ph_sgu_in(wave_s, li); } SEAM(pb + 0); }
        if (IN(pb + 1)) { if (!sgu) { REP(12) ph_gla_prep(wave_s, li); SEAM(pb + 1); } }
        if (IN(pb + 2)) { if (!sgu) { REP(1) ph_gla_scan(wave_s); } else { REP(2) ph_sgu_core(wave_s, li); } SEAM(pb + 2); }
        if (IN(pb + 3)) { if (!sgu) { REP(6) ph_gla_post(wave_s, li); SEAM(pb + 3); } }
        if (IN(pb + 4)) { REP(11) ph_out(wave_s, l); SEAM(pb + 4); }
        if (IN(pb + 5)) { REP(4) ph_rp_mid(wave_s, l); SEAM(pb + 5); }
        if (IN(pb + 6)) { REP(7) ph_place(wave_s); SEAM(pb + 6); }
        if (IN(pb + 7)) { REP(8) ph_moe_up(wave_s, l); SEAM(pb + 7); }
        if (IN(pb + 8)) { REP(9) ph_moe_down(wave_s, l); SEAM(pb + 8); }
        if (IN(pb + 9)) { REP(5) ph_rp_end(wave_s, l); SEAM(pb + 9); }
    }
#undef IN
#undef SEAM
}

#ifndef N_LAUNCH_MODE
#define N_LAUNCH_MODE 1
#endif
extern "C" void kernel_launch(void* const* d_in, const int* in_sizes, int n_in, void* d_out, int out_size, void* d_ws, size_t ws_size, hipStream_t stream) {
    static int grid = 0;
    if (grid == 0) {
        if (n_in != 27 || out_size != T * D || ws_size < WS_END) { fprintf(stderr, "kernel_launch: unexpected shapes (n_in %d out %d ws %zu)\n", n_in, out_size, ws_size); grid = -1; return; }
        int dev = 0, cus = 0, per_cu = 0;
        if (hipGetDevice(&dev) != hipSuccess || hipDeviceGetAttribute(&cus, hipDeviceAttributeMultiprocessorCount, dev) != hipSuccess) { grid = -1; return; }
        if (hipFuncSetAttribute((const void*)fwd_kernel, hipFuncAttributeMaxDynamicSharedMemorySize, LDS_BYTES) != hipSuccess) { fprintf(stderr, "kernel_launch: hipFuncSetAttribute failed\n"); grid = -1; return; }
        if (hipOccupancyMaxActiveBlocksPerMultiprocessor(&per_cu, (const void*)fwd_kernel, NTHREADS, LDS_BYTES) != hipSuccess || per_cu < 1) fprintf(stderr, "kernel_launch: occupancy query reports %d\n", per_cu);
        (void)hipGetLastError();
        grid = cus;
        if (grid > 1024) grid = 1024;
    }
    if (grid < 0) return;
    (void)hipMemsetAsync((char*)d_ws + WS_CTL, 0, CTL_ZERO_BYTES, stream);
    Args a{};
    for (int i = 0; i < 27; ++i) a.in[i] = (const float*)d_in[i];
    a.out = (float*)d_out; a.ws = (unsigned char*)d_ws; a.pad = 0;
#if N_LAUNCH_MODE == 1
    a.ph_lo = 0; a.ph_hi = NPHASES; a.li = 0;
    hipLaunchKernelGGL(fwd_kernel, dim3(grid), dim3(NTHREADS), LDS_BYTES, stream, a);
#else
    for (int ph = 0, li = 0; ph < NPHASES; ++ph) {
        if (ph >= 2 && (((ph - 2) % PH_PER_LAYER) == 1 || ((ph - 2) % PH_PER_LAYER) == 3) && (((ph - 2) / PH_PER_LAYER) & 1)) continue;
        a.ph_lo = ph; a.ph_hi = ph + 1; a.li = li++;
        hipLaunchKernelGGL(fwd_kernel, dim3(grid), dim3(NTHREADS), LDS_BYTES, stream, a);
    }
#endif
}
```

```cpp
#include <hip/hip_runtime.h>
#include <cstdio>
#include <cstdint>

#define LAS __attribute__((address_space(3)))
#define GAS __attribute__((address_space(1)))
typedef unsigned short bf16;
typedef short bf16x8 __attribute__((ext_vector_type(8)));
typedef float f32x4 __attribute__((ext_vector_type(4)));
typedef float f32x2 __attribute__((ext_vector_type(2)));
typedef unsigned u32x4 __attribute__((ext_vector_type(4)));
typedef unsigned u32x2 __attribute__((ext_vector_type(2)));
typedef int i32x4 __attribute__((ext_vector_type(4)));
typedef int i32x8 __attribute__((ext_vector_type(8)));

#ifndef MOE_FP8
#define MOE_FP8 1
#endif
constexpr int D = 1024, NB = 8, SEQ = 4096, T = NB * SEQ, DEPTH = 4;
constexpr int NE = 32, TOPK = 4, CAP = T * TOPK + NE * 256;
constexpr int MAXTILES = CAP / 256;
constexpr float ALPHA = 1.681792830507429f;
constexpr float LN_EPS = 1e-5f;
constexpr float F8_WSCALE = 64.0f, F8_HSCALE = 8.0f, F8_ASCALE = 4.0f, F8_YSCALE = 64.0f;
constexpr int GLA_IN = 3104, GLA_MAIN = 3072;
constexpr int NWAVES = 8, NTHREADS = 512;
constexpr int LDS_BYTES = 147456, MISC_OFF = 139264;

constexpr size_t MiB = 1u << 20;
constexpr size_t WS_CTL = 0, CTL_ZERO_BYTES = 2 * MiB;
constexpr size_t WS_MOD = 2 * MiB;
constexpr size_t WS_ROUTE = 4 * MiB;
constexpr size_t WS_LR = 8 * MiB;
constexpr size_t WS_GLAIN_T = 16 * MiB;
constexpr size_t WS_GLALR_T = 28 * MiB;
constexpr size_t WS_ROUTER_T = 29 * MiB;
constexpr size_t WS_SGUWS = 30 * MiB;
constexpr size_t WS_GLAOUT_T = 32 * MiB;
constexpr size_t WS_SGUIN_T = 36 * MiB;
constexpr size_t WS_SGUOUT_T = 44 * MiB;
constexpr size_t WS_WUP_T = 64 * MiB;
constexpr size_t WS_WDN_T = 576 * MiB;
constexpr size_t WS_X1 = 832 * MiB;
constexpr size_t WS_X2 = 960 * MiB;
constexpr size_t WS_H = 1088 * MiB;
constexpr size_t WS_BIG = 1152 * MiB;
constexpr size_t WS_OF = 1344 * MiB;
constexpr size_t WS_OB = 1408 * MiB;
constexpr size_t WS_A2 = 1472 * MiB;
constexpr size_t WS_Y = 1536 * MiB;
constexpr size_t WS_ACT = 1664 * MiB;
constexpr size_t WS_YS = 1936 * MiB;
constexpr size_t WS_QE = 2208 * MiB;
constexpr size_t WS_KET = 2272 * MiB;
constexpr size_t WS_P = 2336 * MiB;
constexpr size_t WS_VT = 2368 * MiB;
constexpr size_t WS_EL = 2432 * MiB;
constexpr size_t WS_H8 = 2440 * MiB;
constexpr size_t WS_END = 2472 * MiB;
constexpr int R_TOPI = 0;
constexpr int R_TOPW = T * 4;
constexpr int R_DEST = 2 * T * 4;
constexpr int R_BUFTOK = 3 * T * 4;
constexpr int R_HIST = R_BUFTOK + CAP;
constexpr int R_TILEE = R_HIST + 1024 * 32;
constexpr int R_NTILES = R_TILEE + 1024;
static_assert((size_t)(R_NTILES + 64) * 4 <= 4 * MiB, "route tables");
constexpr int CW_BAR = 4096;
constexpr int MAX_LAUNCH = 64;

#define RLX_AGENT __ATOMIC_RELAXED, __HIP_MEMORY_SCOPE_AGENT
#define LDS_WAIT() asm volatile("s_waitcnt lgkmcnt(0)" ::: "memory")
#define VM_WAIT() asm volatile("s_waitcnt vmcnt(0)" ::: "memory")
typedef __bf16 bf16x2_t __attribute__((ext_vector_type(2)));
__device__ __forceinline__ unsigned cvt_pk_bf16(float lo, float hi) { const f32x2 v = {lo, hi}; const bf16x2_t r = __builtin_convertvector(v, bf16x2_t); return __builtin_bit_cast(unsigned, r); }
__device__ __forceinline__ float bf_lo(unsigned w) { return __uint_as_float(w << 16); }
__device__ __forceinline__ float bf_hi(unsigned w) { return __uint_as_float(w & 0xffff0000u); }
__device__ __forceinline__ float bf2f(bf16 b) { return __uint_as_float(((unsigned)b) << 16); }
__device__ __forceinline__ float shfl_xor_f(float v, int o, int lane) { return __builtin_bit_cast(float, __builtin_amdgcn_ds_bpermute((lane ^ o) << 2, __builtin_bit_cast(int, v))); }
__device__ __forceinline__ int shfl_i(int v, int src, int lane) { (void)lane; return __builtin_amdgcn_ds_bpermute(src << 2, v); }
__device__ __forceinline__ float wave_sum(float v, int lane) {
#pragma unroll
    for (int o = 1; o < 64; o <<= 1) v += shfl_xor_f(v, o, lane);
    return v;
}
__device__ __forceinline__ float silu_f(float x) { return x * __builtin_amdgcn_rcpf(1.0f + __expf(-x)); }
__device__ __forceinline__ float sigmoid_f(float x) { return __builtin_amdgcn_rcpf(1.0f + __expf(-x)); }
__device__ __forceinline__ float gelu_f(float v) {
    const float av = fabsf(v), t = __builtin_amdgcn_rcpf(av * 0.2316418882f + 1.0f);
    float q = t * 0.5307027145f + (-0.7265760135f); q = q * t + 0.7107068705f; q = q * t + (-0.142248368f); q = q * t + 0.127414796f; q = q * t;
    const float e = __builtin_amdgcn_exp2f((v * v) * (-0.72134752044f));
    const float m = v * (q * e);
    return v < 0.f ? m : v - m;
}

#define XB_TMO      128
#define XB_XCNT(j)  (256  + 64 * (j))
#define XB_XSUB(j)  (1280 + 64 * (j))
#define XB_XGEN(j)  (2304 + 64 * (j))
#define XB_TOP      3328
#define XB_TOPGEN   3392
#define XCD_BAR_WORDS 3456
#define XB_SPIN_CAP (1u << 18)
__device__ __forceinline__ unsigned xb_ld(unsigned* p)              { return __hip_atomic_load(p, __ATOMIC_RELAXED, __HIP_MEMORY_SCOPE_AGENT); }
__device__ __forceinline__ unsigned xb_add(unsigned* p, unsigned v) { return __hip_atomic_fetch_add(p, v, __ATOMIC_RELAXED, __HIP_MEMORY_SCOPE_AGENT); }
__device__ __forceinline__ unsigned xb_xcc_id() { return (unsigned)__builtin_amdgcn_s_getreg((3 << 11) | 20) & 0xFu; }
#define XB_SPIN(cond, bar) do { unsigned _sp = 0; while (cond) { __builtin_amdgcn_s_sleep(1); \
    if ((++_sp & 255u) == 0u) { if (xb_ld(&(bar)[XB_TMO])) break; if (_sp > XB_SPIN_CAP) { atomicAdd(&(bar)[XB_TMO], 1u); break; } } } } while (0)
struct XcdBarrier { unsigned* bar; unsigned x; volatile LAS unsigned* st; };
__device__ __forceinline__ XcdBarrier xcd_barrier_post(unsigned* bar, volatile LAS unsigned* st) {
    XcdBarrier b; b.bar = bar; b.x = xb_xcc_id(); b.st = st;
    if (threadIdx.x == 0) (void)xb_add(&bar[XB_XCNT(b.x)], 1u);
    return b;
}
__device__ __forceinline__ void xcd_barrier_complete(unsigned* bar, unsigned x, unsigned& nloc, unsigned& nx) {
    const unsigned G = gridDim.x * gridDim.y * gridDim.z;
    unsigned sum, cnt, mine, sp = 0u;
    for (;;) {
        sum = 0u; cnt = 0u; mine = 0u;
#pragma unroll
        for (unsigned j = 0; j < 16; ++j) { const unsigned c = xb_ld(&bar[XB_XCNT(j)]); sum += c; cnt += (c > 0u) ? 1u : 0u; mine = (j == x) ? c : mine; }
        if (sum == G) break;
        __builtin_amdgcn_s_sleep(1);
        if ((++sp & 255u) == 0u) { if (xb_ld(&bar[XB_TMO])) break; if (sp > XB_SPIN_CAP) { atomicAdd(&bar[XB_TMO], 1u); break; } }
    }
    nloc = mine > 0u ? mine : 1u; nx = cnt > 0u ? cnt : 1u;
}
__device__ __forceinline__ void xcd_barrier(const XcdBarrier& b) {
    asm volatile("s_waitcnt vmcnt(0)" ::: "memory");
    __syncthreads();
    if (threadIdx.x == 0) {
        unsigned* bar = b.bar;
        __builtin_amdgcn_s_waitcnt(0);
        unsigned nloc = b.st[0], nx = b.st[1];
        if (nloc == 0u) { xcd_barrier_complete(bar, b.x, nloc, nx); b.st[0] = nloc; b.st[1] = nx; }
        const unsigned old = xb_add(&bar[XB_XSUB(b.x)], 1u);
        const unsigned gen = old / nloc;
        if (old + 1u == (gen + 1u) * nloc) {
            __builtin_amdgcn_fence(__ATOMIC_RELEASE, "agent");
            asm volatile("s_waitcnt vmcnt(0)" ::: "memory");
            const unsigned og = xb_add(&bar[XB_TOP], 1u);
            const unsigned tg = og / nx;
            if (og + 1u == (tg + 1u) * nx) xb_add(&bar[XB_TOPGEN], 1u);
            else XB_SPIN(xb_ld(&bar[XB_TOPGEN]) == tg, bar);
            __builtin_amdgcn_fence(__ATOMIC_ACQUIRE, "agent");
            xb_add(&bar[XB_XGEN(b.x)], 1u);
            asm volatile("s_waitcnt vmcnt(0)" ::: "memory");
        } else {
            XB_SPIN(xb_ld(&bar[XB_XGEN(b.x)]) == gen, bar);
            __builtin_amdgcn_fence(__ATOMIC_ACQUIRE, "agent");
            asm volatile("s_waitcnt vmcnt(0)" ::: "memory");
        }
    }
    __syncthreads();
}

struct Args { const float* in[27]; float* out; unsigned char* ws; int ph_lo, ph_hi, li, pad; };
enum { I_X = 0, I_C, I_ADAW, I_ADAB, I_LNG, I_LNB, I_GWIN, I_GWG2F, I_GBGF, I_GWG2B, I_GBGB, I_GNORM, I_GWOUT, I_SWIN, I_SBIN, I_SLNG, I_SLNB, I_SWS, I_SBS, I_SWOUT, I_SBOUT, I_RW, I_RB, I_WUP, I_BUP, I_WDN, I_BDN };

typedef const __attribute__((address_space(4))) Args* KA;
#define PHASE_ENTER() unsigned m1_ = ~0u; asm volatile("" : "+s"(m1_)); int tid = (wave_s << 6) | (int)__builtin_amdgcn_mbcnt_hi(m1_, __builtin_amdgcn_mbcnt_lo(m1_, 0u)); asm volatile("" : "+v"(tid)); int bx = blockIdx.x, G = gridDim.x; asm volatile("" : "+s"(bx), "+s"(G)); \
    KA a = (KA)__builtin_amdgcn_kernarg_segment_ptr(); asm volatile("" : "+s"(a)); unsigned char* ws = a->ws; \
    extern __shared__ __attribute__((aligned(16))) unsigned char lds_raw[]; LAS unsigned char* lds = (LAS unsigned char*)lds_raw; (void)lds; (void)ws; (void)bx; (void)G; (void)tid
__device__ __forceinline__ int swiglu_perm(int o) {
    const int a = o >> 1, h = o & 1, pn = a >> 7, r = a & 127, bj = r >> 6, r2 = r & 63, wc = r2 >> 4, r3 = r2 & 15;
    return 256 * pn + 128 * bj + 32 * wc + 16 * h + r3;
}
__device__ __forceinline__ void conv_tile(const float* W, int K, int N, int k0, int n0, int nw, bf16* dst, int mode, LAS float* scr, int lane) {
    const int c4 = lane & 15, kr = lane >> 4;
    if (4 * c4 < nw) {
        f32x4 ld[16];
#pragma unroll
        for (int i = 0; i < 16; ++i) ld[i] = __builtin_nontemporal_load((const f32x4*)(W + (size_t)(k0 + 4 * i + kr) * N + n0 + 4 * c4));
#pragma unroll
        for (int i = 0; i < 16; ++i) { LAS float* s = scr + (4 * i + kr) * 65 + 4 * c4; s[0] = ld[i][0]; s[1] = ld[i][1]; s[2] = ld[i][2]; s[3] = ld[i][3]; }
    }
    LDS_WAIT(); asm volatile("" ::: "memory");
    const int kc = lane & 7, ns = lane >> 3;
    for (int j = 0; j < nw / 8; ++j) {
        const int n = ns + 8 * j; const LAS float* s = scr + (8 * kc) * 65 + n;
        float v[8];
#pragma unroll
        for (int q = 0; q < 8; ++q) v[q] = s[q * 65];
        u32x4 o; o.x = cvt_pk_bf16(v[0], v[1]); o.y = cvt_pk_bf16(v[2], v[3]); o.z = cvt_pk_bf16(v[4], v[5]); o.w = cvt_pk_bf16(v[6], v[7]);
        const int ng = n0 + n;
        if (mode >= 3 && mode <= 5) {
            const int row = (mode == 4) ? swiglu_perm(ng) : (mode == 5) ? ((ng & ~31) + 16 * ((ng >> 2) & 1) + 4 * ((ng >> 3) & 3) + (ng & 3)) : ng;
            int w0 = __builtin_amdgcn_cvt_pk_fp8_f32(v[0] * F8_WSCALE, v[1] * F8_WSCALE, 0, false); w0 = __builtin_amdgcn_cvt_pk_fp8_f32(v[2] * F8_WSCALE, v[3] * F8_WSCALE, w0, true);
            int w1 = __builtin_amdgcn_cvt_pk_fp8_f32(v[4] * F8_WSCALE, v[5] * F8_WSCALE, 0, false); w1 = __builtin_amdgcn_cvt_pk_fp8_f32(v[6] * F8_WSCALE, v[7] * F8_WSCALE, w1, true);
            *(u32x2*)((unsigned char*)dst + (size_t)row * K + k0 + 8 * kc) = (u32x2){(unsigned)w0, (unsigned)w1};
        } else if (mode == 2) {
            *(u32x4*)(dst + (size_t)n * K + k0 + 8 * kc) = o;
            u32x4 l; l.x = cvt_pk_bf16(v[0] - bf_lo(o.x), v[1] - bf_hi(o.x)); l.y = cvt_pk_bf16(v[2] - bf_lo(o.y), v[3] - bf_hi(o.y));
            l.z = cvt_pk_bf16(v[4] - bf_lo(o.z), v[5] - bf_hi(o.z)); l.w = cvt_pk_bf16(v[6] - bf_lo(o.w), v[7] - bf_hi(o.w));
            *(u32x4*)(dst + (size_t)(32 + n) * K + k0 + 8 * kc) = l;
        } else {
            const int row = (mode == 1) ? swiglu_perm(ng) : (mode == 6) ? ((ng & ~31) + 16 * ((ng >> 2) & 1) + 4 * ((ng >> 3) & 3) + (ng & 3)) : ng;
            *(u32x4*)(dst + (size_t)row * K + k0 + 8 * kc) = o;
        }
    }
    LDS_WAIT(); asm volatile("" ::: "memory");
}

__device__ __forceinline__ void phase_prologue(KA a, LAS unsigned char* lds, int tid, int bx, int G) {
    const int lane = tid & 63, wave = __builtin_amdgcn_readfirstlane(tid >> 6);
    unsigned char* ws = a->ws;
    for (int slab = bx; slab < 192; slab += G) {
        LAS float* sc = (LAS float*)lds;
        LAS float* red = (LAS float*)(lds + 32768);
        for (int i = tid; i < 8 * 1024; i += NTHREADS) sc[i] = silu_f(a->in[I_C][i]);
        __syncthreads();
        const int g0 = slab * 128, l = g0 / 6144, e0 = g0 % 6144;
        const int c4 = tid & 31, seg = tid >> 5;
        f32x4 acc[8];
#pragma unroll
        for (int b = 0; b < 8; ++b) acc[b] = (f32x4){0.f, 0.f, 0.f, 0.f};
        const float* wp = a->in[I_ADAW] + ((size_t)l * 1024 + seg * 64) * 6144 + e0 + 4 * c4;
#pragma unroll 8
        for (int d = 0; d < 64; ++d) { const f32x4 w = __builtin_nontemporal_load((const f32x4*)(wp + (size_t)d * 6144));
#pragma unroll
            for (int b = 0; b < 8; ++b) acc[b] += w * sc[b * 1024 + seg * 64 + d]; }
#pragma unroll
        for (int b = 0; b < 8; ++b) *(LAS f32x4*)(red + (seg * 8 + b) * 128 + 4 * c4) = acc[b];
        __syncthreads();
        for (int o = tid; o < 1024; o += NTHREADS) { const int b = o >> 7, c = o & 127; float s = a->in[I_ADAB][l * 6144 + e0 + c];
#pragma unroll
            for (int sg = 0; sg < 16; ++sg) s += red[(sg * 8 + b) * 128 + c];
            ((float*)(ws + WS_MOD))[((size_t)l * 8 + b) * 6144 + e0 + c] = s; }
        __syncthreads();
    }
    LAS float* scr = (LAS float*)(lds + wave * 16640);
    const int gw = bx * NWAVES + wave, NGW = G * NWAVES;
    constexpr int N_UP = 128 * 16 * 32, N_DN = 128 * 16 * 16, N_GIN = 2 * 16 * 48, N_GLR = 2 * 16, N_GOUT = 2 * 256, N_SIN = 2 * 16 * 32, N_SOUT = 2 * 256, N_RT = 4 * 16;
    constexpr int NITEMS = N_UP + N_DN + N_GIN + N_GLR + N_GOUT + N_SIN + N_SOUT + N_RT;
    for (int it = gw; it < NITEMS; it += NGW) {
        int r = it;
        if (r < N_UP) { const int m = r >> 9, q = r & 511, kt = q >> 5, nt = q & 31;
            conv_tile(a->in[I_WUP] + (size_t)m * 1024 * 2048, 1024, 2048, kt * 64, nt * 64, 64, (bf16*)(ws + WS_WUP_T + (size_t)m * 2048 * 1024 * (MOE_FP8 ? 1 : 2)), MOE_FP8 ? 4 : 1, scr, lane); continue; } r -= N_UP;
        if (r < N_DN) { const int m = r >> 8, q = r & 255, kt = q >> 4, nt = q & 15;
            conv_tile(a->in[I_WDN] + (size_t)m * 1024 * 1024, 1024, 1024, kt * 64, nt * 64, 64, (bf16*)(ws + WS_WDN_T + (size_t)m * 1024 * 1024 * (MOE_FP8 ? 1 : 2)), MOE_FP8 ? 5 : 0, scr, lane); continue; } r -= N_DN;
        if (r < N_GIN) { const int m = r / 768, q = r % 768, kt = q / 48, nt = q % 48;
            conv_tile(a->in[I_GWIN] + (size_t)m * 1024 * GLA_IN, 1024, GLA_IN, kt * 64, nt * 64, 64, (bf16*)(ws + WS_GLAIN_T) + (size_t)m * GLA_MAIN * 1024, 6, scr, lane); continue; } r -= N_GIN;
        if (r < N_GLR) { const int m = r >> 4, kt = r & 15;
            conv_tile(a->in[I_GWIN] + (size_t)m * 1024 * GLA_IN, 1024, GLA_IN, kt * 64, GLA_MAIN, 32, (bf16*)(ws + WS_GLALR_T) + (size_t)m * 64 * 1024, 2, scr, lane); continue; } r -= N_GLR;
        if (r < N_GOUT) { const int m = r >> 8, q = r & 255, kt = q >> 4, nt = q & 15;
            conv_tile(a->in[I_GWOUT] + (size_t)m * 1024 * 1024, 1024, 1024, kt * 64, nt * 64, 64, (bf16*)(ws + WS_GLAOUT_T) + (size_t)m * 1024 * 1024, 6, scr, lane); continue; } r -= N_GOUT;
        if (r < N_SIN) { const int m = r >> 9, q = r & 511, kt = q >> 5, nt = q & 31;
            conv_tile(a->in[I_SWIN] + (size_t)m * 1024 * 2048, 1024, 2048, kt * 64, nt * 64, 64, (bf16*)(ws + WS_SGUIN_T) + (size_t)m * 2048 * 1024, 6, scr, lane); continue; } r -= N_SIN;
        if (r < N_SOUT) { const int m = r >> 8, q = r & 255, kt = q >> 4, nt = q & 15;
            conv_tile(a->in[I_SWOUT] + (size_t)m * 1024 * 1024, 1024, 1024, kt * 64, nt * 64, 64, (bf16*)(ws + WS_SGUOUT_T) + (size_t)m * 1024 * 1024, 6, scr, lane); continue; } r -= N_SOUT;
        { const int m = r >> 4, kt = r & 15;
            conv_tile(a->in[I_RW] + (size_t)m * 1024 * 32, 1024, 32, kt * 64, 0, 32, (bf16*)(ws + WS_ROUTER_T) + (size_t)m * 64 * 1024, 2, scr, lane); }
    }
    { bf16* d = (bf16*)(ws + WS_SGUWS); const float* s = a->in[I_SWS];
      for (int i = (bx * NTHREADS + tid) * 4; i < 2 * 8 * 128 * 128; i += G * NTHREADS * 4) { const f32x4 v = *(const f32x4*)(s + i); u32x2 o; o.x = cvt_pk_bf16(v[0], v[1]); o.y = cvt_pk_bf16(v[2], v[3]); *(u32x2*)(d + i) = o; } }
}

struct RowPass {
    const void* xin; const bf16* y; void* xout; bf16* hout; unsigned char* h8out; int xin16, xout16;
    const float* gate; const float* lng; const float* lnb; const float* sc; const float* sh;
    const bf16* wside;
    float* lr_out;
    const float* rbias;
    int* topi; float* topw; int* hist;
    const void* ys; const int* dest; const float* tw;
    int has_h, has_side;
};
template <int MODE>
__device__ __forceinline__ void row_pass(const RowPass& p, LAS unsigned char* lds, int tid, int bx, int G) {
    const int lane = tid & 63, wave = __builtin_amdgcn_readfirstlane(tid >> 6);
    constexpr int HS = 1032;
    LAS bf16* Hhi = (LAS bf16*)lds;
    LAS bf16* Hlo = (LAS bf16*)(lds + 16 * HS * 2);
    LAS float* part = (LAS float*)(lds + 2 * 16 * HS * 2);
    LAS float* logit = part + 8 * 32 * 16;
    LAS int* lhist = (LAS int*)(logit + 16 * 32);
    if (MODE == 1) { if (tid < 32) lhist[tid] = 0; }
    const bool side = (p.has_side != 0) && (p.wside != nullptr);
    for (int tile = bx; tile < T / 16; tile += G) {
        const int b = (tile * 16) / SEQ;
#pragma unroll 1
        for (int tt = 0; tt < 2; ++tt) {
            const int tl = 2 * wave + tt, token = tile * 16 + tl;
            f32x4 v[4]; u32x2 xq[4], yq[4]; int y8[4][4]; float wk[4] = {0.f, 0.f, 0.f, 0.f};
            f32x4 vg[4], vlg[4], vlb[4], vsc[4], vsh[4];
            if (p.xin16) { const bf16* xr = (const bf16*)p.xin + (size_t)token * D + 4 * lane;
#pragma unroll
                for (int j = 0; j < 4; ++j) xq[j] = *(const u32x2*)(xr + 256 * j); }
            else { const float* xr = (const float*)p.xin + (size_t)token * D + 4 * lane;
#pragma unroll
                for (int j = 0; j < 4; ++j) v[j] = *(const f32x4*)(xr + 256 * j); }
            if (MODE == 1) { const bf16* yr = p.y + (size_t)token * D + 4 * lane;
#pragma unroll
                for (int j = 0; j < 4; ++j) yq[j] = *(const u32x2*)(yr + 256 * j); }
            if (MODE == 2) {
                const int4 d4 = *(const int4*)(p.dest + token * 4); const f32x4 w4 = *(const f32x4*)(p.tw + token * 4); const int ds[4] = {d4.x, d4.y, d4.z, d4.w};
#pragma unroll
                for (int k = 0; k < 4; ++k) { wk[k] = w4[k];
#if MOE_FP8
                    const unsigned char* yr = (const unsigned char*)p.ys + (size_t)ds[k] * D + 4 * lane;
#pragma unroll
                    for (int j = 0; j < 4; ++j) y8[k][j] = *(const int*)(yr + 256 * j);
#endif
                }
            }
            if (MODE != 0) { const float* gp = p.gate + (size_t)b * 6144 + 4 * lane;
#pragma unroll
                for (int j = 0; j < 4; ++j) vg[j] = *(const f32x4*)(gp + 256 * j); }
#pragma unroll
            for (int j = 0; j < 4; ++j) {
                if (p.xin16) asm volatile("" : "+v"(xq[j])); else asm volatile("" : "+v"(v[j]));
                if (MODE == 1) asm volatile("" : "+v"(yq[j]));
                if (MODE != 0) asm volatile("" : "+v"(vg[j]));
#if MOE_FP8
                if (MODE == 2) asm volatile("" : "+v"(y8[0][j]), "+v"(y8[1][j]), "+v"(y8[2][j]), "+v"(y8[3][j]));
#endif
            }
            if (p.xin16) {
#pragma unroll
                for (int j = 0; j < 4; ++j) v[j] = (f32x4){bf_lo(xq[j].x), bf_hi(xq[j].x), bf_lo(xq[j].y), bf_hi(xq[j].y)}; }
            if (MODE == 1) {
#pragma unroll
                for (int j = 0; j < 4; ++j) { const f32x4 yy = (f32x4){bf_lo(yq[j].x), bf_hi(yq[j].x), bf_lo(yq[j].y), bf_hi(yq[j].y)}; v[j] = v[j] * ALPHA + (vg[j] + 1.0f) * yy; }
            }
            if (MODE == 2) {
                f32x4 ya[4];
#pragma unroll
                for (int j = 0; j < 4; ++j) ya[j] = (f32x4){0.f, 0.f, 0.f, 0.f};
#if MOE_FP8
#pragma unroll
                for (int k = 0; k < 4; ++k) { const float w = wk[k] * (1.0f / F8_YSCALE);
#pragma unroll
                    for (int j = 0; j < 4; ++j) { const f32x2 lo2 = __builtin_amdgcn_cvt_pk_f32_fp8(y8[k][j], false), hi2 = __builtin_amdgcn_cvt_pk_f32_fp8(y8[k][j], true); ya[j] += (f32x4){lo2[0], lo2[1], hi2[0], hi2[1]} * w; } }
#else
                { const int4 d4 = *(const int4*)(p.dest + token * 4); const int ds[4] = {d4.x, d4.y, d4.z, d4.w};
#pragma unroll
                for (int k = 0; k < 4; ++k) { const bf16* yr = (const bf16*)p.ys + (size_t)ds[k] * D + 4 * lane;
#pragma unroll
                    for (int j = 0; j < 4; ++j) { const u32x2 q = *(const u32x2*)(yr + 256 * j); ya[j] += (f32x4){bf_lo(q.x), bf_hi(q.x), bf_lo(q.y), bf_hi(q.y)} * wk[k]; } } }
#endif
#pragma unroll
                for (int j = 0; j < 4; ++j) v[j] = v[j] * ALPHA + (vg[j] + 1.0f) * ya[j];
            }
            if (MODE != 0) {
#pragma unroll
                for (int j = 0; j < 4; ++j) { vlg[j] = *(const f32x4*)(p.lng + 4 * lane + 256 * j); vlb[j] = *(const f32x4*)(p.lnb + 4 * lane + 256 * j); } }
            if (p.has_h) { const float* scp = p.sc + (size_t)b * 6144 + 4 * lane; const float* shp = p.sh + (size_t)b * 6144 + 4 * lane;
#pragma unroll
                for (int j = 0; j < 4; ++j) { vsc[j] = *(const f32x4*)(scp + 256 * j); vsh[j] = *(const f32x4*)(shp + 256 * j); } }
#pragma unroll
            for (int j = 0; j < 4; ++j) { asm volatile("" : "+v"(v[j])); }
            if (MODE != 0) {
                float s = 0.f;
#pragma unroll
                for (int j = 0; j < 4; ++j) s += (v[j][0] + v[j][1]) + (v[j][2] + v[j][3]);
                const float mean = wave_sum(s, lane) * (1.0f / D); float s2 = 0.f;
#pragma unroll
                for (int j = 0; j < 4; ++j) { v[j] = v[j] - mean; s2 += (v[j][0] * v[j][0] + v[j][1] * v[j][1]) + (v[j][2] * v[j][2] + v[j][3] * v[j][3]); }
                const float rstd = 1.0f / sqrtf(wave_sum(s2, lane) * (1.0f / D) + LN_EPS);
#pragma unroll
                for (int j = 0; j < 4; ++j) v[j] = v[j] * rstd * vlg[j] + vlb[j];
                if (p.xout16) { bf16* xo = (bf16*)p.xout + (size_t)token * D + 4 * lane;
#pragma unroll
                    for (int j = 0; j < 4; ++j) { u32x2 o; o.x = cvt_pk_bf16(v[j][0], v[j][1]); o.y = cvt_pk_bf16(v[j][2], v[j][3]); *(u32x2*)(xo + 256 * j) = o; } }
                else { float* xo = (float*)p.xout + (size_t)token * D + 4 * lane;
#pragma unroll
                    for (int j = 0; j < 4; ++j) *(f32x4*)(xo + 256 * j) = v[j]; }
            }
            if (p.has_h) {
                bf16* ho = p.hout + (size_t)token * D + 4 * lane;
#pragma unroll
                for (int j = 0; j < 4; ++j) { const f32x4 h = v[j] * (vsc[j] + 1.0f) + vsh[j];
                    u32x2 o; o.x = cvt_pk_bf16(h[0], h[1]); o.y = cvt_pk_bf16(h[2], h[3]); if (!(MODE == 1 && MOE_FP8)) *(u32x2*)(ho + 256 * j) = o;
                    if (MODE == 1 && p.h8out) { int w8 = __builtin_amdgcn_cvt_pk_fp8_f32(h[0] * F8_HSCALE, h[1] * F8_HSCALE, 0, false); w8 = __builtin_amdgcn_cvt_pk_fp8_f32(h[2] * F8_HSCALE, h[3] * F8_HSCALE, w8, true); *(int*)(p.h8out + (size_t)token * D + 4 * lane + 256 * j) = w8; }
                    if (side) { u32x2 l; l.x = cvt_pk_bf16(h[0] - bf_lo(o.x), h[1] - bf_hi(o.x)); l.y = cvt_pk_bf16(h[2] - bf_lo(o.y), h[3] - bf_hi(o.y));
                        *(LAS u32x2*)(Hhi + tl * HS + 4 * lane + 256 * j) = o; *(LAS u32x2*)(Hlo + tl * HS + 4 * lane + 256 * j) = l; } }
            }
        }
        if (side) {
            bf16x8 whi[2][4], wlo[2][4];
#pragma unroll
            for (int hf = 0; hf < 2; ++hf)
#pragma unroll
                for (int s4 = 0; s4 < 4; ++s4) { const size_t off = (size_t)(hf * 16 + (lane & 15)) * 1024 + 128 * wave + 32 * s4 + 8 * (lane >> 4);
                    whi[hf][s4] = *(const bf16x8*)(p.wside + off); wlo[hf][s4] = *(const bf16x8*)(p.wside + 32 * 1024 + off); }
            __syncthreads();
            f32x4 acc[2]; acc[0] = (f32x4){0.f, 0.f, 0.f, 0.f}; acc[1] = acc[0];
#pragma unroll
            for (int s = 0; s < 4; ++s) { const int ko = (lane & 15) * HS + 128 * wave + 32 * s + 8 * (lane >> 4);
                const bf16x8 bh = *(const LAS bf16x8*)(Hhi + ko), bl = *(const LAS bf16x8*)(Hlo + ko);
#pragma unroll
                for (int hf = 0; hf < 2; ++hf) { acc[hf] = __builtin_amdgcn_mfma_f32_16x16x32_bf16(whi[hf][s], bh, acc[hf], 0, 0, 0);
                    acc[hf] = __builtin_amdgcn_mfma_f32_16x16x32_bf16(wlo[hf][s], bh, acc[hf], 0, 0, 0); acc[hf] = __builtin_amdgcn_mfma_f32_16x16x32_bf16(whi[hf][s], bl, acc[hf], 0, 0, 0); } }
#pragma unroll
            for (int hf = 0; hf < 2; ++hf)
#pragma unroll
                for (int j = 0; j < 4; ++j) part[(wave * 32 + hf * 16 + 4 * (lane >> 4) + j) * 16 + (lane & 15)] = acc[hf][j];
            __syncthreads();
            { const int e = tid >> 4, tk = tid & 15; float s = 0.f;
#pragma unroll
              for (int w = 0; w < 8; ++w) s += part[(w * 32 + e) * 16 + tk];
              if (MODE == 1) logit[tk * 32 + e] = s + p.rbias[e];
              else p.lr_out[(size_t)(tile * 16 + tk) * 32 + e] = s; }
            if (MODE == 1) {
                __syncthreads();
                if (tid < 16) {
                    const int token = tile * 16 + tid; float lv[32];
#pragma unroll
                    for (int e = 0; e < 32; ++e) lv[e] = logit[tid * 32 + e];
                    int bi[4]; float bv[4];
#pragma unroll
                    for (int k = 0; k < 4; ++k) { float m = -3.0e38f; int mi = 0;
#pragma unroll
                        for (int e = 0; e < 32; ++e) { const bool take = lv[e] > m; m = take ? lv[e] : m; mi = take ? e : mi; }
                        bi[k] = mi; bv[k] = m;
#pragma unroll
                        for (int e = 0; e < 32; ++e) lv[e] = (e == mi) ? -3.0e38f : lv[e]; }
                    const float e1 = __expf(bv[1] - bv[0]), e2 = __expf(bv[2] - bv[0]), e3 = __expf(bv[3] - bv[0]); const float inv = 1.0f / (1.0f + e1 + e2 + e3);
                    *(int4*)(p.topi + token * 4) = make_int4(bi[0], bi[1], bi[2], bi[3]);
                    *(f32x4*)(p.topw + token * 4) = (f32x4){inv, e1 * inv, e2 * inv, e3 * inv};
#pragma unroll
                    for (int k = 0; k < 4; ++k) atomicAdd((int*)&lhist[bi[k]], 1);
                }
            }
            __syncthreads();
        }
    }
    if (MODE == 1) { __syncthreads(); if (tid < 32) p.hist[tid] = lhist[tid]; }
}

__device__ __forceinline__ void phase_place(int* route, LAS unsigned char* lds, int tid, int bx, int G) {
    const int lane = tid & 63, wave = tid >> 6;
    LAS int* ptot = (LAS int*)lds;
    LAS int* ppre = ptot + 512;
    LAS int* tot = ppre + 512;
    LAS int* pre = tot + 32;
    LAS int* pstart = pre + 32;
    const int* hist = route + R_HIST;
    { const int e = tid & 31, part = tid >> 5; int st = 0, sp = 0;
      for (int bb = part; bb < G; bb += 16) { const int h = hist[bb * 32 + e]; st += h; if (bb < bx) sp += h; }
      ptot[part * 32 + e] = st; ppre[part * 32 + e] = sp; }
    __syncthreads();
    if (tid < 32) { int st = 0, sp = 0;
#pragma unroll
        for (int q = 0; q < 16; ++q) { st += ptot[q * 32 + tid]; sp += ppre[q * 32 + tid]; }
        tot[tid] = st; pre[tid] = sp; }
    __syncthreads();
    if (tid == 0) { int acc = 0; for (int e = 0; e < 32; ++e) { pstart[e] = acc; acc += (tot[e] + 255) / 256 * 256; } pstart[32] = acc; }
    __syncthreads();
    if (bx == 0) {
        const int ntiles = pstart[32] / 256;
        if (tid == 0) route[R_NTILES] = ntiles;
        for (int t = tid; t < ntiles; t += NTHREADS) { int e = 0; for (int q = 1; q < 32; ++q) if (pstart[q] <= t * 256) e = q; route[R_TILEE + t] = e; }
    }
    for (int e = bx; e < 32; e += G) { const int s0 = pstart[e] + tot[e], s1 = pstart[e + 1]; for (int s = s0 + tid; s < s1; s += NTHREADS) route[R_BUFTOK + s] = 0; }
    if (wave == 0) {
        int run = 0;
        for (int tile = bx; tile < T / 16; tile += G) {
            const int token = tile * 16 + (lane >> 2);
            const int e = route[R_TOPI + tile * 64 + lane];
            const int base = shfl_i(run, e, lane);
            int rank = 0, add = 0;
#pragma unroll 1
            for (int x = 0; x < 32; ++x) { const unsigned long long m = __ballot(e == x); if (e == x) rank = __popcll(m & ((1ull << lane) - 1ull)); if (lane == x) add = __popcll(m); }
            run += add;
            const int ds = pstart[e] + pre[e] + base + rank;
            route[R_DEST + tile * 64 + lane] = ds;
            route[R_BUFTOK + ds] = token;
        }
    }
}

struct Unit { int pm, pn, e; const char* bt; };
constexpr int NXCD = 8, WGM = 8;
struct Sched {
    int nM, nN, nwg, G, c; const char* Bt; size_t estride; const int* tile_e; int KB;
    __device__ __forceinline__ void init(int nM_, int nN_, int G_, int c_, const void* Bt_, size_t es, const int* te, int KB_) { nM = nM_; nN = nN_; nwg = nM * nN; G = G_; c = c_; Bt = (const char*)Bt_; estride = es; tile_e = te; KB = KB_; }
    __device__ __forceinline__ bool next(int i, Unit& u) const {
        const long L = (long)i * G + c; if (L >= nwg) return false;
        int wgid = (int)L; { const int q = nwg / NXCD, r = nwg % NXCD, xcd = wgid % NXCD, off = wgid / NXCD; wgid = (xcd < r ? xcd * (q + 1) : r * (q + 1) + (xcd - r) * q) + off; }
        const int nig = WGM * nN, gid = wgid / nig, fm = gid * WGM, gsz = (nM - fm) < WGM ? (nM - fm) : WGM;
        u.pm = fm + ((wgid % nig) % gsz); u.pn = (wgid % nig) / gsz;
        u.e = tile_e ? __builtin_amdgcn_readfirstlane(tile_e[u.pm]) : 0;
        u.bt = Bt + (size_t)u.e * estride + (size_t)u.pn * 256 * KB;
        return true;
    }
};
struct EpiGlaIn { bf16* O;
    static constexpr int NST = 16;
    __device__ __forceinline__ const float* bias_ptr(const Unit&) const { return nullptr; }
    __device__ __forceinline__ void operator()(const f32x4 (&acc)[2][2][4][2], const Unit& u, int wr, int wc, int fr, int fq, const LAS float*) const {
        const int row0 = u.pm * 256 + wr * 64 + fr, col0 = u.pn * 256 + wc * 32 + 8 * fq; const float sc = (u.pn < 2) ? 0.08838834764831845f : 1.0f;
#pragma unroll
        for (int ai = 0; ai < 2; ++ai)
#pragma unroll
            for (int m = 0; m < 4; ++m) { bf16* rp = O + (size_t)(row0 + ai * 128 + m * 16) * GLA_MAIN + col0;
#pragma unroll
                for (int bj = 0; bj < 2; ++bj) { const f32x4 v0 = acc[ai][bj][m][0] * sc, v1 = acc[ai][bj][m][1] * sc;
                    *(u32x4*)(rp + bj * 128) = (u32x4){cvt_pk_bf16(v0[0], v0[1]), cvt_pk_bf16(v0[2], v0[3]), cvt_pk_bf16(v1[0], v1[1]), cvt_pk_bf16(v1[2], v1[3])}; } }
    }
};
struct EpiSguIn { bf16* O; const float* bias;
    static constexpr int NST = 16;
    __device__ __forceinline__ const float* bias_ptr(const Unit& u) const { return bias + u.pn * 256; }
    __device__ __forceinline__ void operator()(const f32x4 (&acc)[2][2][4][2], const Unit& u, int wr, int wc, int fr, int fq, const LAS float* lb) const {
        const int row0 = u.pm * 256 + wr * 64 + fr, col0 = u.pn * 256 + wc * 32 + 8 * fq;
        f32x4 bv[2][2];
#pragma unroll
        for (int bj = 0; bj < 2; ++bj)
#pragma unroll
            for (int n = 0; n < 2; ++n) bv[bj][n] = *(const LAS f32x4*)(lb + wc * 32 + 8 * fq + bj * 128 + 4 * n);
#pragma unroll
        for (int ai = 0; ai < 2; ++ai)
#pragma unroll
            for (int m = 0; m < 4; ++m) { bf16* rp = O + (size_t)(row0 + ai * 128 + m * 16) * 2048 + col0;
#pragma unroll
                for (int bj = 0; bj < 2; ++bj) { const f32x4 v0 = acc[ai][bj][m][0] + bv[bj][0], v1 = acc[ai][bj][m][1] + bv[bj][1];
                    *(u32x4*)(rp + bj * 128) = (u32x4){cvt_pk_bf16(gelu_f(v0[0]), gelu_f(v0[1])), cvt_pk_bf16(gelu_f(v0[2]), gelu_f(v0[3])), cvt_pk_bf16(gelu_f(v1[0]), gelu_f(v1[1])), cvt_pk_bf16(gelu_f(v1[2]), gelu_f(v1[3]))}; } }
    }
};
struct EpiOut { bf16* O; const float* bias;
    static constexpr int NST = 16;
    __device__ __forceinline__ const float* bias_ptr(const Unit& u) const { return bias ? bias + u.pn * 256 : nullptr; }
    __device__ __forceinline__ void operator()(const f32x4 (&acc)[2][2][4][2], const Unit& u, int wr, int wc, int fr, int fq, const LAS float* lb) const {
        const int row0 = u.pm * 256 + wr * 64 + fr, col0 = u.pn * 256 + wc * 32 + 8 * fq;
        f32x4 bv[2][2];
#pragma unroll
        for (int bj = 0; bj < 2; ++bj)
#pragma unroll
            for (int n = 0; n < 2; ++n) bv[bj][n] = bias ? *(const LAS f32x4*)(lb + wc * 32 + 8 * fq + bj * 128 + 4 * n) : (f32x4){0.f, 0.f, 0.f, 0.f};
#pragma unroll
        for (int ai = 0; ai < 2; ++ai)
#pragma unroll
            for (int m = 0; m < 4; ++m) { bf16* rp = O + (size_t)(row0 + ai * 128 + m * 16) * D + col0;
#pragma unroll
                for (int bj = 0; bj < 2; ++bj) { const f32x4 v0 = acc[ai][bj][m][0] + bv[bj][0], v1 = acc[ai][bj][m][1] + bv[bj][1];
                    *(u32x4*)(rp + bj * 128) = (u32x4){cvt_pk_bf16(v0[0], v0[1]), cvt_pk_bf16(v0[2], v0[3]), cvt_pk_bf16(v1[0], v1[1]), cvt_pk_bf16(v1[2], v1[3])}; } }
    }
};
template <bool F8> struct EpiUp { unsigned char* O; const float* bias;
    __device__ __forceinline__ const float* bias_ptr(const Unit& u) const { return bias + (size_t)u.e * 2048 + u.pn * 256; }
    __device__ __forceinline__ void operator()(const f32x4 (&acc)[2][2][4][2], const Unit& u, int wr, int wc, int fr, int fq, const LAS float* lb) const {
        const int row0 = u.pm * 256 + wr * 64 + fr, a0 = u.pn * 128 + wc * 16 + 4 * fq;
        const float asc = F8 ? 1.0f / (F8_WSCALE * F8_HSCALE) : 1.0f;
        f32x4 bg[2], bl[2];
#pragma unroll
        for (int bj = 0; bj < 2; ++bj) { const LAS float* bp = lb + 2 * (wc * 16 + 4 * fq + 64 * bj); const f32x4 p0 = *(const LAS f32x4*)bp, p1 = *(const LAS f32x4*)(bp + 4);
            bg[bj] = (f32x4){p0[0], p0[2], p1[0], p1[2]}; bl[bj] = (f32x4){p0[1], p0[3], p1[1], p1[3]}; }
#pragma unroll
        for (int ai = 0; ai < 2; ++ai)
#pragma unroll
            for (int m = 0; m < 4; ++m) { const size_t ro = (size_t)(row0 + ai * 128 + m * 16) * D + a0;
#pragma unroll
                for (int bj = 0; bj < 2; ++bj) { const f32x4 g = acc[ai][bj][m][0] * asc + bg[bj], l = acc[ai][bj][m][1] * asc + bl[bj]; float r[4];
#pragma unroll
                    for (int j = 0; j < 4; ++j) { const float gg = fminf(g[j], 7.0f), ll = fminf(fmaxf(l[j], -7.0f), 7.0f); r[j] = gg * sigmoid_f(1.702f * gg) * (ll + 1.0f); }
                    if constexpr (F8) { int w = __builtin_amdgcn_cvt_pk_fp8_f32(r[0] * F8_ASCALE, r[1] * F8_ASCALE, 0, false); w = __builtin_amdgcn_cvt_pk_fp8_f32(r[2] * F8_ASCALE, r[3] * F8_ASCALE, w, true);
                        *(int*)(O + ro + bj * 64) = w; }
                    else { u32x2 o; o.x = cvt_pk_bf16(r[0], r[1]); o.y = cvt_pk_bf16(r[2], r[3]); *(u32x2*)((bf16*)O + ro + bj * 64) = o; } } }
    }
};
struct EpiDown8 { unsigned char* O; const float* bias; float asc;
    static constexpr int NST = 16;
    __device__ __forceinline__ const float* bias_ptr(const Unit& u) const { return bias + (size_t)u.e * 1024 + u.pn * 256; }
    __device__ __forceinline__ void operator()(const f32x4 (&acc)[2][2][4][2], const Unit& u, int wr, int wc, int fr, int fq, const LAS float* lb) const {
        const int row0 = u.pm * 256 + wr * 64 + fr, col0 = u.pn * 256 + wc * 32 + 8 * fq;
        f32x4 bv[2][2];
#pragma unroll
        for (int bj = 0; bj < 2; ++bj)
#pragma unroll
            for (int n = 0; n < 2; ++n) bv[bj][n] = *(const LAS f32x4*)(lb + wc * 32 + 8 * fq + bj * 128 + 4 * n) * F8_YSCALE;
        const float sc = asc * F8_YSCALE;
#pragma unroll
        for (int ai = 0; ai < 2; ++ai)
#pragma unroll
            for (int m = 0; m < 4; ++m) { unsigned char* rp = O + (size_t)(row0 + ai * 128 + m * 16) * D + col0;
#pragma unroll
                for (int bj = 0; bj < 2; ++bj) { const f32x4 v0 = acc[ai][bj][m][0] * sc + bv[bj][0], v1 = acc[ai][bj][m][1] * sc + bv[bj][1];
                    int w0 = __builtin_amdgcn_cvt_pk_fp8_f32(v0[0], v0[1], 0, false); w0 = __builtin_amdgcn_cvt_pk_fp8_f32(v0[2], v0[3], w0, true);
                    int w1 = __builtin_amdgcn_cvt_pk_fp8_f32(v1[0], v1[1], 0, false); w1 = __builtin_amdgcn_cvt_pk_fp8_f32(v1[2], v1[3], w1, true);
                    *(u32x2*)(rp + bj * 128) = (u32x2){(unsigned)w0, (unsigned)w1}; } }
    }
};
struct EpiDown { bf16* O; const float* bias; float asc;
    __device__ __forceinline__ const float* bias_ptr(const Unit& u) const { return bias + (size_t)u.e * 1024 + u.pn * 256; }
    __device__ __forceinline__ void operator()(const f32x4 (&acc)[2][2][4][2], const Unit& u, int wr, int wc, int fr, int fq, const LAS float* lb) const {
        const int row0 = u.pm * 256 + wr * 64 + fr, col0 = u.pn * 256 + wc * 32 + 4 * fq;
        f32x4 bv[2][2];
#pragma unroll
        for (int bj = 0; bj < 2; ++bj)
#pragma unroll
            for (int n = 0; n < 2; ++n) bv[bj][n] = *(const LAS f32x4*)(lb + wc * 32 + 4 * fq + bj * 128 + n * 16);
#pragma unroll
        for (int ai = 0; ai < 2; ++ai)
#pragma unroll
            for (int m = 0; m < 4; ++m) { bf16* rp = O + (size_t)(row0 + ai * 128 + m * 16) * D + col0;
#pragma unroll
                for (int bj = 0; bj < 2; ++bj)
#pragma unroll
                    for (int n = 0; n < 2; ++n) { const f32x4 v = acc[ai][bj][m][n] * asc + bv[bj][n]; u32x2 o; o.x = cvt_pk_bf16(v[0], v[1]); o.y = cvt_pk_bf16(v[2], v[3]); *(u32x2*)(rp + bj * 128 + n * 16) = o; } }
    }
};

constexpr int G8_BK = 64, G8_HALF = 128, G8_HTB = G8_HALF * G8_BK * 2, G8_STAGE_BYTES = 8 * G8_HTB;
__device__ __forceinline__ int g8_lds_byte(int r, int c) { const int st = (r >> 4) * 2 + (c >> 5), rr = r & 15, cc = c & 31, ob = rr * 64 + cc * 2; return st * 1024 + (ob ^ (((ob >> 9) & 1) << 5)); }
__device__ __forceinline__ void g8_stage_rc(int b, int& R, int& C) { const int st = b / 1024, sb = b % 1024, swz = sb ^ (((sb >> 9) & 1) << 5); R = (st >> 1) * 16 + swz / 64; C = (st & 1) * 32 + (swz % 64) / 2; }
__device__ __forceinline__ u32x4 g8_avoff(int pm, const int* gather, int tid, int KB) {
    int t2 = tid; asm volatile("" : "+v"(t2));
    int R, C; g8_stage_rc(t2 * 16, R, C);
    const int* gp = gather + pm * 256 + R;
    const unsigned r00 = gp[0], r01 = gp[64], r10 = gp[128], r11 = gp[192], c2 = (unsigned)(C * 2), k2 = (unsigned)KB;
    return (u32x4){r00 * k2 + c2, r01 * k2 + c2, r10 * k2 + c2, r11 * k2 + c2};
}
template <bool GATHER, bool FP8, class Epi>
__device__ __forceinline__ void gemm_fast(const void* A, const int* gather, const int K, const Sched& S, const Epi& E, LAS unsigned char* lds, int tid) {
    const int wid = __builtin_amdgcn_readfirstlane(tid >> 6), lane = tid & 63, wr = wid >> 2, wc = wid & 3, fr = lane & 15, fq = lane >> 4;
    const int KB = FP8 ? K : 2 * K, nt = KB / 128;
    unsigned voff; { int R, C; g8_stage_rc(tid * 16, R, C); voff = (unsigned)(R * KB + C * 2); }
    const size_t kstep = (size_t)128, hstep = (size_t)G8_HALF * KB, qstep = (size_t)64 * KB, tstep = 2 * hstep;
    const unsigned ldsw = (unsigned)wid * 1024u;
    const int aoff = g8_lds_byte(wr * 64 + fr, fq * (FP8 ? 16 : 8)), boff = g8_lds_byte(wc * 32 + fr, fq * (FP8 ? 16 : 8));
    constexpr int KSTR = FP8 ? 16 : 1024;
#define G8_SA(b, h) (((b) * 2 + (h)) * G8_HTB)
#define G8_SB(b, h) ((4 + (b) * 2 + (h)) * G8_HTB)
#define G8_GLDS(gp, ldsoff) __builtin_amdgcn_global_load_lds((const unsigned*)(gp), (LAS unsigned*)(lds + (ldsoff)), 16, 0, 0)
#define G8_STAGE_D(bufoff, gbase) do { G8_GLDS((const char*)(gbase) + voff, (bufoff) + ldsw); G8_GLDS((const char*)(gbase) + qstep + voff, (bufoff) + ldsw + 8192); } while (0)
#define G8_STAGE_A(bufoff, kb, h) do { if constexpr (GATHER) { G8_GLDS((kb) + va[(h) * 2], (bufoff) + ldsw); G8_GLDS((kb) + va[(h) * 2 + 1], (bufoff) + ldsw + 8192); } \
        else { G8_STAGE_D(bufoff, (kb) + (h) * hstep); } } while (0)
#define G8_LDA(dst, b, h) do { _Pragma("unroll") for (int m = 0; m < 4; ++m) _Pragma("unroll") for (int k = 0; k < 2; ++k) dst[m][k] = *(const LAS bf16x8*)(lds + G8_SA(b, h) + aoff + m * 2048 + k * KSTR); } while (0)
#define G8_LDB(dst, b, h) do { _Pragma("unroll") for (int n = 0; n < 2; ++n) _Pragma("unroll") for (int k = 0; k < 2; ++k) dst[n][k] = *(const LAS bf16x8*)(lds + G8_SB(b, h) + boff + n * 2048 + k * KSTR); } while (0)
#define G8_CAT(x) __builtin_shufflevector(__builtin_bit_cast(i32x4, (x)[0]), __builtin_bit_cast(i32x4, (x)[1]), 0, 1, 2, 3, 4, 5, 6, 7)
#define G8_MMA(ai, bj, At, Bt) do { __builtin_amdgcn_s_setprio(1); _Pragma("unroll") for (int m = 0; m < 4; ++m) _Pragma("unroll") for (int n = 0; n < 2; ++n) { \
        if constexpr (FP8) acc[ai][bj][m][n] = __builtin_amdgcn_mfma_scale_f32_16x16x128_f8f6f4(G8_CAT(Bt[n]), G8_CAT(At[m]), acc[ai][bj][m][n], 0, 0, 0, 0x7f7f7f7f, 0, 0x7f7f7f7f); \
        else { _Pragma("unroll") for (int k = 0; k < 2; ++k) acc[ai][bj][m][n] = __builtin_amdgcn_mfma_f32_16x16x32_bf16(Bt[n][k], At[m][k], acc[ai][bj][m][n], 0, 0, 0); } } \
        __builtin_amdgcn_s_setprio(0); } while (0)
#define G8_WAIT_V(n) asm volatile("s_waitcnt vmcnt(" #n ")" ::: "memory")
#define G8_WAIT_L(n) asm volatile("s_waitcnt lgkmcnt(" #n ")" ::: "memory")
#define G8_BAR __builtin_amdgcn_s_barrier()
#define G8_SCHED __builtin_amdgcn_sched_barrier(0)
    Unit cur, nxt; int ui = 0;
    if (!S.next(0, cur)) return;
    f32x4 acc[2][2][4][2];
#pragma unroll
    for (int a = 0; a < 2; ++a)
#pragma unroll
        for (int b = 0; b < 2; ++b)
#pragma unroll
            for (int m = 0; m < 4; ++m)
#pragma unroll
                for (int n = 0; n < 2; ++n) acc[a][b][m][n] = (f32x4){0.f, 0.f, 0.f, 0.f};
    bf16x8 At[4][2], B0[2][2], B1[2][2];
    u32x4 va = (u32x4){0u, 0u, 0u, 0u};
    if constexpr (GATHER) va = g8_avoff(cur.pm, gather, tid, KB);
    constexpr int G8_IDX = G8_STAGE_BYTES, G8_BIAS = G8_STAGE_BYTES + 1024;
    { const float* bp0 = E.bias_ptr(cur); if (bp0 && wid == 0) G8_GLDS((const char*)bp0 + lane * 16, G8_BIAS); }
    const char* cB = (const char*)cur.bt; const char* cA = (const char*)A + (GATHER ? (size_t)0 : (size_t)cur.pm * tstep);
    G8_STAGE_D(G8_SB(0, 0), cB); G8_STAGE_D(G8_SB(0, 1), cB + hstep); G8_STAGE_A(G8_SA(0, 0), cA, 0); G8_STAGE_A(G8_SA(0, 1), cA, 1);
    if (wr == 1) G8_BAR;
    G8_WAIT_V(2); G8_BAR;
    G8_STAGE_D(G8_SB(1, 0), cB + kstep); G8_STAGE_A(G8_SA(1, 0), cA + kstep, 0); G8_STAGE_D(G8_SB(1, 1), cB + hstep + kstep);
    G8_WAIT_V(6); G8_BAR;
    for (;;) {
        const bool has_next = S.next(ui + 1, nxt);
        if constexpr (GATHER) { if (has_next && wid == 1) G8_GLDS((const char*)(gather + nxt.pm * 256) + lane * 16, G8_IDX); }
        const char* nB = has_next ? (const char*)nxt.bt : cB;
        const char* nA = (GATHER || !has_next) ? cA : (const char*)A + (size_t)nxt.pm * tstep;
#pragma unroll 1
        for (int t = 0; t < nt; t += 2) {
            const bool last = (t == nt - 2);
            const char* a1 = cA + (size_t)(t + 1) * kstep;
            const char* a2 = last ? nA : cA + (size_t)(t + 2) * kstep; const char* b2 = last ? nB : cB + (size_t)(t + 2) * kstep;
            const char* a3 = a2 + kstep; const char* b3 = b2 + kstep;
            G8_LDB(B0, 0, 0); G8_LDB(B1, 0, 1); G8_SCHED; G8_LDA(At, 0, 0); G8_STAGE_A(G8_SA(1, 1), a1, 1);
            if (last && has_next && wid == 0) { const float* bpn = E.bias_ptr(nxt); if (bpn) G8_GLDS((const char*)bpn + lane * 16, G8_BIAS + ((ui + 1) & 1) * 1024); }
            if constexpr (GATHER) { if (last && has_next) {
                int t2 = tid; asm volatile("" : "+v"(t2)); int R, C; g8_stage_rc(t2 * 16, R, C); const LAS int* ip = (const LAS int*)(lds + G8_IDX) + R; const unsigned c2 = (unsigned)(C * 2), k2 = (unsigned)KB;
                va = (u32x4){(unsigned)ip[0] * k2 + c2, (unsigned)ip[64] * k2 + c2, (unsigned)ip[128] * k2 + c2, (unsigned)ip[192] * k2 + c2}; } }
            G8_WAIT_V(8); G8_WAIT_L(0); G8_BAR; G8_MMA(0, 0, At, B0); G8_MMA(0, 1, At, B1); G8_BAR; G8_SCHED;
            G8_LDA(At, 0, 1); G8_STAGE_D(G8_SB(0, 0), b2); G8_STAGE_D(G8_SB(0, 1), b2 + hstep); G8_STAGE_A(G8_SA(0, 0), a2, 0);
            G8_WAIT_V(8); G8_WAIT_L(0); G8_BAR; G8_MMA(1, 0, At, B0); G8_MMA(1, 1, At, B1); G8_BAR; G8_SCHED;
            G8_LDB(B0, 1, 0); G8_LDB(B1, 1, 1); G8_SCHED; G8_LDA(At, 1, 0); G8_STAGE_A(G8_SA(0, 1), a2, 1);
            G8_WAIT_V(8); G8_WAIT_L(0); G8_BAR; G8_MMA(0, 0, At, B0); G8_MMA(0, 1, At, B1); G8_BAR; G8_SCHED;
            G8_LDA(At, 1, 1); G8_STAGE_D(G8_SB(1, 0), b3); G8_STAGE_D(G8_SB(1, 1), b3 + hstep); G8_STAGE_A(G8_SA(1, 0), a3, 0);
            G8_WAIT_V(8); G8_WAIT_L(0); G8_BAR; G8_MMA(1, 0, At, B0); G8_MMA(1, 1, At, B1); G8_BAR; G8_SCHED;
        }
        if (wr == 0) G8_BAR;
        { int t3 = tid; asm volatile("" : "+v"(t3)); const int l3 = t3 & 63; E(acc, cur, wr, wc, l3 & 15, l3 >> 4, (const LAS float*)(lds + G8_BIAS + (ui & 1) * 1024)); }
        if (!has_next) break;
#pragma unroll
        for (int a = 0; a < 2; ++a)
#pragma unroll
            for (int b = 0; b < 2; ++b)
#pragma unroll
                for (int m = 0; m < 4; ++m)
#pragma unroll
                    for (int n = 0; n < 2; ++n) acc[a][b][m][n] = (f32x4){0.f, 0.f, 0.f, 0.f};
        cur = nxt; cB = nB; cA = nA; ++ui;
        if (wr == 1) G8_BAR;
    }
    G8_WAIT_V(0);
    G8_BAR;
#undef G8_SA
#undef G8_SB
#undef G8_GLDS
#undef G8_STAGE_D
#undef G8_STAGE_A
#undef G8_LDA
#undef G8_LDB
#undef G8_MMA
#undef G8_CAT
#undef G8_WAIT_V
#undef G8_WAIT_L
#undef G8_BAR
#undef G8_SCHED
}

__device__ __forceinline__ float logsigmoid_f(float x) { return fminf(x, 0.f) - log1pf(__expf(-fabsf(x))); }
__device__ __forceinline__ void phase_gla_prep(KA a, int li, LAS unsigned char* lds, int tid, int bx, int G) {
    const int lane = tid & 63, wave = __builtin_amdgcn_readfirstlane(tid >> 6), fr = lane & 15, fq = lane >> 4;
    unsigned char* ws = a->ws;
    const bf16* qkvr = (const bf16*)(ws + WS_BIG); const float* lr = (const float*)(ws + WS_LR);
    bf16* QE = (bf16*)(ws + WS_QE); bf16* KET = (bf16*)(ws + WS_KET); bf16* PP = (bf16*)(ws + WS_P); bf16* VT = (bf16*)(ws + WS_VT); float* EL = (float*)(ws + WS_EL);
    constexpr int LS = 136, VLS = 264;
    LAS bf16* qes = (LAS bf16*)lds;
    LAS bf16* kes = qes + 64 * LS;
    LAS float* lrs = (LAS float*)(kes + 64 * LS);
    LAS float* segtot = lrs + 1024;
    LAS bf16* vraw = (LAS bf16*)(segtot + 512);
    const int d = tid & 127, seg = tid >> 7;
    const int so = tid & 15, sr = tid >> 4;
    u32x4 pq[2], pk[2], pv[4]; float plr[2], pw[16], pbg;
#define PF_LOAD(it_) do { const int it__ = (it_); const int chunk_ = it__ & 63, dir_ = (it__ >> 6) & 1, h_ = (it__ >> 7) & 3, b_ = it__ >> 9; const int row0_ = b_ * SEQ + chunk_ * 64; \
        _Pragma("unroll") for (int k2 = 0; k2 < 2; ++k2) { const bf16* src = qkvr + (size_t)(row0_ + sr + 32 * k2) * GLA_MAIN + h_ * 128 + 8 * so; pq[k2] = *(const u32x4*)src; pk[k2] = *(const u32x4*)(src + 512); } \
        if (dir_ == 0) { _Pragma("unroll") for (int k4 = 0; k4 < 4; ++k4) { const int idx = tid + 512 * k4; pv[k4] = *(const u32x4*)(qkvr + (size_t)(row0_ + (idx >> 5)) * GLA_MAIN + 1024 + h_ * 256 + 8 * (idx & 31)); } } \
        _Pragma("unroll") for (int k2 = 0; k2 < 2; ++k2) { const int i = tid + 512 * k2; plr[k2] = lr[(size_t)(row0_ + (i >> 4)) * 32 + dir_ * 16 + (i & 15)]; } \
        { const float* wg2_ = a->in[dir_ ? I_GWG2B : I_GWG2F] + (size_t)li * 16 * 512 + h_ * 128 + d; _Pragma("unroll") for (int r = 0; r < 16; ++r) pw[r] = wg2_[r * 512]; pbg = a->in[dir_ ? I_GBGB : I_GBGF][(size_t)li * 512 + h_ * 128 + d]; } } while (0)
    if (bx < 4096) PF_LOAD(bx);
    for (int it = bx; it < 4096; it += G) {
        const int chunk = it & 63, dir = (it >> 6) & 1, h = (it >> 7) & 3, b = it >> 9;
        const int row0 = b * SEQ + chunk * 64;
        const size_t cidx = (size_t)(((dir * 8 + b) * 4 + h) * 64 + chunk);
#pragma unroll
        for (int k2 = 0; k2 < 2; ++k2) { const int p = sr + 32 * k2; *(LAS u32x4*)(qes + p * LS + 8 * so) = pq[k2]; *(LAS u32x4*)(kes + p * LS + 8 * so) = pk[k2]; }
        if (dir == 0) {
#pragma unroll
            for (int k4 = 0; k4 < 4; ++k4) { const int idx = tid + 512 * k4; *(LAS u32x4*)(vraw + (idx >> 5) * VLS + 8 * (idx & 31)) = pv[k4]; }
        }
#pragma unroll
        for (int k2 = 0; k2 < 2; ++k2) lrs[tid + 512 * k2] = plr[k2];
        float wcol[16];
#pragma unroll
        for (int r = 0; r < 16; ++r) wcol[r] = pw[r];
        const float bgd = pbg;
        __syncthreads();
        if (it + G < 4096) PF_LOAD(it + G);
        float g[16];
#pragma unroll
        for (int s2 = 0; s2 < 16; ++s2) { const LAS float* lp = lrs + (seg * 16 + s2) * 16; float x = bgd;
#pragma unroll
            for (int r4 = 0; r4 < 4; ++r4) { const f32x4 l4 = *(const LAS f32x4*)(lp + 4 * r4); x += l4[0] * wcol[4 * r4] + l4[1] * wcol[4 * r4 + 1] + l4[2] * wcol[4 * r4 + 2] + l4[3] * wcol[4 * r4 + 3]; }
            g[s2] = (fminf(x, 0.f) - __logf(1.0f + __expf(-fabsf(x)))) * (1.0f / 16.0f); }
        if (dir == 0) {
#pragma unroll
            for (int s2 = 1; s2 < 16; ++s2) g[s2] += g[s2 - 1];
        } else {
#pragma unroll
            for (int s2 = 14; s2 >= 0; --s2) g[s2] += g[s2 + 1];
        }
        segtot[seg * 128 + d] = dir ? g[0] : g[15];
        __syncthreads();
        float pre = 0.f, total = 0.f;
#pragma unroll
        for (int sg = 0; sg < 4; ++sg) { const float t = segtot[sg * 128 + d]; total += t; if (dir ? (sg > seg) : (sg < seg)) pre += t; }
        if (seg == 0) EL[cidx * 128 + d] = __expf(total);
        unsigned kt[8];
#pragma unroll
        for (int s2 = 0; s2 < 16; s2 += 2) {
            unsigned kw[2];
#pragma unroll
            for (int u = 0; u < 2; ++u) { const int p = seg * 16 + s2 + u;
                const float q = bf2f(qes[p * LS + d]), k = bf2f(kes[p * LS + d]); const float bb = g[s2 + u] + pre;
                const float eb_ = __expf(bb); const unsigned qw = cvt_pk_bf16(q * eb_, 0.f) & 0xffffu; kw[u] = cvt_pk_bf16(k * __builtin_amdgcn_rcpf(eb_), 0.f) & 0xffffu;
                qes[p * LS + d] = (bf16)qw; kes[p * LS + d] = (bf16)kw[u]; }
            kt[s2 >> 1] = kw[0] | (kw[1] << 16);
        }
        { bf16* kp = KET + cidx * 8192 + (size_t)d * 64 + seg * 16; *(u32x4*)kp = (u32x4){kt[0], kt[1], kt[2], kt[3]}; *(u32x4*)(kp + 8) = (u32x4){kt[4], kt[5], kt[6], kt[7]}; }
        __syncthreads();
#pragma unroll
        for (int k2 = 0; k2 < 2; ++k2) { const int p = sr + 32 * k2; *(u32x4*)(QE + ((size_t)dir * T + row0 + p) * 512 + h * 128 + 8 * so) = *(const LAS u32x4*)(qes + p * LS + 8 * so); }
        { const int jt = wave & 3;
#pragma unroll
          for (int ii = 0; ii < 2; ++ii) { const int itile = 2 * (wave >> 2) + ii;
            f32x4 acc = (f32x4){0.f, 0.f, 0.f, 0.f};
            const bool dead = dir ? (jt < itile) : (jt > itile);
            if (!dead) {
#pragma unroll
                for (int ks = 0; ks < 4; ++ks) { const bf16x8 kf = *(const LAS bf16x8*)(kes + (jt * 16 + fr) * LS + ks * 32 + 8 * fq), qf = *(const LAS bf16x8*)(qes + (itile * 16 + fr) * LS + ks * 32 + 8 * fq);
                    acc = __builtin_amdgcn_mfma_f32_16x16x32_bf16(kf, qf, acc, 0, 0, 0); }
            }
            const int i = itile * 16 + fr, j0 = jt * 16 + 4 * fq; float pv[4];
#pragma unroll
            for (int jj = 0; jj < 4; ++jj) { const int j = j0 + jj; const bool keep = dir ? (j >= i) : (j <= i); pv[jj] = keep ? acc[jj] : 0.f; }
            u32x2 o; o.x = cvt_pk_bf16(pv[0], pv[1]); o.y = cvt_pk_bf16(pv[2], pv[3]);
            *(u32x2*)(PP + cidx * 4096 + (size_t)i * 64 + j0) = o; } }
        if (dir == 0) {
            const int e = tid & 255, jh = tid >> 8; unsigned w[16];
#pragma unroll
            for (int jj = 0; jj < 32; jj += 2) w[jj >> 1] = (unsigned)vraw[(jh * 32 + jj) * VLS + e] | ((unsigned)vraw[(jh * 32 + jj + 1) * VLS + e] << 16);
            bf16* vp = VT + ((size_t)((b * 4 + h) * 64 + chunk) * 256 + e) * 64 + jh * 32;
#pragma unroll
            for (int q4 = 0; q4 < 4; ++q4) *(u32x4*)(vp + 8 * q4) = (u32x4){w[4 * q4], w[4 * q4 + 1], w[4 * q4 + 2], w[4 * q4 + 3]};
        }
        __syncthreads();
    }
}
#undef PF_LOAD
__device__ __forceinline__ void phase_gla_scan(KA a, LAS unsigned char* lds, int tid, int bx, int G) {
    const int lane = tid & 63, wave = __builtin_amdgcn_readfirstlane(tid >> 6), fr = lane & 15, fq = lane >> 4;
    unsigned char* ws = a->ws;
    const char* QE = (const char*)(ws + WS_QE); const char* KET = (const char*)(ws + WS_KET); const char* PP = (const char*)(ws + WS_P); const char* VT = (const char*)(ws + WS_VT); const float* EL = (const float*)(ws + WS_EL);
    constexpr int SS = 136, ST_BYTES = 2 * 64 * SS * 2, BUFB = 50176, OQ = 0, OP = 16384, OK_ = 24576, OV = 40960, OE = 49152;
    LAS bf16* ST = (LAS bf16*)lds;
    LAS unsigned char* BUF = lds + ST_BYTES;
    const int et0 = 2 * (wave & 1), dt0 = 2 * (wave >> 1), itile = wave >> 1;
    const int rq = lane >> 4, pq = lane & 15, r8 = lane >> 3, p8 = lane & 7;
    unsigned sq[2], sk[2], sp, sv;
#pragma unroll
    for (int j = 0; j < 2; ++j) { const int r = 4 * (wave + 8 * j) + rq; sq[j] = (unsigned)(r * 1024 + ((pq ^ (r & 15)) * 16)); const int dk = 8 * (wave + 8 * j) + r8; sk[j] = (unsigned)(dk * 128 + ((p8 ^ ((dk >> 1) & 7)) * 16)); }
    { const int r = 8 * wave + r8; sp = (unsigned)(r * 128 + ((p8 ^ ((r >> 1) & 7)) * 16)); sv = sp; }
    const int kx = fr >> 1;
    for (int it0 = bx; it0 < 256; it0 += G) {
        const int it = (G == 256) ? ((it0 & 7) * 32 + (it0 >> 3)) : it0;
        const int b = it >> 5, h = (it >> 3) & 3, dir = (it >> 2) & 1, es = it & 3;
        bf16* OO = (bf16*)(ws + (dir ? WS_OB : WS_OF));
        __syncthreads();
        for (int i = tid; i < 64 * SS / 2; i += NTHREADS) ((LAS unsigned*)ST)[i] = 0u;
        f32x4 accS[2][2];
#pragma unroll
        for (int x = 0; x < 2; ++x)
#pragma unroll
            for (int y = 0; y < 2; ++y) accS[x][y] = (f32x4){0.f, 0.f, 0.f, 0.f};
        const size_t cbase = (size_t)((dir * 8 + b) * 4 + h) * 64;
        const char* qsrc = QE + (((size_t)dir * T + (size_t)b * SEQ) * 512 + h * 128) * 2;
        const char* psrc = PP + cbase * 8192;
        const char* ksrc = KET + cbase * 16384;
        const char* vsrc = VT + ((size_t)(b * 4 + h) * 64 * 256 + es * 64) * 128;
        const char* esrc = (const char*)(EL + cbase * 128);
        char* ob = (char*)(OO + ((size_t)b * SEQ + itile * 16) * D + h * 256 + es * 64 + et0 * 16);
        const unsigned le = (unsigned)fq * 16u, lo = (unsigned)(fr * D + 4 * fq) * 2u;
#define SC_DMA(c_, bi_) do { const size_t c__ = (size_t)(c_); LAS unsigned char* bb_ = BUF + (bi_) * BUFB + wave * 1024; \
            __builtin_amdgcn_global_load_lds((const unsigned*)(qsrc + c__ * 65536 + sq[0]), (LAS unsigned*)(bb_ + OQ), 16, 0, 0); \
            __builtin_amdgcn_global_load_lds((const unsigned*)(qsrc + c__ * 65536 + sq[1]), (LAS unsigned*)(bb_ + OQ + 8192), 16, 0, 0); \
            __builtin_amdgcn_global_load_lds((const unsigned*)(psrc + c__ * 8192 + sp), (LAS unsigned*)(bb_ + OP), 16, 0, 0); \
            __builtin_amdgcn_global_load_lds((const unsigned*)(ksrc + c__ * 16384 + sk[0]), (LAS unsigned*)(bb_ + OK_), 16, 0, 0); \
            __builtin_amdgcn_global_load_lds((const unsigned*)(ksrc + c__ * 16384 + sk[1]), (LAS unsigned*)(bb_ + OK_ + 8192), 16, 0, 0); \
            __builtin_amdgcn_global_load_lds((const unsigned*)(vsrc + c__ * 32768 + sv), (LAS unsigned*)(bb_ + OV), 16, 0, 0); \
            if (wave == 0) __builtin_amdgcn_global_load_lds((const unsigned*)(esrc + c__ * 512 + lane * 16), (LAS unsigned*)(BUF + (bi_) * BUFB + OE), 16, 0, 0); } while (0)
        SC_DMA(dir ? 63 : 0, 0);
        asm volatile("s_waitcnt vmcnt(0)" ::: "memory");
        __syncthreads();
#pragma unroll 1
        for (int cc = 0; cc < 64; ++cc) {
            const int c = dir ? 63 - cc : cc;
            if (cc + 1 < 64) SC_DMA(dir ? 62 - cc : cc + 1, (cc + 1) & 1);
            const LAS unsigned char* B = BUF + (cc & 1) * BUFB;
            const f32x4 el0 = *(const LAS f32x4*)(B + OE + dt0 * 64 + le), el1 = *(const LAS f32x4*)(B + OE + dt0 * 64 + 64 + le);
            const LAS bf16* Sr = ST + (cc & 1) * 64 * SS; LAS bf16* Sw = ST + ((cc + 1) & 1) * 64 * SS;
            bf16x8 qf[4], pf[2], vf[2][2];
#pragma unroll
            for (int ks = 0; ks < 4; ++ks) qf[ks] = *(const LAS bf16x8*)(B + OQ + (itile * 16 + fr) * 256 + (((4 * ks + fq) ^ fr) * 16));
#pragma unroll
            for (int ks = 0; ks < 2; ++ks) pf[ks] = *(const LAS bf16x8*)(B + OP + (itile * 16 + fr) * 128 + (((4 * ks + fq) ^ kx) * 16));
#pragma unroll
            for (int et = 0; et < 2; ++et)
#pragma unroll
                for (int ks = 0; ks < 2; ++ks) vf[et][ks] = *(const LAS bf16x8*)(B + OV + ((et0 + et) * 16 + fr) * 128 + (((4 * ks + fq) ^ kx) * 16));
#pragma unroll
            for (int et = 0; et < 2; ++et) { f32x4 ao = (f32x4){0.f, 0.f, 0.f, 0.f};
#pragma unroll
                for (int ks = 0; ks < 4; ++ks) { const bf16x8 sf = *(const LAS bf16x8*)(Sr + ((et0 + et) * 16 + fr) * SS + ks * 32 + 8 * fq); ao = __builtin_amdgcn_mfma_f32_16x16x32_bf16(sf, qf[ks], ao, 0, 0, 0); }
#pragma unroll
                for (int ks = 0; ks < 2; ++ks) ao = __builtin_amdgcn_mfma_f32_16x16x32_bf16(vf[et][ks], pf[ks], ao, 0, 0, 0);
                u32x2 o; o.x = cvt_pk_bf16(ao[0], ao[1]); o.y = cvt_pk_bf16(ao[2], ao[3]);
                *(u32x2*)(ob + (size_t)c * (64 * D * 2) + et * 32 + lo) = o; }
#pragma unroll
            for (int dt = 0; dt < 2; ++dt) { bf16x8 kf[2];
#pragma unroll
                for (int ks = 0; ks < 2; ++ks) kf[ks] = *(const LAS bf16x8*)(B + OK_ + ((dt0 + dt) * 16 + fr) * 128 + (((4 * ks + fq) ^ kx) * 16));
#pragma unroll
                for (int et = 0; et < 2; ++et) {
#pragma unroll
                    for (int ks = 0; ks < 2; ++ks) accS[dt][et] = __builtin_amdgcn_mfma_f32_16x16x32_bf16(kf[ks], vf[et][ks], accS[dt][et], 0, 0, 0);
                    accS[dt][et] = accS[dt][et] * (dt ? el1 : el0);
                    u32x2 o; o.x = cvt_pk_bf16(accS[dt][et][0], accS[dt][et][1]); o.y = cvt_pk_bf16(accS[dt][et][2], accS[dt][et][3]);
                    *(LAS u32x2*)(Sw + ((et0 + et) * 16 + fr) * SS + (dt0 + dt) * 16 + 4 * fq) = o; } }
            asm volatile("s_waitcnt vmcnt(0)" ::: "memory");
            __syncthreads();
        }
#undef SC_DMA
    }
}

__device__ __forceinline__ void phase_gla_post(KA a, int li, int tid, int bx, int G) {
    const int lane = tid & 63, wave = tid >> 6;
    const bf16* of = (const bf16*)(a->ws + WS_OF); const bf16* ob = (const bf16*)(a->ws + WS_OB); const bf16* qkvr = (const bf16*)(a->ws + WS_BIG); bf16* A2 = (bf16*)(a->ws + WS_A2);
    const float* ng = a->in[I_GNORM] + (size_t)li * 256 + (lane & 15) * 16;
    float g[16];
#pragma unroll
    for (int j = 0; j < 16; ++j) g[j] = ng[j];
    for (int token = bx * NWAVES + wave; token < T; token += G * NWAVES) {
        const u32x4 f0 = *(const u32x4*)(of + (size_t)token * D + 16 * lane), f1 = *(const u32x4*)(of + (size_t)token * D + 16 * lane + 8);
        const u32x4 b0 = *(const u32x4*)(ob + (size_t)token * D + 16 * lane), b1 = *(const u32x4*)(ob + (size_t)token * D + 16 * lane + 8);
        const u32x4 r0 = *(const u32x4*)(qkvr + (size_t)token * GLA_MAIN + 2048 + 16 * lane), r1 = *(const u32x4*)(qkvr + (size_t)token * GLA_MAIN + 2048 + 16 * lane + 8);
        float o[16], r[16];
#pragma unroll
        for (int q = 0; q < 4; ++q) { o[2 * q] = bf_lo(f0[q]) + bf_lo(b0[q]); o[2 * q + 1] = bf_hi(f0[q]) + bf_hi(b0[q]); o[8 + 2 * q] = bf_lo(f1[q]) + bf_lo(b1[q]); o[8 + 2 * q + 1] = bf_hi(f1[q]) + bf_hi(b1[q]);
            r[2 * q] = bf_lo(r0[q]); r[2 * q + 1] = bf_hi(r0[q]); r[8 + 2 * q] = bf_lo(r1[q]); r[8 + 2 * q + 1] = bf_hi(r1[q]); }
        float ss = 0.f;
#pragma unroll
        for (int j = 0; j < 16; ++j) ss += o[j] * o[j];
        ss += shfl_xor_f(ss, 1, lane); ss += shfl_xor_f(ss, 2, lane); ss += shfl_xor_f(ss, 4, lane); ss += shfl_xor_f(ss, 8, lane);
        const float rstd = 1.0f / sqrtf(ss * (1.0f / 256.0f) + LN_EPS);
        unsigned w[8];
#pragma unroll
        for (int q = 0; q < 8; ++q) w[q] = cvt_pk_bf16(o[2 * q] * rstd * g[2 * q] * silu_f(r[2 * q]), o[2 * q + 1] * rstd * g[2 * q + 1] * silu_f(r[2 * q + 1]));
        *(u32x4*)(A2 + (size_t)token * D + 16 * lane) = (u32x4){w[0], w[1], w[2], w[3]}; *(u32x4*)(A2 + (size_t)token * D + 16 * lane + 8) = (u32x4){w[4], w[5], w[6], w[7]};
    }
}

__device__ __forceinline__ void phase_sgu_core(KA a, int li, LAS unsigned char* lds, int tid, int bx, int G) {
    const int lane = tid & 63, wave = __builtin_amdgcn_readfirstlane(tid >> 6), fr = lane & 15, fq = lane >> 4;
    unsigned char* ws = a->ws;
    const bf16* z = (const bf16*)(ws + WS_BIG); bf16* A2 = (bf16*)(ws + WS_A2);
    const float* lng = a->in[I_SLNG] + (size_t)li * 1024; const float* lnb = a->in[I_SLNB] + (size_t)li * 1024;
    const bf16* wsp = (const bf16*)(ws + WS_SGUWS) + (size_t)li * 8 * 128 * 128; const float* bs = a->in[I_SBS] + (size_t)li * 8 * 128;
    constexpr int VS = 132;
    LAS bf16* vn = (LAS bf16*)lds;
    LAS float* st_mean = (LAS float*)(lds + 2 * 128 * VS * 2); LAS float* st_rstd = st_mean + 128;
    const int co = tid & 15, qr = tid >> 4;
    for (int it = bx; it < T / 128; it += G) {
        const int row0 = it * 128;
        __syncthreads();
#pragma unroll 1
        for (int rr = 0; rr < 16; ++rr) { const int q = wave * 16 + rr; const bf16* vp = z + (size_t)(row0 + q) * 2048 + 1024 + 16 * lane;
            const u32x4 v0 = *(const u32x4*)vp, v1 = *(const u32x4*)(vp + 8); float x[16];
#pragma unroll
            for (int k = 0; k < 4; ++k) { x[2 * k] = bf_lo(v0[k]); x[2 * k + 1] = bf_hi(v0[k]); x[8 + 2 * k] = bf_lo(v1[k]); x[8 + 2 * k + 1] = bf_hi(v1[k]); }
            float s1 = 0.f;
#pragma unroll
            for (int k = 0; k < 16; ++k) s1 += x[k];
            const float mean = wave_sum(s1, lane) * (1.0f / 1024.0f); float s2 = 0.f;
#pragma unroll
            for (int k = 0; k < 16; ++k) { const float dd = x[k] - mean; s2 += dd * dd; }
            const float rstd = 1.0f / sqrtf(wave_sum(s2, lane) * (1.0f / 1024.0f) + LN_EPS);
            if (lane == 0) { st_mean[q] = mean; st_rstd[q] = rstd; } }
        __syncthreads();
        const int p = wave * 16 + fr;
#pragma unroll 1
        for (int g = 0; g < 8; ++g) {
            LAS bf16* vb = vn + (g & 1) * 128 * VS;
            {
                const f32x4 g0 = *(const f32x4*)(lng + g * 128 + 8 * co), g1 = *(const f32x4*)(lng + g * 128 + 8 * co + 4), b0 = *(const f32x4*)(lnb + g * 128 + 8 * co), b1 = *(const f32x4*)(lnb + g * 128 + 8 * co + 4);
#pragma unroll
                for (int k = 0; k < 4; ++k) { const int q = qr + 32 * k; const u32x4 w = *(const u32x4*)(z + (size_t)(row0 + q) * 2048 + 1024 + g * 128 + 8 * co);
                    const float m = st_mean[q], r = st_rstd[q];
                    u32x2 o0, o1;
                    o0.x = cvt_pk_bf16((bf_lo(w.x) - m) * r * g0[0] + b0[0], (bf_hi(w.x) - m) * r * g0[1] + b0[1]); o0.y = cvt_pk_bf16((bf_lo(w.y) - m) * r * g0[2] + b0[2], (bf_hi(w.y) - m) * r * g0[3] + b0[3]);
                    o1.x = cvt_pk_bf16((bf_lo(w.z) - m) * r * g1[0] + b1[0], (bf_hi(w.z) - m) * r * g1[1] + b1[1]); o1.y = cvt_pk_bf16((bf_lo(w.w) - m) * r * g1[2] + b1[2], (bf_hi(w.w) - m) * r * g1[3] + b1[3]);
                    *(LAS u32x2*)(vb + q * VS + 8 * co) = o0; *(LAS u32x2*)(vb + q * VS + 8 * co + 4) = o1; }
            }
            bf16x8 wf[4];
#pragma unroll
            for (int ks = 0; ks < 4; ++ks) wf[ks] = *(const bf16x8*)(wsp + ((size_t)g * 128 + p) * 128 + ks * 32 + 8 * fq);
            const float bias = bs[g * 128 + p];
            __syncthreads();
#pragma unroll 2
            for (int ct = 0; ct < 8; ++ct) {
                f32x4 acc = (f32x4){0.f, 0.f, 0.f, 0.f};
#pragma unroll
                for (int ks = 0; ks < 4; ++ks) { const LAS bf16* sp = vb + (ks * 32 + 8 * fq) * VS + ct * 16 + fr; unsigned w4[4];
#pragma unroll
                    for (int j2 = 0; j2 < 4; ++j2) w4[j2] = (unsigned)sp[(2 * j2) * VS] | ((unsigned)sp[(2 * j2 + 1) * VS] << 16);
                    const bf16x8 vf = __builtin_bit_cast(bf16x8, (u32x4){w4[0], w4[1], w4[2], w4[3]});
                    acc = __builtin_amdgcn_mfma_f32_16x16x32_bf16(vf, wf[ks], acc, 0, 0, 0); }
                const int c0 = g * 128 + ct * 16 + 4 * fq;
                const u32x2 uu = *(const u32x2*)(z + (size_t)(row0 + p) * 2048 + c0);
                u32x2 o; o.x = cvt_pk_bf16(bf_lo(uu.x) * (acc[0] + bias), bf_hi(uu.x) * (acc[1] + bias)); o.y = cvt_pk_bf16(bf_lo(uu.y) * (acc[2] + bias), bf_hi(uu.y) * (acc[3] + bias));
                *(u32x2*)(A2 + (size_t)(row0 + p) * D + c0) = o;
            }
        }
    }
}

constexpr int PH_PER_LAYER = 10;
constexpr int NPHASES = 2 + PH_PER_LAYER * DEPTH;
#define GEMM_BODY(A, g, K, S, E) gemm_fast<false, false>(A, g, K, S, E, lds, tid)
#define GEMM_BODY_G(A, g, K, S, E) gemm_fast<true, false>(A, g, K, S, E, lds, tid)
#define GEMM_BODY8(A, g, K, S, E) gemm_fast<false, true>(A, g, K, S, E, lds, tid)
#define GEMM_BODY8_G(A, g, K, S, E) gemm_fast<true, true>(A, g, K, S, E, lds, tid)
__device__ __forceinline__ void ph_prologue(int wave_s) { PHASE_ENTER(); phase_prologue(a, lds, tid, bx, G); }
__device__ __forceinline__ void ph_rp_init(int wave_s) { PHASE_ENTER(); float* mod = (float*)(ws + WS_MOD);
    RowPass p{}; p.xin = a->in[I_X]; p.hout = (bf16*)(ws + WS_H); p.sc = mod + 1 * 1024; p.sh = mod + 0 * 1024; p.wside = (const bf16*)(ws + WS_GLALR_T); p.lr_out = (float*)(ws + WS_LR); p.has_h = 1; p.has_side = 1;
    row_pass<0>(p, lds, tid, bx, G); }
__device__ __forceinline__ void ph_gla_in(int wave_s, int li) { PHASE_ENTER(); Sched S; S.init(T / 256, GLA_MAIN / 256, G, bx, (const bf16*)(ws + WS_GLAIN_T) + (size_t)li * GLA_MAIN * 1024, 0, nullptr, 2048); EpiGlaIn E{(bf16*)(ws + WS_BIG)}; GEMM_BODY((const bf16*)(ws + WS_H), nullptr, 1024, S, E); }
__device__ __forceinline__ void ph_sgu_in(int wave_s, int li) { PHASE_ENTER(); Sched S; S.init(T / 256, 2048 / 256, G, bx, (const bf16*)(ws + WS_SGUIN_T) + (size_t)li * 2048 * 1024, 0, nullptr, 2048); EpiSguIn E{(bf16*)(ws + WS_BIG), a->in[I_SBIN] + (size_t)li * 2048}; GEMM_BODY((const bf16*)(ws + WS_H), nullptr, 1024, S, E); }
__device__ __forceinline__ void ph_gla_prep(int wave_s, int li) { PHASE_ENTER(); phase_gla_prep(a, li, lds, tid, bx, G); }
__device__ __forceinline__ void ph_gla_scan(int wave_s) { PHASE_ENTER(); phase_gla_scan(a, lds, tid, bx, G); }
__device__ __forceinline__ void ph_sgu_core(int wave_s, int li) { PHASE_ENTER(); phase_sgu_core(a, li, lds, tid, bx, G); }
__device__ __forceinline__ void ph_gla_post(int wave_s, int li) { PHASE_ENTER(); phase_gla_post(a, li, tid, bx, G); }
__device__ __forceinline__ void ph_out(int wave_s, int l) { PHASE_ENTER(); const int li = l >> 1; const bool sgu = (l & 1) != 0;
    Sched S; S.init(T / 256, 4, G, bx, (const bf16*)(ws + (sgu ? WS_SGUOUT_T : WS_GLAOUT_T)) + (size_t)li * 1024 * 1024, 0, nullptr, 2048);
    EpiOut E{(bf16*)(ws + WS_Y), sgu ? a->in[I_SBOUT] + (size_t)li * 1024 : nullptr}; GEMM_BODY((const bf16*)(ws + WS_A2), nullptr, 1024, S, E); }
__device__ __forceinline__ void ph_rp_mid(int wave_s, int l) { PHASE_ENTER(); float* modl = (float*)(ws + WS_MOD) + (size_t)l * 8 * 6144; int* route = (int*)(ws + WS_ROUTE);
    RowPass p{}; p.xin = (l == 0) ? (const void*)a->in[I_X] : (const void*)(ws + WS_X2); p.xin16 = (l != 0); p.y = (const bf16*)(ws + WS_Y); p.xout = ws + WS_X1; p.xout16 = 1; p.hout = (bf16*)(ws + WS_H);
    p.gate = modl + 2 * 1024; p.lng = a->in[I_LNG] + (size_t)(l * 2 + 0) * 1024; p.lnb = a->in[I_LNB] + (size_t)(l * 2 + 0) * 1024; p.sc = modl + 4 * 1024; p.sh = modl + 3 * 1024;
    p.wside = (const bf16*)(ws + WS_ROUTER_T) + (size_t)l * 64 * 1024; p.rbias = a->in[I_RB] + (size_t)l * 32;
    p.topi = route + R_TOPI; p.topw = (float*)(route + R_TOPW); p.hist = route + R_HIST + bx * 32; p.has_h = 1; p.has_side = 1; p.h8out = MOE_FP8 ? (ws + WS_H8) : nullptr;
    row_pass<1>(p, lds, tid, bx, G); }
__device__ __forceinline__ void ph_place(int wave_s) { PHASE_ENTER(); phase_place((int*)(ws + WS_ROUTE), lds, tid, bx, G); }
__device__ __forceinline__ void ph_moe_up(int wave_s, int l) { PHASE_ENTER(); int* route = (int*)(ws + WS_ROUTE); const int ntiles = __builtin_amdgcn_readfirstlane(route[R_NTILES]);
#if MOE_FP8
    Sched S; S.init(ntiles, 8, G, bx, ws + WS_WUP_T + (size_t)l * 32 * 2048 * 1024, (size_t)2048 * 1024, route + R_TILEE, 1024);
    EpiUp<true> E{ws + WS_ACT, a->in[I_BUP] + (size_t)l * 32 * 2048}; GEMM_BODY8_G(ws + WS_H8, route + R_BUFTOK, 1024, S, E); }
#else
    Sched S; S.init(ntiles, 8, G, bx, ws + WS_WUP_T + (size_t)l * 32 * 2048 * 2048, (size_t)2048 * 2048, route + R_TILEE, 2048);
    EpiUp<false> E{ws + WS_ACT, a->in[I_BUP] + (size_t)l * 32 * 2048}; GEMM_BODY_G(ws + WS_H, route + R_BUFTOK, 1024, S, E); }
#endif
__device__ __forceinline__ void ph_moe_down(int wave_s, int l) { PHASE_ENTER(); int* route = (int*)(ws + WS_ROUTE); const int ntiles = __builtin_amdgcn_readfirstlane(route[R_NTILES]);
#if MOE_FP8
    Sched S; S.init(ntiles, 4, G, bx, ws + WS_WDN_T + (size_t)l * 32 * 1024 * 1024, (size_t)1024 * 1024, route + R_TILEE, 1024);
    EpiDown8 E{ws + WS_YS, a->in[I_BDN] + (size_t)l * 32 * 1024, 1.0f / (F8_WSCALE * F8_ASCALE)}; GEMM_BODY8(ws + WS_ACT, nullptr, 1024, S, E); }
#else
    Sched S; S.init(ntiles, 4, G, bx, ws + WS_WDN_T + (size_t)l * 32 * 1024 * 2048, (size_t)1024 * 2048, route + R_TILEE, 2048);
    EpiDown E{(bf16*)(ws + WS_YS), a->in[I_BDN] + (size_t)l * 32 * 1024, 1.0f}; GEMM_BODY(ws + WS_ACT, nullptr, 1024, S, E); }
#endif
__device__ __forceinline__ void ph_rp_end(int wave_s, int l) { PHASE_ENTER(); float* mod = (float*)(ws + WS_MOD); float* modl = mod + (size_t)l * 8 * 6144; int* route = (int*)(ws + WS_ROUTE);
    RowPass p{}; p.xin = ws + WS_X1; p.xin16 = 1; p.xout = (l == DEPTH - 1) ? (void*)a->out : (void*)(ws + WS_X2); p.xout16 = (l != DEPTH - 1); p.hout = (bf16*)(ws + WS_H);
    p.gate = modl + 5 * 1024; p.lng = a->in[I_LNG] + (size_t)(l * 2 + 1) * 1024; p.lnb = a->in[I_LNB] + (size_t)(l * 2 + 1) * 1024;
    p.ys = ws + WS_YS; p.dest = route + R_DEST; p.tw = (const float*)(route + R_TOPW);
    if (l < DEPTH - 1) { float* modn = mod + (size_t)(l + 1) * 8 * 6144; p.sc = modn + 1 * 1024; p.sh = modn + 0 * 1024; p.has_h = 1;
        if (((l + 1) & 1) == 0) { p.has_side = 1; p.wside = (const bf16*)(ws + WS_GLALR_T) + (size_t)((l + 1) >> 1) * 64 * 1024; p.lr_out = (float*)(ws + WS_LR); } }
    row_pass<2>(p, lds, tid, bx, G); }

__global__ void __launch_bounds__(NTHREADS, 2) fwd_kernel(Args a) {
    extern __shared__ __attribute__((aligned(16))) unsigned char lds_raw[];
    LAS unsigned char* lds = (LAS unsigned char*)lds_raw;
    volatile LAS unsigned* MISC = (volatile LAS unsigned*)(lds + MISC_OFF);
    const int tid = threadIdx.x; const int wave_s = __builtin_amdgcn_readfirstlane(tid >> 6);
    if (tid < 32) ((LAS unsigned*)(lds + MISC_OFF))[tid] = 0u;
    __syncthreads();
    unsigned* ctl = (unsigned*)(a.ws + WS_CTL);
    XcdBarrier bar = xcd_barrier_post(ctl + CW_BAR + a.li * XCD_BAR_WORDS, MISC + 8);
    const int lo = a.ph_lo, hi = a.ph_hi;
#ifndef REPK
#define REPK 0
#define REPN 1
#endif
#define REP(kind) for (int rep_ = 0; rep_ < ((REPK == (kind)) ? REPN : 1); ++rep_)
#define IN(k) (lo <= (k) && (k) < hi)
#define SEAM(k) do { if (IN(k) && IN((k) + 1)) xcd_barrier(bar); } while (0)
    if (IN(0)) { REP(3) ph_prologue(wave_s); SEAM(0); }
    if (IN(1)) { ph_rp_init(wave_s); SEAM(1); }
    for (int l = 0; l < DEPTH; ++l) {
        const int pb = 2 + PH_PER_LAYER * l, li = l >> 1; const bool sgu = (l & 1) != 0;
        if (IN(pb + 0)) { REP(10) { if (!sgu) ph_gla_in(wave_s, li); else ph_sgu_in(wave_s, li); } SEAM(pb + 0); }
        if (IN(pb + 1)) { if (!sgu) { REP(12) ph_gla_prep(wave_s, li); SEAM(pb + 1); } }
        if (IN(pb + 2)) { if (!sgu) { REP(1) ph_gla_scan(wave_s); } else { REP(2) ph_sgu_core(wave_s, li); } SEAM(pb + 2); }
        if (IN(pb + 3)) { if (!sgu) { REP(6) ph_gla_post(wave_s, li); SEAM(pb + 3); } }
        if (IN(pb + 4)) { REP(11) ph_out(wave_s, l); SEAM(pb + 4); }
        if (IN(pb + 5)) { REP(4) ph_rp_mid(wave_s, l); SEAM(pb + 5); }
        if (IN(pb + 6)) { REP(7) ph_place(wave_s); SEAM(pb + 6); }
        if (IN(pb + 7)) { REP(8) ph_moe_up(wave_s, l); SEAM(pb + 7); }
        if (IN(pb + 8)) { REP(9) ph_moe_down(wave_s, l); SEAM(pb + 8); }
        if (IN(pb + 9)) { REP(5) ph_rp_end(wave_s, l); SEAM(pb + 9); }
    }
#undef IN
#undef SEAM
}

#ifndef N_LAUNCH_MODE
#define N_LAUNCH_MODE 1
#endif
extern "C" void kernel_launch(void* const* d_in, const int* in_sizes, int n_in, void* d_out, int out_size, void* d_ws, size_t ws_size, hipStream_t stream) {
    static int grid = 0;
    if (grid == 0) {
        if (n_in != 27 || out_size != T * D || ws_size < WS_END) { fprintf(stderr, "kernel_launch: unexpected shapes (n_in %d out %d ws %zu)\n", n_in, out_size, ws_size); grid = -1; return; }
        int dev = 0, cus = 0, per_cu = 0;
        if (hipGetDevice(&dev) != hipSuccess || hipDeviceGetAttribute(&cus, hipDeviceAttributeMultiprocessorCount, dev) != hipSuccess) { grid = -1; return; }
        if (hipFuncSetAttribute((const void*)fwd_kernel, hipFuncAttributeMaxDynamicSharedMemorySize, LDS_BYTES) != hipSuccess) { fprintf(stderr, "kernel_launch: hipFuncSetAttribute failed\n"); grid = -1; return; }
        if (hipOccupancyMaxActiveBlocksPerMultiprocessor(&per_cu, (const void*)fwd_kernel, NTHREADS, LDS_BYTES) != hipSuccess || per_cu < 1) fprintf(stderr, "kernel_launch: occupancy query reports %d\n", per_cu);
        (void)hipGetLastError();
        grid = cus;
        if (grid > 1024) grid = 1024;
    }
    if (grid < 0) return;
    (void)hipMemsetAsync((char*)d_ws + WS_CTL, 0, CTL_ZERO_BYTES, stream);
    Args a{};
    for (int i = 0; i < 27; ++i) a.in[i] = (const float*)d_in[i];
    a.out = (float*)d_out; a.ws = (unsigned char*)d_ws; a.pad = 0;
#if N_LAUNCH_MODE == 1
    a.ph_lo = 0; a.ph_hi = NPHASES; a.li = 0;
    hipLaunchKernelGGL(fwd_kernel, dim3(grid), dim3(NTHREADS), LDS_BYTES, stream, a);
#else
    for (int ph = 0, li = 0; ph < NPHASES; ++ph) {
        if (ph >= 2 && (((ph - 2) % PH_PER_LAYER) == 1 || ((ph - 2) % PH_PER_LAYER) == 3) && (((ph - 2) / PH_PER_LAYER) & 1)) continue;
        a.ph_lo = ph; a.ph_hi = ph + 1; a.li = li++;
        hipLaunchKernelGGL(fwd_kernel, dim3(grid), dim3(NTHREADS), LDS_BYTES, stream, a);
    }
#endif
}
```

```cpp
#include <hip/hip_runtime.h>
#include <cstdio>
#include <cstdint>

#define LAS __attribute__((address_space(3)))
#define GAS __attribute__((address_space(1)))
typedef unsigned short bf16;
typedef short bf16x8 __attribute__((ext_vector_type(8)));
typedef float f32x4 __attribute__((ext_vector_type(4)));
typedef float f32x2 __attribute__((ext_vector_type(2)));
typedef unsigned u32x4 __attribute__((ext_vector_type(4)));
typedef unsigned u32x2 __attribute__((ext_vector_type(2)));
typedef int i32x4 __attribute__((ext_vector_type(4)));
typedef int i32x8 __attribute__((ext_vector_type(8)));

#ifndef MOE_FP8
#define MOE_FP8 1
#endif
#if !MOE_FP8
#error "the combine row pass reads the expert outputs as e4m3 (MOE_FP8 = 1 only)"
#endif
constexpr int D = 1024, NB = 8, SEQ = 4096, T = NB * SEQ, DEPTH = 4;
constexpr int NE = 32, TOPK = 4, CAP = T * TOPK + NE * 256;
constexpr int MAXTILES = CAP / 256;
constexpr float ALPHA = 1.681792830507429f;
constexpr float LN_EPS = 1e-5f;
#ifndef OUT_FP8
#define OUT_FP8 1
#endif
constexpr float F8_A2SCALE = 8.0f;
#ifndef SGUIN_FP8
#define SGUIN_FP8 1
#endif
constexpr float F8_WSCALE = 64.0f, F8_HSCALE = 8.0f, F8_ASCALE = 4.0f, F8_YSCALE = 64.0f;
constexpr int GLA_IN = 3104, GLA_MAIN = 3072;
constexpr int NWAVES = 8, NTHREADS = 512;
constexpr int LDS_BYTES = 147456, MISC_OFF = 147328;

constexpr size_t MiB = 1u << 20;
constexpr size_t WS_CTL = 0, CTL_ZERO_BYTES = 2 * MiB;
constexpr size_t WS_MOD = 2 * MiB;
constexpr size_t WS_ROUTE = 4 * MiB;
constexpr size_t WS_LR = 8 * MiB;
constexpr size_t WS_GLAIN_T = 16 * MiB;
constexpr size_t WS_GLALR_T = 28 * MiB;
constexpr size_t WS_ROUTER_T = 29 * MiB;
constexpr size_t WS_SGUWS = 30 * MiB;
constexpr size_t WS_GLAOUT_T = 32 * MiB;
constexpr size_t WS_SGUIN_T = 36 * MiB;
constexpr size_t WS_SGUOUT_T = 44 * MiB;
constexpr size_t WS_WUP_T = 64 * MiB;
constexpr size_t WS_WDN_T = 576 * MiB;
constexpr size_t WS_X1 = 832 * MiB;
constexpr size_t WS_X2 = 960 * MiB;
constexpr size_t WS_H = 1088 * MiB;
constexpr size_t WS_BIG = 1152 * MiB;
constexpr size_t WS_OF = 1344 * MiB;
constexpr size_t WS_OB = 1408 * MiB;
constexpr size_t WS_A2 = 1472 * MiB;
constexpr size_t WS_Y = 1536 * MiB;
constexpr size_t WS_ACT = 1664 * MiB;
constexpr size_t WS_YS = 1936 * MiB;
constexpr size_t WS_QE = 2208 * MiB;
constexpr size_t WS_KET = 2272 * MiB;
constexpr size_t WS_P = 2336 * MiB;
constexpr size_t WS_VT = 2368 * MiB;
constexpr size_t WS_EL = 2432 * MiB;
constexpr size_t WS_H8 = 2440 * MiB;
constexpr size_t WS_END = 2472 * MiB;
constexpr int R_TOPI = 0;
constexpr int R_TOPW = T * 4;
constexpr int R_DEST = 2 * T * 4;
constexpr int R_BUFTOK = 3 * T * 4;
constexpr int R_HIST = R_BUFTOK + CAP;
constexpr int R_TILEE = R_HIST + 1024 * 32;
constexpr int R_NTILES = R_TILEE + 1024;
static_assert((size_t)(R_NTILES + 64) * 4 <= 4 * MiB, "route tables");
constexpr int CW_BAR = 4096;
constexpr int MAX_LAUNCH = 64;

#define RLX_AGENT __ATOMIC_RELAXED, __HIP_MEMORY_SCOPE_AGENT
#define LDS_WAIT() asm volatile("s_waitcnt lgkmcnt(0)" ::: "memory")
#define VM_WAIT() asm volatile("s_waitcnt vmcnt(0)" ::: "memory")
typedef __bf16 bf16x2_t __attribute__((ext_vector_type(2)));
__device__ __forceinline__ unsigned cvt_pk_bf16(float lo, float hi) { const f32x2 v = {lo, hi}; const bf16x2_t r = __builtin_convertvector(v, bf16x2_t); return __builtin_bit_cast(unsigned, r); }
__device__ __forceinline__ float bf_lo(unsigned w) { return __uint_as_float(w << 16); }
__device__ __forceinline__ float bf_hi(unsigned w) { return __uint_as_float(w & 0xffff0000u); }
__device__ __forceinline__ float bf2f(bf16 b) { return __uint_as_float(((unsigned)b) << 16); }
__device__ __forceinline__ float shfl_xor_f(float v, int o, int lane) { return __builtin_bit_cast(float, __builtin_amdgcn_ds_bpermute((lane ^ o) << 2, __builtin_bit_cast(int, v))); }
__device__ __forceinline__ int shfl_i(int v, int src, int lane) { (void)lane; return __builtin_amdgcn_ds_bpermute(src << 2, v); }
__device__ __forceinline__ float wave_sum(float v, int lane) {
#pragma unroll
    for (int o = 1; o < 64; o <<= 1) v += shfl_xor_f(v, o, lane);
    return v;
}
__device__ __forceinline__ float row16_sum(float v) {
    v += __builtin_bit_cast(float, __builtin_amdgcn_update_dpp(0, __builtin_bit_cast(int, v), 0xB1, 0xf, 0xf, false));
    v += __builtin_bit_cast(float, __builtin_amdgcn_update_dpp(0, __builtin_bit_cast(int, v), 0x4E, 0xf, 0xf, false));
    v += __builtin_bit_cast(float, __builtin_amdgcn_update_dpp(0, __builtin_bit_cast(int, v), 0x141, 0xf, 0xf, false));
    v += __builtin_bit_cast(float, __builtin_amdgcn_update_dpp(0, __builtin_bit_cast(int, v), 0x140, 0xf, 0xf, false));
    return v;
}
__device__ __forceinline__ float wave_allsum(float v) {
    v = row16_sum(v);
    v += __builtin_bit_cast(float, __builtin_amdgcn_update_dpp(0, __builtin_bit_cast(int, v), 0x142, 0xa, 0xf, false));
    v += __builtin_bit_cast(float, __builtin_amdgcn_update_dpp(0, __builtin_bit_cast(int, v), 0x143, 0xc, 0xf, false));
    return __builtin_bit_cast(float, __builtin_amdgcn_readlane(__builtin_bit_cast(int, v), 63));
}
__device__ __forceinline__ float silu_f(float x) { return x * __builtin_amdgcn_rcpf(1.0f + __expf(-x)); }
__device__ __forceinline__ float sigmoid_f(float x) { return __builtin_amdgcn_rcpf(1.0f + __expf(-x)); }
__device__ __forceinline__ float gelu_f(float v) {
    const float av = fabsf(v), t = __builtin_amdgcn_rcpf(av * 0.2316418882f + 1.0f);
    float q = t * 0.5307027145f + (-0.7265760135f); q = q * t + 0.7107068705f; q = q * t + (-0.142248368f); q = q * t + 0.127414796f; q = q * t;
    const float e = __builtin_amdgcn_exp2f((v * v) * (-0.72134752044f));
    const float m = v * (q * e);
    return v < 0.f ? m : v - m;
}

__device__ __forceinline__ f32x2 gelu2(f32x2 v) {
    const f32x2 t = (f32x2){__builtin_amdgcn_rcpf(fabsf(v[0]) * 0.2316418882f + 1.0f), __builtin_amdgcn_rcpf(fabsf(v[1]) * 0.2316418882f + 1.0f)};
    f32x2 q = t * 0.5307027145f + (-0.7265760135f); q = q * t + 0.7107068705f; q = q * t + (-0.142248368f); q = q * t + 0.127414796f; q = q * t;
    const f32x2 x = (v * v) * (-0.72134752044f);
    const f32x2 qe = q * (f32x2){__builtin_amdgcn_exp2f(x[0]), __builtin_amdgcn_exp2f(x[1])};
    return (f32x2){__builtin_fmaf(-fabsf(v[0]), qe[0], fmaxf(v[0], 0.f)), __builtin_fmaf(-fabsf(v[1]), qe[1], fmaxf(v[1], 0.f))};
}
__device__ __forceinline__ int pack4_fp8_sat(float a0, float a1, float a2, float a3) {
    a0 = __builtin_amdgcn_fmed3f(a0, -448.f, 448.f); a1 = __builtin_amdgcn_fmed3f(a1, -448.f, 448.f); a2 = __builtin_amdgcn_fmed3f(a2, -448.f, 448.f); a3 = __builtin_amdgcn_fmed3f(a3, -448.f, 448.f);
    int w = __builtin_amdgcn_cvt_pk_fp8_f32(a0, a1, 0, false); return __builtin_amdgcn_cvt_pk_fp8_f32(a2, a3, w, true); }
#define XB_TMO      128
#define XB_XCNT(j)  (256  + 64 * (j))
#define XB_XSUB(j)  (1280 + 64 * (j))
#define XB_XGEN(j)  (2304 + 64 * (j))
#define XB_TOP      3328
#define XB_TOPGEN   3392
#define XCD_BAR_WORDS 3456
#define XB_SPIN_CAP (1u << 18)
__device__ __forceinline__ unsigned xb_ld(unsigned* p)              { return __hip_atomic_load(p, __ATOMIC_RELAXED, __HIP_MEMORY_SCOPE_AGENT); }
__device__ __forceinline__ unsigned xb_add(unsigned* p, unsigned v) { return __hip_atomic_fetch_add(p, v, __ATOMIC_RELAXED, __HIP_MEMORY_SCOPE_AGENT); }
__device__ __forceinline__ unsigned xb_xcc_id() { return (unsigned)__builtin_amdgcn_s_getreg((3 << 11) | 20) & 0xFu; }
#define XB_SPIN(cond, bar) do { unsigned _sp = 0; while (cond) { __builtin_amdgcn_s_sleep(1); \
    if ((++_sp & 255u) == 0u) { if (xb_ld(&(bar)[XB_TMO])) break; if (_sp > XB_SPIN_CAP) { atomicAdd(&(bar)[XB_TMO], 1u); break; } } } } while (0)
struct XcdBarrier { unsigned* bar; unsigned x; volatile LAS unsigned* st; };
__device__ __forceinline__ XcdBarrier xcd_barrier_post(unsigned* bar, volatile LAS unsigned* st) {
    XcdBarrier b; b.bar = bar; b.x = xb_xcc_id(); b.st = st;
    if (threadIdx.x == 0) (void)xb_add(&bar[XB_XCNT(b.x)], 1u);
    return b;
}
__device__ __forceinline__ void xcd_barrier_complete(unsigned* bar, unsigned x, unsigned& nloc, unsigned& nx) {
    const unsigned G = gridDim.x * gridDim.y * gridDim.z;
    unsigned sum, cnt, mine, sp = 0u;
    for (;;) {
        sum = 0u; cnt = 0u; mine = 0u;
#pragma unroll
        for (unsigned j = 0; j < 16; ++j) { const unsigned c = xb_ld(&bar[XB_XCNT(j)]); sum += c; cnt += (c > 0u) ? 1u : 0u; mine = (j == x) ? c : mine; }
        if (sum == G) break;
        __builtin_amdgcn_s_sleep(1);
        if ((++sp & 255u) == 0u) { if (xb_ld(&bar[XB_TMO])) break; if (sp > XB_SPIN_CAP) { atomicAdd(&bar[XB_TMO], 1u); break; } }
    }
    nloc = mine > 0u ? mine : 1u; nx = cnt > 0u ? cnt : 1u;
}
__device__ __forceinline__ void xcd_barrier(const XcdBarrier& b) {
    asm volatile("s_waitcnt vmcnt(0)" ::: "memory");
    __syncthreads();
    if (threadIdx.x == 0) {
        unsigned* bar = b.bar;
        __builtin_amdgcn_s_waitcnt(0);
        unsigned nloc = b.st[0], nx = b.st[1];
        if (nloc == 0u) { xcd_barrier_complete(bar, b.x, nloc, nx); b.st[0] = nloc; b.st[1] = nx; }
        const unsigned old = xb_add(&bar[XB_XSUB(b.x)], 1u);
        const unsigned gen = old / nloc;
        if (old + 1u == (gen + 1u) * nloc) {
            __builtin_amdgcn_fence(__ATOMIC_RELEASE, "agent");
            asm volatile("s_waitcnt vmcnt(0)" ::: "memory");
            const unsigned og = xb_add(&bar[XB_TOP], 1u);
            const unsigned tg = og / nx;
            if (og + 1u == (tg + 1u) * nx) xb_add(&bar[XB_TOPGEN], 1u);
            else XB_SPIN(xb_ld(&bar[XB_TOPGEN]) == tg, bar);
            __builtin_amdgcn_fence(__ATOMIC_ACQUIRE, "agent");
            xb_add(&bar[XB_XGEN(b.x)], 1u);
            asm volatile("s_waitcnt vmcnt(0)" ::: "memory");
        } else {
            XB_SPIN(xb_ld(&bar[XB_XGEN(b.x)]) == gen, bar);
            __builtin_amdgcn_fence(__ATOMIC_ACQUIRE, "agent");
            asm volatile("s_waitcnt vmcnt(0)" ::: "memory");
        }
    }
    __syncthreads();
}

struct Args { const float* in[27]; float* out; unsigned char* ws; int ph_lo, ph_hi, li, pad; };
enum { I_X = 0, I_C, I_ADAW, I_ADAB, I_LNG, I_LNB, I_GWIN, I_GWG2F, I_GBGF, I_GWG2B, I_GBGB, I_GNORM, I_GWOUT, I_SWIN, I_SBIN, I_SLNG, I_SLNB, I_SWS, I_SBS, I_SWOUT, I_SBOUT, I_RW, I_RB, I_WUP, I_BUP, I_WDN, I_BDN };

typedef const __attribute__((address_space(4))) Args* KA;
#define PHASE_ENTER() unsigned m1_ = ~0u; asm volatile("" : "+s"(m1_)); int tid = (wave_s << 6) | (int)__builtin_amdgcn_mbcnt_hi(m1_, __builtin_amdgcn_mbcnt_lo(m1_, 0u)); asm volatile("" : "+v"(tid)); int bx = blockIdx.x, G = gridDim.x; asm volatile("" : "+s"(bx), "+s"(G)); \
    KA a = (KA)__builtin_amdgcn_kernarg_segment_ptr(); asm volatile("" : "+s"(a)); unsigned char* ws = a->ws; \
    extern __shared__ __attribute__((aligned(16))) unsigned char lds_raw[]; LAS unsigned char* lds = (LAS unsigned char*)lds_raw; (void)lds; (void)ws; (void)bx; (void)G; (void)tid
__device__ __forceinline__ int perm64(int c) {
    return (c & ~255) + 128 * ((c >> 3) & 1) + 32 * ((c >> 6) & 3) + 16 * ((c >> 2) & 1) + 4 * ((c >> 4) & 3) + (c & 3);
}
__device__ __forceinline__ int swiglu_perm(int o) {
    const int a = o >> 1, h = o & 1, pn = a >> 7, r = a & 127, wc = r >> 5, fq = (r >> 3) & 3, bj = (r >> 2) & 1, j = r & 3;
    return 256 * pn + 128 * bj + 32 * wc + 16 * h + 4 * fq + j;
}
__device__ __forceinline__ void conv_tile(const float* W, int K, int N, int k0, int n0, int nw, bf16* dst, int mode, LAS float* scr, int lane) {
    (void)scr;
    if (lane >= nw) return;
    float v[64];
    const float* wp = W + (size_t)k0 * N + n0 + lane;
#pragma unroll
    for (int j = 0; j < 64; ++j) v[j] = __builtin_nontemporal_load(wp + (size_t)j * N);
    const int ng = n0 + lane;
    if (mode >= 3 && mode <= 5) {
        const int row = (mode == 4) ? swiglu_perm(ng) : (mode == 5) ? perm64(ng) : ng;
        unsigned char* dp = (unsigned char*)dst + (size_t)row * K + k0;
#pragma unroll
        for (int q = 0; q < 4; ++q) { unsigned w[4];
#pragma unroll
            for (int u = 0; u < 4; ++u) { const float* x = v + 16 * q + 4 * u; w[u] = (unsigned)pack4_fp8_sat(x[0] * F8_WSCALE, x[1] * F8_WSCALE, x[2] * F8_WSCALE, x[3] * F8_WSCALE); }
            *(u32x4*)(dp + 16 * q) = (u32x4){w[0], w[1], w[2], w[3]}; }
    } else if (mode == 2) {
        bf16* dp = dst + (size_t)lane * K + k0;
#pragma unroll
        for (int q = 0; q < 8; ++q) { const float* x = v + 8 * q; u32x4 o; o.x = cvt_pk_bf16(x[0], x[1]); o.y = cvt_pk_bf16(x[2], x[3]); o.z = cvt_pk_bf16(x[4], x[5]); o.w = cvt_pk_bf16(x[6], x[7]);
            u32x4 l; l.x = cvt_pk_bf16(x[0] - bf_lo(o.x), x[1] - bf_hi(o.x)); l.y = cvt_pk_bf16(x[2] - bf_lo(o.y), x[3] - bf_hi(o.y)); l.z = cvt_pk_bf16(x[4] - bf_lo(o.z), x[5] - bf_hi(o.z)); l.w = cvt_pk_bf16(x[6] - bf_lo(o.w), x[7] - bf_hi(o.w));
            *(u32x4*)(dp + 8 * q) = o; *(u32x4*)(dp + (size_t)32 * K + 8 * q) = l; }
    } else {
        const int row = (mode == 1) ? swiglu_perm(ng) : (mode == 6) ? perm64(ng) : ng;
        bf16* dp = dst + (size_t)row * K + k0;
#pragma unroll
        for (int q = 0; q < 8; ++q) { const float* x = v + 8 * q; *(u32x4*)(dp + 8 * q) = (u32x4){cvt_pk_bf16(x[0], x[1]), cvt_pk_bf16(x[2], x[3]), cvt_pk_bf16(x[4], x[5]), cvt_pk_bf16(x[6], x[7])}; }
    }
}

__device__ __forceinline__ void phase_prologue(KA a, LAS unsigned char* lds, int tid, int bx, int G) {
    const int lane = tid & 63, wave = __builtin_amdgcn_readfirstlane(tid >> 6);
    unsigned char* ws = a->ws;
    for (int slab = bx; slab < 192; slab += G) {
        LAS float* sc = (LAS float*)lds;
        LAS float* red = (LAS float*)(lds + 32768);
        for (int i = tid; i < 8 * 1024; i += NTHREADS) sc[i] = silu_f(a->in[I_C][i]);
        __syncthreads();
        const int g0 = slab * 128, l = g0 / 6144, e0 = g0 % 6144;
        const int c4 = tid & 31, seg = tid >> 5;
        f32x4 acc[8];
#pragma unroll
        for (int b = 0; b < 8; ++b) acc[b] = (f32x4){0.f, 0.f, 0.f, 0.f};
        const float* wp = a->in[I_ADAW] + ((size_t)l * 1024 + seg * 64) * 6144 + e0 + 4 * c4;
#pragma unroll 8
        for (int d = 0; d < 64; ++d) { const f32x4 w = __builtin_nontemporal_load((const f32x4*)(wp + (size_t)d * 6144));
#pragma unroll
            for (int b = 0; b < 8; ++b) acc[b] += w * sc[b * 1024 + seg * 64 + d]; }
#pragma unroll
        for (int b = 0; b < 8; ++b) *(LAS f32x4*)(red + (seg * 8 + b) * 128 + 4 * c4) = acc[b];
        __syncthreads();
        for (int o = tid; o < 1024; o += NTHREADS) { const int b = o >> 7, c = o & 127; float s = a->in[I_ADAB][l * 6144 + e0 + c];
#pragma unroll
            for (int sg = 0; sg < 16; ++sg) s += red[(sg * 8 + b) * 128 + c];
            ((float*)(ws + WS_MOD))[((size_t)l * 8 + b) * 6144 + e0 + c] = s; }
        __syncthreads();
    }
    LAS float* scr = (LAS float*)(lds + wave * 16640);
    const int gw = bx * NWAVES + wave, NGW = G * NWAVES;
    constexpr int N_UP = 128 * 16 * 32, N_DN = 128 * 16 * 16, N_GIN = 2 * 16 * 48, N_GLR = 2 * 16, N_GOUT = 2 * 256, N_SIN = 2 * 16 * 32, N_SOUT = 2 * 256, N_RT = 4 * 16;
    constexpr int NITEMS = N_UP + N_DN + N_GIN + N_GLR + N_GOUT + N_SIN + N_SOUT + N_RT;
    for (int it = gw; it < NITEMS; it += NGW) {
        int r = it;
        if (r < N_UP) { const int m = r >> 9, q = r & 511, kt = q >> 5, nt = q & 31;
            conv_tile(a->in[I_WUP] + (size_t)m * 1024 * 2048, 1024, 2048, kt * 64, nt * 64, 64, (bf16*)(ws + WS_WUP_T + (size_t)m * 2048 * 1024 * (MOE_FP8 ? 1 : 2)), MOE_FP8 ? 4 : 1, scr, lane); continue; } r -= N_UP;
        if (r < N_DN) { const int m = r >> 8, q = r & 255, kt = q >> 4, nt = q & 15;
            conv_tile(a->in[I_WDN] + (size_t)m * 1024 * 1024, 1024, 1024, kt * 64, nt * 64, 64, (bf16*)(ws + WS_WDN_T + (size_t)m * 1024 * 1024 * (MOE_FP8 ? 1 : 2)), MOE_FP8 ? 5 : 0, scr, lane); continue; } r -= N_DN;
        if (r < N_GIN) { const int m = r / 768, q = r % 768, kt = q / 48, nt = q % 48;
            conv_tile(a->in[I_GWIN] + (size_t)m * 1024 * GLA_IN, 1024, GLA_IN, kt * 64, nt * 64, 64, (bf16*)(ws + WS_GLAIN_T) + (size_t)m * GLA_MAIN * 1024, 6, scr, lane); continue; } r -= N_GIN;
        if (r < N_GLR) { const int m = r >> 4, kt = r & 15;
            conv_tile(a->in[I_GWIN] + (size_t)m * 1024 * GLA_IN, 1024, GLA_IN, kt * 64, GLA_MAIN, 32, (bf16*)(ws + WS_GLALR_T) + (size_t)m * 64 * 1024, 2, scr, lane); continue; } r -= N_GLR;
        if (r < N_GOUT) { const int m = r >> 8, q = r & 255, kt = q >> 4, nt = q & 15;
            conv_tile(a->in[I_GWOUT] + (size_t)m * 1024 * 1024, 1024, 1024, kt * 64, nt * 64, 64, (bf16*)(ws + WS_GLAOUT_T + (size_t)m * 1024 * 1024 * (OUT_FP8 ? 1 : 2)), OUT_FP8 ? 5 : 6, scr, lane); continue; } r -= N_GOUT;
        if (r < N_SIN) { const int m = r >> 9, q = r & 511, kt = q >> 5, nt = q & 31;
            conv_tile(a->in[I_SWIN] + (size_t)m * 1024 * 2048, 1024, 2048, kt * 64, nt * 64, 64, (bf16*)(ws + WS_SGUIN_T + (size_t)m * 2048 * 1024 * (SGUIN_FP8 ? 1 : 2)), SGUIN_FP8 ? 5 : 6, scr, lane); continue; } r -= N_SIN;
        if (r < N_SOUT) { const int m = r >> 8, q = r & 255, kt = q >> 4, nt = q & 15;
            conv_tile(a->in[I_SWOUT] + (size_t)m * 1024 * 1024, 1024, 1024, kt * 64, nt * 64, 64, (bf16*)(ws + WS_SGUOUT_T + (size_t)m * 1024 * 1024 * (OUT_FP8 ? 1 : 2)), OUT_FP8 ? 5 : 6, scr, lane); continue; } r -= N_SOUT;
        { const int m = r >> 4, kt = r & 15;
            conv_tile(a->in[I_RW] + (size_t)m * 1024 * 32, 1024, 32, kt * 64, 0, 32, (bf16*)(ws + WS_ROUTER_T) + (size_t)m * 64 * 1024, 2, scr, lane); }
    }
    { bf16* d = (bf16*)(ws + WS_SGUWS); const float* s = a->in[I_SWS];
      for (int i = (bx * NTHREADS + tid) * 4; i < 2 * 8 * 128 * 128; i += G * NTHREADS * 4) { const f32x4 v = *(const f32x4*)(s + i); u32x2 o; o.x = cvt_pk_bf16(v[0], v[1]); o.y = cvt_pk_bf16(v[2], v[3]); *(u32x2*)(d + i) = o; } }
}

struct RowPass {
    const void* xin; const bf16* y; void* xout; bf16* hout; unsigned char* h8out; int xin16, xout16;
    const float* gate; const float* lng; const float* lnb; const float* sc; const float* sh;
    const bf16* wside;
    float* lr_out;
    const float* rbias;
    int* topi; float* topw; int* hist;
    const void* ys; const int* dest; const float* tw;
    int has_h, has_side;
};
template <int MODE, bool X16 = false>
__device__ __forceinline__ void row_pass(const RowPass& p, LAS unsigned char* lds, int tid, int bx, int G) {
    const int lane0 = tid & 63, wave = __builtin_amdgcn_readfirstlane(tid >> 6);
    constexpr int HS = 1040;
    LAS bf16* Hhi = (LAS bf16*)lds;
    LAS bf16* Hlo = (LAS bf16*)(lds + 16 * HS * 2);
    constexpr int PS = 36;
    LAS float* part = (LAS float*)(lds + 2 * 16 * HS * 2);
    LAS float* logit = part + 8 * 16 * PS;
    LAS int* lhist = (LAS int*)(logit + 16 * 32);
    LAS float* selv = (LAS float*)(lhist + 32);
    constexpr bool PF = (MODE == 1) && X16;
    if (MODE == 1) { if (tid < 32) lhist[tid] = 0; }
    const bool side = (p.has_side != 0) && (p.wside != nullptr);
    u32x2 xq[2][4], yq[2][4]; f32x4 vg[4];
    float rb = 0.f; if (MODE == 1) rb = p.rbias[tid & 31];
    if (PF) {
#pragma unroll
        for (int tt = 0; tt < 2; ++tt) { const int token = bx * 16 + 2 * wave + tt;
            { const bf16* xr = (const bf16*)p.xin + (size_t)token * D + 4 * lane0;
#pragma unroll
                for (int j = 0; j < 4; ++j) xq[tt][j] = *(const u32x2*)(xr + 256 * j); }
            const bf16* yr = p.y + (size_t)token * D + 4 * lane0;
#pragma unroll
            for (int j = 0; j < 4; ++j) yq[tt][j] = *(const u32x2*)(yr + 256 * j); }
        { const float* gp = p.gate + (size_t)((bx * 16) / SEQ) * 6144 + 4 * lane0;
#pragma unroll
            for (int j = 0; j < 4; ++j) vg[j] = *(const f32x4*)(gp + 256 * j); }
    }
    for (int tile = bx; tile < T / 16; tile += G) {
        const int b = (tile * 16) / SEQ;
        int lane = lane0; asm volatile("" : "+v"(lane));
        bf16x8 whi[2][4], wlo[2][4];
        {
            const int tl0 = 2 * wave, token0 = tile * 16 + tl0;
            f32x4 v[2][4]; int y8[2][4][4]; float wk[2][4];
            f32x4 vlg[4], vlb[4], vsc[4], vsh[4];
#pragma unroll
            for (int tt = 0; tt < 2; ++tt) {
                const int token = token0 + tt;
                if (p.xin16) { if (!PF) { const bf16* xr = (const bf16*)p.xin + (size_t)token * D + 4 * lane;
#pragma unroll
                    for (int j = 0; j < 4; ++j) xq[tt][j] = *(const u32x2*)(xr + 256 * j); } }
                else { const float* xr = (const float*)p.xin + (size_t)token * D + 4 * lane;
#pragma unroll
                    for (int j = 0; j < 4; ++j) v[tt][j] = *(const f32x4*)(xr + 256 * j); }
                if (MODE == 1 && !PF) { const bf16* yr = p.y + (size_t)token * D + 4 * lane;
#pragma unroll
                    for (int j = 0; j < 4; ++j) yq[tt][j] = *(const u32x2*)(yr + 256 * j); }
                if (MODE == 2) {
                    const int4 d4 = *(const int4*)(p.dest + token * 4); const f32x4 w4 = *(const f32x4*)(p.tw + token * 4); const int ds[4] = {d4.x, d4.y, d4.z, d4.w};
#pragma unroll
                    for (int k = 0; k < 4; ++k) { wk[tt][k] = w4[k];
                        const unsigned char* yr = (const unsigned char*)p.ys + (size_t)ds[k] * D + 4 * lane;
#pragma unroll
                        for (int j = 0; j < 4; ++j) y8[tt][k][j] = *(const int*)(yr + 256 * j); }
                }
            }
            if (MODE != 0 && !PF) { const float* gp = p.gate + (size_t)b * 6144 + 4 * lane;
#pragma unroll
                for (int j = 0; j < 4; ++j) vg[j] = *(const f32x4*)(gp + 256 * j); }
#pragma unroll
            for (int tt = 0; tt < 2; ++tt)
#pragma unroll
                for (int j = 0; j < 4; ++j) {
                    if (p.xin16) asm volatile("" : "+v"(xq[tt][j])); else asm volatile("" : "+v"(v[tt][j]));
                    if (MODE == 1) asm volatile("" : "+v"(yq[tt][j]));
                    if (MODE == 2) asm volatile("" : "+v"(y8[tt][0][j]), "+v"(y8[tt][1][j]), "+v"(y8[tt][2][j]), "+v"(y8[tt][3][j]));
                }
            if (PF && side) {
#pragma unroll
                for (int hf = 0; hf < 2; ++hf)
#pragma unroll
                    for (int s4 = 0; s4 < 4; ++s4) { const size_t off = (size_t)(hf * 16 + (lane & 15)) * 1024 + 128 * wave + 32 * s4 + 8 * (lane >> 4);
                    whi[hf][s4] = *(const bf16x8*)(p.wside + off); wlo[hf][s4] = *(const bf16x8*)(p.wside + 32 * 1024 + off); }
            }
#pragma unroll
            for (int tt = 0; tt < 2; ++tt) {
                if (p.xin16) {
#pragma unroll
                    for (int j = 0; j < 4; ++j) v[tt][j] = (f32x4){bf_lo(xq[tt][j].x), bf_hi(xq[tt][j].x), bf_lo(xq[tt][j].y), bf_hi(xq[tt][j].y)}; }
                if (MODE == 1) {
#pragma unroll
                    for (int j = 0; j < 4; ++j) { const f32x4 yy = (f32x4){bf_lo(yq[tt][j].x), bf_hi(yq[tt][j].x), bf_lo(yq[tt][j].y), bf_hi(yq[tt][j].y)}; v[tt][j] = v[tt][j] * ALPHA + (vg[j] + 1.0f) * yy; }
                }
                if (MODE == 2) {
                    f32x4 ya[4];
#pragma unroll
                    for (int j = 0; j < 4; ++j) ya[j] = (f32x4){0.f, 0.f, 0.f, 0.f};
#pragma unroll
                    for (int k = 0; k < 4; ++k) { const float w = wk[tt][k] * (1.0f / F8_YSCALE);
#pragma unroll
                        for (int j = 0; j < 4; ++j) { const f32x2 lo2 = __builtin_amdgcn_cvt_pk_f32_fp8(y8[tt][k][j], false), hi2 = __builtin_amdgcn_cvt_pk_f32_fp8(y8[tt][k][j], true); ya[j] += (f32x4){lo2[0], lo2[1], hi2[0], hi2[1]} * w; } }
#pragma unroll
                    for (int j = 0; j < 4; ++j) v[tt][j] = v[tt][j] * ALPHA + (vg[j] + 1.0f) * ya[j];
                }
            }
            if (MODE != 0) {
#pragma unroll
                for (int j = 0; j < 4; ++j) { vlg[j] = *(const f32x4*)(p.lng + 4 * lane + 256 * j); vlb[j] = *(const f32x4*)(p.lnb + 4 * lane + 256 * j); } }
            if (p.has_h) { const float* scp = p.sc + (size_t)b * 6144 + 4 * lane; const float* shp = p.sh + (size_t)b * 6144 + 4 * lane;
#pragma unroll
                for (int j = 0; j < 4; ++j) { vsc[j] = *(const f32x4*)(scp + 256 * j); vsh[j] = *(const f32x4*)(shp + 256 * j); } }
#pragma unroll
            for (int j = 0; j < 4; ++j) { asm volatile("" : "+v"(v[0][j]), "+v"(v[1][j])); }
            if (MODE != 0) {
                float s0 = 0.f, s1 = 0.f;
#pragma unroll
                for (int j = 0; j < 4; ++j) { s0 += (v[0][j][0] + v[0][j][1]) + (v[0][j][2] + v[0][j][3]); s1 += (v[1][j][0] + v[1][j][1]) + (v[1][j][2] + v[1][j][3]); }
                s0 = wave_allsum(s0); s1 = wave_allsum(s1);
                const float m0 = s0 * (1.0f / D), m1 = s1 * (1.0f / D); float q0 = 0.f, q1 = 0.f;
#pragma unroll
                for (int j = 0; j < 4; ++j) { v[0][j] = v[0][j] - m0; v[1][j] = v[1][j] - m1;
                    q0 += (v[0][j][0] * v[0][j][0] + v[0][j][1] * v[0][j][1]) + (v[0][j][2] * v[0][j][2] + v[0][j][3] * v[0][j][3]);
                    q1 += (v[1][j][0] * v[1][j][0] + v[1][j][1] * v[1][j][1]) + (v[1][j][2] * v[1][j][2] + v[1][j][3] * v[1][j][3]); }
                q0 = wave_allsum(q0); q1 = wave_allsum(q1);
                const float r0 = __builtin_amdgcn_rsqf(q0 * (1.0f / D) + LN_EPS), r1 = __builtin_amdgcn_rsqf(q1 * (1.0f / D) + LN_EPS);
#pragma unroll
                for (int j = 0; j < 4; ++j) { v[0][j] = v[0][j] * r0 * vlg[j] + vlb[j]; v[1][j] = v[1][j] * r1 * vlg[j] + vlb[j]; }
#pragma unroll
                for (int tt = 0; tt < 2; ++tt) {
                    if (p.xout16) { bf16* xo = (bf16*)p.xout + (size_t)(token0 + tt) * D + 4 * lane;
#pragma unroll
                        for (int j = 0; j < 4; ++j) { u32x2 o; o.x = cvt_pk_bf16(v[tt][j][0], v[tt][j][1]); o.y = cvt_pk_bf16(v[tt][j][2], v[tt][j][3]); *(u32x2*)(xo + 256 * j) = o; } }
                    else { float* xo = (float*)p.xout + (size_t)(token0 + tt) * D + 4 * lane;
#pragma unroll
                        for (int j = 0; j < 4; ++j) *(f32x4*)(xo + 256 * j) = v[tt][j]; }
                }
            }
            if (p.has_h) {
#pragma unroll
                for (int tt = 0; tt < 2; ++tt) { const int token = token0 + tt, tl = tl0 + tt;
                    bf16* ho = p.hout + (size_t)token * D + 4 * lane;
#pragma unroll
                    for (int j = 0; j < 4; ++j) { const f32x4 h = v[tt][j] * (vsc[j] + 1.0f) + vsh[j];
                        u32x2 o; o.x = cvt_pk_bf16(h[0], h[1]); o.y = cvt_pk_bf16(h[2], h[3]);
                        if (p.h8out) { const int w8 = pack4_fp8_sat(h[0] * F8_HSCALE, h[1] * F8_HSCALE, h[2] * F8_HSCALE, h[3] * F8_HSCALE); *(int*)(p.h8out + (size_t)token * D + 4 * lane + 256 * j) = w8; }
                        else *(u32x2*)(ho + 256 * j) = o;
                        if (side) { u32x2 l; l.x = cvt_pk_bf16(h[0] - bf_lo(o.x), h[1] - bf_hi(o.x)); l.y = cvt_pk_bf16(h[2] - bf_lo(o.y), h[3] - bf_hi(o.y));
                            *(LAS u32x2*)(Hhi + tl * HS + 4 * lane + 256 * j) = o; *(LAS u32x2*)(Hlo + tl * HS + 4 * lane + 256 * j) = l; } } }
            }
        }
        if (!PF && side) {
#pragma unroll
            for (int hf = 0; hf < 2; ++hf)
#pragma unroll
                for (int s4 = 0; s4 < 4; ++s4) { const size_t off = (size_t)(hf * 16 + (lane & 15)) * 1024 + 128 * wave + 32 * s4 + 8 * (lane >> 4);
                    whi[hf][s4] = *(const bf16x8*)(p.wside + off); wlo[hf][s4] = *(const bf16x8*)(p.wside + 32 * 1024 + off); }
        }
        if (PF) {
            const int ntile = (tile + G < T / 16) ? tile + G : tile;
#pragma unroll
            for (int tt = 0; tt < 2; ++tt) { const int token = ntile * 16 + 2 * wave + tt;
                { const bf16* xr = (const bf16*)p.xin + (size_t)token * D + 4 * lane;
#pragma unroll
                    for (int j = 0; j < 4; ++j) xq[tt][j] = *(const u32x2*)(xr + 256 * j); }
                const bf16* yr = p.y + (size_t)token * D + 4 * lane;
#pragma unroll
                for (int j = 0; j < 4; ++j) yq[tt][j] = *(const u32x2*)(yr + 256 * j); }
            { const float* gp = p.gate + (size_t)((ntile * 16) / SEQ) * 6144 + 4 * lane;
#pragma unroll
                for (int j = 0; j < 4; ++j) vg[j] = *(const f32x4*)(gp + 256 * j); }
        }
        if (side) {
            __syncthreads();
            f32x4 acc[2]; acc[0] = (f32x4){0.f, 0.f, 0.f, 0.f}; acc[1] = acc[0];
#pragma unroll
            for (int s = 0; s < 4; ++s) { const int ko = (lane & 15) * HS + 128 * wave + 32 * s + 8 * (lane >> 4);
                const bf16x8 bh = *(const LAS bf16x8*)(Hhi + ko), bl = *(const LAS bf16x8*)(Hlo + ko);
#pragma unroll
                for (int hf = 0; hf < 2; ++hf) { acc[hf] = __builtin_amdgcn_mfma_f32_16x16x32_bf16(whi[hf][s], bh, acc[hf], 0, 0, 0);
                    acc[hf] = __builtin_amdgcn_mfma_f32_16x16x32_bf16(wlo[hf][s], bh, acc[hf], 0, 0, 0); acc[hf] = __builtin_amdgcn_mfma_f32_16x16x32_bf16(whi[hf][s], bl, acc[hf], 0, 0, 0); } }
#pragma unroll
            for (int hf = 0; hf < 2; ++hf) *(LAS f32x4*)(part + (wave * 16 + (lane & 15)) * PS + hf * 16 + 4 * (lane >> 4)) = acc[hf];
            __syncthreads();
            int e = tid & 31; asm volatile("" : "+v"(e));
            const int tk = tid >> 5; float sg = 0.f;
#pragma unroll
            for (int w = 0; w < 8; ++w) sg += part[(w * 16 + tk) * PS + e];
            if (MODE != 1) p.lr_out[(size_t)(tile * 16 + tk) * 32 + e] = sg;
            if (MODE == 1) {
                const float lg = sg + rb;
                logit[tk * 32 + e] = lg;
                int rank = 0;
#pragma unroll
                for (int q = 0; q < 8; ++q) { const f32x4 L = *(const LAS f32x4*)(logit + tk * 32 + 4 * q);
#pragma unroll
                    for (int u = 0; u < 4; ++u) rank += (int)(L[u] > lg) | ((int)(L[u] == lg) & (int)((4 * q + u) < e)); }
                if (PF) {
#pragma unroll
                    for (int tt = 0; tt < 2; ++tt)
#pragma unroll
                        for (int j = 0; j < 4; ++j) asm volatile("" : "+v"(xq[tt][j]), "+v"(yq[tt][j]));
#pragma unroll
                    for (int j = 0; j < 4; ++j) asm volatile("" : "+v"(vg[j])); }
                if (rank < 4) { selv[tk * 4 + rank] = lg; ((LAS int*)selv)[64 + tk * 4 + rank] = e; atomicAdd((int*)&lhist[e], 1); }
                const f32x4 bv = *(const LAS f32x4*)(selv + tk * 4); const i32x4 bi = *(const LAS i32x4*)((LAS int*)selv + 64 + tk * 4);
                if (e == 0) { const int token = tile * 16 + tk;
                    const float e1 = __expf(bv[1] - bv[0]), e2 = __expf(bv[2] - bv[0]), e3 = __expf(bv[3] - bv[0]); const float inv = __builtin_amdgcn_rcpf(1.0f + e1 + e2 + e3);
                    *(i32x4*)(p.topi + token * 4) = bi;
                    *(f32x4*)(p.topw + token * 4) = (f32x4){inv, e1 * inv, e2 * inv, e3 * inv}; }
            }
        }
    }
    if (MODE == 1) { __syncthreads(); if (tid < 32) p.hist[tid] = lhist[tid]; }
}

__device__ __forceinline__ void phase_place(int* route, LAS unsigned char* lds, int tid, int bx, int G) {
    const int lane = tid & 63, wave = tid >> 6;
    LAS int* ptot = (LAS int*)lds;
    LAS int* ppre = ptot + 512;
    LAS int* tot = ppre + 512;
    LAS int* pre = tot + 32;
    LAS int* pstart = pre + 32;
    const int* hist = route + R_HIST;
    { const int e = tid & 31, part = tid >> 5; int st = 0, sp = 0;
      if (G <= 256) { int hv[16];
#pragma unroll
          for (int q = 0; q < 16; ++q) { const int bb = part + 16 * q; hv[q] = (bb < G) ? hist[bb * 32 + e] : 0; }
#pragma unroll
          for (int q = 0; q < 16; ++q) { const int bb = part + 16 * q; st += hv[q]; if (bb < bx) sp += hv[q]; } }
      else { for (int bb = part; bb < G; bb += 16) { const int h = hist[bb * 32 + e]; st += h; if (bb < bx) sp += h; } }
      ptot[part * 32 + e] = st; ppre[part * 32 + e] = sp; }
    __syncthreads();
    if (tid < 32) { int st = 0, sp = 0;
#pragma unroll
        for (int q = 0; q < 16; ++q) { st += ptot[q * 32 + tid]; sp += ppre[q * 32 + tid]; }
        tot[tid] = st; pre[tid] = sp; }
    __syncthreads();
    if (tid == 0) { int acc = 0; for (int e = 0; e < 32; ++e) { pstart[e] = acc; acc += (tot[e] + 255) / 256 * 256; } pstart[32] = acc; }
    __syncthreads();
    if (bx == 0) {
        const int ntiles = pstart[32] / 256;
        if (tid == 0) route[R_NTILES] = ntiles;
        for (int t = tid; t < ntiles; t += NTHREADS) { int e = 0; for (int q = 1; q < 32; ++q) if (pstart[q] <= t * 256) e = q; route[R_TILEE + t] = e; }
    }
    for (int e = bx; e < 32; e += G) { const int s0 = pstart[e] + tot[e], s1 = pstart[e + 1]; for (int s = s0 + tid; s < s1; s += NTHREADS) route[R_BUFTOK + s] = 0; }
    LAS int* wcnt = pstart + 40;
    int runbase = 0;
    for (int t0 = bx; t0 < T / 16; t0 += 8 * G) {
        const int tile = t0 + wave * G; const bool live = tile < T / 16;
        const int token = tile * 16 + (lane >> 2);
        const int e = live ? route[R_TOPI + tile * 64 + lane] : -1;
        int rank = 0, add = 0;
#pragma unroll 1
        for (int x = 0; x < 32; ++x) { const unsigned long long m = __ballot(e == x); if (e == x) rank = __popcll(m & ((1ull << lane) - 1ull)); if (lane == x) add = __popcll(m); }
        __syncthreads();
        if (lane < 32) wcnt[wave * 32 + lane] = add;
        __syncthreads();
        int before = 0, all = 0;
        if (lane < 32) {
#pragma unroll
            for (int w = 0; w < 8; ++w) { const int c = wcnt[w * 32 + lane]; all += c; if (w < wave) before += c; } }
        const int basev = runbase + before;
        const int base = shfl_i(basev, live ? e : 0, lane);
        if (live) { const int ds = pstart[e] + pre[e] + base + rank;
            route[R_DEST + tile * 64 + lane] = ds;
            route[R_BUFTOK + ds] = token; }
        runbase += all;
    }
}

struct Unit { int pm, pn, e; const char* bt; };
constexpr int NXCD = 8, WGM = 8;
struct Sched {
    int nM, nN, nwg, G, c; const char* Bt; size_t estride; const int* tile_e; int KB;
    __device__ __forceinline__ void init(int nM_, int nN_, int G_, int c_, const void* Bt_, size_t es, const int* te, int KB_) { nM = nM_; nN = nN_; nwg = nM * nN; G = G_; c = c_; Bt = (const char*)Bt_; estride = es; tile_e = te; KB = KB_; }
    __device__ __forceinline__ bool next(int i, Unit& u) const {
        const long L = (long)i * G + c; if (L >= nwg) return false;
        int wgid = (int)L; { const int q = nwg / NXCD, r = nwg % NXCD, xcd = wgid % NXCD, off = wgid / NXCD; wgid = (xcd < r ? xcd * (q + 1) : r * (q + 1) + (xcd - r) * q) + off; }
        const int nig = WGM * nN, gid = wgid / nig, fm = gid * WGM, gsz = (nM - fm) < WGM ? (nM - fm) : WGM;
        u.pm = fm + ((wgid % nig) % gsz); u.pn = (wgid % nig) / gsz;
        u.e = tile_e ? __builtin_amdgcn_readfirstlane(tile_e[u.pm]) : 0;
        u.bt = Bt + (size_t)u.e * estride + (size_t)u.pn * 256 * KB;
        return true;
    }
};
struct EpiGlaIn { bf16* O;
    static constexpr int NST = 16;
    __device__ __forceinline__ const float* bias_ptr(const Unit&) const { return nullptr; }
    __device__ __forceinline__ void operator()(const f32x4 (&acc)[2][2][4][2], const Unit& u, int wr, int wc, int fr, int fq, const LAS float*) const {
        const int row0 = u.pm * 256 + wr * 64 + fr, col0 = u.pn * 256 + wc * 64 + 16 * fq; const float sc = (u.pn < 2) ? 0.08838834764831845f : 1.0f;
#pragma unroll
        for (int ai = 0; ai < 2; ++ai)
#pragma unroll
            for (int m = 0; m < 4; ++m) { bf16* rp = O + (size_t)(row0 + ai * 128 + m * 16) * GLA_MAIN + col0;
#pragma unroll
                for (int bj = 0; bj < 2; ++bj) { const f32x4 v0 = acc[ai][bj][m][0] * sc, v1 = acc[ai][bj][m][1] * sc;
                    *(u32x4*)(rp + bj * 8) = (u32x4){cvt_pk_bf16(v0[0], v0[1]), cvt_pk_bf16(v0[2], v0[3]), cvt_pk_bf16(v1[0], v1[1]), cvt_pk_bf16(v1[2], v1[3])}; } }
    }
};
struct EpiSguIn { bf16* O; const float* bias; float asc;
    static constexpr int NST = 16;
    __device__ __forceinline__ const float* bias_ptr(const Unit& u) const { return bias + u.pn * 256; }
    __device__ __forceinline__ void operator()(const f32x4 (&acc)[2][2][4][2], const Unit& u, int wr, int wc, int fr, int fq, const LAS float* lb) const {
        const int row0 = u.pm * 256 + wr * 64 + fr, col0 = u.pn * 256 + wc * 64 + 16 * fq;
        f32x4 bv[2][2];
#pragma unroll
        for (int bj = 0; bj < 2; ++bj)
#pragma unroll
            for (int n = 0; n < 2; ++n) bv[bj][n] = *(const LAS f32x4*)(lb + wc * 64 + 16 * fq + bj * 8 + 4 * n);
#pragma unroll
        for (int ai = 0; ai < 2; ++ai)
#pragma unroll
            for (int m = 0; m < 4; ++m) { bf16* rp = O + (size_t)(row0 + ai * 128 + m * 16) * 2048 + col0;
#pragma unroll
                for (int bj = 0; bj < 2; ++bj) { const f32x4 v0 = acc[ai][bj][m][0] * asc + bv[bj][0], v1 = acc[ai][bj][m][1] * asc + bv[bj][1];
                    const f32x2 g0 = gelu2(v0.xy), g1 = gelu2(v0.zw), g2 = gelu2(v1.xy), g3 = gelu2(v1.zw);
                    *(u32x4*)(rp + bj * 8) = (u32x4){cvt_pk_bf16(g0[0], g0[1]), cvt_pk_bf16(g1[0], g1[1]), cvt_pk_bf16(g2[0], g2[1]), cvt_pk_bf16(g3[0], g3[1])}; } }
    }
};
struct EpiOut { bf16* O; const float* bias; float asc;
    static constexpr int NST = 16;
    __device__ __forceinline__ const float* bias_ptr(const Unit& u) const { return bias ? bias + u.pn * 256 : nullptr; }
    __device__ __forceinline__ void operator()(const f32x4 (&acc)[2][2][4][2], const Unit& u, int wr, int wc, int fr, int fq, const LAS float* lb) const {
        const int row0 = u.pm * 256 + wr * 64 + fr, col0 = u.pn * 256 + wc * 64 + 16 * fq;
        f32x4 bv[2][2];
#pragma unroll
        for (int bj = 0; bj < 2; ++bj)
#pragma unroll
            for (int n = 0; n < 2; ++n) bv[bj][n] = bias ? *(const LAS f32x4*)(lb + wc * 64 + 16 * fq + bj * 8 + 4 * n) : (f32x4){0.f, 0.f, 0.f, 0.f};
#pragma unroll
        for (int ai = 0; ai < 2; ++ai)
#pragma unroll
            for (int m = 0; m < 4; ++m) { bf16* rp = O + (size_t)(row0 + ai * 128 + m * 16) * D + col0;
#pragma unroll
                for (int bj = 0; bj < 2; ++bj) { const f32x4 v0 = acc[ai][bj][m][0] * asc + bv[bj][0], v1 = acc[ai][bj][m][1] * asc + bv[bj][1];
                    *(u32x4*)(rp + bj * 8) = (u32x4){cvt_pk_bf16(v0[0], v0[1]), cvt_pk_bf16(v0[2], v0[3]), cvt_pk_bf16(v1[0], v1[1]), cvt_pk_bf16(v1[2], v1[3])}; } }
    }
};
template <bool F8> struct EpiUp { unsigned char* O; const float* bias;
    __device__ __forceinline__ const float* bias_ptr(const Unit& u) const { return bias + (size_t)u.e * 2048 + u.pn * 256; }
    __device__ __forceinline__ void operator()(const f32x4 (&acc)[2][2][4][2], const Unit& u, int wr, int wc, int fr, int fq, const LAS float* lb) const {
        const int row0 = u.pm * 256 + wr * 64 + fr, a0 = u.pn * 128 + wc * 32 + 8 * fq;
        const float osc = F8 ? F8_ASCALE : 1.0f, asc = F8 ? 1.0f / (F8_WSCALE * F8_HSCALE) : 1.0f, ascl = asc * osc;
        f32x2 kc = (f32x2){-1.702f * 1.4426950408889634f, -1.702f * 1.4426950408889634f}, one = (f32x2){1.0f, 1.0f};
        asm volatile("" : "+v"(kc), "+v"(one));
        f32x4 bg[2], bl[2];
#pragma unroll
        for (int bj = 0; bj < 2; ++bj) { const LAS float* bp = lb + 2 * (wc * 32 + 8 * fq + 4 * bj); const f32x4 p0 = *(const LAS f32x4*)bp, p1 = *(const LAS f32x4*)(bp + 4);
            bg[bj] = (f32x4){p0[0], p0[2], p1[0], p1[2]}; bl[bj] = ((f32x4){p0[1], p0[3], p1[1], p1[3]} + 1.0f) * osc; }
#pragma unroll
        for (int ai = 0; ai < 2; ++ai)
#pragma unroll
            for (int m = 0; m < 4; ++m) { const size_t ro = (size_t)(row0 + ai * 128 + m * 16) * D + a0; f32x2 r[2][2];
#pragma unroll
                for (int bj = 0; bj < 2; ++bj) { const f32x4 g = acc[ai][bj][m][0] * asc + bg[bj], l = acc[ai][bj][m][1] * ascl + bl[bj];
#pragma unroll
                    for (int h = 0; h < 2; ++h) { const f32x2 gg = (f32x2){fminf(g[2 * h], 7.0f), fminf(g[2 * h + 1], 7.0f)}; const f32x2 x = gg * kc;
                        const f32x2 e = (f32x2){__builtin_amdgcn_exp2f(x[0]), __builtin_amdgcn_exp2f(x[1])} + one;
                        const f32x2 sg = (f32x2){__builtin_amdgcn_rcpf(e[0]), __builtin_amdgcn_rcpf(e[1])};
                        const f32x2 lc = (f32x2){__builtin_amdgcn_fmed3f(l[2 * h], -6.0f * osc, 8.0f * osc), __builtin_amdgcn_fmed3f(l[2 * h + 1], -6.0f * osc, 8.0f * osc)};
                        r[bj][h] = (gg * sg) * lc; } }
                if constexpr (F8) { int w0 = __builtin_amdgcn_cvt_pk_fp8_f32(r[0][0][0], r[0][0][1], 0, false); w0 = __builtin_amdgcn_cvt_pk_fp8_f32(r[0][1][0], r[0][1][1], w0, true);
                    int w1 = __builtin_amdgcn_cvt_pk_fp8_f32(r[1][0][0], r[1][0][1], 0, false); w1 = __builtin_amdgcn_cvt_pk_fp8_f32(r[1][1][0], r[1][1][1], w1, true);
                    *(u32x2*)(O + ro) = (u32x2){(unsigned)w0, (unsigned)w1}; }
                else { *(u32x4*)((bf16*)O + ro) = (u32x4){cvt_pk_bf16(r[0][0][0], r[0][0][1]), cvt_pk_bf16(r[0][1][0], r[0][1][1]), cvt_pk_bf16(r[1][0][0], r[1][0][1]), cvt_pk_bf16(r[1][1][0], r[1][1][1])}; } }
    }
};
struct EpiDown8 { unsigned char* O; const float* bias; float asc;
    static constexpr int NST = 16;
    __device__ __forceinline__ const float* bias_ptr(const Unit& u) const { return bias + (size_t)u.e * 1024 + u.pn * 256; }
    __device__ __forceinline__ void operator()(const f32x4 (&acc)[2][2][4][2], const Unit& u, int wr, int wc, int fr, int fq, const LAS float* lb) const {
        const int row0 = u.pm * 256 + wr * 64 + fr, col0 = u.pn * 256 + wc * 64 + 16 * fq;
        f32x4 bv[2][2];
#pragma unroll
        for (int bj = 0; bj < 2; ++bj)
#pragma unroll
            for (int n = 0; n < 2; ++n) bv[bj][n] = *(const LAS f32x4*)(lb + wc * 64 + 16 * fq + bj * 8 + 4 * n) * F8_YSCALE;
        const float sc = asc * F8_YSCALE;
#pragma unroll
        for (int ai = 0; ai < 2; ++ai)
#pragma unroll
            for (int m = 0; m < 4; ++m) { unsigned char* rp = O + (size_t)(row0 + ai * 128 + m * 16) * D + col0; unsigned w[4];
#pragma unroll
                for (int bj = 0; bj < 2; ++bj) { const f32x4 v0 = acc[ai][bj][m][0] * sc + bv[bj][0], v1 = acc[ai][bj][m][1] * sc + bv[bj][1];
                    w[2 * bj] = (unsigned)pack4_fp8_sat(v0[0], v0[1], v0[2], v0[3]); w[2 * bj + 1] = (unsigned)pack4_fp8_sat(v1[0], v1[1], v1[2], v1[3]); }
                *(u32x4*)rp = (u32x4){w[0], w[1], w[2], w[3]}; }
    }
};
struct EpiDown { bf16* O; const float* bias; float asc;
    __device__ __forceinline__ const float* bias_ptr(const Unit& u) const { return bias + (size_t)u.e * 1024 + u.pn * 256; }
    __device__ __forceinline__ void operator()(const f32x4 (&acc)[2][2][4][2], const Unit& u, int wr, int wc, int fr, int fq, const LAS float* lb) const {
        const int row0 = u.pm * 256 + wr * 64 + fr, col0 = u.pn * 256 + wc * 32 + 4 * fq;
        f32x4 bv[2][2];
#pragma unroll
        for (int bj = 0; bj < 2; ++bj)
#pragma unroll
            for (int n = 0; n < 2; ++n) bv[bj][n] = *(const LAS f32x4*)(lb + wc * 32 + 4 * fq + bj * 128 + n * 16);
#pragma unroll
        for (int ai = 0; ai < 2; ++ai)
#pragma unroll
            for (int m = 0; m < 4; ++m) { bf16* rp = O + (size_t)(row0 + ai * 128 + m * 16) * D + col0;
#pragma unroll
                for (int bj = 0; bj < 2; ++bj)
#pragma unroll
                    for (int n = 0; n < 2; ++n) { const f32x4 v = acc[ai][bj][m][n] * asc + bv[bj][n]; u32x2 o; o.x = cvt_pk_bf16(v[0], v[1]); o.y = cvt_pk_bf16(v[2], v[3]); *(u32x2*)(rp + bj * 128 + n * 16) = o; } }
    }
};

constexpr int G8_BK = 64, G8_HALF = 128, G8_HTB = G8_HALF * G8_BK * 2, G8_STAGE_BYTES = 8 * G8_HTB;
__device__ __forceinline__ int g8_lds_byte(int r, int c) { const int st = (r >> 4) * 2 + (c >> 5), rr = r & 15, cc = c & 31, ob = rr * 64 + cc * 2; return st * 1024 + (ob ^ (((ob >> 9) & 1) << 5)); }
__device__ __forceinline__ void g8_stage_rc(int b, int& R, int& C) { const int st = b / 1024, sb = b % 1024, swz = sb ^ (((sb >> 9) & 1) << 5); R = (st >> 1) * 16 + swz / 64; C = (st & 1) * 32 + (swz % 64) / 2; }
__device__ __forceinline__ u32x4 g8_avoff(int pm, const int* gather, int tid, int KB) {
    int t2 = tid; asm volatile("" : "+v"(t2));
    int R, C; g8_stage_rc(t2 * 16, R, C);
    const int* gp = gather + pm * 256 + R;
    const unsigned r00 = gp[0], r01 = gp[64], r10 = gp[128], r11 = gp[192], c2 = (unsigned)(C * 2), k2 = (unsigned)KB;
    return (u32x4){r00 * k2 + c2, r01 * k2 + c2, r10 * k2 + c2, r11 * k2 + c2};
}
template <bool GATHER, bool FP8, class Epi>
__device__ __forceinline__ void gemm_fast(const void* A, const int* gather, const int K, const Sched& S, const Epi& E, LAS unsigned char* lds, int tid) {
    const int wid = __builtin_amdgcn_readfirstlane(tid >> 6), lane = tid & 63, wr = wid >> 2, wc = wid & 3, fr = lane & 15, fq = lane >> 4;
    const int KB = FP8 ? K : 2 * K, nt = KB / 128;
    unsigned voff; { int R, C; g8_stage_rc(tid * 16, R, C); voff = (unsigned)(R * KB + C * 2); }
    const size_t kstep = (size_t)128, hstep = (size_t)G8_HALF * KB, qstep = (size_t)64 * KB, tstep = 2 * hstep;
    const unsigned ldsw = (unsigned)wid * 1024u;
    const int aoff = g8_lds_byte(wr * 64 + fr, fq * 8), boff = g8_lds_byte(wc * 32 + fr, fq * 8);
    constexpr int KSTR = 1024;
#define G8_SA(b, h) (((b) * 2 + (h)) * G8_HTB)
#define G8_SB(b, h) ((4 + (b) * 2 + (h)) * G8_HTB)
#define G8_GLDS(gp, ldsoff) __builtin_amdgcn_global_load_lds((const unsigned*)(gp), (LAS unsigned*)(lds + (ldsoff)), 16, 0, 0)
#define G8_STAGE_D(bufoff, gbase) do { G8_GLDS((const char*)(gbase) + voff, (bufoff) + ldsw); G8_GLDS((const char*)(gbase) + qstep + voff, (bufoff) + ldsw + 8192); } while (0)
#define G8_STAGE_A(bufoff, kb, h) do { if constexpr (GATHER) { G8_GLDS((kb) + va[(h) * 2], (bufoff) + ldsw); G8_GLDS((kb) + va[(h) * 2 + 1], (bufoff) + ldsw + 8192); } \
        else { G8_STAGE_D(bufoff, (kb) + (h) * hstep); } } while (0)
#define G8_LDA(dst, b, h) do { _Pragma("unroll") for (int m = 0; m < 4; ++m) _Pragma("unroll") for (int k = 0; k < 2; ++k) dst[m][k] = *(const LAS bf16x8*)(lds + G8_SA(b, h) + aoff + m * 2048 + k * KSTR); } while (0)
#define G8_LDB(dst, b, h) do { _Pragma("unroll") for (int n = 0; n < 2; ++n) _Pragma("unroll") for (int k = 0; k < 2; ++k) dst[n][k] = *(const LAS bf16x8*)(lds + G8_SB(b, h) + boff + n * 2048 + k * KSTR); } while (0)
#define G8_CAT(x) __builtin_shufflevector(__builtin_bit_cast(i32x4, (x)[0]), __builtin_bit_cast(i32x4, (x)[1]), 0, 1, 2, 3, 4, 5, 6, 7)
#define G8_MMA(ai, bj, At, Bt) do { __builtin_amdgcn_s_setprio(1); _Pragma("unroll") for (int m = 0; m < 4; ++m) _Pragma("unroll") for (int n = 0; n < 2; ++n) { \
        if constexpr (FP8) acc[ai][bj][m][n] = __builtin_amdgcn_mfma_scale_f32_16x16x128_f8f6f4(G8_CAT(Bt[n]), G8_CAT(At[m]), acc[ai][bj][m][n], 0, 0, 0, 0x7f7f7f7f, 0, 0x7f7f7f7f); \
        else { _Pragma("unroll") for (int k = 0; k < 2; ++k) acc[ai][bj][m][n] = __builtin_amdgcn_mfma_f32_16x16x32_bf16(Bt[n][k], At[m][k], acc[ai][bj][m][n], 0, 0, 0); } } \
        __builtin_amdgcn_s_setprio(0); } while (0)
#define G8_WAIT_V(n) asm volatile("s_waitcnt vmcnt(" #n ")" ::: "memory")
#define G8_WAIT_L(n) asm volatile("s_waitcnt lgkmcnt(" #n ")" ::: "memory")
#define G8_BAR __builtin_amdgcn_s_barrier()
#define G8_SCHED __builtin_amdgcn_sched_barrier(0)
    Unit cur, nxt; int ui = 0;
    if (!S.next(0, cur)) return;
    f32x4 acc[2][2][4][2];
#pragma unroll
    for (int a = 0; a < 2; ++a)
#pragma unroll
        for (int b = 0; b < 2; ++b)
#pragma unroll
            for (int m = 0; m < 4; ++m)
#pragma unroll
                for (int n = 0; n < 2; ++n) acc[a][b][m][n] = (f32x4){0.f, 0.f, 0.f, 0.f};
    bf16x8 At[4][2], B0[2][2], B1[2][2];
    u32x4 va = (u32x4){0u, 0u, 0u, 0u};
    if constexpr (GATHER) va = g8_avoff(cur.pm, gather, tid, KB);
    constexpr int G8_IDX = G8_STAGE_BYTES, G8_BIAS = G8_STAGE_BYTES + 1024;
    { const float* bp0 = E.bias_ptr(cur); if (bp0 && wid == 0) G8_GLDS((const char*)bp0 + lane * 16, G8_BIAS); }
    const char* cB = (const char*)cur.bt; const char* cA = (const char*)A + (GATHER ? (size_t)0 : (size_t)cur.pm * tstep);
    G8_STAGE_D(G8_SB(0, 0), cB); G8_STAGE_D(G8_SB(0, 1), cB + hstep); G8_STAGE_A(G8_SA(0, 0), cA, 0); G8_STAGE_A(G8_SA(0, 1), cA, 1);
    if (wr == 1) G8_BAR;
    G8_WAIT_V(2); G8_BAR;
    G8_STAGE_D(G8_SB(1, 0), cB + kstep); G8_STAGE_A(G8_SA(1, 0), cA + kstep, 0); G8_STAGE_D(G8_SB(1, 1), cB + hstep + kstep);
    G8_WAIT_V(6); G8_BAR;
    for (;;) {
        const bool has_next = S.next(ui + 1, nxt);
        if constexpr (GATHER) { if (has_next && wid == 1) G8_GLDS((const char*)(gather + nxt.pm * 256) + lane * 16, G8_IDX); }
        const char* nB = has_next ? (const char*)nxt.bt : cB;
        const char* nA = (GATHER || !has_next) ? cA : (const char*)A + (size_t)nxt.pm * tstep;
#pragma unroll 1
        for (int t = 0; t < nt; t += 2) {
            const bool last = (t == nt - 2);
            const char* a1 = cA + (size_t)(t + 1) * kstep;
            const char* a2 = last ? nA : cA + (size_t)(t + 2) * kstep; const char* b2 = last ? nB : cB + (size_t)(t + 2) * kstep;
            const char* a3 = a2 + kstep; const char* b3 = b2 + kstep;
            G8_LDB(B0, 0, 0); G8_LDB(B1, 0, 1); G8_SCHED; G8_LDA(At, 0, 0); G8_STAGE_A(G8_SA(1, 1), a1, 1);
            if (last && has_next && wid == 0) { const float* bpn = E.bias_ptr(nxt); if (bpn) G8_GLDS((const char*)bpn + lane * 16, G8_BIAS + ((ui + 1) & 1) * 1024); }
            if constexpr (GATHER) { if (last && has_next) {
                int t2 = tid; asm volatile("" : "+v"(t2)); int R, C; g8_stage_rc(t2 * 16, R, C); const LAS int* ip = (const LAS int*)(lds + G8_IDX) + R; const unsigned c2 = (unsigned)(C * 2), k2 = (unsigned)KB;
                va = (u32x4){(unsigned)ip[0] * k2 + c2, (unsigned)ip[64] * k2 + c2, (unsigned)ip[128] * k2 + c2, (unsigned)ip[192] * k2 + c2}; } }
            G8_WAIT_V(8); G8_WAIT_L(0); G8_BAR; G8_MMA(0, 0, At, B0); G8_MMA(0, 1, At, B1); G8_BAR; G8_SCHED;
            G8_LDA(At, 0, 1); G8_STAGE_D(G8_SB(0, 0), b2); G8_STAGE_D(G8_SB(0, 1), b2 + hstep); G8_STAGE_A(G8_SA(0, 0), a2, 0);
            G8_WAIT_V(8); G8_WAIT_L(0); G8_BAR; G8_MMA(1, 0, At, B0); G8_MMA(1, 1, At, B1); G8_BAR; G8_SCHED;
            G8_LDB(B0, 1, 0); G8_LDB(B1, 1, 1); G8_SCHED; G8_LDA(At, 1, 0); G8_STAGE_A(G8_SA(0, 1), a2, 1);
            G8_WAIT_V(8); G8_WAIT_L(0); G8_BAR; G8_MMA(0, 0, At, B0); G8_MMA(0, 1, At, B1); G8_BAR; G8_SCHED;
            G8_LDA(At, 1, 1); G8_STAGE_D(G8_SB(1, 0), b3); G8_STAGE_D(G8_SB(1, 1), b3 + hstep); G8_STAGE_A(G8_SA(1, 0), a3, 0);
            G8_WAIT_V(8); G8_WAIT_L(0); G8_BAR; G8_MMA(1, 0, At, B0); G8_MMA(1, 1, At, B1); G8_BAR; G8_SCHED;
        }
        if (wr == 0) G8_BAR;
        { int t3 = tid; asm volatile("" : "+v"(t3)); const int l3 = t3 & 63; E(acc, cur, wr, wc, l3 & 15, l3 >> 4, (const LAS float*)(lds + G8_BIAS + (ui & 1) * 1024)); }
#ifdef EPI2
        if constexpr (FP8 && GATHER) { asm volatile("" ::: "memory");
#pragma unroll
            for (int a_ = 0; a_ < 2; ++a_)
#pragma unroll
                for (int b_ = 0; b_ < 2; ++b_)
#pragma unroll
                    for (int m_ = 0; m_ < 4; ++m_)
#pragma unroll
                        for (int n_ = 0; n_ < 2; ++n_) asm volatile("" : "+v"(acc[a_][b_][m_][n_]));
            int t4 = tid; asm volatile("" : "+v"(t4)); const int l4 = t4 & 63; E(acc, cur, wr, wc, l4 & 15, l4 >> 4, (const LAS float*)(lds + G8_BIAS + (ui & 1) * 1024)); }
#endif
        if (!has_next) break;
#pragma unroll
        for (int a = 0; a < 2; ++a)
#pragma unroll
            for (int b = 0; b < 2; ++b)
#pragma unroll
                for (int m = 0; m < 4; ++m)
#pragma unroll
                    for (int n = 0; n < 2; ++n) acc[a][b][m][n] = (f32x4){0.f, 0.f, 0.f, 0.f};
        cur = nxt; cB = nB; cA = nA; ++ui;
        if (wr == 1) G8_BAR;
    }
    G8_WAIT_V(0);
    G8_BAR;
#undef G8_SA
#undef G8_SB
#undef G8_GLDS
#undef G8_STAGE_D
#undef G8_STAGE_A
#undef G8_LDA
#undef G8_LDB
#undef G8_MMA
#undef G8_CAT
#undef G8_WAIT_V
#undef G8_WAIT_L
#undef G8_BAR
#undef G8_SCHED
}

__device__ __forceinline__ float logsigmoid_f(float x) { return fminf(x, 0.f) - log1pf(__expf(-fabsf(x))); }
__device__ __forceinline__ void phase_gla_prep(KA a, int li, LAS unsigned char* lds, int tid, int bx, int G) {
    const int lane = tid & 63, wave = __builtin_amdgcn_readfirstlane(tid >> 6), fr = lane & 15, fq = lane >> 4;
    unsigned char* ws = a->ws;
    const bf16* qkvr = (const bf16*)(ws + WS_BIG); const float* lr = (const float*)(ws + WS_LR);
    bf16* QE = (bf16*)(ws + WS_QE); bf16* KET = (bf16*)(ws + WS_KET); bf16* PP = (bf16*)(ws + WS_P); float* EL = (float*)(ws + WS_EL);
    constexpr int LS = 144;
    LAS bf16* qes = (LAS bf16*)lds;
    LAS bf16* kes = qes + 64 * LS;
    LAS float* lrs = (LAS float*)(kes + 64 * LS);
    LAS float* segtot = lrs + 1024;
    const int d = tid & 127, seg = tid >> 7;
    const int so = tid & 15, sr = tid >> 4;
    u32x4 pq[2], pk[2]; float plr[2], pw[16], pbg;
#define PF_LOAD(it_) do { const int it__ = (it_); const int chunk_ = it__ & 63, dir_ = (it__ >> 6) & 1, h_ = (it__ >> 7) & 3, b_ = it__ >> 9; const int row0_ = b_ * SEQ + chunk_ * 64; \
        _Pragma("unroll") for (int k2 = 0; k2 < 2; ++k2) { const bf16* src = qkvr + (size_t)(row0_ + sr + 32 * k2) * GLA_MAIN + h_ * 128 + 8 * so; pq[k2] = *(const u32x4*)src; pk[k2] = *(const u32x4*)(src + 512); } \
        _Pragma("unroll") for (int k2 = 0; k2 < 2; ++k2) { const int i = tid + 512 * k2; plr[k2] = lr[(size_t)(row0_ + (i >> 4)) * 32 + dir_ * 16 + (i & 15)]; } \
        { const float* wg2_ = a->in[dir_ ? I_GWG2B : I_GWG2F] + (size_t)li * 16 * 512 + h_ * 128 + d; _Pragma("unroll") for (int r = 0; r < 16; ++r) pw[r] = wg2_[r * 512]; pbg = a->in[dir_ ? I_GBGB : I_GBGF][(size_t)li * 512 + h_ * 128 + d]; } } while (0)
    if (bx < 4096) PF_LOAD(bx);
    for (int it = bx; it < 4096; it += G) {
        const int chunk = it & 63, dir = (it >> 6) & 1, h = (it >> 7) & 3, b = it >> 9;
        const int row0 = b * SEQ + chunk * 64;
        const size_t cidx = (size_t)(((dir * 8 + b) * 4 + h) * 64 + chunk);
#pragma unroll
        for (int k2 = 0; k2 < 2; ++k2) { const int p = sr + 32 * k2; *(LAS u32x4*)(qes + p * LS + 8 * so) = pq[k2]; *(LAS u32x4*)(kes + p * LS + 8 * so) = pk[k2]; }
#pragma unroll
        for (int k2 = 0; k2 < 2; ++k2) lrs[tid + 512 * k2] = plr[k2];
        float wcol[16];
#pragma unroll
        for (int r = 0; r < 16; ++r) wcol[r] = pw[r];
        const float bgd = pbg;
        __syncthreads();
        if (it + G < 4096) PF_LOAD(it + G);
        float g[16];
#pragma unroll
        for (int s2 = 0; s2 < 16; ++s2) { const LAS float* lp = lrs + (seg * 16 + s2) * 16; float x = bgd;
#pragma unroll
            for (int r4 = 0; r4 < 4; ++r4) { const f32x4 l4 = *(const LAS f32x4*)(lp + 4 * r4); x += l4[0] * wcol[4 * r4] + l4[1] * wcol[4 * r4 + 1] + l4[2] * wcol[4 * r4 + 2] + l4[3] * wcol[4 * r4 + 3]; }
            g[s2] = (fminf(x, 0.f) - __logf(1.0f + __expf(-fabsf(x)))) * (1.0f / 16.0f); }
        if (dir == 0) {
#pragma unroll
            for (int s2 = 1; s2 < 16; ++s2) g[s2] += g[s2 - 1];
        } else {
#pragma unroll
            for (int s2 = 14; s2 >= 0; --s2) g[s2] += g[s2 + 1];
        }
        segtot[seg * 128 + d] = dir ? g[0] : g[15];
        __syncthreads();
        float pre = 0.f, total = 0.f;
#pragma unroll
        for (int sg = 0; sg < 4; ++sg) { const float t = segtot[sg * 128 + d]; total += t; if (dir ? (sg > seg) : (sg < seg)) pre += t; }
        if (seg == 0) EL[cidx * 128 + d] = __expf(total);
        unsigned kt[8];
#pragma unroll
        for (int s2 = 0; s2 < 16; s2 += 2) {
            unsigned kw[2];
#pragma unroll
            for (int u = 0; u < 2; ++u) { const int p = seg * 16 + s2 + u;
                const float q = bf2f(qes[p * LS + d]), k = bf2f(kes[p * LS + d]); const float bb = g[s2 + u] + pre;
                const float eb_ = __expf(bb); const unsigned qw = cvt_pk_bf16(q * eb_, 0.f) & 0xffffu; kw[u] = cvt_pk_bf16(k * __builtin_amdgcn_rcpf(eb_), 0.f) & 0xffffu;
                qes[p * LS + d] = (bf16)qw; kes[p * LS + d] = (bf16)kw[u]; }
            kt[s2 >> 1] = kw[0] | (kw[1] << 16);
        }
        { bf16* kp = KET + cidx * 8192 + (size_t)d * 64 + seg * 16; *(u32x4*)kp = (u32x4){kt[0], kt[1], kt[2], kt[3]}; *(u32x4*)(kp + 8) = (u32x4){kt[4], kt[5], kt[6], kt[7]}; }
        __syncthreads();
#pragma unroll
        for (int k2 = 0; k2 < 2; ++k2) { const int p = sr + 32 * k2; *(u32x4*)(QE + ((size_t)dir * T + row0 + p) * 512 + h * 128 + 8 * so) = *(const LAS u32x4*)(qes + p * LS + 8 * so); }
        { const int jt = wave & 3;
#pragma unroll
          for (int ii = 0; ii < 2; ++ii) { const int itile = 2 * (wave >> 2) + ii;
            f32x4 acc = (f32x4){0.f, 0.f, 0.f, 0.f};
            const bool dead = dir ? (jt < itile) : (jt > itile);
            if (!dead) {
#pragma unroll
                for (int ks = 0; ks < 4; ++ks) { const bf16x8 kf = *(const LAS bf16x8*)(kes + (jt * 16 + fr) * LS + ks * 32 + 8 * fq), qf = *(const LAS bf16x8*)(qes + (itile * 16 + fr) * LS + ks * 32 + 8 * fq);
                    acc = __builtin_amdgcn_mfma_f32_16x16x32_bf16(kf, qf, acc, 0, 0, 0); }
            }
            const int i = itile * 16 + fr, j0 = jt * 16 + 4 * fq; float pv[4];
#pragma unroll
            for (int jj = 0; jj < 4; ++jj) { const int j = j0 + jj; const bool keep = dir ? (j >= i) : (j <= i); pv[jj] = keep ? acc[jj] : 0.f; }
            u32x2 o; o.x = cvt_pk_bf16(pv[0], pv[1]); o.y = cvt_pk_bf16(pv[2], pv[3]);
            *(u32x2*)(PP + cidx * 4096 + (size_t)i * 64 + j0) = o; } }
        __syncthreads();
    }
}
#undef PF_LOAD
__device__ __forceinline__ void phase_gla_scan(KA a, LAS unsigned char* lds, int tid, int bx, int G) {
    const int lane = tid & 63, wave = __builtin_amdgcn_readfirstlane(tid >> 6), fr = lane & 15, fq = lane >> 4;
    unsigned char* ws = a->ws;
    const char* QE = (const char*)(ws + WS_QE); const char* KET = (const char*)(ws + WS_KET); const char* PP = (const char*)(ws + WS_P); const char* VV = (const char*)(ws + WS_BIG); const float* EL = (const float*)(ws + WS_EL);
    constexpr int SS = 144, ST_BYTES = 2 * 64 * SS * 2, BUFB = 41984, OQ = 0, OP = 16384, OK_ = 24576, OE = 40960, VBASE = ST_BYTES + 2 * BUFB;
    LAS bf16* ST = (LAS bf16*)lds;
    LAS unsigned char* BUF = lds + ST_BYTES;
    const int et0 = 2 * (wave & 1), dt0 = 2 * (wave >> 1), itile = wave >> 1;
    const int rq = lane >> 4, pq = lane & 15, r8 = lane >> 3, p8 = lane & 7;
    unsigned sq[2], sk[2], sp, sv;
#pragma unroll
    for (int j = 0; j < 2; ++j) { const int r = 4 * (wave + 8 * j) + rq; sq[j] = (unsigned)(r * 1024 + ((pq ^ (r & 15)) * 16)); const int dk = 8 * (wave + 8 * j) + r8; sk[j] = (unsigned)(dk * 128 + ((p8 ^ ((dk >> 1) & 7)) * 16)); }
    { const int r = 8 * wave + r8; sp = (unsigned)(r * 128 + ((p8 ^ ((r >> 1) & 7)) * 16)); sv = (unsigned)(r * (GLA_MAIN * 2) + ((p8 ^ ((r >> 1) & 7)) * 16)); }
    typedef short s16x4 __attribute__((ext_vector_type(4)));
    int vo[2][2][2];
#pragma unroll
    for (int et = 0; et < 2; ++et)
#pragma unroll
        for (int ks = 0; ks < 2; ++ks)
#pragma unroll
            for (int hh = 0; hh < 2; ++hh) { const int row = 32 * ks + 8 * fq + (fr >> 2) + 4 * hh, ch = 2 * (et0 + et) + ((fr & 3) >> 1); vo[et][ks][hh] = row * 128 + ((ch ^ ((row >> 1) & 7)) * 16) + (fr & 1) * 8; }
    const int kx = fr >> 1;
    for (int it0 = bx; it0 < 256; it0 += G) {
        const int it = (G == 256) ? ((it0 & 7) * 32 + (it0 >> 3)) : it0;
        const int b = it >> 5, h = (it >> 3) & 3, dir = (it >> 2) & 1, es = it & 3;
        bf16* OO = (bf16*)(ws + (dir ? WS_OB : WS_OF));
        __syncthreads();
        for (int i = tid; i < 64 * SS / 2; i += NTHREADS) ((LAS unsigned*)ST)[i] = 0u;
        f32x4 accS[2][2];
#pragma unroll
        for (int x = 0; x < 2; ++x)
#pragma unroll
            for (int y = 0; y < 2; ++y) accS[x][y] = (f32x4){0.f, 0.f, 0.f, 0.f};
        const size_t cbase = (size_t)((dir * 8 + b) * 4 + h) * 64;
        const char* qsrc = QE + (((size_t)dir * T + (size_t)b * SEQ) * 512 + h * 128) * 2;
        const char* psrc = PP + cbase * 8192;
        const char* ksrc = KET + cbase * 16384;
        const char* vsrc = VV + (((size_t)b * SEQ) * GLA_MAIN + 1024 + h * 256 + es * 64) * 2;
        const char* esrc = (const char*)(EL + cbase * 128);
        char* ob = (char*)(OO + ((size_t)b * SEQ + itile * 16) * D + h * 256 + es * 64 + et0 * 16);
        const unsigned le = (unsigned)fq * 16u, lo = (unsigned)(fr * D + 4 * fq) * 2u;
#define SC_DMA(c_, bi_) do { const size_t c__ = (size_t)(c_); LAS unsigned char* bb_ = BUF + (bi_) * BUFB + wave * 1024; \
            __builtin_amdgcn_global_load_lds((const unsigned*)(qsrc + c__ * 65536 + sq[0]), (LAS unsigned*)(bb_ + OQ), 16, 0, 0); \
            __builtin_amdgcn_global_load_lds((const unsigned*)(qsrc + c__ * 65536 + sq[1]), (LAS unsigned*)(bb_ + OQ + 8192), 16, 0, 0); \
            __builtin_amdgcn_global_load_lds((const unsigned*)(psrc + c__ * 8192 + sp), (LAS unsigned*)(bb_ + OP), 16, 0, 0); \
            __builtin_amdgcn_global_load_lds((const unsigned*)(ksrc + c__ * 16384 + sk[0]), (LAS unsigned*)(bb_ + OK_), 16, 0, 0); \
            __builtin_amdgcn_global_load_lds((const unsigned*)(ksrc + c__ * 16384 + sk[1]), (LAS unsigned*)(bb_ + OK_ + 8192), 16, 0, 0); \
            if (wave == 0) __builtin_amdgcn_global_load_lds((const unsigned*)(esrc + c__ * 512 + lane * 16), (LAS unsigned*)(BUF + (bi_) * BUFB + OE), 16, 0, 0); } while (0)
#define SC_DMAV(c_, slot_) __builtin_amdgcn_global_load_lds((const unsigned*)(vsrc + (size_t)(c_) * (64 * GLA_MAIN * 2) + sv), (LAS unsigned*)(lds + VBASE + (slot_) * 8192 + wave * 1024), 16, 0, 0)
        SC_DMA(dir ? 63 : 0, 0); SC_DMAV(dir ? 63 : 0, 0); SC_DMAV(dir ? 62 : 1, 1);
        asm volatile("s_waitcnt vmcnt(0)" ::: "memory");
        __syncthreads();
        int vslot = 0;
#pragma unroll 1
        for (int cc = 0; cc < 64; ++cc) {
            const int c = dir ? 63 - cc : cc;
            { const int c1 = cc + 1 < 64 ? cc + 1 : 63, c2 = cc + 2 < 64 ? cc + 2 : 63;
              SC_DMA(dir ? 63 - c1 : c1, (cc + 1) & 1);
              const int s2 = vslot >= 1 ? vslot - 1 : 2;
              SC_DMAV(dir ? 63 - c2 : c2, s2); }
            const LAS unsigned char* Bv = lds + VBASE + vslot * 8192;
            const LAS unsigned char* B = BUF + (cc & 1) * BUFB;
            const f32x4 el0 = *(const LAS f32x4*)(B + OE + dt0 * 64 + le), el1 = *(const LAS f32x4*)(B + OE + dt0 * 64 + 64 + le);
            const LAS bf16* Sr = ST + (cc & 1) * 64 * SS; LAS bf16* Sw = ST + ((cc + 1) & 1) * 64 * SS;
            bf16x8 qf[4], pf[2], vf[2][2];
#pragma unroll
            for (int ks = 0; ks < 4; ++ks) qf[ks] = *(const LAS bf16x8*)(B + OQ + (itile * 16 + fr) * 256 + (((4 * ks + fq) ^ fr) * 16));
#pragma unroll
            for (int ks = 0; ks < 2; ++ks) pf[ks] = *(const LAS bf16x8*)(B + OP + (itile * 16 + fr) * 128 + (((4 * ks + fq) ^ kx) * 16));
            {
                const unsigned vb_ = (unsigned)(size_t)Bv; s16x4 t[2][2][2];
                asm volatile("ds_read_b64_tr_b16 %0, %8\n\tds_read_b64_tr_b16 %1, %9\n\tds_read_b64_tr_b16 %2, %10\n\tds_read_b64_tr_b16 %3, %11\n\t"
                             "ds_read_b64_tr_b16 %4, %12\n\tds_read_b64_tr_b16 %5, %13\n\tds_read_b64_tr_b16 %6, %14\n\tds_read_b64_tr_b16 %7, %15\n\ts_waitcnt lgkmcnt(0)"
                             : "=&v"(t[0][0][0]), "=&v"(t[0][0][1]), "=&v"(t[0][1][0]), "=&v"(t[0][1][1]), "=&v"(t[1][0][0]), "=&v"(t[1][0][1]), "=&v"(t[1][1][0]), "=&v"(t[1][1][1])
                             : "v"(vb_ + vo[0][0][0]), "v"(vb_ + vo[0][0][1]), "v"(vb_ + vo[0][1][0]), "v"(vb_ + vo[0][1][1]), "v"(vb_ + vo[1][0][0]), "v"(vb_ + vo[1][0][1]), "v"(vb_ + vo[1][1][0]), "v"(vb_ + vo[1][1][1]) : "memory");
#pragma unroll
                for (int et = 0; et < 2; ++et)
#pragma unroll
                    for (int ks = 0; ks < 2; ++ks) vf[et][ks] = __builtin_shufflevector(t[et][ks][0], t[et][ks][1], 0, 1, 2, 3, 4, 5, 6, 7);
            }
#pragma unroll
            for (int et = 0; et < 2; ++et) { f32x4 ao = (f32x4){0.f, 0.f, 0.f, 0.f};
#pragma unroll
                for (int ks = 0; ks < 4; ++ks) { const bf16x8 sf = *(const LAS bf16x8*)(Sr + ((et0 + et) * 16 + fr) * SS + ks * 32 + 8 * fq); ao = __builtin_amdgcn_mfma_f32_16x16x32_bf16(sf, qf[ks], ao, 0, 0, 0); }
#pragma unroll
                for (int ks = 0; ks < 2; ++ks) ao = __builtin_amdgcn_mfma_f32_16x16x32_bf16(vf[et][ks], pf[ks], ao, 0, 0, 0);
                u32x2 o; o.x = cvt_pk_bf16(ao[0], ao[1]); o.y = cvt_pk_bf16(ao[2], ao[3]);
                *(u32x2*)(ob + (size_t)c * (64 * D * 2) + et * 32 + lo) = o; }
#pragma unroll
            for (int dt = 0; dt < 2; ++dt) { bf16x8 kf[2];
#pragma unroll
                for (int ks = 0; ks < 2; ++ks) kf[ks] = *(const LAS bf16x8*)(B + OK_ + ((dt0 + dt) * 16 + fr) * 128 + (((4 * ks + fq) ^ kx) * 16));
#pragma unroll
                for (int et = 0; et < 2; ++et) {
#pragma unroll
                    for (int ks = 0; ks < 2; ++ks) accS[dt][et] = __builtin_amdgcn_mfma_f32_16x16x32_bf16(kf[ks], vf[et][ks], accS[dt][et], 0, 0, 0);
                    accS[dt][et] = accS[dt][et] * (dt ? el1 : el0);
                    u32x2 o; o.x = cvt_pk_bf16(accS[dt][et][0], accS[dt][et][1]); o.y = cvt_pk_bf16(accS[dt][et][2], accS[dt][et][3]);
                    *(LAS u32x2*)(Sw + ((et0 + et) * 16 + fr) * SS + (dt0 + dt) * 16 + 4 * fq) = o; } }
            asm volatile("s_waitcnt vmcnt(3) lgkmcnt(0)" ::: "memory");
            __builtin_amdgcn_s_barrier();
            asm volatile("" ::: "memory");
            vslot = vslot == 2 ? 0 : vslot + 1;
        }
#undef SC_DMA
#undef SC_DMAV
    }
}

__device__ __forceinline__ void phase_gla_post(KA a, int li, int tid, int bx, int G) {
    const int lane = tid & 63, wave = tid >> 6;
    const bf16* of = (const bf16*)(a->ws + WS_OF); const bf16* ob = (const bf16*)(a->ws + WS_OB); const bf16* qkvr = (const bf16*)(a->ws + WS_BIG); bf16* A2 = (bf16*)(a->ws + WS_A2);
    const float* ng = a->in[I_GNORM] + (size_t)li * 256 + (lane & 15) * 16;
    float g[16];
#pragma unroll
    for (int j = 0; j < 16; ++j) g[j] = ng[j];
    for (int token = bx * NWAVES + wave; token < T; token += G * NWAVES) {
        const u32x4 f0 = *(const u32x4*)(of + (size_t)token * D + 16 * lane), f1 = *(const u32x4*)(of + (size_t)token * D + 16 * lane + 8);
        const u32x4 b0 = *(const u32x4*)(ob + (size_t)token * D + 16 * lane), b1 = *(const u32x4*)(ob + (size_t)token * D + 16 * lane + 8);
        const u32x4 r0 = *(const u32x4*)(qkvr + (size_t)token * GLA_MAIN + 2048 + 16 * lane), r1 = *(const u32x4*)(qkvr + (size_t)token * GLA_MAIN + 2048 + 16 * lane + 8);
        float o[16], r[16];
#pragma unroll
        for (int q = 0; q < 4; ++q) { o[2 * q] = bf_lo(f0[q]) + bf_lo(b0[q]); o[2 * q + 1] = bf_hi(f0[q]) + bf_hi(b0[q]); o[8 + 2 * q] = bf_lo(f1[q]) + bf_lo(b1[q]); o[8 + 2 * q + 1] = bf_hi(f1[q]) + bf_hi(b1[q]);
            r[2 * q] = bf_lo(r0[q]); r[2 * q + 1] = bf_hi(r0[q]); r[8 + 2 * q] = bf_lo(r1[q]); r[8 + 2 * q + 1] = bf_hi(r1[q]); }
        float ss = 0.f;
#pragma unroll
        for (int j = 0; j < 16; ++j) ss += o[j] * o[j];
        ss = row16_sum(ss);
        const float rstd = __builtin_amdgcn_rsqf(ss * (1.0f / 256.0f) + LN_EPS);
#if OUT_FP8
        unsigned w[4]; const float rs8 = rstd * F8_A2SCALE;
#pragma unroll
        for (int q = 0; q < 4; ++q) w[q] = (unsigned)pack4_fp8_sat(o[4 * q] * rs8 * g[4 * q] * silu_f(r[4 * q]), o[4 * q + 1] * rs8 * g[4 * q + 1] * silu_f(r[4 * q + 1]), o[4 * q + 2] * rs8 * g[4 * q + 2] * silu_f(r[4 * q + 2]), o[4 * q + 3] * rs8 * g[4 * q + 3] * silu_f(r[4 * q + 3]));
        *(u32x4*)((unsigned char*)A2 + (size_t)token * D + 16 * lane) = (u32x4){w[0], w[1], w[2], w[3]};
#else
        unsigned w[8];
#pragma unroll
        for (int q = 0; q < 8; ++q) w[q] = cvt_pk_bf16(o[2 * q] * rstd * g[2 * q] * silu_f(r[2 * q]), o[2 * q + 1] * rstd * g[2 * q + 1] * silu_f(r[2 * q + 1]));
        *(u32x4*)(A2 + (size_t)token * D + 16 * lane) = (u32x4){w[0], w[1], w[2], w[3]}; *(u32x4*)(A2 + (size_t)token * D + 16 * lane + 8) = (u32x4){w[4], w[5], w[6], w[7]};
#endif
    }
}

__device__ __forceinline__ void phase_sgu_core(KA a, int li, LAS unsigned char* lds, int tid, int bx, int G) {
    const int lane = tid & 63, wave = __builtin_amdgcn_readfirstlane(tid >> 6), fr = lane & 15, fq = lane >> 4;
    unsigned char* ws = a->ws;
    const bf16* z = (const bf16*)(ws + WS_BIG); bf16* A2 = (bf16*)(ws + WS_A2);
    const float* lng = a->in[I_SLNG] + (size_t)li * 1024; const float* lnb = a->in[I_SLNB] + (size_t)li * 1024;
    const bf16* wsp = (const bf16*)(ws + WS_SGUWS) + (size_t)li * 8 * 128 * 128; const float* bs = a->in[I_SBS] + (size_t)li * 8 * 128;
    constexpr int VS = 144;
    LAS bf16* vn = (LAS bf16*)lds;
    LAS float* st_mean = (LAS float*)(lds + 2 * 128 * VS * 2); LAS float* st_rstd = st_mean + 128;
    const int co = tid & 15, qr = tid >> 4;
    const int p = wave * 16 + fr;
    typedef short s16x4 __attribute__((ext_vector_type(4)));
    for (int it = bx; it < T / 128; it += G) {
        const int row0 = it * 128;
        __syncthreads();
        u32x4 raw[8][4]; f32x4 lp[8][4]; u32x2 wq[8][4][2]; u32x2 un[8][8]; float bsv[8];
#define SGU_LOADG(gg) do { constexpr int g_ = (gg); \
            _Pragma("unroll") for (int k = 0; k < 4; ++k) raw[g_][k] = *(const u32x4*)(z + (size_t)(row0 + qr + 32 * k) * 2048 + 1024 + g_ * 128 + 8 * co); \
            lp[g_][0] = *(const f32x4*)(lng + g_ * 128 + 8 * co); lp[g_][1] = *(const f32x4*)(lng + g_ * 128 + 8 * co + 4); lp[g_][2] = *(const f32x4*)(lnb + g_ * 128 + 8 * co); lp[g_][3] = *(const f32x4*)(lnb + g_ * 128 + 8 * co + 4); \
            _Pragma("unroll") for (int ks = 0; ks < 4; ++ks) { const bf16* wp = wsp + ((size_t)g_ * 128 + p) * 128 + ks * 32 + 4 * fq; wq[g_][ks][0] = *(const u32x2*)wp; wq[g_][ks][1] = *(const u32x2*)(wp + 16); } \
            bsv[g_] = bs[g_ * 128 + p]; } while (0)
#define SGU_LOADU(gg) do { constexpr int g_ = (gg); \
            _Pragma("unroll") for (int ct = 0; ct < 8; ++ct) un[g_][ct] = *(const u32x2*)(z + (size_t)(row0 + p) * 2048 + g_ * 128 + ct * 16 + 4 * fq); } while (0)
        SGU_LOADU(0); SGU_LOADU(1); SGU_LOADU(2); SGU_LOADG(0);
#pragma unroll 1
        for (int hb = 0; hb < 2; ++hb) {
            u32x4 d[8][2];
#pragma unroll
            for (int rr = 0; rr < 8; ++rr) { const bf16* vp = z + (size_t)(row0 + wave * 16 + hb * 8 + rr) * 2048 + 1024 + 16 * lane; d[rr][0] = *(const u32x4*)vp; d[rr][1] = *(const u32x4*)(vp + 8); }
#pragma unroll
            for (int rr = 0; rr < 8; ++rr) asm volatile("" : "+v"(d[rr][0]), "+v"(d[rr][1]));
            float s1[8], s2[8];
#pragma unroll
            for (int rr = 0; rr < 8; ++rr) { float t1 = 0.f, t2 = 0.f;
#pragma unroll
                for (int h = 0; h < 2; ++h)
#pragma unroll
                    for (int k = 0; k < 4; ++k) { const float x0 = bf_lo(d[rr][h][k]), x1 = bf_hi(d[rr][h][k]); t1 += x0 + x1; t2 += x0 * x0 + x1 * x1; }
                s1[rr] = t1; s2[rr] = t2; }
#pragma unroll
            for (int o = 1; o < 64; o <<= 1)
#pragma unroll
                for (int rr = 0; rr < 8; ++rr) { s1[rr] += shfl_xor_f(s1[rr], o, lane); s2[rr] += shfl_xor_f(s2[rr], o, lane); }
            if (lane == 0) {
#pragma unroll
                for (int rr = 0; rr < 8; ++rr) { const float mean = s1[rr] * (1.0f / 1024.0f), var = fmaxf(s2[rr] * (1.0f / 1024.0f) - mean * mean, 0.f);
                    st_mean[wave * 16 + hb * 8 + rr] = mean; st_rstd[wave * 16 + hb * 8 + rr] = __builtin_amdgcn_rsqf(var + LN_EPS); } }
        }
        __syncthreads();
#define SGU_GROUP(gg) do { constexpr int g = (gg); \
            int tl = tid; asm volatile("" : "+v"(tl));       \
            const int fr = tl & 15, fq = (tl >> 4) & 3, co = tl & 15, qr = tl >> 4, p = wave * 16 + fr; \
            LAS bf16* vb = vn + (g & 1) * 128 * VS; \
              \
            _Pragma("unroll") for (int k = 0; k < 4; ++k) { const int q = qr + 32 * k; const u32x4 w = raw[g][k]; const float m = st_mean[q], r = st_rstd[q]; u32x4 o; \
                o.x = cvt_pk_bf16((bf_lo(w.x) - m) * r * lp[g][0][0] + lp[g][2][0], (bf_hi(w.x) - m) * r * lp[g][0][1] + lp[g][2][1]); o.y = cvt_pk_bf16((bf_lo(w.y) - m) * r * lp[g][0][2] + lp[g][2][2], (bf_hi(w.y) - m) * r * lp[g][0][3] + lp[g][2][3]); \
                o.z = cvt_pk_bf16((bf_lo(w.z) - m) * r * lp[g][1][0] + lp[g][3][0], (bf_hi(w.z) - m) * r * lp[g][1][1] + lp[g][3][1]); o.w = cvt_pk_bf16((bf_lo(w.w) - m) * r * lp[g][1][2] + lp[g][3][2], (bf_hi(w.w) - m) * r * lp[g][1][3] + lp[g][3][3]); \
                *(LAS u32x4*)(vb + q * VS + 8 * co) = o; } \
            __builtin_amdgcn_sched_barrier(0);                  \
            if constexpr (g + 1 < 8) SGU_LOADG(g + 1 < 8 ? g + 1 : 7); \
            if constexpr (g + 3 < 8) SGU_LOADU(g + 3 < 8 ? g + 3 : 7); \
            __syncthreads(); \
            _Pragma("unroll") for (int ct = 0; ct < 8; ++ct) { \
                f32x4 acc = (f32x4){0.f, 0.f, 0.f, 0.f}; \
                _Pragma("unroll") for (int ks = 0; ks < 4; ++ks) { LAS bf16* sp = vb + (ks * 32 + 4 * fq + (fr >> 2)) * VS + ct * 16 + 4 * (fr & 3); \
                    const s16x4 t0 = __builtin_amdgcn_ds_read_tr16_b64_v4i16((LAS s16x4*)sp), t1 = __builtin_amdgcn_ds_read_tr16_b64_v4i16((LAS s16x4*)(sp + 16 * VS)); \
                    const bf16x8 vf = __builtin_shufflevector(t0, t1, 0, 1, 2, 3, 4, 5, 6, 7); \
                    const bf16x8 wfr = __builtin_bit_cast(bf16x8, (u32x4){wq[g][ks][0].x, wq[g][ks][0].y, wq[g][ks][1].x, wq[g][ks][1].y}); \
                    acc = __builtin_amdgcn_mfma_f32_16x16x32_bf16(vf, wfr, acc, 0, 0, 0); } \
                const int c0 = g * 128 + ct * 16 + 4 * fq; const float bias = bsv[g]; \
                if constexpr (OUT_FP8 != 0) { const int w8 = pack4_fp8_sat(bf_lo(un[g][ct].x) * (acc[0] + bias) * F8_A2SCALE, bf_hi(un[g][ct].x) * (acc[1] + bias) * F8_A2SCALE, bf_lo(un[g][ct].y) * (acc[2] + bias) * F8_A2SCALE, bf_hi(un[g][ct].y) * (acc[3] + bias) * F8_A2SCALE); \
                    *(int*)((unsigned char*)A2 + (size_t)(row0 + p) * D + c0) = w8; } \
                else { u32x2 o; o.x = cvt_pk_bf16(bf_lo(un[g][ct].x) * (acc[0] + bias), bf_hi(un[g][ct].x) * (acc[1] + bias)); o.y = cvt_pk_bf16(bf_lo(un[g][ct].y) * (acc[2] + bias), bf_hi(un[g][ct].y) * (acc[3] + bias)); \
                    *(u32x2*)(A2 + (size_t)(row0 + p) * D + c0) = o; } } \
            __builtin_amdgcn_sched_barrier(0); } while (0)
        SGU_GROUP(0); SGU_GROUP(1); SGU_GROUP(2); SGU_GROUP(3); SGU_GROUP(4); SGU_GROUP(5); SGU_GROUP(6); SGU_GROUP(7);
#undef SGU_GROUP
#undef SGU_LOADU
#undef SGU_LOADG
    }
}

constexpr int PH_PER_LAYER = 10;
constexpr int NPHASES = 2 + PH_PER_LAYER * DEPTH;
#define GEMM_BODY(A, g, K, S, E) gemm_fast<false, false>(A, g, K, S, E, lds, tid)
#define GEMM_BODY_G(A, g, K, S, E) gemm_fast<true, false>(A, g, K, S, E, lds, tid)
#define GEMM_BODY8(A, g, K, S, E) gemm_fast<false, true>(A, g, K, S, E, lds, tid)
#define GEMM_BODY8_G(A, g, K, S, E) gemm_fast<true, true>(A, g, K, S, E, lds, tid)
__device__ __forceinline__ void ph_prologue(int wave_s) { PHASE_ENTER(); phase_prologue(a, lds, tid, bx, G); }
__device__ __forceinline__ void ph_rp_init(int wave_s) { PHASE_ENTER(); float* mod = (float*)(ws + WS_MOD);
    RowPass p{}; p.xin = a->in[I_X]; p.hout = (bf16*)(ws + WS_H); p.sc = mod + 1 * 1024; p.sh = mod + 0 * 1024; p.wside = (const bf16*)(ws + WS_GLALR_T); p.lr_out = (float*)(ws + WS_LR); p.has_h = 1; p.has_side = 1;
    row_pass<0>(p, lds, tid, bx, G); }
__device__ __forceinline__ void ph_gla_in(int wave_s, int li) { PHASE_ENTER(); Sched S; S.init(T / 256, GLA_MAIN / 256, G, bx, (const bf16*)(ws + WS_GLAIN_T) + (size_t)li * GLA_MAIN * 1024, 0, nullptr, 2048); EpiGlaIn E{(bf16*)(ws + WS_BIG)}; GEMM_BODY((const bf16*)(ws + WS_H), nullptr, 1024, S, E); }
#if SGUIN_FP8
__device__ __forceinline__ void ph_sgu_in(int wave_s, int li) { PHASE_ENTER(); Sched S; S.init(T / 256, 2048 / 256, G, bx, ws + WS_SGUIN_T + (size_t)li * 2048 * 1024, 0, nullptr, 1024); EpiSguIn E{(bf16*)(ws + WS_BIG), a->in[I_SBIN] + (size_t)li * 2048, 1.0f / (F8_WSCALE * F8_HSCALE)}; GEMM_BODY8(ws + WS_H8, nullptr, 1024, S, E); }
#else
__device__ __forceinline__ void ph_sgu_in(int wave_s, int li) { PHASE_ENTER(); Sched S; S.init(T / 256, 2048 / 256, G, bx, (const bf16*)(ws + WS_SGUIN_T) + (size_t)li * 2048 * 1024, 0, nullptr, 2048); EpiSguIn E{(bf16*)(ws + WS_BIG), a->in[I_SBIN] + (size_t)li * 2048, 1.0f}; GEMM_BODY((const bf16*)(ws + WS_H), nullptr, 1024, S, E); }
#endif
__device__ __forceinline__ void ph_gla_prep(int wave_s, int li) { PHASE_ENTER(); phase_gla_prep(a, li, lds, tid, bx, G); }
__device__ __forceinline__ void ph_gla_scan(int wave_s) { PHASE_ENTER(); phase_gla_scan(a, lds, tid, bx, G); }
__device__ __forceinline__ void ph_sgu_core(int wave_s, int li) { PHASE_ENTER(); phase_sgu_core(a, li, lds, tid, bx, G); }
__device__ __forceinline__ void ph_gla_post(int wave_s, int li) { PHASE_ENTER(); phase_gla_post(a, li, tid, bx, G); }
__device__ __forceinline__ void ph_out(int wave_s, int l) { PHASE_ENTER(); const int li = l >> 1; const bool sgu = (l & 1) != 0;
#if OUT_FP8
    Sched S; S.init(T / 256, 4, G, bx, ws + (sgu ? WS_SGUOUT_T : WS_GLAOUT_T) + (size_t)li * 1024 * 1024, 0, nullptr, 1024);
    EpiOut E{(bf16*)(ws + WS_Y), sgu ? a->in[I_SBOUT] + (size_t)li * 1024 : nullptr, 1.0f / (F8_WSCALE * F8_A2SCALE)}; GEMM_BODY8(ws + WS_A2, nullptr, 1024, S, E); }
#else
    Sched S; S.init(T / 256, 4, G, bx, (const bf16*)(ws + (sgu ? WS_SGUOUT_T : WS_GLAOUT_T)) + (size_t)li * 1024 * 1024, 0, nullptr, 2048);
    EpiOut E{(bf16*)(ws + WS_Y), sgu ? a->in[I_SBOUT] + (size_t)li * 1024 : nullptr, 1.0f}; GEMM_BODY((const bf16*)(ws + WS_A2), nullptr, 1024, S, E); }
#endif
__device__ __forceinline__ void ph_rp_mid(int wave_s, int l) { PHASE_ENTER(); float* modl = (float*)(ws + WS_MOD) + (size_t)l * 8 * 6144; int* route = (int*)(ws + WS_ROUTE);
    RowPass p{}; p.xin = (l == 0) ? (const void*)a->in[I_X] : (const void*)(ws + WS_X2); p.xin16 = (l != 0); p.y = (const bf16*)(ws + WS_Y); p.xout = ws + WS_X1; p.xout16 = 1; p.hout = (bf16*)(ws + WS_H);
    p.gate = modl + 2 * 1024; p.lng = a->in[I_LNG] + (size_t)(l * 2 + 0) * 1024; p.lnb = a->in[I_LNB] + (size_t)(l * 2 + 0) * 1024; p.sc = modl + 4 * 1024; p.sh = modl + 3 * 1024;
    p.wside = (const bf16*)(ws + WS_ROUTER_T) + (size_t)l * 64 * 1024; p.rbias = a->in[I_RB] + (size_t)l * 32;
    p.topi = route + R_TOPI; p.topw = (float*)(route + R_TOPW); p.hist = route + R_HIST + bx * 32; p.has_h = 1; p.has_side = 1; p.h8out = MOE_FP8 ? (ws + WS_H8) : nullptr;
    if (l == 0) row_pass<1, false>(p, lds, tid, bx, G); else row_pass<1, true>(p, lds, tid, bx, G); }
__device__ __forceinline__ void ph_place(int wave_s) { PHASE_ENTER(); phase_place((int*)(ws + WS_ROUTE), lds, tid, bx, G); }
__device__ __forceinline__ void ph_moe_up(int wave_s, int l) { PHASE_ENTER(); int* route = (int*)(ws + WS_ROUTE); const int ntiles = __builtin_amdgcn_readfirstlane(route[R_NTILES]);
#if MOE_FP8
    Sched S; S.init(ntiles, 8, G, bx, ws + WS_WUP_T + (size_t)l * 32 * 2048 * 1024, (size_t)2048 * 1024, route + R_TILEE, 1024);
    EpiUp<true> E{ws + WS_ACT, a->in[I_BUP] + (size_t)l * 32 * 2048}; GEMM_BODY8_G(ws + WS_H8, route + R_BUFTOK, 1024, S, E); }
#else
    Sched S; S.init(ntiles, 8, G, bx, ws + WS_WUP_T + (size_t)l * 32 * 2048 * 2048, (size_t)2048 * 2048, route + R_TILEE, 2048);
    EpiUp<false> E{ws + WS_ACT, a->in[I_BUP] + (size_t)l * 32 * 2048}; GEMM_BODY_G(ws + WS_H, route + R_BUFTOK, 1024, S, E); }
#endif
__device__ __forceinline__ void ph_moe_down(int wave_s, int l) { PHASE_ENTER(); int* route = (int*)(ws + WS_ROUTE); const int ntiles = __builtin_amdgcn_readfirstlane(route[R_NTILES]);
#if MOE_FP8
    Sched S; S.init(ntiles, 4, G, bx, ws + WS_WDN_T + (size_t)l * 32 * 1024 * 1024, (size_t)1024 * 1024, route + R_TILEE, 1024);
    EpiDown8 E{ws + WS_YS, a->in[I_BDN] + (size_t)l * 32 * 1024, 1.0f / (F8_WSCALE * F8_ASCALE)}; GEMM_BODY8(ws + WS_ACT, nullptr, 1024, S, E); }
#else
    Sched S; S.init(ntiles, 4, G, bx, ws + WS_WDN_T + (size_t)l * 32 * 1024 * 2048, (size_t)1024 * 2048, route + R_TILEE, 2048);
    EpiDown E{(bf16*)(ws + WS_YS), a->in[I_BDN] + (size_t)l * 32 * 1024, 1.0f}; GEMM_BODY(ws + WS_ACT, nullptr, 1024, S, E); }
#endif
__device__ __forceinline__ void ph_rp_end(int wave_s, int l) { PHASE_ENTER(); float* mod = (float*)(ws + WS_MOD); float* modl = mod + (size_t)l * 8 * 6144; int* route = (int*)(ws + WS_ROUTE);
    RowPass p{}; p.xin = ws + WS_X1; p.xin16 = 1; p.xout = (l == DEPTH - 1) ? (void*)a->out : (void*)(ws + WS_X2); p.xout16 = (l != DEPTH - 1); p.hout = (bf16*)(ws + WS_H);
    p.gate = modl + 5 * 1024; p.lng = a->in[I_LNG] + (size_t)(l * 2 + 1) * 1024; p.lnb = a->in[I_LNB] + (size_t)(l * 2 + 1) * 1024;
    p.ys = ws + WS_YS; p.dest = route + R_DEST; p.tw = (const float*)(route + R_TOPW);
    if (l < DEPTH - 1) { float* modn = mod + (size_t)(l + 1) * 8 * 6144; p.sc = modn + 1 * 1024; p.sh = modn + 0 * 1024; p.has_h = 1;
        if (SGUIN_FP8 && ((l + 1) & 1) == 1) p.h8out = ws + WS_H8;
        if (((l + 1) & 1) == 0) { p.has_side = 1; p.wside = (const bf16*)(ws + WS_GLALR_T) + (size_t)((l + 1) >> 1) * 64 * 1024; p.lr_out = (float*)(ws + WS_LR); } }
    row_pass<2>(p, lds, tid, bx, G); }

__global__ void __launch_bounds__(NTHREADS, 2) fwd_kernel(Args a) {
    extern __shared__ __attribute__((aligned(16))) unsigned char lds_raw[];
    LAS unsigned char* lds = (LAS unsigned char*)lds_raw;
    volatile LAS unsigned* MISC = (volatile LAS unsigned*)(lds + MISC_OFF);
    const int tid = threadIdx.x; const int wave_s = __builtin_amdgcn_readfirstlane(tid >> 6);
    if (tid < 32) ((LAS unsigned*)(lds + MISC_OFF))[tid] = 0u;
    __syncthreads();
    unsigned* ctl = (unsigned*)(a.ws + WS_CTL);
    XcdBarrier bar = xcd_barrier_post(ctl + CW_BAR + a.li * XCD_BAR_WORDS, MISC + 8);
    const int lo = a.ph_lo, hi = a.ph_hi;
#ifndef REPK
#define REPK 0
#define REPN 1
#endif
#define REP(kind) for (int rep_ = 0; rep_ < ((REPK == (kind)) ? REPN : 1); ++rep_)
#define IN(k) (lo <= (k) && (k) < hi)
#define SEAM(k) do { if (IN(k) && IN((k) + 1)) xcd_barrier(bar); } while (0)
    if (IN(0)) { REP(3) ph_prologue(wave_s); SEAM(0); }
    if (IN(1)) { ph_rp_init(wave_s); SEAM(1); }
    for (int l = 0; l < DEPTH; ++l) {
        const int pb = 2 + PH_PER_LAYER * l, li = l >> 1; const bool sgu = (l & 1) != 0;
        if (IN(pb + 0)) { REP(10) { if (!sgu) ph_gla_in(wave_s, li); else ph_sgu_in(wave_s, li); } SEAM(pb + 0); }
        if (IN(pb + 1)) { if (!sgu) { REP(12) ph_gla_prep(wave_s, li); SEAM(pb + 1); } }
        if (IN(pb + 2)) { if (!sgu) { REP(1) ph_gla_scan(wave_s); } else { REP(2) ph_sgu_core(wave_s, li); } SEAM(pb + 2); }
        if (IN(pb + 3)) { if (!sgu) { REP(6) ph_gla_post(wave_s, li); SEAM(pb + 3); } }
        if (IN(pb + 4)) { REP(11) ph_out(wave_s, l); SEAM(pb + 4); }
        if (IN(pb + 5)) { REP(4) ph_rp_mid(wave_s, l); SEAM(pb + 5); }
        if (IN(pb + 6)) { REP(7) ph_place(wave_s); SEAM(pb + 6); }
        if (IN(pb + 7)) { REP(8) ph_moe_up(wave_s, l); SEAM(pb + 7); }
        if (IN(pb + 8)) { REP(9) ph_moe_down(wave_s, l); SEAM(pb + 8); }
        if (IN(pb + 9)) { REP(5) ph_rp_end(wave_s, l); SEAM(pb + 9); }
    }
#undef IN
#undef SEAM
}

#ifndef N_LAUNCH_MODE
#define N_LAUNCH_MODE 1
#endif
extern "C" void kernel_launch(void* const* d_in, const int* in_sizes, int n_in, void* d_out, int out_size, void* d_ws, size_t ws_size, hipStream_t stream) {
    static int grid = 0;
    if (grid == 0) {
        if (n_in != 27 || out_size != T * D || ws_size < WS_END) { fprintf(stderr, "kernel_launch: unexpected shapes (n_in %d out %d ws %zu)\n", n_in, out_size, ws_size); grid = -1; return; }
        int dev = 0, cus = 0, per_cu = 0;
        if (hipGetDevice(&dev) != hipSuccess || hipDeviceGetAttribute(&cus, hipDeviceAttributeMultiprocessorCount, dev) != hipSuccess) { grid = -1; return; }
        if (hipFuncSetAttribute((const void*)fwd_kernel, hipFuncAttributeMaxDynamicSharedMemorySize, LDS_BYTES) != hipSuccess) { fprintf(stderr, "kernel_launch: hipFuncSetAttribute failed\n"); grid = -1; return; }
        if (hipOccupancyMaxActiveBlocksPerMultiprocessor(&per_cu, (const void*)fwd_kernel, NTHREADS, LDS_BYTES) != hipSuccess || per_cu < 1) fprintf(stderr, "kernel_launch: occupancy query reports %d\n", per_cu);
        (void)hipGetLastError();
        grid = cus;
        if (grid > 1024) grid = 1024;
    }
    if (grid < 0) return;
    (void)hipMemsetAsync((char*)d_ws + WS_CTL, 0, CTL_ZERO_BYTES, stream);
    Args a{};
    for (int i = 0; i < 27; ++i) a.in[i] = (const float*)d_in[i];
    a.out = (float*)d_out; a.ws = (unsigned char*)d_ws; a.pad = 0;
#if N_LAUNCH_MODE == 1
    a.ph_lo = 0; a.ph_hi = NPHASES; a.li = 0;
    hipLaunchKernelGGL(fwd_kernel, dim3(grid), dim3(NTHREADS), LDS_BYTES, stream, a);
#else
    for (int ph = 0, li = 0; ph < NPHASES; ++ph) {
        if (ph >= 2 && (((ph - 2) % PH_PER_LAYER) == 1 || ((ph - 2) % PH_PER_LAYER) == 3) && (((ph - 2) / PH_PER_LAYER) & 1)) continue;
        a.ph_lo = ph; a.ph_hi = ph + 1; a.li = li++;
        hipLaunchKernelGGL(fwd_kernel, dim3(grid), dim3(NTHREADS), LDS_BYTES, stream, a);
    }
#endif
}
```

```cpp
#include <hip/hip_runtime.h>
#include <cstdio>
#include <cstdint>

#define LAS __attribute__((address_space(3)))
#define GAS __attribute__((address_space(1)))
typedef unsigned short bf16;
typedef short bf16x8 __attribute__((ext_vector_type(8)));
typedef float f32x4 __attribute__((ext_vector_type(4)));
typedef float f32x2 __attribute__((ext_vector_type(2)));
typedef unsigned u32x4 __attribute__((ext_vector_type(4)));
typedef unsigned u32x2 __attribute__((ext_vector_type(2)));
typedef int i32x4 __attribute__((ext_vector_type(4)));
typedef int i32x8 __attribute__((ext_vector_type(8)));

#ifndef MOE_FP8
#define MOE_FP8 1
#endif
#if !MOE_FP8
#error "the combine row pass reads the expert outputs as e4m3 (MOE_FP8 = 1 only)"
#endif
constexpr int D = 1024, NB = 8, SEQ = 4096, T = NB * SEQ, DEPTH = 4;
constexpr int NE = 32, TOPK = 4, CAP = T * TOPK + NE * 256;
constexpr int MAXTILES = CAP / 256;
constexpr float ALPHA = 1.681792830507429f;
constexpr float LN_EPS = 1e-5f;
#ifndef OUT_FP8
#define OUT_FP8 1
#endif
constexpr float F8_A2SCALE = 8.0f;
#ifndef SGUIN_FP8
#define SGUIN_FP8 1
#endif
constexpr float F8_WSCALE = 64.0f, F8_HSCALE = 8.0f, F8_ASCALE = 4.0f, F8_YSCALE = 64.0f;
constexpr int GLA_IN = 3104, GLA_MAIN = 3072;
constexpr int NWAVES = 8, NTHREADS = 512;
constexpr int LDS_BYTES = 147456, MISC_OFF = 147328;

constexpr size_t MiB = 1u << 20;
constexpr size_t WS_CTL = 0, CTL_ZERO_BYTES = 2 * MiB;
constexpr size_t WS_MOD = 2 * MiB;
constexpr size_t WS_ROUTE = 4 * MiB;
constexpr size_t WS_LR = 8 * MiB;
constexpr size_t WS_GLAIN_T = 16 * MiB;
constexpr size_t WS_GLALR_T = 28 * MiB;
constexpr size_t WS_ROUTER_T = 29 * MiB;
constexpr size_t WS_SGUWS = 30 * MiB;
constexpr size_t WS_GLAOUT_T = 32 * MiB;
constexpr size_t WS_SGUIN_T = 36 * MiB;
constexpr size_t WS_SGUOUT_T = 44 * MiB;
constexpr size_t WS_WUP_T = 64 * MiB;
constexpr size_t WS_WDN_T = 576 * MiB;
constexpr size_t WS_X1 = 832 * MiB;
constexpr size_t WS_X2 = 960 * MiB;
constexpr size_t WS_H = 1088 * MiB;
constexpr size_t WS_BIG = 1152 * MiB;
constexpr size_t WS_OF = 1344 * MiB;
constexpr size_t WS_OB = 1408 * MiB;
constexpr size_t WS_A2 = 1472 * MiB;
constexpr size_t WS_Y = 1536 * MiB;
constexpr size_t WS_ACT = 1664 * MiB;
constexpr size_t WS_YS = 1936 * MiB;
constexpr size_t WS_QE = 2208 * MiB;
constexpr size_t WS_KET = 2272 * MiB;
constexpr size_t WS_P = 2336 * MiB;
constexpr size_t WS_VT = 2368 * MiB;
constexpr size_t WS_EL = 2432 * MiB;
constexpr size_t WS_H8 = 2440 * MiB;
constexpr size_t WS_END = 2472 * MiB;
constexpr int R_TOPI = 0;
constexpr int R_TOPW = T * 4;
constexpr int R_DEST = 2 * T * 4;
constexpr int R_BUFTOK = 3 * T * 4;
constexpr int R_HIST = R_BUFTOK + CAP;
constexpr int R_TILEE = R_HIST + 1024 * 32;
constexpr int R_NTILES = R_TILEE + 1024;
static_assert((size_t)(R_NTILES + 64) * 4 <= 4 * MiB, "route tables");
constexpr int CW_BAR = 4096;
constexpr int MAX_LAUNCH = 64;

#define RLX_AGENT __ATOMIC_RELAXED, __HIP_MEMORY_SCOPE_AGENT
#define LDS_WAIT() asm volatile("s_waitcnt lgkmcnt(0)" ::: "memory")
#define VM_WAIT() asm volatile("s_waitcnt vmcnt(0)" ::: "memory")
typedef __bf16 bf16x2_t __attribute__((ext_vector_type(2)));
__device__ __forceinline__ unsigned cvt_pk_bf16(float lo, float hi) { const f32x2 v = {lo, hi}; const bf16x2_t r = __builtin_convertvector(v, bf16x2_t); return __builtin_bit_cast(unsigned, r); }
__device__ __forceinline__ float bf_lo(unsigned w) { return __uint_as_float(w << 16); }
__device__ __forceinline__ float bf_hi(unsigned w) { return __uint_as_float(w & 0xffff0000u); }
__device__ __forceinline__ float bf2f(bf16 b) { return __uint_as_float(((unsigned)b) << 16); }
__device__ __forceinline__ float shfl_xor_f(float v, int o, int lane) { return __builtin_bit_cast(float, __builtin_amdgcn_ds_bpermute((lane ^ o) << 2, __builtin_bit_cast(int, v))); }
__device__ __forceinline__ int shfl_i(int v, int src, int lane) { (void)lane; return __builtin_amdgcn_ds_bpermute(src << 2, v); }
__device__ __forceinline__ float wave_sum(float v, int lane) {
#pragma unroll
    for (int o = 1; o < 64; o <<= 1) v += shfl_xor_f(v, o, lane);
    return v;
}
__device__ __forceinline__ float row16_sum(float v) {
    v += __builtin_bit_cast(float, __builtin_amdgcn_update_dpp(0, __builtin_bit_cast(int, v), 0xB1, 0xf, 0xf, false));
    v += __builtin_bit_cast(float, __builtin_amdgcn_update_dpp(0, __builtin_bit_cast(int, v), 0x4E, 0xf, 0xf, false));
    v += __builtin_bit_cast(float, __builtin_amdgcn_update_dpp(0, __builtin_bit_cast(int, v), 0x141, 0xf, 0xf, false));
    v += __builtin_bit_cast(float, __builtin_amdgcn_update_dpp(0, __builtin_bit_cast(int, v), 0x140, 0xf, 0xf, false));
    return v;
}
__device__ __forceinline__ float wave_allsum(float v) {
    v = row16_sum(v);
    v += __builtin_bit_cast(float, __builtin_amdgcn_update_dpp(0, __builtin_bit_cast(int, v), 0x142, 0xa, 0xf, false));
    v += __builtin_bit_cast(float, __builtin_amdgcn_update_dpp(0, __builtin_bit_cast(int, v), 0x143, 0xc, 0xf, false));
    return __builtin_bit_cast(float, __builtin_amdgcn_readlane(__builtin_bit_cast(int, v), 63));
}
__device__ __forceinline__ float silu_f(float x) { return x * __builtin_amdgcn_rcpf(1.0f + __expf(-x)); }
__device__ __forceinline__ float sigmoid_f(float x) { return __builtin_amdgcn_rcpf(1.0f + __expf(-x)); }
__device__ __forceinline__ float gelu_f(float v) {
    const float av = fabsf(v), t = __builtin_amdgcn_rcpf(av * 0.2316418882f + 1.0f);
    float q = t * 0.5307027145f + (-0.7265760135f); q = q * t + 0.7107068705f; q = q * t + (-0.142248368f); q = q * t + 0.127414796f; q = q * t;
    const float e = __builtin_amdgcn_exp2f((v * v) * (-0.72134752044f));
    const float m = v * (q * e);
    return v < 0.f ? m : v - m;
}

__device__ __forceinline__ f32x2 gelu2(f32x2 v) {
    const f32x2 t = (f32x2){__builtin_amdgcn_rcpf(fabsf(v[0]) * 0.2316418882f + 1.0f), __builtin_amdgcn_rcpf(fabsf(v[1]) * 0.2316418882f + 1.0f)};
    f32x2 q = t * 0.5307027145f + (-0.7265760135f); q = q * t + 0.7107068705f; q = q * t + (-0.142248368f); q = q * t + 0.127414796f; q = q * t;
    const f32x2 x = (v * v) * (-0.72134752044f);
    const f32x2 qe = q * (f32x2){__builtin_amdgcn_exp2f(x[0]), __builtin_amdgcn_exp2f(x[1])};
    return (f32x2){__builtin_fmaf(-fabsf(v[0]), qe[0], fmaxf(v[0], 0.f)), __builtin_fmaf(-fabsf(v[1]), qe[1], fmaxf(v[1], 0.f))};
}
__device__ __forceinline__ int pack4_fp8_sat(float a0, float a1, float a2, float a3) {
    a0 = __builtin_amdgcn_fmed3f(a0, -448.f, 448.f); a1 = __builtin_amdgcn_fmed3f(a1, -448.f, 448.f); a2 = __builtin_amdgcn_fmed3f(a2, -448.f, 448.f); a3 = __builtin_amdgcn_fmed3f(a3, -448.f, 448.f);
    int w = __builtin_amdgcn_cvt_pk_fp8_f32(a0, a1, 0, false); return __builtin_amdgcn_cvt_pk_fp8_f32(a2, a3, w, true); }
#define XB_TMO      128
#define XB_XCNT(j)  (256  + 64 * (j))
#define XB_XSUB(j)  (1280 + 64 * (j))
#define XB_XGEN(j)  (2304 + 64 * (j))
#define XB_TOP      3328
#define XB_TOPGEN   3392
#define XCD_BAR_WORDS 3456
#define XB_SPIN_CAP (1u << 18)
__device__ __forceinline__ unsigned xb_ld(unsigned* p)              { return __hip_atomic_load(p, __ATOMIC_RELAXED, __HIP_MEMORY_SCOPE_AGENT); }
__device__ __forceinline__ unsigned xb_add(unsigned* p, unsigned v) { return __hip_atomic_fetch_add(p, v, __ATOMIC_RELAXED, __HIP_MEMORY_SCOPE_AGENT); }
__device__ __forceinline__ unsigned xb_xcc_id() { return (unsigned)__builtin_amdgcn_s_getreg((3 << 11) | 20) & 0xFu; }
#define XB_SPIN(cond, bar) do { unsigned _sp = 0; while (cond) { __builtin_amdgcn_s_sleep(1); \
    if ((++_sp & 255u) == 0u) { if (xb_ld(&(bar)[XB_TMO])) break; if (_sp > XB_SPIN_CAP) { atomicAdd(&(bar)[XB_TMO], 1u); break; } } } } while (0)
struct XcdBarrier { unsigned* bar; unsigned x; volatile LAS unsigned* st; };
__device__ __forceinline__ XcdBarrier xcd_barrier_post(unsigned* bar, volatile LAS unsigned* st) {
    XcdBarrier b; b.bar = bar; b.x = xb_xcc_id(); b.st = st;
    if (threadIdx.x == 0) (void)xb_add(&bar[XB_XCNT(b.x)], 1u);
    return b;
}
__device__ __forceinline__ void xcd_barrier_complete(unsigned* bar, unsigned x, unsigned& nloc, unsigned& nx) {
    const unsigned G = gridDim.x * gridDim.y * gridDim.z;
    unsigned sum, cnt, mine, sp = 0u;
    for (;;) {
        sum = 0u; cnt = 0u; mine = 0u;
#pragma unroll
        for (unsigned j = 0; j < 16; ++j) { const unsigned c = xb_ld(&bar[XB_XCNT(j)]); sum += c; cnt += (c > 0u) ? 1u : 0u; mine = (j == x) ? c : mine; }
        if (sum == G) break;
        __builtin_amdgcn_s_sleep(1);
        if ((++sp & 255u) == 0u) { if (xb_ld(&bar[XB_TMO])) break; if (sp > XB_SPIN_CAP) { atomicAdd(&bar[XB_TMO], 1u); break; } }
    }
    nloc = mine > 0u ? mine : 1u; nx = cnt > 0u ? cnt : 1u;
}
__device__ __forceinline__ void xcd_barrier(const XcdBarrier& b) {
    asm volatile("s_waitcnt vmcnt(0)" ::: "memory");
    __syncthreads();
    if (threadIdx.x == 0) {
        unsigned* bar = b.bar;
        __builtin_amdgcn_s_waitcnt(0);
        unsigned nloc = b.st[0], nx = b.st[1];
        if (nloc == 0u) { xcd_barrier_complete(bar, b.x, nloc, nx); b.st[0] = nloc; b.st[1] = nx; }
        const unsigned old = xb_add(&bar[XB_XSUB(b.x)], 1u);
        const unsigned gen = old / nloc;
        if (old + 1u == (gen + 1u) * nloc) {
            __builtin_amdgcn_fence(__ATOMIC_RELEASE, "agent");
            asm volatile("s_waitcnt vmcnt(0)" ::: "memory");
            const unsigned og = xb_add(&bar[XB_TOP], 1u);
            const unsigned tg = og / nx;
            if (og + 1u == (tg + 1u) * nx) xb_add(&bar[XB_TOPGEN], 1u);
            else XB_SPIN(xb_ld(&bar[XB_TOPGEN]) == tg, bar);
            __builtin_amdgcn_fence(__ATOMIC_ACQUIRE, "agent");
            xb_add(&bar[XB_XGEN(b.x)], 1u);
            asm volatile("s_waitcnt vmcnt(0)" ::: "memory");
        } else {
            XB_SPIN(xb_ld(&bar[XB_XGEN(b.x)]) == gen, bar);
            __builtin_amdgcn_fence(__ATOMIC_ACQUIRE, "agent");
            asm volatile("s_waitcnt vmcnt(0)" ::: "memory");
        }
    }
    __syncthreads();
}

struct Args { const float* in[27]; float* out; unsigned char* ws; int ph_lo, ph_hi, li, pad; };
enum { I_X = 0, I_C, I_ADAW, I_ADAB, I_LNG, I_LNB, I_GWIN, I_GWG2F, I_GBGF, I_GWG2B, I_GBGB, I_GNORM, I_GWOUT, I_SWIN, I_SBIN, I_SLNG, I_SLNB, I_SWS, I_SBS, I_SWOUT, I_SBOUT, I_RW, I_RB, I_WUP, I_BUP, I_WDN, I_BDN };

typedef const __attribute__((address_space(4))) Args* KA;
#define PHASE_ENTER() unsigned m1_ = ~0u; asm volatile("" : "+s"(m1_)); int tid = (wave_s << 6) | (int)__builtin_amdgcn_mbcnt_hi(m1_, __builtin_amdgcn_mbcnt_lo(m1_, 0u)); asm volatile("" : "+v"(tid)); int bx = blockIdx.x, G = gridDim.x; asm volatile("" : "+s"(bx), "+s"(G)); \
    KA a = (KA)__builtin_amdgcn_kernarg_segment_ptr(); asm volatile("" : "+s"(a)); unsigned char* ws = a->ws; \
    extern __shared__ __attribute__((aligned(16))) unsigned char lds_raw[]; LAS unsigned char* lds = (LAS unsigned char*)lds_raw; (void)lds; (void)ws; (void)bx; (void)G; (void)tid
__device__ __forceinline__ int perm64(int c) {
    return (c & ~255) + 128 * ((c >> 3) & 1) + 32 * ((c >> 6) & 3) + 16 * ((c >> 2) & 1) + 4 * ((c >> 4) & 3) + (c & 3);
}
__device__ __forceinline__ int swiglu_perm(int o) {
    const int a = o >> 1, h = o & 1, pn = a >> 7, r = a & 127, wc = r >> 5, fq = (r >> 3) & 3, bj = (r >> 2) & 1, j = r & 3;
    return 256 * pn + 128 * bj + 32 * wc + 16 * h + 4 * fq + j;
}
__device__ __forceinline__ void conv_tile(const float* W, int K, int N, int k0, int n0, int nw, bf16* dst, int mode, LAS float* scr, int lane) {
    (void)scr;
    if (lane >= nw) return;
    float v[64];
    const float* wp = W + (size_t)k0 * N + n0 + lane;
#pragma unroll
    for (int j = 0; j < 64; ++j) v[j] = __builtin_nontemporal_load(wp + (size_t)j * N);
    const int ng = n0 + lane;
    if (mode >= 3 && mode <= 5) {
        const int row = (mode == 4) ? swiglu_perm(ng) : (mode == 5) ? perm64(ng) : ng;
        unsigned char* dp = (unsigned char*)dst + (size_t)row * K + k0;
#pragma unroll
        for (int q = 0; q < 4; ++q) { unsigned w[4];
#pragma unroll
            for (int u = 0; u < 4; ++u) { const float* x = v + 16 * q + 4 * u; w[u] = (unsigned)pack4_fp8_sat(x[0] * F8_WSCALE, x[1] * F8_WSCALE, x[2] * F8_WSCALE, x[3] * F8_WSCALE); }
            *(u32x4*)(dp + 16 * q) = (u32x4){w[0], w[1], w[2], w[3]}; }
    } else if (mode == 2) {
        bf16* dp = dst + (size_t)lane * K + k0;
#pragma unroll
        for (int q = 0; q < 8; ++q) { const float* x = v + 8 * q; u32x4 o; o.x = cvt_pk_bf16(x[0], x[1]); o.y = cvt_pk_bf16(x[2], x[3]); o.z = cvt_pk_bf16(x[4], x[5]); o.w = cvt_pk_bf16(x[6], x[7]);
            u32x4 l; l.x = cvt_pk_bf16(x[0] - bf_lo(o.x), x[1] - bf_hi(o.x)); l.y = cvt_pk_bf16(x[2] - bf_lo(o.y), x[3] - bf_hi(o.y)); l.z = cvt_pk_bf16(x[4] - bf_lo(o.z), x[5] - bf_hi(o.z)); l.w = cvt_pk_bf16(x[6] - bf_lo(o.w), x[7] - bf_hi(o.w));
            *(u32x4*)(dp + 8 * q) = o; *(u32x4*)(dp + (size_t)32 * K + 8 * q) = l; }
    } else {
        const int row = (mode == 1) ? swiglu_perm(ng) : (mode == 6) ? perm64(ng) : ng;
        bf16* dp = dst + (size_t)row * K + k0;
#pragma unroll
        for (int q = 0; q < 8; ++q) { const float* x = v + 8 * q; *(u32x4*)(dp + 8 * q) = (u32x4){cvt_pk_bf16(x[0], x[1]), cvt_pk_bf16(x[2], x[3]), cvt_pk_bf16(x[4], x[5]), cvt_pk_bf16(x[6], x[7])}; }
    }
}

__device__ __forceinline__ void phase_prologue(KA a, LAS unsigned char* lds, int tid, int bx, int G) {
    const int lane = tid & 63, wave = __builtin_amdgcn_readfirstlane(tid >> 6);
    unsigned char* ws = a->ws;
    for (int slab = bx; slab < 192; slab += G) {
        LAS float* sc = (LAS float*)lds;
        LAS float* red = (LAS float*)(lds + 32768);
        for (int i = tid; i < 8 * 1024; i += NTHREADS) sc[i] = silu_f(a->in[I_C][i]);
        __syncthreads();
        const int g0 = slab * 128, l = g0 / 6144, e0 = g0 % 6144;
        const int c4 = tid & 31, seg = tid >> 5;
        f32x4 acc[8];
#pragma unroll
        for (int b = 0; b < 8; ++b) acc[b] = (f32x4){0.f, 0.f, 0.f, 0.f};
        const float* wp = a->in[I_ADAW] + ((size_t)l * 1024 + seg * 64) * 6144 + e0 + 4 * c4;
#pragma unroll 8
        for (int d = 0; d < 64; ++d) { const f32x4 w = __builtin_nontemporal_load((const f32x4*)(wp + (size_t)d * 6144));
#pragma unroll
            for (int b = 0; b < 8; ++b) acc[b] += w * sc[b * 1024 + seg * 64 + d]; }
#pragma unroll
        for (int b = 0; b < 8; ++b) *(LAS f32x4*)(red + (seg * 8 + b) * 128 + 4 * c4) = acc[b];
        __syncthreads();
        for (int o = tid; o < 1024; o += NTHREADS) { const int b = o >> 7, c = o & 127; float s = a->in[I_ADAB][l * 6144 + e0 + c];
#pragma unroll
            for (int sg = 0; sg < 16; ++sg) s += red[(sg * 8 + b) * 128 + c];
            ((float*)(ws + WS_MOD))[((size_t)l * 8 + b) * 6144 + e0 + c] = s; }
        __syncthreads();
    }
    LAS float* scr = (LAS float*)(lds + wave * 16640);
    const int gw = bx * NWAVES + wave, NGW = G * NWAVES;
    constexpr int N_UP = 128 * 16 * 32, N_DN = 128 * 16 * 16, N_GIN = 2 * 16 * 48, N_GLR = 2 * 16, N_GOUT = 2 * 256, N_SIN = 2 * 16 * 32, N_SOUT = 2 * 256, N_RT = 4 * 16;
    constexpr int NITEMS = N_UP + N_DN + N_GIN + N_GLR + N_GOUT + N_SIN + N_SOUT + N_RT;
    for (int it = gw; it < NITEMS; it += NGW) {
        int r = it;
        if (r < N_UP) { const int m = r >> 9, q = r & 511, kt = q >> 5, nt = q & 31;
            conv_tile(a->in[I_WUP] + (size_t)m * 1024 * 2048, 1024, 2048, kt * 64, nt * 64, 64, (bf16*)(ws + WS_WUP_T + (size_t)m * 2048 * 1024 * (MOE_FP8 ? 1 : 2)), MOE_FP8 ? 4 : 1, scr, lane); continue; } r -= N_UP;
        if (r < N_DN) { const int m = r >> 8, q = r & 255, kt = q >> 4, nt = q & 15;
            conv_tile(a->in[I_WDN] + (size_t)m * 1024 * 1024, 1024, 1024, kt * 64, nt * 64, 64, (bf16*)(ws + WS_WDN_T + (size_t)m * 1024 * 1024 * (MOE_FP8 ? 1 : 2)), MOE_FP8 ? 5 : 0, scr, lane); continue; } r -= N_DN;
        if (r < N_GIN) { const int m = r / 768, q = r % 768, kt = q / 48, nt = q % 48;
            conv_tile(a->in[I_GWIN] + (size_t)m * 1024 * GLA_IN, 1024, GLA_IN, kt * 64, nt * 64, 64, (bf16*)(ws + WS_GLAIN_T) + (size_t)m * GLA_MAIN * 1024, 6, scr, lane); continue; } r -= N_GIN;
        if (r < N_GLR) { const int m = r >> 4, kt = r & 15;
            conv_tile(a->in[I_GWIN] + (size_t)m * 1024 * GLA_IN, 1024, GLA_IN, kt * 64, GLA_MAIN, 32, (bf16*)(ws + WS_GLALR_T) + (size_t)m * 64 * 1024, 2, scr, lane); continue; } r -= N_GLR;
        if (r < N_GOUT) { const int m = r >> 8, q = r & 255, kt = q >> 4, nt = q & 15;
            conv_tile(a->in[I_GWOUT] + (size_t)m * 1024 * 1024, 1024, 1024, kt * 64, nt * 64, 64, (bf16*)(ws + WS_GLAOUT_T + (size_t)m * 1024 * 1024 * (OUT_FP8 ? 1 : 2)), OUT_FP8 ? 5 : 6, scr, lane); continue; } r -= N_GOUT;
        if (r < N_SIN) { const int m = r >> 9, q = r & 511, kt = q >> 5, nt = q & 31;
            conv_tile(a->in[I_SWIN] + (size_t)m * 1024 * 2048, 1024, 2048, kt * 64, nt * 64, 64, (bf16*)(ws + WS_SGUIN_T + (size_t)m * 2048 * 1024 * (SGUIN_FP8 ? 1 : 2)), SGUIN_FP8 ? 5 : 6, scr, lane); continue; } r -= N_SIN;
        if (r < N_SOUT) { const int m = r >> 8, q = r & 255, kt = q >> 4, nt = q & 15;
            conv_tile(a->in[I_SWOUT] + (size_t)m * 1024 * 1024, 1024, 1024, kt * 64, nt * 64, 64, (bf16*)(ws + WS_SGUOUT_T + (size_t)m * 1024 * 1024 * (OUT_FP8 ? 1 : 2)), OUT_FP8 ? 5 : 6, scr, lane); continue; } r -= N_SOUT;
        { const int m = r >> 4, kt = r & 15;
            conv_tile(a->in[I_RW] + (size_t)m * 1024 * 32, 1024, 32, kt * 64, 0, 32, (bf16*)(ws + WS_ROUTER_T) + (size_t)m * 64 * 1024, 2, scr, lane); }
    }
    { bf16* d = (bf16*)(ws + WS_SGUWS); const float* s = a->in[I_SWS];
      for (int i = (bx * NTHREADS + tid) * 4; i < 2 * 8 * 128 * 128; i += G * NTHREADS * 4) { const f32x4 v = *(const f32x4*)(s + i); u32x2 o; o.x = cvt_pk_bf16(v[0], v[1]); o.y = cvt_pk_bf16(v[2], v[3]); *(u32x2*)(d + i) = o; } }
}

struct RowPass {
    const void* xin; const bf16* y; void* xout; bf16* hout; unsigned char* h8out; int xin16, xout16;
    const float* gate; const float* lng; const float* lnb; const float* sc; const float* sh;
    const bf16* wside;
    float* lr_out;
    const float* rbias;
    int* topi; float* topw; int* hist;
    const void* ys; const int* dest; const float* tw;
    int has_h, has_side;
};
template <int MODE, bool X16 = false>
__device__ __forceinline__ void row_pass(const RowPass& p, LAS unsigned char* lds, int tid, int bx, int G) {
    const int lane0 = tid & 63, wave = __builtin_amdgcn_readfirstlane(tid >> 6);
    constexpr int HS = 1040;
    LAS bf16* Hhi = (LAS bf16*)lds;
    LAS bf16* Hlo = (LAS bf16*)(lds + 16 * HS * 2);
    constexpr int PS = 36;
    LAS float* part = (LAS float*)(lds + 2 * 16 * HS * 2);
    LAS float* logit = part + 8 * 16 * PS;
    LAS int* lhist = (LAS int*)(logit + 16 * 32);
    LAS float* selv = (LAS float*)(lhist + 32);
    constexpr bool PF = (MODE == 1) && X16;
    if (MODE == 1) { if (tid < 32) lhist[tid] = 0; }
    const bool side = (p.has_side != 0) && (p.wside != nullptr);
    u32x2 xq[2][4], yq[2][4]; f32x4 vg[4];
    float rb = 0.f; if (MODE == 1) rb = p.rbias[tid & 31];
    if (PF) {
#pragma unroll
        for (int tt = 0; tt < 2; ++tt) { const int token = bx * 16 + 2 * wave + tt;
            { const bf16* xr = (const bf16*)p.xin + (size_t)token * D + 4 * lane0;
#pragma unroll
                for (int j = 0; j < 4; ++j) xq[tt][j] = *(const u32x2*)(xr + 256 * j); }
            const bf16* yr = p.y + (size_t)token * D + 4 * lane0;
#pragma unroll
            for (int j = 0; j < 4; ++j) yq[tt][j] = *(const u32x2*)(yr + 256 * j); }
        { const float* gp = p.gate + (size_t)((bx * 16) / SEQ) * 6144 + 4 * lane0;
#pragma unroll
            for (int j = 0; j < 4; ++j) vg[j] = *(const f32x4*)(gp + 256 * j); }
    }
    for (int tile = bx; tile < T / 16; tile += G) {
        const int b = (tile * 16) / SEQ;
        int lane = lane0; asm volatile("" : "+v"(lane));
        bf16x8 whi[2][4], wlo[2][4];
        {
            const int tl0 = 2 * wave, token0 = tile * 16 + tl0;
            f32x4 v[2][4]; int y8[2][4][4]; float wk[2][4];
            f32x4 vlg[4], vlb[4], vsc[4], vsh[4];
#pragma unroll
            for (int tt = 0; tt < 2; ++tt) {
                const int token = token0 + tt;
                if (p.xin16) { if (!PF) { const bf16* xr = (const bf16*)p.xin + (size_t)token * D + 4 * lane;
#pragma unroll
                    for (int j = 0; j < 4; ++j) xq[tt][j] = *(const u32x2*)(xr + 256 * j); } }
                else { const float* xr = (const float*)p.xin + (size_t)token * D + 4 * lane;
#pragma unroll
                    for (int j = 0; j < 4; ++j) v[tt][j] = *(const f32x4*)(xr + 256 * j); }
                if (MODE == 1 && !PF) { const bf16* yr = p.y + (size_t)token * D + 4 * lane;
#pragma unroll
                    for (int j = 0; j < 4; ++j) yq[tt][j] = *(const u32x2*)(yr + 256 * j); }
                if (MODE == 2) {
                    const int4 d4 = *(const int4*)(p.dest + token * 4); const f32x4 w4 = *(const f32x4*)(p.tw + token * 4); const int ds[4] = {d4.x, d4.y, d4.z, d4.w};
#pragma unroll
                    for (int k = 0; k < 4; ++k) { wk[tt][k] = w4[k];
                        const unsigned char* yr = (const unsigned char*)p.ys + (size_t)ds[k] * D + 4 * lane;
#pragma unroll
                        for (int j = 0; j < 4; ++j) y8[tt][k][j] = *(const int*)(yr + 256 * j); }
                }
            }
            if (MODE != 0 && !PF) { const float* gp = p.gate + (size_t)b * 6144 + 4 * lane;
#pragma unroll
                for (int j = 0; j < 4; ++j) vg[j] = *(const f32x4*)(gp + 256 * j); }
#pragma unroll
            for (int tt = 0; tt < 2; ++tt)
#pragma unroll
                for (int j = 0; j < 4; ++j) {
                    if (p.xin16) asm volatile("" : "+v"(xq[tt][j])); else asm volatile("" : "+v"(v[tt][j]));
                    if (MODE == 1) asm volatile("" : "+v"(yq[tt][j]));
                    if (MODE == 2) asm volatile("" : "+v"(y8[tt][0][j]), "+v"(y8[tt][1][j]), "+v"(y8[tt][2][j]), "+v"(y8[tt][3][j]));
                }
            if (PF && side) {
#pragma unroll
                for (int hf = 0; hf < 2; ++hf)
#pragma unroll
                    for (int s4 = 0; s4 < 4; ++s4) { const size_t off = (size_t)(hf * 16 + (lane & 15)) * 1024 + 128 * wave + 32 * s4 + 8 * (lane >> 4);
                    whi[hf][s4] = *(const bf16x8*)(p.wside + off); wlo[hf][s4] = *(const bf16x8*)(p.wside + 32 * 1024 + off); }
            }
#pragma unroll
            for (int tt = 0; tt < 2; ++tt) {
                if (p.xin16) {
#pragma unroll
                    for (int j = 0; j < 4; ++j) v[tt][j] = (f32x4){bf_lo(xq[tt][j].x), bf_hi(xq[tt][j].x), bf_lo(xq[tt][j].y), bf_hi(xq[tt][j].y)}; }
                if (MODE == 1) {
#pragma unroll
                    for (int j = 0; j < 4; ++j) { const f32x4 yy = (f32x4){bf_lo(yq[tt][j].x), bf_hi(yq[tt][j].x), bf_lo(yq[tt][j].y), bf_hi(yq[tt][j].y)}; v[tt][j] = v[tt][j] * ALPHA + (vg[j] + 1.0f) * yy; }
                }
                if (MODE == 2) {
                    f32x4 ya[4];
#pragma unroll
                    for (int j = 0; j < 4; ++j) ya[j] = (f32x4){0.f, 0.f, 0.f, 0.f};
#pragma unroll
                    for (int k = 0; k < 4; ++k) { const float w = wk[tt][k] * (1.0f / F8_YSCALE);
#pragma unroll
                        for (int j = 0; j < 4; ++j) { const f32x2 lo2 = __builtin_amdgcn_cvt_pk_f32_fp8(y8[tt][k][j], false), hi2 = __builtin_amdgcn_cvt_pk_f32_fp8(y8[tt][k][j], true); ya[j] += (f32x4){lo2[0], lo2[1], hi2[0], hi2[1]} * w; } }
#pragma unroll
                    for (int j = 0; j < 4; ++j) v[tt][j] = v[tt][j] * ALPHA + (vg[j] + 1.0f) * ya[j];
                }
            }
            if (MODE != 0) {
#pragma unroll
                for (int j = 0; j < 4; ++j) { vlg[j] = *(const f32x4*)(p.lng + 4 * lane + 256 * j); vlb[j] = *(const f32x4*)(p.lnb + 4 * lane + 256 * j); } }
            if (p.has_h) { const float* scp = p.sc + (size_t)b * 6144 + 4 * lane; const float* shp = p.sh + (size_t)b * 6144 + 4 * lane;
#pragma unroll
                for (int j = 0; j < 4; ++j) { vsc[j] = *(const f32x4*)(scp + 256 * j); vsh[j] = *(const f32x4*)(shp + 256 * j); } }
#pragma unroll
            for (int j = 0; j < 4; ++j) { asm volatile("" : "+v"(v[0][j]), "+v"(v[1][j])); }
            if (MODE != 0) {
                float s0 = 0.f, s1 = 0.f;
#pragma unroll
                for (int j = 0; j < 4; ++j) { s0 += (v[0][j][0] + v[0][j][1]) + (v[0][j][2] + v[0][j][3]); s1 += (v[1][j][0] + v[1][j][1]) + (v[1][j][2] + v[1][j][3]); }
                s0 = wave_allsum(s0); s1 = wave_allsum(s1);
                const float m0 = s0 * (1.0f / D), m1 = s1 * (1.0f / D); float q0 = 0.f, q1 = 0.f;
#pragma unroll
                for (int j = 0; j < 4; ++j) { v[0][j] = v[0][j] - m0; v[1][j] = v[1][j] - m1;
                    q0 += (v[0][j][0] * v[0][j][0] + v[0][j][1] * v[0][j][1]) + (v[0][j][2] * v[0][j][2] + v[0][j][3] * v[0][j][3]);
                    q1 += (v[1][j][0] * v[1][j][0] + v[1][j][1] * v[1][j][1]) + (v[1][j][2] * v[1][j][2] + v[1][j][3] * v[1][j][3]); }
                q0 = wave_allsum(q0); q1 = wave_allsum(q1);
                const float r0 = __builtin_amdgcn_rsqf(q0 * (1.0f / D) + LN_EPS), r1 = __builtin_amdgcn_rsqf(q1 * (1.0f / D) + LN_EPS);
#pragma unroll
                for (int j = 0; j < 4; ++j) { v[0][j] = v[0][j] * r0 * vlg[j] + vlb[j]; v[1][j] = v[1][j] * r1 * vlg[j] + vlb[j]; }
#pragma unroll
                for (int tt = 0; tt < 2; ++tt) {
                    if (p.xout16) { bf16* xo = (bf16*)p.xout + (size_t)(token0 + tt) * D + 4 * lane;
#pragma unroll
                        for (int j = 0; j < 4; ++j) { u32x2 o; o.x = cvt_pk_bf16(v[tt][j][0], v[tt][j][1]); o.y = cvt_pk_bf16(v[tt][j][2], v[tt][j][3]); *(u32x2*)(xo + 256 * j) = o; } }
                    else { float* xo = (float*)p.xout + (size_t)(token0 + tt) * D + 4 * lane;
#pragma unroll
                        for (int j = 0; j < 4; ++j) *(f32x4*)(xo + 256 * j) = v[tt][j]; }
                }
            }
            if (p.has_h) {
#pragma unroll
                for (int tt = 0; tt < 2; ++tt) { const int token = token0 + tt, tl = tl0 + tt;
                    bf16* ho = p.hout + (size_t)token * D + 4 * lane;
#pragma unroll
                    for (int j = 0; j < 4; ++j) { const f32x4 h = v[tt][j] * (vsc[j] + 1.0f) + vsh[j];
                        u32x2 o; o.x = cvt_pk_bf16(h[0], h[1]); o.y = cvt_pk_bf16(h[2], h[3]);
                        if (p.h8out) { const int w8 = pack4_fp8_sat(h[0] * F8_HSCALE, h[1] * F8_HSCALE, h[2] * F8_HSCALE, h[3] * F8_HSCALE); *(int*)(p.h8out + (size_t)token * D + 4 * lane + 256 * j) = w8; }
                        else *(u32x2*)(ho + 256 * j) = o;
                        if (side) { u32x2 l; l.x = cvt_pk_bf16(h[0] - bf_lo(o.x), h[1] - bf_hi(o.x)); l.y = cvt_pk_bf16(h[2] - bf_lo(o.y), h[3] - bf_hi(o.y));
                            *(LAS u32x2*)(Hhi + tl * HS + 4 * lane + 256 * j) = o; *(LAS u32x2*)(Hlo + tl * HS + 4 * lane + 256 * j) = l; } } }
            }
        }
        if (!PF && side) {
#pragma unroll
            for (int hf = 0; hf < 2; ++hf)
#pragma unroll
                for (int s4 = 0; s4 < 4; ++s4) { const size_t off = (size_t)(hf * 16 + (lane & 15)) * 1024 + 128 * wave + 32 * s4 + 8 * (lane >> 4);
                    whi[hf][s4] = *(const bf16x8*)(p.wside + off); wlo[hf][s4] = *(const bf16x8*)(p.wside + 32 * 1024 + off); }
        }
        if (PF) {
            const int ntile = (tile + G < T / 16) ? tile + G : tile;
#pragma unroll
            for (int tt = 0; tt < 2; ++tt) { const int token = ntile * 16 + 2 * wave + tt;
                { const bf16* xr = (const bf16*)p.xin + (size_t)token * D + 4 * lane;
#pragma unroll
                    for (int j = 0; j < 4; ++j) xq[tt][j] = *(const u32x2*)(xr + 256 * j); }
                const bf16* yr = p.y + (size_t)token * D + 4 * lane;
#pragma unroll
                for (int j = 0; j < 4; ++j) yq[tt][j] = *(const u32x2*)(yr + 256 * j); }
            { const float* gp = p.gate + (size_t)((ntile * 16) / SEQ) * 6144 + 4 * lane;
#pragma unroll
                for (int j = 0; j < 4; ++j) vg[j] = *(const f32x4*)(gp + 256 * j); }
        }
        if (side) {
            __syncthreads();
            f32x4 acc[2]; acc[0] = (f32x4){0.f, 0.f, 0.f, 0.f}; acc[1] = acc[0];
#pragma unroll
            for (int s = 0; s < 4; ++s) { const int ko = (lane & 15) * HS + 128 * wave + 32 * s + 8 * (lane >> 4);
                const bf16x8 bh = *(const LAS bf16x8*)(Hhi + ko), bl = *(const LAS bf16x8*)(Hlo + ko);
#pragma unroll
                for (int hf = 0; hf < 2; ++hf) { acc[hf] = __builtin_amdgcn_mfma_f32_16x16x32_bf16(whi[hf][s], bh, acc[hf], 0, 0, 0);
                    acc[hf] = __builtin_amdgcn_mfma_f32_16x16x32_bf16(wlo[hf][s], bh, acc[hf], 0, 0, 0); acc[hf] = __builtin_amdgcn_mfma_f32_16x16x32_bf16(whi[hf][s], bl, acc[hf], 0, 0, 0); } }
#pragma unroll
            for (int hf = 0; hf < 2; ++hf) *(LAS f32x4*)(part + (wave * 16 + (lane & 15)) * PS + hf * 16 + 4 * (lane >> 4)) = acc[hf];
            __syncthreads();
            int e = tid & 31; asm volatile("" : "+v"(e));
            const int tk = tid >> 5; float sg = 0.f;
#pragma unroll
            for (int w = 0; w < 8; ++w) sg += part[(w * 16 + tk) * PS + e];
            if (MODE != 1) p.lr_out[(size_t)(tile * 16 + tk) * 32 + e] = sg;
            if (MODE == 1) {
                const float lg = sg + rb;
                logit[tk * 32 + e] = lg;
                int rank = 0;
#pragma unroll
                for (int q = 0; q < 8; ++q) { const f32x4 L = *(const LAS f32x4*)(logit + tk * 32 + 4 * q);
#pragma unroll
                    for (int u = 0; u < 4; ++u) rank += (int)(L[u] > lg) | ((int)(L[u] == lg) & (int)((4 * q + u) < e)); }
                if (PF) {
#pragma unroll
                    for (int tt = 0; tt < 2; ++tt)
#pragma unroll
                        for (int j = 0; j < 4; ++j) asm volatile("" : "+v"(xq[tt][j]), "+v"(yq[tt][j]));
#pragma unroll
                    for (int j = 0; j < 4; ++j) asm volatile("" : "+v"(vg[j])); }
                if (rank < 4) { selv[tk * 4 + rank] = lg; ((LAS int*)selv)[64 + tk * 4 + rank] = e; atomicAdd((int*)&lhist[e], 1); }
                const f32x4 bv = *(const LAS f32x4*)(selv + tk * 4); const i32x4 bi = *(const LAS i32x4*)((LAS int*)selv + 64 + tk * 4);
                if (e == 0) { const int token = tile * 16 + tk;
                    const float e1 = __expf(bv[1] - bv[0]), e2 = __expf(bv[2] - bv[0]), e3 = __expf(bv[3] - bv[0]); const float inv = __builtin_amdgcn_rcpf(1.0f + e1 + e2 + e3);
                    *(i32x4*)(p.topi + token * 4) = bi;
                    *(f32x4*)(p.topw + token * 4) = (f32x4){inv, e1 * inv, e2 * inv, e3 * inv}; }
            }
        }
    }
    if (MODE == 1) { __syncthreads(); if (tid < 32) p.hist[tid] = lhist[tid]; }
}

__device__ __forceinline__ void phase_place(int* route, LAS unsigned char* lds, int tid, int bx, int G) {
    const int lane = tid & 63, wave = tid >> 6;
    LAS int* ptot = (LAS int*)lds;
    LAS int* ppre = ptot + 512;
    LAS int* tot = ppre + 512;
    LAS int* pre = tot + 32;
    LAS int* pstart = pre + 32;
    const int* hist = route + R_HIST;
    { const int e = tid & 31, part = tid >> 5; int st = 0, sp = 0;
      if (G <= 256) { int hv[16];
#pragma unroll
          for (int q = 0; q < 16; ++q) { const int bb = part + 16 * q; hv[q] = (bb < G) ? hist[bb * 32 + e] : 0; }
#pragma unroll
          for (int q = 0; q < 16; ++q) { const int bb = part + 16 * q; st += hv[q]; if (bb < bx) sp += hv[q]; } }
      else { for (int bb = part; bb < G; bb += 16) { const int h = hist[bb * 32 + e]; st += h; if (bb < bx) sp += h; } }
      ptot[part * 32 + e] = st; ppre[part * 32 + e] = sp; }
    __syncthreads();
    if (tid < 32) { int st = 0, sp = 0;
#pragma unroll
        for (int q = 0; q < 16; ++q) { st += ptot[q * 32 + tid]; sp += ppre[q * 32 + tid]; }
        tot[tid] = st; pre[tid] = sp; }
    __syncthreads();
    if (tid == 0) { int acc = 0; for (int e = 0; e < 32; ++e) { pstart[e] = acc; acc += (tot[e] + 255) / 256 * 256; } pstart[32] = acc; }
    __syncthreads();
    if (bx == 0) {
        const int ntiles = pstart[32] / 256;
        if (tid == 0) route[R_NTILES] = ntiles;
        for (int t = tid; t < ntiles; t += NTHREADS) { int e = 0; for (int q = 1; q < 32; ++q) if (pstart[q] <= t * 256) e = q; route[R_TILEE + t] = e; }
    }
    for (int e = bx; e < 32; e += G) { const int s0 = pstart[e] + tot[e], s1 = pstart[e + 1]; for (int s = s0 + tid; s < s1; s += NTHREADS) route[R_BUFTOK + s] = 0; }
    LAS int* wcnt = pstart + 40;
    int runbase = 0;
    for (int t0 = bx; t0 < T / 16; t0 += 8 * G) {
        const int tile = t0 + wave * G; const bool live = tile < T / 16;
        const int token = tile * 16 + (lane >> 2);
        const int e = live ? route[R_TOPI + tile * 64 + lane] : -1;
        int rank = 0, add = 0;
#pragma unroll 1
        for (int x = 0; x < 32; ++x) { const unsigned long long m = __ballot(e == x); if (e == x) rank = __popcll(m & ((1ull << lane) - 1ull)); if (lane == x) add = __popcll(m); }
        __syncthreads();
        if (lane < 32) wcnt[wave * 32 + lane] = add;
        __syncthreads();
        int before = 0, all = 0;
        if (lane < 32) {
#pragma unroll
            for (int w = 0; w < 8; ++w) { const int c = wcnt[w * 32 + lane]; all += c; if (w < wave) before += c; } }
        const int basev = runbase + before;
        const int base = shfl_i(basev, live ? e : 0, lane);
        if (live) { const int ds = pstart[e] + pre[e] + base + rank;
            route[R_DEST + tile * 64 + lane] = ds;
            route[R_BUFTOK + ds] = token; }
        runbase += all;
    }
}

struct Unit { int pm, pn, e; const char* bt; };
constexpr int NXCD = 8, WGM = 8;
struct Sched {
    int nM, nN, nwg, G, c; const char* Bt; size_t estride; const int* tile_e; int KB;
    __device__ __forceinline__ void init(int nM_, int nN_, int G_, int c_, const void* Bt_, size_t es, const int* te, int KB_) { nM = nM_; nN = nN_; nwg = nM * nN; G = G_; c = c_; Bt = (const char*)Bt_; estride = es; tile_e = te; KB = KB_; }
    __device__ __forceinline__ bool next(int i, Unit& u) const {
        const long L = (long)i * G + c; if (L >= nwg) return false;
        int wgid = (int)L; { const int q = nwg / NXCD, r = nwg % NXCD, xcd = wgid % NXCD, off = wgid / NXCD; wgid = (xcd < r ? xcd * (q + 1) : r * (q + 1) + (xcd - r) * q) + off; }
        const int nig = WGM * nN, gid = wgid / nig, fm = gid * WGM, gsz = (nM - fm) < WGM ? (nM - fm) : WGM;
        u.pm = fm + ((wgid % nig) % gsz); u.pn = (wgid % nig) / gsz;
        u.e = tile_e ? __builtin_amdgcn_readfirstlane(tile_e[u.pm]) : 0;
        u.bt = Bt + (size_t)u.e * estride + (size_t)u.pn * 256 * KB;
        return true;
    }
};
struct EpiGlaIn { bf16* O;
    static constexpr int NST = 16;
    __device__ __forceinline__ const float* bias_ptr(const Unit&) const { return nullptr; }
    __device__ __forceinline__ void operator()(const f32x4 (&acc)[2][2][4][2], const Unit& u, int wr, int wc, int fr, int fq, const LAS float*) const {
        const int row0 = u.pm * 256 + wr * 64 + fr, col0 = u.pn * 256 + wc * 64 + 16 * fq; const float sc = (u.pn < 2) ? 0.08838834764831845f : 1.0f;
#pragma unroll
        for (int ai = 0; ai < 2; ++ai)
#pragma unroll
            for (int m = 0; m < 4; ++m) { bf16* rp = O + (size_t)(row0 + ai * 128 + m * 16) * GLA_MAIN + col0;
#pragma unroll
                for (int bj = 0; bj < 2; ++bj) { const f32x4 v0 = acc[ai][bj][m][0] * sc, v1 = acc[ai][bj][m][1] * sc;
                    *(u32x4*)(rp + bj * 8) = (u32x4){cvt_pk_bf16(v0[0], v0[1]), cvt_pk_bf16(v0[2], v0[3]), cvt_pk_bf16(v1[0], v1[1]), cvt_pk_bf16(v1[2], v1[3])}; } }
    }
};
struct EpiSguIn { bf16* O; const float* bias; float asc;
    static constexpr int NST = 16;
    __device__ __forceinline__ const float* bias_ptr(const Unit& u) const { return bias + u.pn * 256; }
    __device__ __forceinline__ void operator()(const f32x4 (&acc)[2][2][4][2], const Unit& u, int wr, int wc, int fr, int fq, const LAS float* lb) const {
        const int row0 = u.pm * 256 + wr * 64 + fr, col0 = u.pn * 256 + wc * 64 + 16 * fq;
        f32x4 bv[2][2];
#pragma unroll
        for (int bj = 0; bj < 2; ++bj)
#pragma unroll
            for (int n = 0; n < 2; ++n) bv[bj][n] = *(const LAS f32x4*)(lb + wc * 64 + 16 * fq + bj * 8 + 4 * n);
#pragma unroll
        for (int ai = 0; ai < 2; ++ai)
#pragma unroll
            for (int m = 0; m < 4; ++m) { bf16* rp = O + (size_t)(row0 + ai * 128 + m * 16) * 2048 + col0;
#pragma unroll
                for (int bj = 0; bj < 2; ++bj) { const f32x4 v0 = acc[ai][bj][m][0] * asc + bv[bj][0], v1 = acc[ai][bj][m][1] * asc + bv[bj][1];
                    const f32x2 g0 = gelu2(v0.xy), g1 = gelu2(v0.zw), g2 = gelu2(v1.xy), g3 = gelu2(v1.zw);
                    *(u32x4*)(rp + bj * 8) = (u32x4){cvt_pk_bf16(g0[0], g0[1]), cvt_pk_bf16(g1[0], g1[1]), cvt_pk_bf16(g2[0], g2[1]), cvt_pk_bf16(g3[0], g3[1])}; } }
    }
};
struct EpiOut { bf16* O; const float* bias; float asc;
    static constexpr int NST = 16;
    __device__ __forceinline__ const float* bias_ptr(const Unit& u) const { return bias ? bias + u.pn * 256 : nullptr; }
    __device__ __forceinline__ void operator()(const f32x4 (&acc)[2][2][4][2], const Unit& u, int wr, int wc, int fr, int fq, const LAS float* lb) const {
        const int row0 = u.pm * 256 + wr * 64 + fr, col0 = u.pn * 256 + wc * 64 + 16 * fq;
        f32x4 bv[2][2];
#pragma unroll
        for (int bj = 0; bj < 2; ++bj)
#pragma unroll
            for (int n = 0; n < 2; ++n) bv[bj][n] = bias ? *(const LAS f32x4*)(lb + wc * 64 + 16 * fq + bj * 8 + 4 * n) : (f32x4){0.f, 0.f, 0.f, 0.f};
#pragma unroll
        for (int ai = 0; ai < 2; ++ai)
#pragma unroll
            for (int m = 0; m < 4; ++m) { bf16* rp = O + (size_t)(row0 + ai * 128 + m * 16) * D + col0;
#pragma unroll
                for (int bj = 0; bj < 2; ++bj) { const f32x4 v0 = acc[ai][bj][m][0] * asc + bv[bj][0], v1 = acc[ai][bj][m][1] * asc + bv[bj][1];
                    *(u32x4*)(rp + bj * 8) = (u32x4){cvt_pk_bf16(v0[0], v0[1]), cvt_pk_bf16(v0[2], v0[3]), cvt_pk_bf16(v1[0], v1[1]), cvt_pk_bf16(v1[2], v1[3])}; } }
    }
};
template <bool F8> struct EpiUp { unsigned char* O; const float* bias;
    __device__ __forceinline__ const float* bias_ptr(const Unit& u) const { return bias + (size_t)u.e * 2048 + u.pn * 256; }
    __device__ __forceinline__ void operator()(const f32x4 (&acc)[2][2][4][2], const Unit& u, int wr, int wc, int fr, int fq, const LAS float* lb) const {
        const int row0 = u.pm * 256 + wr * 64 + fr, a0 = u.pn * 128 + wc * 32 + 8 * fq;
        const float osc = F8 ? F8_ASCALE : 1.0f, asc = F8 ? 1.0f / (F8_WSCALE * F8_HSCALE) : 1.0f, ascl = asc * osc;
        f32x2 kc = (f32x2){-1.702f * 1.4426950408889634f, -1.702f * 1.4426950408889634f}, one = (f32x2){1.0f, 1.0f};
        asm volatile("" : "+v"(kc), "+v"(one));
        f32x4 bg[2], bl[2];
#pragma unroll
        for (int bj = 0; bj < 2; ++bj) { const LAS float* bp = lb + 2 * (wc * 32 + 8 * fq + 4 * bj); const f32x4 p0 = *(const LAS f32x4*)bp, p1 = *(const LAS f32x4*)(bp + 4);
            bg[bj] = (f32x4){p0[0], p0[2], p1[0], p1[2]}; bl[bj] = ((f32x4){p0[1], p0[3], p1[1], p1[3]} + 1.0f) * osc; }
#pragma unroll
        for (int ai = 0; ai < 2; ++ai)
#pragma unroll
            for (int m = 0; m < 4; ++m) { const size_t ro = (size_t)(row0 + ai * 128 + m * 16) * D + a0; f32x2 r[2][2];
#pragma unroll
                for (int bj = 0; bj < 2; ++bj) { const f32x4 g = acc[ai][bj][m][0] * asc + bg[bj], l = acc[ai][bj][m][1] * ascl + bl[bj];
#pragma unroll
                    for (int h = 0; h < 2; ++h) { const f32x2 gg = (f32x2){fminf(g[2 * h], 7.0f), fminf(g[2 * h + 1], 7.0f)}; const f32x2 x = gg * kc;
                        const f32x2 e = (f32x2){__builtin_amdgcn_exp2f(x[0]), __builtin_amdgcn_exp2f(x[1])} + one;
                        const f32x2 sg = (f32x2){__builtin_amdgcn_rcpf(e[0]), __builtin_amdgcn_rcpf(e[1])};
                        const f32x2 lc = (f32x2){__builtin_amdgcn_fmed3f(l[2 * h], -6.0f * osc, 8.0f * osc), __builtin_amdgcn_fmed3f(l[2 * h + 1], -6.0f * osc, 8.0f * osc)};
                        r[bj][h] = (gg * sg) * lc; } }
                if constexpr (F8) { int w0 = __builtin_amdgcn_cvt_pk_fp8_f32(r[0][0][0], r[0][0][1], 0, false); w0 = __builtin_amdgcn_cvt_pk_fp8_f32(r[0][1][0], r[0][1][1], w0, true);
                    int w1 = __builtin_amdgcn_cvt_pk_fp8_f32(r[1][0][0], r[1][0][1], 0, false); w1 = __builtin_amdgcn_cvt_pk_fp8_f32(r[1][1][0], r[1][1][1], w1, true);
                    *(u32x2*)(O + ro) = (u32x2){(unsigned)w0, (unsigned)w1}; }
                else { *(u32x4*)((bf16*)O + ro) = (u32x4){cvt_pk_bf16(r[0][0][0], r[0][0][1]), cvt_pk_bf16(r[0][1][0], r[0][1][1]), cvt_pk_bf16(r[1][0][0], r[1][0][1]), cvt_pk_bf16(r[1][1][0], r[1][1][1])}; } }
    }
};
struct EpiDown8 { unsigned char* O; const float* bias; float asc;
    static constexpr int NST = 16;
    __device__ __forceinline__ const float* bias_ptr(const Unit& u) const { return bias + (size_t)u.e * 1024 + u.pn * 256; }
    __device__ __forceinline__ void operator()(const f32x4 (&acc)[2][2][4][2], const Unit& u, int wr, int wc, int fr, int fq, const LAS float* lb) const {
        const int row0 = u.pm * 256 + wr * 64 + fr, col0 = u.pn * 256 + wc * 64 + 16 * fq;
        f32x4 bv[2][2];
#pragma unroll
        for (int bj = 0; bj < 2; ++bj)
#pragma unroll
            for (int n = 0; n < 2; ++n) bv[bj][n] = *(const LAS f32x4*)(lb + wc * 64 + 16 * fq + bj * 8 + 4 * n) * F8_YSCALE;
        const float sc = asc * F8_YSCALE;
#pragma unroll
        for (int ai = 0; ai < 2; ++ai)
#pragma unroll
            for (int m = 0; m < 4; ++m) { unsigned char* rp = O + (size_t)(row0 + ai * 128 + m * 16) * D + col0; unsigned w[4];
#pragma unroll
                for (int bj = 0; bj < 2; ++bj) { const f32x4 v0 = acc[ai][bj][m][0] * sc + bv[bj][0], v1 = acc[ai][bj][m][1] * sc + bv[bj][1];
                    w[2 * bj] = (unsigned)pack4_fp8_sat(v0[0], v0[1], v0[2], v0[3]); w[2 * bj + 1] = (unsigned)pack4_fp8_sat(v1[0], v1[1], v1[2], v1[3]); }
                *(u32x4*)rp = (u32x4){w[0], w[1], w[2], w[3]}; }
    }
};
struct EpiDown { bf16* O; const float* bias; float asc;
    __device__ __forceinline__ const float* bias_ptr(const Unit& u) const { return bias + (size_t)u.e * 1024 + u.pn * 256; }
    __device__ __forceinline__ void operator()(const f32x4 (&acc)[2][2][4][2], const Unit& u, int wr, int wc, int fr, int fq, const LAS float* lb) const {
        const int row0 = u.pm * 256 + wr * 64 + fr, col0 = u.pn * 256 + wc * 32 + 4 * fq;
        f32x4 bv[2][2];
#pragma unroll
        for (int bj = 0; bj < 2; ++bj)
#pragma unroll
            for (int n = 0; n < 2; ++n) bv[bj][n] = *(const LAS f32x4*)(lb + wc * 32 + 4 * fq + bj * 128 + n * 16);
#pragma unroll
        for (int ai = 0; ai < 2; ++ai)
#pragma unroll
            for (int m = 0; m < 4; ++m) { bf16* rp = O + (size_t)(row0 + ai * 128 + m * 16) * D + col0;
#pragma unroll
                for (int bj = 0; bj < 2; ++bj)
#pragma unroll
                    for (int n = 0; n < 2; ++n) { const f32x4 v = acc[ai][bj][m][n] * asc + bv[bj][n]; u32x2 o; o.x = cvt_pk_bf16(v[0], v[1]); o.y = cvt_pk_bf16(v[2], v[3]); *(u32x2*)(rp + bj * 128 + n * 16) = o; } }
    }
};

constexpr int G8_BK = 64, G8_HALF = 128, G8_HTB = G8_HALF * G8_BK * 2, G8_STAGE_BYTES = 8 * G8_HTB;
__device__ __forceinline__ int g8_lds_byte(int r, int c) { const int st = (r >> 4) * 2 + (c >> 5), rr = r & 15, cc = c & 31, ob = rr * 64 + cc * 2; return st * 1024 + (ob ^ (((ob >> 9) & 1) << 5)); }
__device__ __forceinline__ void g8_stage_rc(int b, int& R, int& C) { const int st = b / 1024, sb = b % 1024, swz = sb ^ (((sb >> 9) & 1) << 5); R = (st >> 1) * 16 + swz / 64; C = (st & 1) * 32 + (swz % 64) / 2; }
__device__ __forceinline__ u32x4 g8_avoff(int pm, const int* gather, int tid, int KB) {
    int t2 = tid; asm volatile("" : "+v"(t2));
    int R, C; g8_stage_rc(t2 * 16, R, C);
    const int* gp = gather + pm * 256 + R;
    const unsigned r00 = gp[0], r01 = gp[64], r10 = gp[128], r11 = gp[192], c2 = (unsigned)(C * 2), k2 = (unsigned)KB;
    return (u32x4){r00 * k2 + c2, r01 * k2 + c2, r10 * k2 + c2, r11 * k2 + c2};
}
template <bool GATHER, bool FP8, class Epi>
__device__ __forceinline__ void gemm_fast(const void* A, const int* gather, const int K, const Sched& S, const Epi& E, LAS unsigned char* lds, int tid) {
    const int wid = __builtin_amdgcn_readfirstlane(tid >> 6), lane = tid & 63, wr = wid >> 2, wc = wid & 3, fr = lane & 15, fq = lane >> 4;
    const int KB = FP8 ? K : 2 * K, nt = KB / 128;
    unsigned voff; { int R, C; g8_stage_rc(tid * 16, R, C); voff = (unsigned)(R * KB + C * 2); }
    const size_t kstep = (size_t)128, hstep = (size_t)G8_HALF * KB, qstep = (size_t)64 * KB, tstep = 2 * hstep;
    const unsigned ldsw = (unsigned)wid * 1024u;
    const int aoff = g8_lds_byte(wr * 64 + fr, fq * 8), boff = g8_lds_byte(wc * 32 + fr, fq * 8);
    constexpr int KSTR = 1024;
#define G8_SA(b, h) (((b) * 2 + (h)) * G8_HTB)
#define G8_SB(b, h) ((4 + (b) * 2 + (h)) * G8_HTB)
#define G8_GLDS(gp, ldsoff) __builtin_amdgcn_global_load_lds((const unsigned*)(gp), (LAS unsigned*)(lds + (ldsoff)), 16, 0, 0)
#define G8_STAGE_D(bufoff, gbase) do { G8_GLDS((const char*)(gbase) + voff, (bufoff) + ldsw); G8_GLDS((const char*)(gbase) + qstep + voff, (bufoff) + ldsw + 8192); } while (0)
#define G8_STAGE_A(bufoff, kb, h) do { if constexpr (GATHER) { G8_GLDS((kb) + va[(h) * 2], (bufoff) + ldsw); G8_GLDS((kb) + va[(h) * 2 + 1], (bufoff) + ldsw + 8192); } \
        else { G8_STAGE_D(bufoff, (kb) + (h) * hstep); } } while (0)
#define G8_LDA(dst, b, h) do { _Pragma("unroll") for (int m = 0; m < 4; ++m) _Pragma("unroll") for (int k = 0; k < 2; ++k) dst[m][k] = *(const LAS bf16x8*)(lds + G8_SA(b, h) + aoff + m * 2048 + k * KSTR); } while (0)
#define G8_LDB(dst, b, h) do { _Pragma("unroll") for (int n = 0; n < 2; ++n) _Pragma("unroll") for (int k = 0; k < 2; ++k) dst[n][k] = *(const LAS bf16x8*)(lds + G8_SB(b, h) + boff + n * 2048 + k * KSTR); } while (0)
#define G8_CAT(x) __builtin_shufflevector(__builtin_bit_cast(i32x4, (x)[0]), __builtin_bit_cast(i32x4, (x)[1]), 0, 1, 2, 3, 4, 5, 6, 7)
#define G8_MMA(ai, bj, At, Bt) do { __builtin_amdgcn_s_setprio(1); _Pragma("unroll") for (int m = 0; m < 4; ++m) _Pragma("unroll") for (int n = 0; n < 2; ++n) { \
        if constexpr (FP8) acc[ai][bj][m][n] = __builtin_amdgcn_mfma_scale_f32_16x16x128_f8f6f4(G8_CAT(Bt[n]), G8_CAT(At[m]), acc[ai][bj][m][n], 0, 0, 0, 0x7f7f7f7f, 0, 0x7f7f7f7f); \
        else { _Pragma("unroll") for (int k = 0; k < 2; ++k) acc[ai][bj][m][n] = __builtin_amdgcn_mfma_f32_16x16x32_bf16(Bt[n][k], At[m][k], acc[ai][bj][m][n], 0, 0, 0); } } \
        __builtin_amdgcn_s_setprio(0); } while (0)
#define G8_WAIT_V(n) asm volatile("s_waitcnt vmcnt(" #n ")" ::: "memory")
#define G8_WAIT_L(n) asm volatile("s_waitcnt lgkmcnt(" #n ")" ::: "memory")
#define G8_BAR __builtin_amdgcn_s_barrier()
#define G8_SCHED __builtin_amdgcn_sched_barrier(0)
    Unit cur, nxt; int ui = 0;
    if (!S.next(0, cur)) return;
    f32x4 acc[2][2][4][2];
#pragma unroll
    for (int a = 0; a < 2; ++a)
#pragma unroll
        for (int b = 0; b < 2; ++b)
#pragma unroll
            for (int m = 0; m < 4; ++m)
#pragma unroll
                for (int n = 0; n < 2; ++n) acc[a][b][m][n] = (f32x4){0.f, 0.f, 0.f, 0.f};
    bf16x8 At[4][2], B0[2][2], B1[2][2];
    u32x4 va = (u32x4){0u, 0u, 0u, 0u};
    if constexpr (GATHER) va = g8_avoff(cur.pm, gather, tid, KB);
    constexpr int G8_IDX = G8_STAGE_BYTES, G8_BIAS = G8_STAGE_BYTES + 1024;
    { const float* bp0 = E.bias_ptr(cur); if (bp0 && wid == 0) G8_GLDS((const char*)bp0 + lane * 16, G8_BIAS); }
    const char* cB = (const char*)cur.bt; const char* cA = (const char*)A + (GATHER ? (size_t)0 : (size_t)cur.pm * tstep);
    G8_STAGE_D(G8_SB(0, 0), cB); G8_STAGE_D(G8_SB(0, 1), cB + hstep); G8_STAGE_A(G8_SA(0, 0), cA, 0); G8_STAGE_A(G8_SA(0, 1), cA, 1);
    if (wr == 1) G8_BAR;
    G8_WAIT_V(2); G8_BAR;
    G8_STAGE_D(G8_SB(1, 0), cB + kstep); G8_STAGE_A(G8_SA(1, 0), cA + kstep, 0); G8_STAGE_D(G8_SB(1, 1), cB + hstep + kstep);
    G8_WAIT_V(6); G8_BAR;
    for (;;) {
        const bool has_next = S.next(ui + 1, nxt);
        if constexpr (GATHER) { if (has_next && wid == 1) G8_GLDS((const char*)(gather + nxt.pm * 256) + lane * 16, G8_IDX); }
        const char* nB = has_next ? (const char*)nxt.bt : cB;
        const char* nA = (GATHER || !has_next) ? cA : (const char*)A + (size_t)nxt.pm * tstep;
#pragma unroll 1
        for (int t = 0; t < nt; t += 2) {
            const bool last = (t == nt - 2);
            const char* a1 = cA + (size_t)(t + 1) * kstep;
            const char* a2 = last ? nA : cA + (size_t)(t + 2) * kstep; const char* b2 = last ? nB : cB + (size_t)(t + 2) * kstep;
            const char* a3 = a2 + kstep; const char* b3 = b2 + kstep;
            G8_LDB(B0, 0, 0); G8_LDB(B1, 0, 1); G8_SCHED; G8_LDA(At, 0, 0); G8_STAGE_A(G8_SA(1, 1), a1, 1);
            if (last && has_next && wid == 0) { const float* bpn = E.bias_ptr(nxt); if (bpn) G8_GLDS((const char*)bpn + lane * 16, G8_BIAS + ((ui + 1) & 1) * 1024); }
            if constexpr (GATHER) { if (last && has_next) {
                int t2 = tid; asm volatile("" : "+v"(t2)); int R, C; g8_stage_rc(t2 * 16, R, C); const LAS int* ip = (const LAS int*)(lds + G8_IDX) + R; const unsigned c2 = (unsigned)(C * 2), k2 = (unsigned)KB;
                va = (u32x4){(unsigned)ip[0] * k2 + c2, (unsigned)ip[64] * k2 + c2, (unsigned)ip[128] * k2 + c2, (unsigned)ip[192] * k2 + c2}; } }
            G8_WAIT_V(8); G8_WAIT_L(0); G8_BAR; G8_MMA(0, 0, At, B0); G8_MMA(0, 1, At, B1); G8_BAR; G8_SCHED;
            G8_LDA(At, 0, 1); G8_STAGE_D(G8_SB(0, 0), b2); G8_STAGE_D(G8_SB(0, 1), b2 + hstep); G8_STAGE_A(G8_SA(0, 0), a2, 0);
            G8_WAIT_V(8); G8_WAIT_L(0); G8_BAR; G8_MMA(1, 0, At, B0); G8_MMA(1, 1, At, B1); G8_BAR; G8_SCHED;
            G8_LDB(B0, 1, 0); G8_LDB(B1, 1, 1); G8_SCHED; G8_LDA(At, 1, 0); G8_STAGE_A(G8_SA(0, 1), a2, 1);
            G8_WAIT_V(8); G8_WAIT_L(0); G8_BAR; G8_MMA(0, 0, At, B0); G8_MMA(0, 1, At, B1); G8_BAR; G8_SCHED;
            G8_LDA(At, 1, 1); G8_STAGE_D(G8_SB(1, 0), b3); G8_STAGE_D(G8_SB(1, 1), b3 + hstep); G8_STAGE_A(G8_SA(1, 0), a3, 0);
            G8_WAIT_V(8); G8_WAIT_L(0); G8_BAR; G8_MMA(1, 0, At, B0); G8_MMA(1, 1, At, B1); G8_BAR; G8_SCHED;
        }
        if (wr == 0) G8_BAR;
        { int t3 = tid; asm volatile("" : "+v"(t3)); const int l3 = t3 & 63; E(acc, cur, wr, wc, l3 & 15, l3 >> 4, (const LAS float*)(lds + G8_BIAS + (ui & 1) * 1024)); }
#ifdef EPI2
        if constexpr (FP8 && GATHER) { asm volatile("" ::: "memory");
#pragma unroll
            for (int a_ = 0; a_ < 2; ++a_)
#pragma unroll
                for (int b_ = 0; b_ < 2; ++b_)
#pragma unroll
                    for (int m_ = 0; m_ < 4; ++m_)
#pragma unroll
                        for (int n_ = 0; n_ < 2; ++n_) asm volatile("" : "+v"(acc[a_][b_][m_][n_]));
            int t4 = tid; asm volatile("" : "+v"(t4)); const int l4 = t4 & 63; E(acc, cur, wr, wc, l4 & 15, l4 >> 4, (const LAS float*)(lds + G8_BIAS + (ui & 1) * 1024)); }
#endif
        if (!has_next) break;
#pragma unroll
        for (int a = 0; a < 2; ++a)
#pragma unroll
            for (int b = 0; b < 2; ++b)
#pragma unroll
                for (int m = 0; m < 4; ++m)
#pragma unroll
                    for (int n = 0; n < 2; ++n) acc[a][b][m][n] = (f32x4){0.f, 0.f, 0.f, 0.f};
        cur = nxt; cB = nB; cA = nA; ++ui;
        if (wr == 1) G8_BAR;
    }
    G8_WAIT_V(0);
    G8_BAR;
#undef G8_SA
#undef G8_SB
#undef G8_GLDS
#undef G8_STAGE_D
#undef G8_STAGE_A
#undef G8_LDA
#undef G8_LDB
#undef G8_MMA
#undef G8_CAT
#undef G8_WAIT_V
#undef G8_WAIT_L
#undef G8_BAR
#undef G8_SCHED
}

__device__ __forceinline__ float logsigmoid_f(float x) { return fminf(x, 0.f) - log1pf(__expf(-fabsf(x))); }
__device__ __forceinline__ void phase_gla_prep(KA a, int li, LAS unsigned char* lds, int tid, int bx, int G) {
    const int lane = tid & 63, wave = __builtin_amdgcn_readfirstlane(tid >> 6), fr = lane & 15, fq = lane >> 4;
    unsigned char* ws = a->ws;
    const bf16* qkvr = (const bf16*)(ws + WS_BIG); const float* lr = (const float*)(ws + WS_LR);
    bf16* QE = (bf16*)(ws + WS_QE); bf16* KET = (bf16*)(ws + WS_KET); bf16* PP = (bf16*)(ws + WS_P); float* EL = (float*)(ws + WS_EL);
    constexpr int LS = 144;
    LAS bf16* qes = (LAS bf16*)lds;
    LAS bf16* kes = qes + 64 * LS;
    LAS float* lrs = (LAS float*)(kes + 64 * LS);
    LAS float* segtot = lrs + 1024;
    const int d = tid & 127, seg = tid >> 7;
    const int so = tid & 15, sr = tid >> 4;
    u32x4 pq[2], pk[2]; float plr[2], pw[16], pbg;
#define PF_LOAD(it_) do { const int it__ = (it_); const int chunk_ = it__ & 63, dir_ = (it__ >> 6) & 1, h_ = (it__ >> 7) & 3, b_ = it__ >> 9; const int row0_ = b_ * SEQ + chunk_ * 64; \
        _Pragma("unroll") for (int k2 = 0; k2 < 2; ++k2) { const bf16* src = qkvr + (size_t)(row0_ + sr + 32 * k2) * GLA_MAIN + h_ * 128 + 8 * so; pq[k2] = *(const u32x4*)src; pk[k2] = *(const u32x4*)(src + 512); } \
        _Pragma("unroll") for (int k2 = 0; k2 < 2; ++k2) { const int i = tid + 512 * k2; plr[k2] = lr[(size_t)(row0_ + (i >> 4)) * 32 + dir_ * 16 + (i & 15)]; } \
        { const float* wg2_ = a->in[dir_ ? I_GWG2B : I_GWG2F] + (size_t)li * 16 * 512 + h_ * 128 + d; _Pragma("unroll") for (int r = 0; r < 16; ++r) pw[r] = wg2_[r * 512]; pbg = a->in[dir_ ? I_GBGB : I_GBGF][(size_t)li * 512 + h_ * 128 + d]; } } while (0)
    if (bx < 4096) PF_LOAD(bx);
    for (int it = bx; it < 4096; it += G) {
        const int chunk = it & 63, dir = (it >> 6) & 1, h = (it >> 7) & 3, b = it >> 9;
        const int row0 = b * SEQ + chunk * 64;
        const size_t cidx = (size_t)(((dir * 8 + b) * 4 + h) * 64 + chunk);
#pragma unroll
        for (int k2 = 0; k2 < 2; ++k2) { const int p = sr + 32 * k2; *(LAS u32x4*)(qes + p * LS + 8 * so) = pq[k2]; *(LAS u32x4*)(kes + p * LS + 8 * so) = pk[k2]; }
#pragma unroll
        for (int k2 = 0; k2 < 2; ++k2) lrs[tid + 512 * k2] = plr[k2];
        float wcol[16];
#pragma unroll
        for (int r = 0; r < 16; ++r) wcol[r] = pw[r];
        const float bgd = pbg;
        __syncthreads();
        if (it + G < 4096) PF_LOAD(it + G);
        float g[16];
        f32x2 w2[8];
#pragma unroll
        for (int r = 0; r < 8; ++r) w2[r] = (f32x2){wcol[2 * r], wcol[2 * r + 1]};
#pragma unroll
        for (int s2 = 0; s2 < 16; ++s2) { const LAS float* lp = lrs + (seg * 16 + s2) * 16; f32x2 ax = (f32x2){bgd, 0.f};
#pragma unroll
            for (int r4 = 0; r4 < 4; ++r4) { const f32x4 l4 = *(const LAS f32x4*)(lp + 4 * r4); ax = __builtin_elementwise_fma(l4.xy, w2[2 * r4], ax); ax = __builtin_elementwise_fma(l4.zw, w2[2 * r4 + 1], ax); }
            float x = ax[0] + ax[1];
            g[s2] = (fminf(x, 0.f) - 0.6931471805599453f * __builtin_amdgcn_logf(1.0f + __builtin_amdgcn_exp2f(-1.4426950408889634f * fabsf(x)))) * (1.0f / 16.0f); }
        if (dir == 0) {
#pragma unroll
            for (int s2 = 1; s2 < 16; ++s2) g[s2] += g[s2 - 1];
        } else {
#pragma unroll
            for (int s2 = 14; s2 >= 0; --s2) g[s2] += g[s2 + 1];
        }
        segtot[seg * 128 + d] = dir ? g[0] : g[15];
        __syncthreads();
        float pre = 0.f, total = 0.f;
#pragma unroll
        for (int sg = 0; sg < 4; ++sg) { const float t = segtot[sg * 128 + d]; total += t; if (dir ? (sg > seg) : (sg < seg)) pre += t; }
        if (seg == 0) EL[cidx * 128 + d] = __expf(total);
        unsigned kt[8];
#pragma unroll
        for (int s2 = 0; s2 < 16; s2 += 2) {
            unsigned kw[2];
#pragma unroll
            for (int u = 0; u < 2; ++u) { const int p = seg * 16 + s2 + u;
                const float q = bf2f(qes[p * LS + d]), k = bf2f(kes[p * LS + d]); const float bb = g[s2 + u] + pre;
                const float eb_ = __expf(bb); const unsigned qw = cvt_pk_bf16(q * eb_, 0.f) & 0xffffu; kw[u] = cvt_pk_bf16(k * __builtin_amdgcn_rcpf(eb_), 0.f) & 0xffffu;
                qes[p * LS + d] = (bf16)qw; kes[p * LS + d] = (bf16)kw[u]; }
            kt[s2 >> 1] = kw[0] | (kw[1] << 16);
        }
        { bf16* kp = KET + cidx * 8192 + (size_t)d * 64 + seg * 16; *(u32x4*)kp = (u32x4){kt[0], kt[1], kt[2], kt[3]}; *(u32x4*)(kp + 8) = (u32x4){kt[4], kt[5], kt[6], kt[7]}; }
        __syncthreads();
#pragma unroll
        for (int k2 = 0; k2 < 2; ++k2) { const int p = sr + 32 * k2; *(u32x4*)(QE + ((size_t)dir * T + row0 + p) * 512 + h * 128 + 8 * so) = *(const LAS u32x4*)(qes + p * LS + 8 * so); }
        { const int jt = wave & 3;
#pragma unroll
          for (int ii = 0; ii < 2; ++ii) { const int itile = 2 * (wave >> 2) + ii;
            f32x4 acc = (f32x4){0.f, 0.f, 0.f, 0.f};
            const bool dead = dir ? (jt < itile) : (jt > itile);
            if (!dead) {
#pragma unroll
                for (int ks = 0; ks < 4; ++ks) { const bf16x8 kf = *(const LAS bf16x8*)(kes + (jt * 16 + fr) * LS + ks * 32 + 8 * fq), qf = *(const LAS bf16x8*)(qes + (itile * 16 + fr) * LS + ks * 32 + 8 * fq);
                    acc = __builtin_amdgcn_mfma_f32_16x16x32_bf16(kf, qf, acc, 0, 0, 0); }
            }
            const int i = itile * 16 + fr, j0 = jt * 16 + 4 * fq; float pv[4];
#pragma unroll
            for (int jj = 0; jj < 4; ++jj) { const int j = j0 + jj; const bool keep = dir ? (j >= i) : (j <= i); pv[jj] = keep ? acc[jj] : 0.f; }
            u32x2 o; o.x = cvt_pk_bf16(pv[0], pv[1]); o.y = cvt_pk_bf16(pv[2], pv[3]);
            *(u32x2*)(PP + cidx * 4096 + (size_t)i * 64 + j0) = o; } }
        __syncthreads();
    }
}
#undef PF_LOAD
__device__ __forceinline__ void phase_gla_scan(KA a, LAS unsigned char* lds, int tid, int bx, int G) {
    const int lane = tid & 63, wave = __builtin_amdgcn_readfirstlane(tid >> 6), fr = lane & 15, fq = lane >> 4;
    unsigned char* ws = a->ws;
    const char* QE = (const char*)(ws + WS_QE); const char* KET = (const char*)(ws + WS_KET); const char* PP = (const char*)(ws + WS_P); const char* VV = (const char*)(ws + WS_BIG); const float* EL = (const float*)(ws + WS_EL);
    constexpr int SS = 144, ST_BYTES = 2 * 64 * SS * 2, BUFB = 41984, OQ = 0, OP = 16384, OK_ = 24576, OE = 40960, VBASE = ST_BYTES + 2 * BUFB;
    LAS bf16* ST = (LAS bf16*)lds;
    LAS unsigned char* BUF = lds + ST_BYTES;
    const int et0 = 2 * (wave & 1), dt0 = 2 * (wave >> 1), itile = wave >> 1;
    const int rq = lane >> 4, pq = lane & 15, r8 = lane >> 3, p8 = lane & 7;
    unsigned sq[2], sk[2], sp, sv;
#pragma unroll
    for (int j = 0; j < 2; ++j) { const int r = 4 * (wave + 8 * j) + rq; sq[j] = (unsigned)(r * 1024 + ((pq ^ (r & 15)) * 16)); const int dk = 8 * (wave + 8 * j) + r8; sk[j] = (unsigned)(dk * 128 + ((p8 ^ ((dk >> 1) & 7)) * 16)); }
    { const int r = 8 * wave + r8; sp = (unsigned)(r * 128 + ((p8 ^ ((r >> 1) & 7)) * 16)); sv = (unsigned)(r * (GLA_MAIN * 2) + ((p8 ^ ((r >> 1) & 7)) * 16)); }
    typedef short s16x4 __attribute__((ext_vector_type(4)));
    int vo[2][2][2];
#pragma unroll
    for (int et = 0; et < 2; ++et)
#pragma unroll
        for (int ks = 0; ks < 2; ++ks)
#pragma unroll
            for (int hh = 0; hh < 2; ++hh) { const int row = 32 * ks + 8 * fq + (fr >> 2) + 4 * hh, ch = 2 * (et0 + et) + ((fr & 3) >> 1); vo[et][ks][hh] = row * 128 + ((ch ^ ((row >> 1) & 7)) * 16) + (fr & 1) * 8; }
    const int kx = fr >> 1;
    for (int it0 = bx; it0 < 256; it0 += G) {
        const int it = (G == 256) ? ((it0 & 7) * 32 + (it0 >> 3)) : it0;
        const int b = it >> 5, h = (it >> 3) & 3, dir = (it >> 2) & 1, es = it & 3;
        bf16* OO = (bf16*)(ws + (dir ? WS_OB : WS_OF));
        __syncthreads();
        for (int i = tid; i < 64 * SS / 2; i += NTHREADS) ((LAS unsigned*)ST)[i] = 0u;
        f32x4 accS[2][2];
#pragma unroll
        for (int x = 0; x < 2; ++x)
#pragma unroll
            for (int y = 0; y < 2; ++y) accS[x][y] = (f32x4){0.f, 0.f, 0.f, 0.f};
        const size_t cbase = (size_t)((dir * 8 + b) * 4 + h) * 64;
        const char* qsrc = QE + (((size_t)dir * T + (size_t)b * SEQ) * 512 + h * 128) * 2;
        const char* psrc = PP + cbase * 8192;
        const char* ksrc = KET + cbase * 16384;
        const char* vsrc = VV + (((size_t)b * SEQ) * GLA_MAIN + 1024 + h * 256 + es * 64) * 2;
        const char* esrc = (const char*)(EL + cbase * 128);
        char* ob = (char*)(OO + ((size_t)b * SEQ + itile * 16) * D + h * 256 + es * 64 + et0 * 16);
        const unsigned le = (unsigned)fq * 16u, lo = (unsigned)(fr * D + 4 * fq) * 2u;
#define SC_DMA(c_, bi_) do { const size_t c__ = (size_t)(c_); LAS unsigned char* bb_ = BUF + (bi_) * BUFB + wave * 1024; \
            __builtin_amdgcn_global_load_lds((const unsigned*)(qsrc + c__ * 65536 + sq[0]), (LAS unsigned*)(bb_ + OQ), 16, 0, 0); \
            __builtin_amdgcn_global_load_lds((const unsigned*)(qsrc + c__ * 65536 + sq[1]), (LAS unsigned*)(bb_ + OQ + 8192), 16, 0, 0); \
            __builtin_amdgcn_global_load_lds((const unsigned*)(psrc + c__ * 8192 + sp), (LAS unsigned*)(bb_ + OP), 16, 0, 0); \
            __builtin_amdgcn_global_load_lds((const unsigned*)(ksrc + c__ * 16384 + sk[0]), (LAS unsigned*)(bb_ + OK_), 16, 0, 0); \
            __builtin_amdgcn_global_load_lds((const unsigned*)(ksrc + c__ * 16384 + sk[1]), (LAS unsigned*)(bb_ + OK_ + 8192), 16, 0, 0); \
            if (wave == 0) __builtin_amdgcn_global_load_lds((const unsigned*)(esrc + c__ * 512 + lane * 16), (LAS unsigned*)(BUF + (bi_) * BUFB + OE), 16, 0, 0); } while (0)
#define SC_DMAV(c_, slot_) __builtin_amdgcn_global_load_lds((const unsigned*)(vsrc + (size_t)(c_) * (64 * GLA_MAIN * 2) + sv), (LAS unsigned*)(lds + VBASE + (slot_) * 8192 + wave * 1024), 16, 0, 0)
        SC_DMA(dir ? 63 : 0, 0); SC_DMAV(dir ? 63 : 0, 0); SC_DMAV(dir ? 62 : 1, 1);
        asm volatile("s_waitcnt vmcnt(0)" ::: "memory");
        __syncthreads();
        int vslot = 0;
#pragma unroll 1
        for (int cc = 0; cc < 64; ++cc) {
            const int c = dir ? 63 - cc : cc;
            { const int c1 = cc + 1 < 64 ? cc + 1 : 63, c2 = cc + 2 < 64 ? cc + 2 : 63;
              SC_DMA(dir ? 63 - c1 : c1, (cc + 1) & 1);
              const int s2 = vslot >= 1 ? vslot - 1 : 2;
              SC_DMAV(dir ? 63 - c2 : c2, s2); }
            const LAS unsigned char* Bv = lds + VBASE + vslot * 8192;
            const LAS unsigned char* B = BUF + (cc & 1) * BUFB;
            const f32x4 el0 = *(const LAS f32x4*)(B + OE + dt0 * 64 + le), el1 = *(const LAS f32x4*)(B + OE + dt0 * 64 + 64 + le);
            const LAS bf16* Sr = ST + (cc & 1) * 64 * SS; LAS bf16* Sw = ST + ((cc + 1) & 1) * 64 * SS;
            bf16x8 qf[4], pf[2], vf[2][2];
#pragma unroll
            for (int ks = 0; ks < 4; ++ks) qf[ks] = *(const LAS bf16x8*)(B + OQ + (itile * 16 + fr) * 256 + (((4 * ks + fq) ^ fr) * 16));
#pragma unroll
            for (int ks = 0; ks < 2; ++ks) pf[ks] = *(const LAS bf16x8*)(B + OP + (itile * 16 + fr) * 128 + (((4 * ks + fq) ^ kx) * 16));
            {
                const unsigned vb_ = (unsigned)(size_t)Bv; s16x4 t[2][2][2];
                asm volatile("ds_read_b64_tr_b16 %0, %8\n\tds_read_b64_tr_b16 %1, %9\n\tds_read_b64_tr_b16 %2, %10\n\tds_read_b64_tr_b16 %3, %11\n\t"
                             "ds_read_b64_tr_b16 %4, %12\n\tds_read_b64_tr_b16 %5, %13\n\tds_read_b64_tr_b16 %6, %14\n\tds_read_b64_tr_b16 %7, %15\n\ts_waitcnt lgkmcnt(0)"
                             : "=&v"(t[0][0][0]), "=&v"(t[0][0][1]), "=&v"(t[0][1][0]), "=&v"(t[0][1][1]), "=&v"(t[1][0][0]), "=&v"(t[1][0][1]), "=&v"(t[1][1][0]), "=&v"(t[1][1][1])
                             : "v"(vb_ + vo[0][0][0]), "v"(vb_ + vo[0][0][1]), "v"(vb_ + vo[0][1][0]), "v"(vb_ + vo[0][1][1]), "v"(vb_ + vo[1][0][0]), "v"(vb_ + vo[1][0][1]), "v"(vb_ + vo[1][1][0]), "v"(vb_ + vo[1][1][1]) : "memory");
#pragma unroll
                for (int et = 0; et < 2; ++et)
#pragma unroll
                    for (int ks = 0; ks < 2; ++ks) vf[et][ks] = __builtin_shufflevector(t[et][ks][0], t[et][ks][1], 0, 1, 2, 3, 4, 5, 6, 7);
            }
#pragma unroll
            for (int et = 0; et < 2; ++et) { f32x4 ao = (f32x4){0.f, 0.f, 0.f, 0.f};
#pragma unroll
                for (int ks = 0; ks < 4; ++ks) { const bf16x8 sf = *(const LAS bf16x8*)(Sr + ((et0 + et) * 16 + fr) * SS + ks * 32 + 8 * fq); ao = __builtin_amdgcn_mfma_f32_16x16x32_bf16(sf, qf[ks], ao, 0, 0, 0); }
#pragma unroll
                for (int ks = 0; ks < 2; ++ks) ao = __builtin_amdgcn_mfma_f32_16x16x32_bf16(vf[et][ks], pf[ks], ao, 0, 0, 0);
                u32x2 o; o.x = cvt_pk_bf16(ao[0], ao[1]); o.y = cvt_pk_bf16(ao[2], ao[3]);
                *(u32x2*)(ob + (size_t)c * (64 * D * 2) + et * 32 + lo) = o; }
#pragma unroll
            for (int dt = 0; dt < 2; ++dt) { bf16x8 kf[2];
#pragma unroll
                for (int ks = 0; ks < 2; ++ks) kf[ks] = *(const LAS bf16x8*)(B + OK_ + ((dt0 + dt) * 16 + fr) * 128 + (((4 * ks + fq) ^ kx) * 16));
#pragma unroll
                for (int et = 0; et < 2; ++et) {
#pragma unroll
                    for (int ks = 0; ks < 2; ++ks) accS[dt][et] = __builtin_amdgcn_mfma_f32_16x16x32_bf16(kf[ks], vf[et][ks], accS[dt][et], 0, 0, 0);
                    accS[dt][et] = accS[dt][et] * (dt ? el1 : el0);
                    u32x2 o; o.x = cvt_pk_bf16(accS[dt][et][0], accS[dt][et][1]); o.y = cvt_pk_bf16(accS[dt][et][2], accS[dt][et][3]);
                    *(LAS u32x2*)(Sw + ((et0 + et) * 16 + fr) * SS + (dt0 + dt) * 16 + 4 * fq) = o; } }
            asm volatile("s_waitcnt vmcnt(3) lgkmcnt(0)" ::: "memory");
            __builtin_amdgcn_s_barrier();
            asm volatile("" ::: "memory");
            vslot = vslot == 2 ? 0 : vslot + 1;
        }
#undef SC_DMA
#undef SC_DMAV
    }
}

__device__ __forceinline__ void phase_gla_post(KA a, int li, int tid, int bx, int G) {
    const int lane = tid & 63, wave = tid >> 6;
    const bf16* of = (const bf16*)(a->ws + WS_OF); const bf16* ob = (const bf16*)(a->ws + WS_OB); const bf16* qkvr = (const bf16*)(a->ws + WS_BIG); bf16* A2 = (bf16*)(a->ws + WS_A2);
    const float* ng = a->in[I_GNORM] + (size_t)li * 256 + (lane & 15) * 16;
    float g[16];
#pragma unroll
    for (int j = 0; j < 16; ++j) g[j] = ng[j];
    for (int token = bx * NWAVES + wave; token < T; token += G * NWAVES) {
        const u32x4 f0 = *(const u32x4*)(of + (size_t)token * D + 16 * lane), f1 = *(const u32x4*)(of + (size_t)token * D + 16 * lane + 8);
        const u32x4 b0 = *(const u32x4*)(ob + (size_t)token * D + 16 * lane), b1 = *(const u32x4*)(ob + (size_t)token * D + 16 * lane + 8);
        const u32x4 r0 = *(const u32x4*)(qkvr + (size_t)token * GLA_MAIN + 2048 + 16 * lane), r1 = *(const u32x4*)(qkvr + (size_t)token * GLA_MAIN + 2048 + 16 * lane + 8);
        float o[16], r[16];
#pragma unroll
        for (int q = 0; q < 4; ++q) { o[2 * q] = bf_lo(f0[q]) + bf_lo(b0[q]); o[2 * q + 1] = bf_hi(f0[q]) + bf_hi(b0[q]); o[8 + 2 * q] = bf_lo(f1[q]) + bf_lo(b1[q]); o[8 + 2 * q + 1] = bf_hi(f1[q]) + bf_hi(b1[q]);
            r[2 * q] = bf_lo(r0[q]); r[2 * q + 1] = bf_hi(r0[q]); r[8 + 2 * q] = bf_lo(r1[q]); r[8 + 2 * q + 1] = bf_hi(r1[q]); }
        float ss = 0.f;
#pragma unroll
        for (int j = 0; j < 16; ++j) ss += o[j] * o[j];
        ss = row16_sum(ss);
        const float rstd = __builtin_amdgcn_rsqf(ss * (1.0f / 256.0f) + LN_EPS);
#if OUT_FP8
        unsigned w[4]; const float rs8 = rstd * F8_A2SCALE;
#pragma unroll
        for (int q = 0; q < 4; ++q) w[q] = (unsigned)pack4_fp8_sat(o[4 * q] * rs8 * g[4 * q] * silu_f(r[4 * q]), o[4 * q + 1] * rs8 * g[4 * q + 1] * silu_f(r[4 * q + 1]), o[4 * q + 2] * rs8 * g[4 * q + 2] * silu_f(r[4 * q + 2]), o[4 * q + 3] * rs8 * g[4 * q + 3] * silu_f(r[4 * q + 3]));
        *(u32x4*)((unsigned char*)A2 + (size_t)token * D + 16 * lane) = (u32x4){w[0], w[1], w[2], w[3]};
#else
        unsigned w[8];
#pragma unroll
        for (int q = 0; q < 8; ++q) w[q] = cvt_pk_bf16(o[2 * q] * rstd * g[2 * q] * silu_f(r[2 * q]), o[2 * q + 1] * rstd * g[2 * q + 1] * silu_f(r[2 * q + 1]));
        *(u32x4*)(A2 + (size_t)token * D + 16 * lane) = (u32x4){w[0], w[1], w[2], w[3]}; *(u32x4*)(A2 + (size_t)token * D + 16 * lane + 8) = (u32x4){w[4], w[5], w[6], w[7]};
#endif
    }
}

__device__ __forceinline__ void phase_sgu_core(KA a, int li, LAS unsigned char* lds, int tid, int bx, int G) {
    const int lane = tid & 63, wave = __builtin_amdgcn_readfirstlane(tid >> 6), fr = lane & 15, fq = lane >> 4;
    unsigned char* ws = a->ws;
    const bf16* z = (const bf16*)(ws + WS_BIG); bf16* A2 = (bf16*)(ws + WS_A2);
    const float* lng = a->in[I_SLNG] + (size_t)li * 1024; const float* lnb = a->in[I_SLNB] + (size_t)li * 1024;
    const bf16* wsp = (const bf16*)(ws + WS_SGUWS) + (size_t)li * 8 * 128 * 128; const float* bs = a->in[I_SBS] + (size_t)li * 8 * 128;
    constexpr int VS = 144;
    LAS bf16* vn = (LAS bf16*)lds;
    LAS float* st_mean = (LAS float*)(lds + 2 * 128 * VS * 2); LAS float* st_rstd = st_mean + 128;
    const int co = tid & 15, qr = tid >> 4;
    const int p = wave * 16 + fr;
    typedef short s16x4 __attribute__((ext_vector_type(4)));
    for (int it = bx; it < T / 128; it += G) {
        const int row0 = it * 128;
        __syncthreads();
        u32x4 raw[8][4]; f32x4 lp[8][4]; u32x2 wq[8][4][2]; u32x2 un[8][8]; float bsv[8];
#define SGU_LOADG(gg) do { constexpr int g_ = (gg); \
            _Pragma("unroll") for (int k = 0; k < 4; ++k) raw[g_][k] = *(const u32x4*)(z + (size_t)(row0 + qr + 32 * k) * 2048 + 1024 + g_ * 128 + 8 * co); \
            lp[g_][0] = *(const f32x4*)(lng + g_ * 128 + 8 * co); lp[g_][1] = *(const f32x4*)(lng + g_ * 128 + 8 * co + 4); lp[g_][2] = *(const f32x4*)(lnb + g_ * 128 + 8 * co); lp[g_][3] = *(const f32x4*)(lnb + g_ * 128 + 8 * co + 4); \
            _Pragma("unroll") for (int ks = 0; ks < 4; ++ks) { const bf16* wp = wsp + ((size_t)g_ * 128 + p) * 128 + ks * 32 + 4 * fq; wq[g_][ks][0] = *(const u32x2*)wp; wq[g_][ks][1] = *(const u32x2*)(wp + 16); } \
            bsv[g_] = bs[g_ * 128 + p]; } while (0)
#define SGU_LOADU(gg) do { constexpr int g_ = (gg); \
            _Pragma("unroll") for (int ct = 0; ct < 8; ++ct) un[g_][ct] = *(const u32x2*)(z + (size_t)(row0 + p) * 2048 + g_ * 128 + ct * 16 + 4 * fq); } while (0)
        SGU_LOADU(0); SGU_LOADU(1); SGU_LOADU(2); SGU_LOADG(0);
#pragma unroll 1
        for (int hb = 0; hb < 2; ++hb) {
            u32x4 d[8][2];
#pragma unroll
            for (int rr = 0; rr < 8; ++rr) { const bf16* vp = z + (size_t)(row0 + wave * 16 + hb * 8 + rr) * 2048 + 1024 + 16 * lane; d[rr][0] = *(const u32x4*)vp; d[rr][1] = *(const u32x4*)(vp + 8); }
#pragma unroll
            for (int rr = 0; rr < 8; ++rr) asm volatile("" : "+v"(d[rr][0]), "+v"(d[rr][1]));
            float s1[8], s2[8];
#pragma unroll
            for (int rr = 0; rr < 8; ++rr) { float t1 = 0.f, t2 = 0.f;
#pragma unroll
                for (int h = 0; h < 2; ++h)
#pragma unroll
                    for (int k = 0; k < 4; ++k) { const float x0 = bf_lo(d[rr][h][k]), x1 = bf_hi(d[rr][h][k]); t1 += x0 + x1; t2 += x0 * x0 + x1 * x1; }
                s1[rr] = t1; s2[rr] = t2; }
#pragma unroll
            for (int o = 1; o < 64; o <<= 1)
#pragma unroll
                for (int rr = 0; rr < 8; ++rr) { s1[rr] += shfl_xor_f(s1[rr], o, lane); s2[rr] += shfl_xor_f(s2[rr], o, lane); }
            if (lane == 0) {
#pragma unroll
                for (int rr = 0; rr < 8; ++rr) { const float mean = s1[rr] * (1.0f / 1024.0f), var = fmaxf(s2[rr] * (1.0f / 1024.0f) - mean * mean, 0.f);
                    st_mean[wave * 16 + hb * 8 + rr] = mean; st_rstd[wave * 16 + hb * 8 + rr] = __builtin_amdgcn_rsqf(var + LN_EPS); } }
        }
        __syncthreads();
#define SGU_GROUP(gg) do { constexpr int g = (gg); \
            int tl = tid; asm volatile("" : "+v"(tl));       \
            const int fr = tl & 15, fq = (tl >> 4) & 3, co = tl & 15, qr = tl >> 4, p = wave * 16 + fr; \
            LAS bf16* vb = vn + (g & 1) * 128 * VS; \
              \
            _Pragma("unroll") for (int k = 0; k < 4; ++k) { const int q = qr + 32 * k; const u32x4 w = raw[g][k]; const float m = st_mean[q], r = st_rstd[q]; u32x4 o; \
                o.x = cvt_pk_bf16((bf_lo(w.x) - m) * r * lp[g][0][0] + lp[g][2][0], (bf_hi(w.x) - m) * r * lp[g][0][1] + lp[g][2][1]); o.y = cvt_pk_bf16((bf_lo(w.y) - m) * r * lp[g][0][2] + lp[g][2][2], (bf_hi(w.y) - m) * r * lp[g][0][3] + lp[g][2][3]); \
                o.z = cvt_pk_bf16((bf_lo(w.z) - m) * r * lp[g][1][0] + lp[g][3][0], (bf_hi(w.z) - m) * r * lp[g][1][1] + lp[g][3][1]); o.w = cvt_pk_bf16((bf_lo(w.w) - m) * r * lp[g][1][2] + lp[g][3][2], (bf_hi(w.w) - m) * r * lp[g][1][3] + lp[g][3][3]); \
                *(LAS u32x4*)(vb + q * VS + 8 * co) = o; } \
            __builtin_amdgcn_sched_barrier(0);                  \
            if constexpr (g + 1 < 8) SGU_LOADG(g + 1 < 8 ? g + 1 : 7); \
            if constexpr (g + 3 < 8) SGU_LOADU(g + 3 < 8 ? g + 3 : 7); \
            __syncthreads(); \
            _Pragma("unroll") for (int ct = 0; ct < 8; ++ct) { \
                f32x4 acc = (f32x4){0.f, 0.f, 0.f, 0.f}; \
                _Pragma("unroll") for (int ks = 0; ks < 4; ++ks) { LAS bf16* sp = vb + (ks * 32 + 4 * fq + (fr >> 2)) * VS + ct * 16 + 4 * (fr & 3); \
                    const s16x4 t0 = __builtin_amdgcn_ds_read_tr16_b64_v4i16((LAS s16x4*)sp), t1 = __builtin_amdgcn_ds_read_tr16_b64_v4i16((LAS s16x4*)(sp + 16 * VS)); \
                    const bf16x8 vf = __builtin_shufflevector(t0, t1, 0, 1, 2, 3, 4, 5, 6, 7); \
                    const bf16x8 wfr = __builtin_bit_cast(bf16x8, (u32x4){wq[g][ks][0].x, wq[g][ks][0].y, wq[g][ks][1].x, wq[g][ks][1].y}); \
                    acc = __builtin_amdgcn_mfma_f32_16x16x32_bf16(vf, wfr, acc, 0, 0, 0); } \
                const int c0 = g * 128 + ct * 16 + 4 * fq; const float bias = bsv[g]; \
                if constexpr (OUT_FP8 != 0) { const int w8 = pack4_fp8_sat(bf_lo(un[g][ct].x) * (acc[0] + bias) * F8_A2SCALE, bf_hi(un[g][ct].x) * (acc[1] + bias) * F8_A2SCALE, bf_lo(un[g][ct].y) * (acc[2] + bias) * F8_A2SCALE, bf_hi(un[g][ct].y) * (acc[3] + bias) * F8_A2SCALE); \
                    *(int*)((unsigned char*)A2 + (size_t)(row0 + p) * D + c0) = w8; } \
                else { u32x2 o; o.x = cvt_pk_bf16(bf_lo(un[g][ct].x) * (acc[0] + bias), bf_hi(un[g][ct].x) * (acc[1] + bias)); o.y = cvt_pk_bf16(bf_lo(un[g][ct].y) * (acc[2] + bias), bf_hi(un[g][ct].y) * (acc[3] + bias)); \
                    *(u32x2*)(A2 + (size_t)(row0 + p) * D + c0) = o; } } \
            __builtin_amdgcn_sched_barrier(0); } while (0)
        SGU_GROUP(0); SGU_GROUP(1); SGU_GROUP(2); SGU_GROUP(3); SGU_GROUP(4); SGU_GROUP(5); SGU_GROUP(6); SGU_GROUP(7);
#undef SGU_GROUP
#undef SGU_LOADU
#undef SGU_LOADG
    }
}

constexpr int PH_PER_LAYER = 10;
constexpr int NPHASES = 2 + PH_PER_LAYER * DEPTH;
#define GEMM_BODY(A, g, K, S, E) gemm_fast<false, false>(A, g, K, S, E, lds, tid)
#define GEMM_BODY_G(A, g, K, S, E) gemm_fast<true, false>(A, g, K, S, E, lds, tid)
#define GEMM_BODY8(A, g, K, S, E) gemm_fast<false, true>(A, g, K, S, E, lds, tid)
#define GEMM_BODY8_G(A, g, K, S, E) gemm_fast<true, true>(A, g, K, S, E, lds, tid)
__device__ __forceinline__ void ph_prologue(int wave_s) { PHASE_ENTER(); phase_prologue(a, lds, tid, bx, G); }
__device__ __forceinline__ void ph_rp_init(int wave_s) { PHASE_ENTER(); float* mod = (float*)(ws + WS_MOD);
    RowPass p{}; p.xin = a->in[I_X]; p.hout = (bf16*)(ws + WS_H); p.sc = mod + 1 * 1024; p.sh = mod + 0 * 1024; p.wside = (const bf16*)(ws + WS_GLALR_T); p.lr_out = (float*)(ws + WS_LR); p.has_h = 1; p.has_side = 1;
    row_pass<0>(p, lds, tid, bx, G); }
__device__ __forceinline__ void ph_gla_in(int wave_s, int li) { PHASE_ENTER(); Sched S; S.init(T / 256, GLA_MAIN / 256, G, bx, (const bf16*)(ws + WS_GLAIN_T) + (size_t)li * GLA_MAIN * 1024, 0, nullptr, 2048); EpiGlaIn E{(bf16*)(ws + WS_BIG)}; GEMM_BODY((const bf16*)(ws + WS_H), nullptr, 1024, S, E); }
#if SGUIN_FP8
__device__ __forceinline__ void ph_sgu_in(int wave_s, int li) { PHASE_ENTER(); Sched S; S.init(T / 256, 2048 / 256, G, bx, ws + WS_SGUIN_T + (size_t)li * 2048 * 1024, 0, nullptr, 1024); EpiSguIn E{(bf16*)(ws + WS_BIG), a->in[I_SBIN] + (size_t)li * 2048, 1.0f / (F8_WSCALE * F8_HSCALE)}; GEMM_BODY8(ws + WS_H8, nullptr, 1024, S, E); }
#else
__device__ __forceinline__ void ph_sgu_in(int wave_s, int li) { PHASE_ENTER(); Sched S; S.init(T / 256, 2048 / 256, G, bx, (const bf16*)(ws + WS_SGUIN_T) + (size_t)li * 2048 * 1024, 0, nullptr, 2048); EpiSguIn E{(bf16*)(ws + WS_BIG), a->in[I_SBIN] + (size_t)li * 2048, 1.0f}; GEMM_BODY((const bf16*)(ws + WS_H), nullptr, 1024, S, E); }
#endif
__device__ __forceinline__ void ph_gla_prep(int wave_s, int li) { PHASE_ENTER(); phase_gla_prep(a, li, lds, tid, bx, G); }
__device__ __forceinline__ void ph_gla_scan(int wave_s) { PHASE_ENTER(); phase_gla_scan(a, lds, tid, bx, G); }
__device__ __forceinline__ void ph_sgu_core(int wave_s, int li) { PHASE_ENTER(); phase_sgu_core(a, li, lds, tid, bx, G); }
__device__ __forceinline__ void ph_gla_post(int wave_s, int li) { PHASE_ENTER(); phase_gla_post(a, li, tid, bx, G); }
__device__ __forceinline__ void ph_out(int wave_s, int l) { PHASE_ENTER(); const int li = l >> 1; const bool sgu = (l & 1) != 0;
#if OUT_FP8
    Sched S; S.init(T / 256, 4, G, bx, ws + (sgu ? WS_SGUOUT_T : WS_GLAOUT_T) + (size_t)li * 1024 * 1024, 0, nullptr, 1024);
    EpiOut E{(bf16*)(ws + WS_Y), sgu ? a->in[I_SBOUT] + (size_t)li * 1024 : nullptr, 1.0f / (F8_WSCALE * F8_A2SCALE)}; GEMM_BODY8(ws + WS_A2, nullptr, 1024, S, E); }
#else
    Sched S; S.init(T / 256, 4, G, bx, (const bf16*)(ws + (sgu ? WS_SGUOUT_T : WS_GLAOUT_T)) + (size_t)li * 1024 * 1024, 0, nullptr, 2048);
    EpiOut E{(bf16*)(ws + WS_Y), sgu ? a->in[I_SBOUT] + (size_t)li * 1024 : nullptr, 1.0f}; GEMM_BODY((const bf16*)(ws + WS_A2), nullptr, 1024, S, E); }
#endif
__device__ __forceinline__ void ph_rp_mid(int wave_s, int l) { PHASE_ENTER(); float* modl = (float*)(ws + WS_MOD) + (size_t)l * 8 * 6144; int* route = (int*)(ws + WS_ROUTE);
    RowPass p{}; p.xin = (l == 0) ? (const void*)a->in[I_X] : (const void*)(ws + WS_X2); p.xin16 = (l != 0); p.y = (const bf16*)(ws + WS_Y); p.xout = ws + WS_X1; p.xout16 = 1; p.hout = (bf16*)(ws + WS_H);
    p.gate = modl + 2 * 1024; p.lng = a->in[I_LNG] + (size_t)(l * 2 + 0) * 1024; p.lnb = a->in[I_LNB] + (size_t)(l * 2 + 0) * 1024; p.sc = modl + 4 * 1024; p.sh = modl + 3 * 1024;
    p.wside = (const bf16*)(ws + WS_ROUTER_T) + (size_t)l * 64 * 1024; p.rbias = a->in[I_RB] + (size_t)l * 32;
    p.topi = route + R_TOPI; p.topw = (float*)(route + R_TOPW); p.hist = route + R_HIST + bx * 32; p.has_h = 1; p.has_side = 1; p.h8out = MOE_FP8 ? (ws + WS_H8) : nullptr;
    if (l == 0) row_pass<1, false>(p, lds, tid, bx, G); else row_pass<1, true>(p, lds, tid, bx, G); }
__device__ __forceinline__ void ph_place(int wave_s) { PHASE_ENTER(); phase_place((int*)(ws + WS_ROUTE), lds, tid, bx, G); }
__device__ __forceinline__ void ph_moe_up(int wave_s, int l) { PHASE_ENTER(); int* route = (int*)(ws + WS_ROUTE); const int ntiles = __builtin_amdgcn_readfirstlane(route[R_NTILES]);
#if MOE_FP8
    Sched S; S.init(ntiles, 8, G, bx, ws + WS_WUP_T + (size_t)l * 32 * 2048 * 1024, (size_t)2048 * 1024, route + R_TILEE, 1024);
    EpiUp<true> E{ws + WS_ACT, a->in[I_BUP] + (size_t)l * 32 * 2048}; GEMM_BODY8_G(ws + WS_H8, route + R_BUFTOK, 1024, S, E); }
#else
    Sched S; S.init(ntiles, 8, G, bx, ws + WS_WUP_T + (size_t)l * 32 * 2048 * 2048, (size_t)2048 * 2048, route + R_TILEE, 2048);
    EpiUp<false> E{ws + WS_ACT, a->in[I_BUP] + (size_t)l * 32 * 2048}; GEMM_BODY_G(ws + WS_H, route + R_BUFTOK, 1024, S, E); }
#endif
__device__ __forceinline__ void ph_moe_down(int wave_s, int l) { PHASE_ENTER(); int* route = (int*)(ws + WS_ROUTE); const int ntiles = __builtin_amdgcn_readfirstlane(route[R_NTILES]);
#if MOE_FP8
    Sched S; S.init(ntiles, 4, G, bx, ws + WS_WDN_T + (size_t)l * 32 * 1024 * 1024, (size_t)1024 * 1024, route + R_TILEE, 1024);
    EpiDown8 E{ws + WS_YS, a->in[I_BDN] + (size_t)l * 32 * 1024, 1.0f / (F8_WSCALE * F8_ASCALE)}; GEMM_BODY8(ws + WS_ACT, nullptr, 1024, S, E); }
#else
    Sched S; S.init(ntiles, 4, G, bx, ws + WS_WDN_T + (size_t)l * 32 * 1024 * 2048, (size_t)1024 * 2048, route + R_TILEE, 2048);
    EpiDown E{(bf16*)(ws + WS_YS), a->in[I_BDN] + (size_t)l * 32 * 1024, 1.0f}; GEMM_BODY(ws + WS_ACT, nullptr, 1024, S, E); }
#endif
__device__ __forceinline__ void ph_rp_end(int wave_s, int l) { PHASE_ENTER(); float* mod = (float*)(ws + WS_MOD); float* modl = mod + (size_t)l * 8 * 6144; int* route = (int*)(ws + WS_ROUTE);
    RowPass p{}; p.xin = ws + WS_X1; p.xin16 = 1; p.xout = (l == DEPTH - 1) ? (void*)a->out : (void*)(ws + WS_X2); p.xout16 = (l != DEPTH - 1); p.hout = (bf16*)(ws + WS_H);
    p.gate = modl + 5 * 1024; p.lng = a->in[I_LNG] + (size_t)(l * 2 + 1) * 1024; p.lnb = a->in[I_LNB] + (size_t)(l * 2 + 1) * 1024;
    p.ys = ws + WS_YS; p.dest = route + R_DEST; p.tw = (const float*)(route + R_TOPW);
    if (l < DEPTH - 1) { float* modn = mod + (size_t)(l + 1) * 8 * 6144; p.sc = modn + 1 * 1024; p.sh = modn + 0 * 1024; p.has_h = 1;
        if (SGUIN_FP8 && ((l + 1) & 1) == 1) p.h8out = ws + WS_H8;
        if (((l + 1) & 1) == 0) { p.has_side = 1; p.wside = (const bf16*)(ws + WS_GLALR_T) + (size_t)((l + 1) >> 1) * 64 * 1024; p.lr_out = (float*)(ws + WS_LR); } }
    row_pass<2>(p, lds, tid, bx, G); }

__global__ void __launch_bounds__(NTHREADS, 2) fwd_kernel(Args a) {
    extern __shared__ __attribute__((aligned(16))) unsigned char lds_raw[];
    LAS unsigned char* lds = (LAS unsigned char*)lds_raw;
    volatile LAS unsigned* MISC = (volatile LAS unsigned*)(lds + MISC_OFF);
    const int tid = threadIdx.x; const int wave_s = __builtin_amdgcn_readfirstlane(tid >> 6);
    if (tid < 32) ((LAS unsigned*)(lds + MISC_OFF))[tid] = 0u;
    __syncthreads();
    unsigned* ctl = (unsigned*)(a.ws + WS_CTL);
    XcdBarrier bar = xcd_barrier_post(ctl + CW_BAR + a.li * XCD_BAR_WORDS, MISC + 8);
    const int lo = a.ph_lo, hi = a.ph_hi;
#ifndef REPK
#define REPK 0
#define REPN 1
#endif
#define REP(kind) for (int rep_ = 0; rep_ < ((REPK == (kind)) ? REPN : 1); ++rep_)
#define IN(k) (lo <= (k) && (k) < hi)
#define SEAM(k) do { if (IN(k) && IN((k) + 1)) xcd_barrier(bar); } while (0)
    if (IN(0)) { REP(3) ph_prologue(wave_s); SEAM(0); }
    if (IN(1)) { ph_rp_init(wave_s); SEAM(1); }
    for (int l = 0; l < DEPTH; ++l) {
        const int pb = 2 + PH_PER_LAYER * l, li = l >> 1; const bool sgu = (l & 1) != 0;
        if (IN(pb + 0)) { REP(10) { if (!sgu) ph_gla_in(wave_s, li); else ph_sgu_in(wave_s, li); } SEAM(pb + 0); }
        if (IN(pb + 1)) { if (!sgu) { REP(12) ph_gla_prep(wave_s, li); SEAM(pb + 1); } }
        if (IN(pb + 2)) { if (!sgu) { REP(1) ph_gla_scan(wave_s); } else { REP(2) ph_sgu_core(wave_s, li); } SEAM(pb + 2); }
        if (IN(pb + 3)) { if (!sgu) { REP(6) ph_gla_post(wave_s, li); SEAM(pb + 3); } }
        if (IN(pb + 4)) { REP(11) ph_out(wave_s, l); SEAM(pb + 4); }
        if (IN(pb + 5)) { REP(4) ph_rp_mid(wave_s, l); SEAM(pb + 5); }
        if (IN(pb + 6)) { REP(7) ph_place(wave_s); SEAM(pb + 6); }
        if (IN(pb + 7)) { REP(8) ph_moe_up(wave_s, l); SEAM(pb + 7); }
        if (IN(pb + 8)) { REP(9) ph_moe_down(wave_s, l); SEAM(pb + 8); }
        if (IN(pb + 9)) { REP(5) ph_rp_end(wave_s, l); SEAM(pb + 9); }
    }
#undef IN
#undef SEAM
}

#ifndef N_LAUNCH_MODE
#define N_LAUNCH_MODE 1
#endif
extern "C" void kernel_launch(void* const* d_in, const int* in_sizes, int n_in, void* d_out, int out_size, void* d_ws, size_t ws_size, hipStream_t stream) {
    static int grid = 0;
    if (grid == 0) {
        if (n_in != 27 || out_size != T * D || ws_size < WS_END) { fprintf(stderr, "kernel_launch: unexpected shapes (n_in %d out %d ws %zu)\n", n_in, out_size, ws_size); grid = -1; return; }
        int dev = 0, cus = 0, per_cu = 0;
        if (hipGetDevice(&dev) != hipSuccess || hipDeviceGetAttribute(&cus, hipDeviceAttributeMultiprocessorCount, dev) != hipSuccess) { grid = -1; return; }
        if (hipFuncSetAttribute((const void*)fwd_kernel, hipFuncAttributeMaxDynamicSharedMemorySize, LDS_BYTES) != hipSuccess) { fprintf(stderr, "kernel_launch: hipFuncSetAttribute failed\n"); grid = -1; return; }
        if (hipOccupancyMaxActiveBlocksPerMultiprocessor(&per_cu, (const void*)fwd_kernel, NTHREADS, LDS_BYTES) != hipSuccess || per_cu < 1) fprintf(stderr, "kernel_launch: occupancy query reports %d\n", per_cu);
        (void)hipGetLastError();
        grid = cus;
        if (grid > 1024) grid = 1024;
    }
    if (grid < 0) return;
    (void)hipMemsetAsync((char*)d_ws + WS_CTL, 0, CTL_ZERO_BYTES, stream);
    Args a{};
    for (int i = 0; i < 27; ++i) a.in[i] = (const float*)d_in[i];
    a.out = (float*)d_out; a.ws = (unsigned char*)d_ws; a.pad = 0;
#if N_LAUNCH_MODE == 1
    a.ph_lo = 0; a.ph_hi = NPHASES; a.li = 0;
    hipLaunchKernelGGL(fwd_kernel, dim3(grid), dim3(NTHREADS), LDS_BYTES, stream, a);
#else
    for (int ph = 0, li = 0; ph < NPHASES; ++ph) {
        if (ph >= 2 && (((ph - 2) % PH_PER_LAYER) == 1 || ((ph - 2) % PH_PER_LAYER) == 3) && (((ph - 2) / PH_PER_LAYER) & 1)) continue;
        a.ph_lo = ph; a.ph_hi = ph + 1; a.li = li++;
        hipLaunchKernelGGL(fwd_kernel, dim3(grid), dim3(NTHREADS), LDS_BYTES, stream, a);
    }
#endif
}
```
